# Optimizing an MI355X kernel written in HIP

```python
import math
import jax
import jax.numpy as jnp
from jax import lax
import numpy as np

D_MODEL = 1024
BATCH = 2
SEQ = 16384
DEPTH = 2

HEAD_DIM = 128
N_RET_HEADS = 4
N_GDN_HEADS = 4
N_MOBA_HEADS = D_MODEL // HEAD_DIM
D_RET = N_RET_HEADS * HEAD_DIM
D_GDN = N_GDN_HEADS * HEAD_DIM
D_IN_EVEN = 4 * D_RET + 4 * D_GDN + 2 * N_GDN_HEADS
LIN_CHUNK = 64
CONV_WIDTH = 4
MOBA_BLOCK = 256
MOBA_TOPK = 3
MOBA_Q_CHUNK = 64
D_FF_DENSE = 2816
N_EXPERTS = 8
TOP_K = 2
D_FF_EXPERT = 3584
EXPERT_ROW_BLOCK = 512
N_EVEN = (DEPTH + 1) // 2
N_ODD = DEPTH // 2
NORM_EPS = 1e-6
NEG_INF = -1e30

kernel_name = 'hybrid_retnet_gdn_moba_moe'


def rms_norm(x, gain):
    xf = x.astype(jnp.float32)
    y = xf * lax.rsqrt(jnp.mean(xf * xf, axis=-1, keepdims=True) + NORM_EPS)
    return (y * gain.astype(jnp.float32)).astype(x.dtype)


def l2_normalize(x):
    return x * lax.rsqrt(jnp.sum(x * x, axis=-1, keepdims=True) + NORM_EPS)


def to_heads(x, n_heads):
    b, l, _ = x.shape
    return x.reshape(b, l, n_heads, HEAD_DIM).transpose(0, 2, 1, 3)


def to_chunks(x):
    b, h, l = x.shape[:3]
    return x.reshape(b, h, l // LIN_CHUNK, LIN_CHUNK, *x.shape[3:])


def swiglu(x, w_gate, w_up, w_down):
    return (jax.nn.silu(x @ w_gate) * (x @ w_up)) @ w_down


def causal_depthwise_conv(x, w):
    ch = x.shape[-1]
    return lax.conv_general_dilated(
        x, w[:, None, :], window_strides=(1,), padding=((CONV_WIDTH - 1, 0),),
        dimension_numbers=('NWC', 'WIO', 'NWC'), feature_group_count=ch)


def retention_chunkwise(q, k, v):
    b, h, l, d = q.shape
    log_gamma = jnp.log1p(-jnp.exp2(-5.0 - jnp.arange(h, dtype=jnp.float32)))
    pos = jnp.arange(LIN_CHUNK, dtype=jnp.float32)
    diff = pos[:, None] - pos[None, :]
    d_mask = jnp.where(diff >= 0.0, jnp.exp(log_gamma[:, None, None] * jnp.maximum(diff, 0.0)), 0.0)
    qc, kc, vc = to_chunks(q), to_chunks(k * d ** -0.5), to_chunks(v)
    scores = jnp.einsum('bhnid,bhnjd->bhnij', qc, kc) * d_mask[None, :, None]
    o_intra = jnp.einsum('bhnij,bhnjd->bhnid', scores, vc)
    q_dec = qc * jnp.exp(log_gamma[:, None] * (pos + 1.0))[None, :, None, :, None]
    k_dec = kc * jnp.exp(log_gamma[:, None] * (LIN_CHUNK - 1.0 - pos))[None, :, None, :, None]
    chunk_decay = jnp.exp(log_gamma * LIN_CHUNK)[None, :, None, None]

    def step(state, xs):
        q_i, k_i, v_i = xs
        o_i = jnp.einsum('bhcd,bhde->bhce', q_i, state)
        state = state * chunk_decay + jnp.einsum('bhcd,bhce->bhde', k_i, v_i)
        return state, o_i

    state0 = jnp.zeros((b, h, d, d), q.dtype)
    _, o_inter = lax.scan(step, state0, (jnp.moveaxis(q_dec, 2, 0), jnp.moveaxis(k_dec, 2, 0), jnp.moveaxis(vc, 2, 0)))
    o = o_intra + jnp.moveaxis(o_inter, 0, 2)
    return o.reshape(b, h, l, d)


def gated_delta_rule_chunked(q, k, v, g, beta):
    b, h, l, d = q.shape
    idx = jnp.arange(LIN_CHUNK)
    incl = idx[:, None] >= idx[None, :]
    strict = idx[:, None] > idx[None, :]
    eye = jnp.eye(LIN_CHUNK, dtype=q.dtype)
    qc, kc, vc = to_chunks(q * d ** -0.5), to_chunks(k), to_chunks(v)
    gcum = jnp.cumsum(to_chunks(g), axis=-1)
    bc = to_chunks(beta)[..., None]
    gdiff = gcum[..., :, None] - gcum[..., None, :]
    decay = jnp.where(incl, jnp.exp(jnp.where(incl, gdiff, 0.0)), 0.0)
    k_beta = kc * bc
    lower = jnp.where(strict, jnp.einsum('bhnid,bhnjd->bhnij', k_beta, kc) * decay, 0.0)
    t_mat = lax.linalg.triangular_solve(eye + lower, jnp.broadcast_to(eye, lower.shape), left_side=True, lower=True)
    u = t_mat @ (vc * bc)
    w = t_mat @ (k_beta * jnp.exp(gcum)[..., None])
    attn = jnp.where(incl, jnp.einsum('bhnid,bhnjd->bhnij', qc, kc) * decay, 0.0)
    q_dec = qc * jnp.exp(gcum)[..., None]
    k_dec = kc * jnp.exp(gcum[..., -1:] - gcum)[..., None]
    chunk_decay = jnp.exp(gcum[..., -1])

    def step(state, xs):
        w_i, u_i, q_i, k_i, a_i, dec_i = xs
        v_new = u_i - w_i @ state
        o_i = q_i @ state + a_i @ v_new
        state = state * dec_i[..., None, None] + jnp.einsum('bhcd,bhce->bhde', k_i, v_new)
        return state, o_i

    xs = (jnp.moveaxis(w, 2, 0), jnp.moveaxis(u, 2, 0), jnp.moveaxis(q_dec, 2, 0),
          jnp.moveaxis(k_dec, 2, 0), jnp.moveaxis(attn, 2, 0), jnp.moveaxis(chunk_decay, 2, 0))
    state0 = jnp.zeros((b, h, d, d), q.dtype)
    _, o = lax.scan(step, state0, xs)
    return jnp.moveaxis(o, 0, 2).reshape(b, h, l, d)


def retention_deltanet_mixer(h, w_in, conv_w, a_log, dt_bias, ret_norm, gdn_norm, w_out):
    b, l, _ = h.shape
    proj = (h @ w_in).astype(jnp.float32)
    cuts = [D_RET, 2 * D_RET, 3 * D_RET, 4 * D_RET,
            4 * D_RET + 3 * D_GDN, 4 * D_RET + 4 * D_GDN, 4 * D_RET + 4 * D_GDN + N_GDN_HEADS]
    q_a, k_a, v_a, g_a, qkv_b, g_b, beta_raw, a_raw = jnp.split(proj, cuts, axis=-1)
    o_a = retention_chunkwise(to_heads(q_a, N_RET_HEADS), to_heads(k_a, N_RET_HEADS), to_heads(v_a, N_RET_HEADS))
    o_a = rms_norm(o_a.transpose(0, 2, 1, 3), ret_norm).reshape(b, l, D_RET) * jax.nn.silu(g_a)
    qkv_b = jax.nn.silu(causal_depthwise_conv(qkv_b, conv_w.astype(jnp.float32)))
    q_b, k_b, v_b = jnp.split(qkv_b, 3, axis=-1)
    q_b = l2_normalize(to_heads(q_b, N_GDN_HEADS))
    k_b = l2_normalize(to_heads(k_b, N_GDN_HEADS))
    v_b = to_heads(v_b, N_GDN_HEADS)
    beta = jax.nn.sigmoid(beta_raw).transpose(0, 2, 1)
    g = (-jnp.exp(a_log.astype(jnp.float32)) * jax.nn.softplus(a_raw + dt_bias.astype(jnp.float32))).transpose(0, 2, 1)
    o_b = gated_delta_rule_chunked(q_b, k_b, v_b, g, beta)
    o_b = rms_norm(o_b.transpose(0, 2, 1, 3), gdn_norm).reshape(b, l, D_GDN) * jax.nn.silu(g_b)
    mixed = jnp.concatenate([o_a, o_b], axis=-1).astype(h.dtype)
    return mixed @ w_out


def moba_mixer(h, w_qkv, w_out):
    b, l, _ = h.shape
    n_h = N_MOBA_HEADS
    d = HEAD_DIM
    q, k, v = jnp.split((h @ w_qkv).astype(jnp.float32), 3, axis=-1)
    q, k, v = to_heads(q, n_h), to_heads(k, n_h), to_heads(v, n_h)
    n_blk = -(-l // MOBA_BLOCK)
    pad = n_blk * MOBA_BLOCK - l
    kb = jnp.pad(k, ((0, 0), (0, 0), (0, pad), (0, 0))).reshape(b, n_h, n_blk, MOBA_BLOCK, d)
    vb = jnp.pad(v, ((0, 0), (0, 0), (0, pad), (0, 0))).reshape(b, n_h, n_blk, MOBA_BLOCK, d)
    k_mean = jnp.mean(kb, axis=3)
    slopes = jnp.exp2(-8.0 * jnp.arange(1, n_h + 1, dtype=jnp.float32) / n_h)
    n_sel = min(MOBA_TOPK, n_blk)
    n_qc = l // MOBA_Q_CHUNK
    q_chunks = jnp.moveaxis(q.reshape(b, n_h, n_qc, MOBA_Q_CHUNK, d), 2, 0)
    scale = d ** -0.5
    blk_ids = jnp.arange(n_blk)
    offs = jnp.arange(MOBA_BLOCK)
    bi = jnp.arange(b)[:, None, None, None]
    hi = jnp.arange(n_h)[None, :, None, None]

    def attend(args):
        c, q_c = args
        t = c * MOBA_Q_CHUNK + jnp.arange(MOBA_Q_CHUNK)
        own = (c * MOBA_Q_CHUNK) // MOBA_BLOCK
        gate = jnp.einsum('bhqd,bhnd->bhqn', q_c, k_mean)
        gate = jnp.where(blk_ids < own, gate, NEG_INF)
        _, sel = lax.top_k(gate, n_sel)
        valid = sel < own
        k_sel = kb[bi, hi, sel]
        pos_sel = sel[..., None] * MOBA_BLOCK + offs
        dist_sel = (t[:, None, None] - pos_sel).astype(jnp.float32)
        s_sel = jnp.einsum('bhqd,bhqjsd->bhqjs', q_c, k_sel) * scale - slopes[:, None, None, None] * dist_sel
        s_sel = jnp.where(valid[..., None], s_sel, NEG_INF)
        k_own = lax.dynamic_index_in_dim(kb, own, axis=2, keepdims=False)
        v_own = lax.dynamic_index_in_dim(vb, own, axis=2, keepdims=False)
        pos_own = own * MOBA_BLOCK + offs
        dist_own = (t[:, None] - pos_own[None, :]).astype(jnp.float32)
        s_own = jnp.einsum('bhqd,bhsd->bhqs', q_c, k_own) * scale - slopes[:, None, None] * dist_own
        s_own = jnp.where(dist_own >= 0.0, s_own, NEG_INF)
        probs = jax.nn.softmax(jnp.concatenate(
            [s_own, s_sel.reshape(b, n_h, MOBA_Q_CHUNK, n_sel * MOBA_BLOCK)], axis=-1), axis=-1)
        p_own = probs[..., :MOBA_BLOCK]
        p_sel = probs[..., MOBA_BLOCK:].reshape(b, n_h, MOBA_Q_CHUNK, n_sel, MOBA_BLOCK)
        v_sel = vb[bi, hi, sel]
        return jnp.einsum('bhqs,bhsd->bhqd', p_own, v_own) + jnp.einsum('bhqjs,bhqjsd->bhqd', p_sel, v_sel)

    o = lax.map(attend, (jnp.arange(n_qc), q_chunks))
    o = o.transpose(1, 0, 3, 2, 4).reshape(b, l, n_h * d)
    return o.astype(h.dtype) @ w_out


def moe_swiglu(h, w_router, w_gate, w_up, w_down):
    b, l, dm = h.shape
    xt = h.reshape(b * l, dm)
    n_assign = b * l * TOP_K
    logits = (xt @ w_router).astype(jnp.float32)
    top_logit, top_idx = lax.top_k(logits, TOP_K)
    gate = jax.nn.softmax(top_logit, axis=-1)
    expert_of = top_idx.reshape(-1)
    order = jnp.argsort(expert_of)
    sorted_expert = expert_of[order]
    counts = jnp.bincount(expert_of, length=N_EXPERTS)
    padded = (counts + EXPERT_ROW_BLOCK - 1) // EXPERT_ROW_BLOCK * EXPERT_ROW_BLOCK
    padded_end = jnp.cumsum(padded)
    padded_start = padded_end - padded
    start = jnp.cumsum(counts) - counts
    dest = padded_start[sorted_expert] + jnp.arange(n_assign) - start[sorted_expert]
    n_blocks = -(-n_assign // EXPERT_ROW_BLOCK) + N_EXPERTS
    buf = jnp.zeros((n_blocks * EXPERT_ROW_BLOCK, dm), h.dtype).at[dest].set(xt[order // TOP_K])
    block_expert = jnp.minimum(
        jnp.searchsorted(padded_end, jnp.arange(n_blocks) * EXPERT_ROW_BLOCK, side='right'), N_EXPERTS - 1)

    def run_block(args):
        e, rows = args
        return swiglu(rows, w_gate[e], w_up[e], w_down[e])

    y = lax.map(run_block, (block_expert, buf.reshape(n_blocks, EXPERT_ROW_BLOCK, dm)))
    y_sorted = y.reshape(-1, dm)[dest]
    y_assign = jnp.zeros((n_assign, dm), h.dtype).at[order].set(y_sorted).reshape(b * l, TOP_K, dm)
    out = jnp.einsum('tk,tkd->td', gate.astype(h.dtype), y_assign)
    return out.reshape(b, l, dm)


def setup_inputs(seed: int = 0) -> dict:
    key = jax.random.key(seed)
    ks = jax.random.split(key, 20)
    f32 = jnp.float32

    def dense(k, shape, fan_in):
        return jax.random.normal(k, shape, f32) * fan_in ** -0.5

    def gain(k, shape):
        return 1.0 + 0.02 * jax.random.normal(k, shape, f32)

    x = jax.random.normal(ks[0], (BATCH, SEQ, D_MODEL), f32)
    mix_norm = gain(ks[1], (DEPTH, D_MODEL))
    ffn_norm = gain(ks[2], (DEPTH, D_MODEL))
    even_w_in = dense(ks[3], (N_EVEN, D_MODEL, D_IN_EVEN), D_MODEL)
    even_conv_w = dense(ks[4], (N_EVEN, CONV_WIDTH, 3 * D_GDN), CONV_WIDTH)
    even_a_log = jnp.log(jax.random.uniform(ks[5], (N_EVEN, N_GDN_HEADS), f32, 1.0, 16.0))
    dt = jnp.exp(jax.random.uniform(ks[6], (N_EVEN, N_GDN_HEADS), f32, math.log(1e-3), math.log(1e-1)))
    even_dt_bias = dt + jnp.log(-jnp.expm1(-dt))
    even_ret_norm = gain(ks[7], (N_EVEN, N_RET_HEADS, HEAD_DIM))
    even_gdn_norm = gain(ks[8], (N_EVEN, N_GDN_HEADS, HEAD_DIM))
    even_w_out = dense(ks[9], (N_EVEN, D_RET + D_GDN, D_MODEL), D_RET + D_GDN)
    odd_w_qkv = dense(ks[10], (N_ODD, D_MODEL, 3 * D_MODEL), D_MODEL)
    odd_w_out = dense(ks[11], (N_ODD, D_MODEL, D_MODEL), D_MODEL)
    ffn_w_gate = dense(ks[12], (N_EVEN, D_MODEL, D_FF_DENSE), D_MODEL)
    ffn_w_up = dense(ks[13], (N_EVEN, D_MODEL, D_FF_DENSE), D_MODEL)
    ffn_w_down = dense(ks[14], (N_EVEN, D_FF_DENSE, D_MODEL), D_FF_DENSE)
    moe_router = dense(ks[15], (N_ODD, D_MODEL, N_EXPERTS), D_MODEL)
    moe_w_gate = dense(ks[16], (N_ODD, N_EXPERTS, D_MODEL, D_FF_EXPERT), D_MODEL)
    moe_w_up = dense(ks[17], (N_ODD, N_EXPERTS, D_MODEL, D_FF_EXPERT), D_MODEL)
    moe_w_down = dense(ks[18], (N_ODD, N_EXPERTS, D_FF_EXPERT, D_MODEL), D_FF_EXPERT)
    final_norm = gain(ks[19], (D_MODEL,))
    return {'x': x, 'mix_norm': mix_norm, 'ffn_norm': ffn_norm,
            'even_w_in': even_w_in, 'even_conv_w': even_conv_w, 'even_a_log': even_a_log,
            'even_dt_bias': even_dt_bias, 'even_ret_norm': even_ret_norm, 'even_gdn_norm': even_gdn_norm,
            'even_w_out': even_w_out, 'odd_w_qkv': odd_w_qkv, 'odd_w_out': odd_w_out,
            'ffn_w_gate': ffn_w_gate, 'ffn_w_up': ffn_w_up, 'ffn_w_down': ffn_w_down,
            'moe_router': moe_router, 'moe_w_gate': moe_w_gate, 'moe_w_up': moe_w_up,
            'moe_w_down': moe_w_down, 'final_norm': final_norm}


def reference(x, mix_norm, ffn_norm, even_w_in, even_conv_w, even_a_log, even_dt_bias,
              even_ret_norm, even_gdn_norm, even_w_out, odd_w_qkv, odd_w_out,
              ffn_w_gate, ffn_w_up, ffn_w_down, moe_router, moe_w_gate, moe_w_up,
              moe_w_down, final_norm):
    h = x
    for layer in range(DEPTH):
        i = layer // 2
        hn = rms_norm(h, mix_norm[layer])
        if layer % 2 == 0:
            h = h + retention_deltanet_mixer(hn, even_w_in[i], even_conv_w[i], even_a_log[i], even_dt_bias[i],
                                             even_ret_norm[i], even_gdn_norm[i], even_w_out[i])
            h = h + swiglu(rms_norm(h, ffn_norm[layer]), ffn_w_gate[i], ffn_w_up[i], ffn_w_down[i])
        else:
            h = h + moba_mixer(hn, odd_w_qkv[i], odd_w_out[i])
            h = h + moe_swiglu(rms_norm(h, ffn_norm[layer]), moe_router[i], moe_w_gate[i], moe_w_up[i], moe_w_down[i])
    return rms_norm(h, final_norm)
```

```cpp
#ifndef CPU_EMU
#include <hip/hip_runtime.h>
#include <hip/hip_cooperative_groups.h>
#include <cstdio>
#include <cstring>
#define LAS __attribute__((address_space(3)))
#define WAVE_SYNC() __builtin_amdgcn_wave_barrier()
#define SCHED_FENCE() __builtin_amdgcn_sched_barrier(0)
#define OPAQUE_V(x) asm volatile("" : "+v"(x))
static __device__ __forceinline__ unsigned shfl_up_u(unsigned v, int o, int lane) { const int src = lane >= o ? lane - o : lane; return (unsigned)__builtin_amdgcn_ds_bpermute(src << 2, (int)v); }
static __device__ __forceinline__ float shfl_up_f(float v, int o, int lane) { return __uint_as_float(shfl_up_u(__float_as_uint(v), o, lane)); }
#define LDS_ATOMIC_ADD(ptr, v) __hip_atomic_fetch_add((ptr), (v), __ATOMIC_RELAXED, __HIP_MEMORY_SCOPE_WORKGROUP)
#define LDS_ATOMIC_MAX(ptr, v) __hip_atomic_fetch_max((ptr), (v), __ATOMIC_RELAXED, __HIP_MEMORY_SCOPE_WORKGROUP)
#define GLOBAL_ATOMIC_MAX(ptr, v) __hip_atomic_fetch_max((ptr), (v), __ATOMIC_RELAXED, __HIP_MEMORY_SCOPE_AGENT)
static __device__ __forceinline__ int opaque_tid(int wv) { int l; asm volatile("v_mbcnt_lo_u32_b32 %0, -1, 0\n\tv_mbcnt_hi_u32_b32 %0, -1, %0" : "=v"(l)); return (wv << 6) | l; }
#else
static inline int opaque_tid(int) { return threadIdx.x; }
#define LAS
#define WAVE_SYNC() ((void)__ballot(1))
#define SCHED_FENCE() ((void)0)
#define OPAQUE_V(x) ((void)0)
static inline unsigned shfl_up_u(unsigned v, int o, int lane) { return __shfl(v, lane >= o ? lane - o : lane); }
static inline float shfl_up_f(float v, int o, int lane) { return __shfl(v, lane >= o ? lane - o : lane); }
static inline unsigned emu_fetch_add(unsigned* p, unsigned v) { unsigned o = *p; *p = o + v; return o; }
#define LDS_ATOMIC_ADD(ptr, v) emu_fetch_add((ptr), (v))
static inline unsigned emu_fetch_max(unsigned* p, unsigned v) { unsigned o = *p; if (v > o) *p = v; return o; }
#define LDS_ATOMIC_MAX(ptr, v) emu_fetch_max((ptr), (v))
#define GLOBAL_ATOMIC_MAX(ptr, v) atomicMax((ptr), (v))
#endif
namespace cg = cooperative_groups;

#ifndef RPT_SYNC
#define RPT_SYNC 0
#endif
#ifndef RPT_SG
#define RPT_SG 1
#endif
#ifndef RPT_SR
#define RPT_SR 1
#endif
#ifndef RPT_MG
#define RPT_MG 1
#endif
#ifndef RPT_MO
#define RPT_MO 1
#endif
#ifndef RPT_GEMM
#define RPT_GEMM 1
#endif
#ifndef RPT_GDN
#define RPT_GDN 1
#endif
#ifndef RPT_SCAN
#define RPT_SCAN 1
#endif
#ifndef RPT_MOBA
#define RPT_MOBA 1
#endif
#ifndef RPT_CONV
#define RPT_CONV 1
#endif
#ifndef FP8_FFN0
#define FP8_FFN0 0
#endif
#ifndef CFG_SEQ
#define CFG_SEQ 16384
#define CFG_BATCH 2
#define CFG_FF 2816
#define CFG_FFE 3584
#endif

typedef unsigned short bf16_t;
typedef short bf16x8 __attribute__((ext_vector_type(8)));
typedef float f32x4 __attribute__((ext_vector_type(4)));
typedef float f32x16 __attribute__((ext_vector_type(16)));
typedef unsigned u32x4 __attribute__((ext_vector_type(4)));
typedef unsigned u32x2 __attribute__((ext_vector_type(2)));

constexpr int DM = 1024, SEQ = CFG_SEQ, BATCH = CFG_BATCH, NTOK = SEQ * BATCH, HD = 128;
constexpr int DIN = 4104, DINP = 4096, FF = CFG_FF, FFE = CFG_FFE, NE = 8;
constexpr int NCH = SEQ / 64, NBLK = SEQ / 256, NCHH = BATCH * 4 * NCH;
constexpr int NTHREADS = 512;
constexpr int BM = 256, BK = 64, HALF = 128, HTB = HALF * BK * 2, STAGE_BYTES = 8 * HTB, NXCD = 8, WGM = 4;
constexpr size_t kDynLds = 144 * 1024;
constexpr int MAXTILES = NTOK * 2 / 256 + NE;
constexpr int NIT = BATCH * 8 * NBLK;
constexpr int LTOT = NBLK * SEQ - 128 * NBLK * (NBLK + 1);
static_assert(SEQ <= 16384, "16-bit selection-list entries");
constexpr int GNT = (NBLK + 15) / 16;
constexpr int KS_STRIDE = 272, VT_STRIDE = 520;
constexpr int KS_BYTES = 256 * KS_STRIDE, VT_BYTES = 128 * VT_STRIDE;
__host__ __device__ __forceinline__ int list_off(int j) { return j * SEQ - 128 * j * (j + 1); }
constexpr float NORM_EPS = 1e-6f;

__device__ __forceinline__ bf16_t f2bf(float f) { unsigned u = __float_as_uint(f); u += 0x7FFFu + ((u >> 16) & 1u); return (bf16_t)(u >> 16); }
__device__ __forceinline__ float bf2f(bf16_t h) { return __uint_as_float(((unsigned)h) << 16); }
#ifndef CPU_EMU
typedef __bf16 hwbf16x2 __attribute__((ext_vector_type(2)));
typedef float f32x2v __attribute__((ext_vector_type(2)));
__device__ __forceinline__ unsigned pack2(float lo, float hi) { f32x2v v; v.x = lo; v.y = hi; hwbf16x2 b = __builtin_convertvector(v, hwbf16x2); unsigned r; __builtin_memcpy(&r, &b, 4); return r; }
#else
__device__ __forceinline__ unsigned pack2(float lo, float hi) { return (unsigned)f2bf(lo) | ((unsigned)f2bf(hi) << 16); }
#endif
#ifndef CPU_EMU
__device__ __forceinline__ float siluf(float x) { return x * __builtin_amdgcn_rcpf(1.0f + __builtin_amdgcn_exp2f(-1.4426950408889634f * x)); }
#else
__device__ __forceinline__ float siluf(float x) { return x / (1.0f + __expf(-x)); }
#endif
#ifndef CPU_EMU
__device__ __forceinline__ unsigned pack4_fp8(float a, float b, float c, float d) { int r = 0; r = __builtin_amdgcn_cvt_pk_fp8_f32(a, b, r, false); r = __builtin_amdgcn_cvt_pk_fp8_f32(c, d, r, true); return (unsigned)r; }
#else
static inline float fp8_to_f(unsigned char v) { const int s = v >> 7, e = (v >> 3) & 15, m = v & 7; const float a = e == 0 ? ldexpf((float)m, -9) : ldexpf((float)(8 + m), e - 10); return s ? -a : a; }
static inline unsigned char f_to_fp8(float x) {
    const unsigned s = x < 0.f ? 0x80u : 0u; float a = fabsf(x); if (!(a == a)) return 0x7f; if (a > 448.f) a = 448.f; if (a == 0.f) return (unsigned char)s;
    int e; (void)frexpf(a, &e); e -= 1; if (e < -6) e = -6;
    const float step = ldexpf(1.f, e - 3); float q = nearbyintf(a / step) * step; if (q > 448.f) q = 448.f;
    int e2; (void)frexpf(q, &e2); e2 -= 1; unsigned bits;
    if (q < ldexpf(1.f, -6)) bits = (unsigned)nearbyintf(q * 512.f); else bits = ((unsigned)(e2 + 7) << 3) | ((unsigned)nearbyintf(q / ldexpf(1.f, e2 - 3)) - 8u);
    return (unsigned char)(s | bits);
}
static inline unsigned pack4_fp8(float a, float b, float c, float d) { return (unsigned)f_to_fp8(a) | ((unsigned)f_to_fp8(b) << 8) | ((unsigned)f_to_fp8(c) << 16) | ((unsigned)f_to_fp8(d) << 24); }
#endif
constexpr float FP8_TOP = 384.f;
#ifndef CPU_EMU
__device__ __forceinline__ float wave_sum(float s) { int l; asm volatile("v_mbcnt_lo_u32_b32 %0, -1, 0\n\tv_mbcnt_hi_u32_b32 %0, -1, %0" : "=v"(l));
#pragma unroll
    for (int o = 32; o >= 1; o >>= 1) s += __uint_as_float((unsigned)__builtin_amdgcn_ds_bpermute((l ^ o) << 2, (int)__float_as_uint(s))); return s; }
__device__ __forceinline__ float wave_max(float s) { int l; asm volatile("v_mbcnt_lo_u32_b32 %0, -1, 0\n\tv_mbcnt_hi_u32_b32 %0, -1, %0" : "=v"(l));
#pragma unroll
    for (int o = 32; o >= 1; o >>= 1) s = fmaxf(s, __uint_as_float((unsigned)__builtin_amdgcn_ds_bpermute((l ^ o) << 2, (int)__float_as_uint(s)))); return s; }
#else
__device__ __forceinline__ float wave_sum(float s) { for (int o = 32; o >= 1; o >>= 1) s += __shfl_xor(s, o); return s; }
__device__ __forceinline__ float wave_max(float s) { for (int o = 32; o >= 1; o >>= 1) s = fmaxf(s, __shfl_xor(s, o)); return s; }
#endif

struct Params;
#ifndef CPU_EMU
typedef const __attribute__((address_space(4))) Params* KPTR;
#define KARG_PTR(arg) ((KPTR)__builtin_amdgcn_kernarg_segment_ptr())
#define LAUNDER(q) asm volatile("" : "+s"(q))
#else
typedef const Params* KPTR;
#define KARG_PTR(arg) (&(arg))
#define LAUNDER(q) ((void)0)
#endif
struct Params {
    const float* x; const float* mix_norm; const float* ffn_norm; const float* w_in; const float* conv_w; const float* a_log; const float* dt_bias;
    const float* ret_norm; const float* gdn_norm; const float* w_out0; const float* w_qkv; const float* w_out1; const float* w_gate0; const float* w_up0;
    const float* w_down0; const float* w_router; const float* w_mgate; const float* w_mup; const float* w_mdown; const float* final_norm;
    float* out;
    bf16_t* hb;
    bf16_t* hb3;
    unsigned* ctrl;
    unsigned* bar;
    bf16_t* wt_in; bf16_t* wt_out0; bf16_t* wt_gu0; bf16_t* wt_d0; bf16_t* wt_qkv; bf16_t* wt_out1;
    bf16_t* hn;
    float* gbeta; float* gg;
    float* retL;
    unsigned* gflag;
    unsigned char* arena;
    bf16_t* proj; unsigned char* gimg; float* gcdec;
    bf16_t* act0;
    bf16_t* qkv; bf16_t* kmh; bf16_t* kml; unsigned* mcount; unsigned short* mlist; bf16_t* part_o; float* part_lse;
    bf16_t* wt_mgu; bf16_t* wt_md; bf16_t* yslot; bf16_t* mact; int* arow; int* tile_e; int* slot_of; float* mgate; int* midx; unsigned* wghist;
    unsigned char* w8_gu0; float* ws_gu0; unsigned char* w8_mgu; float* ws_mgu; float* hns; float* sslot; unsigned char* w8_md; float* ws_md; float* hnn2; float* sn2; float* shs; bf16_t* wt_md_tmp;
    int tiles_per_pass; int pad0;
};

#define C_CNT(e) (64 + (e))
#define C_CUR(e) (128 + (e))
#define C_NTILES 192
#define C_GMAX 216
#define C_UMAX 224
#define C_TB 200

__host__ __device__ __forceinline__ int lds_byte(int r, int c) { const int st = (r >> 4) * 2 + (c >> 5), rr = r & 15, cc = c & 31, ob = rr * 64 + cc * 2; return st * 1024 + (ob ^ (((ob >> 9) & 1) << 5)); }
__host__ __device__ __forceinline__ void stage_rc(int b, int& R, int& C) { const int st = b / 1024, sb = b % 1024, swz = sb ^ (((sb >> 9) & 1) << 5); R = (st >> 1) * 16 + swz / 64; C = (st & 1) * 32 + (swz % 64) / 2; }
__host__ __device__ __forceinline__ int perm32(int rho) { const int n = rho >> 4, i = rho & 15; return 8 * (i >> 2) + 4 * n + (i & 3); }

struct Unit { int pm, pn, pnb; };
struct Gemm { const bf16_t* A; const bf16_t* Bt; const int* arow; };

struct StaticOrder {
    int nM, nN, nwg, G, c;
    __device__ void init(int nM_, int nN_, int G_, int c_) { nM = nM_; nN = nN_; nwg = nM * nN; G = G_; c = c_; }
    __device__ bool next(int i, Unit& u) const {
        const long L = (long)i * G + c; if (L >= nwg) return false;
        int wgid = (int)L; { const int q = nwg / NXCD, r = nwg % NXCD, xcd = wgid % NXCD, off = wgid / NXCD; wgid = (xcd < r ? xcd * (q + 1) : r * (q + 1) + (xcd - r) * q) + off; }
        const int nig = WGM * nN, gid = wgid / nig, fm = gid * WGM, gsz = (nM - fm) < WGM ? (nM - fm) : WGM;
        u.pm = fm + ((wgid % nig) % gsz); u.pn = (wgid % nig) / gsz; u.pnb = u.pn; return true;
    }
};
struct MoeOrder {
    StaticOrder so; int t0; const int* tile_e;
    __device__ void init(int t0_, int nM_, int nN_, const int* te, int G_, int c_) { so.init(nM_, nN_, G_, c_); t0 = t0_; tile_e = te; }
    __device__ bool next(int i, Unit& u) const { if (!so.next(i, u)) return false; u.pm += t0; u.pnb = tile_e[u.pm] * so.nN + u.pn; return true; }
};

struct EpiBf16 {
    static constexpr bool PERM = true;
    bf16_t* O; int ldc; int rowbase;
    __device__ __forceinline__ void operator()(const f32x4 (&acc)[2][2][4][2], const Unit& u, int wr, int wc, int fr, int fq) const {
        const int row0 = u.pm * BM + wr * 64 + fr - rowbase, col0 = u.pn * BM + wc * 32 + 8 * fq;
#pragma unroll
        for (int ai = 0; ai < 2; ++ai)
#pragma unroll
            for (int m = 0; m < 4; ++m) { bf16_t* rowp = O + (size_t)(row0 + ai * HALF + m * 16) * ldc + col0;
#pragma unroll
                for (int bj = 0; bj < 2; ++bj) { const f32x4 v0 = acc[ai][bj][m][0], v1 = acc[ai][bj][m][1];
                    u32x4 w; w.x = pack2(v0[0], v0[1]); w.y = pack2(v0[2], v0[3]); w.z = pack2(v1[0], v1[1]); w.w = pack2(v1[2], v1[3]);
                    *(u32x4*)(rowp + bj * HALF) = w; } }
    }
};
struct EpiSwiglu {
    static constexpr bool PERM = true;
    bf16_t* O; int ldc; int rowbase;
    __device__ __forceinline__ void operator()(const f32x4 (&acc)[2][2][4][2], const Unit& u, int wr, int wc, int fr, int fq) const {
        const int row0 = u.pm * BM + wr * 64 + fr - rowbase, col0 = u.pn * HALF + wc * 32 + 8 * fq;
#pragma unroll
        for (int ai = 0; ai < 2; ++ai)
#pragma unroll
            for (int m = 0; m < 4; ++m) { bf16_t* rowp = O + (size_t)(row0 + ai * HALF + m * 16) * ldc + col0;
                float r[8];
#pragma unroll
                for (int n = 0; n < 2; ++n)
#pragma unroll
                    for (int j = 0; j < 4; ++j) r[n * 4 + j] = siluf(acc[ai][0][m][n][j]) * acc[ai][1][m][n][j];
                u32x4 w; w.x = pack2(r[0], r[1]); w.y = pack2(r[2], r[3]); w.z = pack2(r[4], r[5]); w.w = pack2(r[6], r[7]);
                *(u32x4*)rowp = w; }
    }
};
struct EpiSwigluS {
    static constexpr bool PERM = true;
    bf16_t* O; int ldc; int rowbase; const float* sa; const float* sb;
    __device__ __forceinline__ void operator()(const f32x4 (&acc)[2][2][4][2], const Unit& u, int wr, int wc, int fr, int fq) const {
        const int rowg = u.pm * BM + wr * 64 + fr, row0 = rowg - rowbase, col0 = u.pn * HALF + wc * 32 + 8 * fq;
        const float* sbp = sb + (size_t)u.pnb * BM + wc * 32 + 8 * fq;
        f32x4 sg[2], su[2];
#pragma unroll
        for (int n = 0; n < 2; ++n) { sg[n] = *(const f32x4*)(sbp + 4 * n); su[n] = *(const f32x4*)(sbp + HALF + 4 * n); }
        float ra[2][4];
#pragma unroll
        for (int ai = 0; ai < 2; ++ai)
#pragma unroll
            for (int m = 0; m < 4; ++m) ra[ai][m] = sa[rowg + ai * HALF + m * 16];
#pragma unroll
        for (int ai = 0; ai < 2; ++ai)
#pragma unroll
            for (int m = 0; m < 4; ++m) { bf16_t* rowp = O + (size_t)(row0 + ai * HALF + m * 16) * ldc + col0;
                float r[8];
#pragma unroll
                for (int n = 0; n < 2; ++n)
#pragma unroll
                    for (int j = 0; j < 4; ++j) r[n * 4 + j] = siluf(acc[ai][0][m][n][j] * (ra[ai][m] * sg[n][j])) * (acc[ai][1][m][n][j] * (ra[ai][m] * su[n][j]));
                u32x4 w; w.x = pack2(r[0], r[1]); w.y = pack2(r[2], r[3]); w.z = pack2(r[4], r[5]); w.w = pack2(r[6], r[7]);
                *(u32x4*)rowp = w; }
    }
};
struct EpiSwigluS8 {
    static constexpr bool PERM = true;
    unsigned char* O8; int ldc; int rowbase; const float* sa; const float* sb; const float* so;
    __device__ __forceinline__ void operator()(const f32x4 (&acc)[2][2][4][2], const Unit& u, int wr, int wc, int fr, int fq) const {
        const int rowg = u.pm * BM + wr * 64 + fr, row0 = rowg - rowbase, col0 = u.pn * HALF + wc * 32 + 8 * fq;
        const float* sbp = sb + (size_t)u.pnb * BM + wc * 32 + 8 * fq;
        f32x4 sg[2], su[2];
#pragma unroll
        for (int n = 0; n < 2; ++n) { sg[n] = *(const f32x4*)(sbp + 4 * n); su[n] = *(const f32x4*)(sbp + HALF + 4 * n); }
        float ra[2][4], ro[2][4];
#pragma unroll
        for (int ai = 0; ai < 2; ++ai)
#pragma unroll
            for (int m = 0; m < 4; ++m) { ra[ai][m] = sa[rowg + ai * HALF + m * 16]; const float so_ = so[rowg + ai * HALF + m * 16]; ro[ai][m] = so_ > 0.f ? 1.0f / so_ : 0.f; }
#pragma unroll
        for (int ai = 0; ai < 2; ++ai)
#pragma unroll
            for (int m = 0; m < 4; ++m) { unsigned char* rowp = O8 + (size_t)(row0 + ai * HALF + m * 16) * ldc + col0;
                float r[8];
#pragma unroll
                for (int n = 0; n < 2; ++n)
#pragma unroll
                    for (int j = 0; j < 4; ++j) r[n * 4 + j] = siluf(acc[ai][0][m][n][j] * (ra[ai][m] * sg[n][j])) * (acc[ai][1][m][n][j] * (ra[ai][m] * su[n][j])) * ro[ai][m];
                u32x2 w; w.x = pack4_fp8(r[0], r[1], r[2], r[3]); w.y = pack4_fp8(r[4], r[5], r[6], r[7]);
                *(u32x2*)rowp = w; }
    }
};
struct EpiBf16S {
    static constexpr bool PERM = true;
    bf16_t* O; int ldc; const float* sa; const float* sb;
    __device__ __forceinline__ void operator()(const f32x4 (&acc)[2][2][4][2], const Unit& u, int wr, int wc, int fr, int fq) const {
        const int row0 = u.pm * BM + wr * 64 + fr, col0 = u.pn * BM + wc * 32 + 8 * fq;
        const float* sbp = sb + (size_t)u.pnb * BM + wc * 32 + 8 * fq;
        f32x4 sv[2][2];
#pragma unroll
        for (int bj = 0; bj < 2; ++bj)
#pragma unroll
            for (int n = 0; n < 2; ++n) sv[bj][n] = *(const f32x4*)(sbp + bj * HALF + 4 * n);
#pragma unroll
        for (int ai = 0; ai < 2; ++ai)
#pragma unroll
            for (int m = 0; m < 4; ++m) { bf16_t* rowp = O + (size_t)(row0 + ai * HALF + m * 16) * ldc + col0; const float ra = sa[row0 + ai * HALF + m * 16];
#pragma unroll
                for (int bj = 0; bj < 2; ++bj) { const f32x4 v0 = acc[ai][bj][m][0] * sv[bj][0] * ra, v1 = acc[ai][bj][m][1] * sv[bj][1] * ra;
                    u32x4 w; w.x = pack2(v0[0], v0[1]); w.y = pack2(v0[2], v0[3]); w.z = pack2(v1[0], v1[1]); w.w = pack2(v1[2], v1[3]);
                    *(u32x4*)(rowp + bj * HALF) = w; } }
    }
};
template <bool F32BASE>
struct EpiResBf16 {
    static constexpr bool PERM = true;
    static constexpr bool LSCALE = false;
    const float* basef; const bf16_t* baseb; bf16_t* out;
    __device__ __forceinline__ void operator()(const f32x4 (&acc)[2][2][4][2], const Unit& u, int wr, int wc, int fr, int fq) const {
        const int row0 = u.pm * BM + wr * 64 + fr, col0 = u.pn * BM + wc * 32 + 8 * fq;
#pragma unroll
        for (int ai = 0; ai < 2; ++ai)
#pragma unroll
            for (int m = 0; m < 4; ++m) { const size_t off = (size_t)(row0 + ai * HALF + m * 16) * DM + col0;
#pragma unroll
                for (int bj = 0; bj < 2; ++bj) { f32x4 b0, b1;
                    if (F32BASE) { b0 = *(const f32x4*)(basef + off + bj * HALF); b1 = *(const f32x4*)(basef + off + bj * HALF + 4); }
                    else { const u32x4 w = *(const u32x4*)(baseb + off + bj * HALF);
                        b0[0] = __uint_as_float(w.x << 16); b0[1] = __uint_as_float(w.x & 0xffff0000u); b0[2] = __uint_as_float(w.y << 16); b0[3] = __uint_as_float(w.y & 0xffff0000u);
                        b1[0] = __uint_as_float(w.z << 16); b1[1] = __uint_as_float(w.z & 0xffff0000u); b1[2] = __uint_as_float(w.w << 16); b1[3] = __uint_as_float(w.w & 0xffff0000u); }
                    const f32x4 v0 = acc[ai][bj][m][0] + b0, v1 = acc[ai][bj][m][1] + b1;
                    u32x4 o; o.x = pack2(v0[0], v0[1]); o.y = pack2(v0[2], v0[3]); o.z = pack2(v1[0], v1[1]); o.w = pack2(v1[2], v1[3]);
                    *(u32x4*)(out + off + bj * HALF) = o; } }
    }
};
struct EpiResF32 {
    static constexpr bool PERM = false;
    const float* base; float* out; int ldc;
    __device__ __forceinline__ void operator()(const f32x4 (&acc)[2][2][4][2], const Unit& u, int wr, int wc, int fr, int fq) const {
        const int row0 = u.pm * BM + wr * 64 + fr, col0 = u.pn * BM + wc * 32 + 4 * fq;
#pragma unroll
        for (int ai = 0; ai < 2; ++ai)
#pragma unroll
            for (int m = 0; m < 4; ++m) { const size_t off = (size_t)(row0 + ai * HALF + m * 16) * ldc + col0;
#pragma unroll
                for (int bj = 0; bj < 2; ++bj)
#pragma unroll
                    for (int n = 0; n < 2; ++n) { const f32x4 b = *(const f32x4*)(base + off + bj * HALF + n * 16); *(f32x4*)(out + off + bj * HALF + n * 16) = b + acc[ai][bj][m][n]; } }
    }
};

#ifndef CPU_EMU
typedef int i32x8 __attribute__((ext_vector_type(8)));
__device__ __forceinline__ i32x8 cat8(const bf16x8 lo, const bf16x8 hi) { u32x4 a, b; __builtin_memcpy(&a, &lo, 16); __builtin_memcpy(&b, &hi, 16); i32x8 r; r[0] = (int)a.x; r[1] = (int)a.y; r[2] = (int)a.z; r[3] = (int)a.w; r[4] = (int)b.x; r[5] = (int)b.y; r[6] = (int)b.z; r[7] = (int)b.w; return r; }
template <int K, class Epi, class Sched, bool FP8 = false>
__device__ __forceinline__ void gemm_phase(LAS unsigned char* lds, const Gemm g, const Sched& S, const Epi& E, int wv) {
    const int tid = opaque_tid(wv), wid = __builtin_amdgcn_readfirstlane(tid >> 6), lane = tid & 63, wr = wid >> 2, wc = wid & 3, fr = lane & 15, fq = lane >> 4;
    constexpr int RB = FP8 ? K : 2 * K;
    constexpr int nt = RB / 128;
    static_assert(nt % 2 == 0 && nt >= 4, "k tiles");
    unsigned voffB[2];
#pragma unroll
    for (int i = 0; i < 2; ++i) { int R, C; stage_rc(tid * 16 + i * 8192, R, C); const int Rb = Epi::PERM ? ((R & ~31) + perm32(R & 31)) : R; voffB[i] = (unsigned)(Rb * RB + C * 2); }
    constexpr size_t kstep = (size_t)(BK * 2);
    constexpr size_t hstep = (size_t)HALF * RB;
    constexpr size_t tstep = 2 * hstep;
    const unsigned ldsw = (unsigned)wid * 1024u;
    const int aoffl = lds_byte(wr * 64 + fr, fq * 8), boffl = lds_byte(wc * 32 + fr, fq * 8);
    unsigned aoff[2][2];
#define G_LOADA(u) do { _Pragma("unroll") for (int _h = 0; _h < 2; ++_h) _Pragma("unroll") for (int _i = 0; _i < 2; ++_i) { int _R, _C; stage_rc(tid * 16 + _i * 8192, _R, _C); const int _r = (u).pm * BM + _h * HALF + _R; \
        const int _s = g.arow ? g.arow[_r] : _r; aoff[_h][_i] = (unsigned)(_s * RB + _C * 2); } } while (0)
#define G_SA(b, h) (((b) * 2 + (h)) * HTB)
#define G_SB(b, h) ((4 + (b) * 2 + (h)) * HTB)
#define G_STAGEB(bufoff, gbase) do { _Pragma("unroll") for (int _i = 0; _i < 2; ++_i) \
        __builtin_amdgcn_global_load_lds((const unsigned*)((const char*)(gbase) + voffB[_i]), (LAS unsigned*)(lds + (bufoff) + ldsw + _i * 8192), 16, 0, 0); } while (0)
#define G_STAGEA(bufoff, kt, h) do { _Pragma("unroll") for (int _i = 0; _i < 2; ++_i) \
        __builtin_amdgcn_global_load_lds((const unsigned*)((const char*)g.A + (size_t)(kt) * kstep + aoff[h][_i]), (LAS unsigned*)(lds + (bufoff) + ldsw + _i * 8192), 16, 0, 0); } while (0)
#define G_LDA(dst, b, h) do { _Pragma("unroll") for (int m = 0; m < 4; ++m) _Pragma("unroll") for (int k = 0; k < 2; ++k) dst[m][k] = *(const LAS bf16x8*)(lds + G_SA(b, h) + aoffl + m * 2048 + k * 1024); } while (0)
#define G_LDB(dst, b, h) do { _Pragma("unroll") for (int n = 0; n < 2; ++n) _Pragma("unroll") for (int k = 0; k < 2; ++k) dst[n][k] = *(const LAS bf16x8*)(lds + G_SB(b, h) + boffl + n * 2048 + k * 1024); } while (0)
#define G_MMA(ai, bj, At, Bt) do { if constexpr (FP8) __builtin_amdgcn_sched_barrier(0); __builtin_amdgcn_s_setprio(1); _Pragma("unroll") for (int m = 0; m < 4; ++m) _Pragma("unroll") for (int n = 0; n < 2; ++n) { \
        if constexpr (FP8) acc[ai][bj][m][n] = __builtin_amdgcn_mfma_scale_f32_16x16x128_f8f6f4(cat8(Bt[n][0], Bt[n][1]), cat8(At[m][0], At[m][1]), acc[ai][bj][m][n], 0, 0, 0, 0x7F7F7F7F, 0, 0x7F7F7F7F); \
        else { _Pragma("unroll") for (int k = 0; k < 2; ++k) acc[ai][bj][m][n] = __builtin_amdgcn_mfma_f32_16x16x32_bf16(Bt[n][k], At[m][k], acc[ai][bj][m][n], 0, 0, 0); } } \
        __builtin_amdgcn_s_setprio(0); if constexpr (FP8) __builtin_amdgcn_sched_barrier(0); } while (0)
#define G_WAIT_V(n) asm volatile("s_waitcnt vmcnt(" #n ")" ::: "memory")
#define G_WAIT_L(n) asm volatile("s_waitcnt lgkmcnt(" #n ")" ::: "memory")
#define G_BAR __builtin_amdgcn_s_barrier()
#define G_SCHED __builtin_amdgcn_sched_barrier(0)
    Unit cur, nxt; int ui = 0;
    if (!S.next(0, cur)) return;
    f32x4 acc[2][2][4][2];
#pragma unroll
    for (int a = 0; a < 2; ++a)
#pragma unroll
        for (int b = 0; b < 2; ++b)
#pragma unroll
            for (int m = 0; m < 4; ++m)
#pragma unroll
                for (int n = 0; n < 2; ++n) acc[a][b][m][n] = (f32x4){0.f, 0.f, 0.f, 0.f};
    bf16x8 At[4][2], B0[2][2], B1[2][2];
    const char* cB = (const char*)g.Bt + (size_t)cur.pnb * tstep;
    G_LOADA(cur);
    G_STAGEB(G_SB(0, 0), cB); G_STAGEA(G_SA(0, 0), 0, 0); G_STAGEB(G_SB(0, 1), cB + hstep); G_STAGEA(G_SA(0, 1), 0, 1);
    if (wr == 1) G_BAR;
    G_WAIT_V(4); G_BAR;
    G_STAGEB(G_SB(1, 0), cB + kstep); G_STAGEA(G_SA(1, 0), 1, 0); G_STAGEB(G_SB(1, 1), cB + hstep + kstep);
    G_WAIT_V(6); G_BAR;
    for (;;) {
        const bool has_next = S.next(ui + 1, nxt);
        const char* nB = has_next ? (const char*)g.Bt + (size_t)nxt.pnb * tstep : cB;
        for (int t = 0; t < nt; t += 2) {
            const bool last = (t == nt - 2);
            const int k2 = last ? 0 : t + 2, k3 = k2 + 1;
            const char* b2 = last ? nB : cB + (size_t)(t + 2) * kstep; const char* b3 = b2 + kstep;
            G_LDB(B0, 0, 0); G_SCHED; G_LDA(At, 0, 0); G_STAGEA(G_SA(1, 1), t + 1, 1);
            if (g.arow && has_next && t == nt - 4 && tid < BM)
                __builtin_amdgcn_global_load_lds((const unsigned*)(g.arow + nxt.pm * BM + tid), (LAS unsigned*)(lds + STAGE_BYTES + wid * 256), 4, 0, 0);
            G_WAIT_L(8); G_BAR; G_WAIT_L(0); G_MMA(0, 0, At, B0); G_BAR; G_SCHED;
            if (last && has_next) {
                if (g.arow) {
#pragma unroll
                    for (int _h = 0; _h < 2; ++_h)
#pragma unroll
                        for (int _i = 0; _i < 2; ++_i) { int _R, _C; stage_rc(tid * 16 + _i * 8192, _R, _C); const int _s = *(LAS const int*)(lds + STAGE_BYTES + (_h * HALF + _R) * 4); aoff[_h][_i] = (unsigned)(_s * RB + _C * 2); }
                } else G_LOADA(nxt);
            }
            G_LDB(B1, 0, 1); G_STAGEB(G_SB(0, 0), b2);
            G_BAR; G_WAIT_L(0); G_MMA(0, 1, At, B1); G_BAR;
            G_LDA(At, 0, 1); G_STAGEA(G_SA(0, 0), k2, 0);
            G_BAR; G_WAIT_L(0); G_MMA(1, 0, At, B0); G_BAR; G_SCHED;
            G_STAGEB(G_SB(0, 1), b2 + hstep);
            G_WAIT_V(6); G_BAR; G_MMA(1, 1, At, B1); G_BAR;
            G_LDB(B0, 1, 0); G_SCHED; G_LDA(At, 1, 0); G_STAGEA(G_SA(0, 1), k2, 1);
            G_WAIT_L(8); G_BAR; G_WAIT_L(0); G_MMA(0, 0, At, B0); G_BAR; G_SCHED;
            G_LDB(B1, 1, 1); G_STAGEB(G_SB(1, 0), b3);
            G_BAR; G_WAIT_L(0); G_MMA(0, 1, At, B1); G_BAR;
            G_LDA(At, 1, 1); G_STAGEA(G_SA(1, 0), k3, 0);
            G_BAR; G_WAIT_L(0); G_MMA(1, 0, At, B0); G_BAR; G_SCHED;
            G_STAGEB(G_SB(1, 1), b3 + hstep);
            G_WAIT_V(6); G_BAR; G_MMA(1, 1, At, B1); G_BAR;
        }
        E(acc, cur, wr, wc, fr, fq);
        if (!has_next) break;
#pragma unroll
        for (int a = 0; a < 2; ++a)
#pragma unroll
            for (int b = 0; b < 2; ++b)
#pragma unroll
                for (int m = 0; m < 4; ++m)
#pragma unroll
                    for (int n = 0; n < 2; ++n) acc[a][b][m][n] = (f32x4){0.f, 0.f, 0.f, 0.f};
        cur = nxt; cB = nB; ++ui;
    }
    G_WAIT_V(0);
    if (wr == 0) G_BAR;
    G_BAR;
}
#else
template <int K, class Epi, class Sched, bool FP8 = false>
__device__ __forceinline__ void gemm_phase(unsigned char* lds, const Gemm g, const Sched& S, const Epi& E, int wv) {
    const int tid = opaque_tid(wv), wid = tid >> 6, lane = tid & 63, wr = wid >> 2, wc = wid & 3, fr = lane & 15, fq = lane >> 4;
    Unit u;
    for (int ui = 0; S.next(ui, u); ++ui) {
        f32x4 acc[2][2][4][2];
        for (int ai = 0; ai < 2; ++ai) for (int bj = 0; bj < 2; ++bj) for (int m = 0; m < 4; ++m) for (int n = 0; n < 2; ++n) for (int j = 0; j < 4; ++j) {
            const int r = u.pm * 256 + 128 * ai + 64 * wr + 16 * m + fr;
            const int cl = Epi::PERM ? (128 * bj + 32 * wc + 8 * fq + 4 * n + j) : (128 * bj + 32 * wc + 16 * n + 4 * fq + j);
            const int ar = g.arow ? g.arow[r] : r;
            float s = 0.f;
            if (FP8) { const unsigned char* a = (const unsigned char*)g.A + (size_t)ar * K; const unsigned char* b = (const unsigned char*)g.Bt + ((size_t)u.pnb * 256 + cl) * K; for (int k = 0; k < K; ++k) s += fp8_to_f(a[k]) * fp8_to_f(b[k]); }
            else { const bf16_t* a = g.A + (size_t)ar * K; const bf16_t* b = g.Bt + ((size_t)u.pnb * 256 + cl) * K; for (int k = 0; k < K; ++k) s += bf2f(a[k]) * bf2f(b[k]); }
            acc[ai][bj][m][n][j] = s;
        }
        E(acc, u, wr, wc, fr, fq);
    }
}
#endif

__device__ __forceinline__ void convert_wt(LAS unsigned char* lds, const float* W, int K, int ldw, int col0, int ncols, bf16_t* Wt, int rowmul, int rowadd, int bid, int nb, int wv) {
    LAS float* t = (LAS float*)lds;
    const int tid = opaque_tid(wv);
    const int tk = K / 64, tn = ncols / 64, ntile = tk * tn;
    const int lr = tid >> 4, c4 = (tid & 15) * 4;
    if (bid >= ntile) return;
    const int nmine = (ntile - bid + nb - 1) / nb;
    constexpr int RD = 4;
    f32x4 v[RD][2];
#define CW_LOAD(slot, idx) do { int _j = (idx) < nmine ? (idx) : nmine - 1; const int _tile = bid + _j * nb; const int _k0 = (_tile % tk) * 64, _n0 = (_tile / tk) * 64; int _lr = lr; OPAQUE_V(_lr); \
        _Pragma("unroll") for (int _i = 0; _i < 2; ++_i) v[slot][_i] = *(const f32x4*)(W + (size_t)(_k0 + _lr + 32 * _i) * ldw + col0 + _n0 + c4); } while (0)
#pragma unroll
    for (int r = 0; r < RD; ++r) CW_LOAD(r, r);
    for (int j0 = 0; j0 < nmine; j0 += RD) {
#pragma unroll
        for (int r = 0; r < RD; ++r) { const int j = j0 + r;
            if (j < nmine) {
                const int tile = bid + j * nb, k0 = (tile % tk) * 64, n0 = (tile / tk) * 64;
                __syncthreads();
#pragma unroll
                for (int i = 0; i < 2; ++i) { const int rr = lr + 32 * i; t[rr * 65 + c4] = v[r][i][0]; t[rr * 65 + c4 + 1] = v[r][i][1]; t[rr * 65 + c4 + 2] = v[r][i][2]; t[rr * 65 + c4 + 3] = v[r][i][3]; }
                CW_LOAD(r, j + RD);
                __syncthreads();
                { const int c = tid >> 3, k8 = (tid & 7) * 8; const int cc = n0 + c; const int dr = (cc >> 7) * rowmul + (cc & 127) + rowadd;
                  u32x4 w; w.x = pack2(t[(k8 + 0) * 65 + c], t[(k8 + 1) * 65 + c]); w.y = pack2(t[(k8 + 2) * 65 + c], t[(k8 + 3) * 65 + c]);
                  w.z = pack2(t[(k8 + 4) * 65 + c], t[(k8 + 5) * 65 + c]); w.w = pack2(t[(k8 + 6) * 65 + c], t[(k8 + 7) * 65 + c]);
                  *(u32x4*)(Wt + (size_t)dr * K + k0 + k8) = w; }
            }
        }
    }
#undef CW_LOAD
    __syncthreads();
}

__device__ __forceinline__ void load_row(const float* src, int row, int lane, f32x4 (&v)[4]) {
#pragma unroll
    for (int i = 0; i < 4; ++i) v[i] = *(const f32x4*)(src + (size_t)row * DM + i * 256 + lane * 4);
}
__device__ __forceinline__ void load_row_b(const bf16_t* src, int row, int lane, f32x4 (&v)[4]) {
#pragma unroll
    for (int i = 0; i < 4; ++i) { const u32x2 w = *(const u32x2*)(src + (size_t)row * DM + i * 256 + lane * 4);
        v[i][0] = __uint_as_float(w.x << 16); v[i][1] = __uint_as_float(w.x & 0xffff0000u); v[i][2] = __uint_as_float(w.y << 16); v[i][3] = __uint_as_float(w.y & 0xffff0000u); }
}
__device__ __forceinline__ float row_rstd(const f32x4 (&v)[4]) {
    float s = 0.f;
#pragma unroll
    for (int i = 0; i < 4; ++i) s += v[i][0] * v[i][0] + v[i][1] * v[i][1] + v[i][2] * v[i][2] + v[i][3] * v[i][3];
    s = wave_sum(s);
    return rsqrtf(s * (1.0f / DM) + NORM_EPS);
}
__device__ __forceinline__ void store_row_bf16(bf16_t* dst, int row, int lane, const f32x4 (&v)[4]) {
#pragma unroll
    for (int i = 0; i < 4; ++i) { u32x2 w; w.x = pack2(v[i][0], v[i][1]); w.y = pack2(v[i][2], v[i][3]); *(u32x2*)(dst + (size_t)row * DM + i * 256 + lane * 4) = w; }
}

__device__ __forceinline__ void store_row_fp8(unsigned char* dst, float* scale, int row, int lane, const f32x4 (&v)[4]) {
    float am = 0.f;
#pragma unroll
    for (int i = 0; i < 4; ++i) am = fmaxf(fmaxf(am, fmaxf(fabsf(v[i][0]), fabsf(v[i][1]))), fmaxf(fabsf(v[i][2]), fabsf(v[i][3])));
    am = wave_max(am);
    const float sc = am > 0.f ? am * (1.0f / FP8_TOP) : 1.0f, inv = 1.0f / sc;
#pragma unroll
    for (int i = 0; i < 4; ++i) *(unsigned*)(dst + (size_t)row * DM + i * 256 + lane * 4) = pack4_fp8(v[i][0] * inv, v[i][1] * inv, v[i][2] * inv, v[i][3] * inv);
    if (lane == 0) scale[row] = sc;
}
template <int K, bool NORMS>
__device__ __forceinline__ void quant_rows(KPTR p, LAS unsigned char* lds, const bf16_t* src, unsigned char* dst, float* scl, int nrows, int bid, int nb, int wv) {
    constexpr int NC = K / 512;
    const int tid = opaque_tid(wv), wid = tid >> 6, lane = tid & 63;
    LAS unsigned* nmx = (LAS unsigned*)lds;
    if (NORMS) { if (tid < 2 * NE) nmx[tid] = 0u; __syncthreads(); }
    int row = bid * 8 + wid;
    u32x4 nx[NC];
#pragma unroll
    for (int c = 0; c < NC; ++c) nx[c] = (u32x4){0u, 0u, 0u, 0u};
    if (row < nrows) {
#pragma unroll
        for (int c = 0; c < NC; ++c) nx[c] = *(const u32x4*)(src + (size_t)row * K + (c * 64 + lane) * 8); }
    for (; row < nrows; row += nb * 8) {
        u32x4 cu[NC];
#pragma unroll
        for (int c = 0; c < NC; ++c) cu[c] = nx[c];
        const int rn = row + nb * 8;
        if (rn < nrows) {
#pragma unroll
            for (int c = 0; c < NC; ++c) nx[c] = *(const u32x4*)(src + (size_t)rn * K + (c * 64 + lane) * 8); }
        float am = 0.f, ss = 0.f;
#pragma unroll
        for (int c = 0; c < NC; ++c)
#pragma unroll
            for (int q = 0; q < 4; ++q) { const float lo = __uint_as_float(cu[c][q] << 16), hi = __uint_as_float(cu[c][q] & 0xffff0000u); am = fmaxf(am, fmaxf(fabsf(lo), fabsf(hi))); if (NORMS) ss += lo * lo + hi * hi; }
        am = wave_max(am);
        const float sc = am > 0.f ? am * (1.0f / FP8_TOP) : 1.0f, inv = 1.0f / sc;
#pragma unroll
        for (int c = 0; c < NC; ++c) { u32x2 w;
            w.x = pack4_fp8(__uint_as_float(cu[c][0] << 16) * inv, __uint_as_float(cu[c][0] & 0xffff0000u) * inv, __uint_as_float(cu[c][1] << 16) * inv, __uint_as_float(cu[c][1] & 0xffff0000u) * inv);
            w.y = pack4_fp8(__uint_as_float(cu[c][2] << 16) * inv, __uint_as_float(cu[c][2] & 0xffff0000u) * inv, __uint_as_float(cu[c][3] << 16) * inv, __uint_as_float(cu[c][3] & 0xffff0000u) * inv);
            *(u32x2*)(dst + (size_t)row * K + (c * 64 + lane) * 8) = w; }
        if (lane == 0) scl[row] = sc;
        if (NORMS) { ss = wave_sum(ss); if (lane == 0) LDS_ATOMIC_MAX(nmx + ((row >> 7) & 1) * NE + row / (2 * FFE), __float_as_uint(sqrtf(ss))); }
    }
    if (NORMS) { __syncthreads(); if (tid < 2 * NE) (void)GLOBAL_ATOMIC_MAX(p->ctrl + (tid < NE ? C_GMAX + tid : C_UMAX + tid - NE), nmx[tid]); __syncthreads(); }
}
__device__ __forceinline__ const float* gu_src(KPTR p, int item, int t, int kr, int c4) {
    constexpr int NPAN = FFE / 32;
    const int e = item / (2 * NPAN), r = item % (2 * NPAN), up = r / NPAN, pn = r % NPAN;
    return (up ? p->w_mup : p->w_mgate) + (size_t)e * DM * FFE + (size_t)(t * 64 + kr) * FFE + pn * 32 + c4;
}
__device__ __forceinline__ void convert_gu_fp8(KPTR p, LAS unsigned char* lds, int bid, int nb, int wv) {
    constexpr int PSF = 1028, NPAN = FFE / 32, NITEM = NE * 2 * NPAN, TPI = DM / 64;
    const int tid = opaque_tid(wv), wid = tid >> 6, lane = tid & 63;
    LAS float* pan = (LAS float*)lds;
    LAS float* red = pan + 32 * PSF;
    LAS float* scl = red + 8 * 32 * 2;
    const int c4 = (tid & 7) * 4, kr = tid >> 3;
    const int nmine = bid < NITEM ? (NITEM - bid + nb - 1) / nb : 0, total = nmine * TPI;
    if (nmine == 0) return;
    constexpr int PD = 8;
    static_assert(TPI % PD == 0, "ring");
    f32x4 pf[PD];
#pragma unroll
    for (int i = 0; i < PD; ++i) { const int gi = i < total ? i : total - 1; pf[i] = *(const f32x4*)gu_src(p, bid + (gi / TPI) * nb, gi % TPI, kr, c4); }
    int g = 0;
    for (int it = 0; it < nmine; ++it) {
        const int item = bid + it * nb, e = item / (2 * NPAN), r = item % (2 * NPAN), up = r / NPAN, pn = r % NPAN;
        float am[4] = {0.f, 0.f, 0.f, 0.f}, ss[4] = {0.f, 0.f, 0.f, 0.f};
        for (int t0 = 0; t0 < TPI; t0 += PD) {
#pragma unroll
            for (int u = 0; u < PD; ++u, ++g) { const int t = t0 + u;
                const f32x4 v = pf[u];
                { int gn = g + PD; gn = gn < total ? gn : total - 1; int kr2 = kr; OPAQUE_V(kr2); pf[u] = *(const f32x4*)gu_src(p, bid + (gn / TPI) * nb, gn % TPI, kr2, c4); }
#pragma unroll
                for (int j = 0; j < 4; ++j) { am[j] = fmaxf(am[j], fabsf(v[j])); ss[j] += v[j] * v[j]; pan[(c4 + j) * PSF + t * 64 + kr] = v[j]; }
            }
        }
#pragma unroll
        for (int j = 0; j < 4; ++j) {
#pragma unroll
            for (int o = 8; o <= 32; o <<= 1) { am[j] = fmaxf(am[j], __shfl_xor(am[j], o)); ss[j] += __shfl_xor(ss[j], o); }
        }
        if ((lane >> 3) == 0) {
#pragma unroll
            for (int j = 0; j < 4; ++j) { red[(wid * 32 + c4 + j) * 2] = am[j]; red[(wid * 32 + c4 + j) * 2 + 1] = ss[j]; } }
        __syncthreads();
        if (tid < 64) { float a = 0.f, q = 0.f;
            if (tid < 32) {
#pragma unroll
                for (int w = 0; w < 8; ++w) { a = fmaxf(a, red[(w * 32 + tid) * 2]); q += red[(w * 32 + tid) * 2 + 1]; }
                const float sc = a > 0.f ? a * (1.0f / FP8_TOP) : 1.0f; scl[tid] = sc; scl[32 + tid] = 1.0f / sc;
                const int cc = pn * 32 + tid; p->ws_mgu[(size_t)e * 2 * FFE + (cc >> 7) * 256 + (cc & 127) + up * 128] = sc; }
            const float nm = wave_max(tid < 32 ? sqrtf(q) : 0.f);
            if (tid == 0) (void)GLOBAL_ATOMIC_MAX(p->ctrl + (up ? C_UMAX : C_GMAX) + e, __float_as_uint(nm)); }
        __syncthreads();
#pragma unroll
        for (int i2 = 0; i2 < 8; ++i2) { const int n = i2 * 4 + (tid >> 7), k8 = (tid & 127) * 8, cc = pn * 32 + n;
            const f32x4 a = *(LAS const f32x4*)(pan + n * PSF + k8), b = *(LAS const f32x4*)(pan + n * PSF + k8 + 4); const float inv = scl[32 + n];
            u32x2 w; w.x = pack4_fp8(a[0] * inv, a[1] * inv, a[2] * inv, a[3] * inv); w.y = pack4_fp8(b[0] * inv, b[1] * inv, b[2] * inv, b[3] * inv);
            *(u32x2*)(p->w8_mgu + ((size_t)e * 2 * FFE + (cc >> 7) * 256 + (cc & 127) + up * 128) * DM + k8) = w; }
        __syncthreads();
    }
}
template <bool WITH_GDN, bool OUT8 = false, bool SRCB = false>
__device__ __forceinline__ void phase_norm(KPTR p, const void* src, const float* gain, int bid, int nb, int wv) {
    const int tid = opaque_tid(wv), wid = tid >> 6, lane = tid & 63;
    f32x4 gv[4];
#pragma unroll
    for (int i = 0; i < 4; ++i) gv[i] = *(const f32x4*)(gain + i * 256 + lane * 4);
    f32x4 w8[WITH_GDN ? 16 : 1][2];
    if (WITH_GDN) {
#pragma unroll
        for (int i = 0; i < 4; ++i)
#pragma unroll
            for (int e = 0; e < 4; ++e) { const float* wr_ = p->w_in + (size_t)(i * 256 + lane * 4 + e) * DIN + DINP; w8[i * 4 + e][0] = *(const f32x4*)wr_; w8[i * 4 + e][1] = *(const f32x4*)(wr_ + 4); }
    }
    for (int row = bid * 8 + wid; row < NTOK; row += nb * 8) {
        f32x4 v[4]; if (SRCB) load_row_b((const bf16_t*)src, row, lane, v); else load_row((const float*)src, row, lane, v);
        const float rs = row_rstd(v);
#pragma unroll
        for (int i = 0; i < 4; ++i) v[i] = v[i] * rs * gv[i];
        if (OUT8) store_row_fp8((unsigned char*)p->hn, p->hns, row, lane, v); else store_row_bf16(p->hn, row, lane, v);
        if (WITH_GDN) {
            f32x4 d0 = (f32x4){0.f, 0.f, 0.f, 0.f}, d1 = (f32x4){0.f, 0.f, 0.f, 0.f};
#pragma unroll
            for (int i = 0; i < 4; ++i)
#pragma unroll
                for (int e = 0; e < 4; ++e) { const float xv = v[i][e]; d0 = d0 + w8[i * 4 + e][0] * xv; d1 = d1 + w8[i * 4 + e][1] * xv; }
            float d[8] = {d0[0], d0[1], d0[2], d0[3], d1[0], d1[1], d1[2], d1[3]};
#pragma unroll
            for (int j = 0; j < 8; ++j) d[j] = wave_sum(d[j]);
            if (lane < 4) {
                const float braw = lane == 0 ? d[0] : lane == 1 ? d[1] : lane == 2 ? d[2] : d[3];
                const float araw = lane == 0 ? d[4] : lane == 1 ? d[5] : lane == 2 ? d[6] : d[7];
                p->gbeta[(size_t)row * 4 + lane] = 1.0f / (1.0f + __expf(-braw));
                const float z = araw + p->dt_bias[lane];
                const float sp = z > 20.f ? z : log1pf(__expf(z));
                p->gg[(size_t)row * 4 + lane] = -__expf(p->a_log[lane]) * sp;
            }
        }
    }
}

constexpr int IMG_W = 0, IMG_QD = 17408, IMG_KDT = 34816, IMG_AT = 53248, IMG_U = 62464, IMG_CH = 78848;
__host__ __device__ constexpr int permb(int k) { return (k >> 5) * 64 + ((((k & 15) >> 2) * 8) + (((k >> 4) & 1) * 4) + (k & 3)) * 2; }
__device__ __forceinline__ bf16x8 frag2(LAS const unsigned char* ptr) {
    const u32x2 lo = *(LAS const u32x2*)ptr, hi = *(LAS const u32x2*)(ptr + 32);
    u32x4 w; w.x = lo.x; w.y = lo.y; w.z = hi.x; w.w = hi.y; bf16x8 r; __builtin_memcpy(&r, &w, 16); return r;
}
__device__ __forceinline__ bf16x8 pack8(const f32x4 a, const f32x4 b) {
    u32x4 w; w.x = pack2(a[0], a[1]); w.y = pack2(a[2], a[3]); w.z = pack2(b[0], b[1]); w.w = pack2(b[2], b[3]); bf16x8 r; __builtin_memcpy(&r, &w, 16); return r;
}


#ifndef CPU_EMU
__device__ __forceinline__ void st_wt32(void* p, unsigned v) { __hip_atomic_store((unsigned*)p, v, __ATOMIC_RELAXED, __HIP_MEMORY_SCOPE_AGENT); }
__device__ __forceinline__ void st_wt64(void* p, u32x2 v) { unsigned long long x = ((unsigned long long)v.y << 32) | v.x; __hip_atomic_store((unsigned long long*)p, x, __ATOMIC_RELAXED, __HIP_MEMORY_SCOPE_AGENT); }
#else
static inline void st_wt32(void* p, unsigned v) { *(unsigned*)p = v; }
static inline void st_wt64(void* p, u32x2 v) { *(u32x2*)p = v; }
#endif

#ifndef CPU_EMU
__device__ __forceinline__ void gdn_publish(unsigned* flag, int tid) {
    asm volatile("s_waitcnt vmcnt(0)" ::: "memory");
    __syncthreads();
    if (tid == 0) __hip_atomic_store(flag, 1u, __ATOMIC_RELAXED, __HIP_MEMORY_SCOPE_AGENT);
}
__device__ __forceinline__ void gdn_wait8(const unsigned* flags, int c, int nmax, int lane) {
    const int k = c + (lane & 7); const bool need = k < nmax;
    unsigned spins = 0;
    for (;;) {
        const unsigned v = need ? __hip_atomic_load(flags + k, __ATOMIC_RELAXED, __HIP_MEMORY_SCOPE_AGENT) : 1u;
        if (__all(v != 0u)) break;
        __builtin_amdgcn_s_sleep(4); if (++spins > (1u << 22)) break;
    }
    __builtin_amdgcn_fence(__ATOMIC_ACQUIRE, "agent");
}
__device__ __forceinline__ float ld_coherent(const float* p) { return __uint_as_float(__hip_atomic_load((const unsigned*)p, __ATOMIC_RELAXED, __HIP_MEMORY_SCOPE_AGENT)); }
#else
static inline void gdn_publish(unsigned* flag, int tid) { __syncthreads(); if (tid == 0) __atomic_store_n(flag, 1u, __ATOMIC_SEQ_CST); }
static inline void gdn_wait8(const unsigned* flags, int c, int nmax, int lane) { for (int k = c; k < c + 8 && k < nmax; ++k) while (__atomic_load_n(flags + k, __ATOMIC_SEQ_CST) == 0) emu::yield(); }
static inline float ld_coherent(const float* p) { return *p; }
#endif

template <int I> struct TSolve {
    static __device__ __forceinline__ void run(float (&tc)[64], LAS const float* sL, LAS unsigned char* tb, int lane) {
        TSolve<I - 1>::run(tc, sL, tb, lane);
        float p0 = 0.f, p1 = 0.f, p2 = 0.f, p3 = 0.f;
#pragma unroll
        for (int j = 0; j < I; ++j) { const float pr = sL[I * 68 + j] * tc[j]; if ((j & 3) == 0) p0 += pr; else if ((j & 3) == 1) p1 += pr; else if ((j & 3) == 2) p2 += pr; else p3 += pr; }
        const float t2 = ((I == lane) ? 1.f : 0.f) - ((p0 + p1) + (p2 + p3));
        tc[I] = t2; *(LAS bf16_t*)(tb + I * 144 + 2 * lane) = f2bf(t2);
    }
};
template <> struct TSolve<-1> { static __device__ __forceinline__ void run(float (&)[64], LAS const float*, LAS unsigned char*, int) {} };

template <bool PUBLISH>
__device__ __forceinline__ void phase_gdn_pre(KPTR p, LAS unsigned char* lds, int first, int stride, int wv) {
    constexpr int QB = 0, KB = 17408, VBT = 34816, KBT = 53248, KDT = 71680, LF = 90112, TB = 107520, ATB = 116736, SG = 125952, SBE = 126208;
    const int tid0 = opaque_tid(wv);
    LAS float* sL = (LAS float*)(lds + LF); LAS float* sg = (LAS float*)(lds + SG); LAS float* sb = (LAS float*)(lds + SBE);
    const bf16_t* proj = p->proj; const float* conv_w = p->conv_w; const float* gg = p->gg; const float* gbeta = p->gbeta; unsigned char* gimg = p->gimg; float* gcdec = p->gcdec;
    for (int uu = first; uu < NCHH; uu += stride) {
        int tid = tid0; OPAQUE_V(tid);
        const int wid = tid >> 6, lane = tid & 63, fr = lane & 15, q4 = lane >> 4;
        const int n = uu / (BATCH * 4), bh_ = uu % (BATCH * 4), h = bh_ & 3, b = bh_ >> 2;
        const int unit = bh_ * NCH + n;
        const size_t tok0 = (size_t)b * SEQ + (size_t)n * 64;
        unsigned char* img = gimg + (size_t)unit * IMG_CH;
        __syncthreads();
        if (wid == 0) { float gsum = gg[(tok0 + lane) * 4 + h]; for (int o = 1; o < 64; o <<= 1) { const float t2 = __shfl_up(gsum, o); if (lane >= o) gsum += t2; } sg[lane] = gsum; sb[lane] = gbeta[(tok0 + lane) * 4 + h]; }
        __syncthreads();
        const float glast = sg[63];
        unsigned xall[3][11];
#pragma unroll
        for (int w3 = 0; w3 < 3; ++w3) { const int cc = w3 * 512 + h * 128 + 2 * lane;
#pragma unroll
            for (int r = 0; r < 11; ++r) { const int tt = n * 64 + wid * 8 - 3 + r; xall[w3][r] = tt >= 0 ? *(const unsigned*)(proj + ((size_t)b * SEQ + tt) * DINP + 2048 + cc) : 0u; } }
#pragma unroll
        for (int which = 0; which < 3; ++which) {
            const int rb = wid, c0 = which * 512 + h * 128 + 2 * lane;
            float cw0[4], cw1[4];
#pragma unroll
            for (int kk = 0; kk < 4; ++kk) { cw0[kk] = conv_w[kk * 1536 + c0]; cw1[kk] = conv_w[kk * 1536 + c0 + 1]; }
            unsigned xv[11];
#pragma unroll
            for (int r = 0; r < 11; ++r) xv[r] = xall[which][r];
            float a0[8], a1[8], ss[8];
#pragma unroll
            for (int i8 = 0; i8 < 8; ++i8) { float y0 = 0.f, y1 = 0.f;
#pragma unroll
                for (int kk = 0; kk < 4; ++kk) { y0 += cw0[kk] * __uint_as_float(xv[i8 + kk] << 16); y1 += cw1[kk] * __uint_as_float(xv[i8 + kk] & 0xffff0000u); }
                a0[i8] = siluf(y0); a1[i8] = siluf(y1); ss[i8] = a0[i8] * a0[i8] + a1[i8] * a1[i8]; }
            if (which != 2) {
#pragma unroll
                for (int i8 = 0; i8 < 8; ++i8) ss[i8] = wave_sum(ss[i8]);
            }
#pragma unroll
            for (int i8 = 0; i8 < 8; ++i8) {
                const int i = rb * 8 + i8;
                const float gi = sg[i], bi = sb[i], eg = __expf(gi);
                if (which == 2) {
                    *(LAS bf16_t*)(lds + VBT + (2 * lane) * 144 + 2 * i) = f2bf(a0[i8] * bi); *(LAS bf16_t*)(lds + VBT + (2 * lane + 1) * 144 + 2 * i) = f2bf(a1[i8] * bi);
                } else {
                    const float sc = rsqrtf(ss[i8] + NORM_EPS) * (which == 0 ? 0.08838834764831845f : 1.0f);
                    const float n0 = a0[i8] * sc, n1 = a1[i8] * sc;
                    if (which == 0) { *(LAS unsigned*)(lds + QB + i * 272 + 4 * lane) = pack2(n0, n1); st_wt32(img + IMG_QD + i * 272 + permb(2 * lane), pack2(n0 * eg, n1 * eg)); }
                    else { *(LAS unsigned*)(lds + KB + i * 272 + 4 * lane) = pack2(n0, n1);
                        const float f1 = bi * eg, f2 = __expf(glast - gi);
                        *(LAS bf16_t*)(lds + KBT + (2 * lane) * 144 + 2 * i) = f2bf(n0 * f1); *(LAS bf16_t*)(lds + KBT + (2 * lane + 1) * 144 + 2 * i) = f2bf(n1 * f1);
                        *(LAS bf16_t*)(lds + KDT + (2 * lane) * 144 + permb(i)) = f2bf(n0 * f2); *(LAS bf16_t*)(lds + KDT + (2 * lane + 1) * 144 + permb(i)) = f2bf(n1 * f2); }
                }
            }
        }
        __syncthreads();
        {
            const int mat = wid >> 2, itile = wid & 3;
            LAS const unsigned char* abase = lds + (mat == 0 ? KB : QB) + (16 * itile + fr) * 272 + 16 * q4;
            bf16x8 af[4];
#pragma unroll
            for (int s4 = 0; s4 < 4; ++s4) af[s4] = *(LAS const bf16x8*)(abase + 64 * s4);
#pragma unroll
            for (int nt = 0; nt < 4; ++nt) {
                f32x4 acc = (f32x4){0.f, 0.f, 0.f, 0.f};
                if (nt <= itile) {
#pragma unroll
                    for (int s4 = 0; s4 < 4; ++s4) { const bf16x8 bfr = *(LAS const bf16x8*)(lds + KB + (16 * nt + fr) * 272 + 16 * q4 + 64 * s4);
                        acc = __builtin_amdgcn_mfma_f32_16x16x32_bf16(af[s4], bfr, acc, 0, 0, 0); }
                }
                const int j = 16 * nt + fr; const float gj = sg[j];
#pragma unroll
                for (int r = 0; r < 4; ++r) { const int i = 16 * itile + 4 * q4 + r; const float dec = __expf(sg[i] - gj);
                    if (mat == 0) sL[i * 68 + j] = i > j ? sb[i] * acc[r] * dec : 0.f;
                    else *(LAS bf16_t*)(lds + ATB + i * 144 + permb(j)) = f2bf(i >= j ? acc[r] * dec : 0.f); }
            }
        }
        __syncthreads();
        if (wid == 0) {
            float tc[64];
            TSolve<63>::run(tc, sL, lds + TB, lane);
        } else {
            for (int pc = tid - 64; pc < 1152 + 576; pc += NTHREADS - 64) {
                if (pc < 1152) { const u32x4 v4 = *(LAS const u32x4*)(lds + KDT + pc * 16); u32x2 a; a.x = v4.x; a.y = v4.y; u32x2 c; c.x = v4.z; c.y = v4.w; st_wt64(img + IMG_KDT + pc * 16, a); st_wt64(img + IMG_KDT + pc * 16 + 8, c); }
                else { const u32x4 v4 = *(LAS const u32x4*)(lds + ATB + (pc - 1152) * 16); u32x2 a; a.x = v4.x; a.y = v4.y; u32x2 c; c.x = v4.z; c.y = v4.w; st_wt64(img + IMG_AT + (pc - 1152) * 16, a); st_wt64(img + IMG_AT + (pc - 1152) * 16 + 8, c); }
            }
        }
        __syncthreads();
        {
            const int itile = wid & 3;
            bf16x8 tf[2];
#pragma unroll
            for (int s2 = 0; s2 < 2; ++s2) tf[s2] = *(LAS const bf16x8*)(lds + TB + (16 * itile + fr) * 144 + 16 * q4 + 64 * s2);
#pragma unroll
            for (int nt = 0; nt < 8; ++nt) {
                f32x4 acc = (f32x4){0.f, 0.f, 0.f, 0.f};
                if (wid < 4) {
#pragma unroll
                    for (int s2 = 0; s2 < 2; ++s2) { const bf16x8 bfr = *(LAS const bf16x8*)(lds + VBT + (16 * nt + fr) * 144 + 16 * q4 + 64 * s2);
                        acc = __builtin_amdgcn_mfma_f32_16x16x32_bf16(tf[s2], bfr, acc, 0, 0, 0); }
                    u32x2 w; w.x = pack2(acc[0], acc[1]); w.y = pack2(acc[2], acc[3]);
                    st_wt64(img + IMG_U + ((nt * 4 + itile) * 64 + lane) * 8, w);
                } else {
#pragma unroll
                    for (int s2 = 0; s2 < 2; ++s2) { const bf16x8 afr = *(LAS const bf16x8*)(lds + KBT + (16 * nt + fr) * 144 + 16 * q4 + 64 * s2);
                        acc = __builtin_amdgcn_mfma_f32_16x16x32_bf16(afr, tf[s2], acc, 0, 0, 0); }
                    u32x2 w; w.x = pack2(acc[0], acc[1]); w.y = pack2(acc[2], acc[3]);
                    st_wt64(img + IMG_W + (16 * itile + fr) * 272 + permb(16 * nt + 4 * q4), w);
                }
            }
        }
        if (tid == 0) st_wt32(gcdec + unit, __float_as_uint(__expf(glast)));
        if (PUBLISH) gdn_publish(p->gflag + unit, tid);
    }
}

constexpr int NCW = 2, NLT = NTHREADS - 64 * NCW;
constexpr int STG = 62464 + NCW * 2048;
#define LDF(ptr) (*(LAS const bf16x8*)(ptr))
#define MF16(a, b, c) __builtin_amdgcn_mfma_f32_16x16x32_bf16((a), (b), (c), 0, 0, 0)
__device__ __forceinline__ void scan_store_ot(bf16_t* op, const f32x4 (&ao)[4]) {
#pragma unroll
    for (int it = 0; it < 4; ++it) { u32x2 w; w.x = pack2(ao[it][0], ao[it][1]); w.y = pack2(ao[it][2], ao[it][3]); *(u32x2*)(op + (size_t)(16 * it) * DM) = w; }
}
__device__ __forceinline__ void scan_store_o(bf16_t* op, const f32x4 (&ao)[4], int q4) {
#pragma unroll
    for (int it = 0; it < 4; ++it)
#pragma unroll
        for (int r = 0; r < 4; ++r) op[(size_t)(16 * it + 4 * q4 + r) * DM] = f2bf(ao[it][r]);
}
__device__ __forceinline__ bf16x8 asfrag(const u32x4 v) { bf16x8 r; __builtin_memcpy(&r, &v, 16); return r; }
#define LDR(ptr) (*(LAS const u32x4*)(ptr))
template <bool WAITF>
__device__ __forceinline__ void scan_gdn(KPTR p, LAS unsigned char* lds, int b, int h, int qt, int wv) {
    const unsigned* gflag = p->gflag + (size_t)(b * 4 + h) * NCH;
    const int tid = opaque_tid(wv), wid = tid >> 6, lane = tid & 63, fr = lane & 15, q4 = lane >> 4;
    const unsigned char* gimg = p->gimg; const float* gcdec = p->gcdec + (size_t)(b * 4 + h) * NCH; bf16_t* out = p->hn;
    const bool loader = wid >= NCW;
    const int cw = wid, lt = tid - 64 * NCW;
    f32x4 S[8];
#pragma unroll
    for (int dt = 0; dt < 8; ++dt) S[dt] = (f32x4){0.f, 0.f, 0.f, 0.f};
    constexpr int NLG = NLT / 2;
    constexpr int NPC = 3904 + NCW * 128, NPR = (NPC + NLG - 1) / NLG;
    static_assert(NPR >= 16, "compute waves use R[0..7] and R[8..15] as their two operand batches");
    u32x4 R[NPR];
    float cdv = 0.f;
    constexpr int OUTB = 2 * STG, CDB = OUTB + 8192;
    const int grp = lt >= NLG ? 1 : 0, lg_ = lt - grp * NLG;
    const unsigned char* base = gimg + (size_t)(b * 4 + h) * NCH * IMG_CH;
#define GDN_PREFETCH(nn) do { int _lg = lg_; OPAQUE_V(_lg); const unsigned char* _src = base + (size_t)(nn) * IMG_CH; _Pragma("unroll") for (int _i = 0; _i < NPR; ++_i) { int _pc = _lg + NLG * _i; _pc = _pc < NPC ? _pc : NPC - 1; \
        const int _so = _pc < 3904 ? _pc * 16 : IMG_U + qt * (NCW * 2048) + (_pc - 3904) * 16; R[_i] = *(const u32x4*)(_src + _so); } cdv = ld_coherent(gcdec + (nn)); } while (0)
    int avail = 0;
    if (loader && grp < NCH) { if (WAITF) { gdn_wait8(gflag, 0, NCH, lane); avail = 8; } GDN_PREFETCH(grp); }
    float cd_next = 0.f;
    __syncthreads();
    auto load_step = [&](int nn) {
        if (nn < NCH && (nn & 1) == grp) {
            LAS unsigned char* buf = lds + (nn & 1) * STG;
#pragma unroll
            for (int i = 0; i < NPR; ++i) { int pc = lg_ + NLG * i; pc = pc < NPC ? pc : NPC - 1; *(LAS u32x4*)(buf + pc * 16) = R[i]; }
            if (lg_ == 0) *(LAS float*)(lds + CDB + (nn & 1) * 8) = cdv;
            if (nn + 2 < NCH) { if (WAITF && nn + 2 >= avail) { gdn_wait8(gflag, avail, NCH, lane); avail += 8; } GDN_PREFETCH(nn + 2); }
        }
    };
    auto flush = [&](int n) {
        for (int pc = lg_; pc < NCW * 256; pc += NLG) { const int cwi = pc >> 8, it = (pc >> 6) & 3, ln = pc & 63;
            const u32x2 w = *(LAS const u32x2*)(lds + OUTB + (n & 1) * 4096 + pc * 8);
            *(u32x2*)(out + ((size_t)b * SEQ + (size_t)n * 64 + 16 * it + (ln & 15)) * DM + 512 + h * 128 + 16 * (NCW * qt + cwi) + 4 * (ln >> 4)) = w; }
    };
    auto compute = [&](int n) {

            LAS const unsigned char* buf = lds + (n & 1) * STG;
            const float cd = *(LAS const float*)(lds + CDB + (n & 1) * 8);
            LAS const unsigned char* pw = buf + IMG_W + fr * 272 + 16 * q4;
            LAS const unsigned char* pq = buf + IMG_QD + fr * 272 + 16 * q4;
            LAS const unsigned char* pk = buf + IMG_KDT + fr * 144 + 16 * q4;
            LAS const unsigned char* pa = buf + IMG_AT + fr * 144 + 16 * q4;
            bf16x8 Sb[4];
#pragma unroll
            for (int s4 = 0; s4 < 4; ++s4) Sb[s4] = pack8(S[2 * s4], S[2 * s4 + 1]);
            f32x4 ao[4], av[4];
            u32x2 uu[4];
#pragma unroll
            for (int it = 0; it < 4; ++it) uu[it] = *(LAS const u32x2*)(buf + IMG_U + ((cw * 4 + it) * 64 + lane) * 8);
            u32x4* RA = R; u32x4* RB = R + 8;
#define GDN_LD_WQ(RR, it_) do { _Pragma("unroll") for (int s4 = 0; s4 < 4; ++s4) { RR[s4] = LDR(pw + (16 * (it_)) * 272 + 64 * s4); RR[4 + s4] = LDR(pq + (16 * (it_)) * 272 + 64 * s4); } } while (0)
#define GDN_LD_K(RR, dh_) do { _Pragma("unroll") for (int d2 = 0; d2 < 4; ++d2) _Pragma("unroll") for (int s2 = 0; s2 < 2; ++s2) RR[d2 * 2 + s2] = LDR(pk + (16 * (4 * (dh_) + d2)) * 144 + 64 * s2); } while (0)
#define GDN_MM_WQ(RR, it_) do { av[it_] = (f32x4){0.f, 0.f, 0.f, 0.f}; ao[it_] = (f32x4){0.f, 0.f, 0.f, 0.f}; \
        _Pragma("unroll") for (int s4 = 0; s4 < 4; ++s4) { av[it_] = MF16(asfrag(RR[s4]), Sb[s4], av[it_]); ao[it_] = MF16(Sb[s4], asfrag(RR[4 + s4]), ao[it_]); } } while (0)
#define GDN_MM_K(RR, dh_) do { _Pragma("unroll") for (int d2 = 0; d2 < 4; ++d2) { S[4 * (dh_) + d2] = S[4 * (dh_) + d2] * cd; \
        _Pragma("unroll") for (int s2 = 0; s2 < 2; ++s2) S[4 * (dh_) + d2] = MF16(asfrag(RR[d2 * 2 + s2]), Vb[s2], S[4 * (dh_) + d2]); } } while (0)
            GDN_LD_WQ(RA, 0); SCHED_FENCE();
            GDN_LD_WQ(RB, 1); SCHED_FENCE(); GDN_MM_WQ(RA, 0); SCHED_FENCE();
            GDN_LD_WQ(RA, 2); SCHED_FENCE(); GDN_MM_WQ(RB, 1); SCHED_FENCE();
            GDN_LD_WQ(RB, 3); SCHED_FENCE(); GDN_MM_WQ(RA, 2); SCHED_FENCE();
            GDN_LD_K(RA, 0); SCHED_FENCE(); GDN_MM_WQ(RB, 3); SCHED_FENCE();
#pragma unroll
            for (int it = 0; it < 4; ++it) {
                av[it][0] = __uint_as_float(uu[it].x << 16) - av[it][0]; av[it][1] = __uint_as_float(uu[it].x & 0xffff0000u) - av[it][1];
                av[it][2] = __uint_as_float(uu[it].y << 16) - av[it][2]; av[it][3] = __uint_as_float(uu[it].y & 0xffff0000u) - av[it][3]; }
            bf16x8 Vb[2];
#pragma unroll
            for (int s2 = 0; s2 < 2; ++s2) Vb[s2] = pack8(av[2 * s2], av[2 * s2 + 1]);
            GDN_LD_K(RB, 1); SCHED_FENCE(); GDN_MM_K(RA, 0); SCHED_FENCE();
#pragma unroll
            for (int it = 0; it < 4; ++it)
#pragma unroll
                for (int s2 = 0; s2 < 2; ++s2) R[it * 2 + s2] = LDR(pa + (16 * it) * 144 + 64 * s2);
            SCHED_FENCE(); GDN_MM_K(RB, 1); SCHED_FENCE();
#pragma unroll
            for (int it = 0; it < 4; ++it)
#pragma unroll
                for (int s2 = 0; s2 < 2; ++s2) ao[it] = MF16(Vb[s2], asfrag(R[it * 2 + s2]), ao[it]);
#undef GDN_LD_WQ
#undef GDN_LD_K
#undef GDN_MM_WQ
#undef GDN_MM_K
#pragma unroll
            for (int it = 0; it < 4; ++it) { u32x2 w; w.x = pack2(ao[it][0], ao[it][1]); w.y = pack2(ao[it][2], ao[it][3]); *(LAS u32x2*)(lds + OUTB + (n & 1) * 4096 + ((cw * 4 + it) * 64 + lane) * 8) = w; }
            };
    for (int n = -1; n < NCH; ++n) {
        if (loader) { load_step(n + 1); if (n >= 1 && (n & 1) == grp) flush(n - 1); } else if (n >= 0) compute(n);
        __syncthreads();
    }
    if (loader && grp == 0) flush(NCH - 1);
#undef GDN_PREFETCH
}
constexpr int CG = NCH >= 256 ? 16 : 4, NG = NCH / CG;
template <int MODE>
__device__ __forceinline__ void scan_ret(KPTR p, LAS unsigned char* lds, int b, int h, int qt, int g, int wv) {
    const int n0 = g * CG;
    constexpr int R_Q = 0, R_K = 17408, R_KDT = 34816, R_VT = 53248;
    constexpr int RAT_OFF = 2 * STG;
    const int tid = opaque_tid(wv), wid = tid >> 6, lane = tid & 63, fr = lane & 15, q4 = lane >> 4;
    const bf16_t* proj = p->proj; bf16_t* out = p->hn; float* Lb = p->retL;
    const bool loader = wid >= NCW;
    const int cw = wid, lt = tid - 64 * NCW;
    const float lg = log1pf(-exp2f(-5.0f - (float)h));
    f32x4 S[8];
#pragma unroll
    for (int dt = 0; dt < 8; ++dt) S[dt] = (f32x4){0.f, 0.f, 0.f, 0.f};
    const float rcd = __expf(lg * 64.f), g1 = __expf(lg);
    if (MODE == 1 && !loader) {
        const float gdec = __expf(lg * (float)(64 * CG)); float wgt = 1.f;
        for (int gp = g - 1; gp >= 0; --gp) {
            const f32x4* lp = (const f32x4*)Lb + ((((size_t)(b * 4 + h) * NG + gp) * (8 / NCW) + qt) * NCW + cw) * 8 * 64 + lane;
#pragma unroll
            for (int dt = 0; dt < 8; ++dt) S[dt] = S[dt] + lp[dt * 64] * wgt;
            wgt *= gdec;
        }
    }
    float gi[4];
#pragma unroll
    for (int t4 = 0; t4 < 4; ++t4) gi[t4] = __expf(lg * (float)(16 * t4 + fr));
    constexpr int NLG = NLT / 2, NQG = (1024 + NLG - 1) / NLG, KB_N = 256 - NLG;
    static_assert(NLG >= 128 && NLG <= 256 && KB_N + 32 * NCW <= NLG, "task slots");
    u32x4 R[NQG + 8 < 16 ? 16 : NQG + 8];
    const int grp = lt >= NLG ? 1 : 0, lg_ = lt - grp * NLG;
#define RET_PREFETCH(nn) do { int _l = lg_; OPAQUE_V(_l); const bf16_t* _pq = proj + ((size_t)b * SEQ + (size_t)(n0 + (nn)) * 64) * DINP + h * 128; \
        _Pragma("unroll") for (int _i = 0; _i < NQG; ++_i) { int _pc = _l + NLG * _i; _pc = _pc < 1024 ? _pc : 1023; const int _row = _pc >> 4, _c = _pc & 15; R[_i] = *(const u32x4*)(_pq + (size_t)_row * DINP + _c * 8); } \
        _Pragma("unroll") for (int _r = 0; _r < 4; ++_r) R[NQG + _r] = *(const u32x4*)(_pq + (size_t)(4 * (_l >> 4) + _r) * DINP + 512 + (_l & 15) * 8); \
        { const bool _isk = _l < KB_N; int _v = _l - KB_N; _v = _v < 0 ? 0 : (_v < 32 * NCW ? _v : 32 * NCW - 1); const int _t = NLG + (_isk ? _l : 0); \
          const int _r0 = _isk ? 4 * (_t >> 4) : 4 * (_v >> 2), _co = _isk ? 512 + (_t & 15) * 8 : 1024 + 16 * NCW * qt + (_v & 3) * 8; \
          _Pragma("unroll") for (int _r = 0; _r < 4; ++_r) R[NQG + 4 + _r] = *(const u32x4*)(_pq + (size_t)(_r0 + _r) * DINP + _co); } } while (0)
#define RET_WRITE_K(RB_, t_) do { const int ig = (t_) >> 4, ck = (t_) & 15; float sc[4]; \
        _Pragma("unroll") for (int r = 0; r < 4; ++r) { sc[r] = 0.08838834764831845f * __expf(lg * (float)(63 - 4 * ig - r)); \
            u32x2 a; a.x = R[(RB_) + r].x; a.y = R[(RB_) + r].y; u32x2 c2; c2.x = R[(RB_) + r].z; c2.y = R[(RB_) + r].w; \
            *(LAS u32x2*)(buf + R_K + (4 * ig + r) * 272 + permb(8 * ck)) = a; *(LAS u32x2*)(buf + R_K + (4 * ig + r) * 272 + permb(8 * ck + 4)) = c2; } \
        _Pragma("unroll") for (int e = 0; e < 8; ++e) { const int wsel = e >> 1; float x[4]; \
            _Pragma("unroll") for (int r = 0; r < 4; ++r) x[r] = ((e & 1) ? __uint_as_float(R[(RB_) + r][wsel] & 0xffff0000u) : __uint_as_float(R[(RB_) + r][wsel] << 16)) * sc[r]; \
            u32x2 o; o.x = pack2(x[0], x[1]); o.y = pack2(x[2], x[3]); *(LAS u32x2*)(buf + R_KDT + (8 * ck + e) * 144 + permb(4 * ig)) = o; } } while (0)
    if (loader && grp < CG) RET_PREFETCH(grp);
    __syncthreads();
    auto load_step = [&](int nn) {
        if (nn < CG && (nn & 1) == grp) {
            LAS unsigned char* buf = lds + (nn & 1) * STG; int l2 = lg_; OPAQUE_V(l2);
#pragma unroll
            for (int i = 0; i < NQG; ++i) { int pc = l2 + NLG * i; pc = pc < 1024 ? pc : 1023; const int row = pc >> 4, c = pc & 15;
                u32x2 a; a.x = R[i].x; a.y = R[i].y; u32x2 c2; c2.x = R[i].z; c2.y = R[i].w;
                *(LAS u32x2*)(buf + R_Q + row * 272 + permb(8 * c)) = a; *(LAS u32x2*)(buf + R_Q + row * 272 + permb(8 * c + 4)) = c2; }
            RET_WRITE_K(NQG, l2);
            if (l2 < KB_N) { RET_WRITE_K(NQG + 4, NLG + l2); }
            else if (l2 < KB_N + 32 * NCW) { const int v = l2 - KB_N, igv = v >> 2, cv = v & 3;
#pragma unroll
                for (int e = 0; e < 8; ++e) { const int wsel = e >> 1, sh = 16 * (e & 1);
                    u32x2 o; o.x = ((R[NQG + 4][wsel] >> sh) & 0xffffu) | (((R[NQG + 5][wsel] >> sh) & 0xffffu) << 16); o.y = ((R[NQG + 6][wsel] >> sh) & 0xffffu) | (((R[NQG + 7][wsel] >> sh) & 0xffffu) << 16);
                    *(LAS u32x2*)(buf + R_VT + (8 * cv + e) * 144 + permb(4 * igv)) = o; } }
            if (nn + 2 < CG) RET_PREFETCH(nn + 2);
        }
    };
    auto scores = [&](int n) {
        LAS const unsigned char* buf = lds + (n & 1) * STG;
        const int lw = wid - NCW;
#pragma unroll
        for (int rep = 0; rep < 2; ++rep) {
            const int tl = lw + (NTHREADS / 64 - NCW) * rep;
            if (tl < 12) {
                int it, jt;
                if (tl < 1) { it = 0; jt = 0; } else if (tl < 3) { it = 1; jt = tl - 1; } else if (tl < 6) { it = 2; jt = tl - 3; } else if (tl < 10) { it = 3; jt = tl - 6; } else if (tl == 10) { it = 0; jt = 1; } else { it = 2; jt = 3; }
                f32x4 acc = (f32x4){0.f, 0.f, 0.f, 0.f};
                if (tl < 10) {
                    bf16x8 kf[4], qf[4];
#pragma unroll
                    for (int s4 = 0; s4 < 4; ++s4) { kf[s4] = LDF(buf + R_K + (16 * jt + fr) * 272 + 64 * s4 + 16 * q4); qf[s4] = LDF(buf + R_Q + (16 * it + fr) * 272 + 64 * s4 + 16 * q4); }
#pragma unroll
                    for (int s4 = 0; s4 < 4; ++s4) acc = MF16(kf[s4], qf[s4], acc);
                    const float gi_ = __expf(lg * (float)(16 * it + fr));
#pragma unroll
                    for (int r = 0; r < 4; ++r) { const int j = 16 * jt + 4 * q4 + r, i = 16 * it + fr;
                        acc[r] = i >= j ? acc[r] * gi_ * 0.08838834764831845f * __expf(-lg * (float)j) : 0.f; }
                }
                u32x2 w; w.x = pack2(acc[0], acc[1]); w.y = pack2(acc[2], acc[3]);
                *(LAS u32x2*)(lds + RAT_OFF + (16 * it + fr) * 144 + permb(16 * jt + 4 * q4)) = w;
            }
        }
    };
    f32x4 ot[4];
    bf16x8 Vf[2];
    auto computeA = [&](int n) {
        LAS const unsigned char* buf = lds + (n & 1) * STG;
        LAS const unsigned char* pq = buf + R_Q + fr * 272 + 16 * q4;
        LAS const unsigned char* pk = buf + R_KDT + fr * 144 + 16 * q4;
        bf16x8 Sb[4];
#pragma unroll
        for (int s4 = 0; s4 < 4; ++s4) Sb[s4] = pack8(S[2 * s4], S[2 * s4 + 1]);
#pragma unroll
        for (int s2 = 0; s2 < 2; ++s2) Vf[s2] = LDF(buf + R_VT + (16 * cw + fr) * 144 + 64 * s2 + 16 * q4);
        u32x4* RA = R; u32x4* RB = R + 8;
#define RET_LD_Q(RR, hh_) do { _Pragma("unroll") for (int i2 = 0; i2 < 2; ++i2) _Pragma("unroll") for (int s4 = 0; s4 < 4; ++s4) RR[i2 * 4 + s4] = LDR(pq + (16 * (2 * (hh_) + i2)) * 272 + 64 * s4); } while (0)
#define RET_LD_K(RR, dh_) do { _Pragma("unroll") for (int d2 = 0; d2 < 4; ++d2) _Pragma("unroll") for (int s2 = 0; s2 < 2; ++s2) RR[d2 * 2 + s2] = LDR(pk + (16 * (4 * (dh_) + d2)) * 144 + 64 * s2); } while (0)
#define RET_MM_Q(RR, hh_) do { _Pragma("unroll") for (int i2 = 0; i2 < 2; ++i2) { const int it = 2 * (hh_) + i2; ot[it] = (f32x4){0.f, 0.f, 0.f, 0.f}; \
        _Pragma("unroll") for (int s4 = 0; s4 < 4; ++s4) ot[it] = MF16(Sb[s4], asfrag(RR[i2 * 4 + s4]), ot[it]); \
        const float rd = gi[it] * g1; _Pragma("unroll") for (int r = 0; r < 4; ++r) ot[it][r] *= rd; } } while (0)
#define RET_MM_K(RR, dh_) do { _Pragma("unroll") for (int d2 = 0; d2 < 4; ++d2) { S[4 * (dh_) + d2] = S[4 * (dh_) + d2] * rcd; \
        _Pragma("unroll") for (int s2 = 0; s2 < 2; ++s2) S[4 * (dh_) + d2] = MF16(asfrag(RR[d2 * 2 + s2]), Vf[s2], S[4 * (dh_) + d2]); } } while (0)
        RET_LD_K(RA, 0); SCHED_FENCE();
        RET_LD_K(RB, 1); SCHED_FENCE(); RET_MM_K(RA, 0); SCHED_FENCE();
        if (MODE == 1) {
            RET_LD_Q(RA, 0); SCHED_FENCE(); RET_MM_K(RB, 1); SCHED_FENCE();
            RET_LD_Q(RB, 1); SCHED_FENCE(); RET_MM_Q(RA, 0); SCHED_FENCE();
            RET_MM_Q(RB, 1);
        } else { RET_MM_K(RB, 1); }
#undef RET_LD_Q
#undef RET_LD_K
#undef RET_MM_Q
#undef RET_MM_K
    };
    auto computeB = [&](int n) {
        LAS const unsigned char* pa = lds + RAT_OFF + fr * 144 + 16 * q4;
        R[0] = LDR(pa); R[1] = LDR(pa + 16 * 144); R[2] = LDR(pa + 32 * 144); R[3] = LDR(pa + 32 * 144 + 64); R[4] = LDR(pa + 48 * 144); R[5] = LDR(pa + 48 * 144 + 64);
        SCHED_FENCE();
        ot[0] = MF16(Vf[0], asfrag(R[0]), ot[0]); ot[1] = MF16(Vf[0], asfrag(R[1]), ot[1]);
        ot[2] = MF16(Vf[0], asfrag(R[2]), ot[2]); ot[2] = MF16(Vf[1], asfrag(R[3]), ot[2]);
        ot[3] = MF16(Vf[0], asfrag(R[4]), ot[3]); ot[3] = MF16(Vf[1], asfrag(R[5]), ot[3]);
        scan_store_ot(out + ((size_t)b * SEQ + (size_t)(n0 + n) * 64 + fr) * DM + h * 128 + 16 * (NCW * qt + cw) + 4 * q4, ot);
    };
    for (int n = -1; n < CG; ++n) {
        if (loader) { if (MODE == 1 && n >= 0) scores(n); load_step(n + 1); } else if (n >= 0) computeA(n);
        __syncthreads();
        if (MODE == 1) {
            if (!loader && n >= 0) computeB(n);
            __syncthreads();
        }
    }
    if (MODE == 0 && !loader) {
        f32x4* lp = (f32x4*)Lb + ((((size_t)(b * 4 + h) * NG + g) * (8 / NCW) + qt) * NCW + cw) * 8 * 64 + lane;
#pragma unroll
        for (int dt = 0; dt < 8; ++dt) lp[dt * 64] = S[dt];
    }
#undef RET_PREFETCH
#undef RET_WRITE_K
}
template <int MODE>
__device__ __forceinline__ void scan_ret_full(KPTR p, LAS unsigned char* lds, int b, int h, int g, int wv) {
    constexpr int F_Q = 0, F_K = 17408, F_KDT = 34816, F_VT = 53248, F_RAT = 71680;
    const int n0 = g * CG;
    const int tid = opaque_tid(wv), wid = tid >> 6, lane = tid & 63, fr = lane & 15, q4 = lane >> 4, cw = wid;
    const bf16_t* proj = p->proj; bf16_t* out = p->hn; float* Lb = p->retL;
    const float lg = log1pf(-exp2f(-5.0f - (float)h));
    const float rcd = __expf(lg * 64.f), g1 = __expf(lg);
    f32x4 S[8];
#pragma unroll
    for (int dt = 0; dt < 8; ++dt) S[dt] = (f32x4){0.f, 0.f, 0.f, 0.f};
    if (MODE == 1) {
        const float gdec = __expf(lg * (float)(64 * CG)); float wgt = 1.f;
        for (int gp = g - 1; gp >= 0; --gp) {
            const f32x4* lp = (const f32x4*)Lb + (((size_t)(b * 4 + h) * NG + gp) * 8 + cw) * 8 * 64 + lane;
#pragma unroll
            for (int dt = 0; dt < 8; ++dt) S[dt] = S[dt] + lp[dt * 64] * wgt;
            wgt *= gdec;
        }
    }
    float gi[4];
#pragma unroll
    for (int t4 = 0; t4 < 4; ++t4) gi[t4] = __expf(lg * (float)(16 * t4 + fr));
    u32x4 rq[2], rkv[4];
#define RF_PREFETCH(nn) do { int _l = tid; OPAQUE_V(_l); const bf16_t* _pq = proj + ((size_t)b * SEQ + (size_t)(n0 + (nn)) * 64) * DINP + h * 128; \
        _Pragma("unroll") for (int _i = 0; _i < 2; ++_i) { const int _pc = _l + NTHREADS * _i; rq[_i] = *(const u32x4*)(_pq + (size_t)(_pc >> 4) * DINP + (_pc & 15) * 8); } \
        { const bool _isk = _l < 256; const int _t = _isk ? _l : _l - 256; const int _r0 = 4 * (_t >> 4), _co = (_isk ? 512 : 1024) + (_t & 15) * 8; \
          _Pragma("unroll") for (int _r = 0; _r < 4; ++_r) rkv[_r] = *(const u32x4*)(_pq + (size_t)(_r0 + _r) * DINP + _co); } } while (0)
    auto write_stage = [&]() {
        int l2 = tid; OPAQUE_V(l2);
#pragma unroll
        for (int i = 0; i < 2; ++i) { const int pc = l2 + NTHREADS * i, row = pc >> 4, c = pc & 15;
            u32x2 a; a.x = rq[i].x; a.y = rq[i].y; u32x2 c2; c2.x = rq[i].z; c2.y = rq[i].w;
            *(LAS u32x2*)(lds + F_Q + row * 272 + permb(8 * c)) = a; *(LAS u32x2*)(lds + F_Q + row * 272 + permb(8 * c + 4)) = c2; }
        if (l2 < 256) { const int ig = l2 >> 4, ck = l2 & 15; float sc[4];
#pragma unroll
            for (int r = 0; r < 4; ++r) { sc[r] = 0.08838834764831845f * __expf(lg * (float)(63 - 4 * ig - r));
                u32x2 a; a.x = rkv[r].x; a.y = rkv[r].y; u32x2 c2; c2.x = rkv[r].z; c2.y = rkv[r].w;
                *(LAS u32x2*)(lds + F_K + (4 * ig + r) * 272 + permb(8 * ck)) = a; *(LAS u32x2*)(lds + F_K + (4 * ig + r) * 272 + permb(8 * ck + 4)) = c2; }
#pragma unroll
            for (int e = 0; e < 8; ++e) { const int wsel = e >> 1; float x[4];
#pragma unroll
                for (int r = 0; r < 4; ++r) x[r] = ((e & 1) ? __uint_as_float(rkv[r][wsel] & 0xffff0000u) : __uint_as_float(rkv[r][wsel] << 16)) * sc[r];
                u32x2 o; o.x = pack2(x[0], x[1]); o.y = pack2(x[2], x[3]); *(LAS u32x2*)(lds + F_KDT + (8 * ck + e) * 144 + permb(4 * ig)) = o; }
        } else { const int v = l2 - 256, igv = v >> 4, cv = v & 15;
#pragma unroll
            for (int e = 0; e < 8; ++e) { const int wsel = e >> 1, sh = 16 * (e & 1);
                u32x2 o; o.x = ((rkv[0][wsel] >> sh) & 0xffffu) | (((rkv[1][wsel] >> sh) & 0xffffu) << 16); o.y = ((rkv[2][wsel] >> sh) & 0xffffu) | (((rkv[3][wsel] >> sh) & 0xffffu) << 16);
                *(LAS u32x2*)(lds + F_VT + (8 * cv + e) * 144 + permb(4 * igv)) = o; } }
    };
    auto scores = [&]() {
#pragma unroll
        for (int rep = 0; rep < 2; ++rep) {
            const int tl = wid + 8 * rep;
            if (tl < 12) {
                int it, jt;
                if (tl < 1) { it = 0; jt = 0; } else if (tl < 3) { it = 1; jt = tl - 1; } else if (tl < 6) { it = 2; jt = tl - 3; } else if (tl < 10) { it = 3; jt = tl - 6; } else if (tl == 10) { it = 0; jt = 1; } else { it = 2; jt = 3; }
                f32x4 acc = (f32x4){0.f, 0.f, 0.f, 0.f};
                if (tl < 10) {
                    bf16x8 kf[4], qf[4];
#pragma unroll
                    for (int s4 = 0; s4 < 4; ++s4) { kf[s4] = LDF(lds + F_K + (16 * jt + fr) * 272 + 64 * s4 + 16 * q4); qf[s4] = LDF(lds + F_Q + (16 * it + fr) * 272 + 64 * s4 + 16 * q4); }
#pragma unroll
                    for (int s4 = 0; s4 < 4; ++s4) acc = MF16(kf[s4], qf[s4], acc);
                    const float gi_ = __expf(lg * (float)(16 * it + fr));
#pragma unroll
                    for (int r = 0; r < 4; ++r) { const int j = 16 * jt + 4 * q4 + r, i = 16 * it + fr;
                        acc[r] = i >= j ? acc[r] * gi_ * 0.08838834764831845f * __expf(-lg * (float)j) : 0.f; }
                }
                u32x2 w; w.x = pack2(acc[0], acc[1]); w.y = pack2(acc[2], acc[3]);
                *(LAS u32x2*)(lds + F_RAT + (16 * it + fr) * 144 + permb(16 * jt + 4 * q4)) = w;
            }
        }
    };
    RF_PREFETCH(0);
    __syncthreads();
    write_stage();
    if (CG > 1) RF_PREFETCH(1);
    __syncthreads();
    for (int n = 0; n < CG; ++n) {
        if (MODE == 1) { scores(); __syncthreads(); }
        {
            LAS const unsigned char* pq = lds + F_Q + fr * 272 + 16 * q4;
            LAS const unsigned char* pk = lds + F_KDT + fr * 144 + 16 * q4;
            bf16x8 Sb[4];
#pragma unroll
            for (int s4 = 0; s4 < 4; ++s4) Sb[s4] = pack8(S[2 * s4], S[2 * s4 + 1]);
            bf16x8 Vf[2];
#pragma unroll
            for (int s2 = 0; s2 < 2; ++s2) Vf[s2] = LDF(lds + F_VT + (16 * cw + fr) * 144 + 64 * s2 + 16 * q4);
            u32x4 RA[8], RB[8];
            f32x4 ot[4];
#define RF_LD_Q(RR, hh_) do { _Pragma("unroll") for (int i2 = 0; i2 < 2; ++i2) _Pragma("unroll") for (int s4 = 0; s4 < 4; ++s4) RR[i2 * 4 + s4] = LDR(pq + (16 * (2 * (hh_) + i2)) * 272 + 64 * s4); } while (0)
#define RF_LD_K(RR, dh_) do { _Pragma("unroll") for (int d2 = 0; d2 < 4; ++d2) _Pragma("unroll") for (int s2 = 0; s2 < 2; ++s2) RR[d2 * 2 + s2] = LDR(pk + (16 * (4 * (dh_) + d2)) * 144 + 64 * s2); } while (0)
#define RF_MM_Q(RR, hh_) do { _Pragma("unroll") for (int i2 = 0; i2 < 2; ++i2) { const int it = 2 * (hh_) + i2; ot[it] = (f32x4){0.f, 0.f, 0.f, 0.f}; \
        _Pragma("unroll") for (int s4 = 0; s4 < 4; ++s4) ot[it] = MF16(Sb[s4], asfrag(RR[i2 * 4 + s4]), ot[it]); \
        const float rd = gi[it] * g1; _Pragma("unroll") for (int r = 0; r < 4; ++r) ot[it][r] *= rd; } } while (0)
#define RF_MM_K(RR, dh_) do { _Pragma("unroll") for (int d2 = 0; d2 < 4; ++d2) { S[4 * (dh_) + d2] = S[4 * (dh_) + d2] * rcd; \
        _Pragma("unroll") for (int s2 = 0; s2 < 2; ++s2) S[4 * (dh_) + d2] = MF16(asfrag(RR[d2 * 2 + s2]), Vf[s2], S[4 * (dh_) + d2]); } } while (0)
            RF_LD_K(RA, 0); SCHED_FENCE();
            RF_LD_K(RB, 1); SCHED_FENCE(); RF_MM_K(RA, 0); SCHED_FENCE();
            if (MODE == 1) {
                RF_LD_Q(RA, 0); SCHED_FENCE(); RF_MM_K(RB, 1); SCHED_FENCE();
                RF_LD_Q(RB, 1); SCHED_FENCE(); RF_MM_Q(RA, 0); SCHED_FENCE();
                RF_MM_Q(RB, 1);
                LAS const unsigned char* pa = lds + F_RAT + fr * 144 + 16 * q4;
                RA[0] = LDR(pa); RA[1] = LDR(pa + 16 * 144); RA[2] = LDR(pa + 32 * 144); RA[3] = LDR(pa + 32 * 144 + 64); RA[4] = LDR(pa + 48 * 144); RA[5] = LDR(pa + 48 * 144 + 64);
                SCHED_FENCE();
                ot[0] = MF16(Vf[0], asfrag(RA[0]), ot[0]); ot[1] = MF16(Vf[0], asfrag(RA[1]), ot[1]);
                ot[2] = MF16(Vf[0], asfrag(RA[2]), ot[2]); ot[2] = MF16(Vf[1], asfrag(RA[3]), ot[2]);
                ot[3] = MF16(Vf[0], asfrag(RA[4]), ot[3]); ot[3] = MF16(Vf[1], asfrag(RA[5]), ot[3]);
                scan_store_ot(out + ((size_t)b * SEQ + (size_t)(n0 + n) * 64 + fr) * DM + h * 128 + 16 * cw + 4 * q4, ot);
            } else { RF_MM_K(RB, 1); }
#undef RF_LD_Q
#undef RF_LD_K
#undef RF_MM_Q
#undef RF_MM_K
        }
        __syncthreads();
        if (n + 1 < CG) { write_stage(); if (n + 2 < CG) RF_PREFETCH(n + 2); }
        __syncthreads();
    }
    if (MODE == 0) {
        f32x4* lp = (f32x4*)Lb + (((size_t)(b * 4 + h) * NG + g) * 8 + cw) * 8 * 64 + lane;
#pragma unroll
        for (int dt = 0; dt < 8; ++dt) lp[dt * 64] = S[dt];
    }
#undef RF_PREFETCH
}

__device__ __forceinline__ void phase_ret_local(KPTR p, LAS unsigned char* lds, int bid, int nb, int wv) {
    constexpr int NIT0 = BATCH * 4 * NG;
    for (int it = bid; it < NIT0; it += nb) {
        const int g = it % NG, bh = it / NG;
        __syncthreads();
        scan_ret_full<0>(p, lds, bh >> 2, bh & 3, g, wv);
    }
}
template <bool OVERLAP>
__device__ __forceinline__ void phase_scan(KPTR p, LAS unsigned char* lds, int bid, int nb, int wv) {
    constexpr int QN = 8 / NCW;
    constexpr int G = BATCH * 4;
    constexpr int NUG = ((G + 7) / 8) * 8 * QN;
    for (int unit = bid; unit < NUG; unit += nb) {
        const int xcd = unit & 7, t = unit >> 3, qt = t % QN, bh = (t / QN) * 8 + xcd;
        if (bh >= G) continue;
        __syncthreads();
        for (int rp = 0; rp < RPT_SG; ++rp) scan_gdn<OVERLAP>(p, lds, bh >> 2, bh & 3, qt, wv);
    }
    if (OVERLAP && bid >= NUG) { __syncthreads(); phase_gdn_pre<true>(p, lds, bid - NUG, nb - NUG, wv); }
    constexpr int NIT1 = G * NG;
    const int first = nb > NUG ? NUG : 0, step = nb > NUG ? nb - NUG : nb;
    if (bid >= first) {
        for (int it = bid - first; it < NIT1; it += step) {
            const int g = it % NG, bh = it / NG;
            __syncthreads();
            for (int rp = 0; rp < RPT_SR; ++rp) scan_ret_full<1>(p, lds, bh >> 2, bh & 3, g, wv);
        }
    }
}

__device__ __forceinline__ void phase_gatednorm(KPTR p, int bid, int nb, int wv) {
    const int tid = opaque_tid(wv), wid = tid >> 6, lane = tid & 63;
    const int hh = lane >> 3, c0 = lane * 16;
    const float* nwp = (hh < 4 ? p->ret_norm + hh * 128 : p->gdn_norm + (hh - 4) * 128) + (lane & 7) * 16;
    float nw[16];
#pragma unroll
    for (int i = 0; i < 4; ++i) { const f32x4 t4 = *(const f32x4*)(nwp + 4 * i); nw[4 * i] = t4[0]; nw[4 * i + 1] = t4[1]; nw[4 * i + 2] = t4[2]; nw[4 * i + 3] = t4[3]; }
    const int gcol = (hh < 4 ? 1536 + hh * 128 : 3584 + (hh - 4) * 128) + (lane & 7) * 16;
    for (int t = bid * 8 + wid; t < NTOK; t += nb * 8) {
        bf16_t* o = p->hn + (size_t)t * DM + c0;
        const u32x4 o0 = *(const u32x4*)o, o1 = *(const u32x4*)(o + 8);
        const bf16_t* gp = p->proj + (size_t)t * DINP + gcol;
        const u32x4 g0 = *(const u32x4*)gp, g1 = *(const u32x4*)(gp + 8);
        float a[16], g[16];
#pragma unroll
        for (int i = 0; i < 4; ++i) { a[2 * i] = __uint_as_float(o0[i] << 16); a[2 * i + 1] = __uint_as_float(o0[i] & 0xffff0000u); a[8 + 2 * i] = __uint_as_float(o1[i] << 16); a[8 + 2 * i + 1] = __uint_as_float(o1[i] & 0xffff0000u);
            g[2 * i] = __uint_as_float(g0[i] << 16); g[2 * i + 1] = __uint_as_float(g0[i] & 0xffff0000u); g[8 + 2 * i] = __uint_as_float(g1[i] << 16); g[8 + 2 * i + 1] = __uint_as_float(g1[i] & 0xffff0000u); }
        float ss = 0.f;
#pragma unroll
        for (int i = 0; i < 16; ++i) ss += a[i] * a[i];
        ss += __shfl_xor(ss, 1); ss += __shfl_xor(ss, 2); ss += __shfl_xor(ss, 4);
        const float rs = rsqrtf(ss * (1.0f / 128.f) + NORM_EPS);
        u32x4 w0, w1;
#pragma unroll
        for (int i = 0; i < 4; ++i) { w0[i] = pack2(a[2 * i] * rs * nw[2 * i] * siluf(g[2 * i]), a[2 * i + 1] * rs * nw[2 * i + 1] * siluf(g[2 * i + 1]));
            w1[i] = pack2(a[8 + 2 * i] * rs * nw[8 + 2 * i] * siluf(g[8 + 2 * i]), a[8 + 2 * i + 1] * rs * nw[8 + 2 * i + 1] * siluf(g[8 + 2 * i + 1])); }
        *(u32x4*)o = w0; *(u32x4*)(o + 8) = w1;
    }
}

__device__ __forceinline__ void phase_kmean(KPTR p, LAS unsigned char* lds, int bid, int nb, int wv) {
    const int tid = opaque_tid(wv);
    LAS float* red = (LAS float*)lds;
    const int rg = tid >> 4, c = tid & 15;
    for (int unit = bid; unit < NIT; unit += nb) {
        const int blk = unit % NBLK, h = (unit / NBLK) & 7, b = unit / (NBLK * 8);
        const bf16_t* kp = p->qkv + ((size_t)b * SEQ + (size_t)blk * 256 + rg) * 3072 + 1024 + h * 128 + c * 8;
        float a[8];
#pragma unroll
        for (int j = 0; j < 8; ++j) a[j] = 0.f;
#pragma unroll
        for (int i = 0; i < 8; ++i) { const u32x4 w = *(const u32x4*)(kp + (size_t)(32 * i) * 3072);
            a[0] += __uint_as_float(w.x << 16); a[1] += __uint_as_float(w.x & 0xffff0000u); a[2] += __uint_as_float(w.y << 16); a[3] += __uint_as_float(w.y & 0xffff0000u);
            a[4] += __uint_as_float(w.z << 16); a[5] += __uint_as_float(w.z & 0xffff0000u); a[6] += __uint_as_float(w.w << 16); a[7] += __uint_as_float(w.w & 0xffff0000u); }
        __syncthreads();
#pragma unroll
        for (int j = 0; j < 8; ++j) red[rg * 128 + c * 8 + j] = a[j];
        __syncthreads();
        if (tid < 128) { float s2 = 0.f;
#pragma unroll
            for (int g = 0; g < 32; ++g) s2 += red[g * 128 + tid];
            s2 *= (1.0f / 256.f);
            const bf16_t hi = f2bf(s2);
            p->kmh[(size_t)unit * 128 + tid] = hi; p->kml[(size_t)unit * 128 + tid] = f2bf(s2 - bf2f(hi)); }
    }
}
__device__ __forceinline__ void phase_moba_select(KPTR p, LAS unsigned char* lds, int bid, int nb, int wv) {
    const int tid = opaque_tid(wv), wid = tid >> 6, lane = tid & 63, fr = lane & 15, fq = lane >> 4;
    LAS float* sg = (LAS float*)lds + wid * (16 * 65);
    LAS unsigned* cnt = (LAS unsigned*)(lds + 8 * 16 * 65 * 4);
    LAS unsigned* gbase = cnt + 64;
    const int TPS = SEQ / 128, NU = BATCH * 8 * TPS;
    const bf16_t* qkv = p->qkv; const bf16_t* kmh = p->kmh; const bf16_t* kml = p->kml; unsigned* mcount = p->mcount; unsigned short* mlist = p->mlist; float* part_lse = p->part_lse;
    for (int unit = bid; unit < NU; unit += nb) {
        const int tile = unit % TPS, h = (unit / TPS) & 7, b = unit / (TPS * 8), bh = b * 8 + h;
        const int t0 = tile * 128 + wid * 16, own = (tile * 128) >> 8;
        if (tid < 64) cnt[tid] = 0u;
        if (own > 0) {
            f32x4 acc[GNT];
#pragma unroll
            for (int nt = 0; nt < GNT; ++nt) acc[nt] = (f32x4){0.f, 0.f, 0.f, 0.f};
            const bf16_t* qrow = qkv + ((size_t)b * SEQ + t0 + fr) * 3072 + h * 128 + 8 * fq;
#pragma unroll
            for (int s4 = 0; s4 < 4; ++s4) {
                const bf16x8 a = *(const bf16x8*)(qrow + 32 * s4);
#pragma unroll
                for (int nt = 0; nt < GNT; ++nt) {
                    int blk = 16 * nt + fr; blk = blk < NBLK ? blk : NBLK - 1;
                    const size_t ko = ((size_t)bh * NBLK + blk) * 128 + 32 * s4 + 8 * fq;
                    const bf16x8 b1 = *(const bf16x8*)(kmh + ko), b2 = *(const bf16x8*)(kml + ko);
                    acc[nt] = __builtin_amdgcn_mfma_f32_16x16x32_bf16(a, b1, acc[nt], 0, 0, 0);
                    acc[nt] = __builtin_amdgcn_mfma_f32_16x16x32_bf16(a, b2, acc[nt], 0, 0, 0);
                }
            }
#pragma unroll
            for (int nt = 0; nt < GNT; ++nt)
#pragma unroll
                for (int r = 0; r < 4; ++r) sg[(4 * fq + r) * 65 + 16 * nt + fr] = acc[nt][r];
        }
        __syncthreads();
        int i0 = -1, i1 = -1, i2 = -1; unsigned r0 = 0, r1 = 0, r2 = 0;
        if (lane < 16) {
            float v0 = -3e38f, v1 = -3e38f, v2 = -3e38f;
            for (int j = 0; j < own; ++j) {
                const float g = sg[lane * 65 + j];
                if (g > v0) { v2 = v1; i2 = i1; v1 = v0; i1 = i0; v0 = g; i0 = j; }
                else if (g > v1) { v2 = v1; i2 = i1; v1 = g; i1 = j; }
                else if (g > v2) { v2 = g; i2 = j; }
            }
            if (i0 >= 0) r0 = LDS_ATOMIC_ADD(cnt + i0, 1u);
            if (i1 >= 0) r1 = LDS_ATOMIC_ADD(cnt + i1, 1u);
            if (i2 >= 0) r2 = LDS_ATOMIC_ADD(cnt + i2, 1u);
        }
        __syncthreads();
        if (tid < 64 && tid < own) { const unsigned c = cnt[tid]; if (c > 0u) gbase[tid] = atomicAdd(mcount + bh * NBLK + tid, c); }
        __syncthreads();
        if (lane < 16) {
            const int t = t0 + lane;
            const size_t pb = ((size_t)((size_t)b * SEQ + t) * 8 + h) * 3;
            unsigned short* lst = mlist + (size_t)bh * LTOT;
            if (i0 >= 0) lst[list_off(i0) + gbase[i0] + r0] = (unsigned short)(((unsigned)t << 2) | 0u); else part_lse[pb + 0] = -1e30f;
            if (i1 >= 0) lst[list_off(i1) + gbase[i1] + r1] = (unsigned short)(((unsigned)t << 2) | 1u); else part_lse[pb + 1] = -1e30f;
            if (i2 >= 0) lst[list_off(i2) + gbase[i2] + r2] = (unsigned short)(((unsigned)t << 2) | 2u); else part_lse[pb + 2] = -1e30f;
        }
    }
}

__device__ __forceinline__ void moba_stage_kv(const bf16_t* qkv, LAS unsigned char* Ks, LAS unsigned char* VTs, int b, int h, int j, int tid) {
    OPAQUE_V(tid);
    const bf16_t* kbase = qkv + ((size_t)b * SEQ + (size_t)j * 256) * 3072 + 1024 + h * 128;
    const bf16_t* vbase = kbase + 1024;
#pragma unroll
    for (int i = 0; i < 8; ++i) { const int id = tid + NTHREADS * i, key = id >> 4, c = id & 15;
        *(LAS u32x4*)(Ks + key * KS_STRIDE + c * 16) = *(const u32x4*)(kbase + (size_t)key * 3072 + c * 8); }
#pragma unroll
    for (int i = 0; i < 2; ++i) { const int id = tid + NTHREADS * i, c = (id & 3) | (((id >> 4) & 3) << 2), g = ((id >> 2) & 3) | ((id >> 6) << 2);
        u32x4 r0 = *(const u32x4*)(vbase + (size_t)(4 * g) * 3072 + c * 8), r1 = *(const u32x4*)(vbase + (size_t)(4 * g + 1) * 3072 + c * 8);
        u32x4 r2 = *(const u32x4*)(vbase + (size_t)(4 * g + 2) * 3072 + c * 8), r3 = *(const u32x4*)(vbase + (size_t)(4 * g + 3) * 3072 + c * 8);
#pragma unroll
        for (int e = 0; e < 8; ++e) { const int wsel = e >> 1, sh = 16 * (e & 1);
            const unsigned x0 = (r0[wsel] >> sh) & 0xffffu, x1 = (r1[wsel] >> sh) & 0xffffu, x2 = (r2[wsel] >> sh) & 0xffffu, x3 = (r3[wsel] >> sh) & 0xffffu;
            u32x2 o; o.x = x0 | (x1 << 16); o.y = x2 | (x3 << 16);
            *(LAS u32x2*)(VTs + (8 * c + e) * VT_STRIDE + 8 * g) = o; }
    }
}
struct AttnState { f32x16 o[4]; float m, l; };
template <bool CAUSAL>
__device__ __forceinline__ void attn_block(LAS const unsigned char* Ks, LAS const unsigned char* VTs, const bf16x8 (&qf)[8], float bias0, float slope, int qloc, int wtile, int lane, AttnState& st) {
    const int l31 = lane & 31, h2 = lane >> 5;
    const float scale = 0.08838834764831845f;
#pragma unroll 1
    for (int hf = 0; hf < 2; ++hf) {
        if (CAUSAL && 4 * hf > wtile) break;
        f32x16 sv[4];
#pragma unroll
        for (int kt = 0; kt < 4; ++kt) {
            const int kt4 = 4 * hf + kt;
            f32x16 acc;
#pragma unroll
            for (int r = 0; r < 16; ++r) acc[r] = 0.f;
            if (!CAUSAL || kt4 <= wtile) {
#pragma unroll
                for (int s8 = 0; s8 < 8; ++s8) { const bf16x8 a = *(LAS const bf16x8*)(Ks + (32 * kt4 + l31) * KS_STRIDE + (16 * s8 + 8 * h2) * 2);
                    acc = __builtin_amdgcn_mfma_f32_32x32x16_bf16(a, qf[s8], acc, 0, 0, 0); }
#pragma unroll
                for (int r = 0; r < 16; ++r) { const int kl = 32 * kt4 + (r & 3) + 8 * (r >> 2) + 4 * h2;
                    float v = acc[r] * scale + (bias0 + slope * (float)kl);
                    if (CAUSAL && kt4 == wtile && kl > qloc) v = -1e30f;
                    acc[r] = v; }
            } else {
#pragma unroll
                for (int r = 0; r < 16; ++r) acc[r] = -1e30f;
            }
            sv[kt] = acc;
            SCHED_FENCE();
        }
        float mx = -1e30f;
#pragma unroll
        for (int kt = 0; kt < 4; ++kt)
#pragma unroll
            for (int r = 0; r < 16; ++r) mx = fmaxf(mx, sv[kt][r]);
        mx = fmaxf(mx, __shfl_xor(mx, 32));
        const float mnew = fmaxf(st.m, mx);
        const float alpha = __expf(st.m - mnew);
        st.m = mnew;
        float ls = 0.f;
#pragma unroll
        for (int kt = 0; kt < 4; ++kt)
#pragma unroll
            for (int r = 0; r < 16; ++r) { const float pv = __expf(sv[kt][r] - mnew); sv[kt][r] = pv; ls += pv; }
        st.l = st.l * alpha + ls;
#pragma unroll
        for (int dt = 0; dt < 4; ++dt)
#pragma unroll
            for (int r = 0; r < 16; ++r) st.o[dt][r] *= alpha;
#pragma unroll
        for (int kt = 0; kt < 4; ++kt) {
            const int kt4 = 4 * hf + kt;
            if (CAUSAL && kt4 > wtile) continue;
#pragma unroll
            for (int s2 = 0; s2 < 2; ++s2) {
                u32x4 pw; pw.x = pack2(sv[kt][8 * s2 + 0], sv[kt][8 * s2 + 1]); pw.y = pack2(sv[kt][8 * s2 + 2], sv[kt][8 * s2 + 3]); pw.z = pack2(sv[kt][8 * s2 + 4], sv[kt][8 * s2 + 5]); pw.w = pack2(sv[kt][8 * s2 + 6], sv[kt][8 * s2 + 7]);
                bf16x8 pf; __builtin_memcpy(&pf, &pw, 16);
#pragma unroll
                for (int dt = 0; dt < 4; ++dt) {
                    LAS const unsigned char* vp = VTs + (32 * dt + l31) * VT_STRIDE + (32 * kt4 + 16 * s2 + 4 * h2) * 2;
                    const u32x2 lo = *(LAS const u32x2*)vp, hi = *(LAS const u32x2*)(vp + 16);
                    u32x4 aw; aw.x = lo.x; aw.y = lo.y; aw.z = hi.x; aw.w = hi.y;
                    bf16x8 a; __builtin_memcpy(&a, &aw, 16);
                    st.o[dt] = __builtin_amdgcn_mfma_f32_32x32x16_bf16(a, pf, st.o[dt], 0, 0, 0);
                }
                SCHED_FENCE();
            }
        }
    }
}
__device__ __forceinline__ void load_qfrag(const bf16_t* qrow, int h2, bf16x8 (&qf)[8]) {
#pragma unroll
    for (int s8 = 0; s8 < 8; ++s8) qf[s8] = *(const bf16x8*)(qrow + 16 * s8 + 8 * h2);
}

__device__ __forceinline__ void phase_moba_gather(KPTR p, LAS unsigned char* lds, int bid, int nb, int wv) {
    const int tid = opaque_tid(wv), wid = tid >> 6, lane = tid & 63, l31 = lane & 31, h2 = lane >> 5;
    LAS unsigned char* Ks = lds; LAS unsigned char* VTs = lds + KS_BYTES;
    LAS unsigned* pref = (LAS unsigned*)(lds + KS_BYTES + VT_BYTES);
    LAS unsigned* wsum = pref + NIT + 1;
    const bf16_t* qkv = p->qkv; const unsigned* mcount = p->mcount; const unsigned short* mlist = p->mlist; bf16_t* part_o = p->part_o; float* part_lse = p->part_lse;
    constexpr int IPT = (NIT + NTHREADS - 1) / NTHREADS;
    unsigned loc[IPT]; unsigned tsum = 0;
#pragma unroll
    for (int i = 0; i < IPT; ++i) { const int it = tid * IPT + i; const unsigned c = it < NIT ? mcount[it] : 0u; loc[i] = c ? 1u + 2u * ((c + 255u) >> 8) : 0u; tsum += loc[i]; }
    unsigned inc = tsum;
    for (int o = 1; o < 64; o <<= 1) { const unsigned t2 = __shfl_up(inc, o); if (lane >= o) inc += t2; }
    if (lane == 63) wsum[wid] = inc;
    __syncthreads();
    unsigned wbase = 0;
#pragma unroll
    for (int w = 0; w < 8; ++w) if (w < wid) wbase += wsum[w];
    unsigned run = wbase + inc - tsum;
#pragma unroll
    for (int i = 0; i < IPT; ++i) { const int it = tid * IPT + i; if (it < NIT) pref[it] = run; run += loc[i]; }
    if (tid == NTHREADS - 1) pref[NIT] = run;
    __syncthreads();
    const unsigned C = pref[NIT];
    const unsigned lo = (unsigned)(((unsigned long long)C * (unsigned)bid) / (unsigned)nb), hi = (unsigned)(((unsigned long long)C * (unsigned)(bid + 1)) / (unsigned)nb);
    if (lo >= hi) return;
    int first = 0; { int a = 0, c = NIT; while (c - a > 1) { const int mid = (a + c) >> 1; if (pref[mid] <= lo) a = mid; else c = mid; } first = a; }
    for (int it = first; it < NIT; ++it) {
        const unsigned ps = pref[it], pe = pref[it + 1];
        if (ps >= hi) break;
        if (pe <= lo || pe == ps) continue;
        const unsigned nr = (pe - ps - 1u) >> 1;
        unsigned r_lo = 0; if (lo > ps + 1u) r_lo = (lo - ps - 1u + 1u) >> 1;
        unsigned r_hi = nr; if (hi < ps + 1u + 2u * nr) r_hi = hi > ps + 1u ? (hi - ps - 1u + 1u) >> 1 : 0u;
        if (r_lo >= r_hi) continue;
        const int j = it % NBLK, h = (it / NBLK) & 7, b = it / (NBLK * 8), bh = b * 8 + h;
        const unsigned cnt = mcount[it];
        const unsigned ra = r_lo * 256u, rb = (r_hi * 256u) < cnt ? (r_hi * 256u) : cnt;
        __syncthreads();
        moba_stage_kv(qkv, Ks, VTs, b, h, j, tid);
        __syncthreads();
        const float slope = exp2f(-(float)(h + 1));
        const unsigned short* lst = mlist + (size_t)bh * LTOT + list_off(j);
        unsigned ent_next = 0;
        { const unsigned row = ra + 32u * wid + l31; if (ra + 32u * wid < rb) ent_next = lst[row < rb ? row : (rb - 1)]; }
        for (unsigned r0 = ra + 32u * wid; r0 < rb; r0 += 256u) {
            const unsigned row = r0 + l31; const bool active = row < rb;
            const unsigned ent = ent_next;
            if (r0 + 256u < rb) { const unsigned rn = row + 256u; ent_next = lst[rn < rb ? rn : (rb - 1)]; }
            const int t = (int)(ent >> 2), k = (int)(ent & 3u);
            bf16x8 qf[8]; load_qfrag(qkv + ((size_t)b * SEQ + t) * 3072 + h * 128, h2, qf);
            AttnState st;
#pragma unroll
            for (int dt = 0; dt < 4; ++dt)
#pragma unroll
                for (int r = 0; r < 16; ++r) st.o[dt][r] = 0.f;
            st.m = -1e30f; st.l = 0.f;
            attn_block<false>(Ks, VTs, qf, slope * (float)(256 * j - t), slope, 0, 0, lane, st);
            const float lt = st.l + __shfl_xor(st.l, 32);
            const float inv = 1.0f / lt;
            if (active) {
                const size_t pb = ((size_t)((size_t)b * SEQ + t) * 8 + h) * 3 + k;
                bf16_t* po = part_o + pb * 128;
#pragma unroll
                for (int dt = 0; dt < 4; ++dt)
#pragma unroll
                    for (int g = 0; g < 4; ++g) { u32x2 w; w.x = pack2(st.o[dt][4 * g] * inv, st.o[dt][4 * g + 1] * inv); w.y = pack2(st.o[dt][4 * g + 2] * inv, st.o[dt][4 * g + 3] * inv);
                        *(u32x2*)(po + 32 * dt + 8 * g + 4 * h2) = w; }
                if (h2 == 0) part_lse[pb] = st.m + __logf(lt);
            }
        }
    }
}
__device__ __forceinline__ void phase_moba_own(KPTR p, LAS unsigned char* lds, int bid, int nb, int wv) {
    const int tid = opaque_tid(wv), wid = tid >> 6, lane = tid & 63, l31 = lane & 31, h2 = lane >> 5;
    LAS unsigned char* Ks = lds; LAS unsigned char* VTs = lds + KS_BYTES;
    const bf16_t* qkv = p->qkv; const bf16_t* part_o = p->part_o; const float* part_lse = p->part_lse; bf16_t* out = p->hn;
    for (int it = bid; it < NIT; it += nb) {
        const int j = it % NBLK, h = (it / NBLK) & 7, b = it / (NBLK * 8);
        const float slope = exp2f(-(float)(h + 1));
        const int qloc = 32 * wid + l31, t = j * 256 + qloc;
        bf16x8 qf[8]; load_qfrag(qkv + ((size_t)b * SEQ + t) * 3072 + h * 128, h2, qf);
        __syncthreads();
        moba_stage_kv(qkv, Ks, VTs, b, h, j, tid);
        __syncthreads();
        AttnState st;
#pragma unroll
        for (int dt = 0; dt < 4; ++dt)
#pragma unroll
            for (int r = 0; r < 16; ++r) st.o[dt][r] = 0.f;
        st.m = -1e30f; st.l = 0.f;
        attn_block<true>(Ks, VTs, qf, slope * (float)(-qloc), slope, qloc, wid, lane, st);
        const float lt = st.l + __shfl_xor(st.l, 32);
        const float lse_own = st.m + __logf(lt);
        const size_t pb = ((size_t)((size_t)b * SEQ + t) * 8 + h) * 3;
        const float l0 = part_lse[pb], l1 = part_lse[pb + 1], l2 = part_lse[pb + 2];
        const float M = fmaxf(fmaxf(lse_own, l0), fmaxf(l1, l2));
        const float w_own = __expf(lse_own - M), w0 = __expf(l0 - M), w1 = __expf(l1 - M), w2 = __expf(l2 - M);
        const float Wi = 1.0f / (w_own + w0 + w1 + w2);
        const float c_own = w_own * Wi / lt, c0 = w0 * Wi, c1 = w1 * Wi, c2 = w2 * Wi;
        bf16_t* orow = out + ((size_t)b * SEQ + t) * DM + h * 128;
        const bool v0 = l0 > -1e29f, v1 = l1 > -1e29f, v2 = l2 > -1e29f;
#pragma unroll
        for (int dt = 0; dt < 4; ++dt) {
            u32x2 pw[3][4];
#pragma unroll
            for (int k = 0; k < 3; ++k)
#pragma unroll
                for (int g = 0; g < 4; ++g) pw[k][g] = *(const u32x2*)(part_o + (pb + k) * 128 + 32 * dt + 8 * g + 4 * h2);
#pragma unroll
            for (int g = 0; g < 4; ++g) {
                const int d0 = 32 * dt + 8 * g + 4 * h2;
                float v[4];
#pragma unroll
                for (int e = 0; e < 4; ++e) v[e] = st.o[dt][4 * g + e] * c_own;
#pragma unroll
                for (int k = 0; k < 3; ++k) {
                    const bool vk = k == 0 ? v0 : (k == 1 ? v1 : v2); const float ck = k == 0 ? c0 : (k == 1 ? c1 : c2);
                    const u32x2 w = pw[k][g];
                    const float f0 = __uint_as_float(w.x << 16), f1 = __uint_as_float(w.x & 0xffff0000u), f2 = __uint_as_float(w.y << 16), f3 = __uint_as_float(w.y & 0xffff0000u);
                    v[0] += vk ? ck * f0 : 0.f; v[1] += vk ? ck * f1 : 0.f; v[2] += vk ? ck * f2 : 0.f; v[3] += vk ? ck * f3 : 0.f;
                }
                u32x2 wo; wo.x = pack2(v[0], v[1]); wo.y = pack2(v[2], v[3]);
                *(u32x2*)(orow + d0) = wo;
            }
        }
    }
}

__device__ __forceinline__ void phase_router(KPTR p, LAS unsigned char* lds, int bid, int nb, int wv) {
    const int tid = opaque_tid(wv), wid = tid >> 6, lane = tid & 63;
    LAS unsigned* hist = (LAS unsigned*)lds;
    if (tid < 8) hist[tid] = 0u;
    __syncthreads();
    f32x4 gv[4];
#pragma unroll
    for (int i = 0; i < 4; ++i) gv[i] = *(const f32x4*)(p->ffn_norm + DM + i * 256 + lane * 4);
    const int rpw = (NTOK + nb - 1) / nb, rbeg = bid * rpw, rend = (rbeg + rpw) < NTOK ? (rbeg + rpw) : NTOK;
    f32x4 w8[16][2];
#pragma unroll
    for (int i = 0; i < 4; ++i)
#pragma unroll
        for (int e = 0; e < 4; ++e) { const float* wr_ = p->w_router + (size_t)(i * 256 + lane * 4 + e) * 8; w8[i * 4 + e][0] = *(const f32x4*)wr_; w8[i * 4 + e][1] = *(const f32x4*)(wr_ + 4); }
    for (int row = rbeg + wid; row < rend; row += 8) {
        f32x4 v[4]; load_row_b(p->hb3, row, lane, v);
        const float rs = row_rstd(v);
#pragma unroll
        for (int i = 0; i < 4; ++i) v[i] = v[i] * rs * gv[i];
        store_row_fp8((unsigned char*)p->hn, p->hns, row, lane, v);
        { float ss = 0.f;
#pragma unroll
          for (int i = 0; i < 4; ++i) ss += v[i][0] * v[i][0] + v[i][1] * v[i][1] + v[i][2] * v[i][2] + v[i][3] * v[i][3];
          ss = wave_sum(ss); if (lane == 0) p->hnn2[row] = ss; }
        f32x4 d0 = (f32x4){0.f, 0.f, 0.f, 0.f}, d1 = (f32x4){0.f, 0.f, 0.f, 0.f};
#pragma unroll
        for (int i = 0; i < 4; ++i)
#pragma unroll
            for (int e = 0; e < 4; ++e) { const float xv = v[i][e]; d0 = d0 + w8[i * 4 + e][0] * xv; d1 = d1 + w8[i * 4 + e][1] * xv; }
        float d[8] = {d0[0], d0[1], d0[2], d0[3], d1[0], d1[1], d1[2], d1[3]};
#pragma unroll
        for (int j = 0; j < 8; ++j) d[j] = wave_sum(d[j]);
        int i0 = 0; float m0 = d[0];
#pragma unroll
        for (int j = 1; j < 8; ++j) if (d[j] > m0) { m0 = d[j]; i0 = j; }
        int i1 = -1; float m1 = -3e38f;
#pragma unroll
        for (int j = 0; j < 8; ++j) if (j != i0 && d[j] > m1) { m1 = d[j]; i1 = j; }
        if (lane == 0) {
            const float e1 = __expf(m1 - m0); const float g0 = 1.0f / (1.0f + e1);
            p->midx[row * 2] = i0; p->midx[row * 2 + 1] = i1; p->mgate[row * 2] = g0; p->mgate[row * 2 + 1] = e1 * g0;
            LDS_ATOMIC_ADD(hist + i0, 1u); LDS_ATOMIC_ADD(hist + i1, 1u);
        }
    }
    __syncthreads();
    if (tid < 8) p->wghist[bid * 8 + tid] = hist[tid];
}
__device__ __forceinline__ void phase_slots(KPTR p, LAS unsigned char* lds, int bid, int nb, int wv) {
    const int tid = opaque_tid(wv);
    LAS unsigned* ltot = (LAS unsigned*)lds; LAS unsigned* lpre = ltot + 8; LAS unsigned* lcur = ltot + 16;
    if (tid < 24) ltot[tid] = 0u;
    __syncthreads();
    { const int e = tid & 7; unsigned tot = 0, pre = 0;
      for (int bb = tid >> 3; bb < nb; bb += NTHREADS / 8) { const unsigned v = p->wghist[bb * 8 + e]; tot += v; if (bb < bid) pre += v; }
      LDS_ATOMIC_ADD(ltot + e, tot); LDS_ATOMIC_ADD(lpre + e, pre); }
    __syncthreads();
    unsigned base[NE], cnt[NE]; unsigned acc = 0; float gu[NE];
#pragma unroll
    for (int e = 0; e < NE; ++e) { cnt[e] = ltot[e]; base[e] = acc; acc += (cnt[e] + 255u) & ~255u; gu[e] = __uint_as_float(p->ctrl[C_GMAX + e]) * __uint_as_float(p->ctrl[C_UMAX + e]); }
    const int rpw = (NTOK + nb - 1) / nb, rbeg = bid * rpw, rend = (rbeg + rpw) < NTOK ? (rbeg + rpw) : NTOK;
    for (int a = rbeg * 2 + tid; a < rend * 2; a += NTHREADS) {
        const int e = p->midx[a];
        unsigned b0 = 0;
#pragma unroll
        for (int j = 0; j < NE; ++j) if (j == e) b0 = base[j];
        const unsigned s = b0 + lpre[e] + LDS_ATOMIC_ADD(lcur + e, 1u);
        p->slot_of[a] = (int)s; p->arow[s] = a >> 1; p->sslot[s] = p->hns[a >> 1];
        float gm = 0.f;
#pragma unroll
        for (int j = 0; j < NE; ++j) if (j == e) gm = gu[j];
        p->shs[s] = p->hnn2[a >> 1] * gm * (1.0f / 256.f);
    }
    if (bid == 0) {
        if (tid == 0) { p->ctrl[C_NTILES] = acc >> 8; p->ctrl[C_TB + NE] = acc >> 8; }
        if (tid < NE) { unsigned bb = 0;
#pragma unroll
            for (int e = 0; e < NE; ++e) if (e == tid) bb = base[e];
            p->ctrl[C_TB + tid] = bb >> 8; }
#pragma unroll
        for (int e = 0; e < NE; ++e) {
            const unsigned lo = base[e] + cnt[e], hi = base[e] + ((cnt[e] + 255u) & ~255u);
            for (unsigned s2 = lo + tid; s2 < hi; s2 += NTHREADS) { p->arow[s2] = 0; p->sslot[s2] = 0.f; p->shs[s2] = 1.0f; }
            for (unsigned t = (base[e] >> 8) + tid; t < (hi >> 8); t += NTHREADS) p->tile_e[t] = e;
        }
    }
}
__device__ __forceinline__ void phase_final(KPTR p, const bf16_t* hsrc, int lo, int hi, int bid, int nb, int wv) {
    const int tid = opaque_tid(wv), wid = tid >> 6, lane = tid & 63;
    f32x4 gv[4];
#pragma unroll
    for (int i = 0; i < 4; ++i) gv[i] = *(const f32x4*)(p->final_norm + i * 256 + lane * 4);
    int sl0 = 0, sl1 = 0; float ga0 = 0.f, ga1 = 0.f;
    { const int row = lo + bid * 8 + wid; if (row < hi) { sl0 = p->slot_of[row * 2]; sl1 = p->slot_of[row * 2 + 1]; ga0 = p->mgate[row * 2]; ga1 = p->mgate[row * 2 + 1]; } }
    for (int row = lo + bid * 8 + wid; row < hi; row += nb * 8) {
        const int s0 = sl0, s1 = sl1; const float g0 = ga0, g1 = ga1;
        u32x2 y0[4], y1[4];
#pragma unroll
        for (int i = 0; i < 4; ++i) { y0[i] = *(const u32x2*)(p->yslot + (size_t)s0 * DM + i * 256 + lane * 4); y1[i] = *(const u32x2*)(p->yslot + (size_t)s1 * DM + i * 256 + lane * 4); }
        f32x4 v[4]; load_row_b(hsrc, row, lane, v);
        { const int rn = row + nb * 8; if (rn < hi) { sl0 = p->slot_of[rn * 2]; sl1 = p->slot_of[rn * 2 + 1]; ga0 = p->mgate[rn * 2]; ga1 = p->mgate[rn * 2 + 1]; } }
#pragma unroll
        for (int i = 0; i < 4; ++i) {
            v[i][0] += g0 * __uint_as_float(y0[i].x << 16) + g1 * __uint_as_float(y1[i].x << 16); v[i][1] += g0 * __uint_as_float(y0[i].x & 0xffff0000u) + g1 * __uint_as_float(y1[i].x & 0xffff0000u);
            v[i][2] += g0 * __uint_as_float(y0[i].y << 16) + g1 * __uint_as_float(y1[i].y << 16); v[i][3] += g0 * __uint_as_float(y0[i].y & 0xffff0000u) + g1 * __uint_as_float(y1[i].y & 0xffff0000u); }
        const float rs = row_rstd(v);
#pragma unroll
        for (int i = 0; i < 4; ++i) *(f32x4*)(p->out + (size_t)row * DM + i * 256 + lane * 4) = v[i] * rs * gv[i];
    }
}


#ifndef CPU_EMU
#define XB_TMO      128
#define XB_XCNT(j)  (256  + 64 * (j))
#define XB_XSUB(j)  (1280 + 64 * (j))
#define XB_XGEN(j)  (2304 + 64 * (j))
#define XB_TOP      3328
#define XB_TOPGEN   3392
#define XCD_BAR_WORDS 3456
#define XB_SPIN_CAP (1u << 20)
__device__ __forceinline__ unsigned xb_ld(unsigned* p) { return __hip_atomic_load(p, __ATOMIC_RELAXED, __HIP_MEMORY_SCOPE_AGENT); }
__device__ __forceinline__ unsigned xb_add(unsigned* p, unsigned v) { return __hip_atomic_fetch_add(p, v, __ATOMIC_RELAXED, __HIP_MEMORY_SCOPE_AGENT); }
__device__ __forceinline__ unsigned xb_xcc_id() { return (unsigned)__builtin_amdgcn_s_getreg((3 << 11) | 20) & 0xFu; }
#define XB_SPIN(cond, bar) do { unsigned _sp = 0; while (cond) { __builtin_amdgcn_s_sleep(1); \
    if ((++_sp & 255u) == 0u) { if (xb_ld(&(bar)[XB_TMO])) break; if (_sp > XB_SPIN_CAP) { atomicAdd(&(bar)[XB_TMO], 1u); break; } } } } while (0)
__device__ __forceinline__ void xcd_barrier_post(unsigned* bar, int tid) { if (tid == 0) (void)xb_add(&bar[XB_XCNT(xb_xcc_id())], 1u); }
__device__ __forceinline__ void xcd_barrier_complete(unsigned* bar, unsigned x, unsigned& nloc, unsigned& nx) {
    const unsigned G = gridDim.x * gridDim.y * gridDim.z;
    unsigned sum, cnt, mine, sp = 0u;
    for (;;) {
        sum = 0u; cnt = 0u; mine = 0u;
#pragma unroll
        for (unsigned j = 0; j < 16; ++j) { const unsigned c = xb_ld(&bar[XB_XCNT(j)]); sum += c; cnt += (c > 0u) ? 1u : 0u; mine = (j == x) ? c : mine; }
        if (sum == G) break;
        __builtin_amdgcn_s_sleep(1);
        if ((++sp & 255u) == 0u) { if (xb_ld(&bar[XB_TMO])) break; if (sp > XB_SPIN_CAP) { atomicAdd(&bar[XB_TMO], 1u); break; } }
    }
    nloc = mine > 0u ? mine : 1u; nx = cnt > 0u ? cnt : 1u;
}
__device__ __forceinline__ void xcd_barrier(unsigned* bar, volatile LAS unsigned* st, int tid) {
    asm volatile("s_waitcnt vmcnt(0)" ::: "memory");
    __syncthreads();
    if (tid == 0) {
        __builtin_amdgcn_s_waitcnt(0);
        const unsigned x = xb_xcc_id();
        unsigned nloc = st[0], nx = st[1];
        if (nloc == 0u) { xcd_barrier_complete(bar, x, nloc, nx); st[0] = nloc; st[1] = nx; }
        const unsigned old = xb_add(&bar[XB_XSUB(x)], 1u);
        const unsigned gen = old / nloc;
        if (old + 1u == (gen + 1u) * nloc) {
            __builtin_amdgcn_fence(__ATOMIC_RELEASE, "agent");
            asm volatile("s_waitcnt vmcnt(0)" ::: "memory");
            const unsigned og = xb_add(&bar[XB_TOP], 1u);
            const unsigned tg = og / nx;
            if (og + 1u == (tg + 1u) * nx) xb_add(&bar[XB_TOPGEN], 1u);
            else XB_SPIN(xb_ld(&bar[XB_TOPGEN]) == tg, bar);
            __builtin_amdgcn_fence(__ATOMIC_ACQUIRE, "agent");
            xb_add(&bar[XB_XGEN(x)], 1u);
            asm volatile("s_waitcnt vmcnt(0)" ::: "memory");
        } else {
            XB_SPIN(xb_ld(&bar[XB_XGEN(x)]) == gen, bar);
            __builtin_amdgcn_fence(__ATOMIC_ACQUIRE, "agent");
            asm volatile("s_waitcnt vmcnt(0)" ::: "memory");
        }
    }
    __syncthreads();
}
#define GRID_BARRIER() do { unsigned* _bar = p->bar; xcd_barrier(_bar, (volatile LAS unsigned*)(lds + kDynLds - 16), opaque_tid(wv)); } while (0)
#else
#define XCD_BAR_WORDS 3456
#define GRID_BARRIER() emu::grid_sync()
#endif

#ifndef CPU_EMU
extern __shared__ __attribute__((aligned(16))) unsigned char smem_raw[];
#define GET_LDS() ((LAS unsigned char*)smem_raw)
#else
#define GET_LDS() (emu::blk->smem)
#endif

__global__ void __launch_bounds__(NTHREADS) fwd_megakernel(Params p_arg) {
    cg::grid_group grid = cg::this_grid();
    KPTR p = KARG_PTR(p_arg);
    LAS unsigned char* lds = GET_LDS();
#ifndef CPU_EMU
    const int wv = __builtin_amdgcn_readfirstlane((int)(threadIdx.x >> 6));
#else
    const int wv = 0;
#endif
    const int bid = blockIdx.x, nb = gridDim.x, tid = opaque_tid(wv);
#ifndef CPU_EMU
    if (tid == 0) { volatile LAS unsigned* st = (volatile LAS unsigned*)(lds + kDynLds - 16); st[0] = 0u; st[1] = 0u; }
    __syncthreads();
    xcd_barrier_post(p->bar, tid);
#endif
    LAUNDER(p);
    if (bid == 0 && tid < 256) p->ctrl[tid] = 0u;
    for (int i = bid * NTHREADS + tid; i < NIT; i += nb * NTHREADS) p->mcount[i] = 0u;
    for (int i = bid * NTHREADS + tid; i < NCHH; i += nb * NTHREADS) p->gflag[i] = 0u;
    convert_wt(lds, p->w_in, DM, DIN, 0, DINP, p->wt_in, 128, 0, bid, nb, wv);
    convert_wt(lds, p->w_out0, DM, DM, 0, DM, p->wt_out0, 128, 0, bid, nb, wv);
    convert_wt(lds, p->w_gate0, DM, FF, 0, FF, p->wt_gu0, 256, 0, bid, nb, wv);
    convert_wt(lds, p->w_up0, DM, FF, 0, FF, p->wt_gu0, 256, 128, bid, nb, wv);
    convert_wt(lds, p->w_down0, FF, DM, 0, DM, p->wt_d0, 128, 0, bid, nb, wv);
    convert_wt(lds, p->w_qkv, DM, 3072, 0, 3072, p->wt_qkv, 128, 0, bid, nb, wv);
    convert_wt(lds, p->w_out1, DM, DM, 0, DM, p->wt_out1, 128, 0, bid, nb, wv);
    phase_norm<true>(p, p->x, p->mix_norm, bid, nb, wv);
    grid.sync();
    LAUNDER(p);
    for (int rp = 0; rp < RPT_GEMM; ++rp) { StaticOrder so; so.init(NTOK / 256, DINP / 256, nb, bid); Gemm g{p->hn, p->wt_in, nullptr}; EpiBf16 e{p->proj, DINP, 0}; gemm_phase<DM>(lds, g, so, e, wv); }
    GRID_BARRIER();
    LAUNDER(p);
    constexpr int NUG_ = ((BATCH * 4 + 7) / 8) * 8 * (8 / NCW);
    const bool overlap = nb >= NUG_ + 32;
    if (!overlap) phase_gdn_pre<false>(p, lds, bid, nb, wv);
    phase_ret_local(p, lds, bid, nb, wv);
    GRID_BARRIER();
    LAUNDER(p);
    if (overlap) phase_scan<true>(p, lds, bid, nb, wv); else phase_scan<false>(p, lds, bid, nb, wv);
    GRID_BARRIER();
    LAUNDER(p);
    phase_gatednorm(p, bid, nb, wv);
    GRID_BARRIER();
    LAUNDER(p);
    { StaticOrder so; so.init(NTOK / 256, DM / 256, nb, bid); Gemm g{p->hn, p->wt_out0, nullptr}; EpiResBf16<true> e{p->x, nullptr, p->hb}; gemm_phase<DM>(lds, g, so, e, wv); }
    GRID_BARRIER();
    LAUNDER(p);
#if FP8_FFN0
    phase_norm<false, true, true>(p, p->hb, p->ffn_norm, bid, nb, wv);
    quant_rows<DM, false>(p, lds, p->wt_gu0, p->w8_gu0, p->ws_gu0, 2 * FF, bid, nb, wv);
#else
    phase_norm<false, false, true>(p, p->hb, p->ffn_norm, bid, nb, wv);
#endif
    GRID_BARRIER();
    LAUNDER(p);
#if FP8_FFN0
    for (int rp = 0; rp < RPT_GEMM; ++rp) { StaticOrder so; so.init(NTOK / 256, 2 * FF / 256, nb, bid); Gemm g{p->hn, (const bf16_t*)p->w8_gu0, nullptr}; EpiSwigluS e{p->act0, FF, 0, p->hns, p->ws_gu0}; gemm_phase<DM, EpiSwigluS, StaticOrder, true>(lds, g, so, e, wv); }
#else
    for (int rp = 0; rp < RPT_GEMM; ++rp) { StaticOrder so; so.init(NTOK / 256, 2 * FF / 256, nb, bid); Gemm g{p->hn, p->wt_gu0, nullptr}; EpiSwiglu e{p->act0, FF, 0}; gemm_phase<DM>(lds, g, so, e, wv); }
#endif
    GRID_BARRIER();
    LAUNDER(p);
    { StaticOrder so; so.init(NTOK / 256, DM / 256, nb, bid); Gemm g{p->act0, p->wt_d0, nullptr}; EpiResBf16<false> e{nullptr, p->hb, p->hb}; gemm_phase<FF>(lds, g, so, e, wv); }
    GRID_BARRIER();
    LAUNDER(p);
    phase_norm<false, false, true>(p, p->hb, p->mix_norm + DM, bid, nb, wv);
    GRID_BARRIER();
    LAUNDER(p);
    for (int rp = 0; rp < RPT_GEMM; ++rp) { StaticOrder so; so.init(NTOK / 256, 3072 / 256, nb, bid); Gemm g{p->hn, p->wt_qkv, nullptr}; EpiBf16 e{p->qkv, 3072, 0}; gemm_phase<DM>(lds, g, so, e, wv); }
    GRID_BARRIER();
    LAUNDER(p);
    phase_kmean(p, lds, bid, nb, wv);
    GRID_BARRIER();
    LAUNDER(p);
    phase_moba_select(p, lds, bid, nb, wv);
    GRID_BARRIER();
    LAUNDER(p);
    for (int rp = 0; rp < RPT_MG; ++rp) phase_moba_gather(p, lds, bid, nb, wv);
    GRID_BARRIER();
    LAUNDER(p);
    for (int rp = 0; rp < RPT_MO; ++rp) phase_moba_own(p, lds, bid, nb, wv);
    GRID_BARRIER();
    LAUNDER(p);
    convert_gu_fp8(p, lds, bid, nb, wv);
    for (int rp = 0; rp < RPT_CONV; ++rp) for (int e = 0; e < NE; ++e) {
        convert_wt(lds, p->w_mdown + (size_t)e * FFE * DM, FFE, DM, 0, DM, p->wt_md_tmp + (size_t)e * DM * FFE, 128, 0, bid, nb, wv);
    }
    { StaticOrder so; so.init(NTOK / 256, DM / 256, nb, bid); Gemm g{p->hn, p->wt_out1, nullptr}; EpiResBf16<false> e{nullptr, p->hb, p->hb3}; gemm_phase<DM>(lds, g, so, e, wv); }
    GRID_BARRIER();
    LAUNDER(p);
    phase_router(p, lds, bid, nb, wv);
    quant_rows<FFE, false>(p, lds, p->wt_md_tmp, p->w8_md, p->ws_md, NE * DM, bid, nb, wv);
    GRID_BARRIER();
    LAUNDER(p);
    phase_slots(p, lds, bid, nb, wv);
    GRID_BARRIER();
    LAUNDER(p);
    {
        const int ntiles = (int)p->ctrl[C_NTILES];
        const int npass = (ntiles + p->tiles_per_pass - 1) / p->tiles_per_pass;
        const int tpp = npass > 0 ? (ntiles + npass - 1) / npass : 1;
        const size_t mbuf = (size_t)p->tiles_per_pass * 256 * FFE; int q = 0;
        for (int t0 = 0; t0 < ntiles; t0 += tpp, ++q) {
            const int nM = (ntiles - t0) < tpp ? (ntiles - t0) : tpp;
            unsigned char* mb = (unsigned char*)p->mact + (size_t)(q & 1) * mbuf;
            for (int rp = 0; rp < RPT_GEMM; ++rp) { MoeOrder mo; mo.init(t0, nM, 2 * FFE / 256, p->tile_e, nb, bid); Gemm g{p->hn, (const bf16_t*)p->w8_mgu, p->arow}; EpiSwigluS8 e{mb, FFE, t0 * 256, p->sslot, p->ws_mgu, p->shs}; gemm_phase<DM, EpiSwigluS8, MoeOrder, true>(lds, g, mo, e, wv); }
            GRID_BARRIER();
            for (int rp = 0; rp < RPT_GEMM; ++rp) { MoeOrder mo; mo.init(t0, nM, DM / 256, p->tile_e, nb, bid); Gemm g{(const bf16_t*)((const unsigned char*)mb - (size_t)t0 * 256 * FFE), (const bf16_t*)p->w8_md, nullptr}; EpiBf16S e{p->yslot, DM, p->shs, p->ws_md}; gemm_phase<FFE, EpiBf16S, MoeOrder, true>(lds, g, mo, e, wv); }
        }
        GRID_BARRIER();
    }
    LAUNDER(p);
    phase_final(p, p->hb3, 0, NTOK, bid, nb, wv);
}

static inline size_t al256(size_t x) { return (x + 255) & ~(size_t)255; }

extern "C" void kernel_launch(void* const* d_in, const int* in_sizes, int n_in, void* d_out, int out_size, void* d_ws, size_t ws_size, hipStream_t stream) {
    Params p; memset(&p, 0, sizeof(p));
    p.x = (const float*)d_in[0]; p.mix_norm = (const float*)d_in[1]; p.ffn_norm = (const float*)d_in[2]; p.w_in = (const float*)d_in[3]; p.conv_w = (const float*)d_in[4];
    p.a_log = (const float*)d_in[5]; p.dt_bias = (const float*)d_in[6]; p.ret_norm = (const float*)d_in[7]; p.gdn_norm = (const float*)d_in[8]; p.w_out0 = (const float*)d_in[9];
    p.w_qkv = (const float*)d_in[10]; p.w_out1 = (const float*)d_in[11]; p.w_gate0 = (const float*)d_in[12]; p.w_up0 = (const float*)d_in[13]; p.w_down0 = (const float*)d_in[14];
    p.w_router = (const float*)d_in[15]; p.w_mgate = (const float*)d_in[16]; p.w_mup = (const float*)d_in[17]; p.w_mdown = (const float*)d_in[18]; p.final_norm = (const float*)d_in[19];
    p.out = (float*)d_out; p.hb = (bf16_t*)((unsigned char*)d_out + (size_t)NTOK * DM * 2);
    unsigned char* w = (unsigned char*)d_ws; size_t off = 0;
    auto take = [&](size_t bytes) { unsigned char* r = w + off; off += al256(bytes); return r; };
    p.ctrl = (unsigned*)take(4096); p.bar = (unsigned*)take((size_t)XCD_BAR_WORDS * 4);
    p.wt_in = (bf16_t*)take((size_t)DINP * DM * 2); p.wt_out0 = (bf16_t*)take((size_t)DM * DM * 2); p.wt_gu0 = (bf16_t*)take((size_t)2 * FF * DM * 2); p.wt_d0 = (bf16_t*)take((size_t)DM * FF * 2);
    p.wt_qkv = (bf16_t*)take((size_t)3072 * DM * 2); p.wt_out1 = (bf16_t*)take((size_t)DM * DM * 2);
    p.hn = (bf16_t*)take((size_t)NTOK * DM * 2);
    p.gflag = (unsigned*)take((size_t)NCHH * 4);
    p.retL = (float*)take((size_t)BATCH * 4 * NG * 128 * 128 * 4);
    p.gbeta = (float*)take((size_t)NTOK * 4 * 4); p.gg = (float*)take((size_t)NTOK * 4 * 4);
    p.arow = (int*)take((size_t)MAXTILES * 256 * 4); p.tile_e = (int*)take((size_t)MAXTILES * 4); p.slot_of = (int*)take((size_t)NTOK * 2 * 4); p.mgate = (float*)take((size_t)NTOK * 2 * 4); p.midx = (int*)take((size_t)NTOK * 2 * 4); p.wghist = (unsigned*)take((size_t)4096 * 8 * 4);
    p.w8_gu0 = take((size_t)2 * FF * DM); p.ws_gu0 = (float*)take((size_t)2 * FF * 4); p.ws_mgu = (float*)take((size_t)NE * 2 * FFE * 4); p.hns = (float*)take((size_t)NTOK * 4); p.sslot = (float*)take((size_t)MAXTILES * 256 * 4);
    p.ws_md = (float*)take((size_t)NE * DM * 4); p.hnn2 = (float*)take((size_t)NTOK * 4); p.shs = (float*)take((size_t)MAXTILES * 256 * 4);
    p.kmh = (bf16_t*)take((size_t)NIT * 128 * 2); p.kml = (bf16_t*)take((size_t)NIT * 128 * 2); p.mcount = (unsigned*)take((size_t)NIT * 4);
    p.arena = w + off;
    const size_t arena_bytes = ws_size - off;
    { size_t a = 0; auto at = [&](size_t bytes) { unsigned char* r = p.arena + a; a += al256(bytes); return r; };
      p.proj = (bf16_t*)at((size_t)NTOK * DINP * 2);
      p.gimg = (unsigned char*)at((size_t)NCHH * IMG_CH); p.gcdec = (float*)at((size_t)NCHH * 4);
      if (a > arena_bytes) fprintf(stderr, "workspace too small (layer0): need %zu have %zu\n", a, arena_bytes); }
    p.act0 = (bf16_t*)p.arena;
    { size_t a = 0; auto at = [&](size_t bytes) { unsigned char* r = p.arena + a; a += al256(bytes); return r; };
      p.qkv = (bf16_t*)at((size_t)NTOK * 3072 * 2); p.part_o = (bf16_t*)at((size_t)NTOK * 8 * 3 * 128 * 2); p.part_lse = (float*)at((size_t)NTOK * 8 * 3 * 4); p.mlist = (unsigned short*)at((size_t)BATCH * 8 * LTOT * 2);
      if (a > arena_bytes) fprintf(stderr, "workspace too small (layer1): need %zu have %zu\n", a, arena_bytes); }
    { size_t a = 0; auto at = [&](size_t bytes) { unsigned char* r = p.arena + a; a += al256(bytes); return r; };
      p.w8_mgu = at((size_t)NE * 2 * FFE * DM); p.w8_md = at((size_t)NE * DM * FFE); p.yslot = (bf16_t*)at((size_t)MAXTILES * 256 * DM * 2);
      p.hb3 = (bf16_t*)at((size_t)NTOK * DM * 2);
      p.mact = (bf16_t*)(p.arena + a);
      p.wt_mgu = nullptr; p.wt_md_tmp = p.mact; p.wt_md = nullptr;
      const size_t rest = arena_bytes > a ? arena_bytes - a : 0;
      if (rest < (size_t)NE * FFE * DM * 2) fprintf(stderr, "workspace too small (moe weights)\n");
      long tiles = (long)(rest / ((size_t)2 * 256 * FFE));
      if (tiles > 64) tiles = 64;
      if (tiles < 1) { fprintf(stderr, "workspace too small (moe)\n"); tiles = 1; }
#ifdef CPU_EMU
      if (getenv("EMU_TPP")) tiles = atoi(getenv("EMU_TPP"));
#endif
      p.tiles_per_pass = (int)tiles; }
#ifdef CPU_EMU
    emu::reg("hn", p.hn, (size_t)NTOK * DM * 2, "bf16"); emu::reg("proj", p.proj, (size_t)NTOK * DINP * 2, "bf16");
    emu::reg("gbeta", p.gbeta, (size_t)NTOK * 16, "f32"); emu::reg("gg", p.gg, (size_t)NTOK * 16, "f32"); emu::reg("midx", p.midx, (size_t)NTOK * 8, "i32");
    const int grid_blocks = getenv("EMU_GRID") ? atoi(getenv("EMU_GRID")) : 8;
    emu::launch(grid_blocks, NTHREADS, kDynLds, [=]() { fwd_megakernel(p); }, true);
#else
    static int grid_blocks = 0;
    if (!grid_blocks) {
        int dev = 0, cus = 0, per_cu = 0;
        (void)hipGetDevice(&dev);
        (void)hipDeviceGetAttribute(&cus, hipDeviceAttributeMultiprocessorCount, dev);
        (void)hipFuncSetAttribute((const void*)fwd_megakernel, hipFuncAttributeMaxDynamicSharedMemorySize, (int)kDynLds);
        (void)hipOccupancyMaxActiveBlocksPerMultiprocessor(&per_cu, fwd_megakernel, NTHREADS, kDynLds);
        if (per_cu < 1) per_cu = 1;
        grid_blocks = cus;
    }
    (void)hipMemsetAsync(p.bar, 0, (size_t)XCD_BAR_WORDS * 4, stream);
    void* args[] = {&p};
    hipError_t e = hipLaunchCooperativeKernel((const void*)fwd_megakernel, dim3(grid_blocks), dim3(NTHREADS), args, kDynLds, stream);
    if (e != hipSuccess) fprintf(stderr, "cooperative launch failed: %s (grid %d)\n", hipGetErrorString(e), grid_blocks);
#endif
}
```

```cpp
#ifndef CPU_EMU
#include <hip/hip_runtime.h>
#include <hip/hip_cooperative_groups.h>
#include <cstdio>
#include <cstring>
#define LAS __attribute__((address_space(3)))
#define WAVE_SYNC() __builtin_amdgcn_wave_barrier()
#define SCHED_FENCE() __builtin_amdgcn_sched_barrier(0)
#define OPAQUE_V(x) asm volatile("" : "+v"(x))
static __device__ __forceinline__ unsigned shfl_up_u(unsigned v, int o, int lane) { const int src = lane >= o ? lane - o : lane; return (unsigned)__builtin_amdgcn_ds_bpermute(src << 2, (int)v); }
static __device__ __forceinline__ float shfl_up_f(float v, int o, int lane) { return __uint_as_float(shfl_up_u(__float_as_uint(v), o, lane)); }
#define LDS_ATOMIC_ADD(ptr, v) __hip_atomic_fetch_add((ptr), (v), __ATOMIC_RELAXED, __HIP_MEMORY_SCOPE_WORKGROUP)
#define LDS_ATOMIC_MAX(ptr, v) __hip_atomic_fetch_max((ptr), (v), __ATOMIC_RELAXED, __HIP_MEMORY_SCOPE_WORKGROUP)
#define GLOBAL_ATOMIC_MAX(ptr, v) __hip_atomic_fetch_max((ptr), (v), __ATOMIC_RELAXED, __HIP_MEMORY_SCOPE_AGENT)
static __device__ __forceinline__ int opaque_tid(int wv) { int l; asm volatile("v_mbcnt_lo_u32_b32 %0, -1, 0\n\tv_mbcnt_hi_u32_b32 %0, -1, %0" : "=v"(l)); return (wv << 6) | l; }
#else
static inline int opaque_tid(int) { return threadIdx.x; }
#define LAS
#define WAVE_SYNC() ((void)__ballot(1))
#define SCHED_FENCE() ((void)0)
#define OPAQUE_V(x) ((void)0)
static inline unsigned shfl_up_u(unsigned v, int o, int lane) { return __shfl(v, lane >= o ? lane - o : lane); }
static inline float shfl_up_f(float v, int o, int lane) { return __shfl(v, lane >= o ? lane - o : lane); }
static inline unsigned emu_fetch_add(unsigned* p, unsigned v) { unsigned o = *p; *p = o + v; return o; }
#define LDS_ATOMIC_ADD(ptr, v) emu_fetch_add((ptr), (v))
static inline unsigned emu_fetch_max(unsigned* p, unsigned v) { unsigned o = *p; if (v > o) *p = v; return o; }
#define LDS_ATOMIC_MAX(ptr, v) emu_fetch_max((ptr), (v))
#define GLOBAL_ATOMIC_MAX(ptr, v) atomicMax((ptr), (v))
#endif
namespace cg = cooperative_groups;

#ifndef RPT_SYNC
#define RPT_SYNC 0
#endif
#ifndef RPT_SG
#define RPT_SG 1
#endif
#ifndef RPT_SR
#define RPT_SR 1
#endif
#ifndef RPT_MG
#define RPT_MG 1
#endif
#ifndef RPT_MO
#define RPT_MO 1
#endif
#ifndef RPT_GEMM
#define RPT_GEMM 1
#endif
#ifndef RPT_GDN
#define RPT_GDN 1
#endif
#ifndef RPT_SCAN
#define RPT_SCAN 1
#endif
#ifndef RPT_MOBA
#define RPT_MOBA 1
#endif
#ifndef RPT_CONV
#define RPT_CONV 1
#endif
#ifndef FP8_FFN0
#define FP8_FFN0 0
#endif
#ifndef CFG_SEQ
#define CFG_SEQ 16384
#define CFG_BATCH 2
#define CFG_FF 2816
#define CFG_FFE 3584
#endif

typedef unsigned short bf16_t;
typedef short bf16x8 __attribute__((ext_vector_type(8)));
typedef float f32x4 __attribute__((ext_vector_type(4)));
typedef float f32x16 __attribute__((ext_vector_type(16)));
typedef unsigned u32x4 __attribute__((ext_vector_type(4)));
typedef unsigned u32x2 __attribute__((ext_vector_type(2)));

constexpr int DM = 1024, SEQ = CFG_SEQ, BATCH = CFG_BATCH, NTOK = SEQ * BATCH, HD = 128;
constexpr int DIN = 4104, DINP = 4096, FF = CFG_FF, FFE = CFG_FFE, NE = 8;
constexpr int NCH = SEQ / 64, NBLK = SEQ / 256, NCHH = BATCH * 4 * NCH;
constexpr int NTHREADS = 512;
constexpr int BM = 256, BK = 64, HALF = 128, HTB = HALF * BK * 2, STAGE_BYTES = 8 * HTB, NXCD = 8, WGM = 4;
constexpr size_t kDynLds = 144 * 1024;
constexpr int MAXTILES = NTOK * 2 / 256 + NE;
constexpr int NIT = BATCH * 8 * NBLK;
constexpr int LTOT = NBLK * SEQ - 128 * NBLK * (NBLK + 1);
static_assert(SEQ <= 16384, "16-bit selection-list entries");
constexpr int GNT = (NBLK + 15) / 16;
constexpr int KS_STRIDE = 272, VT_STRIDE = 520;
constexpr int KS_BYTES = 256 * KS_STRIDE, VT_BYTES = 128 * VT_STRIDE;
__host__ __device__ __forceinline__ int list_off(int j) { return j * SEQ - 128 * j * (j + 1); }
constexpr float NORM_EPS = 1e-6f;

__device__ __forceinline__ bf16_t f2bf(float f) { unsigned u = __float_as_uint(f); u += 0x7FFFu + ((u >> 16) & 1u); return (bf16_t)(u >> 16); }
__device__ __forceinline__ float bf2f(bf16_t h) { return __uint_as_float(((unsigned)h) << 16); }
#ifndef CPU_EMU
typedef __bf16 hwbf16x2 __attribute__((ext_vector_type(2)));
typedef float f32x2v __attribute__((ext_vector_type(2)));
__device__ __forceinline__ unsigned pack2(float lo, float hi) { f32x2v v; v.x = lo; v.y = hi; hwbf16x2 b = __builtin_convertvector(v, hwbf16x2); unsigned r; __builtin_memcpy(&r, &b, 4); return r; }
#else
__device__ __forceinline__ unsigned pack2(float lo, float hi) { return (unsigned)f2bf(lo) | ((unsigned)f2bf(hi) << 16); }
#endif
#ifndef CPU_EMU
__device__ __forceinline__ float siluf(float x) { return x * __builtin_amdgcn_rcpf(1.0f + __builtin_amdgcn_exp2f(-1.4426950408889634f * x)); }
#else
__device__ __forceinline__ float siluf(float x) { return x / (1.0f + __expf(-x)); }
#endif
#ifndef CPU_EMU
__device__ __forceinline__ unsigned pack4_fp8(float a, float b, float c, float d) { int r = 0; r = __builtin_amdgcn_cvt_pk_fp8_f32(a, b, r, false); r = __builtin_amdgcn_cvt_pk_fp8_f32(c, d, r, true); return (unsigned)r; }
#else
static inline float fp8_to_f(unsigned char v) { const int s = v >> 7, e = (v >> 3) & 15, m = v & 7; const float a = e == 0 ? ldexpf((float)m, -9) : ldexpf((float)(8 + m), e - 10); return s ? -a : a; }
static inline unsigned char f_to_fp8(float x) {
    const unsigned s = x < 0.f ? 0x80u : 0u; float a = fabsf(x); if (!(a == a)) return 0x7f; if (a > 448.f) a = 448.f; if (a == 0.f) return (unsigned char)s;
    int e; (void)frexpf(a, &e); e -= 1; if (e < -6) e = -6;
    const float step = ldexpf(1.f, e - 3); float q = nearbyintf(a / step) * step; if (q > 448.f) q = 448.f;
    int e2; (void)frexpf(q, &e2); e2 -= 1; unsigned bits;
    if (q < ldexpf(1.f, -6)) bits = (unsigned)nearbyintf(q * 512.f); else bits = ((unsigned)(e2 + 7) << 3) | ((unsigned)nearbyintf(q / ldexpf(1.f, e2 - 3)) - 8u);
    return (unsigned char)(s | bits);
}
static inline unsigned pack4_fp8(float a, float b, float c, float d) { return (unsigned)f_to_fp8(a) | ((unsigned)f_to_fp8(b) << 8) | ((unsigned)f_to_fp8(c) << 16) | ((unsigned)f_to_fp8(d) << 24); }
#endif
constexpr float FP8_TOP = 384.f;
#ifndef CPU_EMU
__device__ __forceinline__ float wave_sum(float s) { int l; asm volatile("v_mbcnt_lo_u32_b32 %0, -1, 0\n\tv_mbcnt_hi_u32_b32 %0, -1, %0" : "=v"(l));
#pragma unroll
    for (int o = 32; o >= 1; o >>= 1) s += __uint_as_float((unsigned)__builtin_amdgcn_ds_bpermute((l ^ o) << 2, (int)__float_as_uint(s))); return s; }
__device__ __forceinline__ float wave_max(float s) { int l; asm volatile("v_mbcnt_lo_u32_b32 %0, -1, 0\n\tv_mbcnt_hi_u32_b32 %0, -1, %0" : "=v"(l));
#pragma unroll
    for (int o = 32; o >= 1; o >>= 1) s = fmaxf(s, __uint_as_float((unsigned)__builtin_amdgcn_ds_bpermute((l ^ o) << 2, (int)__float_as_uint(s)))); return s; }
#else
__device__ __forceinline__ float wave_sum(float s) { for (int o = 32; o >= 1; o >>= 1) s += __shfl_xor(s, o); return s; }
__device__ __forceinline__ float wave_max(float s) { for (int o = 32; o >= 1; o >>= 1) s = fmaxf(s, __shfl_xor(s, o)); return s; }
#endif

struct Params;
#ifndef CPU_EMU
typedef const __attribute__((address_space(4))) Params* KPTR;
#define KARG_PTR(arg) ((KPTR)__builtin_amdgcn_kernarg_segment_ptr())
#define LAUNDER(q) asm volatile("" : "+s"(q))
#else
typedef const Params* KPTR;
#define KARG_PTR(arg) (&(arg))
#define LAUNDER(q) ((void)0)
#endif
struct Params {
    const float* x; const float* mix_norm; const float* ffn_norm; const float* w_in; const float* conv_w; const float* a_log; const float* dt_bias;
    const float* ret_norm; const float* gdn_norm; const float* w_out0; const float* w_qkv; const float* w_out1; const float* w_gate0; const float* w_up0;
    const float* w_down0; const float* w_router; const float* w_mgate; const float* w_mup; const float* w_mdown; const float* final_norm;
    float* out;
    bf16_t* hb;
    bf16_t* hb3;
    unsigned* ctrl;
    unsigned* bar;
    bf16_t* wt_in; bf16_t* wt_out0; bf16_t* wt_gu0; bf16_t* wt_d0; bf16_t* wt_qkv; bf16_t* wt_out1;
    bf16_t* hn;
    float* gbeta; float* gg;
    float* retL;
    unsigned* gflag;
    unsigned char* arena;
    bf16_t* proj; unsigned char* gimg; float* gcdec;
    bf16_t* act0;
    bf16_t* qkv; bf16_t* kmh; bf16_t* kml; unsigned* mcount; unsigned short* mlist; bf16_t* part_o; float* part_lse;
    bf16_t* wt_mgu; bf16_t* wt_md; bf16_t* yslot; bf16_t* mact; int* arow; int* tile_e; int* slot_of; float* mgate; int* midx; unsigned* wghist;
    unsigned char* w8_gu0; float* ws_gu0; unsigned char* w8_mgu; float* ws_mgu; float* hns; float* sslot; unsigned char* w8_md; float* ws_md; float* hnn2; float* sn2; float* shs; bf16_t* wt_md_tmp;
    int tiles_per_pass; int pad0;
};

#define C_CNT(e) (64 + (e))
#define C_CUR(e) (128 + (e))
#define C_NTILES 192
#define C_GMAX 216
#define C_UMAX 224
#define C_TB 200

__host__ __device__ __forceinline__ int lds_byte(int r, int c) { const int st = (r >> 4) * 2 + (c >> 5), rr = r & 15, cc = c & 31, ob = rr * 64 + cc * 2; return st * 1024 + (ob ^ (((ob >> 9) & 1) << 5)); }
__host__ __device__ __forceinline__ void stage_rc(int b, int& R, int& C) { const int st = b / 1024, sb = b % 1024, swz = sb ^ (((sb >> 9) & 1) << 5); R = (st >> 1) * 16 + swz / 64; C = (st & 1) * 32 + (swz % 64) / 2; }
__host__ __device__ __forceinline__ int perm32(int rho) { const int n = rho >> 4, i = rho & 15; return 8 * (i >> 2) + 4 * n + (i & 3); }

struct Unit { int pm, pn, pnb; };
struct Gemm { const bf16_t* A; const bf16_t* Bt; const int* arow; };

struct StaticOrder {
    int nM, nN, nwg, G, c;
    __device__ void init(int nM_, int nN_, int G_, int c_) { nM = nM_; nN = nN_; nwg = nM * nN; G = G_; c = c_; }
    __device__ bool next(int i, Unit& u) const {
        const long L = (long)i * G + c; if (L >= nwg) return false;
        int wgid = (int)L; { const int q = nwg / NXCD, r = nwg % NXCD, xcd = wgid % NXCD, off = wgid / NXCD; wgid = (xcd < r ? xcd * (q + 1) : r * (q + 1) + (xcd - r) * q) + off; }
        const int nig = WGM * nN, gid = wgid / nig, fm = gid * WGM, gsz = (nM - fm) < WGM ? (nM - fm) : WGM;
        u.pm = fm + ((wgid % nig) % gsz); u.pn = (wgid % nig) / gsz; u.pnb = u.pn; return true;
    }
};
struct MoeOrder {
    StaticOrder so; int t0; const int* tile_e;
    __device__ void init(int t0_, int nM_, int nN_, const int* te, int G_, int c_) { so.init(nM_, nN_, G_, c_); t0 = t0_; tile_e = te; }
    __device__ bool next(int i, Unit& u) const { if (!so.next(i, u)) return false; u.pm += t0; u.pnb = tile_e[u.pm] * so.nN + u.pn; return true; }
};

struct EpiBf16 {
    static constexpr bool PERM = true;
    bf16_t* O; int ldc; int rowbase;
    __device__ __forceinline__ void operator()(const f32x4 (&acc)[2][2][4][2], const Unit& u, int wr, int wc, int fr, int fq) const {
        const int row0 = u.pm * BM + wr * 64 + fr - rowbase, col0 = u.pn * BM + wc * 32 + 8 * fq;
#pragma unroll
        for (int ai = 0; ai < 2; ++ai)
#pragma unroll
            for (int m = 0; m < 4; ++m) { bf16_t* rowp = O + (size_t)(row0 + ai * HALF + m * 16) * ldc + col0;
#pragma unroll
                for (int bj = 0; bj < 2; ++bj) { const f32x4 v0 = acc[ai][bj][m][0], v1 = acc[ai][bj][m][1];
                    u32x4 w; w.x = pack2(v0[0], v0[1]); w.y = pack2(v0[2], v0[3]); w.z = pack2(v1[0], v1[1]); w.w = pack2(v1[2], v1[3]);
                    *(u32x4*)(rowp + bj * HALF) = w; } }
    }
};
struct EpiSwiglu {
    static constexpr bool PERM = true;
    bf16_t* O; int ldc; int rowbase;
    __device__ __forceinline__ void operator()(const f32x4 (&acc)[2][2][4][2], const Unit& u, int wr, int wc, int fr, int fq) const {
        const int row0 = u.pm * BM + wr * 64 + fr - rowbase, col0 = u.pn * HALF + wc * 32 + 8 * fq;
#pragma unroll
        for (int ai = 0; ai < 2; ++ai)
#pragma unroll
            for (int m = 0; m < 4; ++m) { bf16_t* rowp = O + (size_t)(row0 + ai * HALF + m * 16) * ldc + col0;
                float r[8];
#pragma unroll
                for (int n = 0; n < 2; ++n)
#pragma unroll
                    for (int j = 0; j < 4; ++j) r[n * 4 + j] = siluf(acc[ai][0][m][n][j]) * acc[ai][1][m][n][j];
                u32x4 w; w.x = pack2(r[0], r[1]); w.y = pack2(r[2], r[3]); w.z = pack2(r[4], r[5]); w.w = pack2(r[6], r[7]);
                *(u32x4*)rowp = w; }
    }
};
struct EpiSwigluS {
    static constexpr bool PERM = true;
    bf16_t* O; int ldc; int rowbase; const float* sa; const float* sb;
    __device__ __forceinline__ void operator()(const f32x4 (&acc)[2][2][4][2], const Unit& u, int wr, int wc, int fr, int fq) const {
        const int rowg = u.pm * BM + wr * 64 + fr, row0 = rowg - rowbase, col0 = u.pn * HALF + wc * 32 + 8 * fq;
        const float* sbp = sb + (size_t)u.pnb * BM + wc * 32 + 8 * fq;
        f32x4 sg[2], su[2];
#pragma unroll
        for (int n = 0; n < 2; ++n) { sg[n] = *(const f32x4*)(sbp + 4 * n); su[n] = *(const f32x4*)(sbp + HALF + 4 * n); }
        float ra[2][4];
#pragma unroll
        for (int ai = 0; ai < 2; ++ai)
#pragma unroll
            for (int m = 0; m < 4; ++m) ra[ai][m] = sa[rowg + ai * HALF + m * 16];
#pragma unroll
        for (int ai = 0; ai < 2; ++ai)
#pragma unroll
            for (int m = 0; m < 4; ++m) { bf16_t* rowp = O + (size_t)(row0 + ai * HALF + m * 16) * ldc + col0;
                float r[8];
#pragma unroll
                for (int n = 0; n < 2; ++n)
#pragma unroll
                    for (int j = 0; j < 4; ++j) r[n * 4 + j] = siluf(acc[ai][0][m][n][j] * (ra[ai][m] * sg[n][j])) * (acc[ai][1][m][n][j] * (ra[ai][m] * su[n][j]));
                u32x4 w; w.x = pack2(r[0], r[1]); w.y = pack2(r[2], r[3]); w.z = pack2(r[4], r[5]); w.w = pack2(r[6], r[7]);
                *(u32x4*)rowp = w; }
    }
};
struct EpiSwigluS8 {
    static constexpr bool PERM = true;
    unsigned char* O8; int ldc; int rowbase; const float* sa; const float* sb; const float* so;
    __device__ __forceinline__ void operator()(const f32x4 (&acc)[2][2][4][2], const Unit& u, int wr, int wc, int fr, int fq) const {
        const int rowg = u.pm * BM + wr * 64 + fr, row0 = rowg - rowbase, col0 = u.pn * HALF + wc * 32 + 8 * fq;
        const float* sbp = sb + (size_t)u.pnb * BM + wc * 32 + 8 * fq;
        f32x4 sg[2], su[2];
#pragma unroll
        for (int n = 0; n < 2; ++n) { sg[n] = *(const f32x4*)(sbp + 4 * n); su[n] = *(const f32x4*)(sbp + HALF + 4 * n); }
        float ra[2][4], ro[2][4];
#pragma unroll
        for (int ai = 0; ai < 2; ++ai)
#pragma unroll
            for (int m = 0; m < 4; ++m) { ra[ai][m] = sa[rowg + ai * HALF + m * 16]; const float so_ = so[rowg + ai * HALF + m * 16]; ro[ai][m] = so_ > 0.f ? 1.0f / so_ : 0.f; }
#pragma unroll
        for (int ai = 0; ai < 2; ++ai)
#pragma unroll
            for (int m = 0; m < 4; ++m) { unsigned char* rowp = O8 + (size_t)(row0 + ai * HALF + m * 16) * ldc + col0;
                float r[8];
#pragma unroll
                for (int n = 0; n < 2; ++n)
#pragma unroll
                    for (int j = 0; j < 4; ++j) r[n * 4 + j] = siluf(acc[ai][0][m][n][j] * (ra[ai][m] * sg[n][j])) * (acc[ai][1][m][n][j] * (ra[ai][m] * su[n][j])) * ro[ai][m];
                u32x2 w; w.x = pack4_fp8(r[0], r[1], r[2], r[3]); w.y = pack4_fp8(r[4], r[5], r[6], r[7]);
                *(u32x2*)rowp = w; }
    }
};
struct EpiBf16S {
    static constexpr bool PERM = true;
    bf16_t* O; int ldc; const float* sa; const float* sb;
    __device__ __forceinline__ void operator()(const f32x4 (&acc)[2][2][4][2], const Unit& u, int wr, int wc, int fr, int fq) const {
        const int row0 = u.pm * BM + wr * 64 + fr, col0 = u.pn * BM + wc * 32 + 8 * fq;
        const float* sbp = sb + (size_t)u.pnb * BM + wc * 32 + 8 * fq;
        f32x4 sv[2][2];
#pragma unroll
        for (int bj = 0; bj < 2; ++bj)
#pragma unroll
            for (int n = 0; n < 2; ++n) sv[bj][n] = *(const f32x4*)(sbp + bj * HALF + 4 * n);
#pragma unroll
        for (int ai = 0; ai < 2; ++ai)
#pragma unroll
            for (int m = 0; m < 4; ++m) { bf16_t* rowp = O + (size_t)(row0 + ai * HALF + m * 16) * ldc + col0; const float ra = sa[row0 + ai * HALF + m * 16];
#pragma unroll
                for (int bj = 0; bj < 2; ++bj) { const f32x4 v0 = acc[ai][bj][m][0] * sv[bj][0] * ra, v1 = acc[ai][bj][m][1] * sv[bj][1] * ra;
                    u32x4 w; w.x = pack2(v0[0], v0[1]); w.y = pack2(v0[2], v0[3]); w.z = pack2(v1[0], v1[1]); w.w = pack2(v1[2], v1[3]);
                    *(u32x4*)(rowp + bj * HALF) = w; } }
    }
};
template <bool F32BASE>
struct EpiResBf16 {
    static constexpr bool PERM = true;
    static constexpr bool LSCALE = false;
    const float* basef; const bf16_t* baseb; bf16_t* out;
    __device__ __forceinline__ void operator()(const f32x4 (&acc)[2][2][4][2], const Unit& u, int wr, int wc, int fr, int fq) const {
        const int row0 = u.pm * BM + wr * 64 + fr, col0 = u.pn * BM + wc * 32 + 8 * fq;
#pragma unroll
        for (int ai = 0; ai < 2; ++ai)
#pragma unroll
            for (int m = 0; m < 4; ++m) { const size_t off = (size_t)(row0 + ai * HALF + m * 16) * DM + col0;
#pragma unroll
                for (int bj = 0; bj < 2; ++bj) { f32x4 b0, b1;
                    if (F32BASE) { b0 = *(const f32x4*)(basef + off + bj * HALF); b1 = *(const f32x4*)(basef + off + bj * HALF + 4); }
                    else { const u32x4 w = *(const u32x4*)(baseb + off + bj * HALF);
                        b0[0] = __uint_as_float(w.x << 16); b0[1] = __uint_as_float(w.x & 0xffff0000u); b0[2] = __uint_as_float(w.y << 16); b0[3] = __uint_as_float(w.y & 0xffff0000u);
                        b1[0] = __uint_as_float(w.z << 16); b1[1] = __uint_as_float(w.z & 0xffff0000u); b1[2] = __uint_as_float(w.w << 16); b1[3] = __uint_as_float(w.w & 0xffff0000u); }
                    const f32x4 v0 = acc[ai][bj][m][0] + b0, v1 = acc[ai][bj][m][1] + b1;
                    u32x4 o; o.x = pack2(v0[0], v0[1]); o.y = pack2(v0[2], v0[3]); o.z = pack2(v1[0], v1[1]); o.w = pack2(v1[2], v1[3]);
                    *(u32x4*)(out + off + bj * HALF) = o; } }
    }
};
struct EpiResF32 {
    static constexpr bool PERM = false;
    const float* base; float* out; int ldc;
    __device__ __forceinline__ void operator()(const f32x4 (&acc)[2][2][4][2], const Unit& u, int wr, int wc, int fr, int fq) const {
        const int row0 = u.pm * BM + wr * 64 + fr, col0 = u.pn * BM + wc * 32 + 4 * fq;
#pragma unroll
        for (int ai = 0; ai < 2; ++ai)
#pragma unroll
            for (int m = 0; m < 4; ++m) { const size_t off = (size_t)(row0 + ai * HALF + m * 16) * ldc + col0;
#pragma unroll
                for (int bj = 0; bj < 2; ++bj)
#pragma unroll
                    for (int n = 0; n < 2; ++n) { const f32x4 b = *(const f32x4*)(base + off + bj * HALF + n * 16); *(f32x4*)(out + off + bj * HALF + n * 16) = b + acc[ai][bj][m][n]; } }
    }
};

#ifndef CPU_EMU
typedef int i32x8 __attribute__((ext_vector_type(8)));
__device__ __forceinline__ i32x8 cat8(const bf16x8 lo, const bf16x8 hi) { u32x4 a, b; __builtin_memcpy(&a, &lo, 16); __builtin_memcpy(&b, &hi, 16); i32x8 r; r[0] = (int)a.x; r[1] = (int)a.y; r[2] = (int)a.z; r[3] = (int)a.w; r[4] = (int)b.x; r[5] = (int)b.y; r[6] = (int)b.z; r[7] = (int)b.w; return r; }
template <int K, class Epi, class Sched, bool FP8 = false>
__device__ __forceinline__ void gemm_phase(LAS unsigned char* lds, const Gemm g, const Sched& S, const Epi& E, int wv) {
    const int tid = opaque_tid(wv), wid = __builtin_amdgcn_readfirstlane(tid >> 6), lane = tid & 63, wr = wid >> 2, wc = wid & 3, fr = lane & 15, fq = lane >> 4;
    constexpr int RB = FP8 ? K : 2 * K;
    constexpr int nt = RB / 128;
    static_assert(nt % 2 == 0 && nt >= 4, "k tiles");
    unsigned voffB[2];
#pragma unroll
    for (int i = 0; i < 2; ++i) { int R, C; stage_rc(tid * 16 + i * 8192, R, C); const int Rb = Epi::PERM ? ((R & ~31) + perm32(R & 31)) : R; voffB[i] = (unsigned)(Rb * RB + C * 2); }
    constexpr size_t kstep = (size_t)(BK * 2);
    constexpr size_t hstep = (size_t)HALF * RB;
    constexpr size_t tstep = 2 * hstep;
    const unsigned ldsw = (unsigned)wid * 1024u;
    const int aoffl = lds_byte(wr * 64 + fr, fq * 8), boffl = lds_byte(wc * 32 + fr, fq * 8);
    unsigned aoff[2][2];
#define G_LOADA(u) do { _Pragma("unroll") for (int _h = 0; _h < 2; ++_h) _Pragma("unroll") for (int _i = 0; _i < 2; ++_i) { int _R, _C; stage_rc(tid * 16 + _i * 8192, _R, _C); const int _r = (u).pm * BM + _h * HALF + _R; \
        const int _s = g.arow ? g.arow[_r] : _r; aoff[_h][_i] = (unsigned)(_s * RB + _C * 2); } } while (0)
#define G_SA(b, h) (((b) * 2 + (h)) * HTB)
#define G_SB(b, h) ((4 + (b) * 2 + (h)) * HTB)
#define G_STAGEB(bufoff, gbase) do { _Pragma("unroll") for (int _i = 0; _i < 2; ++_i) \
        __builtin_amdgcn_global_load_lds((const unsigned*)((const char*)(gbase) + voffB[_i]), (LAS unsigned*)(lds + (bufoff) + ldsw + _i * 8192), 16, 0, 0); } while (0)
#define G_STAGEA(bufoff, kt, h) do { _Pragma("unroll") for (int _i = 0; _i < 2; ++_i) \
        __builtin_amdgcn_global_load_lds((const unsigned*)((const char*)g.A + (size_t)(kt) * kstep + aoff[h][_i]), (LAS unsigned*)(lds + (bufoff) + ldsw + _i * 8192), 16, 0, 0); } while (0)
#define G_LDA(dst, b, h) do { _Pragma("unroll") for (int m = 0; m < 4; ++m) _Pragma("unroll") for (int k = 0; k < 2; ++k) dst[m][k] = *(const LAS bf16x8*)(lds + G_SA(b, h) + aoffl + m * 2048 + k * 1024); } while (0)
#define G_LDB(dst, b, h) do { _Pragma("unroll") for (int n = 0; n < 2; ++n) _Pragma("unroll") for (int k = 0; k < 2; ++k) dst[n][k] = *(const LAS bf16x8*)(lds + G_SB(b, h) + boffl + n * 2048 + k * 1024); } while (0)
#define G_MMA(ai, bj, At, Bt) do { if constexpr (FP8) __builtin_amdgcn_sched_barrier(0); __builtin_amdgcn_s_setprio(1); _Pragma("unroll") for (int m = 0; m < 4; ++m) _Pragma("unroll") for (int n = 0; n < 2; ++n) { \
        if constexpr (FP8) acc[ai][bj][m][n] = __builtin_amdgcn_mfma_scale_f32_16x16x128_f8f6f4(cat8(Bt[n][0], Bt[n][1]), cat8(At[m][0], At[m][1]), acc[ai][bj][m][n], 0, 0, 0, 0x7F7F7F7F, 0, 0x7F7F7F7F); \
        else { _Pragma("unroll") for (int k = 0; k < 2; ++k) acc[ai][bj][m][n] = __builtin_amdgcn_mfma_f32_16x16x32_bf16(Bt[n][k], At[m][k], acc[ai][bj][m][n], 0, 0, 0); } } \
        __builtin_amdgcn_s_setprio(0); if constexpr (FP8) __builtin_amdgcn_sched_barrier(0); } while (0)
#define G_WAIT_V(n) asm volatile("s_waitcnt vmcnt(" #n ")" ::: "memory")
#define G_WAIT_L(n) asm volatile("s_waitcnt lgkmcnt(" #n ")" ::: "memory")
#define G_BAR __builtin_amdgcn_s_barrier()
#define G_SCHED __builtin_amdgcn_sched_barrier(0)
    Unit cur, nxt; int ui = 0;
    if (!S.next(0, cur)) return;
    f32x4 acc[2][2][4][2];
#pragma unroll
    for (int a = 0; a < 2; ++a)
#pragma unroll
        for (int b = 0; b < 2; ++b)
#pragma unroll
            for (int m = 0; m < 4; ++m)
#pragma unroll
                for (int n = 0; n < 2; ++n) acc[a][b][m][n] = (f32x4){0.f, 0.f, 0.f, 0.f};
    bf16x8 At[4][2], B0[2][2], B1[2][2];
    const char* cB = (const char*)g.Bt + (size_t)cur.pnb * tstep;
    G_LOADA(cur);
    G_STAGEB(G_SB(0, 0), cB); G_STAGEA(G_SA(0, 0), 0, 0); G_STAGEB(G_SB(0, 1), cB + hstep); G_STAGEA(G_SA(0, 1), 0, 1);
    if (wr == 1) G_BAR;
    G_WAIT_V(4); G_BAR;
    G_STAGEB(G_SB(1, 0), cB + kstep); G_STAGEA(G_SA(1, 0), 1, 0); G_STAGEB(G_SB(1, 1), cB + hstep + kstep);
    G_WAIT_V(6); G_BAR;
    for (;;) {
        const bool has_next = S.next(ui + 1, nxt);
        const char* nB = has_next ? (const char*)g.Bt + (size_t)nxt.pnb * tstep : cB;
        for (int t = 0; t < nt; t += 2) {
            const bool last = (t == nt - 2);
            const int k2 = last ? 0 : t + 2, k3 = k2 + 1;
            const char* b2 = last ? nB : cB + (size_t)(t + 2) * kstep; const char* b3 = b2 + kstep;
            G_LDB(B0, 0, 0); G_SCHED; G_LDA(At, 0, 0); G_STAGEA(G_SA(1, 1), t + 1, 1);
            if (g.arow && has_next && t == nt - 4 && tid < BM)
                __builtin_amdgcn_global_load_lds((const unsigned*)(g.arow + nxt.pm * BM + tid), (LAS unsigned*)(lds + STAGE_BYTES + wid * 256), 4, 0, 0);
            G_WAIT_L(8); G_BAR; G_WAIT_L(0); G_MMA(0, 0, At, B0); G_BAR; G_SCHED;
            if (last && has_next) {
                if (g.arow) {
#pragma unroll
                    for (int _h = 0; _h < 2; ++_h)
#pragma unroll
                        for (int _i = 0; _i < 2; ++_i) { int _R, _C; stage_rc(tid * 16 + _i * 8192, _R, _C); const int _s = *(LAS const int*)(lds + STAGE_BYTES + (_h * HALF + _R) * 4); aoff[_h][_i] = (unsigned)(_s * RB + _C * 2); }
                } else G_LOADA(nxt);
            }
            G_LDB(B1, 0, 1); G_STAGEB(G_SB(0, 0), b2);
            G_BAR; G_WAIT_L(0); G_MMA(0, 1, At, B1); G_BAR;
            G_LDA(At, 0, 1); G_STAGEA(G_SA(0, 0), k2, 0);
            G_BAR; G_WAIT_L(0); G_MMA(1, 0, At, B0); G_BAR; G_SCHED;
            G_STAGEB(G_SB(0, 1), b2 + hstep);
            G_WAIT_V(6); G_BAR; G_MMA(1, 1, At, B1); G_BAR;
            G_LDB(B0, 1, 0); G_SCHED; G_LDA(At, 1, 0); G_STAGEA(G_SA(0, 1), k2, 1);
            G_WAIT_L(8); G_BAR; G_WAIT_L(0); G_MMA(0, 0, At, B0); G_BAR; G_SCHED;
            G_LDB(B1, 1, 1); G_STAGEB(G_SB(1, 0), b3);
            G_BAR; G_WAIT_L(0); G_MMA(0, 1, At, B1); G_BAR;
            G_LDA(At, 1, 1); G_STAGEA(G_SA(1, 0), k3, 0);
            G_BAR; G_WAIT_L(0); G_MMA(1, 0, At, B0); G_BAR; G_SCHED;
            G_STAGEB(G_SB(1, 1), b3 + hstep);
            G_WAIT_V(6); G_BAR; G_MMA(1, 1, At, B1); G_BAR;
        }
        E(acc, cur, wr, wc, fr, fq);
        if (!has_next) break;
#pragma unroll
        for (int a = 0; a < 2; ++a)
#pragma unroll
            for (int b = 0; b < 2; ++b)
#pragma unroll
                for (int m = 0; m < 4; ++m)
#pragma unroll
                    for (int n = 0; n < 2; ++n) acc[a][b][m][n] = (f32x4){0.f, 0.f, 0.f, 0.f};
        cur = nxt; cB = nB; ++ui;
    }
    G_WAIT_V(0);
    if (wr == 0) G_BAR;
    G_BAR;
}
#else
template <int K, class Epi, class Sched, bool FP8 = false>
__device__ __forceinline__ void gemm_phase(unsigned char* lds, const Gemm g, const Sched& S, const Epi& E, int wv) {
    const int tid = opaque_tid(wv), wid = tid >> 6, lane = tid & 63, wr = wid >> 2, wc = wid & 3, fr = lane & 15, fq = lane >> 4;
    Unit u;
    for (int ui = 0; S.next(ui, u); ++ui) {
        f32x4 acc[2][2][4][2];
        for (int ai = 0; ai < 2; ++ai) for (int bj = 0; bj < 2; ++bj) for (int m = 0; m < 4; ++m) for (int n = 0; n < 2; ++n) for (int j = 0; j < 4; ++j) {
            const int r = u.pm * 256 + 128 * ai + 64 * wr + 16 * m + fr;
            const int cl = Epi::PERM ? (128 * bj + 32 * wc + 8 * fq + 4 * n + j) : (128 * bj + 32 * wc + 16 * n + 4 * fq + j);
            const int ar = g.arow ? g.arow[r] : r;
            float s = 0.f;
            if (FP8) { const unsigned char* a = (const unsigned char*)g.A + (size_t)ar * K; const unsigned char* b = (const unsigned char*)g.Bt + ((size_t)u.pnb * 256 + cl) * K; for (int k = 0; k < K; ++k) s += fp8_to_f(a[k]) * fp8_to_f(b[k]); }
            else { const bf16_t* a = g.A + (size_t)ar * K; const bf16_t* b = g.Bt + ((size_t)u.pnb * 256 + cl) * K; for (int k = 0; k < K; ++k) s += bf2f(a[k]) * bf2f(b[k]); }
            acc[ai][bj][m][n][j] = s;
        }
        E(acc, u, wr, wc, fr, fq);
    }
}
#endif

__device__ __forceinline__ void convert_wt(LAS unsigned char* lds, const float* W, int K, int ldw, int col0, int ncols, bf16_t* Wt, int rowmul, int rowadd, int bid, int nb, int wv) {
    LAS float* t = (LAS float*)lds;
    const int tid = opaque_tid(wv);
    const int tk = K / 64, tn = ncols / 64, ntile = tk * tn;
    const int lr = tid >> 4, c4 = (tid & 15) * 4;
    f32x4 v[2];
    if (bid < ntile) { const int k0 = (bid % tk) * 64, n0 = (bid / tk) * 64;
#pragma unroll
        for (int i = 0; i < 2; ++i) v[i] = *(const f32x4*)(W + (size_t)(k0 + lr + 32 * i) * ldw + col0 + n0 + c4); }
    for (int tile = bid; tile < ntile; tile += nb) {
        const int k0 = (tile % tk) * 64, n0 = (tile / tk) * 64;
        __syncthreads();
#pragma unroll
        for (int i = 0; i < 2; ++i) { const int r = lr + 32 * i; t[r * 65 + c4] = v[i][0]; t[r * 65 + c4 + 1] = v[i][1]; t[r * 65 + c4 + 2] = v[i][2]; t[r * 65 + c4 + 3] = v[i][3]; }
        const int nt2 = tile + nb;
        if (nt2 < ntile) { const int k1 = (nt2 % tk) * 64, n1 = (nt2 / tk) * 64;
#pragma unroll
            for (int i = 0; i < 2; ++i) v[i] = *(const f32x4*)(W + (size_t)(k1 + lr + 32 * i) * ldw + col0 + n1 + c4); }
        __syncthreads();
        { const int c = tid >> 3, k8 = (tid & 7) * 8; const int cc = n0 + c; const int dr = (cc >> 7) * rowmul + (cc & 127) + rowadd;
          u32x4 w; w.x = pack2(t[(k8 + 0) * 65 + c], t[(k8 + 1) * 65 + c]); w.y = pack2(t[(k8 + 2) * 65 + c], t[(k8 + 3) * 65 + c]);
          w.z = pack2(t[(k8 + 4) * 65 + c], t[(k8 + 5) * 65 + c]); w.w = pack2(t[(k8 + 6) * 65 + c], t[(k8 + 7) * 65 + c]);
          *(u32x4*)(Wt + (size_t)dr * K + k0 + k8) = w; }
    }
    __syncthreads();
}

__device__ __forceinline__ void load_row(const float* src, int row, int lane, f32x4 (&v)[4]) {
#pragma unroll
    for (int i = 0; i < 4; ++i) v[i] = *(const f32x4*)(src + (size_t)row * DM + i * 256 + lane * 4);
}
__device__ __forceinline__ void load_row_b(const bf16_t* src, int row, int lane, f32x4 (&v)[4]) {
#pragma unroll
    for (int i = 0; i < 4; ++i) { const u32x2 w = *(const u32x2*)(src + (size_t)row * DM + i * 256 + lane * 4);
        v[i][0] = __uint_as_float(w.x << 16); v[i][1] = __uint_as_float(w.x & 0xffff0000u); v[i][2] = __uint_as_float(w.y << 16); v[i][3] = __uint_as_float(w.y & 0xffff0000u); }
}
__device__ __forceinline__ float row_rstd(const f32x4 (&v)[4]) {
    float s = 0.f;
#pragma unroll
    for (int i = 0; i < 4; ++i) s += v[i][0] * v[i][0] + v[i][1] * v[i][1] + v[i][2] * v[i][2] + v[i][3] * v[i][3];
    s = wave_sum(s);
    return rsqrtf(s * (1.0f / DM) + NORM_EPS);
}
__device__ __forceinline__ void store_row_bf16(bf16_t* dst, int row, int lane, const f32x4 (&v)[4]) {
#pragma unroll
    for (int i = 0; i < 4; ++i) { u32x2 w; w.x = pack2(v[i][0], v[i][1]); w.y = pack2(v[i][2], v[i][3]); *(u32x2*)(dst + (size_t)row * DM + i * 256 + lane * 4) = w; }
}

__device__ __forceinline__ void store_row_fp8(unsigned char* dst, float* scale, int row, int lane, const f32x4 (&v)[4]) {
    float am = 0.f;
#pragma unroll
    for (int i = 0; i < 4; ++i) am = fmaxf(fmaxf(am, fmaxf(fabsf(v[i][0]), fabsf(v[i][1]))), fmaxf(fabsf(v[i][2]), fabsf(v[i][3])));
    am = wave_max(am);
    const float sc = am > 0.f ? am * (1.0f / FP8_TOP) : 1.0f, inv = 1.0f / sc;
#pragma unroll
    for (int i = 0; i < 4; ++i) *(unsigned*)(dst + (size_t)row * DM + i * 256 + lane * 4) = pack4_fp8(v[i][0] * inv, v[i][1] * inv, v[i][2] * inv, v[i][3] * inv);
    if (lane == 0) scale[row] = sc;
}
template <int K, bool NORMS>
__device__ __forceinline__ void quant_rows(KPTR p, LAS unsigned char* lds, const bf16_t* src, unsigned char* dst, float* scl, int nrows, int bid, int nb, int wv) {
    constexpr int NC = K / 512;
    const int tid = opaque_tid(wv), wid = tid >> 6, lane = tid & 63;
    LAS unsigned* nmx = (LAS unsigned*)lds;
    if (NORMS) { if (tid < 2 * NE) nmx[tid] = 0u; __syncthreads(); }
    int row = bid * 8 + wid;
    u32x4 nx[NC];
#pragma unroll
    for (int c = 0; c < NC; ++c) nx[c] = (u32x4){0u, 0u, 0u, 0u};
    if (row < nrows) {
#pragma unroll
        for (int c = 0; c < NC; ++c) nx[c] = *(const u32x4*)(src + (size_t)row * K + (c * 64 + lane) * 8); }
    for (; row < nrows; row += nb * 8) {
        u32x4 cu[NC];
#pragma unroll
        for (int c = 0; c < NC; ++c) cu[c] = nx[c];
        const int rn = row + nb * 8;
        if (rn < nrows) {
#pragma unroll
            for (int c = 0; c < NC; ++c) nx[c] = *(const u32x4*)(src + (size_t)rn * K + (c * 64 + lane) * 8); }
        float am = 0.f, ss = 0.f;
#pragma unroll
        for (int c = 0; c < NC; ++c)
#pragma unroll
            for (int q = 0; q < 4; ++q) { const float lo = __uint_as_float(cu[c][q] << 16), hi = __uint_as_float(cu[c][q] & 0xffff0000u); am = fmaxf(am, fmaxf(fabsf(lo), fabsf(hi))); if (NORMS) ss += lo * lo + hi * hi; }
        am = wave_max(am);
        const float sc = am > 0.f ? am * (1.0f / FP8_TOP) : 1.0f, inv = 1.0f / sc;
#pragma unroll
        for (int c = 0; c < NC; ++c) { u32x2 w;
            w.x = pack4_fp8(__uint_as_float(cu[c][0] << 16) * inv, __uint_as_float(cu[c][0] & 0xffff0000u) * inv, __uint_as_float(cu[c][1] << 16) * inv, __uint_as_float(cu[c][1] & 0xffff0000u) * inv);
            w.y = pack4_fp8(__uint_as_float(cu[c][2] << 16) * inv, __uint_as_float(cu[c][2] & 0xffff0000u) * inv, __uint_as_float(cu[c][3] << 16) * inv, __uint_as_float(cu[c][3] & 0xffff0000u) * inv);
            *(u32x2*)(dst + (size_t)row * K + (c * 64 + lane) * 8) = w; }
        if (lane == 0) scl[row] = sc;
        if (NORMS) { ss = wave_sum(ss); if (lane == 0) LDS_ATOMIC_MAX(nmx + ((row >> 7) & 1) * NE + row / (2 * FFE), __float_as_uint(sqrtf(ss))); }
    }
    if (NORMS) { __syncthreads(); if (tid < 2 * NE) (void)GLOBAL_ATOMIC_MAX(p->ctrl + (tid < NE ? C_GMAX + tid : C_UMAX + tid - NE), nmx[tid]); __syncthreads(); }
}
__device__ __forceinline__ const float* gu_src(KPTR p, int item, int t, int kr, int c4) {
    constexpr int NPAN = FFE / 32;
    const int e = item / (2 * NPAN), r = item % (2 * NPAN), up = r / NPAN, pn = r % NPAN;
    return (up ? p->w_mup : p->w_mgate) + (size_t)e * DM * FFE + (size_t)(t * 64 + kr) * FFE + pn * 32 + c4;
}
__device__ __forceinline__ void convert_gu_fp8(KPTR p, LAS unsigned char* lds, int bid, int nb, int wv) {
    constexpr int PSF = 1028, NPAN = FFE / 32, NITEM = NE * 2 * NPAN, TPI = DM / 64;
    const int tid = opaque_tid(wv), wid = tid >> 6, lane = tid & 63;
    LAS float* pan = (LAS float*)lds;
    LAS float* red = pan + 32 * PSF;
    LAS float* scl = red + 8 * 32 * 2;
    const int c4 = (tid & 7) * 4, kr = tid >> 3;
    const int nmine = bid < NITEM ? (NITEM - bid + nb - 1) / nb : 0, total = nmine * TPI;
    if (nmine == 0) return;
    constexpr int PD = 8;
    static_assert(TPI % PD == 0, "ring");
    f32x4 pf[PD];
#pragma unroll
    for (int i = 0; i < PD; ++i) { const int gi = i < total ? i : total - 1; pf[i] = *(const f32x4*)gu_src(p, bid + (gi / TPI) * nb, gi % TPI, kr, c4); }
    int g = 0;
    for (int it = 0; it < nmine; ++it) {
        const int item = bid + it * nb, e = item / (2 * NPAN), r = item % (2 * NPAN), up = r / NPAN, pn = r % NPAN;
        float am[4] = {0.f, 0.f, 0.f, 0.f}, ss[4] = {0.f, 0.f, 0.f, 0.f};
        for (int t0 = 0; t0 < TPI; t0 += PD) {
#pragma unroll
            for (int u = 0; u < PD; ++u, ++g) { const int t = t0 + u;
                const f32x4 v = pf[u];
                { int gn = g + PD; gn = gn < total ? gn : total - 1; int kr2 = kr; OPAQUE_V(kr2); pf[u] = *(const f32x4*)gu_src(p, bid + (gn / TPI) * nb, gn % TPI, kr2, c4); }
#pragma unroll
                for (int j = 0; j < 4; ++j) { am[j] = fmaxf(am[j], fabsf(v[j])); ss[j] += v[j] * v[j]; pan[(c4 + j) * PSF + t * 64 + kr] = v[j]; }
            }
        }
#pragma unroll
        for (int j = 0; j < 4; ++j) {
#pragma unroll
            for (int o = 8; o <= 32; o <<= 1) { am[j] = fmaxf(am[j], __shfl_xor(am[j], o)); ss[j] += __shfl_xor(ss[j], o); }
        }
        if ((lane >> 3) == 0) {
#pragma unroll
            for (int j = 0; j < 4; ++j) { red[(wid * 32 + c4 + j) * 2] = am[j]; red[(wid * 32 + c4 + j) * 2 + 1] = ss[j]; } }
        __syncthreads();
        if (tid < 64) { float a = 0.f, q = 0.f;
            if (tid < 32) {
#pragma unroll
                for (int w = 0; w < 8; ++w) { a = fmaxf(a, red[(w * 32 + tid) * 2]); q += red[(w * 32 + tid) * 2 + 1]; }
                const float sc = a > 0.f ? a * (1.0f / FP8_TOP) : 1.0f; scl[tid] = sc; scl[32 + tid] = 1.0f / sc;
                const int cc = pn * 32 + tid; p->ws_mgu[(size_t)e * 2 * FFE + (cc >> 7) * 256 + (cc & 127) + up * 128] = sc; }
            const float nm = wave_max(tid < 32 ? sqrtf(q) : 0.f);
            if (tid == 0) (void)GLOBAL_ATOMIC_MAX(p->ctrl + (up ? C_UMAX : C_GMAX) + e, __float_as_uint(nm)); }
        __syncthreads();
#pragma unroll
        for (int i2 = 0; i2 < 8; ++i2) { const int n = i2 * 4 + (tid >> 7), k8 = (tid & 127) * 8, cc = pn * 32 + n;
            const f32x4 a = *(LAS const f32x4*)(pan + n * PSF + k8), b = *(LAS const f32x4*)(pan + n * PSF + k8 + 4); const float inv = scl[32 + n];
            u32x2 w; w.x = pack4_fp8(a[0] * inv, a[1] * inv, a[2] * inv, a[3] * inv); w.y = pack4_fp8(b[0] * inv, b[1] * inv, b[2] * inv, b[3] * inv);
            *(u32x2*)(p->w8_mgu + ((size_t)e * 2 * FFE + (cc >> 7) * 256 + (cc & 127) + up * 128) * DM + k8) = w; }
        __syncthreads();
    }
}
template <bool WITH_GDN, bool OUT8 = false, bool SRCB = false>
__device__ __forceinline__ void phase_norm(KPTR p, const void* src, const float* gain, int bid, int nb, int wv) {
    const int tid = opaque_tid(wv), wid = tid >> 6, lane = tid & 63;
    f32x4 gv[4];
#pragma unroll
    for (int i = 0; i < 4; ++i) gv[i] = *(const f32x4*)(gain + i * 256 + lane * 4);
    f32x4 w8[WITH_GDN ? 16 : 1][2];
    if (WITH_GDN) {
#pragma unroll
        for (int i = 0; i < 4; ++i)
#pragma unroll
            for (int e = 0; e < 4; ++e) { const float* wr_ = p->w_in + (size_t)(i * 256 + lane * 4 + e) * DIN + DINP; w8[i * 4 + e][0] = *(const f32x4*)wr_; w8[i * 4 + e][1] = *(const f32x4*)(wr_ + 4); }
    }
    for (int row = bid * 8 + wid; row < NTOK; row += nb * 8) {
        f32x4 v[4]; if (SRCB) load_row_b((const bf16_t*)src, row, lane, v); else load_row((const float*)src, row, lane, v);
        const float rs = row_rstd(v);
#pragma unroll
        for (int i = 0; i < 4; ++i) v[i] = v[i] * rs * gv[i];
        if (OUT8) store_row_fp8((unsigned char*)p->hn, p->hns, row, lane, v); else store_row_bf16(p->hn, row, lane, v);
        if (WITH_GDN) {
            f32x4 d0 = (f32x4){0.f, 0.f, 0.f, 0.f}, d1 = (f32x4){0.f, 0.f, 0.f, 0.f};
#pragma unroll
            for (int i = 0; i < 4; ++i)
#pragma unroll
                for (int e = 0; e < 4; ++e) { const float xv = v[i][e]; d0 = d0 + w8[i * 4 + e][0] * xv; d1 = d1 + w8[i * 4 + e][1] * xv; }
            float d[8] = {d0[0], d0[1], d0[2], d0[3], d1[0], d1[1], d1[2], d1[3]};
#pragma unroll
            for (int j = 0; j < 8; ++j) d[j] = wave_sum(d[j]);
            if (lane < 4) {
                const float braw = lane == 0 ? d[0] : lane == 1 ? d[1] : lane == 2 ? d[2] : d[3];
                const float araw = lane == 0 ? d[4] : lane == 1 ? d[5] : lane == 2 ? d[6] : d[7];
                p->gbeta[(size_t)row * 4 + lane] = 1.0f / (1.0f + __expf(-braw));
                const float z = araw + p->dt_bias[lane];
                const float sp = z > 20.f ? z : log1pf(__expf(z));
                p->gg[(size_t)row * 4 + lane] = -__expf(p->a_log[lane]) * sp;
            }
        }
    }
}

constexpr int IMG_W = 0, IMG_QD = 17408, IMG_KDT = 34816, IMG_AT = 53248, IMG_U = 62464, IMG_CH = 78848;
__host__ __device__ constexpr int permb(int k) { return (k >> 5) * 64 + ((((k & 15) >> 2) * 8) + (((k >> 4) & 1) * 4) + (k & 3)) * 2; }
__device__ __forceinline__ bf16x8 frag2(LAS const unsigned char* ptr) {
    const u32x2 lo = *(LAS const u32x2*)ptr, hi = *(LAS const u32x2*)(ptr + 32);
    u32x4 w; w.x = lo.x; w.y = lo.y; w.z = hi.x; w.w = hi.y; bf16x8 r; __builtin_memcpy(&r, &w, 16); return r;
}
__device__ __forceinline__ bf16x8 pack8(const f32x4 a, const f32x4 b) {
    u32x4 w; w.x = pack2(a[0], a[1]); w.y = pack2(a[2], a[3]); w.z = pack2(b[0], b[1]); w.w = pack2(b[2], b[3]); bf16x8 r; __builtin_memcpy(&r, &w, 16); return r;
}


#ifndef CPU_EMU
__device__ __forceinline__ void st_wt32(void* p, unsigned v) { __hip_atomic_store((unsigned*)p, v, __ATOMIC_RELAXED, __HIP_MEMORY_SCOPE_AGENT); }
__device__ __forceinline__ void st_wt64(void* p, u32x2 v) { unsigned long long x = ((unsigned long long)v.y << 32) | v.x; __hip_atomic_store((unsigned long long*)p, x, __ATOMIC_RELAXED, __HIP_MEMORY_SCOPE_AGENT); }
#else
static inline void st_wt32(void* p, unsigned v) { *(unsigned*)p = v; }
static inline void st_wt64(void* p, u32x2 v) { *(u32x2*)p = v; }
#endif

#ifndef CPU_EMU
__device__ __forceinline__ void gdn_publish(unsigned* flag, int tid) {
    asm volatile("s_waitcnt vmcnt(0)" ::: "memory");
    __syncthreads();
    if (tid == 0) __hip_atomic_store(flag, 1u, __ATOMIC_RELAXED, __HIP_MEMORY_SCOPE_AGENT);
}
__device__ __forceinline__ void gdn_wait8(const unsigned* flags, int c, int nmax, int lane) {
    const int k = c + (lane & 7); const bool need = k < nmax;
    unsigned spins = 0;
    for (;;) {
        const unsigned v = need ? __hip_atomic_load(flags + k, __ATOMIC_RELAXED, __HIP_MEMORY_SCOPE_AGENT) : 1u;
        if (__all(v != 0u)) break;
        __builtin_amdgcn_s_sleep(4); if (++spins > (1u << 22)) break;
    }
    __builtin_amdgcn_fence(__ATOMIC_ACQUIRE, "agent");
}
__device__ __forceinline__ float ld_coherent(const float* p) { return __uint_as_float(__hip_atomic_load((const unsigned*)p, __ATOMIC_RELAXED, __HIP_MEMORY_SCOPE_AGENT)); }
#else
static inline void gdn_publish(unsigned* flag, int tid) { __syncthreads(); if (tid == 0) __atomic_store_n(flag, 1u, __ATOMIC_SEQ_CST); }
static inline void gdn_wait8(const unsigned* flags, int c, int nmax, int lane) { for (int k = c; k < c + 8 && k < nmax; ++k) while (__atomic_load_n(flags + k, __ATOMIC_SEQ_CST) == 0) emu::yield(); }
static inline float ld_coherent(const float* p) { return *p; }
#endif

template <int I> struct TSolve {
    static __device__ __forceinline__ void run(float (&tc)[64], LAS const float* sL, LAS unsigned char* tb, int lane) {
        TSolve<I - 1>::run(tc, sL, tb, lane);
        float p0 = 0.f, p1 = 0.f, p2 = 0.f, p3 = 0.f;
#pragma unroll
        for (int j = 0; j < I; ++j) { const float pr = sL[I * 68 + j] * tc[j]; if ((j & 3) == 0) p0 += pr; else if ((j & 3) == 1) p1 += pr; else if ((j & 3) == 2) p2 += pr; else p3 += pr; }
        const float t2 = ((I == lane) ? 1.f : 0.f) - ((p0 + p1) + (p2 + p3));
        tc[I] = t2; *(LAS bf16_t*)(tb + I * 144 + 2 * lane) = f2bf(t2);
    }
};
template <> struct TSolve<-1> { static __device__ __forceinline__ void run(float (&)[64], LAS const float*, LAS unsigned char*, int) {} };

template <bool PUBLISH>
__device__ __forceinline__ void phase_gdn_pre(KPTR p, LAS unsigned char* lds, int first, int stride, int wv) {
    constexpr int QB = 0, KB = 17408, VBT = 34816, KBT = 53248, KDT = 71680, LF = 90112, TB = 107520, ATB = 116736, SG = 125952, SBE = 126208;
    const int tid0 = opaque_tid(wv);
    LAS float* sL = (LAS float*)(lds + LF); LAS float* sg = (LAS float*)(lds + SG); LAS float* sb = (LAS float*)(lds + SBE);
    const bf16_t* proj = p->proj; const float* conv_w = p->conv_w; const float* gg = p->gg; const float* gbeta = p->gbeta; unsigned char* gimg = p->gimg; float* gcdec = p->gcdec;
    for (int uu = first; uu < NCHH; uu += stride) {
        int tid = tid0; OPAQUE_V(tid);
        const int wid = tid >> 6, lane = tid & 63, fr = lane & 15, q4 = lane >> 4;
        const int n = uu / (BATCH * 4), bh_ = uu % (BATCH * 4), h = bh_ & 3, b = bh_ >> 2;
        const int unit = bh_ * NCH + n;
        const size_t tok0 = (size_t)b * SEQ + (size_t)n * 64;
        unsigned char* img = gimg + (size_t)unit * IMG_CH;
        __syncthreads();
        if (wid == 0) { float gsum = gg[(tok0 + lane) * 4 + h]; for (int o = 1; o < 64; o <<= 1) { const float t2 = __shfl_up(gsum, o); if (lane >= o) gsum += t2; } sg[lane] = gsum; sb[lane] = gbeta[(tok0 + lane) * 4 + h]; }
        __syncthreads();
        const float glast = sg[63];
        unsigned xall[3][11];
#pragma unroll
        for (int w3 = 0; w3 < 3; ++w3) { const int cc = w3 * 512 + h * 128 + 2 * lane;
#pragma unroll
            for (int r = 0; r < 11; ++r) { const int tt = n * 64 + wid * 8 - 3 + r; xall[w3][r] = tt >= 0 ? *(const unsigned*)(proj + ((size_t)b * SEQ + tt) * DINP + 2048 + cc) : 0u; } }
#pragma unroll
        for (int which = 0; which < 3; ++which) {
            const int rb = wid, c0 = which * 512 + h * 128 + 2 * lane;
            float cw0[4], cw1[4];
#pragma unroll
            for (int kk = 0; kk < 4; ++kk) { cw0[kk] = conv_w[kk * 1536 + c0]; cw1[kk] = conv_w[kk * 1536 + c0 + 1]; }
            unsigned xv[11];
#pragma unroll
            for (int r = 0; r < 11; ++r) xv[r] = xall[which][r];
            float a0[8], a1[8], ss[8];
#pragma unroll
            for (int i8 = 0; i8 < 8; ++i8) { float y0 = 0.f, y1 = 0.f;
#pragma unroll
                for (int kk = 0; kk < 4; ++kk) { y0 += cw0[kk] * __uint_as_float(xv[i8 + kk] << 16); y1 += cw1[kk] * __uint_as_float(xv[i8 + kk] & 0xffff0000u); }
                a0[i8] = siluf(y0); a1[i8] = siluf(y1); ss[i8] = a0[i8] * a0[i8] + a1[i8] * a1[i8]; }
            if (which != 2) {
#pragma unroll
                for (int i8 = 0; i8 < 8; ++i8) ss[i8] = wave_sum(ss[i8]);
            }
#pragma unroll
            for (int i8 = 0; i8 < 8; ++i8) {
                const int i = rb * 8 + i8;
                const float gi = sg[i], bi = sb[i], eg = __expf(gi);
                if (which == 2) {
                    *(LAS bf16_t*)(lds + VBT + (2 * lane) * 144 + 2 * i) = f2bf(a0[i8] * bi); *(LAS bf16_t*)(lds + VBT + (2 * lane + 1) * 144 + 2 * i) = f2bf(a1[i8] * bi);
                } else {
                    const float sc = rsqrtf(ss[i8] + NORM_EPS) * (which == 0 ? 0.08838834764831845f : 1.0f);
                    const float n0 = a0[i8] * sc, n1 = a1[i8] * sc;
                    if (which == 0) { *(LAS unsigned*)(lds + QB + i * 272 + 4 * lane) = pack2(n0, n1); st_wt32(img + IMG_QD + i * 272 + permb(2 * lane), pack2(n0 * eg, n1 * eg)); }
                    else { *(LAS unsigned*)(lds + KB + i * 272 + 4 * lane) = pack2(n0, n1);
                        const float f1 = bi * eg, f2 = __expf(glast - gi);
                        *(LAS bf16_t*)(lds + KBT + (2 * lane) * 144 + 2 * i) = f2bf(n0 * f1); *(LAS bf16_t*)(lds + KBT + (2 * lane + 1) * 144 + 2 * i) = f2bf(n1 * f1);
                        *(LAS bf16_t*)(lds + KDT + (2 * lane) * 144 + permb(i)) = f2bf(n0 * f2); *(LAS bf16_t*)(lds + KDT + (2 * lane + 1) * 144 + permb(i)) = f2bf(n1 * f2); }
                }
            }
        }
        __syncthreads();
        {
            const int mat = wid >> 2, itile = wid & 3;
            LAS const unsigned char* abase = lds + (mat == 0 ? KB : QB) + (16 * itile + fr) * 272 + 16 * q4;
            bf16x8 af[4];
#pragma unroll
            for (int s4 = 0; s4 < 4; ++s4) af[s4] = *(LAS const bf16x8*)(abase + 64 * s4);
#pragma unroll
            for (int nt = 0; nt < 4; ++nt) {
                f32x4 acc = (f32x4){0.f, 0.f, 0.f, 0.f};
                if (nt <= itile) {
#pragma unroll
                    for (int s4 = 0; s4 < 4; ++s4) { const bf16x8 bfr = *(LAS const bf16x8*)(lds + KB + (16 * nt + fr) * 272 + 16 * q4 + 64 * s4);
                        acc = __builtin_amdgcn_mfma_f32_16x16x32_bf16(af[s4], bfr, acc, 0, 0, 0); }
                }
                const int j = 16 * nt + fr; const float gj = sg[j];
#pragma unroll
                for (int r = 0; r < 4; ++r) { const int i = 16 * itile + 4 * q4 + r; const float dec = __expf(sg[i] - gj);
                    if (mat == 0) sL[i * 68 + j] = i > j ? sb[i] * acc[r] * dec : 0.f;
                    else *(LAS bf16_t*)(lds + ATB + i * 144 + permb(j)) = f2bf(i >= j ? acc[r] * dec : 0.f); }
            }
        }
        __syncthreads();
        if (wid == 0) {
            float tc[64];
            TSolve<63>::run(tc, sL, lds + TB, lane);
        } else {
            for (int pc = tid - 64; pc < 1152 + 576; pc += NTHREADS - 64) {
                if (pc < 1152) { const u32x4 v4 = *(LAS const u32x4*)(lds + KDT + pc * 16); u32x2 a; a.x = v4.x; a.y = v4.y; u32x2 c; c.x = v4.z; c.y = v4.w; st_wt64(img + IMG_KDT + pc * 16, a); st_wt64(img + IMG_KDT + pc * 16 + 8, c); }
                else { const u32x4 v4 = *(LAS const u32x4*)(lds + ATB + (pc - 1152) * 16); u32x2 a; a.x = v4.x; a.y = v4.y; u32x2 c; c.x = v4.z; c.y = v4.w; st_wt64(img + IMG_AT + (pc - 1152) * 16, a); st_wt64(img + IMG_AT + (pc - 1152) * 16 + 8, c); }
            }
        }
        __syncthreads();
        {
            const int itile = wid & 3;
            bf16x8 tf[2];
#pragma unroll
            for (int s2 = 0; s2 < 2; ++s2) tf[s2] = *(LAS const bf16x8*)(lds + TB + (16 * itile + fr) * 144 + 16 * q4 + 64 * s2);
#pragma unroll
            for (int nt = 0; nt < 8; ++nt) {
                f32x4 acc = (f32x4){0.f, 0.f, 0.f, 0.f};
                if (wid < 4) {
#pragma unroll
                    for (int s2 = 0; s2 < 2; ++s2) { const bf16x8 bfr = *(LAS const bf16x8*)(lds + VBT + (16 * nt + fr) * 144 + 16 * q4 + 64 * s2);
                        acc = __builtin_amdgcn_mfma_f32_16x16x32_bf16(tf[s2], bfr, acc, 0, 0, 0); }
                    u32x2 w; w.x = pack2(acc[0], acc[1]); w.y = pack2(acc[2], acc[3]);
                    st_wt64(img + IMG_U + ((nt * 4 + itile) * 64 + lane) * 8, w);
                } else {
#pragma unroll
                    for (int s2 = 0; s2 < 2; ++s2) { const bf16x8 afr = *(LAS const bf16x8*)(lds + KBT + (16 * nt + fr) * 144 + 16 * q4 + 64 * s2);
                        acc = __builtin_amdgcn_mfma_f32_16x16x32_bf16(afr, tf[s2], acc, 0, 0, 0); }
                    u32x2 w; w.x = pack2(acc[0], acc[1]); w.y = pack2(acc[2], acc[3]);
                    st_wt64(img + IMG_W + (16 * itile + fr) * 272 + permb(16 * nt + 4 * q4), w);
                }
            }
        }
        if (tid == 0) st_wt32(gcdec + unit, __float_as_uint(__expf(glast)));
        if (PUBLISH) gdn_publish(p->gflag + unit, tid);
    }
}

constexpr int NCW = 2, NLT = NTHREADS - 64 * NCW;
constexpr int STG = 62464 + NCW * 2048;
#define LDF(ptr) (*(LAS const bf16x8*)(ptr))
#define MF16(a, b, c) __builtin_amdgcn_mfma_f32_16x16x32_bf16((a), (b), (c), 0, 0, 0)
__device__ __forceinline__ void scan_store_ot(bf16_t* op, const f32x4 (&ao)[4]) {
#pragma unroll
    for (int it = 0; it < 4; ++it) { u32x2 w; w.x = pack2(ao[it][0], ao[it][1]); w.y = pack2(ao[it][2], ao[it][3]); *(u32x2*)(op + (size_t)(16 * it) * DM) = w; }
}
__device__ __forceinline__ void scan_store_o(bf16_t* op, const f32x4 (&ao)[4], int q4) {
#pragma unroll
    for (int it = 0; it < 4; ++it)
#pragma unroll
        for (int r = 0; r < 4; ++r) op[(size_t)(16 * it + 4 * q4 + r) * DM] = f2bf(ao[it][r]);
}
__device__ __forceinline__ bf16x8 asfrag(const u32x4 v) { bf16x8 r; __builtin_memcpy(&r, &v, 16); return r; }
#define LDR(ptr) (*(LAS const u32x4*)(ptr))
template <bool WAITF>
__device__ __forceinline__ void scan_gdn(KPTR p, LAS unsigned char* lds, int b, int h, int qt, int wv) {
    const unsigned* gflag = p->gflag + (size_t)(b * 4 + h) * NCH;
    const int tid = opaque_tid(wv), wid = tid >> 6, lane = tid & 63, fr = lane & 15, q4 = lane >> 4;
    const unsigned char* gimg = p->gimg; const float* gcdec = p->gcdec + (size_t)(b * 4 + h) * NCH; bf16_t* out = p->hn;
    const bool loader = wid >= NCW;
    const int cw = wid, lt = tid - 64 * NCW;
    f32x4 S[8];
#pragma unroll
    for (int dt = 0; dt < 8; ++dt) S[dt] = (f32x4){0.f, 0.f, 0.f, 0.f};
    constexpr int NLG = NLT / 2;
    constexpr int NPC = 3904 + NCW * 128, NPR = (NPC + NLG - 1) / NLG;
    static_assert(NPR >= 16, "compute waves use R[0..7] and R[8..15] as their two operand batches");
    u32x4 R[NPR];
    float cdv = 0.f;
    constexpr int OUTB = 2 * STG, CDB = OUTB + 8192;
    const int grp = lt >= NLG ? 1 : 0, lg_ = lt - grp * NLG;
    const unsigned char* base = gimg + (size_t)(b * 4 + h) * NCH * IMG_CH;
#define GDN_PREFETCH(nn) do { int _lg = lg_; OPAQUE_V(_lg); const unsigned char* _src = base + (size_t)(nn) * IMG_CH; _Pragma("unroll") for (int _i = 0; _i < NPR; ++_i) { int _pc = _lg + NLG * _i; _pc = _pc < NPC ? _pc : NPC - 1; \
        const int _so = _pc < 3904 ? _pc * 16 : IMG_U + qt * (NCW * 2048) + (_pc - 3904) * 16; R[_i] = *(const u32x4*)(_src + _so); } cdv = ld_coherent(gcdec + (nn)); } while (0)
    int avail = 0;
    if (loader && grp < NCH) { if (WAITF) { gdn_wait8(gflag, 0, NCH, lane); avail = 8; } GDN_PREFETCH(grp); }
    float cd_next = 0.f;
    __syncthreads();
    auto load_step = [&](int nn) {
        if (nn < NCH && (nn & 1) == grp) {
            LAS unsigned char* buf = lds + (nn & 1) * STG;
#pragma unroll
            for (int i = 0; i < NPR; ++i) { int pc = lg_ + NLG * i; pc = pc < NPC ? pc : NPC - 1; *(LAS u32x4*)(buf + pc * 16) = R[i]; }
            if (lg_ == 0) *(LAS float*)(lds + CDB + (nn & 1) * 8) = cdv;
            if (nn + 2 < NCH) { if (WAITF && nn + 2 >= avail) { gdn_wait8(gflag, avail, NCH, lane); avail += 8; } GDN_PREFETCH(nn + 2); }
        }
    };
    auto flush = [&](int n) {
        for (int pc = lg_; pc < NCW * 256; pc += NLG) { const int cwi = pc >> 8, it = (pc >> 6) & 3, ln = pc & 63;
            const u32x2 w = *(LAS const u32x2*)(lds + OUTB + (n & 1) * 4096 + pc * 8);
            *(u32x2*)(out + ((size_t)b * SEQ + (size_t)n * 64 + 16 * it + (ln & 15)) * DM + 512 + h * 128 + 16 * (NCW * qt + cwi) + 4 * (ln >> 4)) = w; }
    };
    auto compute = [&](int n) {

            LAS const unsigned char* buf = lds + (n & 1) * STG;
            const float cd = *(LAS const float*)(lds + CDB + (n & 1) * 8);
            LAS const unsigned char* pw = buf + IMG_W + fr * 272 + 16 * q4;
            LAS const unsigned char* pq = buf + IMG_QD + fr * 272 + 16 * q4;
            LAS const unsigned char* pk = buf + IMG_KDT + fr * 144 + 16 * q4;
            LAS const unsigned char* pa = buf + IMG_AT + fr * 144 + 16 * q4;
            bf16x8 Sb[4];
#pragma unroll
            for (int s4 = 0; s4 < 4; ++s4) Sb[s4] = pack8(S[2 * s4], S[2 * s4 + 1]);
            f32x4 ao[4], av[4];
            u32x2 uu[4];
#pragma unroll
            for (int it = 0; it < 4; ++it) uu[it] = *(LAS const u32x2*)(buf + IMG_U + ((cw * 4 + it) * 64 + lane) * 8);
            u32x4* RA = R; u32x4* RB = R + 8;
#define GDN_LD_WQ(RR, it_) do { _Pragma("unroll") for (int s4 = 0; s4 < 4; ++s4) { RR[s4] = LDR(pw + (16 * (it_)) * 272 + 64 * s4); RR[4 + s4] = LDR(pq + (16 * (it_)) * 272 + 64 * s4); } } while (0)
#define GDN_LD_K(RR, dh_) do { _Pragma("unroll") for (int d2 = 0; d2 < 4; ++d2) _Pragma("unroll") for (int s2 = 0; s2 < 2; ++s2) RR[d2 * 2 + s2] = LDR(pk + (16 * (4 * (dh_) + d2)) * 144 + 64 * s2); } while (0)
#define GDN_MM_WQ(RR, it_) do { av[it_] = (f32x4){0.f, 0.f, 0.f, 0.f}; ao[it_] = (f32x4){0.f, 0.f, 0.f, 0.f}; \
        _Pragma("unroll") for (int s4 = 0; s4 < 4; ++s4) { av[it_] = MF16(asfrag(RR[s4]), Sb[s4], av[it_]); ao[it_] = MF16(Sb[s4], asfrag(RR[4 + s4]), ao[it_]); } } while (0)
#define GDN_MM_K(RR, dh_) do { _Pragma("unroll") for (int d2 = 0; d2 < 4; ++d2) { S[4 * (dh_) + d2] = S[4 * (dh_) + d2] * cd; \
        _Pragma("unroll") for (int s2 = 0; s2 < 2; ++s2) S[4 * (dh_) + d2] = MF16(asfrag(RR[d2 * 2 + s2]), Vb[s2], S[4 * (dh_) + d2]); } } while (0)
            GDN_LD_WQ(RA, 0); SCHED_FENCE();
            GDN_LD_WQ(RB, 1); SCHED_FENCE(); GDN_MM_WQ(RA, 0); SCHED_FENCE();
            GDN_LD_WQ(RA, 2); SCHED_FENCE(); GDN_MM_WQ(RB, 1); SCHED_FENCE();
            GDN_LD_WQ(RB, 3); SCHED_FENCE(); GDN_MM_WQ(RA, 2); SCHED_FENCE();
            GDN_LD_K(RA, 0); SCHED_FENCE(); GDN_MM_WQ(RB, 3); SCHED_FENCE();
#pragma unroll
            for (int it = 0; it < 4; ++it) {
                av[it][0] = __uint_as_float(uu[it].x << 16) - av[it][0]; av[it][1] = __uint_as_float(uu[it].x & 0xffff0000u) - av[it][1];
                av[it][2] = __uint_as_float(uu[it].y << 16) - av[it][2]; av[it][3] = __uint_as_float(uu[it].y & 0xffff0000u) - av[it][3]; }
            bf16x8 Vb[2];
#pragma unroll
            for (int s2 = 0; s2 < 2; ++s2) Vb[s2] = pack8(av[2 * s2], av[2 * s2 + 1]);
            GDN_LD_K(RB, 1); SCHED_FENCE(); GDN_MM_K(RA, 0); SCHED_FENCE();
#pragma unroll
            for (int it = 0; it < 4; ++it)
#pragma unroll
                for (int s2 = 0; s2 < 2; ++s2) R[it * 2 + s2] = LDR(pa + (16 * it) * 144 + 64 * s2);
            SCHED_FENCE(); GDN_MM_K(RB, 1); SCHED_FENCE();
#pragma unroll
            for (int it = 0; it < 4; ++it)
#pragma unroll
                for (int s2 = 0; s2 < 2; ++s2) ao[it] = MF16(Vb[s2], asfrag(R[it * 2 + s2]), ao[it]);
#undef GDN_LD_WQ
#undef GDN_LD_K
#undef GDN_MM_WQ
#undef GDN_MM_K
#pragma unroll
            for (int it = 0; it < 4; ++it) { u32x2 w; w.x = pack2(ao[it][0], ao[it][1]); w.y = pack2(ao[it][2], ao[it][3]); *(LAS u32x2*)(lds + OUTB + (n & 1) * 4096 + ((cw * 4 + it) * 64 + lane) * 8) = w; }
            };
    for (int n = -1; n < NCH; ++n) {
        if (loader) { load_step(n + 1); if (n >= 1 && (n & 1) == grp) flush(n - 1); } else if (n >= 0) compute(n);
        __syncthreads();
    }
    if (loader && grp == 0) flush(NCH - 1);
#undef GDN_PREFETCH
}
constexpr int CG = NCH >= 256 ? 16 : 4, NG = NCH / CG;
template <int MODE>
__device__ __forceinline__ void scan_ret(KPTR p, LAS unsigned char* lds, int b, int h, int qt, int g, int wv) {
    const int n0 = g * CG;
    constexpr int R_Q = 0, R_K = 17408, R_KDT = 34816, R_VT = 53248;
    constexpr int RAT_OFF = 2 * STG;
    const int tid = opaque_tid(wv), wid = tid >> 6, lane = tid & 63, fr = lane & 15, q4 = lane >> 4;
    const bf16_t* proj = p->proj; bf16_t* out = p->hn; float* Lb = p->retL;
    const bool loader = wid >= NCW;
    const int cw = wid, lt = tid - 64 * NCW;
    const float lg = log1pf(-exp2f(-5.0f - (float)h));
    f32x4 S[8];
#pragma unroll
    for (int dt = 0; dt < 8; ++dt) S[dt] = (f32x4){0.f, 0.f, 0.f, 0.f};
    const float rcd = __expf(lg * 64.f), g1 = __expf(lg);
    if (MODE == 1 && !loader) {
        const float gdec = __expf(lg * (float)(64 * CG)); float wgt = 1.f;
        for (int gp = g - 1; gp >= 0; --gp) {
            const f32x4* lp = (const f32x4*)Lb + ((((size_t)(b * 4 + h) * NG + gp) * (8 / NCW) + qt) * NCW + cw) * 8 * 64 + lane;
#pragma unroll
            for (int dt = 0; dt < 8; ++dt) S[dt] = S[dt] + lp[dt * 64] * wgt;
            wgt *= gdec;
        }
    }
    float gi[4];
#pragma unroll
    for (int t4 = 0; t4 < 4; ++t4) gi[t4] = __expf(lg * (float)(16 * t4 + fr));
    constexpr int NLG = NLT / 2, NQG = (1024 + NLG - 1) / NLG, KB_N = 256 - NLG;
    static_assert(NLG >= 128 && NLG <= 256 && KB_N + 32 * NCW <= NLG, "task slots");
    u32x4 R[NQG + 8 < 16 ? 16 : NQG + 8];
    const int grp = lt >= NLG ? 1 : 0, lg_ = lt - grp * NLG;
#define RET_PREFETCH(nn) do { int _l = lg_; OPAQUE_V(_l); const bf16_t* _pq = proj + ((size_t)b * SEQ + (size_t)(n0 + (nn)) * 64) * DINP + h * 128; \
        _Pragma("unroll") for (int _i = 0; _i < NQG; ++_i) { int _pc = _l + NLG * _i; _pc = _pc < 1024 ? _pc : 1023; const int _row = _pc >> 4, _c = _pc & 15; R[_i] = *(const u32x4*)(_pq + (size_t)_row * DINP + _c * 8); } \
        _Pragma("unroll") for (int _r = 0; _r < 4; ++_r) R[NQG + _r] = *(const u32x4*)(_pq + (size_t)(4 * (_l >> 4) + _r) * DINP + 512 + (_l & 15) * 8); \
        { const bool _isk = _l < KB_N; int _v = _l - KB_N; _v = _v < 0 ? 0 : (_v < 32 * NCW ? _v : 32 * NCW - 1); const int _t = NLG + (_isk ? _l : 0); \
          const int _r0 = _isk ? 4 * (_t >> 4) : 4 * (_v >> 2), _co = _isk ? 512 + (_t & 15) * 8 : 1024 + 16 * NCW * qt + (_v & 3) * 8; \
          _Pragma("unroll") for (int _r = 0; _r < 4; ++_r) R[NQG + 4 + _r] = *(const u32x4*)(_pq + (size_t)(_r0 + _r) * DINP + _co); } } while (0)
#define RET_WRITE_K(RB_, t_) do { const int ig = (t_) >> 4, ck = (t_) & 15; float sc[4]; \
        _Pragma("unroll") for (int r = 0; r < 4; ++r) { sc[r] = 0.08838834764831845f * __expf(lg * (float)(63 - 4 * ig - r)); \
            u32x2 a; a.x = R[(RB_) + r].x; a.y = R[(RB_) + r].y; u32x2 c2; c2.x = R[(RB_) + r].z; c2.y = R[(RB_) + r].w; \
            *(LAS u32x2*)(buf + R_K + (4 * ig + r) * 272 + permb(8 * ck)) = a; *(LAS u32x2*)(buf + R_K + (4 * ig + r) * 272 + permb(8 * ck + 4)) = c2; } \
        _Pragma("unroll") for (int e = 0; e < 8; ++e) { const int wsel = e >> 1; float x[4]; \
            _Pragma("unroll") for (int r = 0; r < 4; ++r) x[r] = ((e & 1) ? __uint_as_float(R[(RB_) + r][wsel] & 0xffff0000u) : __uint_as_float(R[(RB_) + r][wsel] << 16)) * sc[r]; \
            u32x2 o; o.x = pack2(x[0], x[1]); o.y = pack2(x[2], x[3]); *(LAS u32x2*)(buf + R_KDT + (8 * ck + e) * 144 + permb(4 * ig)) = o; } } while (0)
    if (loader && grp < CG) RET_PREFETCH(grp);
    __syncthreads();
    auto load_step = [&](int nn) {
        if (nn < CG && (nn & 1) == grp) {
            LAS unsigned char* buf = lds + (nn & 1) * STG; int l2 = lg_; OPAQUE_V(l2);
#pragma unroll
            for (int i = 0; i < NQG; ++i) { int pc = l2 + NLG * i; pc = pc < 1024 ? pc : 1023; const int row = pc >> 4, c = pc & 15;
                u32x2 a; a.x = R[i].x; a.y = R[i].y; u32x2 c2; c2.x = R[i].z; c2.y = R[i].w;
                *(LAS u32x2*)(buf + R_Q + row * 272 + permb(8 * c)) = a; *(LAS u32x2*)(buf + R_Q + row * 272 + permb(8 * c + 4)) = c2; }
            RET_WRITE_K(NQG, l2);
            if (l2 < KB_N) { RET_WRITE_K(NQG + 4, NLG + l2); }
            else if (l2 < KB_N + 32 * NCW) { const int v = l2 - KB_N, igv = v >> 2, cv = v & 3;
#pragma unroll
                for (int e = 0; e < 8; ++e) { const int wsel = e >> 1, sh = 16 * (e & 1);
                    u32x2 o; o.x = ((R[NQG + 4][wsel] >> sh) & 0xffffu) | (((R[NQG + 5][wsel] >> sh) & 0xffffu) << 16); o.y = ((R[NQG + 6][wsel] >> sh) & 0xffffu) | (((R[NQG + 7][wsel] >> sh) & 0xffffu) << 16);
                    *(LAS u32x2*)(buf + R_VT + (8 * cv + e) * 144 + permb(4 * igv)) = o; } }
            if (nn + 2 < CG) RET_PREFETCH(nn + 2);
        }
    };
    auto scores = [&](int n) {
        LAS const unsigned char* buf = lds + (n & 1) * STG;
        const int lw = wid - NCW;
#pragma unroll
        for (int rep = 0; rep < 2; ++rep) {
            const int tl = lw + (NTHREADS / 64 - NCW) * rep;
            if (tl < 12) {
                int it, jt;
                if (tl < 1) { it = 0; jt = 0; } else if (tl < 3) { it = 1; jt = tl - 1; } else if (tl < 6) { it = 2; jt = tl - 3; } else if (tl < 10) { it = 3; jt = tl - 6; } else if (tl == 10) { it = 0; jt = 1; } else { it = 2; jt = 3; }
                f32x4 acc = (f32x4){0.f, 0.f, 0.f, 0.f};
                if (tl < 10) {
                    bf16x8 kf[4], qf[4];
#pragma unroll
                    for (int s4 = 0; s4 < 4; ++s4) { kf[s4] = LDF(buf + R_K + (16 * jt + fr) * 272 + 64 * s4 + 16 * q4); qf[s4] = LDF(buf + R_Q + (16 * it + fr) * 272 + 64 * s4 + 16 * q4); }
#pragma unroll
                    for (int s4 = 0; s4 < 4; ++s4) acc = MF16(kf[s4], qf[s4], acc);
                    const float gi_ = __expf(lg * (float)(16 * it + fr));
#pragma unroll
                    for (int r = 0; r < 4; ++r) { const int j = 16 * jt + 4 * q4 + r, i = 16 * it + fr;
                        acc[r] = i >= j ? acc[r] * gi_ * 0.08838834764831845f * __expf(-lg * (float)j) : 0.f; }
                }
                u32x2 w; w.x = pack2(acc[0], acc[1]); w.y = pack2(acc[2], acc[3]);
                *(LAS u32x2*)(lds + RAT_OFF + (16 * it + fr) * 144 + permb(16 * jt + 4 * q4)) = w;
            }
        }
    };
    f32x4 ot[4];
    bf16x8 Vf[2];
    auto computeA = [&](int n) {
        LAS const unsigned char* buf = lds + (n & 1) * STG;
        LAS const unsigned char* pq = buf + R_Q + fr * 272 + 16 * q4;
        LAS const unsigned char* pk = buf + R_KDT + fr * 144 + 16 * q4;
        bf16x8 Sb[4];
#pragma unroll
        for (int s4 = 0; s4 < 4; ++s4) Sb[s4] = pack8(S[2 * s4], S[2 * s4 + 1]);
#pragma unroll
        for (int s2 = 0; s2 < 2; ++s2) Vf[s2] = LDF(buf + R_VT + (16 * cw + fr) * 144 + 64 * s2 + 16 * q4);
        u32x4* RA = R; u32x4* RB = R + 8;
#define RET_LD_Q(RR, hh_) do { _Pragma("unroll") for (int i2 = 0; i2 < 2; ++i2) _Pragma("unroll") for (int s4 = 0; s4 < 4; ++s4) RR[i2 * 4 + s4] = LDR(pq + (16 * (2 * (hh_) + i2)) * 272 + 64 * s4); } while (0)
#define RET_LD_K(RR, dh_) do { _Pragma("unroll") for (int d2 = 0; d2 < 4; ++d2) _Pragma("unroll") for (int s2 = 0; s2 < 2; ++s2) RR[d2 * 2 + s2] = LDR(pk + (16 * (4 * (dh_) + d2)) * 144 + 64 * s2); } while (0)
#define RET_MM_Q(RR, hh_) do { _Pragma("unroll") for (int i2 = 0; i2 < 2; ++i2) { const int it = 2 * (hh_) + i2; ot[it] = (f32x4){0.f, 0.f, 0.f, 0.f}; \
        _Pragma("unroll") for (int s4 = 0; s4 < 4; ++s4) ot[it] = MF16(Sb[s4], asfrag(RR[i2 * 4 + s4]), ot[it]); \
        const float rd = gi[it] * g1; _Pragma("unroll") for (int r = 0; r < 4; ++r) ot[it][r] *= rd; } } while (0)
#define RET_MM_K(RR, dh_) do { _Pragma("unroll") for (int d2 = 0; d2 < 4; ++d2) { S[4 * (dh_) + d2] = S[4 * (dh_) + d2] * rcd; \
        _Pragma("unroll") for (int s2 = 0; s2 < 2; ++s2) S[4 * (dh_) + d2] = MF16(asfrag(RR[d2 * 2 + s2]), Vf[s2], S[4 * (dh_) + d2]); } } while (0)
        RET_LD_K(RA, 0); SCHED_FENCE();
        RET_LD_K(RB, 1); SCHED_FENCE(); RET_MM_K(RA, 0); SCHED_FENCE();
        if (MODE == 1) {
            RET_LD_Q(RA, 0); SCHED_FENCE(); RET_MM_K(RB, 1); SCHED_FENCE();
            RET_LD_Q(RB, 1); SCHED_FENCE(); RET_MM_Q(RA, 0); SCHED_FENCE();
            RET_MM_Q(RB, 1);
        } else { RET_MM_K(RB, 1); }
#undef RET_LD_Q
#undef RET_LD_K
#undef RET_MM_Q
#undef RET_MM_K
    };
    auto computeB = [&](int n) {
        LAS const unsigned char* pa = lds + RAT_OFF + fr * 144 + 16 * q4;
        R[0] = LDR(pa); R[1] = LDR(pa + 16 * 144); R[2] = LDR(pa + 32 * 144); R[3] = LDR(pa + 32 * 144 + 64); R[4] = LDR(pa + 48 * 144); R[5] = LDR(pa + 48 * 144 + 64);
        SCHED_FENCE();
        ot[0] = MF16(Vf[0], asfrag(R[0]), ot[0]); ot[1] = MF16(Vf[0], asfrag(R[1]), ot[1]);
        ot[2] = MF16(Vf[0], asfrag(R[2]), ot[2]); ot[2] = MF16(Vf[1], asfrag(R[3]), ot[2]);
        ot[3] = MF16(Vf[0], asfrag(R[4]), ot[3]); ot[3] = MF16(Vf[1], asfrag(R[5]), ot[3]);
        scan_store_ot(out + ((size_t)b * SEQ + (size_t)(n0 + n) * 64 + fr) * DM + h * 128 + 16 * (NCW * qt + cw) + 4 * q4, ot);
    };
    for (int n = -1; n < CG; ++n) {
        if (loader) { if (MODE == 1 && n >= 0) scores(n); load_step(n + 1); } else if (n >= 0) computeA(n);
        __syncthreads();
        if (MODE == 1) {
            if (!loader && n >= 0) computeB(n);
            __syncthreads();
        }
    }
    if (MODE == 0 && !loader) {
        f32x4* lp = (f32x4*)Lb + ((((size_t)(b * 4 + h) * NG + g) * (8 / NCW) + qt) * NCW + cw) * 8 * 64 + lane;
#pragma unroll
        for (int dt = 0; dt < 8; ++dt) lp[dt * 64] = S[dt];
    }
#undef RET_PREFETCH
#undef RET_WRITE_K
}
template <int MODE>
__device__ __forceinline__ void scan_ret_full(KPTR p, LAS unsigned char* lds, int b, int h, int g, int wv) {
    constexpr int F_Q = 0, F_K = 17408, F_KDT = 34816, F_VT = 53248, F_RAT = 71680;
    const int n0 = g * CG;
    const int tid = opaque_tid(wv), wid = tid >> 6, lane = tid & 63, fr = lane & 15, q4 = lane >> 4, cw = wid;
    const bf16_t* proj = p->proj; bf16_t* out = p->hn; float* Lb = p->retL;
    const float lg = log1pf(-exp2f(-5.0f - (float)h));
    const float rcd = __expf(lg * 64.f), g1 = __expf(lg);
    f32x4 S[8];
#pragma unroll
    for (int dt = 0; dt < 8; ++dt) S[dt] = (f32x4){0.f, 0.f, 0.f, 0.f};
    if (MODE == 1) {
        const float gdec = __expf(lg * (float)(64 * CG)); float wgt = 1.f;
        for (int gp = g - 1; gp >= 0; --gp) {
            const f32x4* lp = (const f32x4*)Lb + (((size_t)(b * 4 + h) * NG + gp) * 8 + cw) * 8 * 64 + lane;
#pragma unroll
            for (int dt = 0; dt < 8; ++dt) S[dt] = S[dt] + lp[dt * 64] * wgt;
            wgt *= gdec;
        }
    }
    float gi[4];
#pragma unroll
    for (int t4 = 0; t4 < 4; ++t4) gi[t4] = __expf(lg * (float)(16 * t4 + fr));
    u32x4 rq[2], rkv[4];
#define RF_PREFETCH(nn) do { int _l = tid; OPAQUE_V(_l); const bf16_t* _pq = proj + ((size_t)b * SEQ + (size_t)(n0 + (nn)) * 64) * DINP + h * 128; \
        _Pragma("unroll") for (int _i = 0; _i < 2; ++_i) { const int _pc = _l + NTHREADS * _i; rq[_i] = *(const u32x4*)(_pq + (size_t)(_pc >> 4) * DINP + (_pc & 15) * 8); } \
        { const bool _isk = _l < 256; const int _t = _isk ? _l : _l - 256; const int _r0 = 4 * (_t >> 4), _co = (_isk ? 512 : 1024) + (_t & 15) * 8; \
          _Pragma("unroll") for (int _r = 0; _r < 4; ++_r) rkv[_r] = *(const u32x4*)(_pq + (size_t)(_r0 + _r) * DINP + _co); } } while (0)
    auto write_stage = [&]() {
        int l2 = tid; OPAQUE_V(l2);
#pragma unroll
        for (int i = 0; i < 2; ++i) { const int pc = l2 + NTHREADS * i, row = pc >> 4, c = pc & 15;
            u32x2 a; a.x = rq[i].x; a.y = rq[i].y; u32x2 c2; c2.x = rq[i].z; c2.y = rq[i].w;
            *(LAS u32x2*)(lds + F_Q + row * 272 + permb(8 * c)) = a; *(LAS u32x2*)(lds + F_Q + row * 272 + permb(8 * c + 4)) = c2; }
        if (l2 < 256) { const int ig = l2 >> 4, ck = l2 & 15; float sc[4];
#pragma unroll
            for (int r = 0; r < 4; ++r) { sc[r] = 0.08838834764831845f * __expf(lg * (float)(63 - 4 * ig - r));
                u32x2 a; a.x = rkv[r].x; a.y = rkv[r].y; u32x2 c2; c2.x = rkv[r].z; c2.y = rkv[r].w;
                *(LAS u32x2*)(lds + F_K + (4 * ig + r) * 272 + permb(8 * ck)) = a; *(LAS u32x2*)(lds + F_K + (4 * ig + r) * 272 + permb(8 * ck + 4)) = c2; }
#pragma unroll
            for (int e = 0; e < 8; ++e) { const int wsel = e >> 1; float x[4];
#pragma unroll
                for (int r = 0; r < 4; ++r) x[r] = ((e & 1) ? __uint_as_float(rkv[r][wsel] & 0xffff0000u) : __uint_as_float(rkv[r][wsel] << 16)) * sc[r];
                u32x2 o; o.x = pack2(x[0], x[1]); o.y = pack2(x[2], x[3]); *(LAS u32x2*)(lds + F_KDT + (8 * ck + e) * 144 + permb(4 * ig)) = o; }
        } else { const int v = l2 - 256, igv = v >> 4, cv = v & 15;
#pragma unroll
            for (int e = 0; e < 8; ++e) { const int wsel = e >> 1, sh = 16 * (e & 1);
                u32x2 o; o.x = ((rkv[0][wsel] >> sh) & 0xffffu) | (((rkv[1][wsel] >> sh) & 0xffffu) << 16); o.y = ((rkv[2][wsel] >> sh) & 0xffffu) | (((rkv[3][wsel] >> sh) & 0xffffu) << 16);
                *(LAS u32x2*)(lds + F_VT + (8 * cv + e) * 144 + permb(4 * igv)) = o; } }
    };
    auto scores = [&]() {
#pragma unroll
        for (int rep = 0; rep < 2; ++rep) {
            const int tl = wid + 8 * rep;
            if (tl < 12) {
                int it, jt;
                if (tl < 1) { it = 0; jt = 0; } else if (tl < 3) { it = 1; jt = tl - 1; } else if (tl < 6) { it = 2; jt = tl - 3; } else if (tl < 10) { it = 3; jt = tl - 6; } else if (tl == 10) { it = 0; jt = 1; } else { it = 2; jt = 3; }
                f32x4 acc = (f32x4){0.f, 0.f, 0.f, 0.f};
                if (tl < 10) {
                    bf16x8 kf[4], qf[4];
#pragma unroll
                    for (int s4 = 0; s4 < 4; ++s4) { kf[s4] = LDF(lds + F_K + (16 * jt + fr) * 272 + 64 * s4 + 16 * q4); qf[s4] = LDF(lds + F_Q + (16 * it + fr) * 272 + 64 * s4 + 16 * q4); }
#pragma unroll
                    for (int s4 = 0; s4 < 4; ++s4) acc = MF16(kf[s4], qf[s4], acc);
                    const float gi_ = __expf(lg * (float)(16 * it + fr));
#pragma unroll
                    for (int r = 0; r < 4; ++r) { const int j = 16 * jt + 4 * q4 + r, i = 16 * it + fr;
                        acc[r] = i >= j ? acc[r] * gi_ * 0.08838834764831845f * __expf(-lg * (float)j) : 0.f; }
                }
                u32x2 w; w.x = pack2(acc[0], acc[1]); w.y = pack2(acc[2], acc[3]);
                *(LAS u32x2*)(lds + F_RAT + (16 * it + fr) * 144 + permb(16 * jt + 4 * q4)) = w;
            }
        }
    };
    RF_PREFETCH(0);
    __syncthreads();
    write_stage();
    if (CG > 1) RF_PREFETCH(1);
    __syncthreads();
    for (int n = 0; n < CG; ++n) {
        if (MODE == 1) { scores(); __syncthreads(); }
        {
            LAS const unsigned char* pq = lds + F_Q + fr * 272 + 16 * q4;
            LAS const unsigned char* pk = lds + F_KDT + fr * 144 + 16 * q4;
            bf16x8 Sb[4];
#pragma unroll
            for (int s4 = 0; s4 < 4; ++s4) Sb[s4] = pack8(S[2 * s4], S[2 * s4 + 1]);
            bf16x8 Vf[2];
#pragma unroll
            for (int s2 = 0; s2 < 2; ++s2) Vf[s2] = LDF(lds + F_VT + (16 * cw + fr) * 144 + 64 * s2 + 16 * q4);
            u32x4 RA[8], RB[8];
            f32x4 ot[4];
#define RF_LD_Q(RR, hh_) do { _Pragma("unroll") for (int i2 = 0; i2 < 2; ++i2) _Pragma("unroll") for (int s4 = 0; s4 < 4; ++s4) RR[i2 * 4 + s4] = LDR(pq + (16 * (2 * (hh_) + i2)) * 272 + 64 * s4); } while (0)
#define RF_LD_K(RR, dh_) do { _Pragma("unroll") for (int d2 = 0; d2 < 4; ++d2) _Pragma("unroll") for (int s2 = 0; s2 < 2; ++s2) RR[d2 * 2 + s2] = LDR(pk + (16 * (4 * (dh_) + d2)) * 144 + 64 * s2); } while (0)
#define RF_MM_Q(RR, hh_) do { _Pragma("unroll") for (int i2 = 0; i2 < 2; ++i2) { const int it = 2 * (hh_) + i2; ot[it] = (f32x4){0.f, 0.f, 0.f, 0.f}; \
        _Pragma("unroll") for (int s4 = 0; s4 < 4; ++s4) ot[it] = MF16(Sb[s4], asfrag(RR[i2 * 4 + s4]), ot[it]); \
        const float rd = gi[it] * g1; _Pragma("unroll") for (int r = 0; r < 4; ++r) ot[it][r] *= rd; } } while (0)
#define RF_MM_K(RR, dh_) do { _Pragma("unroll") for (int d2 = 0; d2 < 4; ++d2) { S[4 * (dh_) + d2] = S[4 * (dh_) + d2] * rcd; \
        _Pragma("unroll") for (int s2 = 0; s2 < 2; ++s2) S[4 * (dh_) + d2] = MF16(asfrag(RR[d2 * 2 + s2]), Vf[s2], S[4 * (dh_) + d2]); } } while (0)
            RF_LD_K(RA, 0); SCHED_FENCE();
            RF_LD_K(RB, 1); SCHED_FENCE(); RF_MM_K(RA, 0); SCHED_FENCE();
            if (MODE == 1) {
                RF_LD_Q(RA, 0); SCHED_FENCE(); RF_MM_K(RB, 1); SCHED_FENCE();
                RF_LD_Q(RB, 1); SCHED_FENCE(); RF_MM_Q(RA, 0); SCHED_FENCE();
                RF_MM_Q(RB, 1);
                LAS const unsigned char* pa = lds + F_RAT + fr * 144 + 16 * q4;
                RA[0] = LDR(pa); RA[1] = LDR(pa + 16 * 144); RA[2] = LDR(pa + 32 * 144); RA[3] = LDR(pa + 32 * 144 + 64); RA[4] = LDR(pa + 48 * 144); RA[5] = LDR(pa + 48 * 144 + 64);
                SCHED_FENCE();
                ot[0] = MF16(Vf[0], asfrag(RA[0]), ot[0]); ot[1] = MF16(Vf[0], asfrag(RA[1]), ot[1]);
                ot[2] = MF16(Vf[0], asfrag(RA[2]), ot[2]); ot[2] = MF16(Vf[1], asfrag(RA[3]), ot[2]);
                ot[3] = MF16(Vf[0], asfrag(RA[4]), ot[3]); ot[3] = MF16(Vf[1], asfrag(RA[5]), ot[3]);
                scan_store_ot(out + ((size_t)b * SEQ + (size_t)(n0 + n) * 64 + fr) * DM + h * 128 + 16 * cw + 4 * q4, ot);
            } else { RF_MM_K(RB, 1); }
#undef RF_LD_Q
#undef RF_LD_K
#undef RF_MM_Q
#undef RF_MM_K
        }
        __syncthreads();
        if (n + 1 < CG) { write_stage(); if (n + 2 < CG) RF_PREFETCH(n + 2); }
        __syncthreads();
    }
    if (MODE == 0) {
        f32x4* lp = (f32x4*)Lb + (((size_t)(b * 4 + h) * NG + g) * 8 + cw) * 8 * 64 + lane;
#pragma unroll
        for (int dt = 0; dt < 8; ++dt) lp[dt * 64] = S[dt];
    }
#undef RF_PREFETCH
}

__device__ __forceinline__ void phase_ret_local(KPTR p, LAS unsigned char* lds, int bid, int nb, int wv) {
    constexpr int NIT0 = BATCH * 4 * NG;
    for (int it = bid; it < NIT0; it += nb) {
        const int g = it % NG, bh = it / NG;
        __syncthreads();
        scan_ret_full<0>(p, lds, bh >> 2, bh & 3, g, wv);
    }
}
template <bool OVERLAP>
__device__ __forceinline__ void phase_scan(KPTR p, LAS unsigned char* lds, int bid, int nb, int wv) {
    constexpr int QN = 8 / NCW;
    constexpr int G = BATCH * 4;
    constexpr int NUG = ((G + 7) / 8) * 8 * QN;
    for (int unit = bid; unit < NUG; unit += nb) {
        const int xcd = unit & 7, t = unit >> 3, qt = t % QN, bh = (t / QN) * 8 + xcd;
        if (bh >= G) continue;
        __syncthreads();
        for (int rp = 0; rp < RPT_SG; ++rp) scan_gdn<OVERLAP>(p, lds, bh >> 2, bh & 3, qt, wv);
    }
    if (OVERLAP && bid >= NUG) { __syncthreads(); phase_gdn_pre<true>(p, lds, bid - NUG, nb - NUG, wv); }
    constexpr int NIT1 = G * NG;
    const int first = nb > NUG ? NUG : 0, step = nb > NUG ? nb - NUG : nb;
    if (bid >= first) {
        for (int it = bid - first; it < NIT1; it += step) {
            const int g = it % NG, bh = it / NG;
            __syncthreads();
            for (int rp = 0; rp < RPT_SR; ++rp) scan_ret_full<1>(p, lds, bh >> 2, bh & 3, g, wv);
        }
    }
}

__device__ __forceinline__ void phase_gatednorm(KPTR p, int bid, int nb, int wv) {
    const int tid = opaque_tid(wv), wid = tid >> 6, lane = tid & 63;
    const int hh = lane >> 3, c0 = lane * 16;
    const float* nwp = (hh < 4 ? p->ret_norm + hh * 128 : p->gdn_norm + (hh - 4) * 128) + (lane & 7) * 16;
    float nw[16];
#pragma unroll
    for (int i = 0; i < 4; ++i) { const f32x4 t4 = *(const f32x4*)(nwp + 4 * i); nw[4 * i] = t4[0]; nw[4 * i + 1] = t4[1]; nw[4 * i + 2] = t4[2]; nw[4 * i + 3] = t4[3]; }
    const int gcol = (hh < 4 ? 1536 + hh * 128 : 3584 + (hh - 4) * 128) + (lane & 7) * 16;
    for (int t = bid * 8 + wid; t < NTOK; t += nb * 8) {
        bf16_t* o = p->hn + (size_t)t * DM + c0;
        const u32x4 o0 = *(const u32x4*)o, o1 = *(const u32x4*)(o + 8);
        const bf16_t* gp = p->proj + (size_t)t * DINP + gcol;
        const u32x4 g0 = *(const u32x4*)gp, g1 = *(const u32x4*)(gp + 8);
        float a[16], g[16];
#pragma unroll
        for (int i = 0; i < 4; ++i) { a[2 * i] = __uint_as_float(o0[i] << 16); a[2 * i + 1] = __uint_as_float(o0[i] & 0xffff0000u); a[8 + 2 * i] = __uint_as_float(o1[i] << 16); a[8 + 2 * i + 1] = __uint_as_float(o1[i] & 0xffff0000u);
            g[2 * i] = __uint_as_float(g0[i] << 16); g[2 * i + 1] = __uint_as_float(g0[i] & 0xffff0000u); g[8 + 2 * i] = __uint_as_float(g1[i] << 16); g[8 + 2 * i + 1] = __uint_as_float(g1[i] & 0xffff0000u); }
        float ss = 0.f;
#pragma unroll
        for (int i = 0; i < 16; ++i) ss += a[i] * a[i];
        ss += __shfl_xor(ss, 1); ss += __shfl_xor(ss, 2); ss += __shfl_xor(ss, 4);
        const float rs = rsqrtf(ss * (1.0f / 128.f) + NORM_EPS);
        u32x4 w0, w1;
#pragma unroll
        for (int i = 0; i < 4; ++i) { w0[i] = pack2(a[2 * i] * rs * nw[2 * i] * siluf(g[2 * i]), a[2 * i + 1] * rs * nw[2 * i + 1] * siluf(g[2 * i + 1]));
            w1[i] = pack2(a[8 + 2 * i] * rs * nw[8 + 2 * i] * siluf(g[8 + 2 * i]), a[8 + 2 * i + 1] * rs * nw[8 + 2 * i + 1] * siluf(g[8 + 2 * i + 1])); }
        *(u32x4*)o = w0; *(u32x4*)(o + 8) = w1;
    }
}

__device__ __forceinline__ void phase_kmean(KPTR p, LAS unsigned char* lds, int bid, int nb, int wv) {
    const int tid = opaque_tid(wv);
    LAS float* red = (LAS float*)lds;
    const int rg = tid >> 4, c = tid & 15;
    for (int unit = bid; unit < NIT; unit += nb) {
        const int blk = unit % NBLK, h = (unit / NBLK) & 7, b = unit / (NBLK * 8);
        const bf16_t* kp = p->qkv + ((size_t)b * SEQ + (size_t)blk * 256 + rg) * 3072 + 1024 + h * 128 + c * 8;
        float a[8];
#pragma unroll
        for (int j = 0; j < 8; ++j) a[j] = 0.f;
#pragma unroll
        for (int i = 0; i < 8; ++i) { const u32x4 w = *(const u32x4*)(kp + (size_t)(32 * i) * 3072);
            a[0] += __uint_as_float(w.x << 16); a[1] += __uint_as_float(w.x & 0xffff0000u); a[2] += __uint_as_float(w.y << 16); a[3] += __uint_as_float(w.y & 0xffff0000u);
            a[4] += __uint_as_float(w.z << 16); a[5] += __uint_as_float(w.z & 0xffff0000u); a[6] += __uint_as_float(w.w << 16); a[7] += __uint_as_float(w.w & 0xffff0000u); }
        __syncthreads();
#pragma unroll
        for (int j = 0; j < 8; ++j) red[rg * 128 + c * 8 + j] = a[j];
        __syncthreads();
        if (tid < 128) { float s2 = 0.f;
#pragma unroll
            for (int g = 0; g < 32; ++g) s2 += red[g * 128 + tid];
            s2 *= (1.0f / 256.f);
            const bf16_t hi = f2bf(s2);
            p->kmh[(size_t)unit * 128 + tid] = hi; p->kml[(size_t)unit * 128 + tid] = f2bf(s2 - bf2f(hi)); }
    }
}
__device__ __forceinline__ void phase_moba_select(KPTR p, LAS unsigned char* lds, int bid, int nb, int wv) {
    const int tid = opaque_tid(wv), wid = tid >> 6, lane = tid & 63, fr = lane & 15, fq = lane >> 4;
    LAS float* sg = (LAS float*)lds + wid * (16 * 65);
    LAS unsigned* cnt = (LAS unsigned*)(lds + 8 * 16 * 65 * 4);
    LAS unsigned* gbase = cnt + 64;
    const int TPS = SEQ / 128, NU = BATCH * 8 * TPS;
    const bf16_t* qkv = p->qkv; const bf16_t* kmh = p->kmh; const bf16_t* kml = p->kml; unsigned* mcount = p->mcount; unsigned short* mlist = p->mlist; float* part_lse = p->part_lse;
    for (int unit = bid; unit < NU; unit += nb) {
        const int tile = unit % TPS, h = (unit / TPS) & 7, b = unit / (TPS * 8), bh = b * 8 + h;
        const int t0 = tile * 128 + wid * 16, own = (tile * 128) >> 8;
        if (tid < 64) cnt[tid] = 0u;
        if (own > 0) {
            f32x4 acc[GNT];
#pragma unroll
            for (int nt = 0; nt < GNT; ++nt) acc[nt] = (f32x4){0.f, 0.f, 0.f, 0.f};
            const bf16_t* qrow = qkv + ((size_t)b * SEQ + t0 + fr) * 3072 + h * 128 + 8 * fq;
#pragma unroll
            for (int s4 = 0; s4 < 4; ++s4) {
                const bf16x8 a = *(const bf16x8*)(qrow + 32 * s4);
#pragma unroll
                for (int nt = 0; nt < GNT; ++nt) {
                    int blk = 16 * nt + fr; blk = blk < NBLK ? blk : NBLK - 1;
                    const size_t ko = ((size_t)bh * NBLK + blk) * 128 + 32 * s4 + 8 * fq;
                    const bf16x8 b1 = *(const bf16x8*)(kmh + ko), b2 = *(const bf16x8*)(kml + ko);
                    acc[nt] = __builtin_amdgcn_mfma_f32_16x16x32_bf16(a, b1, acc[nt], 0, 0, 0);
                    acc[nt] = __builtin_amdgcn_mfma_f32_16x16x32_bf16(a, b2, acc[nt], 0, 0, 0);
                }
            }
#pragma unroll
            for (int nt = 0; nt < GNT; ++nt)
#pragma unroll
                for (int r = 0; r < 4; ++r) sg[(4 * fq + r) * 65 + 16 * nt + fr] = acc[nt][r];
        }
        __syncthreads();
        int i0 = -1, i1 = -1, i2 = -1; unsigned r0 = 0, r1 = 0, r2 = 0;
        if (lane < 16) {
            float v0 = -3e38f, v1 = -3e38f, v2 = -3e38f;
            for (int j = 0; j < own; ++j) {
                const float g = sg[lane * 65 + j];
                if (g > v0) { v2 = v1; i2 = i1; v1 = v0; i1 = i0; v0 = g; i0 = j; }
                else if (g > v1) { v2 = v1; i2 = i1; v1 = g; i1 = j; }
                else if (g > v2) { v2 = g; i2 = j; }
            }
            if (i0 >= 0) r0 = LDS_ATOMIC_ADD(cnt + i0, 1u);
            if (i1 >= 0) r1 = LDS_ATOMIC_ADD(cnt + i1, 1u);
            if (i2 >= 0) r2 = LDS_ATOMIC_ADD(cnt + i2, 1u);
        }
        __syncthreads();
        if (tid < 64 && tid < own) { const unsigned c = cnt[tid]; if (c > 0u) gbase[tid] = atomicAdd(mcount + bh * NBLK + tid, c); }
        __syncthreads();
        if (lane < 16) {
            const int t = t0 + lane;
            const size_t pb = ((size_t)((size_t)b * SEQ + t) * 8 + h) * 3;
            unsigned short* lst = mlist + (size_t)bh * LTOT;
            if (i0 >= 0) lst[list_off(i0) + gbase[i0] + r0] = (unsigned short)(((unsigned)t << 2) | 0u); else part_lse[pb + 0] = -1e30f;
            if (i1 >= 0) lst[list_off(i1) + gbase[i1] + r1] = (unsigned short)(((unsigned)t << 2) | 1u); else part_lse[pb + 1] = -1e30f;
            if (i2 >= 0) lst[list_off(i2) + gbase[i2] + r2] = (unsigned short)(((unsigned)t << 2) | 2u); else part_lse[pb + 2] = -1e30f;
        }
    }
}

__device__ __forceinline__ void moba_stage_kv(const bf16_t* qkv, LAS unsigned char* Ks, LAS unsigned char* VTs, int b, int h, int j, int tid) {
    OPAQUE_V(tid);
    const bf16_t* kbase = qkv + ((size_t)b * SEQ + (size_t)j * 256) * 3072 + 1024 + h * 128;
    const bf16_t* vbase = kbase + 1024;
#pragma unroll
    for (int i = 0; i < 8; ++i) { const int id = tid + NTHREADS * i, key = id >> 4, c = id & 15;
        *(LAS u32x4*)(Ks + key * KS_STRIDE + c * 16) = *(const u32x4*)(kbase + (size_t)key * 3072 + c * 8); }
#pragma unroll
    for (int i = 0; i < 2; ++i) { const int id = tid + NTHREADS * i, c = (id & 3) | (((id >> 4) & 3) << 2), g = ((id >> 2) & 3) | ((id >> 6) << 2);
        u32x4 r0 = *(const u32x4*)(vbase + (size_t)(4 * g) * 3072 + c * 8), r1 = *(const u32x4*)(vbase + (size_t)(4 * g + 1) * 3072 + c * 8);
        u32x4 r2 = *(const u32x4*)(vbase + (size_t)(4 * g + 2) * 3072 + c * 8), r3 = *(const u32x4*)(vbase + (size_t)(4 * g + 3) * 3072 + c * 8);
#pragma unroll
        for (int e = 0; e < 8; ++e) { const int wsel = e >> 1, sh = 16 * (e & 1);
            const unsigned x0 = (r0[wsel] >> sh) & 0xffffu, x1 = (r1[wsel] >> sh) & 0xffffu, x2 = (r2[wsel] >> sh) & 0xffffu, x3 = (r3[wsel] >> sh) & 0xffffu;
            u32x2 o; o.x = x0 | (x1 << 16); o.y = x2 | (x3 << 16);
            *(LAS u32x2*)(VTs + (8 * c + e) * VT_STRIDE + 8 * g) = o; }
    }
}
struct AttnState { f32x16 o[4]; float m, l; };
template <bool CAUSAL>
__device__ __forceinline__ void attn_block(LAS const unsigned char* Ks, LAS const unsigned char* VTs, const bf16x8 (&qf)[8], float bias0, float slope, int qloc, int wtile, int lane, AttnState& st) {
    const int l31 = lane & 31, h2 = lane >> 5;
    const float scale = 0.08838834764831845f;
#pragma unroll 1
    for (int hf = 0; hf < 2; ++hf) {
        if (CAUSAL && 4 * hf > wtile) break;
        f32x16 sv[4];
#pragma unroll
        for (int kt = 0; kt < 4; ++kt) {
            const int kt4 = 4 * hf + kt;
            f32x16 acc;
#pragma unroll
            for (int r = 0; r < 16; ++r) acc[r] = 0.f;
            if (!CAUSAL || kt4 <= wtile) {
#pragma unroll
                for (int s8 = 0; s8 < 8; ++s8) { const bf16x8 a = *(LAS const bf16x8*)(Ks + (32 * kt4 + l31) * KS_STRIDE + (16 * s8 + 8 * h2) * 2);
                    acc = __builtin_amdgcn_mfma_f32_32x32x16_bf16(a, qf[s8], acc, 0, 0, 0); }
#pragma unroll
                for (int r = 0; r < 16; ++r) { const int kl = 32 * kt4 + (r & 3) + 8 * (r >> 2) + 4 * h2;
                    float v = acc[r] * scale + (bias0 + slope * (float)kl);
                    if (CAUSAL && kt4 == wtile && kl > qloc) v = -1e30f;
                    acc[r] = v; }
            } else {
#pragma unroll
                for (int r = 0; r < 16; ++r) acc[r] = -1e30f;
            }
            sv[kt] = acc;
            SCHED_FENCE();
        }
        float mx = -1e30f;
#pragma unroll
        for (int kt = 0; kt < 4; ++kt)
#pragma unroll
            for (int r = 0; r < 16; ++r) mx = fmaxf(mx, sv[kt][r]);
        mx = fmaxf(mx, __shfl_xor(mx, 32));
        const float mnew = fmaxf(st.m, mx);
        const float alpha = __expf(st.m - mnew);
        st.m = mnew;
        float ls = 0.f;
#pragma unroll
        for (int kt = 0; kt < 4; ++kt)
#pragma unroll
            for (int r = 0; r < 16; ++r) { const float pv = __expf(sv[kt][r] - mnew); sv[kt][r] = pv; ls += pv; }
        st.l = st.l * alpha + ls;
#pragma unroll
        for (int dt = 0; dt < 4; ++dt)
#pragma unroll
            for (int r = 0; r < 16; ++r) st.o[dt][r] *= alpha;
#pragma unroll
        for (int kt = 0; kt < 4; ++kt) {
            const int kt4 = 4 * hf + kt;
            if (CAUSAL && kt4 > wtile) continue;
#pragma unroll
            for (int s2 = 0; s2 < 2; ++s2) {
                u32x4 pw; pw.x = pack2(sv[kt][8 * s2 + 0], sv[kt][8 * s2 + 1]); pw.y = pack2(sv[kt][8 * s2 + 2], sv[kt][8 * s2 + 3]); pw.z = pack2(sv[kt][8 * s2 + 4], sv[kt][8 * s2 + 5]); pw.w = pack2(sv[kt][8 * s2 + 6], sv[kt][8 * s2 + 7]);
                bf16x8 pf; __builtin_memcpy(&pf, &pw, 16);
#pragma unroll
                for (int dt = 0; dt < 4; ++dt) {
                    LAS const unsigned char* vp = VTs + (32 * dt + l31) * VT_STRIDE + (32 * kt4 + 16 * s2 + 4 * h2) * 2;
                    const u32x2 lo = *(LAS const u32x2*)vp, hi = *(LAS const u32x2*)(vp + 16);
                    u32x4 aw; aw.x = lo.x; aw.y = lo.y; aw.z = hi.x; aw.w = hi.y;
                    bf16x8 a; __builtin_memcpy(&a, &aw, 16);
                    st.o[dt] = __builtin_amdgcn_mfma_f32_32x32x16_bf16(a, pf, st.o[dt], 0, 0, 0);
                }
                SCHED_FENCE();
            }
        }
    }
}
__device__ __forceinline__ void load_qfrag(const bf16_t* qrow, int h2, bf16x8 (&qf)[8]) {
#pragma unroll
    for (int s8 = 0; s8 < 8; ++s8) qf[s8] = *(const bf16x8*)(qrow + 16 * s8 + 8 * h2);
}

__device__ __forceinline__ void phase_moba_gather(KPTR p, LAS unsigned char* lds, int bid, int nb, int wv) {
    const int tid = opaque_tid(wv), wid = tid >> 6, lane = tid & 63, l31 = lane & 31, h2 = lane >> 5;
    LAS unsigned char* Ks = lds; LAS unsigned char* VTs = lds + KS_BYTES;
    LAS unsigned* pref = (LAS unsigned*)(lds + KS_BYTES + VT_BYTES);
    LAS unsigned* wsum = pref + NIT + 1;
    const bf16_t* qkv = p->qkv; const unsigned* mcount = p->mcount; const unsigned short* mlist = p->mlist; bf16_t* part_o = p->part_o; float* part_lse = p->part_lse;
    constexpr int IPT = (NIT + NTHREADS - 1) / NTHREADS;
    unsigned loc[IPT]; unsigned tsum = 0;
#pragma unroll
    for (int i = 0; i < IPT; ++i) { const int it = tid * IPT + i; const unsigned c = it < NIT ? mcount[it] : 0u; loc[i] = c ? 1u + 2u * ((c + 255u) >> 8) : 0u; tsum += loc[i]; }
    unsigned inc = tsum;
    for (int o = 1; o < 64; o <<= 1) { const unsigned t2 = __shfl_up(inc, o); if (lane >= o) inc += t2; }
    if (lane == 63) wsum[wid] = inc;
    __syncthreads();
    unsigned wbase = 0;
#pragma unroll
    for (int w = 0; w < 8; ++w) if (w < wid) wbase += wsum[w];
    unsigned run = wbase + inc - tsum;
#pragma unroll
    for (int i = 0; i < IPT; ++i) { const int it = tid * IPT + i; if (it < NIT) pref[it] = run; run += loc[i]; }
    if (tid == NTHREADS - 1) pref[NIT] = run;
    __syncthreads();
    const unsigned C = pref[NIT];
    const unsigned lo = (unsigned)(((unsigned long long)C * (unsigned)bid) / (unsigned)nb), hi = (unsigned)(((unsigned long long)C * (unsigned)(bid + 1)) / (unsigned)nb);
    if (lo >= hi) return;
    int first = 0; { int a = 0, c = NIT; while (c - a > 1) { const int mid = (a + c) >> 1; if (pref[mid] <= lo) a = mid; else c = mid; } first = a; }
    for (int it = first; it < NIT; ++it) {
        const unsigned ps = pref[it], pe = pref[it + 1];
        if (ps >= hi) break;
        if (pe <= lo || pe == ps) continue;
        const unsigned nr = (pe - ps - 1u) >> 1;
        unsigned r_lo = 0; if (lo > ps + 1u) r_lo = (lo - ps - 1u + 1u) >> 1;
        unsigned r_hi = nr; if (hi < ps + 1u + 2u * nr) r_hi = hi > ps + 1u ? (hi - ps - 1u + 1u) >> 1 : 0u;
        if (r_lo >= r_hi) continue;
        const int j = it % NBLK, h = (it / NBLK) & 7, b = it / (NBLK * 8), bh = b * 8 + h;
        const unsigned cnt = mcount[it];
        const unsigned ra = r_lo * 256u, rb = (r_hi * 256u) < cnt ? (r_hi * 256u) : cnt;
        __syncthreads();
        moba_stage_kv(qkv, Ks, VTs, b, h, j, tid);
        __syncthreads();
        const float slope = exp2f(-(float)(h + 1));
        const unsigned short* lst = mlist + (size_t)bh * LTOT + list_off(j);
        unsigned ent_next = 0;
        { const unsigned row = ra + 32u * wid + l31; if (ra + 32u * wid < rb) ent_next = lst[row < rb ? row : (rb - 1)]; }
        for (unsigned r0 = ra + 32u * wid; r0 < rb; r0 += 256u) {
            const unsigned row = r0 + l31; const bool active = row < rb;
            const unsigned ent = ent_next;
            if (r0 + 256u < rb) { const unsigned rn = row + 256u; ent_next = lst[rn < rb ? rn : (rb - 1)]; }
            const int t = (int)(ent >> 2), k = (int)(ent & 3u);
            bf16x8 qf[8]; load_qfrag(qkv + ((size_t)b * SEQ + t) * 3072 + h * 128, h2, qf);
            AttnState st;
#pragma unroll
            for (int dt = 0; dt < 4; ++dt)
#pragma unroll
                for (int r = 0; r < 16; ++r) st.o[dt][r] = 0.f;
            st.m = -1e30f; st.l = 0.f;
            attn_block<false>(Ks, VTs, qf, slope * (float)(256 * j - t), slope, 0, 0, lane, st);
            const float lt = st.l + __shfl_xor(st.l, 32);
            const float inv = 1.0f / lt;
            if (active) {
                const size_t pb = ((size_t)((size_t)b * SEQ + t) * 8 + h) * 3 + k;
                bf16_t* po = part_o + pb * 128;
#pragma unroll
                for (int dt = 0; dt < 4; ++dt)
#pragma unroll
                    for (int g = 0; g < 4; ++g) { u32x2 w; w.x = pack2(st.o[dt][4 * g] * inv, st.o[dt][4 * g + 1] * inv); w.y = pack2(st.o[dt][4 * g + 2] * inv, st.o[dt][4 * g + 3] * inv);
                        *(u32x2*)(po + 32 * dt + 8 * g + 4 * h2) = w; }
                if (h2 == 0) part_lse[pb] = st.m + __logf(lt);
            }
        }
    }
}
__device__ __forceinline__ void phase_moba_own(KPTR p, LAS unsigned char* lds, int bid, int nb, int wv) {
    const int tid = opaque_tid(wv), wid = tid >> 6, lane = tid & 63, l31 = lane & 31, h2 = lane >> 5;
    LAS unsigned char* Ks = lds; LAS unsigned char* VTs = lds + KS_BYTES;
    const bf16_t* qkv = p->qkv; const bf16_t* part_o = p->part_o; const float* part_lse = p->part_lse; bf16_t* out = p->hn;
    for (int it = bid; it < NIT; it += nb) {
        const int j = it % NBLK, h = (it / NBLK) & 7, b = it / (NBLK * 8);
        const float slope = exp2f(-(float)(h + 1));
        const int qloc = 32 * wid + l31, t = j * 256 + qloc;
        bf16x8 qf[8]; load_qfrag(qkv + ((size_t)b * SEQ + t) * 3072 + h * 128, h2, qf);
        __syncthreads();
        moba_stage_kv(qkv, Ks, VTs, b, h, j, tid);
        __syncthreads();
        AttnState st;
#pragma unroll
        for (int dt = 0; dt < 4; ++dt)
#pragma unroll
            for (int r = 0; r < 16; ++r) st.o[dt][r] = 0.f;
        st.m = -1e30f; st.l = 0.f;
        attn_block<true>(Ks, VTs, qf, slope * (float)(-qloc), slope, qloc, wid, lane, st);
        const float lt = st.l + __shfl_xor(st.l, 32);
        const float lse_own = st.m + __logf(lt);
        const size_t pb = ((size_t)((size_t)b * SEQ + t) * 8 + h) * 3;
        const float l0 = part_lse[pb], l1 = part_lse[pb + 1], l2 = part_lse[pb + 2];
        const float M = fmaxf(fmaxf(lse_own, l0), fmaxf(l1, l2));
        const float w_own = __expf(lse_own - M), w0 = __expf(l0 - M), w1 = __expf(l1 - M), w2 = __expf(l2 - M);
        const float Wi = 1.0f / (w_own + w0 + w1 + w2);
        const float c_own = w_own * Wi / lt, c0 = w0 * Wi, c1 = w1 * Wi, c2 = w2 * Wi;
        bf16_t* orow = out + ((size_t)b * SEQ + t) * DM + h * 128;
        const bool v0 = l0 > -1e29f, v1 = l1 > -1e29f, v2 = l2 > -1e29f;
#pragma unroll
        for (int dt = 0; dt < 4; ++dt) {
            u32x2 pw[3][4];
#pragma unroll
            for (int k = 0; k < 3; ++k)
#pragma unroll
                for (int g = 0; g < 4; ++g) pw[k][g] = *(const u32x2*)(part_o + (pb + k) * 128 + 32 * dt + 8 * g + 4 * h2);
#pragma unroll
            for (int g = 0; g < 4; ++g) {
                const int d0 = 32 * dt + 8 * g + 4 * h2;
                float v[4];
#pragma unroll
                for (int e = 0; e < 4; ++e) v[e] = st.o[dt][4 * g + e] * c_own;
#pragma unroll
                for (int k = 0; k < 3; ++k) {
                    const bool vk = k == 0 ? v0 : (k == 1 ? v1 : v2); const float ck = k == 0 ? c0 : (k == 1 ? c1 : c2);
                    const u32x2 w = pw[k][g];
                    const float f0 = __uint_as_float(w.x << 16), f1 = __uint_as_float(w.x & 0xffff0000u), f2 = __uint_as_float(w.y << 16), f3 = __uint_as_float(w.y & 0xffff0000u);
                    v[0] += vk ? ck * f0 : 0.f; v[1] += vk ? ck * f1 : 0.f; v[2] += vk ? ck * f2 : 0.f; v[3] += vk ? ck * f3 : 0.f;
                }
                u32x2 wo; wo.x = pack2(v[0], v[1]); wo.y = pack2(v[2], v[3]);
                *(u32x2*)(orow + d0) = wo;
            }
        }
    }
}

__device__ __forceinline__ void phase_router(KPTR p, LAS unsigned char* lds, int bid, int nb, int wv) {
    const int tid = opaque_tid(wv), wid = tid >> 6, lane = tid & 63;
    LAS unsigned* hist = (LAS unsigned*)lds;
    if (tid < 8) hist[tid] = 0u;
    __syncthreads();
    f32x4 gv[4];
#pragma unroll
    for (int i = 0; i < 4; ++i) gv[i] = *(const f32x4*)(p->ffn_norm + DM + i * 256 + lane * 4);
    const int rpw = (NTOK + nb - 1) / nb, rbeg = bid * rpw, rend = (rbeg + rpw) < NTOK ? (rbeg + rpw) : NTOK;
    f32x4 w8[16][2];
#pragma unroll
    for (int i = 0; i < 4; ++i)
#pragma unroll
        for (int e = 0; e < 4; ++e) { const float* wr_ = p->w_router + (size_t)(i * 256 + lane * 4 + e) * 8; w8[i * 4 + e][0] = *(const f32x4*)wr_; w8[i * 4 + e][1] = *(const f32x4*)(wr_ + 4); }
    for (int row = rbeg + wid; row < rend; row += 8) {
        f32x4 v[4]; load_row_b(p->hb3, row, lane, v);
        const float rs = row_rstd(v);
#pragma unroll
        for (int i = 0; i < 4; ++i) v[i] = v[i] * rs * gv[i];
        store_row_fp8((unsigned char*)p->hn, p->hns, row, lane, v);
        { float ss = 0.f;
#pragma unroll
          for (int i = 0; i < 4; ++i) ss += v[i][0] * v[i][0] + v[i][1] * v[i][1] + v[i][2] * v[i][2] + v[i][3] * v[i][3];
          ss = wave_sum(ss); if (lane == 0) p->hnn2[row] = ss; }
        f32x4 d0 = (f32x4){0.f, 0.f, 0.f, 0.f}, d1 = (f32x4){0.f, 0.f, 0.f, 0.f};
#pragma unroll
        for (int i = 0; i < 4; ++i)
#pragma unroll
            for (int e = 0; e < 4; ++e) { const float xv = v[i][e]; d0 = d0 + w8[i * 4 + e][0] * xv; d1 = d1 + w8[i * 4 + e][1] * xv; }
        float d[8] = {d0[0], d0[1], d0[2], d0[3], d1[0], d1[1], d1[2], d1[3]};
#pragma unroll
        for (int j = 0; j < 8; ++j) d[j] = wave_sum(d[j]);
        int i0 = 0; float m0 = d[0];
#pragma unroll
        for (int j = 1; j < 8; ++j) if (d[j] > m0) { m0 = d[j]; i0 = j; }
        int i1 = -1; float m1 = -3e38f;
#pragma unroll
        for (int j = 0; j < 8; ++j) if (j != i0 && d[j] > m1) { m1 = d[j]; i1 = j; }
        if (lane == 0) {
            const float e1 = __expf(m1 - m0); const float g0 = 1.0f / (1.0f + e1);
            p->midx[row * 2] = i0; p->midx[row * 2 + 1] = i1; p->mgate[row * 2] = g0; p->mgate[row * 2 + 1] = e1 * g0;
            LDS_ATOMIC_ADD(hist + i0, 1u); LDS_ATOMIC_ADD(hist + i1, 1u);
        }
    }
    __syncthreads();
    if (tid < 8) p->wghist[bid * 8 + tid] = hist[tid];
}
__device__ __forceinline__ void phase_slots(KPTR p, LAS unsigned char* lds, int bid, int nb, int wv) {
    const int tid = opaque_tid(wv);
    LAS unsigned* ltot = (LAS unsigned*)lds; LAS unsigned* lpre = ltot + 8; LAS unsigned* lcur = ltot + 16;
    if (tid < 24) ltot[tid] = 0u;
    __syncthreads();
    { const int e = tid & 7; unsigned tot = 0, pre = 0;
      for (int bb = tid >> 3; bb < nb; bb += NTHREADS / 8) { const unsigned v = p->wghist[bb * 8 + e]; tot += v; if (bb < bid) pre += v; }
      LDS_ATOMIC_ADD(ltot + e, tot); LDS_ATOMIC_ADD(lpre + e, pre); }
    __syncthreads();
    unsigned base[NE], cnt[NE]; unsigned acc = 0; float gu[NE];
#pragma unroll
    for (int e = 0; e < NE; ++e) { cnt[e] = ltot[e]; base[e] = acc; acc += (cnt[e] + 255u) & ~255u; gu[e] = __uint_as_float(p->ctrl[C_GMAX + e]) * __uint_as_float(p->ctrl[C_UMAX + e]); }
    const int rpw = (NTOK + nb - 1) / nb, rbeg = bid * rpw, rend = (rbeg + rpw) < NTOK ? (rbeg + rpw) : NTOK;
    for (int a = rbeg * 2 + tid; a < rend * 2; a += NTHREADS) {
        const int e = p->midx[a];
        unsigned b0 = 0;
#pragma unroll
        for (int j = 0; j < NE; ++j) if (j == e) b0 = base[j];
        const unsigned s = b0 + lpre[e] + LDS_ATOMIC_ADD(lcur + e, 1u);
        p->slot_of[a] = (int)s; p->arow[s] = a >> 1; p->sslot[s] = p->hns[a >> 1];
        float gm = 0.f;
#pragma unroll
        for (int j = 0; j < NE; ++j) if (j == e) gm = gu[j];
        p->shs[s] = p->hnn2[a >> 1] * gm * (1.0f / 256.f);
    }
    if (bid == 0) {
        if (tid == 0) { p->ctrl[C_NTILES] = acc >> 8; p->ctrl[C_TB + NE] = acc >> 8; }
        if (tid < NE) { unsigned bb = 0;
#pragma unroll
            for (int e = 0; e < NE; ++e) if (e == tid) bb = base[e];
            p->ctrl[C_TB + tid] = bb >> 8; }
#pragma unroll
        for (int e = 0; e < NE; ++e) {
            const unsigned lo = base[e] + cnt[e], hi = base[e] + ((cnt[e] + 255u) & ~255u);
            for (unsigned s2 = lo + tid; s2 < hi; s2 += NTHREADS) { p->arow[s2] = 0; p->sslot[s2] = 0.f; p->shs[s2] = 1.0f; }
            for (unsigned t = (base[e] >> 8) + tid; t < (hi >> 8); t += NTHREADS) p->tile_e[t] = e;
        }
    }
}
__device__ __forceinline__ void phase_final(KPTR p, const bf16_t* hsrc, int lo, int hi, int bid, int nb, int wv) {
    const int tid = opaque_tid(wv), wid = tid >> 6, lane = tid & 63;
    f32x4 gv[4];
#pragma unroll
    for (int i = 0; i < 4; ++i) gv[i] = *(const f32x4*)(p->final_norm + i * 256 + lane * 4);
    int sl0 = 0, sl1 = 0; float ga0 = 0.f, ga1 = 0.f;
    { const int row = lo + bid * 8 + wid; if (row < hi) { sl0 = p->slot_of[row * 2]; sl1 = p->slot_of[row * 2 + 1]; ga0 = p->mgate[row * 2]; ga1 = p->mgate[row * 2 + 1]; } }
    for (int row = lo + bid * 8 + wid; row < hi; row += nb * 8) {
        const int s0 = sl0, s1 = sl1; const float g0 = ga0, g1 = ga1;
        u32x2 y0[4], y1[4];
#pragma unroll
        for (int i = 0; i < 4; ++i) { y0[i] = *(const u32x2*)(p->yslot + (size_t)s0 * DM + i * 256 + lane * 4); y1[i] = *(const u32x2*)(p->yslot + (size_t)s1 * DM + i * 256 + lane * 4); }
        f32x4 v[4]; load_row_b(hsrc, row, lane, v);
        { const int rn = row + nb * 8; if (rn < hi) { sl0 = p->slot_of[rn * 2]; sl1 = p->slot_of[rn * 2 + 1]; ga0 = p->mgate[rn * 2]; ga1 = p->mgate[rn * 2 + 1]; } }
#pragma unroll
        for (int i = 0; i < 4; ++i) {
            v[i][0] += g0 * __uint_as_float(y0[i].x << 16) + g1 * __uint_as_float(y1[i].x << 16); v[i][1] += g0 * __uint_as_float(y0[i].x & 0xffff0000u) + g1 * __uint_as_float(y1[i].x & 0xffff0000u);
            v[i][2] += g0 * __uint_as_float(y0[i].y << 16) + g1 * __uint_as_float(y1[i].y << 16); v[i][3] += g0 * __uint_as_float(y0[i].y & 0xffff0000u) + g1 * __uint_as_float(y1[i].y & 0xffff0000u); }
        const float rs = row_rstd(v);
#pragma unroll
        for (int i = 0; i < 4; ++i) *(f32x4*)(p->out + (size_t)row * DM + i * 256 + lane * 4) = v[i] * rs * gv[i];
    }
}


#ifndef CPU_EMU
#define XB_TMO      128
#define XB_XCNT(j)  (256  + 64 * (j))
#define XB_XSUB(j)  (1280 + 64 * (j))
#define XB_XGEN(j)  (2304 + 64 * (j))
#define XB_TOP      3328
#define XB_TOPGEN   3392
#define XCD_BAR_WORDS 3456
#define XB_SPIN_CAP (1u << 20)
__device__ __forceinline__ unsigned xb_ld(unsigned* p) { return __hip_atomic_load(p, __ATOMIC_RELAXED, __HIP_MEMORY_SCOPE_AGENT); }
__device__ __forceinline__ unsigned xb_add(unsigned* p, unsigned v) { return __hip_atomic_fetch_add(p, v, __ATOMIC_RELAXED, __HIP_MEMORY_SCOPE_AGENT); }
__device__ __forceinline__ unsigned xb_xcc_id() { return (unsigned)__builtin_amdgcn_s_getreg((3 << 11) | 20) & 0xFu; }
#define XB_SPIN(cond, bar) do { unsigned _sp = 0; while (cond) { __builtin_amdgcn_s_sleep(1); \
    if ((++_sp & 255u) == 0u) { if (xb_ld(&(bar)[XB_TMO])) break; if (_sp > XB_SPIN_CAP) { atomicAdd(&(bar)[XB_TMO], 1u); break; } } } } while (0)
__device__ __forceinline__ void xcd_barrier_post(unsigned* bar, int tid) { if (tid == 0) (void)xb_add(&bar[XB_XCNT(xb_xcc_id())], 1u); }
__device__ __forceinline__ void xcd_barrier_complete(unsigned* bar, unsigned x, unsigned& nloc, unsigned& nx) {
    const unsigned G = gridDim.x * gridDim.y * gridDim.z;
    unsigned sum, cnt, mine, sp = 0u;
    for (;;) {
        sum = 0u; cnt = 0u; mine = 0u;
#pragma unroll
        for (unsigned j = 0; j < 16; ++j) { const unsigned c = xb_ld(&bar[XB_XCNT(j)]); sum += c; cnt += (c > 0u) ? 1u : 0u; mine = (j == x) ? c : mine; }
        if (sum == G) break;
        __builtin_amdgcn_s_sleep(1);
        if ((++sp & 255u) == 0u) { if (xb_ld(&bar[XB_TMO])) break; if (sp > XB_SPIN_CAP) { atomicAdd(&bar[XB_TMO], 1u); break; } }
    }
    nloc = mine > 0u ? mine : 1u; nx = cnt > 0u ? cnt : 1u;
}
__device__ __forceinline__ void xcd_barrier(unsigned* bar, volatile LAS unsigned* st, int tid) {
    asm volatile("s_waitcnt vmcnt(0)" ::: "memory");
    __syncthreads();
    if (tid == 0) {
        __builtin_amdgcn_s_waitcnt(0);
        const unsigned x = xb_xcc_id();
        unsigned nloc = st[0], nx = st[1];
        if (nloc == 0u) { xcd_barrier_complete(bar, x, nloc, nx); st[0] = nloc; st[1] = nx; }
        const unsigned old = xb_add(&bar[XB_XSUB(x)], 1u);
        const unsigned gen = old / nloc;
        if (old + 1u == (gen + 1u) * nloc) {
            __builtin_amdgcn_fence(__ATOMIC_RELEASE, "agent");
            asm volatile("s_waitcnt vmcnt(0)" ::: "memory");
            const unsigned og = xb_add(&bar[XB_TOP], 1u);
            const unsigned tg = og / nx;
            if (og + 1u == (tg + 1u) * nx) xb_add(&bar[XB_TOPGEN], 1u);
            else XB_SPIN(xb_ld(&bar[XB_TOPGEN]) == tg, bar);
            __builtin_amdgcn_fence(__ATOMIC_ACQUIRE, "agent");
            xb_add(&bar[XB_XGEN(x)], 1u);
            asm volatile("s_waitcnt vmcnt(0)" ::: "memory");
        } else {
            XB_SPIN(xb_ld(&bar[XB_XGEN(x)]) == gen, bar);
            __builtin_amdgcn_fence(__ATOMIC_ACQUIRE, "agent");
            asm volatile("s_waitcnt vmcnt(0)" ::: "memory");
        }
    }
    __syncthreads();
}
#define GRID_BARRIER() do { unsigned* _bar = p->bar; xcd_barrier(_bar, (volatile LAS unsigned*)(lds + kDynLds - 16), opaque_tid(wv)); } while (0)
#else
#define XCD_BAR_WORDS 3456
#define GRID_BARRIER() emu::grid_sync()
#endif

#ifndef CPU_EMU
extern __shared__ __attribute__((aligned(16))) unsigned char smem_raw[];
#define GET_LDS() ((LAS unsigned char*)smem_raw)
#else
#define GET_LDS() (emu::blk->smem)
#endif

__global__ void __launch_bounds__(NTHREADS) fwd_megakernel(Params p_arg) {
    cg::grid_group grid = cg::this_grid();
    KPTR p = KARG_PTR(p_arg);
    LAS unsigned char* lds = GET_LDS();
#ifndef CPU_EMU
    const int wv = __builtin_amdgcn_readfirstlane((int)(threadIdx.x >> 6));
#else
    const int wv = 0;
#endif
    const int bid = blockIdx.x, nb = gridDim.x, tid = opaque_tid(wv);
#ifndef CPU_EMU
    if (tid == 0) { volatile LAS unsigned* st = (volatile LAS unsigned*)(lds + kDynLds - 16); st[0] = 0u; st[1] = 0u; }
    __syncthreads();
    xcd_barrier_post(p->bar, tid);
#endif
    LAUNDER(p);
    if (bid == 0 && tid < 256) p->ctrl[tid] = 0u;
    for (int i = bid * NTHREADS + tid; i < NIT; i += nb * NTHREADS) p->mcount[i] = 0u;
    for (int i = bid * NTHREADS + tid; i < NCHH; i += nb * NTHREADS) p->gflag[i] = 0u;
    convert_wt(lds, p->w_in, DM, DIN, 0, DINP, p->wt_in, 128, 0, bid, nb, wv);
    convert_wt(lds, p->w_out0, DM, DM, 0, DM, p->wt_out0, 128, 0, bid, nb, wv);
    convert_wt(lds, p->w_gate0, DM, FF, 0, FF, p->wt_gu0, 256, 0, bid, nb, wv);
    convert_wt(lds, p->w_up0, DM, FF, 0, FF, p->wt_gu0, 256, 128, bid, nb, wv);
    convert_wt(lds, p->w_down0, FF, DM, 0, DM, p->wt_d0, 128, 0, bid, nb, wv);
    convert_wt(lds, p->w_qkv, DM, 3072, 0, 3072, p->wt_qkv, 128, 0, bid, nb, wv);
    convert_wt(lds, p->w_out1, DM, DM, 0, DM, p->wt_out1, 128, 0, bid, nb, wv);
    phase_norm<true>(p, p->x, p->mix_norm, bid, nb, wv);
    if (p->pad0 != 0) grid.sync(); else GRID_BARRIER();
    LAUNDER(p);
    for (int rp = 0; rp < RPT_GEMM; ++rp) { StaticOrder so; so.init(NTOK / 256, DINP / 256, nb, bid); Gemm g{p->hn, p->wt_in, nullptr}; EpiBf16 e{p->proj, DINP, 0}; gemm_phase<DM>(lds, g, so, e, wv); }
    GRID_BARRIER();
    LAUNDER(p);
    constexpr int NUG_ = ((BATCH * 4 + 7) / 8) * 8 * (8 / NCW);
    const bool overlap = nb >= NUG_ + 32;
    if (!overlap) phase_gdn_pre<false>(p, lds, bid, nb, wv);
    phase_ret_local(p, lds, bid, nb, wv);
    GRID_BARRIER();
    LAUNDER(p);
    if (overlap) phase_scan<true>(p, lds, bid, nb, wv); else phase_scan<false>(p, lds, bid, nb, wv);
    GRID_BARRIER();
    LAUNDER(p);
    phase_gatednorm(p, bid, nb, wv);
    GRID_BARRIER();
    LAUNDER(p);
    { StaticOrder so; so.init(NTOK / 256, DM / 256, nb, bid); Gemm g{p->hn, p->wt_out0, nullptr}; EpiResBf16<true> e{p->x, nullptr, p->hb}; gemm_phase<DM>(lds, g, so, e, wv); }
    GRID_BARRIER();
    LAUNDER(p);
#if FP8_FFN0
    phase_norm<false, true, true>(p, p->hb, p->ffn_norm, bid, nb, wv);
    quant_rows<DM, false>(p, lds, p->wt_gu0, p->w8_gu0, p->ws_gu0, 2 * FF, bid, nb, wv);
#else
    phase_norm<false, false, true>(p, p->hb, p->ffn_norm, bid, nb, wv);
#endif
    GRID_BARRIER();
    LAUNDER(p);
#if FP8_FFN0
    for (int rp = 0; rp < RPT_GEMM; ++rp) { StaticOrder so; so.init(NTOK / 256, 2 * FF / 256, nb, bid); Gemm g{p->hn, (const bf16_t*)p->w8_gu0, nullptr}; EpiSwigluS e{p->act0, FF, 0, p->hns, p->ws_gu0}; gemm_phase<DM, EpiSwigluS, StaticOrder, true>(lds, g, so, e, wv); }
#else
    for (int rp = 0; rp < RPT_GEMM; ++rp) { StaticOrder so; so.init(NTOK / 256, 2 * FF / 256, nb, bid); Gemm g{p->hn, p->wt_gu0, nullptr}; EpiSwiglu e{p->act0, FF, 0}; gemm_phase<DM>(lds, g, so, e, wv); }
#endif
    GRID_BARRIER();
    LAUNDER(p);
    { StaticOrder so; so.init(NTOK / 256, DM / 256, nb, bid); Gemm g{p->act0, p->wt_d0, nullptr}; EpiResBf16<false> e{nullptr, p->hb, p->hb}; gemm_phase<FF>(lds, g, so, e, wv); }
    GRID_BARRIER();
    LAUNDER(p);
    phase_norm<false, false, true>(p, p->hb, p->mix_norm + DM, bid, nb, wv);
    GRID_BARRIER();
    LAUNDER(p);
    for (int rp = 0; rp < RPT_GEMM; ++rp) { StaticOrder so; so.init(NTOK / 256, 3072 / 256, nb, bid); Gemm g{p->hn, p->wt_qkv, nullptr}; EpiBf16 e{p->qkv, 3072, 0}; gemm_phase<DM>(lds, g, so, e, wv); }
    GRID_BARRIER();
    LAUNDER(p);
    phase_kmean(p, lds, bid, nb, wv);
    GRID_BARRIER();
    LAUNDER(p);
    phase_moba_select(p, lds, bid, nb, wv);
    GRID_BARRIER();
    LAUNDER(p);
    for (int rp = 0; rp < RPT_MG; ++rp) phase_moba_gather(p, lds, bid, nb, wv);
    GRID_BARRIER();
    LAUNDER(p);
    for (int rp = 0; rp < RPT_MO; ++rp) phase_moba_own(p, lds, bid, nb, wv);
    GRID_BARRIER();
    LAUNDER(p);
    convert_gu_fp8(p, lds, bid, nb, wv);
    for (int rp = 0; rp < RPT_CONV; ++rp) for (int e = 0; e < NE; ++e) {
        convert_wt(lds, p->w_mdown + (size_t)e * FFE * DM, FFE, DM, 0, DM, p->wt_md_tmp + (size_t)e * DM * FFE, 128, 0, bid, nb, wv);
    }
    { StaticOrder so; so.init(NTOK / 256, DM / 256, nb, bid); Gemm g{p->hn, p->wt_out1, nullptr}; EpiResBf16<false> e{nullptr, p->hb, p->hb3}; gemm_phase<DM>(lds, g, so, e, wv); }
    GRID_BARRIER();
    LAUNDER(p);
    phase_router(p, lds, bid, nb, wv);
    quant_rows<FFE, false>(p, lds, p->wt_md_tmp, p->w8_md, p->ws_md, NE * DM, bid, nb, wv);
    GRID_BARRIER();
    LAUNDER(p);
    phase_slots(p, lds, bid, nb, wv);
    GRID_BARRIER();
    LAUNDER(p);
    {
        const int ntiles = (int)p->ctrl[C_NTILES];
        const int npass = (ntiles + p->tiles_per_pass - 1) / p->tiles_per_pass;
        const int tpp = npass > 0 ? (ntiles + npass - 1) / npass : 1;
        const size_t mbuf = (size_t)p->tiles_per_pass * 256 * FFE; int q = 0;
        for (int t0 = 0; t0 < ntiles; t0 += tpp, ++q) {
            const int nM = (ntiles - t0) < tpp ? (ntiles - t0) : tpp;
            unsigned char* mb = (unsigned char*)p->mact + (size_t)(q & 1) * mbuf;
            for (int rp = 0; rp < RPT_GEMM; ++rp) { MoeOrder mo; mo.init(t0, nM, 2 * FFE / 256, p->tile_e, nb, bid); Gemm g{p->hn, (const bf16_t*)p->w8_mgu, p->arow}; EpiSwigluS8 e{mb, FFE, t0 * 256, p->sslot, p->ws_mgu, p->shs}; gemm_phase<DM, EpiSwigluS8, MoeOrder, true>(lds, g, mo, e, wv); }
            GRID_BARRIER();
            for (int rp = 0; rp < RPT_GEMM; ++rp) { MoeOrder mo; mo.init(t0, nM, DM / 256, p->tile_e, nb, bid); Gemm g{(const bf16_t*)((const unsigned char*)mb - (size_t)t0 * 256 * FFE), (const bf16_t*)p->w8_md, nullptr}; EpiBf16S e{p->yslot, DM, p->shs, p->ws_md}; gemm_phase<FFE, EpiBf16S, MoeOrder, true>(lds, g, mo, e, wv); }
        }
        GRID_BARRIER();
    }
    LAUNDER(p);
    phase_final(p, p->hb3, 0, NTOK, bid, nb, wv);
}

static inline size_t al256(size_t x) { return (x + 255) & ~(size_t)255; }

extern "C" void kernel_launch(void* const* d_in, const int* in_sizes, int n_in, void* d_out, int out_size, void* d_ws, size_t ws_size, hipStream_t stream) {
    Params p; memset(&p, 0, sizeof(p));
    p.x = (const float*)d_in[0]; p.mix_norm = (const float*)d_in[1]; p.ffn_norm = (const float*)d_in[2]; p.w_in = (const float*)d_in[3]; p.conv_w = (const float*)d_in[4];
    p.a_log = (const float*)d_in[5]; p.dt_bias = (const float*)d_in[6]; p.ret_norm = (const float*)d_in[7]; p.gdn_norm = (const float*)d_in[8]; p.w_out0 = (const float*)d_in[9];
    p.w_qkv = (const float*)d_in[10]; p.w_out1 = (const float*)d_in[11]; p.w_gate0 = (const float*)d_in[12]; p.w_up0 = (const float*)d_in[13]; p.w_down0 = (const float*)d_in[14];
    p.w_router = (const float*)d_in[15]; p.w_mgate = (const float*)d_in[16]; p.w_mup = (const float*)d_in[17]; p.w_mdown = (const float*)d_in[18]; p.final_norm = (const float*)d_in[19];
    p.out = (float*)d_out; p.hb = (bf16_t*)((unsigned char*)d_out + (size_t)NTOK * DM * 2);
    unsigned char* w = (unsigned char*)d_ws; size_t off = 0;
    auto take = [&](size_t bytes) { unsigned char* r = w + off; off += al256(bytes); return r; };
    p.ctrl = (unsigned*)take(4096); p.bar = (unsigned*)take((size_t)XCD_BAR_WORDS * 4);
    p.wt_in = (bf16_t*)take((size_t)DINP * DM * 2); p.wt_out0 = (bf16_t*)take((size_t)DM * DM * 2); p.wt_gu0 = (bf16_t*)take((size_t)2 * FF * DM * 2); p.wt_d0 = (bf16_t*)take((size_t)DM * FF * 2);
    p.wt_qkv = (bf16_t*)take((size_t)3072 * DM * 2); p.wt_out1 = (bf16_t*)take((size_t)DM * DM * 2);
    p.hn = (bf16_t*)take((size_t)NTOK * DM * 2);
    p.gflag = (unsigned*)take((size_t)NCHH * 4);
    p.retL = (float*)take((size_t)BATCH * 4 * NG * 128 * 128 * 4);
    p.gbeta = (float*)take((size_t)NTOK * 4 * 4); p.gg = (float*)take((size_t)NTOK * 4 * 4);
    p.arow = (int*)take((size_t)MAXTILES * 256 * 4); p.tile_e = (int*)take((size_t)MAXTILES * 4); p.slot_of = (int*)take((size_t)NTOK * 2 * 4); p.mgate = (float*)take((size_t)NTOK * 2 * 4); p.midx = (int*)take((size_t)NTOK * 2 * 4); p.wghist = (unsigned*)take((size_t)4096 * 8 * 4);
    p.w8_gu0 = take((size_t)2 * FF * DM); p.ws_gu0 = (float*)take((size_t)2 * FF * 4); p.ws_mgu = (float*)take((size_t)NE * 2 * FFE * 4); p.hns = (float*)take((size_t)NTOK * 4); p.sslot = (float*)take((size_t)MAXTILES * 256 * 4);
    p.ws_md = (float*)take((size_t)NE * DM * 4); p.hnn2 = (float*)take((size_t)NTOK * 4); p.shs = (float*)take((size_t)MAXTILES * 256 * 4);
    p.kmh = (bf16_t*)take((size_t)NIT * 128 * 2); p.kml = (bf16_t*)take((size_t)NIT * 128 * 2); p.mcount = (unsigned*)take((size_t)NIT * 4);
    p.arena = w + off;
    const size_t arena_bytes = ws_size - off;
    { size_t a = 0; auto at = [&](size_t bytes) { unsigned char* r = p.arena + a; a += al256(bytes); return r; };
      p.proj = (bf16_t*)at((size_t)NTOK * DINP * 2);
      p.gimg = (unsigned char*)at((size_t)NCHH * IMG_CH); p.gcdec = (float*)at((size_t)NCHH * 4);
      if (a > arena_bytes) fprintf(stderr, "workspace too small (layer0): need %zu have %zu\n", a, arena_bytes); }
    p.act0 = (bf16_t*)p.arena;
    { size_t a = 0; auto at = [&](size_t bytes) { unsigned char* r = p.arena + a; a += al256(bytes); return r; };
      p.qkv = (bf16_t*)at((size_t)NTOK * 3072 * 2); p.part_o = (bf16_t*)at((size_t)NTOK * 8 * 3 * 128 * 2); p.part_lse = (float*)at((size_t)NTOK * 8 * 3 * 4); p.mlist = (unsigned short*)at((size_t)BATCH * 8 * LTOT * 2);
      if (a > arena_bytes) fprintf(stderr, "workspace too small (layer1): need %zu have %zu\n", a, arena_bytes); }
    { size_t a = 0; auto at = [&](size_t bytes) { unsigned char* r = p.arena + a; a += al256(bytes); return r; };
      p.w8_mgu = at((size_t)NE * 2 * FFE * DM); p.w8_md = at((size_t)NE * DM * FFE); p.yslot = (bf16_t*)at((size_t)MAXTILES * 256 * DM * 2);
      p.hb3 = (bf16_t*)at((size_t)NTOK * DM * 2);
      p.mact = (bf16_t*)(p.arena + a);
      p.wt_mgu = nullptr; p.wt_md_tmp = p.mact; p.wt_md = nullptr;
      const size_t rest = arena_bytes > a ? arena_bytes - a : 0;
      if (rest < (size_t)NE * FFE * DM * 2) fprintf(stderr, "workspace too small (moe weights)\n");
      long tiles = (long)(rest / ((size_t)2 * 256 * FFE));
      if (tiles > 64) tiles = 64;
      if (tiles < 1) { fprintf(stderr, "workspace too small (moe)\n"); tiles = 1; }
#ifdef CPU_EMU
      if (getenv("EMU_TPP")) tiles = atoi(getenv("EMU_TPP"));
#endif
      p.tiles_per_pass = (int)tiles; }
#ifdef CPU_EMU
    emu::reg("hn", p.hn, (size_t)NTOK * DM * 2, "bf16"); emu::reg("proj", p.proj, (size_t)NTOK * DINP * 2, "bf16");
    emu::reg("gbeta", p.gbeta, (size_t)NTOK * 16, "f32"); emu::reg("gg", p.gg, (size_t)NTOK * 16, "f32"); emu::reg("midx", p.midx, (size_t)NTOK * 8, "i32");
    const int grid_blocks = getenv("EMU_GRID") ? atoi(getenv("EMU_GRID")) : 8;
    emu::launch(grid_blocks, NTHREADS, kDynLds, [=]() { fwd_megakernel(p); }, true);
#else
    static int grid_blocks = 0;
    if (!grid_blocks) {
        int dev = 0, cus = 0, per_cu = 0;
        (void)hipGetDevice(&dev);
        (void)hipDeviceGetAttribute(&cus, hipDeviceAttributeMultiprocessorCount, dev);
        (void)hipFuncSetAttribute((const void*)fwd_megakernel, hipFuncAttributeMaxDynamicSharedMemorySize, (int)kDynLds);
        (void)hipOccupancyMaxActiveBlocksPerMultiprocessor(&per_cu, fwd_megakernel, NTHREADS, kDynLds);
        if (per_cu < 1) per_cu = 1;
        grid_blocks = cus;
    }
    (void)hipMemsetAsync(p.bar, 0, (size_t)XCD_BAR_WORDS * 4, stream);
    void* args[] = {&p};
    hipError_t e = hipLaunchCooperativeKernel((const void*)fwd_megakernel, dim3(grid_blocks), dim3(NTHREADS), args, kDynLds, stream);
    if (e != hipSuccess) fprintf(stderr, "cooperative launch failed: %s (grid %d)\n", hipGetErrorString(e), grid_blocks);
#endif
}
```

```cpp
#ifndef CPU_EMU
#include <hip/hip_runtime.h>
#include <hip/hip_cooperative_groups.h>
#include <cstdio>
#include <cstring>
#define LAS __attribute__((address_space(3)))
#define WAVE_SYNC() __builtin_amdgcn_wave_barrier()
#define SCHED_FENCE() __builtin_amdgcn_sched_barrier(0)
#define OPAQUE_V(x) asm volatile("" : "+v"(x))
static __device__ __forceinline__ unsigned shfl_up_u(unsigned v, int o, int lane) { const int src = lane >= o ? lane - o : lane; return (unsigned)__builtin_amdgcn_ds_bpermute(src << 2, (int)v); }
static __device__ __forceinline__ float shfl_up_f(float v, int o, int lane) { return __uint_as_float(shfl_up_u(__float_as_uint(v), o, lane)); }
#define LDS_ATOMIC_ADD(ptr, v) __hip_atomic_fetch_add((ptr), (v), __ATOMIC_RELAXED, __HIP_MEMORY_SCOPE_WORKGROUP)
#define LDS_ATOMIC_MAX(ptr, v) __hip_atomic_fetch_max((ptr), (v), __ATOMIC_RELAXED, __HIP_MEMORY_SCOPE_WORKGROUP)
#define GLOBAL_ATOMIC_MAX(ptr, v) __hip_atomic_fetch_max((ptr), (v), __ATOMIC_RELAXED, __HIP_MEMORY_SCOPE_AGENT)
static __device__ __forceinline__ int opaque_tid(int wv) { int l; asm volatile("v_mbcnt_lo_u32_b32 %0, -1, 0\n\tv_mbcnt_hi_u32_b32 %0, -1, %0" : "=v"(l)); return (wv << 6) | l; }
#else
static inline int opaque_tid(int) { return threadIdx.x; }
#define LAS
#define WAVE_SYNC() ((void)__ballot(1))
#define SCHED_FENCE() ((void)0)
#define OPAQUE_V(x) ((void)0)
static inline unsigned shfl_up_u(unsigned v, int o, int lane) { return __shfl(v, lane >= o ? lane - o : lane); }
static inline float shfl_up_f(float v, int o, int lane) { return __shfl(v, lane >= o ? lane - o : lane); }
static inline unsigned emu_fetch_add(unsigned* p, unsigned v) { unsigned o = *p; *p = o + v; return o; }
#define LDS_ATOMIC_ADD(ptr, v) emu_fetch_add((ptr), (v))
static inline unsigned emu_fetch_max(unsigned* p, unsigned v) { unsigned o = *p; if (v > o) *p = v; return o; }
#define LDS_ATOMIC_MAX(ptr, v) emu_fetch_max((ptr), (v))
#define GLOBAL_ATOMIC_MAX(ptr, v) atomicMax((ptr), (v))
#endif
namespace cg = cooperative_groups;

#ifndef RPT_SYNC
#define RPT_SYNC 0
#endif
#ifndef RPT_SG
#define RPT_SG 1
#endif
#ifndef RPT_SR
#define RPT_SR 1
#endif
#ifndef RPT_MG
#define RPT_MG 1
#endif
#ifndef RPT_MO
#define RPT_MO 1
#endif
#ifndef RPT_GEMM
#define RPT_GEMM 1
#endif
#ifndef RPT_GDN
#define RPT_GDN 1
#endif
#ifndef RPT_SCAN
#define RPT_SCAN 1
#endif
#ifndef RPT_MOBA
#define RPT_MOBA 1
#endif
#ifndef RPT_CONV
#define RPT_CONV 1
#endif
#ifndef FP8_FFN0
#define FP8_FFN0 0
#endif
#ifndef CFG_SEQ
#define CFG_SEQ 16384
#define CFG_BATCH 2
#define CFG_FF 2816
#define CFG_FFE 3584
#endif

typedef unsigned short bf16_t;
typedef short bf16x8 __attribute__((ext_vector_type(8)));
typedef float f32x4 __attribute__((ext_vector_type(4)));
typedef float f32x16 __attribute__((ext_vector_type(16)));
typedef unsigned u32x4 __attribute__((ext_vector_type(4)));
typedef unsigned u32x2 __attribute__((ext_vector_type(2)));

constexpr int DM = 1024, SEQ = CFG_SEQ, BATCH = CFG_BATCH, NTOK = SEQ * BATCH, HD = 128;
constexpr int DIN = 4104, DINP = 4096, FF = CFG_FF, FFE = CFG_FFE, NE = 8;
constexpr int NCH = SEQ / 64, NBLK = SEQ / 256, NCHH = BATCH * 4 * NCH;
constexpr int NTHREADS = 512;
constexpr int BM = 256, BK = 64, HALF = 128, HTB = HALF * BK * 2, STAGE_BYTES = 8 * HTB, NXCD = 8, WGM = 4;
constexpr size_t kDynLds = 144 * 1024;
constexpr int MAXTILES = NTOK * 2 / 256 + NE;
constexpr int NIT = BATCH * 8 * NBLK;
constexpr int LTOT = NBLK * SEQ - 128 * NBLK * (NBLK + 1);
static_assert(SEQ <= 16384, "16-bit selection-list entries");
constexpr int GNT = (NBLK + 15) / 16;
constexpr int KS_STRIDE = 272, VT_STRIDE = 520;
constexpr int KS_BYTES = 256 * KS_STRIDE, VT_BYTES = 128 * VT_STRIDE;
__host__ __device__ __forceinline__ int list_off(int j) { return j * SEQ - 128 * j * (j + 1); }
constexpr float NORM_EPS = 1e-6f;

__device__ __forceinline__ bf16_t f2bf(float f) { unsigned u = __float_as_uint(f); u += 0x7FFFu + ((u >> 16) & 1u); return (bf16_t)(u >> 16); }
__device__ __forceinline__ float bf2f(bf16_t h) { return __uint_as_float(((unsigned)h) << 16); }
#ifndef CPU_EMU
typedef __bf16 hwbf16x2 __attribute__((ext_vector_type(2)));
typedef float f32x2v __attribute__((ext_vector_type(2)));
__device__ __forceinline__ unsigned pack2(float lo, float hi) { f32x2v v; v.x = lo; v.y = hi; hwbf16x2 b = __builtin_convertvector(v, hwbf16x2); unsigned r; __builtin_memcpy(&r, &b, 4); return r; }
#else
__device__ __forceinline__ unsigned pack2(float lo, float hi) { return (unsigned)f2bf(lo) | ((unsigned)f2bf(hi) << 16); }
#endif
#ifndef CPU_EMU
__device__ __forceinline__ float siluf(float x) { return x * __builtin_amdgcn_rcpf(1.0f + __builtin_amdgcn_exp2f(-1.4426950408889634f * x)); }
#else
__device__ __forceinline__ float siluf(float x) { return x / (1.0f + __expf(-x)); }
#endif
#ifndef CPU_EMU
__device__ __forceinline__ unsigned pack4_fp8(float a, float b, float c, float d) { int r = 0; r = __builtin_amdgcn_cvt_pk_fp8_f32(a, b, r, false); r = __builtin_amdgcn_cvt_pk_fp8_f32(c, d, r, true); return (unsigned)r; }
#else
static inline float fp8_to_f(unsigned char v) { const int s = v >> 7, e = (v >> 3) & 15, m = v & 7; const float a = e == 0 ? ldexpf((float)m, -9) : ldexpf((float)(8 + m), e - 10); return s ? -a : a; }
static inline unsigned char f_to_fp8(float x) {
    const unsigned s = x < 0.f ? 0x80u : 0u; float a = fabsf(x); if (!(a == a)) return 0x7f; if (a > 448.f) a = 448.f; if (a == 0.f) return (unsigned char)s;
    int e; (void)frexpf(a, &e); e -= 1; if (e < -6) e = -6;
    const float step = ldexpf(1.f, e - 3); float q = nearbyintf(a / step) * step; if (q > 448.f) q = 448.f;
    int e2; (void)frexpf(q, &e2); e2 -= 1; unsigned bits;
    if (q < ldexpf(1.f, -6)) bits = (unsigned)nearbyintf(q * 512.f); else bits = ((unsigned)(e2 + 7) << 3) | ((unsigned)nearbyintf(q / ldexpf(1.f, e2 - 3)) - 8u);
    return (unsigned char)(s | bits);
}
static inline unsigned pack4_fp8(float a, float b, float c, float d) { return (unsigned)f_to_fp8(a) | ((unsigned)f_to_fp8(b) << 8) | ((unsigned)f_to_fp8(c) << 16) | ((unsigned)f_to_fp8(d) << 24); }
#endif
constexpr float FP8_TOP = 384.f;
#ifndef CPU_EMU
__device__ __forceinline__ float wave_sum(float s) { int l; asm volatile("v_mbcnt_lo_u32_b32 %0, -1, 0\n\tv_mbcnt_hi_u32_b32 %0, -1, %0" : "=v"(l));
#pragma unroll
    for (int o = 32; o >= 1; o >>= 1) s += __uint_as_float((unsigned)__builtin_amdgcn_ds_bpermute((l ^ o) << 2, (int)__float_as_uint(s))); return s; }
__device__ __forceinline__ float wave_max(float s) { int l; asm volatile("v_mbcnt_lo_u32_b32 %0, -1, 0\n\tv_mbcnt_hi_u32_b32 %0, -1, %0" : "=v"(l));
#pragma unroll
    for (int o = 32; o >= 1; o >>= 1) s = fmaxf(s, __uint_as_float((unsigned)__builtin_amdgcn_ds_bpermute((l ^ o) << 2, (int)__float_as_uint(s)))); return s; }
#else
__device__ __forceinline__ float wave_sum(float s) { for (int o = 32; o >= 1; o >>= 1) s += __shfl_xor(s, o); return s; }
__device__ __forceinline__ float wave_max(float s) { for (int o = 32; o >= 1; o >>= 1) s = fmaxf(s, __shfl_xor(s, o)); return s; }
#endif

struct Params;
#ifndef CPU_EMU
typedef const __attribute__((address_space(4))) Params* KPTR;
#define KARG_PTR(arg) ((KPTR)__builtin_amdgcn_kernarg_segment_ptr())
#define LAUNDER(q) asm volatile("" : "+s"(q))
#else
typedef const Params* KPTR;
#define KARG_PTR(arg) (&(arg))
#define LAUNDER(q) ((void)0)
#endif
struct Params {
    const float* x; const float* mix_norm; const float* ffn_norm; const float* w_in; const float* conv_w; const float* a_log; const float* dt_bias;
    const float* ret_norm; const float* gdn_norm; const float* w_out0; const float* w_qkv; const float* w_out1; const float* w_gate0; const float* w_up0;
    const float* w_down0; const float* w_router; const float* w_mgate; const float* w_mup; const float* w_mdown; const float* final_norm;
    float* out;
    bf16_t* hb;
    bf16_t* hb3;
    unsigned* ctrl;
    unsigned* bar;
    bf16_t* wt_in; bf16_t* wt_out0; bf16_t* wt_gu0; bf16_t* wt_d0; bf16_t* wt_qkv; bf16_t* wt_out1;
    bf16_t* hn;
    float* gbeta; float* gg;
    float* retL;
    unsigned* gflag;
    unsigned char* arena;
    bf16_t* proj; unsigned char* gimg; float* gcdec;
    bf16_t* act0;
    bf16_t* qkv; bf16_t* kmh; bf16_t* kml; unsigned* mcount; unsigned short* mlist; bf16_t* part_o; float* part_lse;
    bf16_t* wt_mgu; bf16_t* wt_md; bf16_t* yslot; bf16_t* mact; int* arow; int* tile_e; int* slot_of; float* mgate; int* midx; unsigned* wghist;
    unsigned char* w8_gu0; float* ws_gu0; unsigned char* w8_mgu; float* ws_mgu; float* hns; float* sslot; unsigned char* w8_md; float* ws_md; float* hnn2; float* sn2; float* shs; bf16_t* wt_md_tmp;
    int tiles_per_pass; int pad0;
};

#define C_CNT(e) (64 + (e))
#define C_CUR(e) (128 + (e))
#define C_NTILES 192
#define C_GMAX 216
#define C_UMAX 224
#define C_TB 200

__host__ __device__ __forceinline__ int lds_byte(int r, int c) { const int st = (r >> 4) * 2 + (c >> 5), rr = r & 15, cc = c & 31, ob = rr * 64 + cc * 2; return st * 1024 + (ob ^ (((ob >> 9) & 1) << 5)); }
__host__ __device__ __forceinline__ void stage_rc(int b, int& R, int& C) { const int st = b / 1024, sb = b % 1024, swz = sb ^ (((sb >> 9) & 1) << 5); R = (st >> 1) * 16 + swz / 64; C = (st & 1) * 32 + (swz % 64) / 2; }
__host__ __device__ __forceinline__ int perm32(int rho) { const int n = rho >> 4, i = rho & 15; return 8 * (i >> 2) + 4 * n + (i & 3); }

struct Unit { int pm, pn, pnb; };
struct Gemm { const bf16_t* A; const bf16_t* Bt; const int* arow; };

struct StaticOrder {
    int nM, nN, nwg, G, c;
    __device__ void init(int nM_, int nN_, int G_, int c_) { nM = nM_; nN = nN_; nwg = nM * nN; G = G_; c = c_; }
    __device__ bool next(int i, Unit& u) const {
        const long L = (long)i * G + c; if (L >= nwg) return false;
        int wgid = (int)L; { const int q = nwg / NXCD, r = nwg % NXCD, xcd = wgid % NXCD, off = wgid / NXCD; wgid = (xcd < r ? xcd * (q + 1) : r * (q + 1) + (xcd - r) * q) + off; }
        const int nig = WGM * nN, gid = wgid / nig, fm = gid * WGM, gsz = (nM - fm) < WGM ? (nM - fm) : WGM;
        u.pm = fm + ((wgid % nig) % gsz); u.pn = (wgid % nig) / gsz; u.pnb = u.pn; return true;
    }
};
struct MoeOrder {
    StaticOrder so; int t0; const int* tile_e;
    __device__ void init(int t0_, int nM_, int nN_, const int* te, int G_, int c_) { so.init(nM_, nN_, G_, c_); t0 = t0_; tile_e = te; }
    __device__ bool next(int i, Unit& u) const { if (!so.next(i, u)) return false; u.pm += t0; u.pnb = tile_e[u.pm] * so.nN + u.pn; return true; }
};

struct EpiBf16 {
    static constexpr bool PERM = true;
    bf16_t* O; int ldc; int rowbase;
    __device__ __forceinline__ void operator()(const f32x4 (&acc)[2][2][4][2], const Unit& u, int wr, int wc, int fr, int fq) const {
        const int row0 = u.pm * BM + wr * 64 + fr - rowbase, col0 = u.pn * BM + wc * 32 + 8 * fq;
#pragma unroll
        for (int ai = 0; ai < 2; ++ai)
#pragma unroll
            for (int m = 0; m < 4; ++m) { bf16_t* rowp = O + (size_t)(row0 + ai * HALF + m * 16) * ldc + col0;
#pragma unroll
                for (int bj = 0; bj < 2; ++bj) { const f32x4 v0 = acc[ai][bj][m][0], v1 = acc[ai][bj][m][1];
                    u32x4 w; w.x = pack2(v0[0], v0[1]); w.y = pack2(v0[2], v0[3]); w.z = pack2(v1[0], v1[1]); w.w = pack2(v1[2], v1[3]);
                    *(u32x4*)(rowp + bj * HALF) = w; } }
    }
};
struct EpiSwiglu {
    static constexpr bool PERM = true;
    bf16_t* O; int ldc; int rowbase;
    __device__ __forceinline__ void operator()(const f32x4 (&acc)[2][2][4][2], const Unit& u, int wr, int wc, int fr, int fq) const {
        const int row0 = u.pm * BM + wr * 64 + fr - rowbase, col0 = u.pn * HALF + wc * 32 + 8 * fq;
#pragma unroll
        for (int ai = 0; ai < 2; ++ai)
#pragma unroll
            for (int m = 0; m < 4; ++m) { bf16_t* rowp = O + (size_t)(row0 + ai * HALF + m * 16) * ldc + col0;
                float r[8];
#pragma unroll
                for (int n = 0; n < 2; ++n)
#pragma unroll
                    for (int j = 0; j < 4; ++j) r[n * 4 + j] = siluf(acc[ai][0][m][n][j]) * acc[ai][1][m][n][j];
                u32x4 w; w.x = pack2(r[0], r[1]); w.y = pack2(r[2], r[3]); w.z = pack2(r[4], r[5]); w.w = pack2(r[6], r[7]);
                *(u32x4*)rowp = w; }
    }
};
struct EpiSwigluS {
    static constexpr bool PERM = true;
    bf16_t* O; int ldc; int rowbase; const float* sa; const float* sb;
    __device__ __forceinline__ void operator()(const f32x4 (&acc)[2][2][4][2], const Unit& u, int wr, int wc, int fr, int fq) const {
        const int rowg = u.pm * BM + wr * 64 + fr, row0 = rowg - rowbase, col0 = u.pn * HALF + wc * 32 + 8 * fq;
        const float* sbp = sb + (size_t)u.pnb * BM + wc * 32 + 8 * fq;
        f32x4 sg[2], su[2];
#pragma unroll
        for (int n = 0; n < 2; ++n) { sg[n] = *(const f32x4*)(sbp + 4 * n); su[n] = *(const f32x4*)(sbp + HALF + 4 * n); }
        float ra[2][4];
#pragma unroll
        for (int ai = 0; ai < 2; ++ai)
#pragma unroll
            for (int m = 0; m < 4; ++m) ra[ai][m] = sa[rowg + ai * HALF + m * 16];
#pragma unroll
        for (int ai = 0; ai < 2; ++ai)
#pragma unroll
            for (int m = 0; m < 4; ++m) { bf16_t* rowp = O + (size_t)(row0 + ai * HALF + m * 16) * ldc + col0;
                float r[8];
#pragma unroll
                for (int n = 0; n < 2; ++n)
#pragma unroll
                    for (int j = 0; j < 4; ++j) r[n * 4 + j] = siluf(acc[ai][0][m][n][j] * (ra[ai][m] * sg[n][j])) * (acc[ai][1][m][n][j] * (ra[ai][m] * su[n][j]));
                u32x4 w; w.x = pack2(r[0], r[1]); w.y = pack2(r[2], r[3]); w.z = pack2(r[4], r[5]); w.w = pack2(r[6], r[7]);
                *(u32x4*)rowp = w; }
    }
};
struct EpiSwigluS8 {
    static constexpr bool PERM = true;
    unsigned char* O8; int ldc; int rowbase; const float* sa; const float* sb; const float* so;
    __device__ __forceinline__ void operator()(const f32x4 (&acc)[2][2][4][2], const Unit& u, int wr, int wc, int fr, int fq) const {
        const int rowg = u.pm * BM + wr * 64 + fr, row0 = rowg - rowbase, col0 = u.pn * HALF + wc * 32 + 8 * fq;
        const float* sbp = sb + (size_t)u.pnb * BM + wc * 32 + 8 * fq;
        f32x4 sg[2], su[2];
#pragma unroll
        for (int n = 0; n < 2; ++n) { sg[n] = *(const f32x4*)(sbp + 4 * n); su[n] = *(const f32x4*)(sbp + HALF + 4 * n); }
        float ra[2][4], ro[2][4];
#pragma unroll
        for (int ai = 0; ai < 2; ++ai)
#pragma unroll
            for (int m = 0; m < 4; ++m) { ra[ai][m] = sa[rowg + ai * HALF + m * 16]; const float so_ = so[rowg + ai * HALF + m * 16]; ro[ai][m] = so_ > 0.f ? 1.0f / so_ : 0.f; }
#pragma unroll
        for (int ai = 0; ai < 2; ++ai)
#pragma unroll
            for (int m = 0; m < 4; ++m) { unsigned char* rowp = O8 + (size_t)(row0 + ai * HALF + m * 16) * ldc + col0;
                float r[8];
#pragma unroll
                for (int n = 0; n < 2; ++n)
#pragma unroll
                    for (int j = 0; j < 4; ++j) r[n * 4 + j] = siluf(acc[ai][0][m][n][j] * (ra[ai][m] * sg[n][j])) * (acc[ai][1][m][n][j] * (ra[ai][m] * su[n][j])) * ro[ai][m];
                u32x2 w; w.x = pack4_fp8(r[0], r[1], r[2], r[3]); w.y = pack4_fp8(r[4], r[5], r[6], r[7]);
                *(u32x2*)rowp = w; }
    }
};
struct EpiBf16S {
    static constexpr bool PERM = true;
    bf16_t* O; int ldc; const float* sa; const float* sb;
    __device__ __forceinline__ void operator()(const f32x4 (&acc)[2][2][4][2], const Unit& u, int wr, int wc, int fr, int fq) const {
        const int row0 = u.pm * BM + wr * 64 + fr, col0 = u.pn * BM + wc * 32 + 8 * fq;
        const float* sbp = sb + (size_t)u.pnb * BM + wc * 32 + 8 * fq;
        f32x4 sv[2][2];
#pragma unroll
        for (int bj = 0; bj < 2; ++bj)
#pragma unroll
            for (int n = 0; n < 2; ++n) sv[bj][n] = *(const f32x4*)(sbp + bj * HALF + 4 * n);
#pragma unroll
        for (int ai = 0; ai < 2; ++ai)
#pragma unroll
            for (int m = 0; m < 4; ++m) { bf16_t* rowp = O + (size_t)(row0 + ai * HALF + m * 16) * ldc + col0; const float ra = sa[row0 + ai * HALF + m * 16];
#pragma unroll
                for (int bj = 0; bj < 2; ++bj) { const f32x4 v0 = acc[ai][bj][m][0] * sv[bj][0] * ra, v1 = acc[ai][bj][m][1] * sv[bj][1] * ra;
                    u32x4 w; w.x = pack2(v0[0], v0[1]); w.y = pack2(v0[2], v0[3]); w.z = pack2(v1[0], v1[1]); w.w = pack2(v1[2], v1[3]);
                    *(u32x4*)(rowp + bj * HALF) = w; } }
    }
};
template <bool F32BASE>
struct EpiResBf16 {
    static constexpr bool PERM = true;
    static constexpr bool LSCALE = false;
    const float* basef; const bf16_t* baseb; bf16_t* out;
    __device__ __forceinline__ void operator()(const f32x4 (&acc)[2][2][4][2], const Unit& u, int wr, int wc, int fr, int fq) const {
        const int row0 = u.pm * BM + wr * 64 + fr, col0 = u.pn * BM + wc * 32 + 8 * fq;
#pragma unroll
        for (int ai = 0; ai < 2; ++ai)
#pragma unroll
            for (int m = 0; m < 4; ++m) { const size_t off = (size_t)(row0 + ai * HALF + m * 16) * DM + col0;
#pragma unroll
                for (int bj = 0; bj < 2; ++bj) { f32x4 b0, b1;
                    if (F32BASE) { b0 = *(const f32x4*)(basef + off + bj * HALF); b1 = *(const f32x4*)(basef + off + bj * HALF + 4); }
                    else { const u32x4 w = *(const u32x4*)(baseb + off + bj * HALF);
                        b0[0] = __uint_as_float(w.x << 16); b0[1] = __uint_as_float(w.x & 0xffff0000u); b0[2] = __uint_as_float(w.y << 16); b0[3] = __uint_as_float(w.y & 0xffff0000u);
                        b1[0] = __uint_as_float(w.z << 16); b1[1] = __uint_as_float(w.z & 0xffff0000u); b1[2] = __uint_as_float(w.w << 16); b1[3] = __uint_as_float(w.w & 0xffff0000u); }
                    const f32x4 v0 = acc[ai][bj][m][0] + b0, v1 = acc[ai][bj][m][1] + b1;
                    u32x4 o; o.x = pack2(v0[0], v0[1]); o.y = pack2(v0[2], v0[3]); o.z = pack2(v1[0], v1[1]); o.w = pack2(v1[2], v1[3]);
                    *(u32x4*)(out + off + bj * HALF) = o; } }
    }
};
struct EpiResF32 {
    static constexpr bool PERM = false;
    const float* base; float* out; int ldc;
    __device__ __forceinline__ void operator()(const f32x4 (&acc)[2][2][4][2], const Unit& u, int wr, int wc, int fr, int fq) const {
        const int row0 = u.pm * BM + wr * 64 + fr, col0 = u.pn * BM + wc * 32 + 4 * fq;
#pragma unroll
        for (int ai = 0; ai < 2; ++ai)
#pragma unroll
            for (int m = 0; m < 4; ++m) { const size_t off = (size_t)(row0 + ai * HALF + m * 16) * ldc + col0;
#pragma unroll
                for (int bj = 0; bj < 2; ++bj)
#pragma unroll
                    for (int n = 0; n < 2; ++n) { const f32x4 b = *(const f32x4*)(base + off + bj * HALF + n * 16); *(f32x4*)(out + off + bj * HALF + n * 16) = b + acc[ai][bj][m][n]; } }
    }
};

#ifndef CPU_EMU
typedef int i32x8 __attribute__((ext_vector_type(8)));
__device__ __forceinline__ i32x8 cat8(const bf16x8 lo, const bf16x8 hi) { u32x4 a, b; __builtin_memcpy(&a, &lo, 16); __builtin_memcpy(&b, &hi, 16); i32x8 r; r[0] = (int)a.x; r[1] = (int)a.y; r[2] = (int)a.z; r[3] = (int)a.w; r[4] = (int)b.x; r[5] = (int)b.y; r[6] = (int)b.z; r[7] = (int)b.w; return r; }
template <int K, class Epi, class Sched, bool FP8 = false>
__device__ __forceinline__ void gemm_phase(LAS unsigned char* lds, const Gemm g, const Sched& S, const Epi& E, int wv) {
    const int tid = opaque_tid(wv), wid = __builtin_amdgcn_readfirstlane(tid >> 6), lane = tid & 63, wr = wid >> 2, wc = wid & 3, fr = lane & 15, fq = lane >> 4;
    constexpr int RB = FP8 ? K : 2 * K;
    constexpr int nt = RB / 128;
    static_assert(nt % 2 == 0 && nt >= 4, "k tiles");
    unsigned voffB[2];
#pragma unroll
    for (int i = 0; i < 2; ++i) { int R, C; stage_rc(tid * 16 + i * 8192, R, C); const int Rb = Epi::PERM ? ((R & ~31) + perm32(R & 31)) : R; voffB[i] = (unsigned)(Rb * RB + C * 2); }
    constexpr size_t kstep = (size_t)(BK * 2);
    constexpr size_t hstep = (size_t)HALF * RB;
    constexpr size_t tstep = 2 * hstep;
    const unsigned ldsw = (unsigned)wid * 1024u;
    const int aoffl = lds_byte(wr * 64 + fr, fq * 8), boffl = lds_byte(wc * 32 + fr, fq * 8);
    unsigned aoff[2][2];
#define G_LOADA(u) do { _Pragma("unroll") for (int _h = 0; _h < 2; ++_h) _Pragma("unroll") for (int _i = 0; _i < 2; ++_i) { int _R, _C; stage_rc(tid * 16 + _i * 8192, _R, _C); const int _r = (u).pm * BM + _h * HALF + _R; \
        const int _s = g.arow ? g.arow[_r] : _r; aoff[_h][_i] = (unsigned)(_s * RB + _C * 2); } } while (0)
#define G_SA(b, h) (((b) * 2 + (h)) * HTB)
#define G_SB(b, h) ((4 + (b) * 2 + (h)) * HTB)
#define G_STAGEB(bufoff, gbase) do { _Pragma("unroll") for (int _i = 0; _i < 2; ++_i) \
        __builtin_amdgcn_global_load_lds((const unsigned*)((const char*)(gbase) + voffB[_i]), (LAS unsigned*)(lds + (bufoff) + ldsw + _i * 8192), 16, 0, 0); } while (0)
#define G_STAGEA(bufoff, kt, h) do { _Pragma("unroll") for (int _i = 0; _i < 2; ++_i) \
        __builtin_amdgcn_global_load_lds((const unsigned*)((const char*)g.A + (size_t)(kt) * kstep + aoff[h][_i]), (LAS unsigned*)(lds + (bufoff) + ldsw + _i * 8192), 16, 0, 0); } while (0)
#define G_LDA(dst, b, h) do { _Pragma("unroll") for (int m = 0; m < 4; ++m) _Pragma("unroll") for (int k = 0; k < 2; ++k) dst[m][k] = *(const LAS bf16x8*)(lds + G_SA(b, h) + aoffl + m * 2048 + k * 1024); } while (0)
#define G_LDB(dst, b, h) do { _Pragma("unroll") for (int n = 0; n < 2; ++n) _Pragma("unroll") for (int k = 0; k < 2; ++k) dst[n][k] = *(const LAS bf16x8*)(lds + G_SB(b, h) + boffl + n * 2048 + k * 1024); } while (0)
#define G_MMA(ai, bj, At, Bt) do { if constexpr (FP8) __builtin_amdgcn_sched_barrier(0); __builtin_amdgcn_s_setprio(1); _Pragma("unroll") for (int m = 0; m < 4; ++m) _Pragma("unroll") for (int n = 0; n < 2; ++n) { \
        if constexpr (FP8) acc[ai][bj][m][n] = __builtin_amdgcn_mfma_scale_f32_16x16x128_f8f6f4(cat8(Bt[n][0], Bt[n][1]), cat8(At[m][0], At[m][1]), acc[ai][bj][m][n], 0, 0, 0, 0x7F7F7F7F, 0, 0x7F7F7F7F); \
        else { _Pragma("unroll") for (int k = 0; k < 2; ++k) acc[ai][bj][m][n] = __builtin_amdgcn_mfma_f32_16x16x32_bf16(Bt[n][k], At[m][k], acc[ai][bj][m][n], 0, 0, 0); } } \
        __builtin_amdgcn_s_setprio(0); if constexpr (FP8) __builtin_amdgcn_sched_barrier(0); } while (0)
#define G_WAIT_V(n) asm volatile("s_waitcnt vmcnt(" #n ")" ::: "memory")
#define G_WAIT_L(n) asm volatile("s_waitcnt lgkmcnt(" #n ")" ::: "memory")
#define G_BAR __builtin_amdgcn_s_barrier()
#define G_SCHED __builtin_amdgcn_sched_barrier(0)
    Unit cur, nxt; int ui = 0;
    if (!S.next(0, cur)) return;
    f32x4 acc[2][2][4][2];
#pragma unroll
    for (int a = 0; a < 2; ++a)
#pragma unroll
        for (int b = 0; b < 2; ++b)
#pragma unroll
            for (int m = 0; m < 4; ++m)
#pragma unroll
                for (int n = 0; n < 2; ++n) acc[a][b][m][n] = (f32x4){0.f, 0.f, 0.f, 0.f};
    bf16x8 At[4][2], B0[2][2], B1[2][2];
    const char* cB = (const char*)g.Bt + (size_t)cur.pnb * tstep;
    G_LOADA(cur);
    G_STAGEB(G_SB(0, 0), cB); G_STAGEA(G_SA(0, 0), 0, 0); G_STAGEB(G_SB(0, 1), cB + hstep); G_STAGEA(G_SA(0, 1), 0, 1);
    if (wr == 1) G_BAR;
    G_WAIT_V(4); G_BAR;
    G_STAGEB(G_SB(1, 0), cB + kstep); G_STAGEA(G_SA(1, 0), 1, 0); G_STAGEB(G_SB(1, 1), cB + hstep + kstep);
    G_WAIT_V(6); G_BAR;
    for (;;) {
        const bool has_next = S.next(ui + 1, nxt);
        const char* nB = has_next ? (const char*)g.Bt + (size_t)nxt.pnb * tstep : cB;
        for (int t = 0; t < nt; t += 2) {
            const bool last = (t == nt - 2);
            const int k2 = last ? 0 : t + 2, k3 = k2 + 1;
            const char* b2 = last ? nB : cB + (size_t)(t + 2) * kstep; const char* b3 = b2 + kstep;
            G_LDB(B0, 0, 0); G_SCHED; G_LDA(At, 0, 0); G_STAGEA(G_SA(1, 1), t + 1, 1);
            if (g.arow && has_next && t == nt - 4 && tid < BM)
                __builtin_amdgcn_global_load_lds((const unsigned*)(g.arow + nxt.pm * BM + tid), (LAS unsigned*)(lds + STAGE_BYTES + wid * 256), 4, 0, 0);
            G_WAIT_L(8); G_BAR; G_WAIT_L(0); G_MMA(0, 0, At, B0); G_BAR; G_SCHED;
            if (last && has_next) {
                if (g.arow) {
#pragma unroll
                    for (int _h = 0; _h < 2; ++_h)
#pragma unroll
                        for (int _i = 0; _i < 2; ++_i) { int _R, _C; stage_rc(tid * 16 + _i * 8192, _R, _C); const int _s = *(LAS const int*)(lds + STAGE_BYTES + (_h * HALF + _R) * 4); aoff[_h][_i] = (unsigned)(_s * RB + _C * 2); }
                } else G_LOADA(nxt);
            }
            G_LDB(B1, 0, 1); G_STAGEB(G_SB(0, 0), b2);
            G_BAR; G_WAIT_L(0); G_MMA(0, 1, At, B1); G_BAR;
            G_LDA(At, 0, 1); G_STAGEA(G_SA(0, 0), k2, 0);
            G_BAR; G_WAIT_L(0); G_MMA(1, 0, At, B0); G_BAR; G_SCHED;
            G_STAGEB(G_SB(0, 1), b2 + hstep);
            G_WAIT_V(6); G_BAR; G_MMA(1, 1, At, B1); G_BAR;
            G_LDB(B0, 1, 0); G_SCHED; G_LDA(At, 1, 0); G_STAGEA(G_SA(0, 1), k2, 1);
            G_WAIT_L(8); G_BAR; G_WAIT_L(0); G_MMA(0, 0, At, B0); G_BAR; G_SCHED;
            G_LDB(B1, 1, 1); G_STAGEB(G_SB(1, 0), b3);
            G_BAR; G_WAIT_L(0); G_MMA(0, 1, At, B1); G_BAR;
            G_LDA(At, 1, 1); G_STAGEA(G_SA(1, 0), k3, 0);
            G_BAR; G_WAIT_L(0); G_MMA(1, 0, At, B0); G_BAR; G_SCHED;
            G_STAGEB(G_SB(1, 1), b3 + hstep);
            G_WAIT_V(6); G_BAR; G_MMA(1, 1, At, B1); G_BAR;
        }
        E(acc, cur, wr, wc, fr, fq);
        if (!has_next) break;
#pragma unroll
        for (int a = 0; a < 2; ++a)
#pragma unroll
            for (int b = 0; b < 2; ++b)
#pragma unroll
                for (int m = 0; m < 4; ++m)
#pragma unroll
                    for (int n = 0; n < 2; ++n) acc[a][b][m][n] = (f32x4){0.f, 0.f, 0.f, 0.f};
        cur = nxt; cB = nB; ++ui;
    }
    G_WAIT_V(0);
    if (wr == 0) G_BAR;
    G_BAR;
}
#else
template <int K, class Epi, class Sched, bool FP8 = false>
__device__ __forceinline__ void gemm_phase(unsigned char* lds, const Gemm g, const Sched& S, const Epi& E, int wv) {
    const int tid = opaque_tid(wv), wid = tid >> 6, lane = tid & 63, wr = wid >> 2, wc = wid & 3, fr = lane & 15, fq = lane >> 4;
    Unit u;
    for (int ui = 0; S.next(ui, u); ++ui) {
        f32x4 acc[2][2][4][2];
        for (int ai = 0; ai < 2; ++ai) for (int bj = 0; bj < 2; ++bj) for (int m = 0; m < 4; ++m) for (int n = 0; n < 2; ++n) for (int j = 0; j < 4; ++j) {
            const int r = u.pm * 256 + 128 * ai + 64 * wr + 16 * m + fr;
            const int cl = Epi::PERM ? (128 * bj + 32 * wc + 8 * fq + 4 * n + j) : (128 * bj + 32 * wc + 16 * n + 4 * fq + j);
            const int ar = g.arow ? g.arow[r] : r;
            float s = 0.f;
            if (FP8) { const unsigned char* a = (const unsigned char*)g.A + (size_t)ar * K; const unsigned char* b = (const unsigned char*)g.Bt + ((size_t)u.pnb * 256 + cl) * K; for (int k = 0; k < K; ++k) s += fp8_to_f(a[k]) * fp8_to_f(b[k]); }
            else { const bf16_t* a = g.A + (size_t)ar * K; const bf16_t* b = g.Bt + ((size_t)u.pnb * 256 + cl) * K; for (int k = 0; k < K; ++k) s += bf2f(a[k]) * bf2f(b[k]); }
            acc[ai][bj][m][n][j] = s;
        }
        E(acc, u, wr, wc, fr, fq);
    }
}
#endif

__device__ __forceinline__ void convert_wt(LAS unsigned char* lds, const float* W, int K, int ldw, int col0, int ncols, bf16_t* Wt, int rowmul, int rowadd, int bid, int nb, int wv) {
    LAS float* t = (LAS float*)lds;
    const int tid = opaque_tid(wv);
    const int tk = K / 64, tn = ncols / 64, ntile = tk * tn;
    const int lr = tid >> 4, c4 = (tid & 15) * 4;
    f32x4 v[2];
    if (bid < ntile) { const int k0 = (bid % tk) * 64, n0 = (bid / tk) * 64;
#pragma unroll
        for (int i = 0; i < 2; ++i) v[i] = *(const f32x4*)(W + (size_t)(k0 + lr + 32 * i) * ldw + col0 + n0 + c4); }
    for (int tile = bid; tile < ntile; tile += nb) {
        const int k0 = (tile % tk) * 64, n0 = (tile / tk) * 64;
        __syncthreads();
#pragma unroll
        for (int i = 0; i < 2; ++i) { const int r = lr + 32 * i; t[r * 65 + c4] = v[i][0]; t[r * 65 + c4 + 1] = v[i][1]; t[r * 65 + c4 + 2] = v[i][2]; t[r * 65 + c4 + 3] = v[i][3]; }
        const int nt2 = tile + nb;
        if (nt2 < ntile) { const int k1 = (nt2 % tk) * 64, n1 = (nt2 / tk) * 64;
#pragma unroll
            for (int i = 0; i < 2; ++i) v[i] = *(const f32x4*)(W + (size_t)(k1 + lr + 32 * i) * ldw + col0 + n1 + c4); }
        __syncthreads();
        { const int c = tid >> 3, k8 = (tid & 7) * 8; const int cc = n0 + c; const int dr = (cc >> 7) * rowmul + (cc & 127) + rowadd;
          u32x4 w; w.x = pack2(t[(k8 + 0) * 65 + c], t[(k8 + 1) * 65 + c]); w.y = pack2(t[(k8 + 2) * 65 + c], t[(k8 + 3) * 65 + c]);
          w.z = pack2(t[(k8 + 4) * 65 + c], t[(k8 + 5) * 65 + c]); w.w = pack2(t[(k8 + 6) * 65 + c], t[(k8 + 7) * 65 + c]);
          *(u32x4*)(Wt + (size_t)dr * K + k0 + k8) = w; }
    }
    __syncthreads();
}

__device__ __forceinline__ void load_row(const float* src, int row, int lane, f32x4 (&v)[4]) {
#pragma unroll
    for (int i = 0; i < 4; ++i) v[i] = *(const f32x4*)(src + (size_t)row * DM + i * 256 + lane * 4);
}
__device__ __forceinline__ void load_row_b(const bf16_t* src, int row, int lane, f32x4 (&v)[4]) {
#pragma unroll
    for (int i = 0; i < 4; ++i) { const u32x2 w = *(const u32x2*)(src + (size_t)row * DM + i * 256 + lane * 4);
        v[i][0] = __uint_as_float(w.x << 16); v[i][1] = __uint_as_float(w.x & 0xffff0000u); v[i][2] = __uint_as_float(w.y << 16); v[i][3] = __uint_as_float(w.y & 0xffff0000u); }
}
__device__ __forceinline__ float row_rstd(const f32x4 (&v)[4]) {
    float s = 0.f;
#pragma unroll
    for (int i = 0; i < 4; ++i) s += v[i][0] * v[i][0] + v[i][1] * v[i][1] + v[i][2] * v[i][2] + v[i][3] * v[i][3];
    s = wave_sum(s);
    return rsqrtf(s * (1.0f / DM) + NORM_EPS);
}
__device__ __forceinline__ void store_row_bf16(bf16_t* dst, int row, int lane, const f32x4 (&v)[4]) {
#pragma unroll
    for (int i = 0; i < 4; ++i) { u32x2 w; w.x = pack2(v[i][0], v[i][1]); w.y = pack2(v[i][2], v[i][3]); *(u32x2*)(dst + (size_t)row * DM + i * 256 + lane * 4) = w; }
}

__device__ __forceinline__ void store_row_fp8(unsigned char* dst, float* scale, int row, int lane, const f32x4 (&v)[4]) {
    float am = 0.f;
#pragma unroll
    for (int i = 0; i < 4; ++i) am = fmaxf(fmaxf(am, fmaxf(fabsf(v[i][0]), fabsf(v[i][1]))), fmaxf(fabsf(v[i][2]), fabsf(v[i][3])));
    am = wave_max(am);
    const float sc = am > 0.f ? am * (1.0f / FP8_TOP) : 1.0f, inv = 1.0f / sc;
#pragma unroll
    for (int i = 0; i < 4; ++i) *(unsigned*)(dst + (size_t)row * DM + i * 256 + lane * 4) = pack4_fp8(v[i][0] * inv, v[i][1] * inv, v[i][2] * inv, v[i][3] * inv);
    if (lane == 0) scale[row] = sc;
}
template <int K, bool NORMS>
__device__ __forceinline__ void quant_rows(KPTR p, LAS unsigned char* lds, const bf16_t* src, unsigned char* dst, float* scl, int nrows, int bid, int nb, int wv) {
    constexpr int NC = K / 512;
    const int tid = opaque_tid(wv), wid = tid >> 6, lane = tid & 63;
    LAS unsigned* nmx = (LAS unsigned*)lds;
    if (NORMS) { if (tid < 2 * NE) nmx[tid] = 0u; __syncthreads(); }
    int row = bid * 8 + wid;
    u32x4 nx[NC];
#pragma unroll
    for (int c = 0; c < NC; ++c) nx[c] = (u32x4){0u, 0u, 0u, 0u};
    if (row < nrows) {
#pragma unroll
        for (int c = 0; c < NC; ++c) nx[c] = *(const u32x4*)(src + (size_t)row * K + (c * 64 + lane) * 8); }
    for (; row < nrows; row += nb * 8) {
        u32x4 cu[NC];
#pragma unroll
        for (int c = 0; c < NC; ++c) cu[c] = nx[c];
        const int rn = row + nb * 8;
        if (rn < nrows) {
#pragma unroll
            for (int c = 0; c < NC; ++c) nx[c] = *(const u32x4*)(src + (size_t)rn * K + (c * 64 + lane) * 8); }
        float am = 0.f, ss = 0.f;
#pragma unroll
        for (int c = 0; c < NC; ++c)
#pragma unroll
            for (int q = 0; q < 4; ++q) { const float lo = __uint_as_float(cu[c][q] << 16), hi = __uint_as_float(cu[c][q] & 0xffff0000u); am = fmaxf(am, fmaxf(fabsf(lo), fabsf(hi))); if (NORMS) ss += lo * lo + hi * hi; }
        am = wave_max(am);
        const float sc = am > 0.f ? am * (1.0f / FP8_TOP) : 1.0f, inv = 1.0f / sc;
#pragma unroll
        for (int c = 0; c < NC; ++c) { u32x2 w;
            w.x = pack4_fp8(__uint_as_float(cu[c][0] << 16) * inv, __uint_as_float(cu[c][0] & 0xffff0000u) * inv, __uint_as_float(cu[c][1] << 16) * inv, __uint_as_float(cu[c][1] & 0xffff0000u) * inv);
            w.y = pack4_fp8(__uint_as_float(cu[c][2] << 16) * inv, __uint_as_float(cu[c][2] & 0xffff0000u) * inv, __uint_as_float(cu[c][3] << 16) * inv, __uint_as_float(cu[c][3] & 0xffff0000u) * inv);
            *(u32x2*)(dst + (size_t)row * K + (c * 64 + lane) * 8) = w; }
        if (lane == 0) scl[row] = sc;
        if (NORMS) { ss = wave_sum(ss); if (lane == 0) LDS_ATOMIC_MAX(nmx + ((row >> 7) & 1) * NE + row / (2 * FFE), __float_as_uint(sqrtf(ss))); }
    }
    if (NORMS) { __syncthreads(); if (tid < 2 * NE) (void)GLOBAL_ATOMIC_MAX(p->ctrl + (tid < NE ? C_GMAX + tid : C_UMAX + tid - NE), nmx[tid]); __syncthreads(); }
}
__device__ __forceinline__ const float* gu_src(KPTR p, int item, int t, int kr, int c4) {
    constexpr int NPAN = FFE / 32;
    const int e = item / (2 * NPAN), r = item % (2 * NPAN), up = r / NPAN, pn = r % NPAN;
    return (up ? p->w_mup : p->w_mgate) + (size_t)e * DM * FFE + (size_t)(t * 64 + kr) * FFE + pn * 32 + c4;
}
__device__ __forceinline__ void convert_gu_fp8(KPTR p, LAS unsigned char* lds, int bid, int nb, int wv) {
    constexpr int PSF = 1028, NPAN = FFE / 32, NITEM = NE * 2 * NPAN, TPI = DM / 64;
    const int tid = opaque_tid(wv), wid = tid >> 6, lane = tid & 63;
    LAS float* pan = (LAS float*)lds;
    LAS float* red = pan + 32 * PSF;
    LAS float* scl = red + 8 * 32 * 2;
    const int c4 = (tid & 7) * 4, kr = tid >> 3;
    const int nmine = bid < NITEM ? (NITEM - bid + nb - 1) / nb : 0, total = nmine * TPI;
    if (nmine == 0) return;
    constexpr int PD = 8;
    static_assert(TPI % PD == 0, "ring");
    f32x4 pf[PD];
#pragma unroll
    for (int i = 0; i < PD; ++i) { const int gi = i < total ? i : total - 1; pf[i] = *(const f32x4*)gu_src(p, bid + (gi / TPI) * nb, gi % TPI, kr, c4); }
    int g = 0;
    for (int it = 0; it < nmine; ++it) {
        const int item = bid + it * nb, e = item / (2 * NPAN), r = item % (2 * NPAN), up = r / NPAN, pn = r % NPAN;
        float am[4] = {0.f, 0.f, 0.f, 0.f}, ss[4] = {0.f, 0.f, 0.f, 0.f};
        for (int t0 = 0; t0 < TPI; t0 += PD) {
#pragma unroll
            for (int u = 0; u < PD; ++u, ++g) { const int t = t0 + u;
                const f32x4 v = pf[u];
                { int gn = g + PD; gn = gn < total ? gn : total - 1; int kr2 = kr; OPAQUE_V(kr2); pf[u] = *(const f32x4*)gu_src(p, bid + (gn / TPI) * nb, gn % TPI, kr2, c4); }
#pragma unroll
                for (int j = 0; j < 4; ++j) { am[j] = fmaxf(am[j], fabsf(v[j])); ss[j] += v[j] * v[j]; pan[(c4 + j) * PSF + t * 64 + kr] = v[j]; }
            }
        }
#pragma unroll
        for (int j = 0; j < 4; ++j) {
#pragma unroll
            for (int o = 8; o <= 32; o <<= 1) { am[j] = fmaxf(am[j], __shfl_xor(am[j], o)); ss[j] += __shfl_xor(ss[j], o); }
        }
        if ((lane >> 3) == 0) {
#pragma unroll
            for (int j = 0; j < 4; ++j) { red[(wid * 32 + c4 + j) * 2] = am[j]; red[(wid * 32 + c4 + j) * 2 + 1] = ss[j]; } }
        __syncthreads();
        if (tid < 64) { float a = 0.f, q = 0.f;
            if (tid < 32) {
#pragma unroll
                for (int w = 0; w < 8; ++w) { a = fmaxf(a, red[(w * 32 + tid) * 2]); q += red[(w * 32 + tid) * 2 + 1]; }
                const float sc = a > 0.f ? a * (1.0f / FP8_TOP) : 1.0f; scl[tid] = sc; scl[32 + tid] = 1.0f / sc;
                const int cc = pn * 32 + tid; p->ws_mgu[(size_t)e * 2 * FFE + (cc >> 7) * 256 + (cc & 127) + up * 128] = sc; }
            const float nm = wave_max(tid < 32 ? sqrtf(q) : 0.f);
            if (tid == 0) (void)GLOBAL_ATOMIC_MAX(p->ctrl + (up ? C_UMAX : C_GMAX) + e, __float_as_uint(nm)); }
        __syncthreads();
#pragma unroll
        for (int i2 = 0; i2 < 8; ++i2) { const int n = i2 * 4 + (tid >> 7), k8 = (tid & 127) * 8, cc = pn * 32 + n;
            const f32x4 a = *(LAS const f32x4*)(pan + n * PSF + k8), b = *(LAS const f32x4*)(pan + n * PSF + k8 + 4); const float inv = scl[32 + n];
            u32x2 w; w.x = pack4_fp8(a[0] * inv, a[1] * inv, a[2] * inv, a[3] * inv); w.y = pack4_fp8(b[0] * inv, b[1] * inv, b[2] * inv, b[3] * inv);
            *(u32x2*)(p->w8_mgu + ((size_t)e * 2 * FFE + (cc >> 7) * 256 + (cc & 127) + up * 128) * DM + k8) = w; }
        __syncthreads();
    }
}
template <bool WITH_GDN, bool OUT8 = false, bool SRCB = false>
__device__ __forceinline__ void phase_norm(KPTR p, const void* src, const float* gain, int bid, int nb, int wv) {
    const int tid = opaque_tid(wv), wid = tid >> 6, lane = tid & 63;
    f32x4 gv[4];
#pragma unroll
    for (int i = 0; i < 4; ++i) gv[i] = *(const f32x4*)(gain + i * 256 + lane * 4);
    f32x4 w8[WITH_GDN ? 16 : 1][2];
    if (WITH_GDN) {
#pragma unroll
        for (int i = 0; i < 4; ++i)
#pragma unroll
            for (int e = 0; e < 4; ++e) { const float* wr_ = p->w_in + (size_t)(i * 256 + lane * 4 + e) * DIN + DINP; w8[i * 4 + e][0] = *(const f32x4*)wr_; w8[i * 4 + e][1] = *(const f32x4*)(wr_ + 4); }
    }
    for (int row = bid * 8 + wid; row < NTOK; row += nb * 8) {
        f32x4 v[4]; if (SRCB) load_row_b((const bf16_t*)src, row, lane, v); else load_row((const float*)src, row, lane, v);
        const float rs = row_rstd(v);
#pragma unroll
        for (int i = 0; i < 4; ++i) v[i] = v[i] * rs * gv[i];
        if (OUT8) store_row_fp8((unsigned char*)p->hn, p->hns, row, lane, v); else store_row_bf16(p->hn, row, lane, v);
        if (WITH_GDN) {
            f32x4 d0 = (f32x4){0.f, 0.f, 0.f, 0.f}, d1 = (f32x4){0.f, 0.f, 0.f, 0.f};
#pragma unroll
            for (int i = 0; i < 4; ++i)
#pragma unroll
                for (int e = 0; e < 4; ++e) { const float xv = v[i][e]; d0 = d0 + w8[i * 4 + e][0] * xv; d1 = d1 + w8[i * 4 + e][1] * xv; }
            float d[8] = {d0[0], d0[1], d0[2], d0[3], d1[0], d1[1], d1[2], d1[3]};
#pragma unroll
            for (int j = 0; j < 8; ++j) d[j] = wave_sum(d[j]);
            if (lane < 4) {
                const float braw = lane == 0 ? d[0] : lane == 1 ? d[1] : lane == 2 ? d[2] : d[3];
                const float araw = lane == 0 ? d[4] : lane == 1 ? d[5] : lane == 2 ? d[6] : d[7];
                p->gbeta[(size_t)row * 4 + lane] = 1.0f / (1.0f + __expf(-braw));
                const float z = araw + p->dt_bias[lane];
                const float sp = z > 20.f ? z : log1pf(__expf(z));
                p->gg[(size_t)row * 4 + lane] = -__expf(p->a_log[lane]) * sp;
            }
        }
    }
}

constexpr int IMG_W = 0, IMG_QD = 17408, IMG_KDT = 34816, IMG_AT = 53248, IMG_U = 62464, IMG_CH = 78848;
__host__ __device__ constexpr int permb(int k) { return (k >> 5) * 64 + ((((k & 15) >> 2) * 8) + (((k >> 4) & 1) * 4) + (k & 3)) * 2; }
__device__ __forceinline__ bf16x8 frag2(LAS const unsigned char* ptr) {
    const u32x2 lo = *(LAS const u32x2*)ptr, hi = *(LAS const u32x2*)(ptr + 32);
    u32x4 w; w.x = lo.x; w.y = lo.y; w.z = hi.x; w.w = hi.y; bf16x8 r; __builtin_memcpy(&r, &w, 16); return r;
}
__device__ __forceinline__ bf16x8 pack8(const f32x4 a, const f32x4 b) {
    u32x4 w; w.x = pack2(a[0], a[1]); w.y = pack2(a[2], a[3]); w.z = pack2(b[0], b[1]); w.w = pack2(b[2], b[3]); bf16x8 r; __builtin_memcpy(&r, &w, 16); return r;
}


#ifndef CPU_EMU
__device__ __forceinline__ void st_wt32(void* p, unsigned v) { __hip_atomic_store((unsigned*)p, v, __ATOMIC_RELAXED, __HIP_MEMORY_SCOPE_AGENT); }
__device__ __forceinline__ void st_wt64(void* p, u32x2 v) { unsigned long long x = ((unsigned long long)v.y << 32) | v.x; __hip_atomic_store((unsigned long long*)p, x, __ATOMIC_RELAXED, __HIP_MEMORY_SCOPE_AGENT); }
#else
static inline void st_wt32(void* p, unsigned v) { *(unsigned*)p = v; }
static inline void st_wt64(void* p, u32x2 v) { *(u32x2*)p = v; }
#endif

#ifndef CPU_EMU
__device__ __forceinline__ void gdn_publish(unsigned* flag, int tid) {
    asm volatile("s_waitcnt vmcnt(0)" ::: "memory");
    __syncthreads();
    if (tid == 0) __hip_atomic_store(flag, 1u, __ATOMIC_RELAXED, __HIP_MEMORY_SCOPE_AGENT);
}
__device__ __forceinline__ void gdn_wait8(const unsigned* flags, int c, int nmax, int lane) {
    const int k = c + (lane & 7); const bool need = k < nmax;
    unsigned spins = 0;
    for (;;) {
        const unsigned v = need ? __hip_atomic_load(flags + k, __ATOMIC_RELAXED, __HIP_MEMORY_SCOPE_AGENT) : 1u;
        if (__all(v != 0u)) break;
        __builtin_amdgcn_s_sleep(4); if (++spins > (1u << 22)) break;
    }
    __builtin_amdgcn_fence(__ATOMIC_ACQUIRE, "agent");
}
__device__ __forceinline__ float ld_coherent(const float* p) { return __uint_as_float(__hip_atomic_load((const unsigned*)p, __ATOMIC_RELAXED, __HIP_MEMORY_SCOPE_AGENT)); }
#else
static inline void gdn_publish(unsigned* flag, int tid) { __syncthreads(); if (tid == 0) __atomic_store_n(flag, 1u, __ATOMIC_SEQ_CST); }
static inline void gdn_wait8(const unsigned* flags, int c, int nmax, int lane) { for (int k = c; k < c + 8 && k < nmax; ++k) while (__atomic_load_n(flags + k, __ATOMIC_SEQ_CST) == 0) emu::yield(); }
static inline float ld_coherent(const float* p) { return *p; }
#endif

template <int I> struct TSolve {
    static __device__ __forceinline__ void run(float (&tc)[64], LAS const float* sL, LAS unsigned char* tb, int lane) {
        TSolve<I - 1>::run(tc, sL, tb, lane);
        float p0 = 0.f, p1 = 0.f, p2 = 0.f, p3 = 0.f;
#pragma unroll
        for (int j = 0; j < I; ++j) { const float pr = sL[I * 68 + j] * tc[j]; if ((j & 3) == 0) p0 += pr; else if ((j & 3) == 1) p1 += pr; else if ((j & 3) == 2) p2 += pr; else p3 += pr; }
        const float t2 = ((I == lane) ? 1.f : 0.f) - ((p0 + p1) + (p2 + p3));
        tc[I] = t2; *(LAS bf16_t*)(tb + I * 144 + 2 * lane) = f2bf(t2);
    }
};
template <> struct TSolve<-1> { static __device__ __forceinline__ void run(float (&)[64], LAS const float*, LAS unsigned char*, int) {} };

template <bool PUBLISH>
__device__ __forceinline__ void phase_gdn_pre(KPTR p, LAS unsigned char* lds, int first, int stride, int wv) {
    constexpr int QB = 0, KB = 17408, VBT = 34816, KBT = 53248, KDT = 71680, LF = 90112, TB = 107520, ATB = 116736, SG = 125952, SBE = 126208;
    const int tid0 = opaque_tid(wv);
    LAS float* sL = (LAS float*)(lds + LF); LAS float* sg = (LAS float*)(lds + SG); LAS float* sb = (LAS float*)(lds + SBE);
    const bf16_t* proj = p->proj; const float* conv_w = p->conv_w; const float* gg = p->gg; const float* gbeta = p->gbeta; unsigned char* gimg = p->gimg; float* gcdec = p->gcdec;
    for (int uu = first; uu < NCHH; uu += stride) {
        int tid = tid0; OPAQUE_V(tid);
        const int wid = tid >> 6, lane = tid & 63, fr = lane & 15, q4 = lane >> 4;
        const int n = uu / (BATCH * 4), bh_ = uu % (BATCH * 4), h = bh_ & 3, b = bh_ >> 2;
        const int unit = bh_ * NCH + n;
        const size_t tok0 = (size_t)b * SEQ + (size_t)n * 64;
        unsigned char* img = gimg + (size_t)unit * IMG_CH;
        __syncthreads();
        if (wid == 0) { float gsum = gg[(tok0 + lane) * 4 + h]; for (int o = 1; o < 64; o <<= 1) { const float t2 = __shfl_up(gsum, o); if (lane >= o) gsum += t2; } sg[lane] = gsum; sb[lane] = gbeta[(tok0 + lane) * 4 + h]; }
        __syncthreads();
        const float glast = sg[63];
        unsigned xall[3][11];
#pragma unroll
        for (int w3 = 0; w3 < 3; ++w3) { const int cc = w3 * 512 + h * 128 + 2 * lane;
#pragma unroll
            for (int r = 0; r < 11; ++r) { const int tt = n * 64 + wid * 8 - 3 + r; xall[w3][r] = tt >= 0 ? *(const unsigned*)(proj + ((size_t)b * SEQ + tt) * DINP + 2048 + cc) : 0u; } }
#pragma unroll
        for (int which = 0; which < 3; ++which) {
            const int rb = wid, c0 = which * 512 + h * 128 + 2 * lane;
            float cw0[4], cw1[4];
#pragma unroll
            for (int kk = 0; kk < 4; ++kk) { cw0[kk] = conv_w[kk * 1536 + c0]; cw1[kk] = conv_w[kk * 1536 + c0 + 1]; }
            unsigned xv[11];
#pragma unroll
            for (int r = 0; r < 11; ++r) xv[r] = xall[which][r];
            float a0[8], a1[8], ss[8];
#pragma unroll
            for (int i8 = 0; i8 < 8; ++i8) { float y0 = 0.f, y1 = 0.f;
#pragma unroll
                for (int kk = 0; kk < 4; ++kk) { y0 += cw0[kk] * __uint_as_float(xv[i8 + kk] << 16); y1 += cw1[kk] * __uint_as_float(xv[i8 + kk] & 0xffff0000u); }
                a0[i8] = siluf(y0); a1[i8] = siluf(y1); ss[i8] = a0[i8] * a0[i8] + a1[i8] * a1[i8]; }
            if (which != 2) {
#pragma unroll
                for (int i8 = 0; i8 < 8; ++i8) ss[i8] = wave_sum(ss[i8]);
            }
#pragma unroll
            for (int i8 = 0; i8 < 8; ++i8) {
                const int i = rb * 8 + i8;
                const float gi = sg[i], bi = sb[i], eg = __expf(gi);
                if (which == 2) {
                    *(LAS bf16_t*)(lds + VBT + (2 * lane) * 144 + 2 * i) = f2bf(a0[i8] * bi); *(LAS bf16_t*)(lds + VBT + (2 * lane + 1) * 144 + 2 * i) = f2bf(a1[i8] * bi);
                } else {
                    const float sc = rsqrtf(ss[i8] + NORM_EPS) * (which == 0 ? 0.08838834764831845f : 1.0f);
                    const float n0 = a0[i8] * sc, n1 = a1[i8] * sc;
                    if (which == 0) { *(LAS unsigned*)(lds + QB + i * 272 + 4 * lane) = pack2(n0, n1); st_wt32(img + IMG_QD + i * 272 + permb(2 * lane), pack2(n0 * eg, n1 * eg)); }
                    else { *(LAS unsigned*)(lds + KB + i * 272 + 4 * lane) = pack2(n0, n1);
                        const float f1 = bi * eg, f2 = __expf(glast - gi);
                        *(LAS bf16_t*)(lds + KBT + (2 * lane) * 144 + 2 * i) = f2bf(n0 * f1); *(LAS bf16_t*)(lds + KBT + (2 * lane + 1) * 144 + 2 * i) = f2bf(n1 * f1);
                        *(LAS bf16_t*)(lds + KDT + (2 * lane) * 144 + permb(i)) = f2bf(n0 * f2); *(LAS bf16_t*)(lds + KDT + (2 * lane + 1) * 144 + permb(i)) = f2bf(n1 * f2); }
                }
            }
        }
        __syncthreads();
        {
            const int mat = wid >> 2, itile = wid & 3;
            LAS const unsigned char* abase = lds + (mat == 0 ? KB : QB) + (16 * itile + fr) * 272 + 16 * q4;
            bf16x8 af[4];
#pragma unroll
            for (int s4 = 0; s4 < 4; ++s4) af[s4] = *(LAS const bf16x8*)(abase + 64 * s4);
#pragma unroll
            for (int nt = 0; nt < 4; ++nt) {
                f32x4 acc = (f32x4){0.f, 0.f, 0.f, 0.f};
                if (nt <= itile) {
#pragma unroll
                    for (int s4 = 0; s4 < 4; ++s4) { const bf16x8 bfr = *(LAS const bf16x8*)(lds + KB + (16 * nt + fr) * 272 + 16 * q4 + 64 * s4);
                        acc = __builtin_amdgcn_mfma_f32_16x16x32_bf16(af[s4], bfr, acc, 0, 0, 0); }
                }
                const int j = 16 * nt + fr; const float gj = sg[j];
#pragma unroll
                for (int r = 0; r < 4; ++r) { const int i = 16 * itile + 4 * q4 + r; const float dec = __expf(sg[i] - gj);
                    if (mat == 0) sL[i * 68 + j] = i > j ? sb[i] * acc[r] * dec : 0.f;
                    else *(LAS bf16_t*)(lds + ATB + i * 144 + permb(j)) = f2bf(i >= j ? acc[r] * dec : 0.f); }
            }
        }
        __syncthreads();
        if (wid == 0) {
            float tc[64];
            TSolve<63>::run(tc, sL, lds + TB, lane);
        } else {
            for (int pc = tid - 64; pc < 1152 + 576; pc += NTHREADS - 64) {
                if (pc < 1152) { const u32x4 v4 = *(LAS const u32x4*)(lds + KDT + pc * 16); u32x2 a; a.x = v4.x; a.y = v4.y; u32x2 c; c.x = v4.z; c.y = v4.w; st_wt64(img + IMG_KDT + pc * 16, a); st_wt64(img + IMG_KDT + pc * 16 + 8, c); }
                else { const u32x4 v4 = *(LAS const u32x4*)(lds + ATB + (pc - 1152) * 16); u32x2 a; a.x = v4.x; a.y = v4.y; u32x2 c; c.x = v4.z; c.y = v4.w; st_wt64(img + IMG_AT + (pc - 1152) * 16, a); st_wt64(img + IMG_AT + (pc - 1152) * 16 + 8, c); }
            }
        }
        __syncthreads();
        {
            const int itile = wid & 3;
            bf16x8 tf[2];
#pragma unroll
            for (int s2 = 0; s2 < 2; ++s2) tf[s2] = *(LAS const bf16x8*)(lds + TB + (16 * itile + fr) * 144 + 16 * q4 + 64 * s2);
#pragma unroll
            for (int nt = 0; nt < 8; ++nt) {
                f32x4 acc = (f32x4){0.f, 0.f, 0.f, 0.f};
                if (wid < 4) {
#pragma unroll
                    for (int s2 = 0; s2 < 2; ++s2) { const bf16x8 bfr = *(LAS const bf16x8*)(lds + VBT + (16 * nt + fr) * 144 + 16 * q4 + 64 * s2);
                        acc = __builtin_amdgcn_mfma_f32_16x16x32_bf16(tf[s2], bfr, acc, 0, 0, 0); }
                    u32x2 w; w.x = pack2(acc[0], acc[1]); w.y = pack2(acc[2], acc[3]);
                    st_wt64(img + IMG_U + ((nt * 4 + itile) * 64 + lane) * 8, w);
                } else {
#pragma unroll
                    for (int s2 = 0; s2 < 2; ++s2) { const bf16x8 afr = *(LAS const bf16x8*)(lds + KBT + (16 * nt + fr) * 144 + 16 * q4 + 64 * s2);
                        acc = __builtin_amdgcn_mfma_f32_16x16x32_bf16(afr, tf[s2], acc, 0, 0, 0); }
                    u32x2 w; w.x = pack2(acc[0], acc[1]); w.y = pack2(acc[2], acc[3]);
                    st_wt64(img + IMG_W + (16 * itile + fr) * 272 + permb(16 * nt + 4 * q4), w);
                }
            }
        }
        if (tid == 0) st_wt32(gcdec + unit, __float_as_uint(__expf(glast)));
        if (PUBLISH) gdn_publish(p->gflag + unit, tid);
    }
}

constexpr int NCW = 2, NLT = NTHREADS - 64 * NCW;
constexpr int STG = 62464 + NCW * 2048;
#define LDF(ptr) (*(LAS const bf16x8*)(ptr))
#define MF16(a, b, c) __builtin_amdgcn_mfma_f32_16x16x32_bf16((a), (b), (c), 0, 0, 0)
__device__ __forceinline__ void scan_store_ot(bf16_t* op, const f32x4 (&ao)[4]) {
#pragma unroll
    for (int it = 0; it < 4; ++it) { u32x2 w; w.x = pack2(ao[it][0], ao[it][1]); w.y = pack2(ao[it][2], ao[it][3]); *(u32x2*)(op + (size_t)(16 * it) * DM) = w; }
}
__device__ __forceinline__ void scan_store_o(bf16_t* op, const f32x4 (&ao)[4], int q4) {
#pragma unroll
    for (int it = 0; it < 4; ++it)
#pragma unroll
        for (int r = 0; r < 4; ++r) op[(size_t)(16 * it + 4 * q4 + r) * DM] = f2bf(ao[it][r]);
}
__device__ __forceinline__ bf16x8 asfrag(const u32x4 v) { bf16x8 r; __builtin_memcpy(&r, &v, 16); return r; }
#define LDR(ptr) (*(LAS const u32x4*)(ptr))
template <bool WAITF>
__device__ __forceinline__ void scan_gdn(KPTR p, LAS unsigned char* lds, int b, int h, int qt, int wv) {
    const unsigned* gflag = p->gflag + (size_t)(b * 4 + h) * NCH;
    const int tid = opaque_tid(wv), wid = tid >> 6, lane = tid & 63, fr = lane & 15, q4 = lane >> 4;
    const unsigned char* gimg = p->gimg; const float* gcdec = p->gcdec + (size_t)(b * 4 + h) * NCH; bf16_t* out = p->hn;
    const bool loader = wid >= NCW;
    const int cw = wid, lt = tid - 64 * NCW;
    f32x4 S[8];
#pragma unroll
    for (int dt = 0; dt < 8; ++dt) S[dt] = (f32x4){0.f, 0.f, 0.f, 0.f};
    constexpr int NLG = NLT / 2;
    constexpr int NPC = 3904 + NCW * 128, NPR = (NPC + NLG - 1) / NLG;
    static_assert(NPR >= 16, "compute waves use R[0..7] and R[8..15] as their two operand batches");
    u32x4 R[NPR];
    float cdv = 0.f;
    constexpr int OUTB = 2 * STG, CDB = OUTB + 8192;
    const int grp = lt >= NLG ? 1 : 0, lg_ = lt - grp * NLG;
    const unsigned char* base = gimg + (size_t)(b * 4 + h) * NCH * IMG_CH;
#define GDN_PREFETCH(nn) do { int _lg = lg_; OPAQUE_V(_lg); const unsigned char* _src = base + (size_t)(nn) * IMG_CH; _Pragma("unroll") for (int _i = 0; _i < NPR; ++_i) { int _pc = _lg + NLG * _i; _pc = _pc < NPC ? _pc : NPC - 1; \
        const int _so = _pc < 3904 ? _pc * 16 : IMG_U + qt * (NCW * 2048) + (_pc - 3904) * 16; R[_i] = *(const u32x4*)(_src + _so); } cdv = ld_coherent(gcdec + (nn)); } while (0)
    int avail = 0;
    if (loader && grp < NCH) { if (WAITF) { gdn_wait8(gflag, 0, NCH, lane); avail = 8; } GDN_PREFETCH(grp); }
    float cd_next = 0.f;
    __syncthreads();
    auto load_step = [&](int nn) {
        if (nn < NCH && (nn & 1) == grp) {
            LAS unsigned char* buf = lds + (nn & 1) * STG;
#pragma unroll
            for (int i = 0; i < NPR; ++i) { int pc = lg_ + NLG * i; pc = pc < NPC ? pc : NPC - 1; *(LAS u32x4*)(buf + pc * 16) = R[i]; }
            if (lg_ == 0) *(LAS float*)(lds + CDB + (nn & 1) * 8) = cdv;
            if (nn + 2 < NCH) { if (WAITF && nn + 2 >= avail) { gdn_wait8(gflag, avail, NCH, lane); avail += 8; } GDN_PREFETCH(nn + 2); }
        }
    };
    auto flush = [&](int n) {
        for (int pc = lg_; pc < NCW * 256; pc += NLG) { const int cwi = pc >> 8, it = (pc >> 6) & 3, ln = pc & 63;
            const u32x2 w = *(LAS const u32x2*)(lds + OUTB + (n & 1) * 4096 + pc * 8);
            *(u32x2*)(out + ((size_t)b * SEQ + (size_t)n * 64 + 16 * it + (ln & 15)) * DM + 512 + h * 128 + 16 * (NCW * qt + cwi) + 4 * (ln >> 4)) = w; }
    };
    auto compute = [&](int n) {

            LAS const unsigned char* buf = lds + (n & 1) * STG;
            const float cd = *(LAS const float*)(lds + CDB + (n & 1) * 8);
            LAS const unsigned char* pw = buf + IMG_W + fr * 272 + 16 * q4;
            LAS const unsigned char* pq = buf + IMG_QD + fr * 272 + 16 * q4;
            LAS const unsigned char* pk = buf + IMG_KDT + fr * 144 + 16 * q4;
            LAS const unsigned char* pa = buf + IMG_AT + fr * 144 + 16 * q4;
            bf16x8 Sb[4];
#pragma unroll
            for (int s4 = 0; s4 < 4; ++s4) Sb[s4] = pack8(S[2 * s4], S[2 * s4 + 1]);
            f32x4 ao[4], av[4];
            u32x2 uu[4];
#pragma unroll
            for (int it = 0; it < 4; ++it) uu[it] = *(LAS const u32x2*)(buf + IMG_U + ((cw * 4 + it) * 64 + lane) * 8);
            u32x4* RA = R; u32x4* RB = R + 8;
#define GDN_LD_WQ(RR, it_) do { _Pragma("unroll") for (int s4 = 0; s4 < 4; ++s4) { RR[s4] = LDR(pw + (16 * (it_)) * 272 + 64 * s4); RR[4 + s4] = LDR(pq + (16 * (it_)) * 272 + 64 * s4); } } while (0)
#define GDN_LD_K(RR, dh_) do { _Pragma("unroll") for (int d2 = 0; d2 < 4; ++d2) _Pragma("unroll") for (int s2 = 0; s2 < 2; ++s2) RR[d2 * 2 + s2] = LDR(pk + (16 * (4 * (dh_) + d2)) * 144 + 64 * s2); } while (0)
#define GDN_MM_WQ(RR, it_) do { av[it_] = (f32x4){0.f, 0.f, 0.f, 0.f}; ao[it_] = (f32x4){0.f, 0.f, 0.f, 0.f}; \
        _Pragma("unroll") for (int s4 = 0; s4 < 4; ++s4) { av[it_] = MF16(asfrag(RR[s4]), Sb[s4], av[it_]); ao[it_] = MF16(Sb[s4], asfrag(RR[4 + s4]), ao[it_]); } } while (0)
#define GDN_MM_K(RR, dh_) do { _Pragma("unroll") for (int d2 = 0; d2 < 4; ++d2) { S[4 * (dh_) + d2] = S[4 * (dh_) + d2] * cd; \
        _Pragma("unroll") for (int s2 = 0; s2 < 2; ++s2) S[4 * (dh_) + d2] = MF16(asfrag(RR[d2 * 2 + s2]), Vb[s2], S[4 * (dh_) + d2]); } } while (0)
            GDN_LD_WQ(RA, 0); SCHED_FENCE();
            GDN_LD_WQ(RB, 1); SCHED_FENCE(); GDN_MM_WQ(RA, 0); SCHED_FENCE();
            GDN_LD_WQ(RA, 2); SCHED_FENCE(); GDN_MM_WQ(RB, 1); SCHED_FENCE();
            GDN_LD_WQ(RB, 3); SCHED_FENCE(); GDN_MM_WQ(RA, 2); SCHED_FENCE();
            GDN_LD_K(RA, 0); SCHED_FENCE(); GDN_MM_WQ(RB, 3); SCHED_FENCE();
#pragma unroll
            for (int it = 0; it < 4; ++it) {
                av[it][0] = __uint_as_float(uu[it].x << 16) - av[it][0]; av[it][1] = __uint_as_float(uu[it].x & 0xffff0000u) - av[it][1];
                av[it][2] = __uint_as_float(uu[it].y << 16) - av[it][2]; av[it][3] = __uint_as_float(uu[it].y & 0xffff0000u) - av[it][3]; }
            bf16x8 Vb[2];
#pragma unroll
            for (int s2 = 0; s2 < 2; ++s2) Vb[s2] = pack8(av[2 * s2], av[2 * s2 + 1]);
            GDN_LD_K(RB, 1); SCHED_FENCE(); GDN_MM_K(RA, 0); SCHED_FENCE();
#pragma unroll
            for (int it = 0; it < 4; ++it)
#pragma unroll
                for (int s2 = 0; s2 < 2; ++s2) R[it * 2 + s2] = LDR(pa + (16 * it) * 144 + 64 * s2);
            SCHED_FENCE(); GDN_MM_K(RB, 1); SCHED_FENCE();
#pragma unroll
            for (int it = 0; it < 4; ++it)
#pragma unroll
                for (int s2 = 0; s2 < 2; ++s2) ao[it] = MF16(Vb[s2], asfrag(R[it * 2 + s2]), ao[it]);
#undef GDN_LD_WQ
#undef GDN_LD_K
#undef GDN_MM_WQ
#undef GDN_MM_K
#pragma unroll
            for (int it = 0; it < 4; ++it) { u32x2 w; w.x = pack2(ao[it][0], ao[it][1]); w.y = pack2(ao[it][2], ao[it][3]); *(LAS u32x2*)(lds + OUTB + (n & 1) * 4096 + ((cw * 4 + it) * 64 + lane) * 8) = w; }
            };
    for (int n = -1; n < NCH; ++n) {
        if (loader) { load_step(n + 1); if (n >= 1 && (n & 1) == grp) flush(n - 1); } else if (n >= 0) compute(n);
        __syncthreads();
    }
    if (loader && grp == 0) flush(NCH - 1);
#undef GDN_PREFETCH
}
#ifndef CG_FORCE
#define CG_FORCE 0
#endif
constexpr int CG = CG_FORCE ? CG_FORCE : (NCH >= 256 ? 8 : 4), NG = NCH / CG;
template <int MODE>
__device__ __forceinline__ void scan_ret(KPTR p, LAS unsigned char* lds, int b, int h, int qt, int g, int wv) {
    const int n0 = g * CG;
    constexpr int R_Q = 0, R_K = 17408, R_KDT = 34816, R_VT = 53248;
    constexpr int RAT_OFF = 2 * STG;
    const int tid = opaque_tid(wv), wid = tid >> 6, lane = tid & 63, fr = lane & 15, q4 = lane >> 4;
    const bf16_t* proj = p->proj; bf16_t* out = p->hn; float* Lb = p->retL;
    const bool loader = wid >= NCW;
    const int cw = wid, lt = tid - 64 * NCW;
    const float lg = log1pf(-exp2f(-5.0f - (float)h));
    f32x4 S[8];
#pragma unroll
    for (int dt = 0; dt < 8; ++dt) S[dt] = (f32x4){0.f, 0.f, 0.f, 0.f};
    const float rcd = __expf(lg * 64.f), g1 = __expf(lg);
    if (MODE == 1 && !loader) {
        const float gdec = __expf(lg * (float)(64 * CG)); float wgt = 1.f;
        for (int gp = g - 1; gp >= 0; --gp) {
            const f32x4* lp = (const f32x4*)Lb + ((((size_t)(b * 4 + h) * NG + gp) * (8 / NCW) + qt) * NCW + cw) * 8 * 64 + lane;
#pragma unroll
            for (int dt = 0; dt < 8; ++dt) S[dt] = S[dt] + lp[dt * 64] * wgt;
            wgt *= gdec;
        }
    }
    float gi[4];
#pragma unroll
    for (int t4 = 0; t4 < 4; ++t4) gi[t4] = __expf(lg * (float)(16 * t4 + fr));
    constexpr int NLG = NLT / 2, NQG = (1024 + NLG - 1) / NLG, KB_N = 256 - NLG;
    static_assert(NLG >= 128 && NLG <= 256 && KB_N + 32 * NCW <= NLG, "task slots");
    u32x4 R[NQG + 8 < 16 ? 16 : NQG + 8];
    const int grp = lt >= NLG ? 1 : 0, lg_ = lt - grp * NLG;
#define RET_PREFETCH(nn) do { int _l = lg_; OPAQUE_V(_l); const bf16_t* _pq = proj + ((size_t)b * SEQ + (size_t)(n0 + (nn)) * 64) * DINP + h * 128; \
        _Pragma("unroll") for (int _i = 0; _i < NQG; ++_i) { int _pc = _l + NLG * _i; _pc = _pc < 1024 ? _pc : 1023; const int _row = _pc >> 4, _c = _pc & 15; R[_i] = *(const u32x4*)(_pq + (size_t)_row * DINP + _c * 8); } \
        _Pragma("unroll") for (int _r = 0; _r < 4; ++_r) R[NQG + _r] = *(const u32x4*)(_pq + (size_t)(4 * (_l >> 4) + _r) * DINP + 512 + (_l & 15) * 8); \
        { const bool _isk = _l < KB_N; int _v = _l - KB_N; _v = _v < 0 ? 0 : (_v < 32 * NCW ? _v : 32 * NCW - 1); const int _t = NLG + (_isk ? _l : 0); \
          const int _r0 = _isk ? 4 * (_t >> 4) : 4 * (_v >> 2), _co = _isk ? 512 + (_t & 15) * 8 : 1024 + 16 * NCW * qt + (_v & 3) * 8; \
          _Pragma("unroll") for (int _r = 0; _r < 4; ++_r) R[NQG + 4 + _r] = *(const u32x4*)(_pq + (size_t)(_r0 + _r) * DINP + _co); } } while (0)
#define RET_WRITE_K(RB_, t_) do { const int ig = (t_) >> 4, ck = (t_) & 15; float sc[4]; \
        _Pragma("unroll") for (int r = 0; r < 4; ++r) { sc[r] = 0.08838834764831845f * __expf(lg * (float)(63 - 4 * ig - r)); \
            u32x2 a; a.x = R[(RB_) + r].x; a.y = R[(RB_) + r].y; u32x2 c2; c2.x = R[(RB_) + r].z; c2.y = R[(RB_) + r].w; \
            *(LAS u32x2*)(buf + R_K + (4 * ig + r) * 272 + permb(8 * ck)) = a; *(LAS u32x2*)(buf + R_K + (4 * ig + r) * 272 + permb(8 * ck + 4)) = c2; } \
        _Pragma("unroll") for (int e = 0; e < 8; ++e) { const int wsel = e >> 1; float x[4]; \
            _Pragma("unroll") for (int r = 0; r < 4; ++r) x[r] = ((e & 1) ? __uint_as_float(R[(RB_) + r][wsel] & 0xffff0000u) : __uint_as_float(R[(RB_) + r][wsel] << 16)) * sc[r]; \
            u32x2 o; o.x = pack2(x[0], x[1]); o.y = pack2(x[2], x[3]); *(LAS u32x2*)(buf + R_KDT + (8 * ck + e) * 144 + permb(4 * ig)) = o; } } while (0)
    if (loader && grp < CG) RET_PREFETCH(grp);
    __syncthreads();
    auto load_step = [&](int nn) {
        if (nn < CG && (nn & 1) == grp) {
            LAS unsigned char* buf = lds + (nn & 1) * STG; int l2 = lg_; OPAQUE_V(l2);
#pragma unroll
            for (int i = 0; i < NQG; ++i) { int pc = l2 + NLG * i; pc = pc < 1024 ? pc : 1023; const int row = pc >> 4, c = pc & 15;
                u32x2 a; a.x = R[i].x; a.y = R[i].y; u32x2 c2; c2.x = R[i].z; c2.y = R[i].w;
                *(LAS u32x2*)(buf + R_Q + row * 272 + permb(8 * c)) = a; *(LAS u32x2*)(buf + R_Q + row * 272 + permb(8 * c + 4)) = c2; }
            RET_WRITE_K(NQG, l2);
            if (l2 < KB_N) { RET_WRITE_K(NQG + 4, NLG + l2); }
            else if (l2 < KB_N + 32 * NCW) { const int v = l2 - KB_N, igv = v >> 2, cv = v & 3;
#pragma unroll
                for (int e = 0; e < 8; ++e) { const int wsel = e >> 1, sh = 16 * (e & 1);
                    u32x2 o; o.x = ((R[NQG + 4][wsel] >> sh) & 0xffffu) | (((R[NQG + 5][wsel] >> sh) & 0xffffu) << 16); o.y = ((R[NQG + 6][wsel] >> sh) & 0xffffu) | (((R[NQG + 7][wsel] >> sh) & 0xffffu) << 16);
                    *(LAS u32x2*)(buf + R_VT + (8 * cv + e) * 144 + permb(4 * igv)) = o; } }
            if (nn + 2 < CG) RET_PREFETCH(nn + 2);
        }
    };
    auto scores = [&](int n) {
        LAS const unsigned char* buf = lds + (n & 1) * STG;
        const int lw = wid - NCW;
#pragma unroll
        for (int rep = 0; rep < 2; ++rep) {
            const int tl = lw + (NTHREADS / 64 - NCW) * rep;
            if (tl < 12) {
                int it, jt;
                if (tl < 1) { it = 0; jt = 0; } else if (tl < 3) { it = 1; jt = tl - 1; } else if (tl < 6) { it = 2; jt = tl - 3; } else if (tl < 10) { it = 3; jt = tl - 6; } else if (tl == 10) { it = 0; jt = 1; } else { it = 2; jt = 3; }
                f32x4 acc = (f32x4){0.f, 0.f, 0.f, 0.f};
                if (tl < 10) {
                    bf16x8 kf[4], qf[4];
#pragma unroll
                    for (int s4 = 0; s4 < 4; ++s4) { kf[s4] = LDF(buf + R_K + (16 * jt + fr) * 272 + 64 * s4 + 16 * q4); qf[s4] = LDF(buf + R_Q + (16 * it + fr) * 272 + 64 * s4 + 16 * q4); }
#pragma unroll
                    for (int s4 = 0; s4 < 4; ++s4) acc = MF16(kf[s4], qf[s4], acc);
                    const float gi_ = __expf(lg * (float)(16 * it + fr));
#pragma unroll
                    for (int r = 0; r < 4; ++r) { const int j = 16 * jt + 4 * q4 + r, i = 16 * it + fr;
                        acc[r] = i >= j ? acc[r] * gi_ * 0.08838834764831845f * __expf(-lg * (float)j) : 0.f; }
                }
                u32x2 w; w.x = pack2(acc[0], acc[1]); w.y = pack2(acc[2], acc[3]);
                *(LAS u32x2*)(lds + RAT_OFF + (16 * it + fr) * 144 + permb(16 * jt + 4 * q4)) = w;
            }
        }
    };
    f32x4 ot[4];
    bf16x8 Vf[2];
    auto computeA = [&](int n) {
        LAS const unsigned char* buf = lds + (n & 1) * STG;
        LAS const unsigned char* pq = buf + R_Q + fr * 272 + 16 * q4;
        LAS const unsigned char* pk = buf + R_KDT + fr * 144 + 16 * q4;
        bf16x8 Sb[4];
#pragma unroll
        for (int s4 = 0; s4 < 4; ++s4) Sb[s4] = pack8(S[2 * s4], S[2 * s4 + 1]);
#pragma unroll
        for (int s2 = 0; s2 < 2; ++s2) Vf[s2] = LDF(buf + R_VT + (16 * cw + fr) * 144 + 64 * s2 + 16 * q4);
        u32x4* RA = R; u32x4* RB = R + 8;
#define RET_LD_Q(RR, hh_) do { _Pragma("unroll") for (int i2 = 0; i2 < 2; ++i2) _Pragma("unroll") for (int s4 = 0; s4 < 4; ++s4) RR[i2 * 4 + s4] = LDR(pq + (16 * (2 * (hh_) + i2)) * 272 + 64 * s4); } while (0)
#define RET_LD_K(RR, dh_) do { _Pragma("unroll") for (int d2 = 0; d2 < 4; ++d2) _Pragma("unroll") for (int s2 = 0; s2 < 2; ++s2) RR[d2 * 2 + s2] = LDR(pk + (16 * (4 * (dh_) + d2)) * 144 + 64 * s2); } while (0)
#define RET_MM_Q(RR, hh_) do { _Pragma("unroll") for (int i2 = 0; i2 < 2; ++i2) { const int it = 2 * (hh_) + i2; ot[it] = (f32x4){0.f, 0.f, 0.f, 0.f}; \
        _Pragma("unroll") for (int s4 = 0; s4 < 4; ++s4) ot[it] = MF16(Sb[s4], asfrag(RR[i2 * 4 + s4]), ot[it]); \
        const float rd = gi[it] * g1; _Pragma("unroll") for (int r = 0; r < 4; ++r) ot[it][r] *= rd; } } while (0)
#define RET_MM_K(RR, dh_) do { _Pragma("unroll") for (int d2 = 0; d2 < 4; ++d2) { S[4 * (dh_) + d2] = S[4 * (dh_) + d2] * rcd; \
        _Pragma("unroll") for (int s2 = 0; s2 < 2; ++s2) S[4 * (dh_) + d2] = MF16(asfrag(RR[d2 * 2 + s2]), Vf[s2], S[4 * (dh_) + d2]); } } while (0)
        RET_LD_K(RA, 0); SCHED_FENCE();
        RET_LD_K(RB, 1); SCHED_FENCE(); RET_MM_K(RA, 0); SCHED_FENCE();
        if (MODE == 1) {
            RET_LD_Q(RA, 0); SCHED_FENCE(); RET_MM_K(RB, 1); SCHED_FENCE();
            RET_LD_Q(RB, 1); SCHED_FENCE(); RET_MM_Q(RA, 0); SCHED_FENCE();
            RET_MM_Q(RB, 1);
        } else { RET_MM_K(RB, 1); }
#undef RET_LD_Q
#undef RET_LD_K
#undef RET_MM_Q
#undef RET_MM_K
    };
    auto computeB = [&](int n) {
        LAS const unsigned char* pa = lds + RAT_OFF + fr * 144 + 16 * q4;
        R[0] = LDR(pa); R[1] = LDR(pa + 16 * 144); R[2] = LDR(pa + 32 * 144); R[3] = LDR(pa + 32 * 144 + 64); R[4] = LDR(pa + 48 * 144); R[5] = LDR(pa + 48 * 144 + 64);
        SCHED_FENCE();
        ot[0] = MF16(Vf[0], asfrag(R[0]), ot[0]); ot[1] = MF16(Vf[0], asfrag(R[1]), ot[1]);
        ot[2] = MF16(Vf[0], asfrag(R[2]), ot[2]); ot[2] = MF16(Vf[1], asfrag(R[3]), ot[2]);
        ot[3] = MF16(Vf[0], asfrag(R[4]), ot[3]); ot[3] = MF16(Vf[1], asfrag(R[5]), ot[3]);
        scan_store_ot(out + ((size_t)b * SEQ + (size_t)(n0 + n) * 64 + fr) * DM + h * 128 + 16 * (NCW * qt + cw) + 4 * q4, ot);
    };
    for (int n = -1; n < CG; ++n) {
        if (loader) { if (MODE == 1 && n >= 0) scores(n); load_step(n + 1); } else if (n >= 0) computeA(n);
        __syncthreads();
        if (MODE == 1) {
            if (!loader && n >= 0) computeB(n);
            __syncthreads();
        }
    }
    if (MODE == 0 && !loader) {
        f32x4* lp = (f32x4*)Lb + ((((size_t)(b * 4 + h) * NG + g) * (8 / NCW) + qt) * NCW + cw) * 8 * 64 + lane;
#pragma unroll
        for (int dt = 0; dt < 8; ++dt) lp[dt * 64] = S[dt];
    }
#undef RET_PREFETCH
#undef RET_WRITE_K
}
template <int MODE>
__device__ __forceinline__ void scan_ret_full(KPTR p, LAS unsigned char* lds, int b, int h, int g, int wv) {
    constexpr int F_Q = 0, F_K = 17408, F_KDT = 34816, F_VT = 53248, F_RAT = 71680;
    const int n0 = g * CG;
    const int tid = opaque_tid(wv), wid = tid >> 6, lane = tid & 63, fr = lane & 15, q4 = lane >> 4, cw = wid;
    const bf16_t* proj = p->proj; bf16_t* out = p->hn; float* Lb = p->retL;
    const float lg = log1pf(-exp2f(-5.0f - (float)h));
    const float rcd = __expf(lg * 64.f), g1 = __expf(lg);
    f32x4 S[8];
#pragma unroll
    for (int dt = 0; dt < 8; ++dt) S[dt] = (f32x4){0.f, 0.f, 0.f, 0.f};
    if (MODE == 1) {
        const float gdec = __expf(lg * (float)(64 * CG)); float wgt = 1.f;
        for (int gp = g - 1; gp >= 0; --gp) {
            const f32x4* lp = (const f32x4*)Lb + (((size_t)(b * 4 + h) * NG + gp) * 8 + cw) * 8 * 64 + lane;
#pragma unroll
            for (int dt = 0; dt < 8; ++dt) S[dt] = S[dt] + lp[dt * 64] * wgt;
            wgt *= gdec;
        }
    }
    float gi[4];
#pragma unroll
    for (int t4 = 0; t4 < 4; ++t4) gi[t4] = __expf(lg * (float)(16 * t4 + fr));
    u32x4 rq[2], rkv[4];
#define RF_PREFETCH(nn) do { int _l = tid; OPAQUE_V(_l); const bf16_t* _pq = proj + ((size_t)b * SEQ + (size_t)(n0 + (nn)) * 64) * DINP + h * 128; \
        _Pragma("unroll") for (int _i = 0; _i < 2; ++_i) { const int _pc = _l + NTHREADS * _i; rq[_i] = *(const u32x4*)(_pq + (size_t)(_pc >> 4) * DINP + (_pc & 15) * 8); } \
        { const bool _isk = _l < 256; const int _t = _isk ? _l : _l - 256; const int _r0 = 4 * (_t >> 4), _co = (_isk ? 512 : 1024) + (_t & 15) * 8; \
          _Pragma("unroll") for (int _r = 0; _r < 4; ++_r) rkv[_r] = *(const u32x4*)(_pq + (size_t)(_r0 + _r) * DINP + _co); } } while (0)
    auto write_stage = [&]() {
        int l2 = tid; OPAQUE_V(l2);
#pragma unroll
        for (int i = 0; i < 2; ++i) { const int pc = l2 + NTHREADS * i, row = pc >> 4, c = pc & 15;
            u32x2 a; a.x = rq[i].x; a.y = rq[i].y; u32x2 c2; c2.x = rq[i].z; c2.y = rq[i].w;
            *(LAS u32x2*)(lds + F_Q + row * 272 + permb(8 * c)) = a; *(LAS u32x2*)(lds + F_Q + row * 272 + permb(8 * c + 4)) = c2; }
        if (l2 < 256) { const int ig = l2 >> 4, ck = l2 & 15; float sc[4];
#pragma unroll
            for (int r = 0; r < 4; ++r) { sc[r] = 0.08838834764831845f * __expf(lg * (float)(63 - 4 * ig - r));
                u32x2 a; a.x = rkv[r].x; a.y = rkv[r].y; u32x2 c2; c2.x = rkv[r].z; c2.y = rkv[r].w;
                *(LAS u32x2*)(lds + F_K + (4 * ig + r) * 272 + permb(8 * ck)) = a; *(LAS u32x2*)(lds + F_K + (4 * ig + r) * 272 + permb(8 * ck + 4)) = c2; }
#pragma unroll
            for (int e = 0; e < 8; ++e) { const int wsel = e >> 1; float x[4];
#pragma unroll
                for (int r = 0; r < 4; ++r) x[r] = ((e & 1) ? __uint_as_float(rkv[r][wsel] & 0xffff0000u) : __uint_as_float(rkv[r][wsel] << 16)) * sc[r];
                u32x2 o; o.x = pack2(x[0], x[1]); o.y = pack2(x[2], x[3]); *(LAS u32x2*)(lds + F_KDT + (8 * ck + e) * 144 + permb(4 * ig)) = o; }
        } else { const int v = l2 - 256, igv = v >> 4, cv = v & 15;
#pragma unroll
            for (int e = 0; e < 8; ++e) { const int wsel = e >> 1, sh = 16 * (e & 1);
                u32x2 o; o.x = ((rkv[0][wsel] >> sh) & 0xffffu) | (((rkv[1][wsel] >> sh) & 0xffffu) << 16); o.y = ((rkv[2][wsel] >> sh) & 0xffffu) | (((rkv[3][wsel] >> sh) & 0xffffu) << 16);
                *(LAS u32x2*)(lds + F_VT + (8 * cv + e) * 144 + permb(4 * igv)) = o; } }
    };
    auto scores = [&]() {
#pragma unroll
        for (int rep = 0; rep < 2; ++rep) {
            const int tl = wid + 8 * rep;
            if (tl < 12) {
                int it, jt;
                if (tl < 1) { it = 0; jt = 0; } else if (tl < 3) { it = 1; jt = tl - 1; } else if (tl < 6) { it = 2; jt = tl - 3; } else if (tl < 10) { it = 3; jt = tl - 6; } else if (tl == 10) { it = 0; jt = 1; } else { it = 2; jt = 3; }
                f32x4 acc = (f32x4){0.f, 0.f, 0.f, 0.f};
                if (tl < 10) {
                    bf16x8 kf[4], qf[4];
#pragma unroll
                    for (int s4 = 0; s4 < 4; ++s4) { kf[s4] = LDF(lds + F_K + (16 * jt + fr) * 272 + 64 * s4 + 16 * q4); qf[s4] = LDF(lds + F_Q + (16 * it + fr) * 272 + 64 * s4 + 16 * q4); }
#pragma unroll
                    for (int s4 = 0; s4 < 4; ++s4) acc = MF16(kf[s4], qf[s4], acc);
                    const float gi_ = __expf(lg * (float)(16 * it + fr));
#pragma unroll
                    for (int r = 0; r < 4; ++r) { const int j = 16 * jt + 4 * q4 + r, i = 16 * it + fr;
                        acc[r] = i >= j ? acc[r] * gi_ * 0.08838834764831845f * __expf(-lg * (float)j) : 0.f; }
                }
                u32x2 w; w.x = pack2(acc[0], acc[1]); w.y = pack2(acc[2], acc[3]);
                *(LAS u32x2*)(lds + F_RAT + (16 * it + fr) * 144 + permb(16 * jt + 4 * q4)) = w;
            }
        }
    };
    RF_PREFETCH(0);
    __syncthreads();
    write_stage();
    if (CG > 1) RF_PREFETCH(1);
    __syncthreads();
    for (int n = 0; n < CG; ++n) {
        if (MODE == 1) { scores(); __syncthreads(); }
        {
            LAS const unsigned char* pq = lds + F_Q + fr * 272 + 16 * q4;
            LAS const unsigned char* pk = lds + F_KDT + fr * 144 + 16 * q4;
            bf16x8 Sb[4];
#pragma unroll
            for (int s4 = 0; s4 < 4; ++s4) Sb[s4] = pack8(S[2 * s4], S[2 * s4 + 1]);
            bf16x8 Vf[2];
#pragma unroll
            for (int s2 = 0; s2 < 2; ++s2) Vf[s2] = LDF(lds + F_VT + (16 * cw + fr) * 144 + 64 * s2 + 16 * q4);
            u32x4 RA[8], RB[8];
            f32x4 ot[4];
#define RF_LD_Q(RR, hh_) do { _Pragma("unroll") for (int i2 = 0; i2 < 2; ++i2) _Pragma("unroll") for (int s4 = 0; s4 < 4; ++s4) RR[i2 * 4 + s4] = LDR(pq + (16 * (2 * (hh_) + i2)) * 272 + 64 * s4); } while (0)
#define RF_LD_K(RR, dh_) do { _Pragma("unroll") for (int d2 = 0; d2 < 4; ++d2) _Pragma("unroll") for (int s2 = 0; s2 < 2; ++s2) RR[d2 * 2 + s2] = LDR(pk + (16 * (4 * (dh_) + d2)) * 144 + 64 * s2); } while (0)
#define RF_MM_Q(RR, hh_) do { _Pragma("unroll") for (int i2 = 0; i2 < 2; ++i2) { const int it = 2 * (hh_) + i2; ot[it] = (f32x4){0.f, 0.f, 0.f, 0.f}; \
        _Pragma("unroll") for (int s4 = 0; s4 < 4; ++s4) ot[it] = MF16(Sb[s4], asfrag(RR[i2 * 4 + s4]), ot[it]); \
        const float rd = gi[it] * g1; _Pragma("unroll") for (int r = 0; r < 4; ++r) ot[it][r] *= rd; } } while (0)
#define RF_MM_K(RR, dh_) do { _Pragma("unroll") for (int d2 = 0; d2 < 4; ++d2) { S[4 * (dh_) + d2] = S[4 * (dh_) + d2] * rcd; \
        _Pragma("unroll") for (int s2 = 0; s2 < 2; ++s2) S[4 * (dh_) + d2] = MF16(asfrag(RR[d2 * 2 + s2]), Vf[s2], S[4 * (dh_) + d2]); } } while (0)
            RF_LD_K(RA, 0); SCHED_FENCE();
            RF_LD_K(RB, 1); SCHED_FENCE(); RF_MM_K(RA, 0); SCHED_FENCE();
            if (MODE == 1) {
                RF_LD_Q(RA, 0); SCHED_FENCE(); RF_MM_K(RB, 1); SCHED_FENCE();
                RF_LD_Q(RB, 1); SCHED_FENCE(); RF_MM_Q(RA, 0); SCHED_FENCE();
                RF_MM_Q(RB, 1);
                LAS const unsigned char* pa = lds + F_RAT + fr * 144 + 16 * q4;
                RA[0] = LDR(pa); RA[1] = LDR(pa + 16 * 144); RA[2] = LDR(pa + 32 * 144); RA[3] = LDR(pa + 32 * 144 + 64); RA[4] = LDR(pa + 48 * 144); RA[5] = LDR(pa + 48 * 144 + 64);
                SCHED_FENCE();
                ot[0] = MF16(Vf[0], asfrag(RA[0]), ot[0]); ot[1] = MF16(Vf[0], asfrag(RA[1]), ot[1]);
                ot[2] = MF16(Vf[0], asfrag(RA[2]), ot[2]); ot[2] = MF16(Vf[1], asfrag(RA[3]), ot[2]);
                ot[3] = MF16(Vf[0], asfrag(RA[4]), ot[3]); ot[3] = MF16(Vf[1], asfrag(RA[5]), ot[3]);
                scan_store_ot(out + ((size_t)b * SEQ + (size_t)(n0 + n) * 64 + fr) * DM + h * 128 + 16 * cw + 4 * q4, ot);
            } else { RF_MM_K(RB, 1); }
#undef RF_LD_Q
#undef RF_LD_K
#undef RF_MM_Q
#undef RF_MM_K
        }
        __syncthreads();
        if (n + 1 < CG) { write_stage(); if (n + 2 < CG) RF_PREFETCH(n + 2); }
        __syncthreads();
    }
    if (MODE == 0) {
        f32x4* lp = (f32x4*)Lb + (((size_t)(b * 4 + h) * NG + g) * 8 + cw) * 8 * 64 + lane;
#pragma unroll
        for (int dt = 0; dt < 8; ++dt) lp[dt * 64] = S[dt];
    }
#undef RF_PREFETCH
}

__device__ __forceinline__ void phase_ret_local(KPTR p, LAS unsigned char* lds, int bid, int nb, int wv) {
    constexpr int NIT0 = BATCH * 4 * NG;
    for (int it = bid; it < NIT0; it += nb) {
        const int g = it % NG, bh = it / NG;
        __syncthreads();
        scan_ret_full<0>(p, lds, bh >> 2, bh & 3, g, wv);
    }
}
template <bool OVERLAP>
__device__ __forceinline__ void phase_scan(KPTR p, LAS unsigned char* lds, int bid, int nb, int wv) {
    constexpr int QN = 8 / NCW;
    constexpr int G = BATCH * 4;
    constexpr int NUG = ((G + 7) / 8) * 8 * QN;
    for (int unit = bid; unit < NUG; unit += nb) {
        const int xcd = unit & 7, t = unit >> 3, qt = t % QN, bh = (t / QN) * 8 + xcd;
        if (bh >= G) continue;
        __syncthreads();
        for (int rp = 0; rp < RPT_SG; ++rp) scan_gdn<OVERLAP>(p, lds, bh >> 2, bh & 3, qt, wv);
    }
    if (OVERLAP && bid >= NUG) { __syncthreads(); phase_gdn_pre<true>(p, lds, bid - NUG, nb - NUG, wv); }
    constexpr int NIT1 = G * NG;
    const int first = nb > NUG ? NUG : 0, step = nb > NUG ? nb - NUG : nb;
    if (bid >= first) {
        for (int it = bid - first; it < NIT1; it += step) {
            const int g = it % NG, bh = it / NG;
            __syncthreads();
            for (int rp = 0; rp < RPT_SR; ++rp) scan_ret_full<1>(p, lds, bh >> 2, bh & 3, g, wv);
        }
    }
}

__device__ __forceinline__ void phase_gatednorm(KPTR p, int bid, int nb, int wv) {
    const int tid = opaque_tid(wv), wid = tid >> 6, lane = tid & 63;
    const int hh = lane >> 3, c0 = lane * 16;
    const float* nwp = (hh < 4 ? p->ret_norm + hh * 128 : p->gdn_norm + (hh - 4) * 128) + (lane & 7) * 16;
    float nw[16];
#pragma unroll
    for (int i = 0; i < 4; ++i) { const f32x4 t4 = *(const f32x4*)(nwp + 4 * i); nw[4 * i] = t4[0]; nw[4 * i + 1] = t4[1]; nw[4 * i + 2] = t4[2]; nw[4 * i + 3] = t4[3]; }
    const int gcol = (hh < 4 ? 1536 + hh * 128 : 3584 + (hh - 4) * 128) + (lane & 7) * 16;
    for (int t = bid * 8 + wid; t < NTOK; t += nb * 8) {
        bf16_t* o = p->hn + (size_t)t * DM + c0;
        const u32x4 o0 = *(const u32x4*)o, o1 = *(const u32x4*)(o + 8);
        const bf16_t* gp = p->proj + (size_t)t * DINP + gcol;
        const u32x4 g0 = *(const u32x4*)gp, g1 = *(const u32x4*)(gp + 8);
        float a[16], g[16];
#pragma unroll
        for (int i = 0; i < 4; ++i) { a[2 * i] = __uint_as_float(o0[i] << 16); a[2 * i + 1] = __uint_as_float(o0[i] & 0xffff0000u); a[8 + 2 * i] = __uint_as_float(o1[i] << 16); a[8 + 2 * i + 1] = __uint_as_float(o1[i] & 0xffff0000u);
            g[2 * i] = __uint_as_float(g0[i] << 16); g[2 * i + 1] = __uint_as_float(g0[i] & 0xffff0000u); g[8 + 2 * i] = __uint_as_float(g1[i] << 16); g[8 + 2 * i + 1] = __uint_as_float(g1[i] & 0xffff0000u); }
        float ss = 0.f;
#pragma unroll
        for (int i = 0; i < 16; ++i) ss += a[i] * a[i];
        ss += __shfl_xor(ss, 1); ss += __shfl_xor(ss, 2); ss += __shfl_xor(ss, 4);
        const float rs = rsqrtf(ss * (1.0f / 128.f) + NORM_EPS);
        u32x4 w0, w1;
#pragma unroll
        for (int i = 0; i < 4; ++i) { w0[i] = pack2(a[2 * i] * rs * nw[2 * i] * siluf(g[2 * i]), a[2 * i + 1] * rs * nw[2 * i + 1] * siluf(g[2 * i + 1]));
            w1[i] = pack2(a[8 + 2 * i] * rs * nw[8 + 2 * i] * siluf(g[8 + 2 * i]), a[8 + 2 * i + 1] * rs * nw[8 + 2 * i + 1] * siluf(g[8 + 2 * i + 1])); }
        *(u32x4*)o = w0; *(u32x4*)(o + 8) = w1;
    }
}

__device__ __forceinline__ void phase_kmean(KPTR p, LAS unsigned char* lds, int bid, int nb, int wv) {
    const int tid = opaque_tid(wv);
    LAS float* red = (LAS float*)lds;
    const int rg = tid >> 4, c = tid & 15;
    for (int unit = bid; unit < NIT; unit += nb) {
        const int blk = unit % NBLK, h = (unit / NBLK) & 7, b = unit / (NBLK * 8);
        const bf16_t* kp = p->qkv + ((size_t)b * SEQ + (size_t)blk * 256 + rg) * 3072 + 1024 + h * 128 + c * 8;
        float a[8];
#pragma unroll
        for (int j = 0; j < 8; ++j) a[j] = 0.f;
#pragma unroll
        for (int i = 0; i < 8; ++i) { const u32x4 w = *(const u32x4*)(kp + (size_t)(32 * i) * 3072);
            a[0] += __uint_as_float(w.x << 16); a[1] += __uint_as_float(w.x & 0xffff0000u); a[2] += __uint_as_float(w.y << 16); a[3] += __uint_as_float(w.y & 0xffff0000u);
            a[4] += __uint_as_float(w.z << 16); a[5] += __uint_as_float(w.z & 0xffff0000u); a[6] += __uint_as_float(w.w << 16); a[7] += __uint_as_float(w.w & 0xffff0000u); }
        __syncthreads();
#pragma unroll
        for (int j = 0; j < 8; ++j) red[rg * 128 + c * 8 + j] = a[j];
        __syncthreads();
        if (tid < 128) { float s2 = 0.f;
#pragma unroll
            for (int g = 0; g < 32; ++g) s2 += red[g * 128 + tid];
            s2 *= (1.0f / 256.f);
            const bf16_t hi = f2bf(s2);
            p->kmh[(size_t)unit * 128 + tid] = hi; p->kml[(size_t)unit * 128 + tid] = f2bf(s2 - bf2f(hi)); }
    }
}
__device__ __forceinline__ void phase_moba_select(KPTR p, LAS unsigned char* lds, int bid, int nb, int wv) {
    const int tid = opaque_tid(wv), wid = tid >> 6, lane = tid & 63, fr = lane & 15, fq = lane >> 4;
    LAS float* sg = (LAS float*)lds + wid * (16 * 65);
    LAS unsigned* cnt = (LAS unsigned*)(lds + 8 * 16 * 65 * 4);
    LAS unsigned* gbase = cnt + 64;
    const int TPS = SEQ / 128, NU = BATCH * 8 * TPS;
    const bf16_t* qkv = p->qkv; const bf16_t* kmh = p->kmh; const bf16_t* kml = p->kml; unsigned* mcount = p->mcount; unsigned short* mlist = p->mlist; float* part_lse = p->part_lse;
    for (int unit = bid; unit < NU; unit += nb) {
        const int tile = unit % TPS, h = (unit / TPS) & 7, b = unit / (TPS * 8), bh = b * 8 + h;
        const int t0 = tile * 128 + wid * 16, own = (tile * 128) >> 8;
        if (tid < 64) cnt[tid] = 0u;
        if (own > 0) {
            f32x4 acc[GNT];
#pragma unroll
            for (int nt = 0; nt < GNT; ++nt) acc[nt] = (f32x4){0.f, 0.f, 0.f, 0.f};
            const bf16_t* qrow = qkv + ((size_t)b * SEQ + t0 + fr) * 3072 + h * 128 + 8 * fq;
#pragma unroll
            for (int s4 = 0; s4 < 4; ++s4) {
                const bf16x8 a = *(const bf16x8*)(qrow + 32 * s4);
#pragma unroll
                for (int nt = 0; nt < GNT; ++nt) {
                    int blk = 16 * nt + fr; blk = blk < NBLK ? blk : NBLK - 1;
                    const size_t ko = ((size_t)bh * NBLK + blk) * 128 + 32 * s4 + 8 * fq;
                    const bf16x8 b1 = *(const bf16x8*)(kmh + ko), b2 = *(const bf16x8*)(kml + ko);
                    acc[nt] = __builtin_amdgcn_mfma_f32_16x16x32_bf16(a, b1, acc[nt], 0, 0, 0);
                    acc[nt] = __builtin_amdgcn_mfma_f32_16x16x32_bf16(a, b2, acc[nt], 0, 0, 0);
                }
            }
#pragma unroll
            for (int nt = 0; nt < GNT; ++nt)
#pragma unroll
                for (int r = 0; r < 4; ++r) sg[(4 * fq + r) * 65 + 16 * nt + fr] = acc[nt][r];
        }
        __syncthreads();
        int i0 = -1, i1 = -1, i2 = -1; unsigned r0 = 0, r1 = 0, r2 = 0;
        if (lane < 16) {
            float v0 = -3e38f, v1 = -3e38f, v2 = -3e38f;
            for (int j = 0; j < own; ++j) {
                const float g = sg[lane * 65 + j];
                if (g > v0) { v2 = v1; i2 = i1; v1 = v0; i1 = i0; v0 = g; i0 = j; }
                else if (g > v1) { v2 = v1; i2 = i1; v1 = g; i1 = j; }
                else if (g > v2) { v2 = g; i2 = j; }
            }
            if (i0 >= 0) r0 = LDS_ATOMIC_ADD(cnt + i0, 1u);
            if (i1 >= 0) r1 = LDS_ATOMIC_ADD(cnt + i1, 1u);
            if (i2 >= 0) r2 = LDS_ATOMIC_ADD(cnt + i2, 1u);
        }
        __syncthreads();
        if (tid < 64 && tid < own) { const unsigned c = cnt[tid]; if (c > 0u) gbase[tid] = atomicAdd(mcount + bh * NBLK + tid, c); }
        __syncthreads();
        if (lane < 16) {
            const int t = t0 + lane;
            const size_t pb = ((size_t)((size_t)b * SEQ + t) * 8 + h) * 3;
            unsigned short* lst = mlist + (size_t)bh * LTOT;
            if (i0 >= 0) lst[list_off(i0) + gbase[i0] + r0] = (unsigned short)(((unsigned)t << 2) | 0u); else part_lse[pb + 0] = -1e30f;
            if (i1 >= 0) lst[list_off(i1) + gbase[i1] + r1] = (unsigned short)(((unsigned)t << 2) | 1u); else part_lse[pb + 1] = -1e30f;
            if (i2 >= 0) lst[list_off(i2) + gbase[i2] + r2] = (unsigned short)(((unsigned)t << 2) | 2u); else part_lse[pb + 2] = -1e30f;
        }
    }
}

__device__ __forceinline__ void moba_stage_kv(const bf16_t* qkv, LAS unsigned char* Ks, LAS unsigned char* VTs, int b, int h, int j, int tid) {
    OPAQUE_V(tid);
    const bf16_t* kbase = qkv + ((size_t)b * SEQ + (size_t)j * 256) * 3072 + 1024 + h * 128;
    const bf16_t* vbase = kbase + 1024;
#pragma unroll
    for (int i = 0; i < 8; ++i) { const int id = tid + NTHREADS * i, key = id >> 4, c = id & 15;
        *(LAS u32x4*)(Ks + key * KS_STRIDE + c * 16) = *(const u32x4*)(kbase + (size_t)key * 3072 + c * 8); }
#pragma unroll
    for (int i = 0; i < 2; ++i) { const int id = tid + NTHREADS * i, c = (id & 3) | (((id >> 4) & 3) << 2), g = ((id >> 2) & 3) | ((id >> 6) << 2);
        u32x4 r0 = *(const u32x4*)(vbase + (size_t)(4 * g) * 3072 + c * 8), r1 = *(const u32x4*)(vbase + (size_t)(4 * g + 1) * 3072 + c * 8);
        u32x4 r2 = *(const u32x4*)(vbase + (size_t)(4 * g + 2) * 3072 + c * 8), r3 = *(const u32x4*)(vbase + (size_t)(4 * g + 3) * 3072 + c * 8);
#pragma unroll
        for (int e = 0; e < 8; ++e) { const int wsel = e >> 1, sh = 16 * (e & 1);
            const unsigned x0 = (r0[wsel] >> sh) & 0xffffu, x1 = (r1[wsel] >> sh) & 0xffffu, x2 = (r2[wsel] >> sh) & 0xffffu, x3 = (r3[wsel] >> sh) & 0xffffu;
            u32x2 o; o.x = x0 | (x1 << 16); o.y = x2 | (x3 << 16);
            *(LAS u32x2*)(VTs + (8 * c + e) * VT_STRIDE + 8 * g) = o; }
    }
}
struct AttnState { f32x16 o[4]; float m, l; };
template <bool CAUSAL>
__device__ __forceinline__ void attn_block(LAS const unsigned char* Ks, LAS const unsigned char* VTs, const bf16x8 (&qf)[8], float bias0, float slope, int qloc, int wtile, int lane, AttnState& st) {
    const int l31 = lane & 31, h2 = lane >> 5;
    const float scale = 0.08838834764831845f;
#pragma unroll 1
    for (int hf = 0; hf < 2; ++hf) {
        if (CAUSAL && 4 * hf > wtile) break;
        f32x16 sv[4];
#pragma unroll
        for (int kt = 0; kt < 4; ++kt) {
            const int kt4 = 4 * hf + kt;
            f32x16 acc;
#pragma unroll
            for (int r = 0; r < 16; ++r) acc[r] = 0.f;
            if (!CAUSAL || kt4 <= wtile) {
#pragma unroll
                for (int s8 = 0; s8 < 8; ++s8) { const bf16x8 a = *(LAS const bf16x8*)(Ks + (32 * kt4 + l31) * KS_STRIDE + (16 * s8 + 8 * h2) * 2);
                    acc = __builtin_amdgcn_mfma_f32_32x32x16_bf16(a, qf[s8], acc, 0, 0, 0); }
#pragma unroll
                for (int r = 0; r < 16; ++r) { const int kl = 32 * kt4 + (r & 3) + 8 * (r >> 2) + 4 * h2;
                    float v = acc[r] * scale + (bias0 + slope * (float)kl);
                    if (CAUSAL && kt4 == wtile && kl > qloc) v = -1e30f;
                    acc[r] = v; }
            } else {
#pragma unroll
                for (int r = 0; r < 16; ++r) acc[r] = -1e30f;
            }
            sv[kt] = acc;
            SCHED_FENCE();
        }
        float mx = -1e30f;
#pragma unroll
        for (int kt = 0; kt < 4; ++kt)
#pragma unroll
            for (int r = 0; r < 16; ++r) mx = fmaxf(mx, sv[kt][r]);
        mx = fmaxf(mx, __shfl_xor(mx, 32));
        const float mnew = fmaxf(st.m, mx);
        const float alpha = __expf(st.m - mnew);
        st.m = mnew;
        float ls = 0.f;
#pragma unroll
        for (int kt = 0; kt < 4; ++kt)
#pragma unroll
            for (int r = 0; r < 16; ++r) { const float pv = __expf(sv[kt][r] - mnew); sv[kt][r] = pv; ls += pv; }
        st.l = st.l * alpha + ls;
#pragma unroll
        for (int dt = 0; dt < 4; ++dt)
#pragma unroll
            for (int r = 0; r < 16; ++r) st.o[dt][r] *= alpha;
#pragma unroll
        for (int kt = 0; kt < 4; ++kt) {
            const int kt4 = 4 * hf + kt;
            if (CAUSAL && kt4 > wtile) continue;
#pragma unroll
            for (int s2 = 0; s2 < 2; ++s2) {
                u32x4 pw; pw.x = pack2(sv[kt][8 * s2 + 0], sv[kt][8 * s2 + 1]); pw.y = pack2(sv[kt][8 * s2 + 2], sv[kt][8 * s2 + 3]); pw.z = pack2(sv[kt][8 * s2 + 4], sv[kt][8 * s2 + 5]); pw.w = pack2(sv[kt][8 * s2 + 6], sv[kt][8 * s2 + 7]);
                bf16x8 pf; __builtin_memcpy(&pf, &pw, 16);
#pragma unroll
                for (int dt = 0; dt < 4; ++dt) {
                    LAS const unsigned char* vp = VTs + (32 * dt + l31) * VT_STRIDE + (32 * kt4 + 16 * s2 + 4 * h2) * 2;
                    const u32x2 lo = *(LAS const u32x2*)vp, hi = *(LAS const u32x2*)(vp + 16);
                    u32x4 aw; aw.x = lo.x; aw.y = lo.y; aw.z = hi.x; aw.w = hi.y;
                    bf16x8 a; __builtin_memcpy(&a, &aw, 16);
                    st.o[dt] = __builtin_amdgcn_mfma_f32_32x32x16_bf16(a, pf, st.o[dt], 0, 0, 0);
                }
                SCHED_FENCE();
            }
        }
    }
}
__device__ __forceinline__ void load_qfrag(const bf16_t* qrow, int h2, bf16x8 (&qf)[8]) {
#pragma unroll
    for (int s8 = 0; s8 < 8; ++s8) qf[s8] = *(const bf16x8*)(qrow + 16 * s8 + 8 * h2);
}

__device__ __forceinline__ void phase_moba_gather(KPTR p, LAS unsigned char* lds, int bid, int nb, int wv) {
    const int tid = opaque_tid(wv), wid = tid >> 6, lane = tid & 63, l31 = lane & 31, h2 = lane >> 5;
    LAS unsigned char* Ks = lds; LAS unsigned char* VTs = lds + KS_BYTES;
    LAS unsigned* pref = (LAS unsigned*)(lds + KS_BYTES + VT_BYTES);
    LAS unsigned* wsum = pref + NIT + 1;
    const bf16_t* qkv = p->qkv; const unsigned* mcount = p->mcount; const unsigned short* mlist = p->mlist; bf16_t* part_o = p->part_o; float* part_lse = p->part_lse;
    constexpr int IPT = (NIT + NTHREADS - 1) / NTHREADS;
    unsigned loc[IPT]; unsigned tsum = 0;
#pragma unroll
    for (int i = 0; i < IPT; ++i) { const int it = tid * IPT + i; const unsigned c = it < NIT ? mcount[it] : 0u; loc[i] = c ? 1u + 2u * ((c + 255u) >> 8) : 0u; tsum += loc[i]; }
    unsigned inc = tsum;
    for (int o = 1; o < 64; o <<= 1) { const unsigned t2 = __shfl_up(inc, o); if (lane >= o) inc += t2; }
    if (lane == 63) wsum[wid] = inc;
    __syncthreads();
    unsigned wbase = 0;
#pragma unroll
    for (int w = 0; w < 8; ++w) if (w < wid) wbase += wsum[w];
    unsigned run = wbase + inc - tsum;
#pragma unroll
    for (int i = 0; i < IPT; ++i) { const int it = tid * IPT + i; if (it < NIT) pref[it] = run; run += loc[i]; }
    if (tid == NTHREADS - 1) pref[NIT] = run;
    __syncthreads();
    const unsigned C = pref[NIT];
    const unsigned lo = (unsigned)(((unsigned long long)C * (unsigned)bid) / (unsigned)nb), hi = (unsigned)(((unsigned long long)C * (unsigned)(bid + 1)) / (unsigned)nb);
    if (lo >= hi) return;
    int first = 0; { int a = 0, c = NIT; while (c - a > 1) { const int mid = (a + c) >> 1; if (pref[mid] <= lo) a = mid; else c = mid; } first = a; }
    for (int it = first; it < NIT; ++it) {
        const unsigned ps = pref[it], pe = pref[it + 1];
        if (ps >= hi) break;
        if (pe <= lo || pe == ps) continue;
        const unsigned nr = (pe - ps - 1u) >> 1;
        unsigned r_lo = 0; if (lo > ps + 1u) r_lo = (lo - ps - 1u + 1u) >> 1;
        unsigned r_hi = nr; if (hi < ps + 1u + 2u * nr) r_hi = hi > ps + 1u ? (hi - ps - 1u + 1u) >> 1 : 0u;
        if (r_lo >= r_hi) continue;
        const int j = it % NBLK, h = (it / NBLK) & 7, b = it / (NBLK * 8), bh = b * 8 + h;
        const unsigned cnt = mcount[it];
        const unsigned ra = r_lo * 256u, rb = (r_hi * 256u) < cnt ? (r_hi * 256u) : cnt;
        __syncthreads();
        moba_stage_kv(qkv, Ks, VTs, b, h, j, tid);
        __syncthreads();
        const float slope = exp2f(-(float)(h + 1));
        const unsigned short* lst = mlist + (size_t)bh * LTOT + list_off(j);
        unsigned ent_next = 0;
        { const unsigned row = ra + 32u * wid + l31; if (ra + 32u * wid < rb) ent_next = lst[row < rb ? row : (rb - 1)]; }
        for (unsigned r0 = ra + 32u * wid; r0 < rb; r0 += 256u) {
            const unsigned row = r0 + l31; const bool active = row < rb;
            const unsigned ent = ent_next;
            if (r0 + 256u < rb) { const unsigned rn = row + 256u; ent_next = lst[rn < rb ? rn : (rb - 1)]; }
            const int t = (int)(ent >> 2), k = (int)(ent & 3u);
            bf16x8 qf[8]; load_qfrag(qkv + ((size_t)b * SEQ + t) * 3072 + h * 128, h2, qf);
            AttnState st;
#pragma unroll
            for (int dt = 0; dt < 4; ++dt)
#pragma unroll
                for (int r = 0; r < 16; ++r) st.o[dt][r] = 0.f;
            st.m = -1e30f; st.l = 0.f;
            attn_block<false>(Ks, VTs, qf, slope * (float)(256 * j - t), slope, 0, 0, lane, st);
            const float lt = st.l + __shfl_xor(st.l, 32);
            const float inv = 1.0f / lt;
            if (active) {
                const size_t pb = ((size_t)((size_t)b * SEQ + t) * 8 + h) * 3 + k;
                bf16_t* po = part_o + pb * 128;
#pragma unroll
                for (int dt = 0; dt < 4; ++dt)
#pragma unroll
                    for (int g = 0; g < 4; ++g) { u32x2 w; w.x = pack2(st.o[dt][4 * g] * inv, st.o[dt][4 * g + 1] * inv); w.y = pack2(st.o[dt][4 * g + 2] * inv, st.o[dt][4 * g + 3] * inv);
                        *(u32x2*)(po + 32 * dt + 8 * g + 4 * h2) = w; }
                if (h2 == 0) part_lse[pb] = st.m + __logf(lt);
            }
        }
    }
}
__device__ __forceinline__ void phase_moba_own(KPTR p, LAS unsigned char* lds, int bid, int nb, int wv) {
    const int tid = opaque_tid(wv), wid = tid >> 6, lane = tid & 63, l31 = lane & 31, h2 = lane >> 5;
    LAS unsigned char* Ks = lds; LAS unsigned char* VTs = lds + KS_BYTES;
    const bf16_t* qkv = p->qkv; const bf16_t* part_o = p->part_o; const float* part_lse = p->part_lse; bf16_t* out = p->hn;
    for (int it = bid; it < NIT; it += nb) {
        const int j = it % NBLK, h = (it / NBLK) & 7, b = it / (NBLK * 8);
        const float slope = exp2f(-(float)(h + 1));
        const int qloc = 32 * wid + l31, t = j * 256 + qloc;
        bf16x8 qf[8]; load_qfrag(qkv + ((size_t)b * SEQ + t) * 3072 + h * 128, h2, qf);
        __syncthreads();
        moba_stage_kv(qkv, Ks, VTs, b, h, j, tid);
        __syncthreads();
        AttnState st;
#pragma unroll
        for (int dt = 0; dt < 4; ++dt)
#pragma unroll
            for (int r = 0; r < 16; ++r) st.o[dt][r] = 0.f;
        st.m = -1e30f; st.l = 0.f;
        attn_block<true>(Ks, VTs, qf, slope * (float)(-qloc), slope, qloc, wid, lane, st);
        const float lt = st.l + __shfl_xor(st.l, 32);
        const float lse_own = st.m + __logf(lt);
        const size_t pb = ((size_t)((size_t)b * SEQ + t) * 8 + h) * 3;
        const float l0 = part_lse[pb], l1 = part_lse[pb + 1], l2 = part_lse[pb + 2];
        const float M = fmaxf(fmaxf(lse_own, l0), fmaxf(l1, l2));
        const float w_own = __expf(lse_own - M), w0 = __expf(l0 - M), w1 = __expf(l1 - M), w2 = __expf(l2 - M);
        const float Wi = 1.0f / (w_own + w0 + w1 + w2);
        const float c_own = w_own * Wi / lt, c0 = w0 * Wi, c1 = w1 * Wi, c2 = w2 * Wi;
        bf16_t* orow = out + ((size_t)b * SEQ + t) * DM + h * 128;
        const bool v0 = l0 > -1e29f, v1 = l1 > -1e29f, v2 = l2 > -1e29f;
#pragma unroll
        for (int dt = 0; dt < 4; ++dt) {
            u32x2 pw[3][4];
#pragma unroll
            for (int k = 0; k < 3; ++k)
#pragma unroll
                for (int g = 0; g < 4; ++g) pw[k][g] = *(const u32x2*)(part_o + (pb + k) * 128 + 32 * dt + 8 * g + 4 * h2);
#pragma unroll
            for (int g = 0; g < 4; ++g) {
                const int d0 = 32 * dt + 8 * g + 4 * h2;
                float v[4];
#pragma unroll
                for (int e = 0; e < 4; ++e) v[e] = st.o[dt][4 * g + e] * c_own;
#pragma unroll
                for (int k = 0; k < 3; ++k) {
                    const bool vk = k == 0 ? v0 : (k == 1 ? v1 : v2); const float ck = k == 0 ? c0 : (k == 1 ? c1 : c2);
                    const u32x2 w = pw[k][g];
                    const float f0 = __uint_as_float(w.x << 16), f1 = __uint_as_float(w.x & 0xffff0000u), f2 = __uint_as_float(w.y << 16), f3 = __uint_as_float(w.y & 0xffff0000u);
                    v[0] += vk ? ck * f0 : 0.f; v[1] += vk ? ck * f1 : 0.f; v[2] += vk ? ck * f2 : 0.f; v[3] += vk ? ck * f3 : 0.f;
                }
                u32x2 wo; wo.x = pack2(v[0], v[1]); wo.y = pack2(v[2], v[3]);
                *(u32x2*)(orow + d0) = wo;
            }
        }
    }
}

__device__ __forceinline__ void phase_router(KPTR p, LAS unsigned char* lds, int bid, int nb, int wv) {
    const int tid = opaque_tid(wv), wid = tid >> 6, lane = tid & 63;
    LAS unsigned* hist = (LAS unsigned*)lds;
    if (tid < 8) hist[tid] = 0u;
    __syncthreads();
    f32x4 gv[4];
#pragma unroll
    for (int i = 0; i < 4; ++i) gv[i] = *(const f32x4*)(p->ffn_norm + DM + i * 256 + lane * 4);
    const int rpw = (NTOK + nb - 1) / nb, rbeg = bid * rpw, rend = (rbeg + rpw) < NTOK ? (rbeg + rpw) : NTOK;
    f32x4 w8[16][2];
#pragma unroll
    for (int i = 0; i < 4; ++i)
#pragma unroll
        for (int e = 0; e < 4; ++e) { const float* wr_ = p->w_router + (size_t)(i * 256 + lane * 4 + e) * 8; w8[i * 4 + e][0] = *(const f32x4*)wr_; w8[i * 4 + e][1] = *(const f32x4*)(wr_ + 4); }
    for (int row = rbeg + wid; row < rend; row += 8) {
        f32x4 v[4]; load_row_b(p->hb3, row, lane, v);
        const float rs = row_rstd(v);
#pragma unroll
        for (int i = 0; i < 4; ++i) v[i] = v[i] * rs * gv[i];
        store_row_fp8((unsigned char*)p->hn, p->hns, row, lane, v);
        { float ss = 0.f;
#pragma unroll
          for (int i = 0; i < 4; ++i) ss += v[i][0] * v[i][0] + v[i][1] * v[i][1] + v[i][2] * v[i][2] + v[i][3] * v[i][3];
          ss = wave_sum(ss); if (lane == 0) p->hnn2[row] = ss; }
        f32x4 d0 = (f32x4){0.f, 0.f, 0.f, 0.f}, d1 = (f32x4){0.f, 0.f, 0.f, 0.f};
#pragma unroll
        for (int i = 0; i < 4; ++i)
#pragma unroll
            for (int e = 0; e < 4; ++e) { const float xv = v[i][e]; d0 = d0 + w8[i * 4 + e][0] * xv; d1 = d1 + w8[i * 4 + e][1] * xv; }
        float d[8] = {d0[0], d0[1], d0[2], d0[3], d1[0], d1[1], d1[2], d1[3]};
#pragma unroll
        for (int j = 0; j < 8; ++j) d[j] = wave_sum(d[j]);
        int i0 = 0; float m0 = d[0];
#pragma unroll
        for (int j = 1; j < 8; ++j) if (d[j] > m0) { m0 = d[j]; i0 = j; }
        int i1 = -1; float m1 = -3e38f;
#pragma unroll
        for (int j = 0; j < 8; ++j) if (j != i0 && d[j] > m1) { m1 = d[j]; i1 = j; }
        if (lane == 0) {
            const float e1 = __expf(m1 - m0); const float g0 = 1.0f / (1.0f + e1);
            p->midx[row * 2] = i0; p->midx[row * 2 + 1] = i1; p->mgate[row * 2] = g0; p->mgate[row * 2 + 1] = e1 * g0;
            LDS_ATOMIC_ADD(hist + i0, 1u); LDS_ATOMIC_ADD(hist + i1, 1u);
        }
    }
    __syncthreads();
    if (tid < 8) p->wghist[bid * 8 + tid] = hist[tid];
}
__device__ __forceinline__ void phase_slots(KPTR p, LAS unsigned char* lds, int bid, int nb, int wv) {
    const int tid = opaque_tid(wv);
    LAS unsigned* ltot = (LAS unsigned*)lds; LAS unsigned* lpre = ltot + 8; LAS unsigned* lcur = ltot + 16;
    if (tid < 24) ltot[tid] = 0u;
    __syncthreads();
    { const int e = tid & 7; unsigned tot = 0, pre = 0;
      for (int bb = tid >> 3; bb < nb; bb += NTHREADS / 8) { const unsigned v = p->wghist[bb * 8 + e]; tot += v; if (bb < bid) pre += v; }
      LDS_ATOMIC_ADD(ltot + e, tot); LDS_ATOMIC_ADD(lpre + e, pre); }
    __syncthreads();
    unsigned base[NE], cnt[NE]; unsigned acc = 0; float gu[NE];
#pragma unroll
    for (int e = 0; e < NE; ++e) { cnt[e] = ltot[e]; base[e] = acc; acc += (cnt[e] + 255u) & ~255u; gu[e] = __uint_as_float(p->ctrl[C_GMAX + e]) * __uint_as_float(p->ctrl[C_UMAX + e]); }
    const int rpw = (NTOK + nb - 1) / nb, rbeg = bid * rpw, rend = (rbeg + rpw) < NTOK ? (rbeg + rpw) : NTOK;
    for (int a = rbeg * 2 + tid; a < rend * 2; a += NTHREADS) {
        const int e = p->midx[a];
        unsigned b0 = 0;
#pragma unroll
        for (int j = 0; j < NE; ++j) if (j == e) b0 = base[j];
        const unsigned s = b0 + lpre[e] + LDS_ATOMIC_ADD(lcur + e, 1u);
        p->slot_of[a] = (int)s; p->arow[s] = a >> 1; p->sslot[s] = p->hns[a >> 1];
        float gm = 0.f;
#pragma unroll
        for (int j = 0; j < NE; ++j) if (j == e) gm = gu[j];
        p->shs[s] = p->hnn2[a >> 1] * gm * (1.0f / 256.f);
    }
    if (bid == 0) {
        if (tid == 0) { p->ctrl[C_NTILES] = acc >> 8; p->ctrl[C_TB + NE] = acc >> 8; }
        if (tid < NE) { unsigned bb = 0;
#pragma unroll
            for (int e = 0; e < NE; ++e) if (e == tid) bb = base[e];
            p->ctrl[C_TB + tid] = bb >> 8; }
#pragma unroll
        for (int e = 0; e < NE; ++e) {
            const unsigned lo = base[e] + cnt[e], hi = base[e] + ((cnt[e] + 255u) & ~255u);
            for (unsigned s2 = lo + tid; s2 < hi; s2 += NTHREADS) { p->arow[s2] = 0; p->sslot[s2] = 0.f; p->shs[s2] = 1.0f; }
            for (unsigned t = (base[e] >> 8) + tid; t < (hi >> 8); t += NTHREADS) p->tile_e[t] = e;
        }
    }
}
__device__ __forceinline__ void phase_final(KPTR p, const bf16_t* hsrc, int lo, int hi, int bid, int nb, int wv) {
    const int tid = opaque_tid(wv), wid = tid >> 6, lane = tid & 63;
    f32x4 gv[4];
#pragma unroll
    for (int i = 0; i < 4; ++i) gv[i] = *(const f32x4*)(p->final_norm + i * 256 + lane * 4);
    int sl0 = 0, sl1 = 0; float ga0 = 0.f, ga1 = 0.f;
    { const int row = lo + bid * 8 + wid; if (row < hi) { sl0 = p->slot_of[row * 2]; sl1 = p->slot_of[row * 2 + 1]; ga0 = p->mgate[row * 2]; ga1 = p->mgate[row * 2 + 1]; } }
    for (int row = lo + bid * 8 + wid; row < hi; row += nb * 8) {
        const int s0 = sl0, s1 = sl1; const float g0 = ga0, g1 = ga1;
        u32x2 y0[4], y1[4];
#pragma unroll
        for (int i = 0; i < 4; ++i) { y0[i] = *(const u32x2*)(p->yslot + (size_t)s0 * DM + i * 256 + lane * 4); y1[i] = *(const u32x2*)(p->yslot + (size_t)s1 * DM + i * 256 + lane * 4); }
        f32x4 v[4]; load_row_b(hsrc, row, lane, v);
        { const int rn = row + nb * 8; if (rn < hi) { sl0 = p->slot_of[rn * 2]; sl1 = p->slot_of[rn * 2 + 1]; ga0 = p->mgate[rn * 2]; ga1 = p->mgate[rn * 2 + 1]; } }
#pragma unroll
        for (int i = 0; i < 4; ++i) {
            v[i][0] += g0 * __uint_as_float(y0[i].x << 16) + g1 * __uint_as_float(y1[i].x << 16); v[i][1] += g0 * __uint_as_float(y0[i].x & 0xffff0000u) + g1 * __uint_as_float(y1[i].x & 0xffff0000u);
            v[i][2] += g0 * __uint_as_float(y0[i].y << 16) + g1 * __uint_as_float(y1[i].y << 16); v[i][3] += g0 * __uint_as_float(y0[i].y & 0xffff0000u) + g1 * __uint_as_float(y1[i].y & 0xffff0000u); }
        const float rs = row_rstd(v);
#pragma unroll
        for (int i = 0; i < 4; ++i) *(f32x4*)(p->out + (size_t)row * DM + i * 256 + lane * 4) = v[i] * rs * gv[i];
    }
}


#ifndef CPU_EMU
#define XB_TMO      128
#define XB_XCNT(j)  (256  + 64 * (j))
#define XB_XSUB(j)  (1280 + 64 * (j))
#define XB_XGEN(j)  (2304 + 64 * (j))
#define XB_TOP      3328
#define XB_TOPGEN   3392
#define XCD_BAR_WORDS 3456
#define XB_SPIN_CAP (1u << 20)
__device__ __forceinline__ unsigned xb_ld(unsigned* p) { return __hip_atomic_load(p, __ATOMIC_RELAXED, __HIP_MEMORY_SCOPE_AGENT); }
__device__ __forceinline__ unsigned xb_add(unsigned* p, unsigned v) { return __hip_atomic_fetch_add(p, v, __ATOMIC_RELAXED, __HIP_MEMORY_SCOPE_AGENT); }
__device__ __forceinline__ unsigned xb_xcc_id() { return (unsigned)__builtin_amdgcn_s_getreg((3 << 11) | 20) & 0xFu; }
#define XB_SPIN(cond, bar) do { unsigned _sp = 0; while (cond) { __builtin_amdgcn_s_sleep(1); \
    if ((++_sp & 255u) == 0u) { if (xb_ld(&(bar)[XB_TMO])) break; if (_sp > XB_SPIN_CAP) { atomicAdd(&(bar)[XB_TMO], 1u); break; } } } } while (0)
__device__ __forceinline__ void xcd_barrier_post(unsigned* bar, int tid) { if (tid == 0) (void)xb_add(&bar[XB_XCNT(xb_xcc_id())], 1u); }
__device__ __forceinline__ void xcd_barrier_complete(unsigned* bar, unsigned x, unsigned& nloc, unsigned& nx) {
    const unsigned G = gridDim.x * gridDim.y * gridDim.z;
    unsigned sum, cnt, mine, sp = 0u;
    for (;;) {
        sum = 0u; cnt = 0u; mine = 0u;
#pragma unroll
        for (unsigned j = 0; j < 16; ++j) { const unsigned c = xb_ld(&bar[XB_XCNT(j)]); sum += c; cnt += (c > 0u) ? 1u : 0u; mine = (j == x) ? c : mine; }
        if (sum == G) break;
        __builtin_amdgcn_s_sleep(1);
        if ((++sp & 255u) == 0u) { if (xb_ld(&bar[XB_TMO])) break; if (sp > XB_SPIN_CAP) { atomicAdd(&bar[XB_TMO], 1u); break; } }
    }
    nloc = mine > 0u ? mine : 1u; nx = cnt > 0u ? cnt : 1u;
}
__device__ __forceinline__ void xcd_barrier(unsigned* bar, volatile LAS unsigned* st, int tid) {
    asm volatile("s_waitcnt vmcnt(0)" ::: "memory");
    __syncthreads();
    if (tid == 0) {
        __builtin_amdgcn_s_waitcnt(0);
        const unsigned x = xb_xcc_id();
        unsigned nloc = st[0], nx = st[1];
        if (nloc == 0u) { xcd_barrier_complete(bar, x, nloc, nx); st[0] = nloc; st[1] = nx; }
        const unsigned old = xb_add(&bar[XB_XSUB(x)], 1u);
        const unsigned gen = old / nloc;
        if (old + 1u == (gen + 1u) * nloc) {
            __builtin_amdgcn_fence(__ATOMIC_RELEASE, "agent");
            asm volatile("s_waitcnt vmcnt(0)" ::: "memory");
            const unsigned og = xb_add(&bar[XB_TOP], 1u);
            const unsigned tg = og / nx;
            if (og + 1u == (tg + 1u) * nx) xb_add(&bar[XB_TOPGEN], 1u);
            else XB_SPIN(xb_ld(&bar[XB_TOPGEN]) == tg, bar);
            __builtin_amdgcn_fence(__ATOMIC_ACQUIRE, "agent");
            xb_add(&bar[XB_XGEN(x)], 1u);
            asm volatile("s_waitcnt vmcnt(0)" ::: "memory");
        } else {
            XB_SPIN(xb_ld(&bar[XB_XGEN(x)]) == gen, bar);
            __builtin_amdgcn_fence(__ATOMIC_ACQUIRE, "agent");
            asm volatile("s_waitcnt vmcnt(0)" ::: "memory");
        }
    }
    __syncthreads();
}
#define GRID_BARRIER() do { unsigned* _bar = p->bar; xcd_barrier(_bar, (volatile LAS unsigned*)(lds + kDynLds - 16), opaque_tid(wv)); } while (0)
#else
#define XCD_BAR_WORDS 3456
#define GRID_BARRIER() emu::grid_sync()
#endif

#ifndef CPU_EMU
extern __shared__ __attribute__((aligned(16))) unsigned char smem_raw[];
#define GET_LDS() ((LAS unsigned char*)smem_raw)
#else
#define GET_LDS() (emu::blk->smem)
#endif

__global__ void __launch_bounds__(NTHREADS) fwd_megakernel(Params p_arg) {
    cg::grid_group grid = cg::this_grid();
    KPTR p = KARG_PTR(p_arg);
    LAS unsigned char* lds = GET_LDS();
#ifndef CPU_EMU
    const int wv = __builtin_amdgcn_readfirstlane((int)(threadIdx.x >> 6));
#else
    const int wv = 0;
#endif
    const int bid = blockIdx.x, nb = gridDim.x, tid = opaque_tid(wv);
#ifndef CPU_EMU
    if (tid == 0) { volatile LAS unsigned* st = (volatile LAS unsigned*)(lds + kDynLds - 16); st[0] = 0u; st[1] = 0u; }
    __syncthreads();
    xcd_barrier_post(p->bar, tid);
#endif
    LAUNDER(p);
    if (bid == 0 && tid < 256) p->ctrl[tid] = 0u;
    for (int i = bid * NTHREADS + tid; i < NIT; i += nb * NTHREADS) p->mcount[i] = 0u;
    for (int i = bid * NTHREADS + tid; i < NCHH; i += nb * NTHREADS) p->gflag[i] = 0u;
    convert_wt(lds, p->w_in, DM, DIN, 0, DINP, p->wt_in, 128, 0, bid, nb, wv);
    convert_wt(lds, p->w_out0, DM, DM, 0, DM, p->wt_out0, 128, 0, bid, nb, wv);
    convert_wt(lds, p->w_gate0, DM, FF, 0, FF, p->wt_gu0, 256, 0, bid, nb, wv);
    convert_wt(lds, p->w_up0, DM, FF, 0, FF, p->wt_gu0, 256, 128, bid, nb, wv);
    convert_wt(lds, p->w_down0, FF, DM, 0, DM, p->wt_d0, 128, 0, bid, nb, wv);
    convert_wt(lds, p->w_qkv, DM, 3072, 0, 3072, p->wt_qkv, 128, 0, bid, nb, wv);
    convert_wt(lds, p->w_out1, DM, DM, 0, DM, p->wt_out1, 128, 0, bid, nb, wv);
    phase_norm<true>(p, p->x, p->mix_norm, bid, nb, wv);
    if (p->pad0 != 0) grid.sync(); else GRID_BARRIER();
    LAUNDER(p);
    for (int rp = 0; rp < RPT_GEMM; ++rp) { StaticOrder so; so.init(NTOK / 256, DINP / 256, nb, bid); Gemm g{p->hn, p->wt_in, nullptr}; EpiBf16 e{p->proj, DINP, 0}; gemm_phase<DM>(lds, g, so, e, wv); }
    GRID_BARRIER();
    LAUNDER(p);
    constexpr int NUG_ = ((BATCH * 4 + 7) / 8) * 8 * (8 / NCW);
    const bool overlap = nb >= NUG_ + 32;
    if (!overlap) phase_gdn_pre<false>(p, lds, bid, nb, wv);
    phase_ret_local(p, lds, bid, nb, wv);
    GRID_BARRIER();
    LAUNDER(p);
    if (overlap) phase_scan<true>(p, lds, bid, nb, wv); else phase_scan<false>(p, lds, bid, nb, wv);
    GRID_BARRIER();
    LAUNDER(p);
    phase_gatednorm(p, bid, nb, wv);
    GRID_BARRIER();
    LAUNDER(p);
    { StaticOrder so; so.init(NTOK / 256, DM / 256, nb, bid); Gemm g{p->hn, p->wt_out0, nullptr}; EpiResBf16<true> e{p->x, nullptr, p->hb}; gemm_phase<DM>(lds, g, so, e, wv); }
    GRID_BARRIER();
    LAUNDER(p);
#if FP8_FFN0
    phase_norm<false, true, true>(p, p->hb, p->ffn_norm, bid, nb, wv);
    quant_rows<DM, false>(p, lds, p->wt_gu0, p->w8_gu0, p->ws_gu0, 2 * FF, bid, nb, wv);
#else
    phase_norm<false, false, true>(p, p->hb, p->ffn_norm, bid, nb, wv);
#endif
    GRID_BARRIER();
    LAUNDER(p);
#if FP8_FFN0
    for (int rp = 0; rp < RPT_GEMM; ++rp) { StaticOrder so; so.init(NTOK / 256, 2 * FF / 256, nb, bid); Gemm g{p->hn, (const bf16_t*)p->w8_gu0, nullptr}; EpiSwigluS e{p->act0, FF, 0, p->hns, p->ws_gu0}; gemm_phase<DM, EpiSwigluS, StaticOrder, true>(lds, g, so, e, wv); }
#else
    for (int rp = 0; rp < RPT_GEMM; ++rp) { StaticOrder so; so.init(NTOK / 256, 2 * FF / 256, nb, bid); Gemm g{p->hn, p->wt_gu0, nullptr}; EpiSwiglu e{p->act0, FF, 0}; gemm_phase<DM>(lds, g, so, e, wv); }
#endif
    GRID_BARRIER();
    LAUNDER(p);
    { StaticOrder so; so.init(NTOK / 256, DM / 256, nb, bid); Gemm g{p->act0, p->wt_d0, nullptr}; EpiResBf16<false> e{nullptr, p->hb, p->hb}; gemm_phase<FF>(lds, g, so, e, wv); }
    GRID_BARRIER();
    LAUNDER(p);
    phase_norm<false, false, true>(p, p->hb, p->mix_norm + DM, bid, nb, wv);
    GRID_BARRIER();
    LAUNDER(p);
    for (int rp = 0; rp < RPT_GEMM; ++rp) { StaticOrder so; so.init(NTOK / 256, 3072 / 256, nb, bid); Gemm g{p->hn, p->wt_qkv, nullptr}; EpiBf16 e{p->qkv, 3072, 0}; gemm_phase<DM>(lds, g, so, e, wv); }
    GRID_BARRIER();
    LAUNDER(p);
    phase_kmean(p, lds, bid, nb, wv);
    GRID_BARRIER();
    LAUNDER(p);
    phase_moba_select(p, lds, bid, nb, wv);
    GRID_BARRIER();
    LAUNDER(p);
    for (int rp = 0; rp < RPT_MG; ++rp) phase_moba_gather(p, lds, bid, nb, wv);
    GRID_BARRIER();
    LAUNDER(p);
    for (int rp = 0; rp < RPT_MO; ++rp) phase_moba_own(p, lds, bid, nb, wv);
    GRID_BARRIER();
    LAUNDER(p);
    convert_gu_fp8(p, lds, bid, nb, wv);
    for (int rp = 0; rp < RPT_CONV; ++rp) for (int e = 0; e < NE; ++e) {
        convert_wt(lds, p->w_mdown + (size_t)e * FFE * DM, FFE, DM, 0, DM, p->wt_md_tmp + (size_t)e * DM * FFE, 128, 0, bid, nb, wv);
    }
    { StaticOrder so; so.init(NTOK / 256, DM / 256, nb, bid); Gemm g{p->hn, p->wt_out1, nullptr}; EpiResBf16<false> e{nullptr, p->hb, p->hb3}; gemm_phase<DM>(lds, g, so, e, wv); }
    GRID_BARRIER();
    LAUNDER(p);
    phase_router(p, lds, bid, nb, wv);
    quant_rows<FFE, false>(p, lds, p->wt_md_tmp, p->w8_md, p->ws_md, NE * DM, bid, nb, wv);
    GRID_BARRIER();
    LAUNDER(p);
    phase_slots(p, lds, bid, nb, wv);
    GRID_BARRIER();
    LAUNDER(p);
    {
        const int ntiles = (int)p->ctrl[C_NTILES];
        const int npass = (ntiles + p->tiles_per_pass - 1) / p->tiles_per_pass;
        const int tpp = npass > 0 ? (ntiles + npass - 1) / npass : 1;
        const size_t mbuf = (size_t)p->tiles_per_pass * 256 * FFE; int q = 0;
        for (int t0 = 0; t0 < ntiles; t0 += tpp, ++q) {
            const int nM = (ntiles - t0) < tpp ? (ntiles - t0) : tpp;
            unsigned char* mb = (unsigned char*)p->mact + (size_t)(q & 1) * mbuf;
            for (int rp = 0; rp < RPT_GEMM; ++rp) { MoeOrder mo; mo.init(t0, nM, 2 * FFE / 256, p->tile_e, nb, bid); Gemm g{p->hn, (const bf16_t*)p->w8_mgu, p->arow}; EpiSwigluS8 e{mb, FFE, t0 * 256, p->sslot, p->ws_mgu, p->shs}; gemm_phase<DM, EpiSwigluS8, MoeOrder, true>(lds, g, mo, e, wv); }
            GRID_BARRIER();
            for (int rp = 0; rp < RPT_GEMM; ++rp) { MoeOrder mo; mo.init(t0, nM, DM / 256, p->tile_e, nb, bid); Gemm g{(const bf16_t*)((const unsigned char*)mb - (size_t)t0 * 256 * FFE), (const bf16_t*)p->w8_md, nullptr}; EpiBf16S e{p->yslot, DM, p->shs, p->ws_md}; gemm_phase<FFE, EpiBf16S, MoeOrder, true>(lds, g, mo, e, wv); }
        }
        GRID_BARRIER();
    }
    LAUNDER(p);
    phase_final(p, p->hb3, 0, NTOK, bid, nb, wv);
}

static inline size_t al256(size_t x) { return (x + 255) & ~(size_t)255; }

extern "C" void kernel_launch(void* const* d_in, const int* in_sizes, int n_in, void* d_out, int out_size, void* d_ws, size_t ws_size, hipStream_t stream) {
    Params p; memset(&p, 0, sizeof(p));
    p.x = (const float*)d_in[0]; p.mix_norm = (const float*)d_in[1]; p.ffn_norm = (const float*)d_in[2]; p.w_in = (const float*)d_in[3]; p.conv_w = (const float*)d_in[4];
    p.a_log = (const float*)d_in[5]; p.dt_bias = (const float*)d_in[6]; p.ret_norm = (const float*)d_in[7]; p.gdn_norm = (const float*)d_in[8]; p.w_out0 = (const float*)d_in[9];
    p.w_qkv = (const float*)d_in[10]; p.w_out1 = (const float*)d_in[11]; p.w_gate0 = (const float*)d_in[12]; p.w_up0 = (const float*)d_in[13]; p.w_down0 = (const float*)d_in[14];
    p.w_router = (const float*)d_in[15]; p.w_mgate = (const float*)d_in[16]; p.w_mup = (const float*)d_in[17]; p.w_mdown = (const float*)d_in[18]; p.final_norm = (const float*)d_in[19];
    p.out = (float*)d_out; p.hb = (bf16_t*)((unsigned char*)d_out + (size_t)NTOK * DM * 2);
    unsigned char* w = (unsigned char*)d_ws; size_t off = 0;
    auto take = [&](size_t bytes) { unsigned char* r = w + off; off += al256(bytes); return r; };
    p.ctrl = (unsigned*)take(4096); p.bar = (unsigned*)take((size_t)XCD_BAR_WORDS * 4);
    p.wt_in = (bf16_t*)take((size_t)DINP * DM * 2); p.wt_out0 = (bf16_t*)take((size_t)DM * DM * 2); p.wt_gu0 = (bf16_t*)take((size_t)2 * FF * DM * 2); p.wt_d0 = (bf16_t*)take((size_t)DM * FF * 2);
    p.wt_qkv = (bf16_t*)take((size_t)3072 * DM * 2); p.wt_out1 = (bf16_t*)take((size_t)DM * DM * 2);
    p.hn = (bf16_t*)take((size_t)NTOK * DM * 2);
    p.gflag = (unsigned*)take((size_t)NCHH * 4);
    p.retL = (float*)take((size_t)BATCH * 4 * NG * 128 * 128 * 4);
    p.gbeta = (float*)take((size_t)NTOK * 4 * 4); p.gg = (float*)take((size_t)NTOK * 4 * 4);
    p.arow = (int*)take((size_t)MAXTILES * 256 * 4); p.tile_e = (int*)take((size_t)MAXTILES * 4); p.slot_of = (int*)take((size_t)NTOK * 2 * 4); p.mgate = (float*)take((size_t)NTOK * 2 * 4); p.midx = (int*)take((size_t)NTOK * 2 * 4); p.wghist = (unsigned*)take((size_t)4096 * 8 * 4);
    p.w8_gu0 = take(FP8_FFN0 ? (size_t)2 * FF * DM : (size_t)256); p.ws_gu0 = (float*)take((size_t)2 * FF * 4); p.ws_mgu = (float*)take((size_t)NE * 2 * FFE * 4); p.hns = (float*)take((size_t)NTOK * 4); p.sslot = (float*)take((size_t)MAXTILES * 256 * 4);
    p.ws_md = (float*)take((size_t)NE * DM * 4); p.hnn2 = (float*)take((size_t)NTOK * 4); p.shs = (float*)take((size_t)MAXTILES * 256 * 4);
    p.kmh = (bf16_t*)take((size_t)NIT * 128 * 2); p.kml = (bf16_t*)take((size_t)NIT * 128 * 2); p.mcount = (unsigned*)take((size_t)NIT * 4);
    p.arena = w + off;
    const size_t arena_bytes = ws_size - off;
    { size_t a = 0; auto at = [&](size_t bytes) { unsigned char* r = p.arena + a; a += al256(bytes); return r; };
      p.proj = (bf16_t*)at((size_t)NTOK * DINP * 2);
      p.gimg = (unsigned char*)at((size_t)NCHH * IMG_CH); p.gcdec = (float*)at((size_t)NCHH * 4);
      if (a > arena_bytes) fprintf(stderr, "workspace too small (layer0): need %zu have %zu\n", a, arena_bytes); }
    p.act0 = (bf16_t*)p.arena;
    { size_t a = 0; auto at = [&](size_t bytes) { unsigned char* r = p.arena + a; a += al256(bytes); return r; };
      p.qkv = (bf16_t*)at((size_t)NTOK * 3072 * 2); p.part_o = (bf16_t*)at((size_t)NTOK * 8 * 3 * 128 * 2); p.part_lse = (float*)at((size_t)NTOK * 8 * 3 * 4); p.mlist = (unsigned short*)at((size_t)BATCH * 8 * LTOT * 2);
      if (a > arena_bytes) fprintf(stderr, "workspace too small (layer1): need %zu have %zu\n", a, arena_bytes); }
    { size_t a = 0; auto at = [&](size_t bytes) { unsigned char* r = p.arena + a; a += al256(bytes); return r; };
      p.w8_mgu = at((size_t)NE * 2 * FFE * DM); p.w8_md = at((size_t)NE * DM * FFE); p.yslot = (bf16_t*)at((size_t)MAXTILES * 256 * DM * 2);
      p.hb3 = (bf16_t*)at((size_t)NTOK * DM * 2);
      p.mact = (bf16_t*)(p.arena + a);
      p.wt_mgu = nullptr; p.wt_md_tmp = p.mact; p.wt_md = nullptr;
      const size_t rest = arena_bytes > a ? arena_bytes - a : 0;
      if (rest < (size_t)NE * FFE * DM * 2) fprintf(stderr, "workspace too small (moe weights)\n");
      long tiles = (long)(rest / ((size_t)2 * 256 * FFE));
      if (tiles > 64) tiles = 64;
      if (tiles < 1) { fprintf(stderr, "workspace too small (moe)\n"); tiles = 1; }
#ifdef CPU_EMU
      if (getenv("EMU_TPP")) tiles = atoi(getenv("EMU_TPP"));
#endif
      p.tiles_per_pass = (int)tiles; }
#ifdef CPU_EMU
    emu::reg("hn", p.hn, (size_t)NTOK * DM * 2, "bf16"); emu::reg("proj", p.proj, (size_t)NTOK * DINP * 2, "bf16");
    emu::reg("gbeta", p.gbeta, (size_t)NTOK * 16, "f32"); emu::reg("gg", p.gg, (size_t)NTOK * 16, "f32"); emu::reg("midx", p.midx, (size_t)NTOK * 8, "i32");
    const int grid_blocks = getenv("EMU_GRID") ? atoi(getenv("EMU_GRID")) : 8;
    emu::launch(grid_blocks, NTHREADS, kDynLds, [=]() { fwd_megakernel(p); }, true);
#else
    static int grid_blocks = 0;
    if (!grid_blocks) {
        int dev = 0, cus = 0, per_cu = 0;
        (void)hipGetDevice(&dev);
        (void)hipDeviceGetAttribute(&cus, hipDeviceAttributeMultiprocessorCount, dev);
        (void)hipFuncSetAttribute((const void*)fwd_megakernel, hipFuncAttributeMaxDynamicSharedMemorySize, (int)kDynLds);
        (void)hipOccupancyMaxActiveBlocksPerMultiprocessor(&per_cu, fwd_megakernel, NTHREADS, kDynLds);
        if (per_cu < 1) per_cu = 1;
        grid_blocks = cus;
    }
    (void)hipMemsetAsync(p.bar, 0, (size_t)XCD_BAR_WORDS * 4, stream);
    void* args[] = {&p};
    hipError_t e = hipLaunchCooperativeKernel((const void*)fwd_megakernel, dim3(grid_blocks), dim3(NTHREADS), args, kDynLds, stream);
    if (e != hipSuccess) fprintf(stderr, "cooperative launch failed: %s (grid %d)\n", hipGetErrorString(e), grid_blocks);
#endif
}
```

```cpp
#ifndef CPU_EMU
#include <hip/hip_runtime.h>
#include <hip/hip_cooperative_groups.h>
#include <cstdio>
#include <cstring>
#define LAS __attribute__((address_space(3)))
#define WAVE_SYNC() __builtin_amdgcn_wave_barrier()
#define SCHED_FENCE() __builtin_amdgcn_sched_barrier(0)
#define OPAQUE_V(x) asm volatile("" : "+v"(x))
static __device__ __forceinline__ unsigned shfl_up_u(unsigned v, int o, int lane) { const int src = lane >= o ? lane - o : lane; return (unsigned)__builtin_amdgcn_ds_bpermute(src << 2, (int)v); }
static __device__ __forceinline__ float shfl_up_f(float v, int o, int lane) { return __uint_as_float(shfl_up_u(__float_as_uint(v), o, lane)); }
#define LDS_ATOMIC_ADD(ptr, v) __hip_atomic_fetch_add((ptr), (v), __ATOMIC_RELAXED, __HIP_MEMORY_SCOPE_WORKGROUP)
#define LDS_ATOMIC_MAX(ptr, v) __hip_atomic_fetch_max((ptr), (v), __ATOMIC_RELAXED, __HIP_MEMORY_SCOPE_WORKGROUP)
#define GLOBAL_ATOMIC_MAX(ptr, v) __hip_atomic_fetch_max((ptr), (v), __ATOMIC_RELAXED, __HIP_MEMORY_SCOPE_AGENT)
static __device__ __forceinline__ int opaque_tid(int wv) { int l; asm volatile("v_mbcnt_lo_u32_b32 %0, -1, 0\n\tv_mbcnt_hi_u32_b32 %0, -1, %0" : "=v"(l)); return (wv << 6) | l; }
#else
static inline int opaque_tid(int) { return threadIdx.x; }
#define LAS
#define WAVE_SYNC() ((void)__ballot(1))
#define SCHED_FENCE() ((void)0)
#define OPAQUE_V(x) ((void)0)
static inline unsigned shfl_up_u(unsigned v, int o, int lane) { return __shfl(v, lane >= o ? lane - o : lane); }
static inline float shfl_up_f(float v, int o, int lane) { return __shfl(v, lane >= o ? lane - o : lane); }
static inline unsigned emu_fetch_add(unsigned* p, unsigned v) { unsigned o = *p; *p = o + v; return o; }
#define LDS_ATOMIC_ADD(ptr, v) emu_fetch_add((ptr), (v))
static inline unsigned emu_fetch_max(unsigned* p, unsigned v) { unsigned o = *p; if (v > o) *p = v; return o; }
#define LDS_ATOMIC_MAX(ptr, v) emu_fetch_max((ptr), (v))
#define GLOBAL_ATOMIC_MAX(ptr, v) atomicMax((ptr), (v))
#endif
namespace cg = cooperative_groups;

#ifndef RPT_SYNC
#define RPT_SYNC 0
#endif
#ifndef RPT_SG
#define RPT_SG 1
#endif
#ifndef RPT_SR
#define RPT_SR 1
#endif
#ifndef RPT_MG
#define RPT_MG 1
#endif
#ifndef RPT_MO
#define RPT_MO 1
#endif
#ifndef RPT_GEMM
#define RPT_GEMM 1
#endif
#ifndef RPT_GDN
#define RPT_GDN 1
#endif
#ifndef RPT_SCAN
#define RPT_SCAN 1
#endif
#ifndef RPT_MOBA
#define RPT_MOBA 1
#endif
#ifndef RPT_CONV
#define RPT_CONV 1
#endif
#ifndef FP8_FFN0
#define FP8_FFN0 0
#endif
#ifndef CFG_SEQ
#define CFG_SEQ 16384
#define CFG_BATCH 2
#define CFG_FF 2816
#define CFG_FFE 3584
#endif

typedef unsigned short bf16_t;
typedef short bf16x8 __attribute__((ext_vector_type(8)));
typedef float f32x4 __attribute__((ext_vector_type(4)));
typedef float f32x16 __attribute__((ext_vector_type(16)));
typedef unsigned u32x4 __attribute__((ext_vector_type(4)));
typedef unsigned u32x2 __attribute__((ext_vector_type(2)));

constexpr int DM = 1024, SEQ = CFG_SEQ, BATCH = CFG_BATCH, NTOK = SEQ * BATCH, HD = 128;
constexpr int DIN = 4104, DINP = 4096, FF = CFG_FF, FFE = CFG_FFE, NE = 8;
constexpr int NCH = SEQ / 64, NBLK = SEQ / 256, NCHH = BATCH * 4 * NCH;
constexpr int NTHREADS = 512;
constexpr int BM = 256, BK = 64, HALF = 128, HTB = HALF * BK * 2, STAGE_BYTES = 8 * HTB, NXCD = 8, WGM = 4;
constexpr size_t kDynLds = 144 * 1024;
constexpr int MAXTILES = NTOK * 2 / 256 + NE;
constexpr int NIT = BATCH * 8 * NBLK;
constexpr int LTOT = NBLK * SEQ - 128 * NBLK * (NBLK + 1);
static_assert(SEQ <= 16384, "16-bit selection-list entries");
constexpr int GNT = (NBLK + 15) / 16;
constexpr int KS_STRIDE = 272, VT_STRIDE = 520;
constexpr int KS_BYTES = 256 * KS_STRIDE, VT_BYTES = 128 * VT_STRIDE;
__host__ __device__ __forceinline__ int list_off(int j) { return j * SEQ - 128 * j * (j + 1); }
constexpr float NORM_EPS = 1e-6f;

__device__ __forceinline__ bf16_t f2bf(float f) { unsigned u = __float_as_uint(f); u += 0x7FFFu + ((u >> 16) & 1u); return (bf16_t)(u >> 16); }
__device__ __forceinline__ float bf2f(bf16_t h) { return __uint_as_float(((unsigned)h) << 16); }
#ifndef CPU_EMU
typedef __bf16 hwbf16x2 __attribute__((ext_vector_type(2)));
typedef float f32x2v __attribute__((ext_vector_type(2)));
__device__ __forceinline__ unsigned pack2(float lo, float hi) { f32x2v v; v.x = lo; v.y = hi; hwbf16x2 b = __builtin_convertvector(v, hwbf16x2); unsigned r; __builtin_memcpy(&r, &b, 4); return r; }
#else
__device__ __forceinline__ unsigned pack2(float lo, float hi) { return (unsigned)f2bf(lo) | ((unsigned)f2bf(hi) << 16); }
#endif
#ifndef CPU_EMU
__device__ __forceinline__ float siluf(float x) { return x * __builtin_amdgcn_rcpf(1.0f + __builtin_amdgcn_exp2f(-1.4426950408889634f * x)); }
#else
__device__ __forceinline__ float siluf(float x) { return x / (1.0f + __expf(-x)); }
#endif
#ifndef CPU_EMU
__device__ __forceinline__ unsigned pack4_fp8(float a, float b, float c, float d) { int r = 0; r = __builtin_amdgcn_cvt_pk_fp8_f32(a, b, r, false); r = __builtin_amdgcn_cvt_pk_fp8_f32(c, d, r, true); return (unsigned)r; }
#else
static inline float fp8_to_f(unsigned char v) { const int s = v >> 7, e = (v >> 3) & 15, m = v & 7; const float a = e == 0 ? ldexpf((float)m, -9) : ldexpf((float)(8 + m), e - 10); return s ? -a : a; }
static inline unsigned char f_to_fp8(float x) {
    const unsigned s = x < 0.f ? 0x80u : 0u; float a = fabsf(x); if (!(a == a)) return 0x7f; if (a > 448.f) a = 448.f; if (a == 0.f) return (unsigned char)s;
    int e; (void)frexpf(a, &e); e -= 1; if (e < -6) e = -6;
    const float step = ldexpf(1.f, e - 3); float q = nearbyintf(a / step) * step; if (q > 448.f) q = 448.f;
    int e2; (void)frexpf(q, &e2); e2 -= 1; unsigned bits;
    if (q < ldexpf(1.f, -6)) bits = (unsigned)nearbyintf(q * 512.f); else bits = ((unsigned)(e2 + 7) << 3) | ((unsigned)nearbyintf(q / ldexpf(1.f, e2 - 3)) - 8u);
    return (unsigned char)(s | bits);
}
static inline unsigned pack4_fp8(float a, float b, float c, float d) { return (unsigned)f_to_fp8(a) | ((unsigned)f_to_fp8(b) << 8) | ((unsigned)f_to_fp8(c) << 16) | ((unsigned)f_to_fp8(d) << 24); }
#endif
constexpr float FP8_TOP = 384.f;
#ifndef CPU_EMU
__device__ __forceinline__ float wave_sum(float s) { int l; asm volatile("v_mbcnt_lo_u32_b32 %0, -1, 0\n\tv_mbcnt_hi_u32_b32 %0, -1, %0" : "=v"(l));
#pragma unroll
    for (int o = 32; o >= 1; o >>= 1) s += __uint_as_float((unsigned)__builtin_amdgcn_ds_bpermute((l ^ o) << 2, (int)__float_as_uint(s))); return s; }
__device__ __forceinline__ float wave_max(float s) { int l; asm volatile("v_mbcnt_lo_u32_b32 %0, -1, 0\n\tv_mbcnt_hi_u32_b32 %0, -1, %0" : "=v"(l));
#pragma unroll
    for (int o = 32; o >= 1; o >>= 1) s = fmaxf(s, __uint_as_float((unsigned)__builtin_amdgcn_ds_bpermute((l ^ o) << 2, (int)__float_as_uint(s)))); return s; }
#else
__device__ __forceinline__ float wave_sum(float s) { for (int o = 32; o >= 1; o >>= 1) s += __shfl_xor(s, o); return s; }
__device__ __forceinline__ float wave_max(float s) { for (int o = 32; o >= 1; o >>= 1) s = fmaxf(s, __shfl_xor(s, o)); return s; }
#endif

struct Params;
#ifndef CPU_EMU
typedef const __attribute__((address_space(4))) Params* KPTR;
#define KARG_PTR(arg) ((KPTR)__builtin_amdgcn_kernarg_segment_ptr())
#define LAUNDER(q) asm volatile("" : "+s"(q))
#else
typedef const Params* KPTR;
#define KARG_PTR(arg) (&(arg))
#define LAUNDER(q) ((void)0)
#endif
struct Params {
    const float* x; const float* mix_norm; const float* ffn_norm; const float* w_in; const float* conv_w; const float* a_log; const float* dt_bias;
    const float* ret_norm; const float* gdn_norm; const float* w_out0; const float* w_qkv; const float* w_out1; const float* w_gate0; const float* w_up0;
    const float* w_down0; const float* w_router; const float* w_mgate; const float* w_mup; const float* w_mdown; const float* final_norm;
    float* out;
    bf16_t* hb;
    bf16_t* hb3;
    unsigned* ctrl;
    unsigned* bar;
    bf16_t* wt_in; bf16_t* wt_out0; bf16_t* wt_gu0; bf16_t* wt_d0; bf16_t* wt_qkv; bf16_t* wt_out1;
    bf16_t* hn;
    float* gbeta; float* gg;
    float* retL;
    unsigned* gflag;
    unsigned char* arena;
    bf16_t* proj; unsigned char* gimg; float* gcdec;
    bf16_t* act0;
    bf16_t* qkv; bf16_t* kmh; bf16_t* kml; unsigned* mcount; unsigned short* mlist; bf16_t* part_o; float* part_lse;
    bf16_t* wt_mgu; bf16_t* wt_md; bf16_t* yslot; bf16_t* mact; int* arow; int* tile_e; int* slot_of; float* mgate; int* midx; unsigned* wghist;
    unsigned char* w8_gu0; float* ws_gu0; unsigned char* w8_mgu; float* ws_mgu; float* hns; float* sslot; unsigned char* w8_md; float* ws_md; float* hnn2; float* sn2; float* shs; bf16_t* wt_md_tmp;
    int tiles_per_pass; int pad0;
};

#define C_CNT(e) (64 + (e))
#define C_CUR(e) (128 + (e))
#define C_NTILES 192
#define C_GMAX 216
#define C_UMAX 224
#define C_TB 200

__host__ __device__ __forceinline__ int lds_byte(int r, int c) { const int st = (r >> 4) * 2 + (c >> 5), rr = r & 15, cc = c & 31, ob = rr * 64 + cc * 2; return st * 1024 + (ob ^ (((ob >> 9) & 1) << 5)); }
__host__ __device__ __forceinline__ void stage_rc(int b, int& R, int& C) { const int st = b / 1024, sb = b % 1024, swz = sb ^ (((sb >> 9) & 1) << 5); R = (st >> 1) * 16 + swz / 64; C = (st & 1) * 32 + (swz % 64) / 2; }
__host__ __device__ __forceinline__ int perm32(int rho) { const int n = rho >> 4, i = rho & 15; return 8 * (i >> 2) + 4 * n + (i & 3); }

struct Unit { int pm, pn, pnb; };
struct Gemm { const bf16_t* A; const bf16_t* Bt; const int* arow; };

struct StaticOrder {
    int nM, nN, nwg, G, c;
    __device__ void init(int nM_, int nN_, int G_, int c_) { nM = nM_; nN = nN_; nwg = nM * nN; G = G_; c = c_; }
    __device__ bool next(int i, Unit& u) const {
        const long L = (long)i * G + c; if (L >= nwg) return false;
        int wgid = (int)L; { const int q = nwg / NXCD, r = nwg % NXCD, xcd = wgid % NXCD, off = wgid / NXCD; wgid = (xcd < r ? xcd * (q + 1) : r * (q + 1) + (xcd - r) * q) + off; }
        const int nig = WGM * nN, gid = wgid / nig, fm = gid * WGM, gsz = (nM - fm) < WGM ? (nM - fm) : WGM;
        u.pm = fm + ((wgid % nig) % gsz); u.pn = (wgid % nig) / gsz; u.pnb = u.pn; return true;
    }
};
struct MoeOrder {
    StaticOrder so; int t0; const int* tile_e;
    __device__ void init(int t0_, int nM_, int nN_, const int* te, int G_, int c_) { so.init(nM_, nN_, G_, c_); t0 = t0_; tile_e = te; }
    __device__ bool next(int i, Unit& u) const { if (!so.next(i, u)) return false; u.pm += t0; u.pnb = tile_e[u.pm] * so.nN + u.pn; return true; }
};

struct EpiBf16 {
    static constexpr bool PERM = true;
    bf16_t* O; int ldc; int rowbase;
    __device__ __forceinline__ void operator()(const f32x4 (&acc)[2][2][4][2], const Unit& u, int wr, int wc, int fr, int fq) const {
        const int row0 = u.pm * BM + wr * 64 + fr - rowbase, col0 = u.pn * BM + wc * 32 + 8 * fq;
#pragma unroll
        for (int ai = 0; ai < 2; ++ai)
#pragma unroll
            for (int m = 0; m < 4; ++m) { bf16_t* rowp = O + (size_t)(row0 + ai * HALF + m * 16) * ldc + col0;
#pragma unroll
                for (int bj = 0; bj < 2; ++bj) { const f32x4 v0 = acc[ai][bj][m][0], v1 = acc[ai][bj][m][1];
                    u32x4 w; w.x = pack2(v0[0], v0[1]); w.y = pack2(v0[2], v0[3]); w.z = pack2(v1[0], v1[1]); w.w = pack2(v1[2], v1[3]);
                    *(u32x4*)(rowp + bj * HALF) = w; } }
    }
};
struct EpiSwiglu {
    static constexpr bool PERM = true;
    bf16_t* O; int ldc; int rowbase;
    __device__ __forceinline__ void operator()(const f32x4 (&acc)[2][2][4][2], const Unit& u, int wr, int wc, int fr, int fq) const {
        const int row0 = u.pm * BM + wr * 64 + fr - rowbase, col0 = u.pn * HALF + wc * 32 + 8 * fq;
#pragma unroll
        for (int ai = 0; ai < 2; ++ai)
#pragma unroll
            for (int m = 0; m < 4; ++m) { bf16_t* rowp = O + (size_t)(row0 + ai * HALF + m * 16) * ldc + col0;
                float r[8];
#pragma unroll
                for (int n = 0; n < 2; ++n)
#pragma unroll
                    for (int j = 0; j < 4; ++j) r[n * 4 + j] = siluf(acc[ai][0][m][n][j]) * acc[ai][1][m][n][j];
                u32x4 w; w.x = pack2(r[0], r[1]); w.y = pack2(r[2], r[3]); w.z = pack2(r[4], r[5]); w.w = pack2(r[6], r[7]);
                *(u32x4*)rowp = w; }
    }
};
struct EpiSwigluS {
    static constexpr bool PERM = true;
    bf16_t* O; int ldc; int rowbase; const float* sa; const float* sb;
    __device__ __forceinline__ void operator()(const f32x4 (&acc)[2][2][4][2], const Unit& u, int wr, int wc, int fr, int fq) const {
        const int rowg = u.pm * BM + wr * 64 + fr, row0 = rowg - rowbase, col0 = u.pn * HALF + wc * 32 + 8 * fq;
        const float* sbp = sb + (size_t)u.pnb * BM + wc * 32 + 8 * fq;
        f32x4 sg[2], su[2];
#pragma unroll
        for (int n = 0; n < 2; ++n) { sg[n] = *(const f32x4*)(sbp + 4 * n); su[n] = *(const f32x4*)(sbp + HALF + 4 * n); }
        float ra[2][4];
#pragma unroll
        for (int ai = 0; ai < 2; ++ai)
#pragma unroll
            for (int m = 0; m < 4; ++m) ra[ai][m] = sa[rowg + ai * HALF + m * 16];
#pragma unroll
        for (int ai = 0; ai < 2; ++ai)
#pragma unroll
            for (int m = 0; m < 4; ++m) { bf16_t* rowp = O + (size_t)(row0 + ai * HALF + m * 16) * ldc + col0;
                float r[8];
#pragma unroll
                for (int n = 0; n < 2; ++n)
#pragma unroll
                    for (int j = 0; j < 4; ++j) r[n * 4 + j] = siluf(acc[ai][0][m][n][j] * (ra[ai][m] * sg[n][j])) * (acc[ai][1][m][n][j] * (ra[ai][m] * su[n][j]));
                u32x4 w; w.x = pack2(r[0], r[1]); w.y = pack2(r[2], r[3]); w.z = pack2(r[4], r[5]); w.w = pack2(r[6], r[7]);
                *(u32x4*)rowp = w; }
    }
};
struct EpiSwigluS8 {
    static constexpr bool PERM = true;
    unsigned char* O8; int ldc; int rowbase; const float* sa; const float* sb; const float* so;
    __device__ __forceinline__ void operator()(const f32x4 (&acc)[2][2][4][2], const Unit& u, int wr, int wc, int fr, int fq) const {
        const int rowg = u.pm * BM + wr * 64 + fr, row0 = rowg - rowbase, col0 = u.pn * HALF + wc * 32 + 8 * fq;
        const float* sbp = sb + (size_t)u.pnb * BM + wc * 32 + 8 * fq;
        f32x4 sg[2], su[2];
#pragma unroll
        for (int n = 0; n < 2; ++n) { sg[n] = *(const f32x4*)(sbp + 4 * n); su[n] = *(const f32x4*)(sbp + HALF + 4 * n); }
        float ra[2][4], ro[2][4];
#pragma unroll
        for (int ai = 0; ai < 2; ++ai)
#pragma unroll
            for (int m = 0; m < 4; ++m) { ra[ai][m] = sa[rowg + ai * HALF + m * 16]; const float so_ = so[rowg + ai * HALF + m * 16]; ro[ai][m] = so_ > 0.f ? 1.0f / so_ : 0.f; }
#pragma unroll
        for (int ai = 0; ai < 2; ++ai)
#pragma unroll
            for (int m = 0; m < 4; ++m) { unsigned char* rowp = O8 + (size_t)(row0 + ai * HALF + m * 16) * ldc + col0;
                float r[8];
#pragma unroll
                for (int n = 0; n < 2; ++n)
#pragma unroll
                    for (int j = 0; j < 4; ++j) r[n * 4 + j] = siluf(acc[ai][0][m][n][j] * (ra[ai][m] * sg[n][j])) * (acc[ai][1][m][n][j] * (ra[ai][m] * su[n][j])) * ro[ai][m];
                u32x2 w; w.x = pack4_fp8(r[0], r[1], r[2], r[3]); w.y = pack4_fp8(r[4], r[5], r[6], r[7]);
                *(u32x2*)rowp = w; }
    }
};
struct EpiBf16S {
    static constexpr bool PERM = true;
    bf16_t* O; int ldc; const float* sa; const float* sb;
    __device__ __forceinline__ void operator()(const f32x4 (&acc)[2][2][4][2], const Unit& u, int wr, int wc, int fr, int fq) const {
        const int row0 = u.pm * BM + wr * 64 + fr, col0 = u.pn * BM + wc * 32 + 8 * fq;
        const float* sbp = sb + (size_t)u.pnb * BM + wc * 32 + 8 * fq;
        f32x4 sv[2][2];
#pragma unroll
        for (int bj = 0; bj < 2; ++bj)
#pragma unroll
            for (int n = 0; n < 2; ++n) sv[bj][n] = *(const f32x4*)(sbp + bj * HALF + 4 * n);
#pragma unroll
        for (int ai = 0; ai < 2; ++ai)
#pragma unroll
            for (int m = 0; m < 4; ++m) { bf16_t* rowp = O + (size_t)(row0 + ai * HALF + m * 16) * ldc + col0; const float ra = sa[row0 + ai * HALF + m * 16];
#pragma unroll
                for (int bj = 0; bj < 2; ++bj) { const f32x4 v0 = acc[ai][bj][m][0] * sv[bj][0] * ra, v1 = acc[ai][bj][m][1] * sv[bj][1] * ra;
                    u32x4 w; w.x = pack2(v0[0], v0[1]); w.y = pack2(v0[2], v0[3]); w.z = pack2(v1[0], v1[1]); w.w = pack2(v1[2], v1[3]);
                    *(u32x4*)(rowp + bj * HALF) = w; } }
    }
};
template <bool F32BASE>
struct EpiResBf16 {
    static constexpr bool PERM = true;
    static constexpr bool LSCALE = false;
    const float* basef; const bf16_t* baseb; bf16_t* out;
    __device__ __forceinline__ void operator()(const f32x4 (&acc)[2][2][4][2], const Unit& u, int wr, int wc, int fr, int fq) const {
        const int row0 = u.pm * BM + wr * 64 + fr, col0 = u.pn * BM + wc * 32 + 8 * fq;
#pragma unroll
        for (int ai = 0; ai < 2; ++ai)
#pragma unroll
            for (int m = 0; m < 4; ++m) { const size_t off = (size_t)(row0 + ai * HALF + m * 16) * DM + col0;
#pragma unroll
                for (int bj = 0; bj < 2; ++bj) { f32x4 b0, b1;
                    if (F32BASE) { b0 = *(const f32x4*)(basef + off + bj * HALF); b1 = *(const f32x4*)(basef + off + bj * HALF + 4); }
                    else { const u32x4 w = *(const u32x4*)(baseb + off + bj * HALF);
                        b0[0] = __uint_as_float(w.x << 16); b0[1] = __uint_as_float(w.x & 0xffff0000u); b0[2] = __uint_as_float(w.y << 16); b0[3] = __uint_as_float(w.y & 0xffff0000u);
                        b1[0] = __uint_as_float(w.z << 16); b1[1] = __uint_as_float(w.z & 0xffff0000u); b1[2] = __uint_as_float(w.w << 16); b1[3] = __uint_as_float(w.w & 0xffff0000u); }
                    const f32x4 v0 = acc[ai][bj][m][0] + b0, v1 = acc[ai][bj][m][1] + b1;
                    u32x4 o; o.x = pack2(v0[0], v0[1]); o.y = pack2(v0[2], v0[3]); o.z = pack2(v1[0], v1[1]); o.w = pack2(v1[2], v1[3]);
                    *(u32x4*)(out + off + bj * HALF) = o; } }
    }
};
struct EpiResF32 {
    static constexpr bool PERM = false;
    const float* base; float* out; int ldc;
    __device__ __forceinline__ void operator()(const f32x4 (&acc)[2][2][4][2], const Unit& u, int wr, int wc, int fr, int fq) const {
        const int row0 = u.pm * BM + wr * 64 + fr, col0 = u.pn * BM + wc * 32 + 4 * fq;
#pragma unroll
        for (int ai = 0; ai < 2; ++ai)
#pragma unroll
            for (int m = 0; m < 4; ++m) { const size_t off = (size_t)(row0 + ai * HALF + m * 16) * ldc + col0;
#pragma unroll
                for (int bj = 0; bj < 2; ++bj)
#pragma unroll
                    for (int n = 0; n < 2; ++n) { const f32x4 b = *(const f32x4*)(base + off + bj * HALF + n * 16); *(f32x4*)(out + off + bj * HALF + n * 16) = b + acc[ai][bj][m][n]; } }
    }
};

#ifndef CPU_EMU
typedef int i32x8 __attribute__((ext_vector_type(8)));
__device__ __forceinline__ i32x8 cat8(const bf16x8 lo, const bf16x8 hi) { u32x4 a, b; __builtin_memcpy(&a, &lo, 16); __builtin_memcpy(&b, &hi, 16); i32x8 r; r[0] = (int)a.x; r[1] = (int)a.y; r[2] = (int)a.z; r[3] = (int)a.w; r[4] = (int)b.x; r[5] = (int)b.y; r[6] = (int)b.z; r[7] = (int)b.w; return r; }
template <int K, class Epi, class Sched, bool FP8 = false>
__device__ __forceinline__ void gemm_phase(LAS unsigned char* lds, const Gemm g, const Sched& S, const Epi& E, int wv) {
    const int tid = opaque_tid(wv), wid = __builtin_amdgcn_readfirstlane(tid >> 6), lane = tid & 63, wr = wid >> 2, wc = wid & 3, fr = lane & 15, fq = lane >> 4;
    constexpr int RB = FP8 ? K : 2 * K;
    constexpr int nt = RB / 128;
    static_assert(nt % 2 == 0 && nt >= 4, "k tiles");
    unsigned voffB[2];
#pragma unroll
    for (int i = 0; i < 2; ++i) { int R, C; stage_rc(tid * 16 + i * 8192, R, C); const int Rb = Epi::PERM ? ((R & ~31) + perm32(R & 31)) : R; voffB[i] = (unsigned)(Rb * RB + C * 2); }
    constexpr size_t kstep = (size_t)(BK * 2);
    constexpr size_t hstep = (size_t)HALF * RB;
    constexpr size_t tstep = 2 * hstep;
    const unsigned ldsw = (unsigned)wid * 1024u;
    const int aoffl = lds_byte(wr * 64 + fr, fq * 8), boffl = lds_byte(wc * 32 + fr, fq * 8);
    unsigned aoff[2][2];
#define G_LOADA(u) do { _Pragma("unroll") for (int _h = 0; _h < 2; ++_h) _Pragma("unroll") for (int _i = 0; _i < 2; ++_i) { int _R, _C; stage_rc(tid * 16 + _i * 8192, _R, _C); const int _r = (u).pm * BM + _h * HALF + _R; \
        const int _s = g.arow ? g.arow[_r] : _r; aoff[_h][_i] = (unsigned)(_s * RB + _C * 2); } } while (0)
#define G_SA(b, h) (((b) * 2 + (h)) * HTB)
#define G_SB(b, h) ((4 + (b) * 2 + (h)) * HTB)
#define G_STAGEB(bufoff, gbase) do { _Pragma("unroll") for (int _i = 0; _i < 2; ++_i) \
        __builtin_amdgcn_global_load_lds((const unsigned*)((const char*)(gbase) + voffB[_i]), (LAS unsigned*)(lds + (bufoff) + ldsw + _i * 8192), 16, 0, 0); } while (0)
#define G_STAGEA(bufoff, kt, h) do { _Pragma("unroll") for (int _i = 0; _i < 2; ++_i) \
        __builtin_amdgcn_global_load_lds((const unsigned*)((const char*)g.A + (size_t)(kt) * kstep + aoff[h][_i]), (LAS unsigned*)(lds + (bufoff) + ldsw + _i * 8192), 16, 0, 0); } while (0)
#define G_LDA(dst, b, h) do { _Pragma("unroll") for (int m = 0; m < 4; ++m) _Pragma("unroll") for (int k = 0; k < 2; ++k) dst[m][k] = *(const LAS bf16x8*)(lds + G_SA(b, h) + aoffl + m * 2048 + k * 1024); } while (0)
#define G_LDB(dst, b, h) do { _Pragma("unroll") for (int n = 0; n < 2; ++n) _Pragma("unroll") for (int k = 0; k < 2; ++k) dst[n][k] = *(const LAS bf16x8*)(lds + G_SB(b, h) + boffl + n * 2048 + k * 1024); } while (0)
#define G_MMA(ai, bj, At, Bt) do { if constexpr (FP8) __builtin_amdgcn_sched_barrier(0); __builtin_amdgcn_s_setprio(1); _Pragma("unroll") for (int m = 0; m < 4; ++m) _Pragma("unroll") for (int n = 0; n < 2; ++n) { \
        if constexpr (FP8) acc[ai][bj][m][n] = __builtin_amdgcn_mfma_scale_f32_16x16x128_f8f6f4(cat8(Bt[n][0], Bt[n][1]), cat8(At[m][0], At[m][1]), acc[ai][bj][m][n], 0, 0, 0, 0x7F7F7F7F, 0, 0x7F7F7F7F); \
        else { _Pragma("unroll") for (int k = 0; k < 2; ++k) acc[ai][bj][m][n] = __builtin_amdgcn_mfma_f32_16x16x32_bf16(Bt[n][k], At[m][k], acc[ai][bj][m][n], 0, 0, 0); } } \
        __builtin_amdgcn_s_setprio(0); if constexpr (FP8) __builtin_amdgcn_sched_barrier(0); } while (0)
#define G_WAIT_V(n) asm volatile("s_waitcnt vmcnt(" #n ")" ::: "memory")
#define G_WAIT_L(n) asm volatile("s_waitcnt lgkmcnt(" #n ")" ::: "memory")
#define G_BAR __builtin_amdgcn_s_barrier()
#define G_SCHED __builtin_amdgcn_sched_barrier(0)
    Unit cur, nxt; int ui = 0;
    if (!S.next(0, cur)) return;
    f32x4 acc[2][2][4][2];
#pragma unroll
    for (int a = 0; a < 2; ++a)
#pragma unroll
        for (int b = 0; b < 2; ++b)
#pragma unroll
            for (int m = 0; m < 4; ++m)
#pragma unroll
                for (int n = 0; n < 2; ++n) acc[a][b][m][n] = (f32x4){0.f, 0.f, 0.f, 0.f};
    bf16x8 At[4][2], B0[2][2], B1[2][2];
    const char* cB = (const char*)g.Bt + (size_t)cur.pnb * tstep;
    G_LOADA(cur);
    G_STAGEB(G_SB(0, 0), cB); G_STAGEA(G_SA(0, 0), 0, 0); G_STAGEB(G_SB(0, 1), cB + hstep); G_STAGEA(G_SA(0, 1), 0, 1);
    if (wr == 1) G_BAR;
    G_WAIT_V(4); G_BAR;
    G_STAGEB(G_SB(1, 0), cB + kstep); G_STAGEA(G_SA(1, 0), 1, 0); G_STAGEB(G_SB(1, 1), cB + hstep + kstep);
    G_WAIT_V(6); G_BAR;
    for (;;) {
        const bool has_next = S.next(ui + 1, nxt);
        const char* nB = has_next ? (const char*)g.Bt + (size_t)nxt.pnb * tstep : cB;
        for (int t = 0; t < nt; t += 2) {
            const bool last = (t == nt - 2);
            const int k2 = last ? 0 : t + 2, k3 = k2 + 1;
            const char* b2 = last ? nB : cB + (size_t)(t + 2) * kstep; const char* b3 = b2 + kstep;
            G_LDB(B0, 0, 0); G_SCHED; G_LDA(At, 0, 0); G_STAGEA(G_SA(1, 1), t + 1, 1);
            if (g.arow && has_next && t == nt - 4 && tid < BM)
                __builtin_amdgcn_global_load_lds((const unsigned*)(g.arow + nxt.pm * BM + tid), (LAS unsigned*)(lds + STAGE_BYTES + wid * 256), 4, 0, 0);
            G_WAIT_L(8); G_BAR; G_WAIT_L(0); G_MMA(0, 0, At, B0); G_BAR; G_SCHED;
            if (last && has_next) {
                if (g.arow) {
#pragma unroll
                    for (int _h = 0; _h < 2; ++_h)
#pragma unroll
                        for (int _i = 0; _i < 2; ++_i) { int _R, _C; stage_rc(tid * 16 + _i * 8192, _R, _C); const int _s = *(LAS const int*)(lds + STAGE_BYTES + (_h * HALF + _R) * 4); aoff[_h][_i] = (unsigned)(_s * RB + _C * 2); }
                } else G_LOADA(nxt);
            }
            G_LDB(B1, 0, 1); G_STAGEB(G_SB(0, 0), b2);
            G_BAR; G_WAIT_L(0); G_MMA(0, 1, At, B1); G_BAR;
            G_LDA(At, 0, 1); G_STAGEA(G_SA(0, 0), k2, 0);
            G_BAR; G_WAIT_L(0); G_MMA(1, 0, At, B0); G_BAR; G_SCHED;
            G_STAGEB(G_SB(0, 1), b2 + hstep);
            G_WAIT_V(6); G_BAR; G_MMA(1, 1, At, B1); G_BAR;
            G_LDB(B0, 1, 0); G_SCHED; G_LDA(At, 1, 0); G_STAGEA(G_SA(0, 1), k2, 1);
            G_WAIT_L(8); G_BAR; G_WAIT_L(0); G_MMA(0, 0, At, B0); G_BAR; G_SCHED;
            G_LDB(B1, 1, 1); G_STAGEB(G_SB(1, 0), b3);
            G_BAR; G_WAIT_L(0); G_MMA(0, 1, At, B1); G_BAR;
            G_LDA(At, 1, 1); G_STAGEA(G_SA(1, 0), k3, 0);
            G_BAR; G_WAIT_L(0); G_MMA(1, 0, At, B0); G_BAR; G_SCHED;
            G_STAGEB(G_SB(1, 1), b3 + hstep);
            G_WAIT_V(6); G_BAR; G_MMA(1, 1, At, B1); G_BAR;
        }
        E(acc, cur, wr, wc, fr, fq);
        if (!has_next) break;
#pragma unroll
        for (int a = 0; a < 2; ++a)
#pragma unroll
            for (int b = 0; b < 2; ++b)
#pragma unroll
                for (int m = 0; m < 4; ++m)
#pragma unroll
                    for (int n = 0; n < 2; ++n) acc[a][b][m][n] = (f32x4){0.f, 0.f, 0.f, 0.f};
        cur = nxt; cB = nB; ++ui;
    }
    G_WAIT_V(0);
    if (wr == 0) G_BAR;
    G_BAR;
}
#else
template <int K, class Epi, class Sched, bool FP8 = false>
__device__ __forceinline__ void gemm_phase(unsigned char* lds, const Gemm g, const Sched& S, const Epi& E, int wv) {
    const int tid = opaque_tid(wv), wid = tid >> 6, lane = tid & 63, wr = wid >> 2, wc = wid & 3, fr = lane & 15, fq = lane >> 4;
    Unit u;
    for (int ui = 0; S.next(ui, u); ++ui) {
        f32x4 acc[2][2][4][2];
        for (int ai = 0; ai < 2; ++ai) for (int bj = 0; bj < 2; ++bj) for (int m = 0; m < 4; ++m) for (int n = 0; n < 2; ++n) for (int j = 0; j < 4; ++j) {
            const int r = u.pm * 256 + 128 * ai + 64 * wr + 16 * m + fr;
            const int cl = Epi::PERM ? (128 * bj + 32 * wc + 8 * fq + 4 * n + j) : (128 * bj + 32 * wc + 16 * n + 4 * fq + j);
            const int ar = g.arow ? g.arow[r] : r;
            float s = 0.f;
            if (FP8) { const unsigned char* a = (const unsigned char*)g.A + (size_t)ar * K; const unsigned char* b = (const unsigned char*)g.Bt + ((size_t)u.pnb * 256 + cl) * K; for (int k = 0; k < K; ++k) s += fp8_to_f(a[k]) * fp8_to_f(b[k]); }
            else { const bf16_t* a = g.A + (size_t)ar * K; const bf16_t* b = g.Bt + ((size_t)u.pnb * 256 + cl) * K; for (int k = 0; k < K; ++k) s += bf2f(a[k]) * bf2f(b[k]); }
            acc[ai][bj][m][n][j] = s;
        }
        E(acc, u, wr, wc, fr, fq);
    }
}
#endif

__device__ __forceinline__ void convert_wt(LAS unsigned char* lds, const float* W, int K, int ldw, int col0, int ncols, bf16_t* Wt, int rowmul, int rowadd, int bid, int nb, int wv) {
    LAS float* t = (LAS float*)lds;
    const int tid = opaque_tid(wv);
    const int tk = K / 64, tn = ncols / 64, ntile = tk * tn;
    const int lr = tid >> 4, c4 = (tid & 15) * 4;
    f32x4 v[2];
    if (bid < ntile) { const int k0 = (bid % tk) * 64, n0 = (bid / tk) * 64;
#pragma unroll
        for (int i = 0; i < 2; ++i) v[i] = *(const f32x4*)(W + (size_t)(k0 + lr + 32 * i) * ldw + col0 + n0 + c4); }
    for (int tile = bid; tile < ntile; tile += nb) {
        const int k0 = (tile % tk) * 64, n0 = (tile / tk) * 64;
        __syncthreads();
#pragma unroll
        for (int i = 0; i < 2; ++i) { const int r = lr + 32 * i; t[r * 65 + c4] = v[i][0]; t[r * 65 + c4 + 1] = v[i][1]; t[r * 65 + c4 + 2] = v[i][2]; t[r * 65 + c4 + 3] = v[i][3]; }
        const int nt2 = tile + nb;
        if (nt2 < ntile) { const int k1 = (nt2 % tk) * 64, n1 = (nt2 / tk) * 64;
#pragma unroll
            for (int i = 0; i < 2; ++i) v[i] = *(const f32x4*)(W + (size_t)(k1 + lr + 32 * i) * ldw + col0 + n1 + c4); }
        __syncthreads();
        { const int c = tid >> 3, k8 = (tid & 7) * 8; const int cc = n0 + c; const int dr = (cc >> 7) * rowmul + (cc & 127) + rowadd;
          u32x4 w; w.x = pack2(t[(k8 + 0) * 65 + c], t[(k8 + 1) * 65 + c]); w.y = pack2(t[(k8 + 2) * 65 + c], t[(k8 + 3) * 65 + c]);
          w.z = pack2(t[(k8 + 4) * 65 + c], t[(k8 + 5) * 65 + c]); w.w = pack2(t[(k8 + 6) * 65 + c], t[(k8 + 7) * 65 + c]);
          *(u32x4*)(Wt + (size_t)dr * K + k0 + k8) = w; }
    }
    __syncthreads();
}

__device__ __forceinline__ void load_row(const float* src, int row, int lane, f32x4 (&v)[4]) {
#pragma unroll
    for (int i = 0; i < 4; ++i) v[i] = *(const f32x4*)(src + (size_t)row * DM + i * 256 + lane * 4);
}
__device__ __forceinline__ void load_row_b(const bf16_t* src, int row, int lane, f32x4 (&v)[4]) {
#pragma unroll
    for (int i = 0; i < 4; ++i) { const u32x2 w = *(const u32x2*)(src + (size_t)row * DM + i * 256 + lane * 4);
        v[i][0] = __uint_as_float(w.x << 16); v[i][1] = __uint_as_float(w.x & 0xffff0000u); v[i][2] = __uint_as_float(w.y << 16); v[i][3] = __uint_as_float(w.y & 0xffff0000u); }
}
__device__ __forceinline__ float row_rstd(const f32x4 (&v)[4]) {
    float s = 0.f;
#pragma unroll
    for (int i = 0; i < 4; ++i) s += v[i][0] * v[i][0] + v[i][1] * v[i][1] + v[i][2] * v[i][2] + v[i][3] * v[i][3];
    s = wave_sum(s);
    return rsqrtf(s * (1.0f / DM) + NORM_EPS);
}
__device__ __forceinline__ void store_row_bf16(bf16_t* dst, int row, int lane, const f32x4 (&v)[4]) {
#pragma unroll
    for (int i = 0; i < 4; ++i) { u32x2 w; w.x = pack2(v[i][0], v[i][1]); w.y = pack2(v[i][2], v[i][3]); *(u32x2*)(dst + (size_t)row * DM + i * 256 + lane * 4) = w; }
}

__device__ __forceinline__ void store_row_fp8(unsigned char* dst, float* scale, int row, int lane, const f32x4 (&v)[4]) {
    float am = 0.f;
#pragma unroll
    for (int i = 0; i < 4; ++i) am = fmaxf(fmaxf(am, fmaxf(fabsf(v[i][0]), fabsf(v[i][1]))), fmaxf(fabsf(v[i][2]), fabsf(v[i][3])));
    am = wave_max(am);
    const float sc = am > 0.f ? am * (1.0f / FP8_TOP) : 1.0f, inv = 1.0f / sc;
#pragma unroll
    for (int i = 0; i < 4; ++i) *(unsigned*)(dst + (size_t)row * DM + i * 256 + lane * 4) = pack4_fp8(v[i][0] * inv, v[i][1] * inv, v[i][2] * inv, v[i][3] * inv);
    if (lane == 0) scale[row] = sc;
}
template <int K, bool NORMS>
__device__ __forceinline__ void quant_rows(KPTR p, LAS unsigned char* lds, const bf16_t* src, unsigned char* dst, float* scl, int nrows, int bid, int nb, int wv) {
    constexpr int NC = K / 512;
    const int tid = opaque_tid(wv), wid = tid >> 6, lane = tid & 63;
    LAS unsigned* nmx = (LAS unsigned*)lds;
    if (NORMS) { if (tid < 2 * NE) nmx[tid] = 0u; __syncthreads(); }
    int row = bid * 8 + wid;
    u32x4 nx[NC];
#pragma unroll
    for (int c = 0; c < NC; ++c) nx[c] = (u32x4){0u, 0u, 0u, 0u};
    if (row < nrows) {
#pragma unroll
        for (int c = 0; c < NC; ++c) nx[c] = *(const u32x4*)(src + (size_t)row * K + (c * 64 + lane) * 8); }
    for (; row < nrows; row += nb * 8) {
        u32x4 cu[NC];
#pragma unroll
        for (int c = 0; c < NC; ++c) cu[c] = nx[c];
        const int rn = row + nb * 8;
        if (rn < nrows) {
#pragma unroll
            for (int c = 0; c < NC; ++c) nx[c] = *(const u32x4*)(src + (size_t)rn * K + (c * 64 + lane) * 8); }
        float am = 0.f, ss = 0.f;
#pragma unroll
        for (int c = 0; c < NC; ++c)
#pragma unroll
            for (int q = 0; q < 4; ++q) { const float lo = __uint_as_float(cu[c][q] << 16), hi = __uint_as_float(cu[c][q] & 0xffff0000u); am = fmaxf(am, fmaxf(fabsf(lo), fabsf(hi))); if (NORMS) ss += lo * lo + hi * hi; }
        am = wave_max(am);
        const float sc = am > 0.f ? am * (1.0f / FP8_TOP) : 1.0f, inv = 1.0f / sc;
#pragma unroll
        for (int c = 0; c < NC; ++c) { u32x2 w;
            w.x = pack4_fp8(__uint_as_float(cu[c][0] << 16) * inv, __uint_as_float(cu[c][0] & 0xffff0000u) * inv, __uint_as_float(cu[c][1] << 16) * inv, __uint_as_float(cu[c][1] & 0xffff0000u) * inv);
            w.y = pack4_fp8(__uint_as_float(cu[c][2] << 16) * inv, __uint_as_float(cu[c][2] & 0xffff0000u) * inv, __uint_as_float(cu[c][3] << 16) * inv, __uint_as_float(cu[c][3] & 0xffff0000u) * inv);
            *(u32x2*)(dst + (size_t)row * K + (c * 64 + lane) * 8) = w; }
        if (lane == 0) scl[row] = sc;
        if (NORMS) { ss = wave_sum(ss); if (lane == 0) LDS_ATOMIC_MAX(nmx + ((row >> 7) & 1) * NE + row / (2 * FFE), __float_as_uint(sqrtf(ss))); }
    }
    if (NORMS) { __syncthreads(); if (tid < 2 * NE) (void)GLOBAL_ATOMIC_MAX(p->ctrl + (tid < NE ? C_GMAX + tid : C_UMAX + tid - NE), nmx[tid]); __syncthreads(); }
}
__device__ __forceinline__ const float* gu_src(KPTR p, int item, int t, int kr, int c4) {
    constexpr int NPAN = FFE / 32;
    const int e = item / (2 * NPAN), r = item % (2 * NPAN), up = r / NPAN, pn = r % NPAN;
    return (up ? p->w_mup : p->w_mgate) + (size_t)e * DM * FFE + (size_t)(t * 64 + kr) * FFE + pn * 32 + c4;
}
__device__ __forceinline__ void convert_gu_fp8(KPTR p, LAS unsigned char* lds, int bid, int nb, int wv) {
    constexpr int PSF = 1028, NPAN = FFE / 32, NITEM = NE * 2 * NPAN, TPI = DM / 64;
    const int tid = opaque_tid(wv), wid = tid >> 6, lane = tid & 63;
    LAS float* pan = (LAS float*)lds;
    LAS float* red = pan + 32 * PSF;
    LAS float* scl = red + 8 * 32 * 2;
    const int c4 = (tid & 7) * 4, kr = tid >> 3;
    const int nmine = bid < NITEM ? (NITEM - bid + nb - 1) / nb : 0, total = nmine * TPI;
    if (nmine == 0) return;
    constexpr int PD = 8;
    static_assert(TPI % PD == 0, "ring");
    f32x4 pf[PD];
#pragma unroll
    for (int i = 0; i < PD; ++i) { const int gi = i < total ? i : total - 1; pf[i] = *(const f32x4*)gu_src(p, bid + (gi / TPI) * nb, gi % TPI, kr, c4); }
    int g = 0;
    for (int it = 0; it < nmine; ++it) {
        const int item = bid + it * nb, e = item / (2 * NPAN), r = item % (2 * NPAN), up = r / NPAN, pn = r % NPAN;
        float am[4] = {0.f, 0.f, 0.f, 0.f}, ss[4] = {0.f, 0.f, 0.f, 0.f};
        for (int t0 = 0; t0 < TPI; t0 += PD) {
#pragma unroll
            for (int u = 0; u < PD; ++u, ++g) { const int t = t0 + u;
                const f32x4 v = pf[u];
                { int gn = g + PD; gn = gn < total ? gn : total - 1; int kr2 = kr; OPAQUE_V(kr2); pf[u] = *(const f32x4*)gu_src(p, bid + (gn / TPI) * nb, gn % TPI, kr2, c4); }
#pragma unroll
                for (int j = 0; j < 4; ++j) { am[j] = fmaxf(am[j], fabsf(v[j])); ss[j] += v[j] * v[j]; pan[(c4 + j) * PSF + t * 64 + kr] = v[j]; }
            }
        }
#pragma unroll
        for (int j = 0; j < 4; ++j) {
#pragma unroll
            for (int o = 8; o <= 32; o <<= 1) { am[j] = fmaxf(am[j], __shfl_xor(am[j], o)); ss[j] += __shfl_xor(ss[j], o); }
        }
        if ((lane >> 3) == 0) {
#pragma unroll
            for (int j = 0; j < 4; ++j) { red[(wid * 32 + c4 + j) * 2] = am[j]; red[(wid * 32 + c4 + j) * 2 + 1] = ss[j]; } }
        __syncthreads();
        if (tid < 64) { float a = 0.f, q = 0.f;
            if (tid < 32) {
#pragma unroll
                for (int w = 0; w < 8; ++w) { a = fmaxf(a, red[(w * 32 + tid) * 2]); q += red[(w * 32 + tid) * 2 + 1]; }
                const float sc = a > 0.f ? a * (1.0f / FP8_TOP) : 1.0f; scl[tid] = sc; scl[32 + tid] = 1.0f / sc;
                const int cc = pn * 32 + tid; p->ws_mgu[(size_t)e * 2 * FFE + (cc >> 7) * 256 + (cc & 127) + up * 128] = sc; }
            const float nm = wave_max(tid < 32 ? sqrtf(q) : 0.f);
            if (tid == 0) (void)GLOBAL_ATOMIC_MAX(p->ctrl + (up ? C_UMAX : C_GMAX) + e, __float_as_uint(nm)); }
        __syncthreads();
#pragma unroll
        for (int i2 = 0; i2 < 8; ++i2) { const int n = i2 * 4 + (tid >> 7), k8 = (tid & 127) * 8, cc = pn * 32 + n;
            const f32x4 a = *(LAS const f32x4*)(pan + n * PSF + k8), b = *(LAS const f32x4*)(pan + n * PSF + k8 + 4); const float inv = scl[32 + n];
            u32x2 w; w.x = pack4_fp8(a[0] * inv, a[1] * inv, a[2] * inv, a[3] * inv); w.y = pack4_fp8(b[0] * inv, b[1] * inv, b[2] * inv, b[3] * inv);
            *(u32x2*)(p->w8_mgu + ((size_t)e * 2 * FFE + (cc >> 7) * 256 + (cc & 127) + up * 128) * DM + k8) = w; }
        __syncthreads();
    }
}
template <bool WITH_GDN, bool OUT8 = false, bool SRCB = false>
__device__ __forceinline__ void phase_norm(KPTR p, const void* src, const float* gain, int bid, int nb, int wv) {
    const int tid = opaque_tid(wv), wid = tid >> 6, lane = tid & 63;
    f32x4 gv[4];
#pragma unroll
    for (int i = 0; i < 4; ++i) gv[i] = *(const f32x4*)(gain + i * 256 + lane * 4);
    f32x4 w8[WITH_GDN ? 16 : 1][2];
    if (WITH_GDN) {
#pragma unroll
        for (int i = 0; i < 4; ++i)
#pragma unroll
            for (int e = 0; e < 4; ++e) { const float* wr_ = p->w_in + (size_t)(i * 256 + lane * 4 + e) * DIN + DINP; w8[i * 4 + e][0] = *(const f32x4*)wr_; w8[i * 4 + e][1] = *(const f32x4*)(wr_ + 4); }
    }
    for (int row = bid * 8 + wid; row < NTOK; row += nb * 8) {
        f32x4 v[4]; if (SRCB) load_row_b((const bf16_t*)src, row, lane, v); else load_row((const float*)src, row, lane, v);
        const float rs = row_rstd(v);
#pragma unroll
        for (int i = 0; i < 4; ++i) v[i] = v[i] * rs * gv[i];
        if (OUT8) store_row_fp8((unsigned char*)p->hn, p->hns, row, lane, v); else store_row_bf16(p->hn, row, lane, v);
        if (WITH_GDN) {
            f32x4 d0 = (f32x4){0.f, 0.f, 0.f, 0.f}, d1 = (f32x4){0.f, 0.f, 0.f, 0.f};
#pragma unroll
            for (int i = 0; i < 4; ++i)
#pragma unroll
                for (int e = 0; e < 4; ++e) { const float xv = v[i][e]; d0 = d0 + w8[i * 4 + e][0] * xv; d1 = d1 + w8[i * 4 + e][1] * xv; }
            float d[8] = {d0[0], d0[1], d0[2], d0[3], d1[0], d1[1], d1[2], d1[3]};
#pragma unroll
            for (int j = 0; j < 8; ++j) d[j] = wave_sum(d[j]);
            if (lane < 4) {
                const float braw = lane == 0 ? d[0] : lane == 1 ? d[1] : lane == 2 ? d[2] : d[3];
                const float araw = lane == 0 ? d[4] : lane == 1 ? d[5] : lane == 2 ? d[6] : d[7];
                p->gbeta[(size_t)row * 4 + lane] = 1.0f / (1.0f + __expf(-braw));
                const float z = araw + p->dt_bias[lane];
                const float sp = z > 20.f ? z : log1pf(__expf(z));
                p->gg[(size_t)row * 4 + lane] = -__expf(p->a_log[lane]) * sp;
            }
        }
    }
}

constexpr int IMG_W = 0, IMG_QD = 17408, IMG_KDT = 34816, IMG_AT = 53248, IMG_U = 62464, IMG_CH = 78848;
__host__ __device__ constexpr int permb(int k) { return (k >> 5) * 64 + ((((k & 15) >> 2) * 8) + (((k >> 4) & 1) * 4) + (k & 3)) * 2; }
__device__ __forceinline__ bf16x8 frag2(LAS const unsigned char* ptr) {
    const u32x2 lo = *(LAS const u32x2*)ptr, hi = *(LAS const u32x2*)(ptr + 32);
    u32x4 w; w.x = lo.x; w.y = lo.y; w.z = hi.x; w.w = hi.y; bf16x8 r; __builtin_memcpy(&r, &w, 16); return r;
}
__device__ __forceinline__ bf16x8 pack8(const f32x4 a, const f32x4 b) {
    u32x4 w; w.x = pack2(a[0], a[1]); w.y = pack2(a[2], a[3]); w.z = pack2(b[0], b[1]); w.w = pack2(b[2], b[3]); bf16x8 r; __builtin_memcpy(&r, &w, 16); return r;
}


#ifndef CPU_EMU
__device__ __forceinline__ void st_wt32(void* p, unsigned v) { __hip_atomic_store((unsigned*)p, v, __ATOMIC_RELAXED, __HIP_MEMORY_SCOPE_AGENT); }
__device__ __forceinline__ void st_wt64(void* p, u32x2 v) { unsigned long long x = ((unsigned long long)v.y << 32) | v.x; __hip_atomic_store((unsigned long long*)p, x, __ATOMIC_RELAXED, __HIP_MEMORY_SCOPE_AGENT); }
#else
static inline void st_wt32(void* p, unsigned v) { *(unsigned*)p = v; }
static inline void st_wt64(void* p, u32x2 v) { *(u32x2*)p = v; }
#endif

#ifndef CPU_EMU
__device__ __forceinline__ void gdn_publish(unsigned* flag, int tid) {
    asm volatile("s_waitcnt vmcnt(0)" ::: "memory");
    __syncthreads();
    if (tid == 0) __hip_atomic_store(flag, 1u, __ATOMIC_RELAXED, __HIP_MEMORY_SCOPE_AGENT);
}
__device__ __forceinline__ void gdn_wait8(const unsigned* flags, int c, int nmax, int lane) {
    const int k = c + (lane & 7); const bool need = k < nmax;
    unsigned spins = 0;
    for (;;) {
        const unsigned v = need ? __hip_atomic_load(flags + k, __ATOMIC_RELAXED, __HIP_MEMORY_SCOPE_AGENT) : 1u;
        if (__all(v != 0u)) break;
        __builtin_amdgcn_s_sleep(4); if (++spins > (1u << 22)) break;
    }
    __builtin_amdgcn_fence(__ATOMIC_ACQUIRE, "agent");
}
__device__ __forceinline__ float ld_coherent(const float* p) { return __uint_as_float(__hip_atomic_load((const unsigned*)p, __ATOMIC_RELAXED, __HIP_MEMORY_SCOPE_AGENT)); }
#else
static inline void gdn_publish(unsigned* flag, int tid) { __syncthreads(); if (tid == 0) __atomic_store_n(flag, 1u, __ATOMIC_SEQ_CST); }
static inline void gdn_wait8(const unsigned* flags, int c, int nmax, int lane) { for (int k = c; k < c + 8 && k < nmax; ++k) while (__atomic_load_n(flags + k, __ATOMIC_SEQ_CST) == 0) emu::yield(); }
static inline float ld_coherent(const float* p) { return *p; }
#endif

template <int I> struct TSolve {
    static __device__ __forceinline__ void run(float (&tc)[64], LAS const float* sL, LAS unsigned char* tb, int lane) {
        TSolve<I - 1>::run(tc, sL, tb, lane);
        float p0 = 0.f, p1 = 0.f, p2 = 0.f, p3 = 0.f;
#pragma unroll
        for (int j = 0; j < I; ++j) { const float pr = sL[I * 68 + j] * tc[j]; if ((j & 3) == 0) p0 += pr; else if ((j & 3) == 1) p1 += pr; else if ((j & 3) == 2) p2 += pr; else p3 += pr; }
        const float t2 = ((I == lane) ? 1.f : 0.f) - ((p0 + p1) + (p2 + p3));
        tc[I] = t2; *(LAS bf16_t*)(tb + I * 144 + 2 * lane) = f2bf(t2);
    }
};
template <> struct TSolve<-1> { static __device__ __forceinline__ void run(float (&)[64], LAS const float*, LAS unsigned char*, int) {} };

template <bool PUBLISH>
__device__ __forceinline__ void phase_gdn_pre(KPTR p, LAS unsigned char* lds, int first, int stride, int wv) {
    constexpr int QB = 0, KB = 17408, VBT = 34816, KBT = 53248, KDT = 71680, LF = 90112, TB = 107520, ATB = 116736, SG = 125952, SBE = 126208;
    const int tid0 = opaque_tid(wv);
    LAS float* sL = (LAS float*)(lds + LF); LAS float* sg = (LAS float*)(lds + SG); LAS float* sb = (LAS float*)(lds + SBE);
    const bf16_t* proj = p->proj; const float* conv_w = p->conv_w; const float* gg = p->gg; const float* gbeta = p->gbeta; unsigned char* gimg = p->gimg; float* gcdec = p->gcdec;
    for (int uu = first; uu < NCHH; uu += stride) {
        int tid = tid0; OPAQUE_V(tid);
        const int wid = tid >> 6, lane = tid & 63, fr = lane & 15, q4 = lane >> 4;
        const int n = uu / (BATCH * 4), bh_ = uu % (BATCH * 4), h = bh_ & 3, b = bh_ >> 2;
        const int unit = bh_ * NCH + n;
        const size_t tok0 = (size_t)b * SEQ + (size_t)n * 64;
        unsigned char* img = gimg + (size_t)unit * IMG_CH;
        __syncthreads();
        if (wid == 0) { float gsum = gg[(tok0 + lane) * 4 + h]; for (int o = 1; o < 64; o <<= 1) { const float t2 = __shfl_up(gsum, o); if (lane >= o) gsum += t2; } sg[lane] = gsum; sb[lane] = gbeta[(tok0 + lane) * 4 + h]; }
        __syncthreads();
        const float glast = sg[63];
        unsigned xall[3][11];
#pragma unroll
        for (int w3 = 0; w3 < 3; ++w3) { const int cc = w3 * 512 + h * 128 + 2 * lane;
#pragma unroll
            for (int r = 0; r < 11; ++r) { const int tt = n * 64 + wid * 8 - 3 + r; xall[w3][r] = tt >= 0 ? *(const unsigned*)(proj + ((size_t)b * SEQ + tt) * DINP + 2048 + cc) : 0u; } }
#pragma unroll
        for (int which = 0; which < 3; ++which) {
            const int rb = wid, c0 = which * 512 + h * 128 + 2 * lane;
            float cw0[4], cw1[4];
#pragma unroll
            for (int kk = 0; kk < 4; ++kk) { cw0[kk] = conv_w[kk * 1536 + c0]; cw1[kk] = conv_w[kk * 1536 + c0 + 1]; }
            unsigned xv[11];
#pragma unroll
            for (int r = 0; r < 11; ++r) xv[r] = xall[which][r];
            float a0[8], a1[8], ss[8];
#pragma unroll
            for (int i8 = 0; i8 < 8; ++i8) { float y0 = 0.f, y1 = 0.f;
#pragma unroll
                for (int kk = 0; kk < 4; ++kk) { y0 += cw0[kk] * __uint_as_float(xv[i8 + kk] << 16); y1 += cw1[kk] * __uint_as_float(xv[i8 + kk] & 0xffff0000u); }
                a0[i8] = siluf(y0); a1[i8] = siluf(y1); ss[i8] = a0[i8] * a0[i8] + a1[i8] * a1[i8]; }
            if (which != 2) {
#pragma unroll
                for (int i8 = 0; i8 < 8; ++i8) ss[i8] = wave_sum(ss[i8]);
            }
#pragma unroll
            for (int i8 = 0; i8 < 8; ++i8) {
                const int i = rb * 8 + i8;
                const float gi = sg[i], bi = sb[i], eg = __expf(gi);
                if (which == 2) {
                    *(LAS bf16_t*)(lds + VBT + (2 * lane) * 144 + 2 * i) = f2bf(a0[i8] * bi); *(LAS bf16_t*)(lds + VBT + (2 * lane + 1) * 144 + 2 * i) = f2bf(a1[i8] * bi);
                } else {
                    const float sc = rsqrtf(ss[i8] + NORM_EPS) * (which == 0 ? 0.08838834764831845f : 1.0f);
                    const float n0 = a0[i8] * sc, n1 = a1[i8] * sc;
                    if (which == 0) { *(LAS unsigned*)(lds + QB + i * 272 + 4 * lane) = pack2(n0, n1); st_wt32(img + IMG_QD + i * 272 + permb(2 * lane), pack2(n0 * eg, n1 * eg)); }
                    else { *(LAS unsigned*)(lds + KB + i * 272 + 4 * lane) = pack2(n0, n1);
                        const float f1 = bi * eg, f2 = __expf(glast - gi);
                        *(LAS bf16_t*)(lds + KBT + (2 * lane) * 144 + 2 * i) = f2bf(n0 * f1); *(LAS bf16_t*)(lds + KBT + (2 * lane + 1) * 144 + 2 * i) = f2bf(n1 * f1);
                        *(LAS bf16_t*)(lds + KDT + (2 * lane) * 144 + permb(i)) = f2bf(n0 * f2); *(LAS bf16_t*)(lds + KDT + (2 * lane + 1) * 144 + permb(i)) = f2bf(n1 * f2); }
                }
            }
        }
        __syncthreads();
        {
            const int mat = wid >> 2, itile = wid & 3;
            LAS const unsigned char* abase = lds + (mat == 0 ? KB : QB) + (16 * itile + fr) * 272 + 16 * q4;
            bf16x8 af[4];
#pragma unroll
            for (int s4 = 0; s4 < 4; ++s4) af[s4] = *(LAS const bf16x8*)(abase + 64 * s4);
#pragma unroll
            for (int nt = 0; nt < 4; ++nt) {
                f32x4 acc = (f32x4){0.f, 0.f, 0.f, 0.f};
                if (nt <= itile) {
#pragma unroll
                    for (int s4 = 0; s4 < 4; ++s4) { const bf16x8 bfr = *(LAS const bf16x8*)(lds + KB + (16 * nt + fr) * 272 + 16 * q4 + 64 * s4);
                        acc = __builtin_amdgcn_mfma_f32_16x16x32_bf16(af[s4], bfr, acc, 0, 0, 0); }
                }
                const int j = 16 * nt + fr; const float gj = sg[j];
#pragma unroll
                for (int r = 0; r < 4; ++r) { const int i = 16 * itile + 4 * q4 + r; const float dec = __expf(sg[i] - gj);
                    if (mat == 0) sL[i * 68 + j] = i > j ? sb[i] * acc[r] * dec : 0.f;
                    else *(LAS bf16_t*)(lds + ATB + i * 144 + permb(j)) = f2bf(i >= j ? acc[r] * dec : 0.f); }
            }
        }
        __syncthreads();
        if (wid == 0) {
            float tc[64];
            TSolve<63>::run(tc, sL, lds + TB, lane);
        } else {
            for (int pc = tid - 64; pc < 1152 + 576; pc += NTHREADS - 64) {
                if (pc < 1152) { const u32x4 v4 = *(LAS const u32x4*)(lds + KDT + pc * 16); u32x2 a; a.x = v4.x; a.y = v4.y; u32x2 c; c.x = v4.z; c.y = v4.w; st_wt64(img + IMG_KDT + pc * 16, a); st_wt64(img + IMG_KDT + pc * 16 + 8, c); }
                else { const u32x4 v4 = *(LAS const u32x4*)(lds + ATB + (pc - 1152) * 16); u32x2 a; a.x = v4.x; a.y = v4.y; u32x2 c; c.x = v4.z; c.y = v4.w; st_wt64(img + IMG_AT + (pc - 1152) * 16, a); st_wt64(img + IMG_AT + (pc - 1152) * 16 + 8, c); }
            }
        }
        __syncthreads();
        {
            const int itile = wid & 3;
            bf16x8 tf[2];
#pragma unroll
            for (int s2 = 0; s2 < 2; ++s2) tf[s2] = *(LAS const bf16x8*)(lds + TB + (16 * itile + fr) * 144 + 16 * q4 + 64 * s2);
#pragma unroll
            for (int nt = 0; nt < 8; ++nt) {
                f32x4 acc = (f32x4){0.f, 0.f, 0.f, 0.f};
                if (wid < 4) {
#pragma unroll
                    for (int s2 = 0; s2 < 2; ++s2) { const bf16x8 bfr = *(LAS const bf16x8*)(lds + VBT + (16 * nt + fr) * 144 + 16 * q4 + 64 * s2);
                        acc = __builtin_amdgcn_mfma_f32_16x16x32_bf16(tf[s2], bfr, acc, 0, 0, 0); }
                    u32x2 w; w.x = pack2(acc[0], acc[1]); w.y = pack2(acc[2], acc[3]);
                    st_wt64(img + IMG_U + ((nt * 4 + itile) * 64 + lane) * 8, w);
                } else {
#pragma unroll
                    for (int s2 = 0; s2 < 2; ++s2) { const bf16x8 afr = *(LAS const bf16x8*)(lds + KBT + (16 * nt + fr) * 144 + 16 * q4 + 64 * s2);
                        acc = __builtin_amdgcn_mfma_f32_16x16x32_bf16(afr, tf[s2], acc, 0, 0, 0); }
                    u32x2 w; w.x = pack2(acc[0], acc[1]); w.y = pack2(acc[2], acc[3]);
                    st_wt64(img + IMG_W + (16 * itile + fr) * 272 + permb(16 * nt + 4 * q4), w);
                }
            }
        }
        if (tid == 0) st_wt32(gcdec + unit, __float_as_uint(__expf(glast)));
        if (PUBLISH) gdn_publish(p->gflag + unit, tid);
    }
}

constexpr int NCW = 2, NLT = NTHREADS - 64 * NCW;
constexpr int STG = 62464 + NCW * 2048;
#define LDF(ptr) (*(LAS const bf16x8*)(ptr))
#define MF16(a, b, c) __builtin_amdgcn_mfma_f32_16x16x32_bf16((a), (b), (c), 0, 0, 0)
__device__ __forceinline__ void scan_store_ot(bf16_t* op, const f32x4 (&ao)[4]) {
#pragma unroll
    for (int it = 0; it < 4; ++it) { u32x2 w; w.x = pack2(ao[it][0], ao[it][1]); w.y = pack2(ao[it][2], ao[it][3]); *(u32x2*)(op + (size_t)(16 * it) * DM) = w; }
}
__device__ __forceinline__ void scan_store_o(bf16_t* op, const f32x4 (&ao)[4], int q4) {
#pragma unroll
    for (int it = 0; it < 4; ++it)
#pragma unroll
        for (int r = 0; r < 4; ++r) op[(size_t)(16 * it + 4 * q4 + r) * DM] = f2bf(ao[it][r]);
}
__device__ __forceinline__ bf16x8 asfrag(const u32x4 v) { bf16x8 r; __builtin_memcpy(&r, &v, 16); return r; }
#define LDR(ptr) (*(LAS const u32x4*)(ptr))
template <bool WAITF>
__device__ __forceinline__ void scan_gdn(KPTR p, LAS unsigned char* lds, int b, int h, int qt, int wv) {
    const unsigned* gflag = p->gflag + (size_t)(b * 4 + h) * NCH;
    const int tid = opaque_tid(wv), wid = tid >> 6, lane = tid & 63, fr = lane & 15, q4 = lane >> 4;
    const unsigned char* gimg = p->gimg; const float* gcdec = p->gcdec + (size_t)(b * 4 + h) * NCH; bf16_t* out = p->hn;
    const bool loader = wid >= NCW;
    const int cw = wid, lt = tid - 64 * NCW;
    f32x4 S[8];
#pragma unroll
    for (int dt = 0; dt < 8; ++dt) S[dt] = (f32x4){0.f, 0.f, 0.f, 0.f};
    constexpr int NLG = NLT / 2;
    constexpr int NPC = 3904 + NCW * 128, NPR = (NPC + NLG - 1) / NLG;
    static_assert(NPR >= 16, "compute waves use R[0..7] and R[8..15] as their two operand batches");
    u32x4 R[NPR];
    float cdv = 0.f;
    constexpr int OUTB = 2 * STG, CDB = OUTB + 8192;
    const int grp = lt >= NLG ? 1 : 0, lg_ = lt - grp * NLG;
    const unsigned char* base = gimg + (size_t)(b * 4 + h) * NCH * IMG_CH;
#define GDN_PREFETCH(nn) do { int _lg = lg_; OPAQUE_V(_lg); const unsigned char* _src = base + (size_t)(nn) * IMG_CH; _Pragma("unroll") for (int _i = 0; _i < NPR; ++_i) { int _pc = _lg + NLG * _i; _pc = _pc < NPC ? _pc : NPC - 1; \
        const int _so = _pc < 3904 ? _pc * 16 : IMG_U + qt * (NCW * 2048) + (_pc - 3904) * 16; R[_i] = *(const u32x4*)(_src + _so); } cdv = ld_coherent(gcdec + (nn)); } while (0)
    int avail = 0;
    if (loader && grp < NCH) { if (WAITF) { gdn_wait8(gflag, 0, NCH, lane); avail = 8; } GDN_PREFETCH(grp); }
    float cd_next = 0.f;
    __syncthreads();
    auto load_step = [&](int nn) {
        if (nn < NCH && (nn & 1) == grp) {
            LAS unsigned char* buf = lds + (nn & 1) * STG;
#pragma unroll
            for (int i = 0; i < NPR; ++i) { int pc = lg_ + NLG * i; pc = pc < NPC ? pc : NPC - 1; *(LAS u32x4*)(buf + pc * 16) = R[i]; }
            if (lg_ == 0) *(LAS float*)(lds + CDB + (nn & 1) * 8) = cdv;
            if (nn + 2 < NCH) { if (WAITF && nn + 2 >= avail) { gdn_wait8(gflag, avail, NCH, lane); avail += 8; } GDN_PREFETCH(nn + 2); }
        }
    };
    auto flush = [&](int n) {
        for (int pc = lg_; pc < NCW * 256; pc += NLG) { const int cwi = pc >> 8, it = (pc >> 6) & 3, ln = pc & 63;
            const u32x2 w = *(LAS const u32x2*)(lds + OUTB + (n & 1) * 4096 + pc * 8);
            *(u32x2*)(out + ((size_t)b * SEQ + (size_t)n * 64 + 16 * it + (ln & 15)) * DM + 512 + h * 128 + 16 * (NCW * qt + cwi) + 4 * (ln >> 4)) = w; }
    };
    auto compute = [&](int n) {

            LAS const unsigned char* buf = lds + (n & 1) * STG;
            const float cd = *(LAS const float*)(lds + CDB + (n & 1) * 8);
            LAS const unsigned char* pw = buf + IMG_W + fr * 272 + 16 * q4;
            LAS const unsigned char* pq = buf + IMG_QD + fr * 272 + 16 * q4;
            LAS const unsigned char* pk = buf + IMG_KDT + fr * 144 + 16 * q4;
            LAS const unsigned char* pa = buf + IMG_AT + fr * 144 + 16 * q4;
            bf16x8 Sb[4];
#pragma unroll
            for (int s4 = 0; s4 < 4; ++s4) Sb[s4] = pack8(S[2 * s4], S[2 * s4 + 1]);
            f32x4 ao[4], av[4];
            u32x2 uu[4];
#pragma unroll
            for (int it = 0; it < 4; ++it) uu[it] = *(LAS const u32x2*)(buf + IMG_U + ((cw * 4 + it) * 64 + lane) * 8);
            u32x4* RA = R; u32x4* RB = R + 8;
#define GDN_LD_WQ(RR, it_) do { _Pragma("unroll") for (int s4 = 0; s4 < 4; ++s4) { RR[s4] = LDR(pw + (16 * (it_)) * 272 + 64 * s4); RR[4 + s4] = LDR(pq + (16 * (it_)) * 272 + 64 * s4); } } while (0)
#define GDN_LD_K(RR, dh_) do { _Pragma("unroll") for (int d2 = 0; d2 < 4; ++d2) _Pragma("unroll") for (int s2 = 0; s2 < 2; ++s2) RR[d2 * 2 + s2] = LDR(pk + (16 * (4 * (dh_) + d2)) * 144 + 64 * s2); } while (0)
#define GDN_MM_WQ(RR, it_) do { av[it_] = (f32x4){0.f, 0.f, 0.f, 0.f}; ao[it_] = (f32x4){0.f, 0.f, 0.f, 0.f}; \
        _Pragma("unroll") for (int s4 = 0; s4 < 4; ++s4) { av[it_] = MF16(asfrag(RR[s4]), Sb[s4], av[it_]); ao[it_] = MF16(Sb[s4], asfrag(RR[4 + s4]), ao[it_]); } } while (0)
#define GDN_MM_K(RR, dh_) do { _Pragma("unroll") for (int d2 = 0; d2 < 4; ++d2) { S[4 * (dh_) + d2] = S[4 * (dh_) + d2] * cd; \
        _Pragma("unroll") for (int s2 = 0; s2 < 2; ++s2) S[4 * (dh_) + d2] = MF16(asfrag(RR[d2 * 2 + s2]), Vb[s2], S[4 * (dh_) + d2]); } } while (0)
            GDN_LD_WQ(RA, 0); SCHED_FENCE();
            GDN_LD_WQ(RB, 1); SCHED_FENCE(); GDN_MM_WQ(RA, 0); SCHED_FENCE();
            GDN_LD_WQ(RA, 2); SCHED_FENCE(); GDN_MM_WQ(RB, 1); SCHED_FENCE();
            GDN_LD_WQ(RB, 3); SCHED_FENCE(); GDN_MM_WQ(RA, 2); SCHED_FENCE();
            GDN_LD_K(RA, 0); SCHED_FENCE(); GDN_MM_WQ(RB, 3); SCHED_FENCE();
#pragma unroll
            for (int it = 0; it < 4; ++it) {
                av[it][0] = __uint_as_float(uu[it].x << 16) - av[it][0]; av[it][1] = __uint_as_float(uu[it].x & 0xffff0000u) - av[it][1];
                av[it][2] = __uint_as_float(uu[it].y << 16) - av[it][2]; av[it][3] = __uint_as_float(uu[it].y & 0xffff0000u) - av[it][3]; }
            bf16x8 Vb[2];
#pragma unroll
            for (int s2 = 0; s2 < 2; ++s2) Vb[s2] = pack8(av[2 * s2], av[2 * s2 + 1]);
            GDN_LD_K(RB, 1); SCHED_FENCE(); GDN_MM_K(RA, 0); SCHED_FENCE();
#pragma unroll
            for (int it = 0; it < 4; ++it)
#pragma unroll
                for (int s2 = 0; s2 < 2; ++s2) R[it * 2 + s2] = LDR(pa + (16 * it) * 144 + 64 * s2);
            SCHED_FENCE(); GDN_MM_K(RB, 1); SCHED_FENCE();
#pragma unroll
            for (int it = 0; it < 4; ++it)
#pragma unroll
                for (int s2 = 0; s2 < 2; ++s2) ao[it] = MF16(Vb[s2], asfrag(R[it * 2 + s2]), ao[it]);
#undef GDN_LD_WQ
#undef GDN_LD_K
#undef GDN_MM_WQ
#undef GDN_MM_K
#pragma unroll
            for (int it = 0; it < 4; ++it) { u32x2 w; w.x = pack2(ao[it][0], ao[it][1]); w.y = pack2(ao[it][2], ao[it][3]); *(LAS u32x2*)(lds + OUTB + (n & 1) * 4096 + ((cw * 4 + it) * 64 + lane) * 8) = w; }
            };
    for (int n = -1; n < NCH; ++n) {
        if (loader) { load_step(n + 1); if (n >= 1 && (n & 1) == grp) flush(n - 1); } else if (n >= 0) compute(n);
        __syncthreads();
    }
    if (loader && grp == 0) flush(NCH - 1);
#undef GDN_PREFETCH
}
#ifndef CG_FORCE
#define CG_FORCE 0
#endif
constexpr int CG = CG_FORCE ? CG_FORCE : (NCH >= 256 ? 8 : 4), NG = NCH / CG;
template <int MODE>
__device__ __forceinline__ void scan_ret(KPTR p, LAS unsigned char* lds, int b, int h, int qt, int g, int wv) {
    const int n0 = g * CG;
    constexpr int R_Q = 0, R_K = 17408, R_KDT = 34816, R_VT = 53248;
    constexpr int RAT_OFF = 2 * STG;
    const int tid = opaque_tid(wv), wid = tid >> 6, lane = tid & 63, fr = lane & 15, q4 = lane >> 4;
    const bf16_t* proj = p->proj; bf16_t* out = p->hn; float* Lb = p->retL;
    const bool loader = wid >= NCW;
    const int cw = wid, lt = tid - 64 * NCW;
    const float lg = log1pf(-exp2f(-5.0f - (float)h));
    f32x4 S[8];
#pragma unroll
    for (int dt = 0; dt < 8; ++dt) S[dt] = (f32x4){0.f, 0.f, 0.f, 0.f};
    const float rcd = __expf(lg * 64.f), g1 = __expf(lg);
    if (MODE == 1 && !loader) {
        const float gdec = __expf(lg * (float)(64 * CG)); float wgt = 1.f;
        for (int gp = g - 1; gp >= 0; --gp) {
            const f32x4* lp = (const f32x4*)Lb + ((((size_t)(b * 4 + h) * NG + gp) * (8 / NCW) + qt) * NCW + cw) * 8 * 64 + lane;
#pragma unroll
            for (int dt = 0; dt < 8; ++dt) S[dt] = S[dt] + lp[dt * 64] * wgt;
            wgt *= gdec;
        }
    }
    float gi[4];
#pragma unroll
    for (int t4 = 0; t4 < 4; ++t4) gi[t4] = __expf(lg * (float)(16 * t4 + fr));
    constexpr int NLG = NLT / 2, NQG = (1024 + NLG - 1) / NLG, KB_N = 256 - NLG;
    static_assert(NLG >= 128 && NLG <= 256 && KB_N + 32 * NCW <= NLG, "task slots");
    u32x4 R[NQG + 8 < 16 ? 16 : NQG + 8];
    const int grp = lt >= NLG ? 1 : 0, lg_ = lt - grp * NLG;
#define RET_PREFETCH(nn) do { int _l = lg_; OPAQUE_V(_l); const bf16_t* _pq = proj + ((size_t)b * SEQ + (size_t)(n0 + (nn)) * 64) * DINP + h * 128; \
        _Pragma("unroll") for (int _i = 0; _i < NQG; ++_i) { int _pc = _l + NLG * _i; _pc = _pc < 1024 ? _pc : 1023; const int _row = _pc >> 4, _c = _pc & 15; R[_i] = *(const u32x4*)(_pq + (size_t)_row * DINP + _c * 8); } \
        _Pragma("unroll") for (int _r = 0; _r < 4; ++_r) R[NQG + _r] = *(const u32x4*)(_pq + (size_t)(4 * (_l >> 4) + _r) * DINP + 512 + (_l & 15) * 8); \
        { const bool _isk = _l < KB_N; int _v = _l - KB_N; _v = _v < 0 ? 0 : (_v < 32 * NCW ? _v : 32 * NCW - 1); const int _t = NLG + (_isk ? _l : 0); \
          const int _r0 = _isk ? 4 * (_t >> 4) : 4 * (_v >> 2), _co = _isk ? 512 + (_t & 15) * 8 : 1024 + 16 * NCW * qt + (_v & 3) * 8; \
          _Pragma("unroll") for (int _r = 0; _r < 4; ++_r) R[NQG + 4 + _r] = *(const u32x4*)(_pq + (size_t)(_r0 + _r) * DINP + _co); } } while (0)
#define RET_WRITE_K(RB_, t_) do { const int ig = (t_) >> 4, ck = (t_) & 15; float sc[4]; \
        _Pragma("unroll") for (int r = 0; r < 4; ++r) { sc[r] = 0.08838834764831845f * __expf(lg * (float)(63 - 4 * ig - r)); \
            u32x2 a; a.x = R[(RB_) + r].x; a.y = R[(RB_) + r].y; u32x2 c2; c2.x = R[(RB_) + r].z; c2.y = R[(RB_) + r].w; \
            *(LAS u32x2*)(buf + R_K + (4 * ig + r) * 272 + permb(8 * ck)) = a; *(LAS u32x2*)(buf + R_K + (4 * ig + r) * 272 + permb(8 * ck + 4)) = c2; } \
        _Pragma("unroll") for (int e = 0; e < 8; ++e) { const int wsel = e >> 1; float x[4]; \
            _Pragma("unroll") for (int r = 0; r < 4; ++r) x[r] = ((e & 1) ? __uint_as_float(R[(RB_) + r][wsel] & 0xffff0000u) : __uint_as_float(R[(RB_) + r][wsel] << 16)) * sc[r]; \
            u32x2 o; o.x = pack2(x[0], x[1]); o.y = pack2(x[2], x[3]); *(LAS u32x2*)(buf + R_KDT + (8 * ck + e) * 144 + permb(4 * ig)) = o; } } while (0)
    if (loader && grp < CG) RET_PREFETCH(grp);
    __syncthreads();
    auto load_step = [&](int nn) {
        if (nn < CG && (nn & 1) == grp) {
            LAS unsigned char* buf = lds + (nn & 1) * STG; int l2 = lg_; OPAQUE_V(l2);
#pragma unroll
            for (int i = 0; i < NQG; ++i) { int pc = l2 + NLG * i; pc = pc < 1024 ? pc : 1023; const int row = pc >> 4, c = pc & 15;
                u32x2 a; a.x = R[i].x; a.y = R[i].y; u32x2 c2; c2.x = R[i].z; c2.y = R[i].w;
                *(LAS u32x2*)(buf + R_Q + row * 272 + permb(8 * c)) = a; *(LAS u32x2*)(buf + R_Q + row * 272 + permb(8 * c + 4)) = c2; }
            RET_WRITE_K(NQG, l2);
            if (l2 < KB_N) { RET_WRITE_K(NQG + 4, NLG + l2); }
            else if (l2 < KB_N + 32 * NCW) { const int v = l2 - KB_N, igv = v >> 2, cv = v & 3;
#pragma unroll
                for (int e = 0; e < 8; ++e) { const int wsel = e >> 1, sh = 16 * (e & 1);
                    u32x2 o; o.x = ((R[NQG + 4][wsel] >> sh) & 0xffffu) | (((R[NQG + 5][wsel] >> sh) & 0xffffu) << 16); o.y = ((R[NQG + 6][wsel] >> sh) & 0xffffu) | (((R[NQG + 7][wsel] >> sh) & 0xffffu) << 16);
                    *(LAS u32x2*)(buf + R_VT + (8 * cv + e) * 144 + permb(4 * igv)) = o; } }
            if (nn + 2 < CG) RET_PREFETCH(nn + 2);
        }
    };
    auto scores = [&](int n) {
        LAS const unsigned char* buf = lds + (n & 1) * STG;
        const int lw = wid - NCW;
#pragma unroll
        for (int rep = 0; rep < 2; ++rep) {
            const int tl = lw + (NTHREADS / 64 - NCW) * rep;
            if (tl < 12) {
                int it, jt;
                if (tl < 1) { it = 0; jt = 0; } else if (tl < 3) { it = 1; jt = tl - 1; } else if (tl < 6) { it = 2; jt = tl - 3; } else if (tl < 10) { it = 3; jt = tl - 6; } else if (tl == 10) { it = 0; jt = 1; } else { it = 2; jt = 3; }
                f32x4 acc = (f32x4){0.f, 0.f, 0.f, 0.f};
                if (tl < 10) {
                    bf16x8 kf[4], qf[4];
#pragma unroll
                    for (int s4 = 0; s4 < 4; ++s4) { kf[s4] = LDF(buf + R_K + (16 * jt + fr) * 272 + 64 * s4 + 16 * q4); qf[s4] = LDF(buf + R_Q + (16 * it + fr) * 272 + 64 * s4 + 16 * q4); }
#pragma unroll
                    for (int s4 = 0; s4 < 4; ++s4) acc = MF16(kf[s4], qf[s4], acc);
                    const float gi_ = __expf(lg * (float)(16 * it + fr));
#pragma unroll
                    for (int r = 0; r < 4; ++r) { const int j = 16 * jt + 4 * q4 + r, i = 16 * it + fr;
                        acc[r] = i >= j ? acc[r] * gi_ * 0.08838834764831845f * __expf(-lg * (float)j) : 0.f; }
                }
                u32x2 w; w.x = pack2(acc[0], acc[1]); w.y = pack2(acc[2], acc[3]);
                *(LAS u32x2*)(lds + RAT_OFF + (16 * it + fr) * 144 + permb(16 * jt + 4 * q4)) = w;
            }
        }
    };
    f32x4 ot[4];
    bf16x8 Vf[2];
    auto computeA = [&](int n) {
        LAS const unsigned char* buf = lds + (n & 1) * STG;
        LAS const unsigned char* pq = buf + R_Q + fr * 272 + 16 * q4;
        LAS const unsigned char* pk = buf + R_KDT + fr * 144 + 16 * q4;
        bf16x8 Sb[4];
#pragma unroll
        for (int s4 = 0; s4 < 4; ++s4) Sb[s4] = pack8(S[2 * s4], S[2 * s4 + 1]);
#pragma unroll
        for (int s2 = 0; s2 < 2; ++s2) Vf[s2] = LDF(buf + R_VT + (16 * cw + fr) * 144 + 64 * s2 + 16 * q4);
        u32x4* RA = R; u32x4* RB = R + 8;
#define RET_LD_Q(RR, hh_) do { _Pragma("unroll") for (int i2 = 0; i2 < 2; ++i2) _Pragma("unroll") for (int s4 = 0; s4 < 4; ++s4) RR[i2 * 4 + s4] = LDR(pq + (16 * (2 * (hh_) + i2)) * 272 + 64 * s4); } while (0)
#define RET_LD_K(RR, dh_) do { _Pragma("unroll") for (int d2 = 0; d2 < 4; ++d2) _Pragma("unroll") for (int s2 = 0; s2 < 2; ++s2) RR[d2 * 2 + s2] = LDR(pk + (16 * (4 * (dh_) + d2)) * 144 + 64 * s2); } while (0)
#define RET_MM_Q(RR, hh_) do { _Pragma("unroll") for (int i2 = 0; i2 < 2; ++i2) { const int it = 2 * (hh_) + i2; ot[it] = (f32x4){0.f, 0.f, 0.f, 0.f}; \
        _Pragma("unroll") for (int s4 = 0; s4 < 4; ++s4) ot[it] = MF16(Sb[s4], asfrag(RR[i2 * 4 + s4]), ot[it]); \
        const float rd = gi[it] * g1; _Pragma("unroll") for (int r = 0; r < 4; ++r) ot[it][r] *= rd; } } while (0)
#define RET_MM_K(RR, dh_) do { _Pragma("unroll") for (int d2 = 0; d2 < 4; ++d2) { S[4 * (dh_) + d2] = S[4 * (dh_) + d2] * rcd; \
        _Pragma("unroll") for (int s2 = 0; s2 < 2; ++s2) S[4 * (dh_) + d2] = MF16(asfrag(RR[d2 * 2 + s2]), Vf[s2], S[4 * (dh_) + d2]); } } while (0)
        RET_LD_K(RA, 0); SCHED_FENCE();
        RET_LD_K(RB, 1); SCHED_FENCE(); RET_MM_K(RA, 0); SCHED_FENCE();
        if (MODE == 1) {
            RET_LD_Q(RA, 0); SCHED_FENCE(); RET_MM_K(RB, 1); SCHED_FENCE();
            RET_LD_Q(RB, 1); SCHED_FENCE(); RET_MM_Q(RA, 0); SCHED_FENCE();
            RET_MM_Q(RB, 1);
        } else { RET_MM_K(RB, 1); }
#undef RET_LD_Q
#undef RET_LD_K
#undef RET_MM_Q
#undef RET_MM_K
    };
    auto computeB = [&](int n) {
        LAS const unsigned char* pa = lds + RAT_OFF + fr * 144 + 16 * q4;
        R[0] = LDR(pa); R[1] = LDR(pa + 16 * 144); R[2] = LDR(pa + 32 * 144); R[3] = LDR(pa + 32 * 144 + 64); R[4] = LDR(pa + 48 * 144); R[5] = LDR(pa + 48 * 144 + 64);
        SCHED_FENCE();
        ot[0] = MF16(Vf[0], asfrag(R[0]), ot[0]); ot[1] = MF16(Vf[0], asfrag(R[1]), ot[1]);
        ot[2] = MF16(Vf[0], asfrag(R[2]), ot[2]); ot[2] = MF16(Vf[1], asfrag(R[3]), ot[2]);
        ot[3] = MF16(Vf[0], asfrag(R[4]), ot[3]); ot[3] = MF16(Vf[1], asfrag(R[5]), ot[3]);
        scan_store_ot(out + ((size_t)b * SEQ + (size_t)(n0 + n) * 64 + fr) * DM + h * 128 + 16 * (NCW * qt + cw) + 4 * q4, ot);
    };
    for (int n = -1; n < CG; ++n) {
        if (loader) { if (MODE == 1 && n >= 0) scores(n); load_step(n + 1); } else if (n >= 0) computeA(n);
        __syncthreads();
        if (MODE == 1) {
            if (!loader && n >= 0) computeB(n);
            __syncthreads();
        }
    }
    if (MODE == 0 && !loader) {
        f32x4* lp = (f32x4*)Lb + ((((size_t)(b * 4 + h) * NG + g) * (8 / NCW) + qt) * NCW + cw) * 8 * 64 + lane;
#pragma unroll
        for (int dt = 0; dt < 8; ++dt) lp[dt * 64] = S[dt];
    }
#undef RET_PREFETCH
#undef RET_WRITE_K
}
template <int MODE>
__device__ __forceinline__ void scan_ret_full(KPTR p, LAS unsigned char* lds, int b, int h, int g, int wv) {
    constexpr int F_Q = 0, F_K = 17408, F_KDT = 34816, F_VT = 53248, F_RAT = 71680;
    const int n0 = g * CG;
    const int tid = opaque_tid(wv), wid = tid >> 6, lane = tid & 63, fr = lane & 15, q4 = lane >> 4, cw = wid;
    const bf16_t* proj = p->proj; bf16_t* out = p->hn; float* Lb = p->retL;
    const float lg = log1pf(-exp2f(-5.0f - (float)h));
    const float rcd = __expf(lg * 64.f), g1 = __expf(lg);
    f32x4 S[8];
#pragma unroll
    for (int dt = 0; dt < 8; ++dt) S[dt] = (f32x4){0.f, 0.f, 0.f, 0.f};
    if (MODE == 1) {
        const float gdec = __expf(lg * (float)(64 * CG)); float wgt = 1.f;
        for (int gp = g - 1; gp >= 0; --gp) {
            const f32x4* lp = (const f32x4*)Lb + (((size_t)(b * 4 + h) * NG + gp) * 8 + cw) * 8 * 64 + lane;
#pragma unroll
            for (int dt = 0; dt < 8; ++dt) S[dt] = S[dt] + lp[dt * 64] * wgt;
            wgt *= gdec;
        }
    }
    float gi[4];
#pragma unroll
    for (int t4 = 0; t4 < 4; ++t4) gi[t4] = __expf(lg * (float)(16 * t4 + fr));
    u32x4 rq[2], rkv[4];
#define RF_PREFETCH(nn) do { int _l = tid; OPAQUE_V(_l); const bf16_t* _pq = proj + ((size_t)b * SEQ + (size_t)(n0 + (nn)) * 64) * DINP + h * 128; \
        _Pragma("unroll") for (int _i = 0; _i < 2; ++_i) { const int _pc = _l + NTHREADS * _i; rq[_i] = *(const u32x4*)(_pq + (size_t)(_pc >> 4) * DINP + (_pc & 15) * 8); } \
        { const bool _isk = _l < 256; const int _t = _isk ? _l : _l - 256; const int _r0 = 4 * (_t >> 4), _co = (_isk ? 512 : 1024) + (_t & 15) * 8; \
          _Pragma("unroll") for (int _r = 0; _r < 4; ++_r) rkv[_r] = *(const u32x4*)(_pq + (size_t)(_r0 + _r) * DINP + _co); } } while (0)
    auto write_stage = [&]() {
        int l2 = tid; OPAQUE_V(l2);
#pragma unroll
        for (int i = 0; i < 2; ++i) { const int pc = l2 + NTHREADS * i, row = pc >> 4, c = pc & 15;
            u32x2 a; a.x = rq[i].x; a.y = rq[i].y; u32x2 c2; c2.x = rq[i].z; c2.y = rq[i].w;
            *(LAS u32x2*)(lds + F_Q + row * 272 + permb(8 * c)) = a; *(LAS u32x2*)(lds + F_Q + row * 272 + permb(8 * c + 4)) = c2; }
        if (l2 < 256) { const int ig = l2 >> 4, ck = l2 & 15; float sc[4];
#pragma unroll
            for (int r = 0; r < 4; ++r) { sc[r] = 0.08838834764831845f * __expf(lg * (float)(63 - 4 * ig - r));
                u32x2 a; a.x = rkv[r].x; a.y = rkv[r].y; u32x2 c2; c2.x = rkv[r].z; c2.y = rkv[r].w;
                *(LAS u32x2*)(lds + F_K + (4 * ig + r) * 272 + permb(8 * ck)) = a; *(LAS u32x2*)(lds + F_K + (4 * ig + r) * 272 + permb(8 * ck + 4)) = c2; }
#pragma unroll
            for (int e = 0; e < 8; ++e) { const int wsel = e >> 1; float x[4];
#pragma unroll
                for (int r = 0; r < 4; ++r) x[r] = ((e & 1) ? __uint_as_float(rkv[r][wsel] & 0xffff0000u) : __uint_as_float(rkv[r][wsel] << 16)) * sc[r];
                u32x2 o; o.x = pack2(x[0], x[1]); o.y = pack2(x[2], x[3]); *(LAS u32x2*)(lds + F_KDT + (8 * ck + e) * 144 + permb(4 * ig)) = o; }
        } else { const int v = l2 - 256, igv = v >> 4, cv = v & 15;
#pragma unroll
            for (int e = 0; e < 8; ++e) { const int wsel = e >> 1, sh = 16 * (e & 1);
                u32x2 o; o.x = ((rkv[0][wsel] >> sh) & 0xffffu) | (((rkv[1][wsel] >> sh) & 0xffffu) << 16); o.y = ((rkv[2][wsel] >> sh) & 0xffffu) | (((rkv[3][wsel] >> sh) & 0xffffu) << 16);
                *(LAS u32x2*)(lds + F_VT + (8 * cv + e) * 144 + permb(4 * igv)) = o; } }
    };
    auto scores = [&]() {
#pragma unroll
        for (int rep = 0; rep < 2; ++rep) {
            const int tl = wid + 8 * rep;
            if (tl < 12) {
                int it, jt;
                if (tl < 1) { it = 0; jt = 0; } else if (tl < 3) { it = 1; jt = tl - 1; } else if (tl < 6) { it = 2; jt = tl - 3; } else if (tl < 10) { it = 3; jt = tl - 6; } else if (tl == 10) { it = 0; jt = 1; } else { it = 2; jt = 3; }
                f32x4 acc = (f32x4){0.f, 0.f, 0.f, 0.f};
                if (tl < 10) {
                    bf16x8 kf[4], qf[4];
#pragma unroll
                    for (int s4 = 0; s4 < 4; ++s4) { kf[s4] = LDF(lds + F_K + (16 * jt + fr) * 272 + 64 * s4 + 16 * q4); qf[s4] = LDF(lds + F_Q + (16 * it + fr) * 272 + 64 * s4 + 16 * q4); }
#pragma unroll
                    for (int s4 = 0; s4 < 4; ++s4) acc = MF16(kf[s4], qf[s4], acc);
                    const float gi_ = __expf(lg * (float)(16 * it + fr));
#pragma unroll
                    for (int r = 0; r < 4; ++r) { const int j = 16 * jt + 4 * q4 + r, i = 16 * it + fr;
                        acc[r] = i >= j ? acc[r] * gi_ * 0.08838834764831845f * __expf(-lg * (float)j) : 0.f; }
                }
                u32x2 w; w.x = pack2(acc[0], acc[1]); w.y = pack2(acc[2], acc[3]);
                *(LAS u32x2*)(lds + F_RAT + (16 * it + fr) * 144 + permb(16 * jt + 4 * q4)) = w;
            }
        }
    };
    RF_PREFETCH(0);
    __syncthreads();
    write_stage();
    if (CG > 1) RF_PREFETCH(1);
    __syncthreads();
    for (int n = 0; n < CG; ++n) {
        if (MODE == 1) { scores(); __syncthreads(); }
        {
            LAS const unsigned char* pq = lds + F_Q + fr * 272 + 16 * q4;
            LAS const unsigned char* pk = lds + F_KDT + fr * 144 + 16 * q4;
            bf16x8 Sb[4];
#pragma unroll
            for (int s4 = 0; s4 < 4; ++s4) Sb[s4] = pack8(S[2 * s4], S[2 * s4 + 1]);
            bf16x8 Vf[2];
#pragma unroll
            for (int s2 = 0; s2 < 2; ++s2) Vf[s2] = LDF(lds + F_VT + (16 * cw + fr) * 144 + 64 * s2 + 16 * q4);
            u32x4 RA[8], RB[8];
            f32x4 ot[4];
#define RF_LD_Q(RR, hh_) do { _Pragma("unroll") for (int i2 = 0; i2 < 2; ++i2) _Pragma("unroll") for (int s4 = 0; s4 < 4; ++s4) RR[i2 * 4 + s4] = LDR(pq + (16 * (2 * (hh_) + i2)) * 272 + 64 * s4); } while (0)
#define RF_LD_K(RR, dh_) do { _Pragma("unroll") for (int d2 = 0; d2 < 4; ++d2) _Pragma("unroll") for (int s2 = 0; s2 < 2; ++s2) RR[d2 * 2 + s2] = LDR(pk + (16 * (4 * (dh_) + d2)) * 144 + 64 * s2); } while (0)
#define RF_MM_Q(RR, hh_) do { _Pragma("unroll") for (int i2 = 0; i2 < 2; ++i2) { const int it = 2 * (hh_) + i2; ot[it] = (f32x4){0.f, 0.f, 0.f, 0.f}; \
        _Pragma("unroll") for (int s4 = 0; s4 < 4; ++s4) ot[it] = MF16(Sb[s4], asfrag(RR[i2 * 4 + s4]), ot[it]); \
        const float rd = gi[it] * g1; _Pragma("unroll") for (int r = 0; r < 4; ++r) ot[it][r] *= rd; } } while (0)
#define RF_MM_K(RR, dh_) do { _Pragma("unroll") for (int d2 = 0; d2 < 4; ++d2) { S[4 * (dh_) + d2] = S[4 * (dh_) + d2] * rcd; \
        _Pragma("unroll") for (int s2 = 0; s2 < 2; ++s2) S[4 * (dh_) + d2] = MF16(asfrag(RR[d2 * 2 + s2]), Vf[s2], S[4 * (dh_) + d2]); } } while (0)
            RF_LD_K(RA, 0); SCHED_FENCE();
            RF_LD_K(RB, 1); SCHED_FENCE(); RF_MM_K(RA, 0); SCHED_FENCE();
            if (MODE == 1) {
                RF_LD_Q(RA, 0); SCHED_FENCE(); RF_MM_K(RB, 1); SCHED_FENCE();
                RF_LD_Q(RB, 1); SCHED_FENCE(); RF_MM_Q(RA, 0); SCHED_FENCE();
                RF_MM_Q(RB, 1);
                LAS const unsigned char* pa = lds + F_RAT + fr * 144 + 16 * q4;
                RA[0] = LDR(pa); RA[1] = LDR(pa + 16 * 144); RA[2] = LDR(pa + 32 * 144); RA[3] = LDR(pa + 32 * 144 + 64); RA[4] = LDR(pa + 48 * 144); RA[5] = LDR(pa + 48 * 144 + 64);
                SCHED_FENCE();
                ot[0] = MF16(Vf[0], asfrag(RA[0]), ot[0]); ot[1] = MF16(Vf[0], asfrag(RA[1]), ot[1]);
                ot[2] = MF16(Vf[0], asfrag(RA[2]), ot[2]); ot[2] = MF16(Vf[1], asfrag(RA[3]), ot[2]);
                ot[3] = MF16(Vf[0], asfrag(RA[4]), ot[3]); ot[3] = MF16(Vf[1], asfrag(RA[5]), ot[3]);
                scan_store_ot(out + ((size_t)b * SEQ + (size_t)(n0 + n) * 64 + fr) * DM + h * 128 + 16 * cw + 4 * q4, ot);
            } else { RF_MM_K(RB, 1); }
#undef RF_LD_Q
#undef RF_LD_K
#undef RF_MM_Q
#undef RF_MM_K
        }
        __syncthreads();
        if (n + 1 < CG) { write_stage(); if (n + 2 < CG) RF_PREFETCH(n + 2); }
        __syncthreads();
    }
    if (MODE == 0) {
        f32x4* lp = (f32x4*)Lb + (((size_t)(b * 4 + h) * NG + g) * 8 + cw) * 8 * 64 + lane;
#pragma unroll
        for (int dt = 0; dt < 8; ++dt) lp[dt * 64] = S[dt];
    }
#undef RF_PREFETCH
}

__device__ __forceinline__ void phase_ret_local(KPTR p, LAS unsigned char* lds, int bid, int nb, int wv) {
    constexpr int NIT0 = BATCH * 4 * NG;
    for (int it = bid; it < NIT0; it += nb) {
        const int g = it % NG, bh = it / NG;
        __syncthreads();
        scan_ret_full<0>(p, lds, bh >> 2, bh & 3, g, wv);
    }
}
template <bool OVERLAP>
__device__ __forceinline__ void phase_scan(KPTR p, LAS unsigned char* lds, int bid, int nb, int wv) {
    constexpr int QN = 8 / NCW;
    constexpr int G = BATCH * 4;
    constexpr int NUG = ((G + 7) / 8) * 8 * QN;
    for (int unit = bid; unit < NUG; unit += nb) {
        const int xcd = unit & 7, t = unit >> 3, qt = t % QN, bh = (t / QN) * 8 + xcd;
        if (bh >= G) continue;
        __syncthreads();
        for (int rp = 0; rp < RPT_SG; ++rp) scan_gdn<OVERLAP>(p, lds, bh >> 2, bh & 3, qt, wv);
    }
    if (OVERLAP && bid >= NUG) { __syncthreads(); phase_gdn_pre<true>(p, lds, bid - NUG, nb - NUG, wv); }
    constexpr int NIT1 = G * NG;
    const int first = nb > NUG ? NUG : 0, step = nb > NUG ? nb - NUG : nb;
    if (bid >= first) {
        for (int it = bid - first; it < NIT1; it += step) {
            const int g = it % NG, bh = it / NG;
            __syncthreads();
            for (int rp = 0; rp < RPT_SR; ++rp) scan_ret_full<1>(p, lds, bh >> 2, bh & 3, g, wv);
        }
    }
}

__device__ __forceinline__ void phase_gatednorm(KPTR p, int bid, int nb, int wv) {
    const int tid = opaque_tid(wv), wid = tid >> 6, lane = tid & 63;
    const int hh = lane >> 3, c0 = lane * 16;
    const float* nwp = (hh < 4 ? p->ret_norm + hh * 128 : p->gdn_norm + (hh - 4) * 128) + (lane & 7) * 16;
    float nw[16];
#pragma unroll
    for (int i = 0; i < 4; ++i) { const f32x4 t4 = *(const f32x4*)(nwp + 4 * i); nw[4 * i] = t4[0]; nw[4 * i + 1] = t4[1]; nw[4 * i + 2] = t4[2]; nw[4 * i + 3] = t4[3]; }
    const int gcol = (hh < 4 ? 1536 + hh * 128 : 3584 + (hh - 4) * 128) + (lane & 7) * 16;
    for (int t = bid * 8 + wid; t < NTOK; t += nb * 8) {
        bf16_t* o = p->hn + (size_t)t * DM + c0;
        const u32x4 o0 = *(const u32x4*)o, o1 = *(const u32x4*)(o + 8);
        const bf16_t* gp = p->proj + (size_t)t * DINP + gcol;
        const u32x4 g0 = *(const u32x4*)gp, g1 = *(const u32x4*)(gp + 8);
        float a[16], g[16];
#pragma unroll
        for (int i = 0; i < 4; ++i) { a[2 * i] = __uint_as_float(o0[i] << 16); a[2 * i + 1] = __uint_as_float(o0[i] & 0xffff0000u); a[8 + 2 * i] = __uint_as_float(o1[i] << 16); a[8 + 2 * i + 1] = __uint_as_float(o1[i] & 0xffff0000u);
            g[2 * i] = __uint_as_float(g0[i] << 16); g[2 * i + 1] = __uint_as_float(g0[i] & 0xffff0000u); g[8 + 2 * i] = __uint_as_float(g1[i] << 16); g[8 + 2 * i + 1] = __uint_as_float(g1[i] & 0xffff0000u); }
        float ss = 0.f;
#pragma unroll
        for (int i = 0; i < 16; ++i) ss += a[i] * a[i];
        ss += __shfl_xor(ss, 1); ss += __shfl_xor(ss, 2); ss += __shfl_xor(ss, 4);
        const float rs = rsqrtf(ss * (1.0f / 128.f) + NORM_EPS);
        u32x4 w0, w1;
#pragma unroll
        for (int i = 0; i < 4; ++i) { w0[i] = pack2(a[2 * i] * rs * nw[2 * i] * siluf(g[2 * i]), a[2 * i + 1] * rs * nw[2 * i + 1] * siluf(g[2 * i + 1]));
            w1[i] = pack2(a[8 + 2 * i] * rs * nw[8 + 2 * i] * siluf(g[8 + 2 * i]), a[8 + 2 * i + 1] * rs * nw[8 + 2 * i + 1] * siluf(g[8 + 2 * i + 1])); }
        *(u32x4*)o = w0; *(u32x4*)(o + 8) = w1;
    }
}

__device__ __forceinline__ void phase_kmean(KPTR p, LAS unsigned char* lds, int bid, int nb, int wv) {
    const int tid = opaque_tid(wv);
    LAS float* red = (LAS float*)lds;
    const int rg = tid >> 4, c = tid & 15;
    for (int unit = bid; unit < NIT; unit += nb) {
        const int blk = unit % NBLK, h = (unit / NBLK) & 7, b = unit / (NBLK * 8);
        const bf16_t* kp = p->qkv + ((size_t)b * SEQ + (size_t)blk * 256 + rg) * 3072 + 1024 + h * 128 + c * 8;
        float a[8];
#pragma unroll
        for (int j = 0; j < 8; ++j) a[j] = 0.f;
#pragma unroll
        for (int i = 0; i < 8; ++i) { const u32x4 w = *(const u32x4*)(kp + (size_t)(32 * i) * 3072);
            a[0] += __uint_as_float(w.x << 16); a[1] += __uint_as_float(w.x & 0xffff0000u); a[2] += __uint_as_float(w.y << 16); a[3] += __uint_as_float(w.y & 0xffff0000u);
            a[4] += __uint_as_float(w.z << 16); a[5] += __uint_as_float(w.z & 0xffff0000u); a[6] += __uint_as_float(w.w << 16); a[7] += __uint_as_float(w.w & 0xffff0000u); }
        __syncthreads();
#pragma unroll
        for (int j = 0; j < 8; ++j) red[rg * 128 + c * 8 + j] = a[j];
        __syncthreads();
        if (tid < 128) { float s2 = 0.f;
#pragma unroll
            for (int g = 0; g < 32; ++g) s2 += red[g * 128 + tid];
            s2 *= (1.0f / 256.f);
            const bf16_t hi = f2bf(s2);
            p->kmh[(size_t)unit * 128 + tid] = hi; p->kml[(size_t)unit * 128 + tid] = f2bf(s2 - bf2f(hi)); }
    }
}
__device__ __forceinline__ void phase_moba_select(KPTR p, LAS unsigned char* lds, int bid, int nb, int wv) {
    const int tid = opaque_tid(wv), wid = tid >> 6, lane = tid & 63, fr = lane & 15, fq = lane >> 4;
    LAS float* sg = (LAS float*)lds + wid * (16 * 65);
    LAS unsigned* cnt = (LAS unsigned*)(lds + 8 * 16 * 65 * 4);
    LAS unsigned* gbase = cnt + 64;
    const int TPS = SEQ / 128, NU = BATCH * 8 * TPS;
    const bf16_t* qkv = p->qkv; const bf16_t* kmh = p->kmh; const bf16_t* kml = p->kml; unsigned* mcount = p->mcount; unsigned short* mlist = p->mlist; float* part_lse = p->part_lse;
    for (int unit = bid; unit < NU; unit += nb) {
        const int tile = unit % TPS, h = (unit / TPS) & 7, b = unit / (TPS * 8), bh = b * 8 + h;
        const int t0 = tile * 128 + wid * 16, own = (tile * 128) >> 8;
        if (tid < 64) cnt[tid] = 0u;
        if (own > 0) {
            f32x4 acc[GNT];
#pragma unroll
            for (int nt = 0; nt < GNT; ++nt) acc[nt] = (f32x4){0.f, 0.f, 0.f, 0.f};
            const bf16_t* qrow = qkv + ((size_t)b * SEQ + t0 + fr) * 3072 + h * 128 + 8 * fq;
#pragma unroll
            for (int s4 = 0; s4 < 4; ++s4) {
                const bf16x8 a = *(const bf16x8*)(qrow + 32 * s4);
#pragma unroll
                for (int nt = 0; nt < GNT; ++nt) {
                    int blk = 16 * nt + fr; blk = blk < NBLK ? blk : NBLK - 1;
                    const size_t ko = ((size_t)bh * NBLK + blk) * 128 + 32 * s4 + 8 * fq;
                    const bf16x8 b1 = *(const bf16x8*)(kmh + ko), b2 = *(const bf16x8*)(kml + ko);
                    acc[nt] = __builtin_amdgcn_mfma_f32_16x16x32_bf16(a, b1, acc[nt], 0, 0, 0);
                    acc[nt] = __builtin_amdgcn_mfma_f32_16x16x32_bf16(a, b2, acc[nt], 0, 0, 0);
                }
            }
#pragma unroll
            for (int nt = 0; nt < GNT; ++nt)
#pragma unroll
                for (int r = 0; r < 4; ++r) sg[(4 * fq + r) * 65 + 16 * nt + fr] = acc[nt][r];
        }
        __syncthreads();
        int i0 = -1, i1 = -1, i2 = -1; unsigned r0 = 0, r1 = 0, r2 = 0;
        if (lane < 16) {
            float v0 = -3e38f, v1 = -3e38f, v2 = -3e38f;
            for (int j = 0; j < own; ++j) {
                const float g = sg[lane * 65 + j];
                if (g > v0) { v2 = v1; i2 = i1; v1 = v0; i1 = i0; v0 = g; i0 = j; }
                else if (g > v1) { v2 = v1; i2 = i1; v1 = g; i1 = j; }
                else if (g > v2) { v2 = g; i2 = j; }
            }
            if (i0 >= 0) r0 = LDS_ATOMIC_ADD(cnt + i0, 1u);
            if (i1 >= 0) r1 = LDS_ATOMIC_ADD(cnt + i1, 1u);
            if (i2 >= 0) r2 = LDS_ATOMIC_ADD(cnt + i2, 1u);
        }
        __syncthreads();
        if (tid < 64 && tid < own) { const unsigned c = cnt[tid]; if (c > 0u) gbase[tid] = atomicAdd(mcount + bh * NBLK + tid, c); }
        __syncthreads();
        if (lane < 16) {
            const int t = t0 + lane;
            const size_t pb = ((size_t)((size_t)b * SEQ + t) * 8 + h) * 3;
            unsigned short* lst = mlist + (size_t)bh * LTOT;
            if (i0 >= 0) lst[list_off(i0) + gbase[i0] + r0] = (unsigned short)(((unsigned)t << 2) | 0u); else part_lse[pb + 0] = -1e30f;
            if (i1 >= 0) lst[list_off(i1) + gbase[i1] + r1] = (unsigned short)(((unsigned)t << 2) | 1u); else part_lse[pb + 1] = -1e30f;
            if (i2 >= 0) lst[list_off(i2) + gbase[i2] + r2] = (unsigned short)(((unsigned)t << 2) | 2u); else part_lse[pb + 2] = -1e30f;
        }
    }
}

__device__ __forceinline__ void moba_stage_kv(const bf16_t* qkv, LAS unsigned char* Ks, LAS unsigned char* VTs, int b, int h, int j, int tid) {
    OPAQUE_V(tid);
    const bf16_t* kbase = qkv + ((size_t)b * SEQ + (size_t)j * 256) * 3072 + 1024 + h * 128;
    const bf16_t* vbase = kbase + 1024;
#pragma unroll
    for (int i = 0; i < 8; ++i) { const int id = tid + NTHREADS * i, key = id >> 4, c = id & 15;
        *(LAS u32x4*)(Ks + key * KS_STRIDE + c * 16) = *(const u32x4*)(kbase + (size_t)key * 3072 + c * 8); }
#pragma unroll
    for (int i = 0; i < 2; ++i) { const int id = tid + NTHREADS * i, c = (id & 3) | (((id >> 4) & 3) << 2), g = ((id >> 2) & 3) | ((id >> 6) << 2);
        u32x4 r0 = *(const u32x4*)(vbase + (size_t)(4 * g) * 3072 + c * 8), r1 = *(const u32x4*)(vbase + (size_t)(4 * g + 1) * 3072 + c * 8);
        u32x4 r2 = *(const u32x4*)(vbase + (size_t)(4 * g + 2) * 3072 + c * 8), r3 = *(const u32x4*)(vbase + (size_t)(4 * g + 3) * 3072 + c * 8);
#pragma unroll
        for (int e = 0; e < 8; ++e) { const int wsel = e >> 1, sh = 16 * (e & 1);
            const unsigned x0 = (r0[wsel] >> sh) & 0xffffu, x1 = (r1[wsel] >> sh) & 0xffffu, x2 = (r2[wsel] >> sh) & 0xffffu, x3 = (r3[wsel] >> sh) & 0xffffu;
            u32x2 o; o.x = x0 | (x1 << 16); o.y = x2 | (x3 << 16);
            *(LAS u32x2*)(VTs + (8 * c + e) * VT_STRIDE + 8 * g) = o; }
    }
}
struct AttnState { f32x16 o[4]; float m, l; };
#ifndef CPU_EMU
__device__ __forceinline__ u32x4 swap16(const u32x4 w, int) {
    const u32x2 r0 = __builtin_amdgcn_permlane32_swap(w.x, w.z, false, false), r1 = __builtin_amdgcn_permlane32_swap(w.y, w.w, false, false);
    u32x4 o; o.x = r0.x; o.z = r0.y; o.y = r1.x; o.w = r1.y; return o; }
#else
static inline u32x4 swap16(const u32x4 w, int lane) {
    unsigned a0 = w.x, b0 = w.z, a1 = w.y, b1 = w.w;
    const unsigned a0o = __shfl(a0, lane ^ 32), b0o = __shfl(b0, lane ^ 32), a1o = __shfl(a1, lane ^ 32), b1o = __shfl(b1, lane ^ 32);
    if (lane < 32) { b0 = a0o; b1 = a1o; } else { a0 = b0o; a1 = b1o; }
    u32x4 o; o.x = a0; o.y = a1; o.z = b0; o.w = b1; return o; }
#endif
template <bool CAUSAL>
__device__ __forceinline__ void attn_block(LAS const unsigned char* Ks, LAS const unsigned char* VTs, const bf16x8 (&qf)[8], float bias0, float slope, int qloc, int wtile, int lane, AttnState& st) {
    const int l31 = lane & 31, h2 = lane >> 5;
    const float scale = 0.08838834764831845f;
#pragma unroll 1
    for (int hf = 0; hf < 2; ++hf) {
        if (CAUSAL && 4 * hf > wtile) break;
        f32x16 sv[4];
#pragma unroll
        for (int kt = 0; kt < 4; ++kt) {
            const int kt4 = 4 * hf + kt;
            f32x16 acc;
#pragma unroll
            for (int r = 0; r < 16; ++r) acc[r] = 0.f;
            if (!CAUSAL || kt4 <= wtile) {
#pragma unroll
                for (int s8 = 0; s8 < 8; ++s8) { const bf16x8 a = *(LAS const bf16x8*)(Ks + (32 * kt4 + l31) * KS_STRIDE + (16 * s8 + 8 * h2) * 2);
                    acc = __builtin_amdgcn_mfma_f32_32x32x16_bf16(a, qf[s8], acc, 0, 0, 0); }
#pragma unroll
                for (int r = 0; r < 16; ++r) { const int kl = 32 * kt4 + (r & 3) + 8 * (r >> 2) + 4 * h2;
                    float v = acc[r] * scale + (bias0 + slope * (float)kl);
                    if (CAUSAL && kt4 == wtile && kl > qloc) v = -1e30f;
                    acc[r] = v; }
            } else {
#pragma unroll
                for (int r = 0; r < 16; ++r) acc[r] = -1e30f;
            }
            sv[kt] = acc;
            SCHED_FENCE();
        }
        float mx = -1e30f;
#pragma unroll
        for (int kt = 0; kt < 4; ++kt)
#pragma unroll
            for (int r = 0; r < 16; ++r) mx = fmaxf(mx, sv[kt][r]);
        mx = fmaxf(mx, __shfl_xor(mx, 32));
        const float mnew = fmaxf(st.m, mx);
        const float alpha = __expf(st.m - mnew);
        st.m = mnew;
        float ls = 0.f;
#pragma unroll
        for (int kt = 0; kt < 4; ++kt)
#pragma unroll
            for (int r = 0; r < 16; ++r) { const float pv = __expf(sv[kt][r] - mnew); sv[kt][r] = pv; ls += pv; }
        st.l = st.l * alpha + ls;
#pragma unroll
        for (int dt = 0; dt < 4; ++dt)
#pragma unroll
            for (int r = 0; r < 16; ++r) st.o[dt][r] *= alpha;
#pragma unroll
        for (int kt = 0; kt < 4; ++kt) {
            const int kt4 = 4 * hf + kt;
            if (CAUSAL && kt4 > wtile) continue;
#pragma unroll
            for (int s2 = 0; s2 < 2; ++s2) {
                u32x4 pw; pw.x = pack2(sv[kt][8 * s2 + 0], sv[kt][8 * s2 + 1]); pw.y = pack2(sv[kt][8 * s2 + 2], sv[kt][8 * s2 + 3]); pw.z = pack2(sv[kt][8 * s2 + 4], sv[kt][8 * s2 + 5]); pw.w = pack2(sv[kt][8 * s2 + 6], sv[kt][8 * s2 + 7]);
                bf16x8 pf; __builtin_memcpy(&pf, &pw, 16);
#pragma unroll
                for (int dt = 0; dt < 4; ++dt) {
                    LAS const unsigned char* vp = VTs + (32 * dt + l31) * VT_STRIDE + (32 * kt4 + 16 * s2 + 4 * h2) * 2;
                    const u32x2 lo = *(LAS const u32x2*)vp, hi = *(LAS const u32x2*)(vp + 16);
                    u32x4 aw; aw.x = lo.x; aw.y = lo.y; aw.z = hi.x; aw.w = hi.y;
                    bf16x8 a; __builtin_memcpy(&a, &aw, 16);
                    st.o[dt] = __builtin_amdgcn_mfma_f32_32x32x16_bf16(a, pf, st.o[dt], 0, 0, 0);
                }
                SCHED_FENCE();
            }
        }
    }
}
__device__ __forceinline__ void load_qfrag(const bf16_t* qrow, int h2, bf16x8 (&qf)[8]) {
#pragma unroll
    for (int s8 = 0; s8 < 8; ++s8) qf[s8] = *(const bf16x8*)(qrow + 16 * s8 + 8 * h2);
}

__device__ __forceinline__ void phase_moba_gather(KPTR p, LAS unsigned char* lds, int bid, int nb, int wv) {
    const int tid = opaque_tid(wv), wid = tid >> 6, lane = tid & 63, l31 = lane & 31, h2 = lane >> 5;
    LAS unsigned char* Ks = lds; LAS unsigned char* VTs = lds + KS_BYTES;
    LAS unsigned* pref = (LAS unsigned*)(lds + KS_BYTES + VT_BYTES);
    LAS unsigned* wsum = pref + NIT + 1;
    const bf16_t* qkv = p->qkv; const unsigned* mcount = p->mcount; const unsigned short* mlist = p->mlist; bf16_t* part_o = p->part_o; float* part_lse = p->part_lse;
    constexpr int IPT = (NIT + NTHREADS - 1) / NTHREADS;
    unsigned loc[IPT]; unsigned tsum = 0;
#pragma unroll
    for (int i = 0; i < IPT; ++i) { const int it = tid * IPT + i; const unsigned c = it < NIT ? mcount[it] : 0u; loc[i] = c ? 1u + 2u * ((c + 255u) >> 8) : 0u; tsum += loc[i]; }
    unsigned inc = tsum;
    for (int o = 1; o < 64; o <<= 1) { const unsigned t2 = __shfl_up(inc, o); if (lane >= o) inc += t2; }
    if (lane == 63) wsum[wid] = inc;
    __syncthreads();
    unsigned wbase = 0;
#pragma unroll
    for (int w = 0; w < 8; ++w) if (w < wid) wbase += wsum[w];
    unsigned run = wbase + inc - tsum;
#pragma unroll
    for (int i = 0; i < IPT; ++i) { const int it = tid * IPT + i; if (it < NIT) pref[it] = run; run += loc[i]; }
    if (tid == NTHREADS - 1) pref[NIT] = run;
    __syncthreads();
    const unsigned C = pref[NIT];
    const unsigned lo = (unsigned)(((unsigned long long)C * (unsigned)bid) / (unsigned)nb), hi = (unsigned)(((unsigned long long)C * (unsigned)(bid + 1)) / (unsigned)nb);
    if (lo >= hi) return;
    int first = 0; { int a = 0, c = NIT; while (c - a > 1) { const int mid = (a + c) >> 1; if (pref[mid] <= lo) a = mid; else c = mid; } first = a; }
    for (int it = first; it < NIT; ++it) {
        const unsigned ps = pref[it], pe = pref[it + 1];
        if (ps >= hi) break;
        if (pe <= lo || pe == ps) continue;
        const unsigned nr = (pe - ps - 1u) >> 1;
        unsigned r_lo = 0; if (lo > ps + 1u) r_lo = (lo - ps - 1u + 1u) >> 1;
        unsigned r_hi = nr; if (hi < ps + 1u + 2u * nr) r_hi = hi > ps + 1u ? (hi - ps - 1u + 1u) >> 1 : 0u;
        if (r_lo >= r_hi) continue;
        const int j = it % NBLK, h = (it / NBLK) & 7, b = it / (NBLK * 8), bh = b * 8 + h;
        const unsigned cnt = mcount[it];
        const unsigned ra = r_lo * 256u, rb = (r_hi * 256u) < cnt ? (r_hi * 256u) : cnt;
        __syncthreads();
        moba_stage_kv(qkv, Ks, VTs, b, h, j, tid);
        __syncthreads();
        const float slope = exp2f(-(float)(h + 1));
        const unsigned short* lst = mlist + (size_t)bh * LTOT + list_off(j);
        unsigned ent_next = 0;
        { const unsigned row = ra + 32u * wid + l31; if (ra + 32u * wid < rb) ent_next = lst[row < rb ? row : (rb - 1)]; }
        for (unsigned r0 = ra + 32u * wid; r0 < rb; r0 += 256u) {
            const unsigned row = r0 + l31; const bool active = row < rb;
            const unsigned ent = ent_next;
            if (r0 + 256u < rb) { const unsigned rn = row + 256u; ent_next = lst[rn < rb ? rn : (rb - 1)]; }
            const int t = (int)(ent >> 2), k = (int)(ent & 3u);
            bf16x8 qf[8]; load_qfrag(qkv + ((size_t)b * SEQ + t) * 3072 + h * 128, h2, qf);
            AttnState st;
#pragma unroll
            for (int dt = 0; dt < 4; ++dt)
#pragma unroll
                for (int r = 0; r < 16; ++r) st.o[dt][r] = 0.f;
            st.m = -1e30f; st.l = 0.f;
            attn_block<false>(Ks, VTs, qf, slope * (float)(256 * j - t), slope, 0, 0, lane, st);
            const float lt = st.l + __shfl_xor(st.l, 32);
            const float inv = 1.0f / lt;
            {
                const size_t pb = ((size_t)((size_t)b * SEQ + t) * 8 + h) * 3 + k;
                bf16_t* po = part_o + pb * 128;
#pragma unroll
                for (int dt = 0; dt < 4; ++dt)
#pragma unroll
                    for (int gp = 0; gp < 4; gp += 2) { u32x4 w;
                        w.x = pack2(st.o[dt][4 * gp] * inv, st.o[dt][4 * gp + 1] * inv); w.y = pack2(st.o[dt][4 * gp + 2] * inv, st.o[dt][4 * gp + 3] * inv);
                        w.z = pack2(st.o[dt][4 * gp + 4] * inv, st.o[dt][4 * gp + 5] * inv); w.w = pack2(st.o[dt][4 * gp + 6] * inv, st.o[dt][4 * gp + 7] * inv);
                        w = swap16(w, lane);
                        if (active) *(u32x4*)(po + 32 * dt + 8 * (gp + h2)) = w; }
                if (active && h2 == 0) part_lse[pb] = st.m + __logf(lt);
            }
        }
    }
}
__device__ __forceinline__ void phase_moba_own(KPTR p, LAS unsigned char* lds, int bid, int nb, int wv) {
    const int tid = opaque_tid(wv), wid = tid >> 6, lane = tid & 63, l31 = lane & 31, h2 = lane >> 5;
    LAS unsigned char* Ks = lds; LAS unsigned char* VTs = lds + KS_BYTES;
    const bf16_t* qkv = p->qkv; const bf16_t* part_o = p->part_o; const float* part_lse = p->part_lse; bf16_t* out = p->hn;
    for (int it = bid; it < NIT; it += nb) {
        const int j = it % NBLK, h = (it / NBLK) & 7, b = it / (NBLK * 8);
        const float slope = exp2f(-(float)(h + 1));
        const int qloc = 32 * wid + l31, t = j * 256 + qloc;
        bf16x8 qf[8]; load_qfrag(qkv + ((size_t)b * SEQ + t) * 3072 + h * 128, h2, qf);
        __syncthreads();
        moba_stage_kv(qkv, Ks, VTs, b, h, j, tid);
        __syncthreads();
        AttnState st;
#pragma unroll
        for (int dt = 0; dt < 4; ++dt)
#pragma unroll
            for (int r = 0; r < 16; ++r) st.o[dt][r] = 0.f;
        st.m = -1e30f; st.l = 0.f;
        attn_block<true>(Ks, VTs, qf, slope * (float)(-qloc), slope, qloc, wid, lane, st);
        const float lt = st.l + __shfl_xor(st.l, 32);
        const float lse_own = st.m + __logf(lt);
        const size_t pb = ((size_t)((size_t)b * SEQ + t) * 8 + h) * 3;
        const float l0 = part_lse[pb], l1 = part_lse[pb + 1], l2 = part_lse[pb + 2];
        const float M = fmaxf(fmaxf(lse_own, l0), fmaxf(l1, l2));
        const float w_own = __expf(lse_own - M), w0 = __expf(l0 - M), w1 = __expf(l1 - M), w2 = __expf(l2 - M);
        const float Wi = 1.0f / (w_own + w0 + w1 + w2);
        const float c_own = w_own * Wi / lt, c0 = w0 * Wi, c1 = w1 * Wi, c2 = w2 * Wi;
        bf16_t* orow = out + ((size_t)b * SEQ + t) * DM + h * 128;
        const bool v0 = l0 > -1e29f, v1 = l1 > -1e29f, v2 = l2 > -1e29f;
#pragma unroll
        for (int dt = 0; dt < 4; ++dt) {
            u32x2 pw[3][4]; u32x4 pq[3][2];
#pragma unroll
            for (int k = 0; k < 3; ++k)
#pragma unroll
                for (int gp = 0; gp < 2; ++gp) pq[k][gp] = *(const u32x4*)(part_o + (pb + k) * 128 + 32 * dt + 8 * (2 * gp + h2));
#pragma unroll
            for (int k = 0; k < 3; ++k)
#pragma unroll
                for (int gp = 0; gp < 2; ++gp) { const u32x4 q = swap16(pq[k][gp], lane); pw[k][2 * gp].x = q.x; pw[k][2 * gp].y = q.y; pw[k][2 * gp + 1].x = q.z; pw[k][2 * gp + 1].y = q.w; }
            u32x2 wo4[4];
#pragma unroll
            for (int g = 0; g < 4; ++g) {
                const int d0 = 32 * dt + 8 * g + 4 * h2;
                float v[4];
#pragma unroll
                for (int e = 0; e < 4; ++e) v[e] = st.o[dt][4 * g + e] * c_own;
#pragma unroll
                for (int k = 0; k < 3; ++k) {
                    const bool vk = k == 0 ? v0 : (k == 1 ? v1 : v2); const float ck = k == 0 ? c0 : (k == 1 ? c1 : c2);
                    const u32x2 w = pw[k][g];
                    const float f0 = __uint_as_float(w.x << 16), f1 = __uint_as_float(w.x & 0xffff0000u), f2 = __uint_as_float(w.y << 16), f3 = __uint_as_float(w.y & 0xffff0000u);
                    v[0] += vk ? ck * f0 : 0.f; v[1] += vk ? ck * f1 : 0.f; v[2] += vk ? ck * f2 : 0.f; v[3] += vk ? ck * f3 : 0.f;
                }
                wo4[g].x = pack2(v[0], v[1]); wo4[g].y = pack2(v[2], v[3]);
            }
#pragma unroll
            for (int gp = 0; gp < 4; gp += 2) { u32x4 w; w.x = wo4[gp].x; w.y = wo4[gp].y; w.z = wo4[gp + 1].x; w.w = wo4[gp + 1].y;
                w = swap16(w, lane);
                *(u32x4*)(orow + 32 * dt + 8 * (gp + h2)) = w; }
        }
    }
}

__device__ __forceinline__ void phase_router(KPTR p, LAS unsigned char* lds, int bid, int nb, int wv) {
    const int tid = opaque_tid(wv), wid = tid >> 6, lane = tid & 63;
    LAS unsigned* hist = (LAS unsigned*)lds;
    if (tid < 8) hist[tid] = 0u;
    __syncthreads();
    f32x4 gv[4];
#pragma unroll
    for (int i = 0; i < 4; ++i) gv[i] = *(const f32x4*)(p->ffn_norm + DM + i * 256 + lane * 4);
    const int rpw = (NTOK + nb - 1) / nb, rbeg = bid * rpw, rend = (rbeg + rpw) < NTOK ? (rbeg + rpw) : NTOK;
    f32x4 w8[16][2];
#pragma unroll
    for (int i = 0; i < 4; ++i)
#pragma unroll
        for (int e = 0; e < 4; ++e) { const float* wr_ = p->w_router + (size_t)(i * 256 + lane * 4 + e) * 8; w8[i * 4 + e][0] = *(const f32x4*)wr_; w8[i * 4 + e][1] = *(const f32x4*)(wr_ + 4); }
    for (int row = rbeg + wid; row < rend; row += 8) {
        f32x4 v[4]; load_row_b(p->hb3, row, lane, v);
        const float rs = row_rstd(v);
#pragma unroll
        for (int i = 0; i < 4; ++i) v[i] = v[i] * rs * gv[i];
        store_row_fp8((unsigned char*)p->hn, p->hns, row, lane, v);
        { float ss = 0.f;
#pragma unroll
          for (int i = 0; i < 4; ++i) ss += v[i][0] * v[i][0] + v[i][1] * v[i][1] + v[i][2] * v[i][2] + v[i][3] * v[i][3];
          ss = wave_sum(ss); if (lane == 0) p->hnn2[row] = ss; }
        f32x4 d0 = (f32x4){0.f, 0.f, 0.f, 0.f}, d1 = (f32x4){0.f, 0.f, 0.f, 0.f};
#pragma unroll
        for (int i = 0; i < 4; ++i)
#pragma unroll
            for (int e = 0; e < 4; ++e) { const float xv = v[i][e]; d0 = d0 + w8[i * 4 + e][0] * xv; d1 = d1 + w8[i * 4 + e][1] * xv; }
        float d[8] = {d0[0], d0[1], d0[2], d0[3], d1[0], d1[1], d1[2], d1[3]};
#pragma unroll
        for (int j = 0; j < 8; ++j) d[j] = wave_sum(d[j]);
        int i0 = 0; float m0 = d[0];
#pragma unroll
        for (int j = 1; j < 8; ++j) if (d[j] > m0) { m0 = d[j]; i0 = j; }
        int i1 = -1; float m1 = -3e38f;
#pragma unroll
        for (int j = 0; j < 8; ++j) if (j != i0 && d[j] > m1) { m1 = d[j]; i1 = j; }
        if (lane == 0) {
            const float e1 = __expf(m1 - m0); const float g0 = 1.0f / (1.0f + e1);
            p->midx[row * 2] = i0; p->midx[row * 2 + 1] = i1; p->mgate[row * 2] = g0; p->mgate[row * 2 + 1] = e1 * g0;
            LDS_ATOMIC_ADD(hist + i0, 1u); LDS_ATOMIC_ADD(hist + i1, 1u);
        }
    }
    __syncthreads();
    if (tid < 8) p->wghist[bid * 8 + tid] = hist[tid];
}
__device__ __forceinline__ void phase_slots(KPTR p, LAS unsigned char* lds, int bid, int nb, int wv) {
    const int tid = opaque_tid(wv);
    LAS unsigned* ltot = (LAS unsigned*)lds; LAS unsigned* lpre = ltot + 8; LAS unsigned* lcur = ltot + 16;
    if (tid < 24) ltot[tid] = 0u;
    __syncthreads();
    { const int e = tid & 7; unsigned tot = 0, pre = 0;
      for (int bb = tid >> 3; bb < nb; bb += NTHREADS / 8) { const unsigned v = p->wghist[bb * 8 + e]; tot += v; if (bb < bid) pre += v; }
      LDS_ATOMIC_ADD(ltot + e, tot); LDS_ATOMIC_ADD(lpre + e, pre); }
    __syncthreads();
    unsigned base[NE], cnt[NE]; unsigned acc = 0; float gu[NE];
#pragma unroll
    for (int e = 0; e < NE; ++e) { cnt[e] = ltot[e]; base[e] = acc; acc += (cnt[e] + 255u) & ~255u; gu[e] = __uint_as_float(p->ctrl[C_GMAX + e]) * __uint_as_float(p->ctrl[C_UMAX + e]); }
    const int rpw = (NTOK + nb - 1) / nb, rbeg = bid * rpw, rend = (rbeg + rpw) < NTOK ? (rbeg + rpw) : NTOK;
    for (int a = rbeg * 2 + tid; a < rend * 2; a += NTHREADS) {
        const int e = p->midx[a];
        unsigned b0 = 0;
#pragma unroll
        for (int j = 0; j < NE; ++j) if (j == e) b0 = base[j];
        const unsigned s = b0 + lpre[e] + LDS_ATOMIC_ADD(lcur + e, 1u);
        p->slot_of[a] = (int)s; p->arow[s] = a >> 1; p->sslot[s] = p->hns[a >> 1];
        float gm = 0.f;
#pragma unroll
        for (int j = 0; j < NE; ++j) if (j == e) gm = gu[j];
        p->shs[s] = p->hnn2[a >> 1] * gm * (1.0f / 256.f);
    }
    if (bid == 0) {
        if (tid == 0) { p->ctrl[C_NTILES] = acc >> 8; p->ctrl[C_TB + NE] = acc >> 8; }
        if (tid < NE) { unsigned bb = 0;
#pragma unroll
            for (int e = 0; e < NE; ++e) if (e == tid) bb = base[e];
            p->ctrl[C_TB + tid] = bb >> 8; }
#pragma unroll
        for (int e = 0; e < NE; ++e) {
            const unsigned lo = base[e] + cnt[e], hi = base[e] + ((cnt[e] + 255u) & ~255u);
            for (unsigned s2 = lo + tid; s2 < hi; s2 += NTHREADS) { p->arow[s2] = 0; p->sslot[s2] = 0.f; p->shs[s2] = 1.0f; }
            for (unsigned t = (base[e] >> 8) + tid; t < (hi >> 8); t += NTHREADS) p->tile_e[t] = e;
        }
    }
}
__device__ __forceinline__ void phase_final(KPTR p, const bf16_t* hsrc, int lo, int hi, int bid, int nb, int wv) {
    const int tid = opaque_tid(wv), wid = tid >> 6, lane = tid & 63;
    f32x4 gv[4];
#pragma unroll
    for (int i = 0; i < 4; ++i) gv[i] = *(const f32x4*)(p->final_norm + i * 256 + lane * 4);
    int sl0 = 0, sl1 = 0; float ga0 = 0.f, ga1 = 0.f;
    { const int row = lo + bid * 8 + wid; if (row < hi) { sl0 = p->slot_of[row * 2]; sl1 = p->slot_of[row * 2 + 1]; ga0 = p->mgate[row * 2]; ga1 = p->mgate[row * 2 + 1]; } }
    for (int row = lo + bid * 8 + wid; row < hi; row += nb * 8) {
        const int s0 = sl0, s1 = sl1; const float g0 = ga0, g1 = ga1;
        u32x2 y0[4], y1[4];
#pragma unroll
        for (int i = 0; i < 4; ++i) { y0[i] = *(const u32x2*)(p->yslot + (size_t)s0 * DM + i * 256 + lane * 4); y1[i] = *(const u32x2*)(p->yslot + (size_t)s1 * DM + i * 256 + lane * 4); }
        f32x4 v[4]; load_row_b(hsrc, row, lane, v);
        { const int rn = row + nb * 8; if (rn < hi) { sl0 = p->slot_of[rn * 2]; sl1 = p->slot_of[rn * 2 + 1]; ga0 = p->mgate[rn * 2]; ga1 = p->mgate[rn * 2 + 1]; } }
#pragma unroll
        for (int i = 0; i < 4; ++i) {
            v[i][0] += g0 * __uint_as_float(y0[i].x << 16) + g1 * __uint_as_float(y1[i].x << 16); v[i][1] += g0 * __uint_as_float(y0[i].x & 0xffff0000u) + g1 * __uint_as_float(y1[i].x & 0xffff0000u);
            v[i][2] += g0 * __uint_as_float(y0[i].y << 16) + g1 * __uint_as_float(y1[i].y << 16); v[i][3] += g0 * __uint_as_float(y0[i].y & 0xffff0000u) + g1 * __uint_as_float(y1[i].y & 0xffff0000u); }
        const float rs = row_rstd(v);
#pragma unroll
        for (int i = 0; i < 4; ++i) *(f32x4*)(p->out + (size_t)row * DM + i * 256 + lane * 4) = v[i] * rs * gv[i];
    }
}


#ifndef CPU_EMU
#define XB_TMO      128
#define XB_XCNT(j)  (256  + 64 * (j))
#define XB_XSUB(j)  (1280 + 64 * (j))
#define XB_XGEN(j)  (2304 + 64 * (j))
#define XB_TOP      3328
#define XB_TOPGEN   3392
#define XCD_BAR_WORDS 3456
#define XB_SPIN_CAP (1u << 20)
__device__ __forceinline__ unsigned xb_ld(unsigned* p) { return __hip_atomic_load(p, __ATOMIC_RELAXED, __HIP_MEMORY_SCOPE_AGENT); }
__device__ __forceinline__ unsigned xb_add(unsigned* p, unsigned v) { return __hip_atomic_fetch_add(p, v, __ATOMIC_RELAXED, __HIP_MEMORY_SCOPE_AGENT); }
__device__ __forceinline__ unsigned xb_xcc_id() { return (unsigned)__builtin_amdgcn_s_getreg((3 << 11) | 20) & 0xFu; }
#define XB_SPIN(cond, bar) do { unsigned _sp = 0; while (cond) { __builtin_amdgcn_s_sleep(1); \
    if ((++_sp & 255u) == 0u) { if (xb_ld(&(bar)[XB_TMO])) break; if (_sp > XB_SPIN_CAP) { atomicAdd(&(bar)[XB_TMO], 1u); break; } } } } while (0)
__device__ __forceinline__ void xcd_barrier_post(unsigned* bar, int tid) { if (tid == 0) (void)xb_add(&bar[XB_XCNT(xb_xcc_id())], 1u); }
__device__ __forceinline__ void xcd_barrier_complete(unsigned* bar, unsigned x, unsigned& nloc, unsigned& nx) {
    const unsigned G = gridDim.x * gridDim.y * gridDim.z;
    unsigned sum, cnt, mine, sp = 0u;
    for (;;) {
        sum = 0u; cnt = 0u; mine = 0u;
#pragma unroll
        for (unsigned j = 0; j < 16; ++j) { const unsigned c = xb_ld(&bar[XB_XCNT(j)]); sum += c; cnt += (c > 0u) ? 1u : 0u; mine = (j == x) ? c : mine; }
        if (sum == G) break;
        __builtin_amdgcn_s_sleep(1);
        if ((++sp & 255u) == 0u) { if (xb_ld(&bar[XB_TMO])) break; if (sp > XB_SPIN_CAP) { atomicAdd(&bar[XB_TMO], 1u); break; } }
    }
    nloc = mine > 0u ? mine : 1u; nx = cnt > 0u ? cnt : 1u;
}
__device__ __forceinline__ void xcd_barrier(unsigned* bar, volatile LAS unsigned* st, int tid) {
    asm volatile("s_waitcnt vmcnt(0)" ::: "memory");
    __syncthreads();
    if (tid == 0) {
        __builtin_amdgcn_s_waitcnt(0);
        const unsigned x = xb_xcc_id();
        unsigned nloc = st[0], nx = st[1];
        if (nloc == 0u) { xcd_barrier_complete(bar, x, nloc, nx); st[0] = nloc; st[1] = nx; }
        const unsigned old = xb_add(&bar[XB_XSUB(x)], 1u);
        const unsigned gen = old / nloc;
        if (old + 1u == (gen + 1u) * nloc) {
            __builtin_amdgcn_fence(__ATOMIC_RELEASE, "agent");
            asm volatile("s_waitcnt vmcnt(0)" ::: "memory");
            const unsigned og = xb_add(&bar[XB_TOP], 1u);
            const unsigned tg = og / nx;
            if (og + 1u == (tg + 1u) * nx) xb_add(&bar[XB_TOPGEN], 1u);
            else XB_SPIN(xb_ld(&bar[XB_TOPGEN]) == tg, bar);
            __builtin_amdgcn_fence(__ATOMIC_ACQUIRE, "agent");
            xb_add(&bar[XB_XGEN(x)], 1u);
            asm volatile("s_waitcnt vmcnt(0)" ::: "memory");
        } else {
            XB_SPIN(xb_ld(&bar[XB_XGEN(x)]) == gen, bar);
            __builtin_amdgcn_fence(__ATOMIC_ACQUIRE, "agent");
            asm volatile("s_waitcnt vmcnt(0)" ::: "memory");
        }
    }
    __syncthreads();
}
#define GRID_BARRIER() do { unsigned* _bar = p->bar; xcd_barrier(_bar, (volatile LAS unsigned*)(lds + kDynLds - 16), opaque_tid(wv)); } while (0)
#else
#define XCD_BAR_WORDS 3456
#define GRID_BARRIER() emu::grid_sync()
#endif

#ifndef CPU_EMU
extern __shared__ __attribute__((aligned(16))) unsigned char smem_raw[];
#define GET_LDS() ((LAS unsigned char*)smem_raw)
#else
#define GET_LDS() (emu::blk->smem)
#endif

__global__ void __launch_bounds__(NTHREADS) fwd_megakernel(Params p_arg) {
    cg::grid_group grid = cg::this_grid();
    KPTR p = KARG_PTR(p_arg);
    LAS unsigned char* lds = GET_LDS();
#ifndef CPU_EMU
    const int wv = __builtin_amdgcn_readfirstlane((int)(threadIdx.x >> 6));
#else
    const int wv = 0;
#endif
    const int bid = blockIdx.x, nb = gridDim.x, tid = opaque_tid(wv);
#ifndef CPU_EMU
    if (tid == 0) { volatile LAS unsigned* st = (volatile LAS unsigned*)(lds + kDynLds - 16); st[0] = 0u; st[1] = 0u; }
    __syncthreads();
    xcd_barrier_post(p->bar, tid);
#endif
    LAUNDER(p);
    if (bid == 0 && tid < 256) p->ctrl[tid] = 0u;
    for (int i = bid * NTHREADS + tid; i < NIT; i += nb * NTHREADS) p->mcount[i] = 0u;
    for (int i = bid * NTHREADS + tid; i < NCHH; i += nb * NTHREADS) p->gflag[i] = 0u;
    convert_wt(lds, p->w_in, DM, DIN, 0, DINP, p->wt_in, 128, 0, bid, nb, wv);
    convert_wt(lds, p->w_out0, DM, DM, 0, DM, p->wt_out0, 128, 0, bid, nb, wv);
    convert_wt(lds, p->w_gate0, DM, FF, 0, FF, p->wt_gu0, 256, 0, bid, nb, wv);
    convert_wt(lds, p->w_up0, DM, FF, 0, FF, p->wt_gu0, 256, 128, bid, nb, wv);
    convert_wt(lds, p->w_down0, FF, DM, 0, DM, p->wt_d0, 128, 0, bid, nb, wv);
    convert_wt(lds, p->w_qkv, DM, 3072, 0, 3072, p->wt_qkv, 128, 0, bid, nb, wv);
    convert_wt(lds, p->w_out1, DM, DM, 0, DM, p->wt_out1, 128, 0, bid, nb, wv);
    phase_norm<true>(p, p->x, p->mix_norm, bid, nb, wv);
    if (p->pad0 != 0) grid.sync(); else GRID_BARRIER();
    LAUNDER(p);
    for (int rp = 0; rp < RPT_GEMM; ++rp) { StaticOrder so; so.init(NTOK / 256, DINP / 256, nb, bid); Gemm g{p->hn, p->wt_in, nullptr}; EpiBf16 e{p->proj, DINP, 0}; gemm_phase<DM>(lds, g, so, e, wv); }
    GRID_BARRIER();
    LAUNDER(p);
    constexpr int NUG_ = ((BATCH * 4 + 7) / 8) * 8 * (8 / NCW);
    const bool overlap = nb >= NUG_ + 32;
    if (!overlap) phase_gdn_pre<false>(p, lds, bid, nb, wv);
    phase_ret_local(p, lds, bid, nb, wv);
    GRID_BARRIER();
    LAUNDER(p);
    if (overlap) phase_scan<true>(p, lds, bid, nb, wv); else phase_scan<false>(p, lds, bid, nb, wv);
    GRID_BARRIER();
    LAUNDER(p);
    phase_gatednorm(p, bid, nb, wv);
    GRID_BARRIER();
    LAUNDER(p);
    { StaticOrder so; so.init(NTOK / 256, DM / 256, nb, bid); Gemm g{p->hn, p->wt_out0, nullptr}; EpiResBf16<true> e{p->x, nullptr, p->hb}; gemm_phase<DM>(lds, g, so, e, wv); }
    GRID_BARRIER();
    LAUNDER(p);
#if FP8_FFN0
    phase_norm<false, true, true>(p, p->hb, p->ffn_norm, bid, nb, wv);
    quant_rows<DM, false>(p, lds, p->wt_gu0, p->w8_gu0, p->ws_gu0, 2 * FF, bid, nb, wv);
#else
    phase_norm<false, false, true>(p, p->hb, p->ffn_norm, bid, nb, wv);
#endif
    GRID_BARRIER();
    LAUNDER(p);
#if FP8_FFN0
    for (int rp = 0; rp < RPT_GEMM; ++rp) { StaticOrder so; so.init(NTOK / 256, 2 * FF / 256, nb, bid); Gemm g{p->hn, (const bf16_t*)p->w8_gu0, nullptr}; EpiSwigluS e{p->act0, FF, 0, p->hns, p->ws_gu0}; gemm_phase<DM, EpiSwigluS, StaticOrder, true>(lds, g, so, e, wv); }
#else
    for (int rp = 0; rp < RPT_GEMM; ++rp) { StaticOrder so; so.init(NTOK / 256, 2 * FF / 256, nb, bid); Gemm g{p->hn, p->wt_gu0, nullptr}; EpiSwiglu e{p->act0, FF, 0}; gemm_phase<DM>(lds, g, so, e, wv); }
#endif
    GRID_BARRIER();
    LAUNDER(p);
    { StaticOrder so; so.init(NTOK / 256, DM / 256, nb, bid); Gemm g{p->act0, p->wt_d0, nullptr}; EpiResBf16<false> e{nullptr, p->hb, p->hb}; gemm_phase<FF>(lds, g, so, e, wv); }
    GRID_BARRIER();
    LAUNDER(p);
    phase_norm<false, false, true>(p, p->hb, p->mix_norm + DM, bid, nb, wv);
    GRID_BARRIER();
    LAUNDER(p);
    for (int rp = 0; rp < RPT_GEMM; ++rp) { StaticOrder so; so.init(NTOK / 256, 3072 / 256, nb, bid); Gemm g{p->hn, p->wt_qkv, nullptr}; EpiBf16 e{p->qkv, 3072, 0}; gemm_phase<DM>(lds, g, so, e, wv); }
    GRID_BARRIER();
    LAUNDER(p);
    phase_kmean(p, lds, bid, nb, wv);
    GRID_BARRIER();
    LAUNDER(p);
    phase_moba_select(p, lds, bid, nb, wv);
    GRID_BARRIER();
    LAUNDER(p);
    for (int rp = 0; rp < RPT_MG; ++rp) phase_moba_gather(p, lds, bid, nb, wv);
    GRID_BARRIER();
    LAUNDER(p);
    for (int rp = 0; rp < RPT_MO; ++rp) phase_moba_own(p, lds, bid, nb, wv);
    GRID_BARRIER();
    LAUNDER(p);
    convert_gu_fp8(p, lds, bid, nb, wv);
    for (int rp = 0; rp < RPT_CONV; ++rp) for (int e = 0; e < NE; ++e) {
        convert_wt(lds, p->w_mdown + (size_t)e * FFE * DM, FFE, DM, 0, DM, p->wt_md_tmp + (size_t)e * DM * FFE, 128, 0, bid, nb, wv);
    }
    { StaticOrder so; so.init(NTOK / 256, DM / 256, nb, bid); Gemm g{p->hn, p->wt_out1, nullptr}; EpiResBf16<false> e{nullptr, p->hb, p->hb3}; gemm_phase<DM>(lds, g, so, e, wv); }
    GRID_BARRIER();
    LAUNDER(p);
    phase_router(p, lds, bid, nb, wv);
    quant_rows<FFE, false>(p, lds, p->wt_md_tmp, p->w8_md, p->ws_md, NE * DM, bid, nb, wv);
    GRID_BARRIER();
    LAUNDER(p);
    phase_slots(p, lds, bid, nb, wv);
    GRID_BARRIER();
    LAUNDER(p);
    {
        const int ntiles = (int)p->ctrl[C_NTILES];
        const int npass = (ntiles + p->tiles_per_pass - 1) / p->tiles_per_pass;
        const int tpp = npass > 0 ? (ntiles + npass - 1) / npass : 1;
        const size_t mbuf = (size_t)p->tiles_per_pass * 256 * FFE; int q = 0;
        for (int t0 = 0; t0 < ntiles; t0 += tpp, ++q) {
            const int nM = (ntiles - t0) < tpp ? (ntiles - t0) : tpp;
            unsigned char* mb = (unsigned char*)p->mact + (size_t)(q & 1) * mbuf;
            for (int rp = 0; rp < RPT_GEMM; ++rp) { MoeOrder mo; mo.init(t0, nM, 2 * FFE / 256, p->tile_e, nb, bid); Gemm g{p->hn, (const bf16_t*)p->w8_mgu, p->arow}; EpiSwigluS8 e{mb, FFE, t0 * 256, p->sslot, p->ws_mgu, p->shs}; gemm_phase<DM, EpiSwigluS8, MoeOrder, true>(lds, g, mo, e, wv); }
            GRID_BARRIER();
            for (int rp = 0; rp < RPT_GEMM; ++rp) { MoeOrder mo; mo.init(t0, nM, DM / 256, p->tile_e, nb, bid); Gemm g{(const bf16_t*)((const unsigned char*)mb - (size_t)t0 * 256 * FFE), (const bf16_t*)p->w8_md, nullptr}; EpiBf16S e{p->yslot, DM, p->shs, p->ws_md}; gemm_phase<FFE, EpiBf16S, MoeOrder, true>(lds, g, mo, e, wv); }
        }
        GRID_BARRIER();
    }
    LAUNDER(p);
    phase_final(p, p->hb3, 0, NTOK, bid, nb, wv);
}

static inline size_t al256(size_t x) { return (x + 255) & ~(size_t)255; }

extern "C" void kernel_launch(void* const* d_in, const int* in_sizes, int n_in, void* d_out, int out_size, void* d_ws, size_t ws_size, hipStream_t stream) {
    Params p; memset(&p, 0, sizeof(p));
    p.x = (const float*)d_in[0]; p.mix_norm = (const float*)d_in[1]; p.ffn_norm = (const float*)d_in[2]; p.w_in = (const float*)d_in[3]; p.conv_w = (const float*)d_in[4];
    p.a_log = (const float*)d_in[5]; p.dt_bias = (const float*)d_in[6]; p.ret_norm = (const float*)d_in[7]; p.gdn_norm = (const float*)d_in[8]; p.w_out0 = (const float*)d_in[9];
    p.w_qkv = (const float*)d_in[10]; p.w_out1 = (const float*)d_in[11]; p.w_gate0 = (const float*)d_in[12]; p.w_up0 = (const float*)d_in[13]; p.w_down0 = (const float*)d_in[14];
    p.w_router = (const float*)d_in[15]; p.w_mgate = (const float*)d_in[16]; p.w_mup = (const float*)d_in[17]; p.w_mdown = (const float*)d_in[18]; p.final_norm = (const float*)d_in[19];
    p.out = (float*)d_out; p.hb = (bf16_t*)((unsigned char*)d_out + (size_t)NTOK * DM * 2);
    unsigned char* w = (unsigned char*)d_ws; size_t off = 0;
    auto take = [&](size_t bytes) { unsigned char* r = w + off; off += al256(bytes); return r; };
    p.ctrl = (unsigned*)take(4096); p.bar = (unsigned*)take((size_t)XCD_BAR_WORDS * 4);
    p.wt_in = (bf16_t*)take((size_t)DINP * DM * 2); p.wt_out0 = (bf16_t*)take((size_t)DM * DM * 2); p.wt_gu0 = (bf16_t*)take((size_t)2 * FF * DM * 2); p.wt_d0 = (bf16_t*)take((size_t)DM * FF * 2);
    p.wt_qkv = (bf16_t*)take((size_t)3072 * DM * 2); p.wt_out1 = (bf16_t*)take((size_t)DM * DM * 2);
    p.hn = (bf16_t*)take((size_t)NTOK * DM * 2);
    p.gflag = (unsigned*)take((size_t)NCHH * 4);
    p.retL = (float*)take((size_t)BATCH * 4 * NG * 128 * 128 * 4);
    p.gbeta = (float*)take((size_t)NTOK * 4 * 4); p.gg = (float*)take((size_t)NTOK * 4 * 4);
    p.arow = (int*)take((size_t)MAXTILES * 256 * 4); p.tile_e = (int*)take((size_t)MAXTILES * 4); p.slot_of = (int*)take((size_t)NTOK * 2 * 4); p.mgate = (float*)take((size_t)NTOK * 2 * 4); p.midx = (int*)take((size_t)NTOK * 2 * 4); p.wghist = (unsigned*)take((size_t)4096 * 8 * 4);
    p.w8_gu0 = take(FP8_FFN0 ? (size_t)2 * FF * DM : (size_t)256); p.ws_gu0 = (float*)take((size_t)2 * FF * 4); p.ws_mgu = (float*)take((size_t)NE * 2 * FFE * 4); p.hns = (float*)take((size_t)NTOK * 4); p.sslot = (float*)take((size_t)MAXTILES * 256 * 4);
    p.ws_md = (float*)take((size_t)NE * DM * 4); p.hnn2 = (float*)take((size_t)NTOK * 4); p.shs = (float*)take((size_t)MAXTILES * 256 * 4);
    p.kmh = (bf16_t*)take((size_t)NIT * 128 * 2); p.kml = (bf16_t*)take((size_t)NIT * 128 * 2); p.mcount = (unsigned*)take((size_t)NIT * 4);
    p.arena = w + off;
    const size_t arena_bytes = ws_size - off;
    { size_t a = 0; auto at = [&](size_t bytes) { unsigned char* r = p.arena + a; a += al256(bytes); return r; };
      p.proj = (bf16_t*)at((size_t)NTOK * DINP * 2);
      p.gimg = (unsigned char*)at((size_t)NCHH * IMG_CH); p.gcdec = (float*)at((size_t)NCHH * 4);
      if (a > arena_bytes) fprintf(stderr, "workspace too small (layer0): need %zu have %zu\n", a, arena_bytes); }
    p.act0 = (bf16_t*)p.arena;
    { size_t a = 0; auto at = [&](size_t bytes) { unsigned char* r = p.arena + a; a += al256(bytes); return r; };
      p.qkv = (bf16_t*)at((size_t)NTOK * 3072 * 2); p.part_o = (bf16_t*)at((size_t)NTOK * 8 * 3 * 128 * 2); p.part_lse = (float*)at((size_t)NTOK * 8 * 3 * 4); p.mlist = (unsigned short*)at((size_t)BATCH * 8 * LTOT * 2);
      if (a > arena_bytes) fprintf(stderr, "workspace too small (layer1): need %zu have %zu\n", a, arena_bytes); }
    { size_t a = 0; auto at = [&](size_t bytes) { unsigned char* r = p.arena + a; a += al256(bytes); return r; };
      p.w8_mgu = at((size_t)NE * 2 * FFE * DM); p.w8_md = at((size_t)NE * DM * FFE); p.yslot = (bf16_t*)at((size_t)MAXTILES * 256 * DM * 2);
      p.hb3 = (bf16_t*)at((size_t)NTOK * DM * 2);
      p.mact = (bf16_t*)(p.arena + a);
      p.wt_mgu = nullptr; p.wt_md_tmp = p.mact; p.wt_md = nullptr;
      const size_t rest = arena_bytes > a ? arena_bytes - a : 0;
      if (rest < (size_t)NE * FFE * DM * 2) fprintf(stderr, "workspace too small (moe weights)\n");
      long tiles = (long)(rest / ((size_t)2 * 256 * FFE));
      if (tiles > 64) tiles = 64;
      if (tiles < 1) { fprintf(stderr, "workspace too small (moe)\n"); tiles = 1; }
#ifdef CPU_EMU
      if (getenv("EMU_TPP")) tiles = atoi(getenv("EMU_TPP"));
#endif
      p.tiles_per_pass = (int)tiles; }
#ifdef CPU_EMU
    emu::reg("hn", p.hn, (size_t)NTOK * DM * 2, "bf16"); emu::reg("proj", p.proj, (size_t)NTOK * DINP * 2, "bf16");
    emu::reg("gbeta", p.gbeta, (size_t)NTOK * 16, "f32"); emu::reg("gg", p.gg, (size_t)NTOK * 16, "f32"); emu::reg("midx", p.midx, (size_t)NTOK * 8, "i32");
    const int grid_blocks = getenv("EMU_GRID") ? atoi(getenv("EMU_GRID")) : 8;
    emu::launch(grid_blocks, NTHREADS, kDynLds, [=]() { fwd_megakernel(p); }, true);
#else
    static int grid_blocks = 0;
    if (!grid_blocks) {
        int dev = 0, cus = 0, per_cu = 0;
        (void)hipGetDevice(&dev);
        (void)hipDeviceGetAttribute(&cus, hipDeviceAttributeMultiprocessorCount, dev);
        (void)hipFuncSetAttribute((const void*)fwd_megakernel, hipFuncAttributeMaxDynamicSharedMemorySize, (int)kDynLds);
        (void)hipOccupancyMaxActiveBlocksPerMultiprocessor(&per_cu, fwd_megakernel, NTHREADS, kDynLds);
        if (per_cu < 1) per_cu = 1;
        grid_blocks = cus;
    }
    (void)hipMemsetAsync(p.bar, 0, (size_t)XCD_BAR_WORDS * 4, stream);
    void* args[] = {&p};
    hipError_t e = hipLaunchCooperativeKernel((const void*)fwd_megakernel, dim3(grid_blocks), dim3(NTHREADS), args, kDynLds, stream);
    if (e != hipSuccess) fprintf(stderr, "cooperative launch failed: %s (grid %d)\n", hipGetErrorString(e), grid_blocks);
#endif
}
```

```cpp
#ifndef CPU_EMU
#include <hip/hip_runtime.h>
#include <hip/hip_cooperative_groups.h>
#include <cstdio>
#include <cstring>
#define LAS __attribute__((address_space(3)))
#define WAVE_SYNC() __builtin_amdgcn_wave_barrier()
#define SCHED_FENCE() __builtin_amdgcn_sched_barrier(0)
#define OPAQUE_V(x) asm volatile("" : "+v"(x))
static __device__ __forceinline__ unsigned shfl_up_u(unsigned v, int o, int lane) { const int src = lane >= o ? lane - o : lane; return (unsigned)__builtin_amdgcn_ds_bpermute(src << 2, (int)v); }
static __device__ __forceinline__ float shfl_up_f(float v, int o, int lane) { return __uint_as_float(shfl_up_u(__float_as_uint(v), o, lane)); }
#define LDS_ATOMIC_ADD(ptr, v) __hip_atomic_fetch_add((ptr), (v), __ATOMIC_RELAXED, __HIP_MEMORY_SCOPE_WORKGROUP)
#define LDS_ATOMIC_MAX(ptr, v) __hip_atomic_fetch_max((ptr), (v), __ATOMIC_RELAXED, __HIP_MEMORY_SCOPE_WORKGROUP)
#define GLOBAL_ATOMIC_MAX(ptr, v) __hip_atomic_fetch_max((ptr), (v), __ATOMIC_RELAXED, __HIP_MEMORY_SCOPE_AGENT)
static __device__ __forceinline__ int opaque_tid(int wv) { int l; asm volatile("v_mbcnt_lo_u32_b32 %0, -1, 0\n\tv_mbcnt_hi_u32_b32 %0, -1, %0" : "=v"(l)); return (wv << 6) | l; }
#else
static inline int opaque_tid(int) { return threadIdx.x; }
#define LAS
#define WAVE_SYNC() ((void)__ballot(1))
#define SCHED_FENCE() ((void)0)
#define OPAQUE_V(x) ((void)0)
static inline unsigned shfl_up_u(unsigned v, int o, int lane) { return __shfl(v, lane >= o ? lane - o : lane); }
static inline float shfl_up_f(float v, int o, int lane) { return __shfl(v, lane >= o ? lane - o : lane); }
static inline unsigned emu_fetch_add(unsigned* p, unsigned v) { unsigned o = *p; *p = o + v; return o; }
#define LDS_ATOMIC_ADD(ptr, v) emu_fetch_add((ptr), (v))
static inline unsigned emu_fetch_max(unsigned* p, unsigned v) { unsigned o = *p; if (v > o) *p = v; return o; }
#define LDS_ATOMIC_MAX(ptr, v) emu_fetch_max((ptr), (v))
#define GLOBAL_ATOMIC_MAX(ptr, v) atomicMax((ptr), (v))
#endif
namespace cg = cooperative_groups;

#ifndef RPT_SYNC
#define RPT_SYNC 0
#endif
#ifndef RPT_SG
#define RPT_SG 1
#endif
#ifndef RPT_SR
#define RPT_SR 1
#endif
#ifndef RPT_MG
#define RPT_MG 1
#endif
#ifndef RPT_MO
#define RPT_MO 1
#endif
#ifndef RPT_GEMM
#define RPT_GEMM 1
#endif
#ifndef RPT_GDN
#define RPT_GDN 1
#endif
#ifndef RPT_SCAN
#define RPT_SCAN 1
#endif
#ifndef RPT_MOBA
#define RPT_MOBA 1
#endif
#ifndef RPT_CONV
#define RPT_CONV 1
#endif
#ifndef FP8_FFN0
#define FP8_FFN0 0
#endif
#ifndef CFG_SEQ
#define CFG_SEQ 16384
#define CFG_BATCH 2
#define CFG_FF 2816
#define CFG_FFE 3584
#endif

typedef unsigned short bf16_t;
typedef short bf16x8 __attribute__((ext_vector_type(8)));
typedef float f32x4 __attribute__((ext_vector_type(4)));
typedef float f32x16 __attribute__((ext_vector_type(16)));
typedef unsigned u32x4 __attribute__((ext_vector_type(4)));
typedef unsigned u32x2 __attribute__((ext_vector_type(2)));

constexpr int DM = 1024, SEQ = CFG_SEQ, BATCH = CFG_BATCH, NTOK = SEQ * BATCH, HD = 128;
constexpr int DIN = 4104, DINP = 4096, FF = CFG_FF, FFE = CFG_FFE, NE = 8;
constexpr int NCH = SEQ / 64, NBLK = SEQ / 256, NCHH = BATCH * 4 * NCH;
constexpr int NTHREADS = 512;
constexpr int BM = 256, BK = 64, HALF = 128, HTB = HALF * BK * 2, STAGE_BYTES = 8 * HTB, NXCD = 8, WGM = 4;
constexpr size_t kDynLds = 144 * 1024;
constexpr int MAXTILES = NTOK * 2 / 256 + NE;
constexpr int NIT = BATCH * 8 * NBLK;
constexpr int LTOT = NBLK * SEQ - 128 * NBLK * (NBLK + 1);
static_assert(SEQ <= 16384, "16-bit selection-list entries");
constexpr int GNT = (NBLK + 15) / 16;
constexpr int KS_STRIDE = 272, VT_STRIDE = 520;
constexpr int KS_BYTES = 256 * KS_STRIDE, VT_BYTES = 128 * VT_STRIDE;
__host__ __device__ __forceinline__ int list_off(int j) { return j * SEQ - 128 * j * (j + 1); }
constexpr float NORM_EPS = 1e-6f;

__device__ __forceinline__ bf16_t f2bf(float f) { unsigned u = __float_as_uint(f); u += 0x7FFFu + ((u >> 16) & 1u); return (bf16_t)(u >> 16); }
__device__ __forceinline__ float bf2f(bf16_t h) { return __uint_as_float(((unsigned)h) << 16); }
#ifndef CPU_EMU
typedef __bf16 hwbf16x2 __attribute__((ext_vector_type(2)));
typedef float f32x2v __attribute__((ext_vector_type(2)));
__device__ __forceinline__ unsigned pack2(float lo, float hi) { f32x2v v; v.x = lo; v.y = hi; hwbf16x2 b = __builtin_convertvector(v, hwbf16x2); unsigned r; __builtin_memcpy(&r, &b, 4); return r; }
#else
__device__ __forceinline__ unsigned pack2(float lo, float hi) { return (unsigned)f2bf(lo) | ((unsigned)f2bf(hi) << 16); }
#endif
#ifndef CPU_EMU
__device__ __forceinline__ float siluf(float x) { return x * __builtin_amdgcn_rcpf(1.0f + __builtin_amdgcn_exp2f(-1.4426950408889634f * x)); }
#else
__device__ __forceinline__ float siluf(float x) { return x / (1.0f + __expf(-x)); }
#endif
#ifndef CPU_EMU
__device__ __forceinline__ unsigned pack4_fp8(float a, float b, float c, float d) { int r = 0; r = __builtin_amdgcn_cvt_pk_fp8_f32(a, b, r, false); r = __builtin_amdgcn_cvt_pk_fp8_f32(c, d, r, true); return (unsigned)r; }
#else
static inline float fp8_to_f(unsigned char v) { const int s = v >> 7, e = (v >> 3) & 15, m = v & 7; const float a = e == 0 ? ldexpf((float)m, -9) : ldexpf((float)(8 + m), e - 10); return s ? -a : a; }
static inline unsigned char f_to_fp8(float x) {
    const unsigned s = x < 0.f ? 0x80u : 0u; float a = fabsf(x); if (!(a == a)) return 0x7f; if (a > 448.f) a = 448.f; if (a == 0.f) return (unsigned char)s;
    int e; (void)frexpf(a, &e); e -= 1; if (e < -6) e = -6;
    const float step = ldexpf(1.f, e - 3); float q = nearbyintf(a / step) * step; if (q > 448.f) q = 448.f;
    int e2; (void)frexpf(q, &e2); e2 -= 1; unsigned bits;
    if (q < ldexpf(1.f, -6)) bits = (unsigned)nearbyintf(q * 512.f); else bits = ((unsigned)(e2 + 7) << 3) | ((unsigned)nearbyintf(q / ldexpf(1.f, e2 - 3)) - 8u);
    return (unsigned char)(s | bits);
}
static inline unsigned pack4_fp8(float a, float b, float c, float d) { return (unsigned)f_to_fp8(a) | ((unsigned)f_to_fp8(b) << 8) | ((unsigned)f_to_fp8(c) << 16) | ((unsigned)f_to_fp8(d) << 24); }
#endif
constexpr float FP8_TOP = 384.f;
#ifndef CPU_EMU
__device__ __forceinline__ float wave_sum(float s) { int l; asm volatile("v_mbcnt_lo_u32_b32 %0, -1, 0\n\tv_mbcnt_hi_u32_b32 %0, -1, %0" : "=v"(l));
#pragma unroll
    for (int o = 32; o >= 1; o >>= 1) s += __uint_as_float((unsigned)__builtin_amdgcn_ds_bpermute((l ^ o) << 2, (int)__float_as_uint(s))); return s; }
__device__ __forceinline__ float wave_max(float s) { int l; asm volatile("v_mbcnt_lo_u32_b32 %0, -1, 0\n\tv_mbcnt_hi_u32_b32 %0, -1, %0" : "=v"(l));
#pragma unroll
    for (int o = 32; o >= 1; o >>= 1) s = fmaxf(s, __uint_as_float((unsigned)__builtin_amdgcn_ds_bpermute((l ^ o) << 2, (int)__float_as_uint(s)))); return s; }
#else
__device__ __forceinline__ float wave_sum(float s) { for (int o = 32; o >= 1; o >>= 1) s += __shfl_xor(s, o); return s; }
__device__ __forceinline__ float wave_max(float s) { for (int o = 32; o >= 1; o >>= 1) s = fmaxf(s, __shfl_xor(s, o)); return s; }
#endif

struct Params;
#ifndef CPU_EMU
typedef const __attribute__((address_space(4))) Params* KPTR;
#define KARG_PTR(arg) ((KPTR)__builtin_amdgcn_kernarg_segment_ptr())
#define LAUNDER(q) asm volatile("" : "+s"(q))
#else
typedef const Params* KPTR;
#define KARG_PTR(arg) (&(arg))
#define LAUNDER(q) ((void)0)
#endif
struct Params {
    const float* x; const float* mix_norm; const float* ffn_norm; const float* w_in; const float* conv_w; const float* a_log; const float* dt_bias;
    const float* ret_norm; const float* gdn_norm; const float* w_out0; const float* w_qkv; const float* w_out1; const float* w_gate0; const float* w_up0;
    const float* w_down0; const float* w_router; const float* w_mgate; const float* w_mup; const float* w_mdown; const float* final_norm;
    float* out;
    bf16_t* hb;
    bf16_t* hb3;
    unsigned* ctrl;
    unsigned* bar;
    bf16_t* wt_in; bf16_t* wt_out0; bf16_t* wt_gu0; bf16_t* wt_d0; bf16_t* wt_qkv; bf16_t* wt_out1;
    bf16_t* hn;
    float* gbeta; float* gg;
    float* retL;
    unsigned* gflag;
    unsigned char* arena;
    bf16_t* proj; unsigned char* gimg; float* gcdec;
    bf16_t* act0;
    bf16_t* qkv; bf16_t* kmh; bf16_t* kml; unsigned* mcount; unsigned short* mlist; bf16_t* part_o; float* part_lse;
    bf16_t* wt_mgu; bf16_t* wt_md; bf16_t* yslot; bf16_t* mact; int* arow; int* tile_e; int* slot_of; float* mgate; int* midx; unsigned* wghist;
    unsigned char* w8_gu0; float* ws_gu0; unsigned char* w8_mgu; float* ws_mgu; float* hns; float* sslot; unsigned char* w8_md; float* ws_md; float* hnn2; float* sn2; float* shs; bf16_t* wt_md_tmp;
    int tiles_per_pass; int pad0;
};

#define C_CNT(e) (64 + (e))
#define C_CUR(e) (128 + (e))
#define C_NTILES 192
#define C_GMAX 216
#define C_UMAX 224
#define C_TB 200

__host__ __device__ __forceinline__ int lds_byte(int r, int c) { const int st = (r >> 4) * 2 + (c >> 5), rr = r & 15, cc = c & 31, ob = rr * 64 + cc * 2; return st * 1024 + (ob ^ (((ob >> 9) & 1) << 5)); }
__host__ __device__ __forceinline__ void stage_rc(int b, int& R, int& C) { const int st = b / 1024, sb = b % 1024, swz = sb ^ (((sb >> 9) & 1) << 5); R = (st >> 1) * 16 + swz / 64; C = (st & 1) * 32 + (swz % 64) / 2; }
__host__ __device__ __forceinline__ int perm32(int rho) { const int n = rho >> 4, i = rho & 15; return 8 * (i >> 2) + 4 * n + (i & 3); }

struct Unit { int pm, pn, pnb; };
struct Gemm { const bf16_t* A; const bf16_t* Bt; const int* arow; };

struct StaticOrder {
    int nM, nN, nwg, G, c;
    __device__ void init(int nM_, int nN_, int G_, int c_) { nM = nM_; nN = nN_; nwg = nM * nN; G = G_; c = c_; }
    __device__ bool next(int i, Unit& u) const {
        const long L = (long)i * G + c; if (L >= nwg) return false;
        int wgid = (int)L; { const int q = nwg / NXCD, r = nwg % NXCD, xcd = wgid % NXCD, off = wgid / NXCD; wgid = (xcd < r ? xcd * (q + 1) : r * (q + 1) + (xcd - r) * q) + off; }
        const int nig = WGM * nN, gid = wgid / nig, fm = gid * WGM, gsz = (nM - fm) < WGM ? (nM - fm) : WGM;
        u.pm = fm + ((wgid % nig) % gsz); u.pn = (wgid % nig) / gsz; u.pnb = u.pn; return true;
    }
};
struct MoeOrder {
    StaticOrder so; int t0; const int* tile_e;
    __device__ void init(int t0_, int nM_, int nN_, const int* te, int G_, int c_) { so.init(nM_, nN_, G_, c_); t0 = t0_; tile_e = te; }
    __device__ bool next(int i, Unit& u) const { if (!so.next(i, u)) return false; u.pm += t0; u.pnb = tile_e[u.pm] * so.nN + u.pn; return true; }
};

struct EpiBf16 {
    static constexpr bool PERM = true;
    bf16_t* O; int ldc; int rowbase;
    __device__ __forceinline__ void operator()(const f32x4 (&acc)[2][2][4][2], const Unit& u, int wr, int wc, int fr, int fq) const {
        const int row0 = u.pm * BM + wr * 64 + fr - rowbase, col0 = u.pn * BM + wc * 32 + 8 * fq;
#pragma unroll
        for (int ai = 0; ai < 2; ++ai)
#pragma unroll
            for (int m = 0; m < 4; ++m) { bf16_t* rowp = O + (size_t)(row0 + ai * HALF + m * 16) * ldc + col0;
#pragma unroll
                for (int bj = 0; bj < 2; ++bj) { const f32x4 v0 = acc[ai][bj][m][0], v1 = acc[ai][bj][m][1];
                    u32x4 w; w.x = pack2(v0[0], v0[1]); w.y = pack2(v0[2], v0[3]); w.z = pack2(v1[0], v1[1]); w.w = pack2(v1[2], v1[3]);
                    *(u32x4*)(rowp + bj * HALF) = w; } }
    }
};
struct EpiSwiglu {
    static constexpr bool PERM = true;
    bf16_t* O; int ldc; int rowbase;
    __device__ __forceinline__ void operator()(const f32x4 (&acc)[2][2][4][2], const Unit& u, int wr, int wc, int fr, int fq) const {
        const int row0 = u.pm * BM + wr * 64 + fr - rowbase, col0 = u.pn * HALF + wc * 32 + 8 * fq;
#pragma unroll
        for (int ai = 0; ai < 2; ++ai)
#pragma unroll
            for (int m = 0; m < 4; ++m) { bf16_t* rowp = O + (size_t)(row0 + ai * HALF + m * 16) * ldc + col0;
                float r[8];
#pragma unroll
                for (int n = 0; n < 2; ++n)
#pragma unroll
                    for (int j = 0; j < 4; ++j) r[n * 4 + j] = siluf(acc[ai][0][m][n][j]) * acc[ai][1][m][n][j];
                u32x4 w; w.x = pack2(r[0], r[1]); w.y = pack2(r[2], r[3]); w.z = pack2(r[4], r[5]); w.w = pack2(r[6], r[7]);
                *(u32x4*)rowp = w; }
    }
};
struct EpiSwigluS {
    static constexpr bool PERM = true;
    bf16_t* O; int ldc; int rowbase; const float* sa; const float* sb;
    __device__ __forceinline__ void operator()(const f32x4 (&acc)[2][2][4][2], const Unit& u, int wr, int wc, int fr, int fq) const {
        const int rowg = u.pm * BM + wr * 64 + fr, row0 = rowg - rowbase, col0 = u.pn * HALF + wc * 32 + 8 * fq;
        const float* sbp = sb + (size_t)u.pnb * BM + wc * 32 + 8 * fq;
        f32x4 sg[2], su[2];
#pragma unroll
        for (int n = 0; n < 2; ++n) { sg[n] = *(const f32x4*)(sbp + 4 * n); su[n] = *(const f32x4*)(sbp + HALF + 4 * n); }
        float ra[2][4];
#pragma unroll
        for (int ai = 0; ai < 2; ++ai)
#pragma unroll
            for (int m = 0; m < 4; ++m) ra[ai][m] = sa[rowg + ai * HALF + m * 16];
#pragma unroll
        for (int ai = 0; ai < 2; ++ai)
#pragma unroll
            for (int m = 0; m < 4; ++m) { bf16_t* rowp = O + (size_t)(row0 + ai * HALF + m * 16) * ldc + col0;
                float r[8];
#pragma unroll
                for (int n = 0; n < 2; ++n)
#pragma unroll
                    for (int j = 0; j < 4; ++j) r[n * 4 + j] = siluf(acc[ai][0][m][n][j] * (ra[ai][m] * sg[n][j])) * (acc[ai][1][m][n][j] * (ra[ai][m] * su[n][j]));
                u32x4 w; w.x = pack2(r[0], r[1]); w.y = pack2(r[2], r[3]); w.z = pack2(r[4], r[5]); w.w = pack2(r[6], r[7]);
                *(u32x4*)rowp = w; }
    }
};
struct EpiSwigluS8 {
    static constexpr bool PERM = true;
    unsigned char* O8; int ldc; int rowbase; const float* sa; const float* sb; const float* so;
    __device__ __forceinline__ void operator()(const f32x4 (&acc)[2][2][4][2], const Unit& u, int wr, int wc, int fr, int fq) const {
        const int rowg = u.pm * BM + wr * 64 + fr, row0 = rowg - rowbase, col0 = u.pn * HALF + wc * 32 + 8 * fq;
        const float* sbp = sb + (size_t)u.pnb * BM + wc * 32 + 8 * fq;
        f32x4 sg[2], su[2];
#pragma unroll
        for (int n = 0; n < 2; ++n) { sg[n] = *(const f32x4*)(sbp + 4 * n); su[n] = *(const f32x4*)(sbp + HALF + 4 * n); }
        float ra[2][4], ro[2][4];
#pragma unroll
        for (int ai = 0; ai < 2; ++ai)
#pragma unroll
            for (int m = 0; m < 4; ++m) { ra[ai][m] = sa[rowg + ai * HALF + m * 16]; const float so_ = so[rowg + ai * HALF + m * 16]; ro[ai][m] = so_ > 0.f ? 1.0f / so_ : 0.f; }
#pragma unroll
        for (int ai = 0; ai < 2; ++ai)
#pragma unroll
            for (int m = 0; m < 4; ++m) { unsigned char* rowp = O8 + (size_t)(row0 + ai * HALF + m * 16) * ldc + col0;
                float r[8];
#pragma unroll
                for (int n = 0; n < 2; ++n)
#pragma unroll
                    for (int j = 0; j < 4; ++j) r[n * 4 + j] = siluf(acc[ai][0][m][n][j] * (ra[ai][m] * sg[n][j])) * (acc[ai][1][m][n][j] * (ra[ai][m] * su[n][j])) * ro[ai][m];
                u32x2 w; w.x = pack4_fp8(r[0], r[1], r[2], r[3]); w.y = pack4_fp8(r[4], r[5], r[6], r[7]);
                *(u32x2*)rowp = w; }
    }
};
struct EpiBf16S {
    static constexpr bool PERM = true;
    bf16_t* O; int ldc; const float* sa; const float* sb;
    __device__ __forceinline__ void operator()(const f32x4 (&acc)[2][2][4][2], const Unit& u, int wr, int wc, int fr, int fq) const {
        const int row0 = u.pm * BM + wr * 64 + fr, col0 = u.pn * BM + wc * 32 + 8 * fq;
        const float* sbp = sb + (size_t)u.pnb * BM + wc * 32 + 8 * fq;
        f32x4 sv[2][2];
#pragma unroll
        for (int bj = 0; bj < 2; ++bj)
#pragma unroll
            for (int n = 0; n < 2; ++n) sv[bj][n] = *(const f32x4*)(sbp + bj * HALF + 4 * n);
#pragma unroll
        for (int ai = 0; ai < 2; ++ai)
#pragma unroll
            for (int m = 0; m < 4; ++m) { bf16_t* rowp = O + (size_t)(row0 + ai * HALF + m * 16) * ldc + col0; const float ra = sa[row0 + ai * HALF + m * 16];
#pragma unroll
                for (int bj = 0; bj < 2; ++bj) { const f32x4 v0 = acc[ai][bj][m][0] * sv[bj][0] * ra, v1 = acc[ai][bj][m][1] * sv[bj][1] * ra;
                    u32x4 w; w.x = pack2(v0[0], v0[1]); w.y = pack2(v0[2], v0[3]); w.z = pack2(v1[0], v1[1]); w.w = pack2(v1[2], v1[3]);
                    *(u32x4*)(rowp + bj * HALF) = w; } }
    }
};
template <bool F32BASE>
struct EpiResBf16 {
    static constexpr bool PERM = true;
    static constexpr bool LSCALE = false;
    const float* basef; const bf16_t* baseb; bf16_t* out;
    __device__ __forceinline__ void operator()(const f32x4 (&acc)[2][2][4][2], const Unit& u, int wr, int wc, int fr, int fq) const {
        const int row0 = u.pm * BM + wr * 64 + fr, col0 = u.pn * BM + wc * 32 + 8 * fq;
#pragma unroll
        for (int ai = 0; ai < 2; ++ai)
#pragma unroll
            for (int m = 0; m < 4; ++m) { const size_t off = (size_t)(row0 + ai * HALF + m * 16) * DM + col0;
#pragma unroll
                for (int bj = 0; bj < 2; ++bj) { f32x4 b0, b1;
                    if (F32BASE) { b0 = *(const f32x4*)(basef + off + bj * HALF); b1 = *(const f32x4*)(basef + off + bj * HALF + 4); }
                    else { const u32x4 w = *(const u32x4*)(baseb + off + bj * HALF);
                        b0[0] = __uint_as_float(w.x << 16); b0[1] = __uint_as_float(w.x & 0xffff0000u); b0[2] = __uint_as_float(w.y << 16); b0[3] = __uint_as_float(w.y & 0xffff0000u);
                        b1[0] = __uint_as_float(w.z << 16); b1[1] = __uint_as_float(w.z & 0xffff0000u); b1[2] = __uint_as_float(w.w << 16); b1[3] = __uint_as_float(w.w & 0xffff0000u); }
                    const f32x4 v0 = acc[ai][bj][m][0] + b0, v1 = acc[ai][bj][m][1] + b1;
                    u32x4 o; o.x = pack2(v0[0], v0[1]); o.y = pack2(v0[2], v0[3]); o.z = pack2(v1[0], v1[1]); o.w = pack2(v1[2], v1[3]);
                    *(u32x4*)(out + off + bj * HALF) = o; } }
    }
};
struct EpiResF32 {
    static constexpr bool PERM = false;
    const float* base; float* out; int ldc;
    __device__ __forceinline__ void operator()(const f32x4 (&acc)[2][2][4][2], const Unit& u, int wr, int wc, int fr, int fq) const {
        const int row0 = u.pm * BM + wr * 64 + fr, col0 = u.pn * BM + wc * 32 + 4 * fq;
#pragma unroll
        for (int ai = 0; ai < 2; ++ai)
#pragma unroll
            for (int m = 0; m < 4; ++m) { const size_t off = (size_t)(row0 + ai * HALF + m * 16) * ldc + col0;
#pragma unroll
                for (int bj = 0; bj < 2; ++bj)
#pragma unroll
                    for (int n = 0; n < 2; ++n) { const f32x4 b = *(const f32x4*)(base + off + bj * HALF + n * 16); *(f32x4*)(out + off + bj * HALF + n * 16) = b + acc[ai][bj][m][n]; } }
    }
};

#ifndef CPU_EMU
typedef int i32x8 __attribute__((ext_vector_type(8)));
__device__ __forceinline__ i32x8 cat8(const bf16x8 lo, const bf16x8 hi) { u32x4 a, b; __builtin_memcpy(&a, &lo, 16); __builtin_memcpy(&b, &hi, 16); i32x8 r; r[0] = (int)a.x; r[1] = (int)a.y; r[2] = (int)a.z; r[3] = (int)a.w; r[4] = (int)b.x; r[5] = (int)b.y; r[6] = (int)b.z; r[7] = (int)b.w; return r; }
template <int K, class Epi, class Sched, bool FP8 = false>
__device__ __forceinline__ void gemm_phase(LAS unsigned char* lds, const Gemm g, const Sched& S, const Epi& E, int wv) {
    const int tid = opaque_tid(wv), wid = __builtin_amdgcn_readfirstlane(tid >> 6), lane = tid & 63, wr = wid >> 2, wc = wid & 3, fr = lane & 15, fq = lane >> 4;
    constexpr int RB = FP8 ? K : 2 * K;
    constexpr int nt = RB / 128;
    static_assert(nt % 2 == 0 && nt >= 4, "k tiles");
    unsigned voffB[2];
#pragma unroll
    for (int i = 0; i < 2; ++i) { int R, C; stage_rc(tid * 16 + i * 8192, R, C); const int Rb = Epi::PERM ? ((R & ~31) + perm32(R & 31)) : R; voffB[i] = (unsigned)(Rb * RB + C * 2); }
    constexpr size_t kstep = (size_t)(BK * 2);
    constexpr size_t hstep = (size_t)HALF * RB;
    constexpr size_t tstep = 2 * hstep;
    const unsigned ldsw = (unsigned)wid * 1024u;
    const int aoffl = lds_byte(wr * 64 + fr, fq * 8), boffl = lds_byte(wc * 32 + fr, fq * 8);
    unsigned aoff[2][2];
#define G_LOADA(u) do { _Pragma("unroll") for (int _h = 0; _h < 2; ++_h) _Pragma("unroll") for (int _i = 0; _i < 2; ++_i) { int _R, _C; stage_rc(tid * 16 + _i * 8192, _R, _C); const int _r = (u).pm * BM + _h * HALF + _R; \
        const int _s = g.arow ? g.arow[_r] : _r; aoff[_h][_i] = (unsigned)(_s * RB + _C * 2); } } while (0)
#define G_SA(b, h) (((b) * 2 + (h)) * HTB)
#define G_SB(b, h) ((4 + (b) * 2 + (h)) * HTB)
#define G_STAGEB(bufoff, gbase) do { _Pragma("unroll") for (int _i = 0; _i < 2; ++_i) \
        __builtin_amdgcn_global_load_lds((const unsigned*)((const char*)(gbase) + voffB[_i]), (LAS unsigned*)(lds + (bufoff) + ldsw + _i * 8192), 16, 0, 0); } while (0)
#define G_STAGEA(bufoff, kt, h) do { _Pragma("unroll") for (int _i = 0; _i < 2; ++_i) \
        __builtin_amdgcn_global_load_lds((const unsigned*)((const char*)g.A + (size_t)(kt) * kstep + aoff[h][_i]), (LAS unsigned*)(lds + (bufoff) + ldsw + _i * 8192), 16, 0, 0); } while (0)
#define G_LDA(dst, b, h) do { _Pragma("unroll") for (int m = 0; m < 4; ++m) _Pragma("unroll") for (int k = 0; k < 2; ++k) dst[m][k] = *(const LAS bf16x8*)(lds + G_SA(b, h) + aoffl + m * 2048 + k * 1024); } while (0)
#define G_LDB(dst, b, h) do { _Pragma("unroll") for (int n = 0; n < 2; ++n) _Pragma("unroll") for (int k = 0; k < 2; ++k) dst[n][k] = *(const LAS bf16x8*)(lds + G_SB(b, h) + boffl + n * 2048 + k * 1024); } while (0)
#define G_MMA(ai, bj, At, Bt) do { if constexpr (FP8) __builtin_amdgcn_sched_barrier(0); __builtin_amdgcn_s_setprio(1); _Pragma("unroll") for (int m = 0; m < 4; ++m) _Pragma("unroll") for (int n = 0; n < 2; ++n) { \
        if constexpr (FP8) acc[ai][bj][m][n] = __builtin_amdgcn_mfma_scale_f32_16x16x128_f8f6f4(cat8(Bt[n][0], Bt[n][1]), cat8(At[m][0], At[m][1]), acc[ai][bj][m][n], 0, 0, 0, 0x7F7F7F7F, 0, 0x7F7F7F7F); \
        else { _Pragma("unroll") for (int k = 0; k < 2; ++k) acc[ai][bj][m][n] = __builtin_amdgcn_mfma_f32_16x16x32_bf16(Bt[n][k], At[m][k], acc[ai][bj][m][n], 0, 0, 0); } } \
        __builtin_amdgcn_s_setprio(0); if constexpr (FP8) __builtin_amdgcn_sched_barrier(0); } while (0)
#define G_WAIT_V(n) asm volatile("s_waitcnt vmcnt(" #n ")" ::: "memory")
#define G_WAIT_L(n) asm volatile("s_waitcnt lgkmcnt(" #n ")" ::: "memory")
#define G_BAR __builtin_amdgcn_s_barrier()
#define G_SCHED __builtin_amdgcn_sched_barrier(0)
    Unit cur, nxt; int ui = 0;
    if (!S.next(0, cur)) return;
    f32x4 acc[2][2][4][2];
#pragma unroll
    for (int a = 0; a < 2; ++a)
#pragma unroll
        for (int b = 0; b < 2; ++b)
#pragma unroll
            for (int m = 0; m < 4; ++m)
#pragma unroll
                for (int n = 0; n < 2; ++n) acc[a][b][m][n] = (f32x4){0.f, 0.f, 0.f, 0.f};
    bf16x8 At[4][2], B0[2][2], B1[2][2];
    const char* cB = (const char*)g.Bt + (size_t)cur.pnb * tstep;
    G_LOADA(cur);
    G_STAGEB(G_SB(0, 0), cB); G_STAGEA(G_SA(0, 0), 0, 0); G_STAGEB(G_SB(0, 1), cB + hstep); G_STAGEA(G_SA(0, 1), 0, 1);
    if (wr == 1) G_BAR;
    G_WAIT_V(4); G_BAR;
    G_STAGEB(G_SB(1, 0), cB + kstep); G_STAGEA(G_SA(1, 0), 1, 0); G_STAGEB(G_SB(1, 1), cB + hstep + kstep);
    G_WAIT_V(6); G_BAR;
    for (;;) {
        const bool has_next = S.next(ui + 1, nxt);
        const char* nB = has_next ? (const char*)g.Bt + (size_t)nxt.pnb * tstep : cB;
        for (int t = 0; t < nt; t += 2) {
            const bool last = (t == nt - 2);
            const int k2 = last ? 0 : t + 2, k3 = k2 + 1;
            const char* b2 = last ? nB : cB + (size_t)(t + 2) * kstep; const char* b3 = b2 + kstep;
            G_LDB(B0, 0, 0); G_SCHED; G_LDA(At, 0, 0); G_STAGEA(G_SA(1, 1), t + 1, 1);
            if (g.arow && has_next && t == nt - 4 && tid < BM)
                __builtin_amdgcn_global_load_lds((const unsigned*)(g.arow + nxt.pm * BM + tid), (LAS unsigned*)(lds + STAGE_BYTES + wid * 256), 4, 0, 0);
            G_WAIT_L(8); G_BAR; G_WAIT_L(0); G_MMA(0, 0, At, B0); G_BAR; G_SCHED;
            if (last && has_next) {
                if (g.arow) {
#pragma unroll
                    for (int _h = 0; _h < 2; ++_h)
#pragma unroll
                        for (int _i = 0; _i < 2; ++_i) { int _R, _C; stage_rc(tid * 16 + _i * 8192, _R, _C); const int _s = *(LAS const int*)(lds + STAGE_BYTES + (_h * HALF + _R) * 4); aoff[_h][_i] = (unsigned)(_s * RB + _C * 2); }
                } else G_LOADA(nxt);
            }
            G_LDB(B1, 0, 1); G_STAGEB(G_SB(0, 0), b2);
            G_BAR; G_WAIT_L(0); G_MMA(0, 1, At, B1); G_BAR;
            G_LDA(At, 0, 1); G_STAGEA(G_SA(0, 0), k2, 0);
            G_BAR; G_WAIT_L(0); G_MMA(1, 0, At, B0); G_BAR; G_SCHED;
            G_STAGEB(G_SB(0, 1), b2 + hstep);
            G_WAIT_V(6); G_BAR; G_MMA(1, 1, At, B1); G_BAR;
            G_LDB(B0, 1, 0); G_SCHED; G_LDA(At, 1, 0); G_STAGEA(G_SA(0, 1), k2, 1);
            G_WAIT_L(8); G_BAR; G_WAIT_L(0); G_MMA(0, 0, At, B0); G_BAR; G_SCHED;
            G_LDB(B1, 1, 1); G_STAGEB(G_SB(1, 0), b3);
            G_BAR; G_WAIT_L(0); G_MMA(0, 1, At, B1); G_BAR;
            G_LDA(At, 1, 1); G_STAGEA(G_SA(1, 0), k3, 0);
            G_BAR; G_WAIT_L(0); G_MMA(1, 0, At, B0); G_BAR; G_SCHED;
            G_STAGEB(G_SB(1, 1), b3 + hstep);
            G_WAIT_V(6); G_BAR; G_MMA(1, 1, At, B1); G_BAR;
        }
        E(acc, cur, wr, wc, fr, fq);
        if (!has_next) break;
#pragma unroll
        for (int a = 0; a < 2; ++a)
#pragma unroll
            for (int b = 0; b < 2; ++b)
#pragma unroll
                for (int m = 0; m < 4; ++m)
#pragma unroll
                    for (int n = 0; n < 2; ++n) acc[a][b][m][n] = (f32x4){0.f, 0.f, 0.f, 0.f};
        cur = nxt; cB = nB; ++ui;
    }
    G_WAIT_V(0);
    if (wr == 0) G_BAR;
    G_BAR;
}
#else
template <int K, class Epi, class Sched, bool FP8 = false>
__device__ __forceinline__ void gemm_phase(unsigned char* lds, const Gemm g, const Sched& S, const Epi& E, int wv) {
    const int tid = opaque_tid(wv), wid = tid >> 6, lane = tid & 63, wr = wid >> 2, wc = wid & 3, fr = lane & 15, fq = lane >> 4;
    Unit u;
    for (int ui = 0; S.next(ui, u); ++ui) {
        f32x4 acc[2][2][4][2];
        for (int ai = 0; ai < 2; ++ai) for (int bj = 0; bj < 2; ++bj) for (int m = 0; m < 4; ++m) for (int n = 0; n < 2; ++n) for (int j = 0; j < 4; ++j) {
            const int r = u.pm * 256 + 128 * ai + 64 * wr + 16 * m + fr;
            const int cl = Epi::PERM ? (128 * bj + 32 * wc + 8 * fq + 4 * n + j) : (128 * bj + 32 * wc + 16 * n + 4 * fq + j);
            const int ar = g.arow ? g.arow[r] : r;
            float s = 0.f;
            if (FP8) { const unsigned char* a = (const unsigned char*)g.A + (size_t)ar * K; const unsigned char* b = (const unsigned char*)g.Bt + ((size_t)u.pnb * 256 + cl) * K; for (int k = 0; k < K; ++k) s += fp8_to_f(a[k]) * fp8_to_f(b[k]); }
            else { const bf16_t* a = g.A + (size_t)ar * K; const bf16_t* b = g.Bt + ((size_t)u.pnb * 256 + cl) * K; for (int k = 0; k < K; ++k) s += bf2f(a[k]) * bf2f(b[k]); }
            acc[ai][bj][m][n][j] = s;
        }
        E(acc, u, wr, wc, fr, fq);
    }
}
#endif

__device__ __forceinline__ void convert_wt(LAS unsigned char* lds, const float* W, int K, int ldw, int col0, int ncols, bf16_t* Wt, int rowmul, int rowadd, int bid, int nb, int wv) {
    LAS float* t = (LAS float*)lds;
    const int tid = opaque_tid(wv);
    const int tk = K / 64, tn = ncols / 64, ntile = tk * tn;
    const int lr = tid >> 4, c4 = (tid & 15) * 4;
    f32x4 v[2];
    if (bid < ntile) { const int k0 = (bid % tk) * 64, n0 = (bid / tk) * 64;
#pragma unroll
        for (int i = 0; i < 2; ++i) v[i] = *(const f32x4*)(W + (size_t)(k0 + lr + 32 * i) * ldw + col0 + n0 + c4); }
    for (int tile = bid; tile < ntile; tile += nb) {
        const int k0 = (tile % tk) * 64, n0 = (tile / tk) * 64;
        __syncthreads();
#pragma unroll
        for (int i = 0; i < 2; ++i) { const int r = lr + 32 * i; t[r * 65 + c4] = v[i][0]; t[r * 65 + c4 + 1] = v[i][1]; t[r * 65 + c4 + 2] = v[i][2]; t[r * 65 + c4 + 3] = v[i][3]; }
        const int nt2 = tile + nb;
        if (nt2 < ntile) { const int k1 = (nt2 % tk) * 64, n1 = (nt2 / tk) * 64;
#pragma unroll
            for (int i = 0; i < 2; ++i) v[i] = *(const f32x4*)(W + (size_t)(k1 + lr + 32 * i) * ldw + col0 + n1 + c4); }
        __syncthreads();
        { const int c = tid >> 3, k8 = (tid & 7) * 8; const int cc = n0 + c; const int dr = (cc >> 7) * rowmul + (cc & 127) + rowadd;
          u32x4 w; w.x = pack2(t[(k8 + 0) * 65 + c], t[(k8 + 1) * 65 + c]); w.y = pack2(t[(k8 + 2) * 65 + c], t[(k8 + 3) * 65 + c]);
          w.z = pack2(t[(k8 + 4) * 65 + c], t[(k8 + 5) * 65 + c]); w.w = pack2(t[(k8 + 6) * 65 + c], t[(k8 + 7) * 65 + c]);
          *(u32x4*)(Wt + (size_t)dr * K + k0 + k8) = w; }
    }
    __syncthreads();
}

__device__ __forceinline__ void load_row(const float* src, int row, int lane, f32x4 (&v)[4]) {
#pragma unroll
    for (int i = 0; i < 4; ++i) v[i] = *(const f32x4*)(src + (size_t)row * DM + i * 256 + lane * 4);
}
__device__ __forceinline__ void load_row_b(const bf16_t* src, int row, int lane, f32x4 (&v)[4]) {
#pragma unroll
    for (int i = 0; i < 4; ++i) { const u32x2 w = *(const u32x2*)(src + (size_t)row * DM + i * 256 + lane * 4);
        v[i][0] = __uint_as_float(w.x << 16); v[i][1] = __uint_as_float(w.x & 0xffff0000u); v[i][2] = __uint_as_float(w.y << 16); v[i][3] = __uint_as_float(w.y & 0xffff0000u); }
}
__device__ __forceinline__ float row_rstd(const f32x4 (&v)[4]) {
    float s = 0.f;
#pragma unroll
    for (int i = 0; i < 4; ++i) s += v[i][0] * v[i][0] + v[i][1] * v[i][1] + v[i][2] * v[i][2] + v[i][3] * v[i][3];
    s = wave_sum(s);
    return rsqrtf(s * (1.0f / DM) + NORM_EPS);
}
__device__ __forceinline__ void store_row_bf16(bf16_t* dst, int row, int lane, const f32x4 (&v)[4]) {
#pragma unroll
    for (int i = 0; i < 4; ++i) { u32x2 w; w.x = pack2(v[i][0], v[i][1]); w.y = pack2(v[i][2], v[i][3]); *(u32x2*)(dst + (size_t)row * DM + i * 256 + lane * 4) = w; }
}

__device__ __forceinline__ void store_row_fp8(unsigned char* dst, float* scale, int row, int lane, const f32x4 (&v)[4]) {
    float am = 0.f;
#pragma unroll
    for (int i = 0; i < 4; ++i) am = fmaxf(fmaxf(am, fmaxf(fabsf(v[i][0]), fabsf(v[i][1]))), fmaxf(fabsf(v[i][2]), fabsf(v[i][3])));
    am = wave_max(am);
    const float sc = am > 0.f ? am * (1.0f / FP8_TOP) : 1.0f, inv = 1.0f / sc;
#pragma unroll
    for (int i = 0; i < 4; ++i) *(unsigned*)(dst + (size_t)row * DM + i * 256 + lane * 4) = pack4_fp8(v[i][0] * inv, v[i][1] * inv, v[i][2] * inv, v[i][3] * inv);
    if (lane == 0) scale[row] = sc;
}
template <int K, bool NORMS>
__device__ __forceinline__ void quant_rows(KPTR p, LAS unsigned char* lds, const bf16_t* src, unsigned char* dst, float* scl, int nrows, int bid, int nb, int wv) {
    constexpr int NC = K / 512;
    const int tid = opaque_tid(wv), wid = tid >> 6, lane = tid & 63;
    LAS unsigned* nmx = (LAS unsigned*)lds;
    if (NORMS) { if (tid < 2 * NE) nmx[tid] = 0u; __syncthreads(); }
    int row = bid * 8 + wid;
    u32x4 nx[NC];
#pragma unroll
    for (int c = 0; c < NC; ++c) nx[c] = (u32x4){0u, 0u, 0u, 0u};
    if (row < nrows) {
#pragma unroll
        for (int c = 0; c < NC; ++c) nx[c] = *(const u32x4*)(src + (size_t)row * K + (c * 64 + lane) * 8); }
    for (; row < nrows; row += nb * 8) {
        u32x4 cu[NC];
#pragma unroll
        for (int c = 0; c < NC; ++c) cu[c] = nx[c];
        const int rn = row + nb * 8;
        if (rn < nrows) {
#pragma unroll
            for (int c = 0; c < NC; ++c) nx[c] = *(const u32x4*)(src + (size_t)rn * K + (c * 64 + lane) * 8); }
        float am = 0.f, ss = 0.f;
#pragma unroll
        for (int c = 0; c < NC; ++c)
#pragma unroll
            for (int q = 0; q < 4; ++q) { const float lo = __uint_as_float(cu[c][q] << 16), hi = __uint_as_float(cu[c][q] & 0xffff0000u); am = fmaxf(am, fmaxf(fabsf(lo), fabsf(hi))); if (NORMS) ss += lo * lo + hi * hi; }
        am = wave_max(am);
        const float sc = am > 0.f ? am * (1.0f / FP8_TOP) : 1.0f, inv = 1.0f / sc;
#pragma unroll
        for (int c = 0; c < NC; ++c) { u32x2 w;
            w.x = pack4_fp8(__uint_as_float(cu[c][0] << 16) * inv, __uint_as_float(cu[c][0] & 0xffff0000u) * inv, __uint_as_float(cu[c][1] << 16) * inv, __uint_as_float(cu[c][1] & 0xffff0000u) * inv);
            w.y = pack4_fp8(__uint_as_float(cu[c][2] << 16) * inv, __uint_as_float(cu[c][2] & 0xffff0000u) * inv, __uint_as_float(cu[c][3] << 16) * inv, __uint_as_float(cu[c][3] & 0xffff0000u) * inv);
            *(u32x2*)(dst + (size_t)row * K + (c * 64 + lane) * 8) = w; }
        if (lane == 0) scl[row] = sc;
        if (NORMS) { ss = wave_sum(ss); if (lane == 0) LDS_ATOMIC_MAX(nmx + ((row >> 7) & 1) * NE + row / (2 * FFE), __float_as_uint(sqrtf(ss))); }
    }
    if (NORMS) { __syncthreads(); if (tid < 2 * NE) (void)GLOBAL_ATOMIC_MAX(p->ctrl + (tid < NE ? C_GMAX + tid : C_UMAX + tid - NE), nmx[tid]); __syncthreads(); }
}
__device__ __forceinline__ const float* gu_src(KPTR p, int item, int t, int kr, int c4) {
    constexpr int NPAN = FFE / 32;
    const int e = item / (2 * NPAN), r = item % (2 * NPAN), up = r / NPAN, pn = r % NPAN;
    return (up ? p->w_mup : p->w_mgate) + (size_t)e * DM * FFE + (size_t)(t * 64 + kr) * FFE + pn * 32 + c4;
}
__device__ __forceinline__ void convert_gu_fp8(KPTR p, LAS unsigned char* lds, int bid, int nb, int wv) {
    constexpr int PSF = 1028, NPAN = FFE / 32, NITEM = NE * 2 * NPAN, TPI = DM / 64;
    const int tid = opaque_tid(wv), wid = tid >> 6, lane = tid & 63;
    LAS float* pan = (LAS float*)lds;
    LAS float* red = pan + 32 * PSF;
    LAS float* scl = red + 8 * 32 * 2;
    const int c4 = (tid & 7) * 4, kr = tid >> 3;
    const int nmine = bid < NITEM ? (NITEM - bid + nb - 1) / nb : 0, total = nmine * TPI;
    if (nmine == 0) return;
    constexpr int PD = 8;
    static_assert(TPI % PD == 0, "ring");
    f32x4 pf[PD];
#pragma unroll
    for (int i = 0; i < PD; ++i) { const int gi = i < total ? i : total - 1; pf[i] = *(const f32x4*)gu_src(p, bid + (gi / TPI) * nb, gi % TPI, kr, c4); }
    int g = 0;
    for (int it = 0; it < nmine; ++it) {
        const int item = bid + it * nb, e = item / (2 * NPAN), r = item % (2 * NPAN), up = r / NPAN, pn = r % NPAN;
        float am[4] = {0.f, 0.f, 0.f, 0.f}, ss[4] = {0.f, 0.f, 0.f, 0.f};
        for (int t0 = 0; t0 < TPI; t0 += PD) {
#pragma unroll
            for (int u = 0; u < PD; ++u, ++g) { const int t = t0 + u;
                const f32x4 v = pf[u];
                { int gn = g + PD; gn = gn < total ? gn : total - 1; int kr2 = kr; OPAQUE_V(kr2); pf[u] = *(const f32x4*)gu_src(p, bid + (gn / TPI) * nb, gn % TPI, kr2, c4); }
#pragma unroll
                for (int j = 0; j < 4; ++j) { am[j] = fmaxf(am[j], fabsf(v[j])); ss[j] += v[j] * v[j]; pan[(c4 + j) * PSF + t * 64 + kr] = v[j]; }
            }
        }
#pragma unroll
        for (int j = 0; j < 4; ++j) {
#pragma unroll
            for (int o = 8; o <= 32; o <<= 1) { am[j] = fmaxf(am[j], __shfl_xor(am[j], o)); ss[j] += __shfl_xor(ss[j], o); }
        }
        if ((lane >> 3) == 0) {
#pragma unroll
            for (int j = 0; j < 4; ++j) { red[(wid * 32 + c4 + j) * 2] = am[j]; red[(wid * 32 + c4 + j) * 2 + 1] = ss[j]; } }
        __syncthreads();
        if (tid < 64) { float a = 0.f, q = 0.f;
            if (tid < 32) {
#pragma unroll
                for (int w = 0; w < 8; ++w) { a = fmaxf(a, red[(w * 32 + tid) * 2]); q += red[(w * 32 + tid) * 2 + 1]; }
                const float sc = a > 0.f ? a * (1.0f / FP8_TOP) : 1.0f; scl[tid] = sc; scl[32 + tid] = 1.0f / sc;
                const int cc = pn * 32 + tid; p->ws_mgu[(size_t)e * 2 * FFE + (cc >> 7) * 256 + (cc & 127) + up * 128] = sc; }
            const float nm = wave_max(tid < 32 ? sqrtf(q) : 0.f);
            if (tid == 0) (void)GLOBAL_ATOMIC_MAX(p->ctrl + (up ? C_UMAX : C_GMAX) + e, __float_as_uint(nm)); }
        __syncthreads();
#pragma unroll
        for (int i2 = 0; i2 < 8; ++i2) { const int n = i2 * 4 + (tid >> 7), k8 = (tid & 127) * 8, cc = pn * 32 + n;
            const f32x4 a = *(LAS const f32x4*)(pan + n * PSF + k8), b = *(LAS const f32x4*)(pan + n * PSF + k8 + 4); const float inv = scl[32 + n];
            u32x2 w; w.x = pack4_fp8(a[0] * inv, a[1] * inv, a[2] * inv, a[3] * inv); w.y = pack4_fp8(b[0] * inv, b[1] * inv, b[2] * inv, b[3] * inv);
            *(u32x2*)(p->w8_mgu + ((size_t)e * 2 * FFE + (cc >> 7) * 256 + (cc & 127) + up * 128) * DM + k8) = w; }
        __syncthreads();
    }
}
template <bool WITH_GDN, bool OUT8 = false, bool SRCB = false>
__device__ __forceinline__ void phase_norm(KPTR p, const void* src, const float* gain, int bid, int nb, int wv) {
    const int tid = opaque_tid(wv), wid = tid >> 6, lane = tid & 63;
    f32x4 gv[4];
#pragma unroll
    for (int i = 0; i < 4; ++i) gv[i] = *(const f32x4*)(gain + i * 256 + lane * 4);
    f32x4 w8[WITH_GDN ? 16 : 1][2];
    if (WITH_GDN) {
#pragma unroll
        for (int i = 0; i < 4; ++i)
#pragma unroll
            for (int e = 0; e < 4; ++e) { const float* wr_ = p->w_in + (size_t)(i * 256 + lane * 4 + e) * DIN + DINP; w8[i * 4 + e][0] = *(const f32x4*)wr_; w8[i * 4 + e][1] = *(const f32x4*)(wr_ + 4); }
    }
    for (int row = bid * 8 + wid; row < NTOK; row += nb * 8) {
        f32x4 v[4]; if (SRCB) load_row_b((const bf16_t*)src, row, lane, v); else load_row((const float*)src, row, lane, v);
        const float rs = row_rstd(v);
#pragma unroll
        for (int i = 0; i < 4; ++i) v[i] = v[i] * rs * gv[i];
        if (OUT8) store_row_fp8((unsigned char*)p->hn, p->hns, row, lane, v); else store_row_bf16(p->hn, row, lane, v);
        if (WITH_GDN) {
            f32x4 d0 = (f32x4){0.f, 0.f, 0.f, 0.f}, d1 = (f32x4){0.f, 0.f, 0.f, 0.f};
#pragma unroll
            for (int i = 0; i < 4; ++i)
#pragma unroll
                for (int e = 0; e < 4; ++e) { const float xv = v[i][e]; d0 = d0 + w8[i * 4 + e][0] * xv; d1 = d1 + w8[i * 4 + e][1] * xv; }
            float d[8] = {d0[0], d0[1], d0[2], d0[3], d1[0], d1[1], d1[2], d1[3]};
#pragma unroll
            for (int j = 0; j < 8; ++j) d[j] = wave_sum(d[j]);
            if (lane < 4) {
                const float braw = lane == 0 ? d[0] : lane == 1 ? d[1] : lane == 2 ? d[2] : d[3];
                const float araw = lane == 0 ? d[4] : lane == 1 ? d[5] : lane == 2 ? d[6] : d[7];
                p->gbeta[(size_t)row * 4 + lane] = 1.0f / (1.0f + __expf(-braw));
                const float z = araw + p->dt_bias[lane];
                const float sp = z > 20.f ? z : log1pf(__expf(z));
                p->gg[(size_t)row * 4 + lane] = -__expf(p->a_log[lane]) * sp;
            }
        }
    }
}

constexpr int IMG_W = 0, IMG_QD = 17408, IMG_KDT = 34816, IMG_AT = 53248, IMG_U = 62464, IMG_CH = 78848;
__host__ __device__ constexpr int permb(int k) { return (k >> 5) * 64 + ((((k & 15) >> 2) * 8) + (((k >> 4) & 1) * 4) + (k & 3)) * 2; }
__device__ __forceinline__ bf16x8 frag2(LAS const unsigned char* ptr) {
    const u32x2 lo = *(LAS const u32x2*)ptr, hi = *(LAS const u32x2*)(ptr + 32);
    u32x4 w; w.x = lo.x; w.y = lo.y; w.z = hi.x; w.w = hi.y; bf16x8 r; __builtin_memcpy(&r, &w, 16); return r;
}
__device__ __forceinline__ bf16x8 pack8(const f32x4 a, const f32x4 b) {
    u32x4 w; w.x = pack2(a[0], a[1]); w.y = pack2(a[2], a[3]); w.z = pack2(b[0], b[1]); w.w = pack2(b[2], b[3]); bf16x8 r; __builtin_memcpy(&r, &w, 16); return r;
}


#ifndef CPU_EMU
__device__ __forceinline__ void st_wt32(void* p, unsigned v) { __hip_atomic_store((unsigned*)p, v, __ATOMIC_RELAXED, __HIP_MEMORY_SCOPE_AGENT); }
__device__ __forceinline__ void st_wt64(void* p, u32x2 v) { unsigned long long x = ((unsigned long long)v.y << 32) | v.x; __hip_atomic_store((unsigned long long*)p, x, __ATOMIC_RELAXED, __HIP_MEMORY_SCOPE_AGENT); }
#else
static inline void st_wt32(void* p, unsigned v) { *(unsigned*)p = v; }
static inline void st_wt64(void* p, u32x2 v) { *(u32x2*)p = v; }
#endif

#ifndef CPU_EMU
__device__ __forceinline__ void gdn_publish(unsigned* flag, int tid) {
    asm volatile("s_waitcnt vmcnt(0)" ::: "memory");
    __syncthreads();
    if (tid == 0) __hip_atomic_store(flag, 1u, __ATOMIC_RELAXED, __HIP_MEMORY_SCOPE_AGENT);
}
__device__ __forceinline__ void gdn_wait8(const unsigned* flags, int c, int nmax, int lane) {
    const int k = c + (lane & 7); const bool need = k < nmax;
    unsigned spins = 0;
    for (;;) {
        const unsigned v = need ? __hip_atomic_load(flags + k, __ATOMIC_RELAXED, __HIP_MEMORY_SCOPE_AGENT) : 1u;
        if (__all(v != 0u)) break;
        __builtin_amdgcn_s_sleep(4); if (++spins > (1u << 22)) break;
    }
    __builtin_amdgcn_fence(__ATOMIC_ACQUIRE, "agent");
}
__device__ __forceinline__ float ld_coherent(const float* p) { return __uint_as_float(__hip_atomic_load((const unsigned*)p, __ATOMIC_RELAXED, __HIP_MEMORY_SCOPE_AGENT)); }
#else
static inline void gdn_publish(unsigned* flag, int tid) { __syncthreads(); if (tid == 0) __atomic_store_n(flag, 1u, __ATOMIC_SEQ_CST); }
static inline void gdn_wait8(const unsigned* flags, int c, int nmax, int lane) { for (int k = c; k < c + 8 && k < nmax; ++k) while (__atomic_load_n(flags + k, __ATOMIC_SEQ_CST) == 0) emu::yield(); }
static inline float ld_coherent(const float* p) { return *p; }
#endif

template <int I> struct TSolve {
    static __device__ __forceinline__ void run(float (&tc)[64], LAS const float* sL, LAS unsigned char* tb, int lane) {
        TSolve<I - 1>::run(tc, sL, tb, lane);
        float p0 = 0.f, p1 = 0.f, p2 = 0.f, p3 = 0.f;
#pragma unroll
        for (int j = 0; j < I; ++j) { const float pr = sL[I * 68 + j] * tc[j]; if ((j & 3) == 0) p0 += pr; else if ((j & 3) == 1) p1 += pr; else if ((j & 3) == 2) p2 += pr; else p3 += pr; }
        const float t2 = ((I == lane) ? 1.f : 0.f) - ((p0 + p1) + (p2 + p3));
        tc[I] = t2; *(LAS bf16_t*)(tb + I * 144 + 2 * lane) = f2bf(t2);
    }
};
template <> struct TSolve<-1> { static __device__ __forceinline__ void run(float (&)[64], LAS const float*, LAS unsigned char*, int) {} };

template <bool PUBLISH>
__device__ __forceinline__ void phase_gdn_pre(KPTR p, LAS unsigned char* lds, int first, int stride, int wv) {
    constexpr int QB = 0, KB = 17408, VBT = 34816, KBT = 53248, KDT = 71680, LF = 90112, TB = 107520, ATB = 116736, SG = 125952, SBE = 126208;
    const int tid0 = opaque_tid(wv);
    LAS float* sL = (LAS float*)(lds + LF); LAS float* sg = (LAS float*)(lds + SG); LAS float* sb = (LAS float*)(lds + SBE);
    const bf16_t* proj = p->proj; const float* conv_w = p->conv_w; const float* gg = p->gg; const float* gbeta = p->gbeta; unsigned char* gimg = p->gimg; float* gcdec = p->gcdec;
    for (int uu = first; uu < NCHH; uu += stride) {
        int tid = tid0; OPAQUE_V(tid);
        const int wid = tid >> 6, lane = tid & 63, fr = lane & 15, q4 = lane >> 4;
        const int n = uu / (BATCH * 4), bh_ = uu % (BATCH * 4), h = bh_ & 3, b = bh_ >> 2;
        const int unit = bh_ * NCH + n;
        const size_t tok0 = (size_t)b * SEQ + (size_t)n * 64;
        unsigned char* img = gimg + (size_t)unit * IMG_CH;
        __syncthreads();
        if (wid == 0) { float gsum = gg[(tok0 + lane) * 4 + h]; for (int o = 1; o < 64; o <<= 1) { const float t2 = __shfl_up(gsum, o); if (lane >= o) gsum += t2; } sg[lane] = gsum; sb[lane] = gbeta[(tok0 + lane) * 4 + h]; }
        __syncthreads();
        const float glast = sg[63];
        unsigned xall[3][11];
#pragma unroll
        for (int w3 = 0; w3 < 3; ++w3) { const int cc = w3 * 512 + h * 128 + 2 * lane;
#pragma unroll
            for (int r = 0; r < 11; ++r) { const int tt = n * 64 + wid * 8 - 3 + r; xall[w3][r] = tt >= 0 ? *(const unsigned*)(proj + ((size_t)b * SEQ + tt) * DINP + 2048 + cc) : 0u; } }
#pragma unroll
        for (int which = 0; which < 3; ++which) {
            const int rb = wid, c0 = which * 512 + h * 128 + 2 * lane;
            float cw0[4], cw1[4];
#pragma unroll
            for (int kk = 0; kk < 4; ++kk) { cw0[kk] = conv_w[kk * 1536 + c0]; cw1[kk] = conv_w[kk * 1536 + c0 + 1]; }
            unsigned xv[11];
#pragma unroll
            for (int r = 0; r < 11; ++r) xv[r] = xall[which][r];
            float a0[8], a1[8], ss[8];
#pragma unroll
            for (int i8 = 0; i8 < 8; ++i8) { float y0 = 0.f, y1 = 0.f;
#pragma unroll
                for (int kk = 0; kk < 4; ++kk) { y0 += cw0[kk] * __uint_as_float(xv[i8 + kk] << 16); y1 += cw1[kk] * __uint_as_float(xv[i8 + kk] & 0xffff0000u); }
                a0[i8] = siluf(y0); a1[i8] = siluf(y1); ss[i8] = a0[i8] * a0[i8] + a1[i8] * a1[i8]; }
            if (which != 2) {
#pragma unroll
                for (int i8 = 0; i8 < 8; ++i8) ss[i8] = wave_sum(ss[i8]);
            }
#pragma unroll
            for (int i8 = 0; i8 < 8; ++i8) {
                const int i = rb * 8 + i8;
                const float gi = sg[i], bi = sb[i], eg = __expf(gi);
                if (which == 2) {
                    *(LAS bf16_t*)(lds + VBT + (2 * lane) * 144 + 2 * i) = f2bf(a0[i8] * bi); *(LAS bf16_t*)(lds + VBT + (2 * lane + 1) * 144 + 2 * i) = f2bf(a1[i8] * bi);
                } else {
                    const float sc = rsqrtf(ss[i8] + NORM_EPS) * (which == 0 ? 0.08838834764831845f : 1.0f);
                    const float n0 = a0[i8] * sc, n1 = a1[i8] * sc;
                    if (which == 0) { *(LAS unsigned*)(lds + QB + i * 272 + 4 * lane) = pack2(n0, n1); st_wt32(img + IMG_QD + i * 272 + permb(2 * lane), pack2(n0 * eg, n1 * eg)); }
                    else { *(LAS unsigned*)(lds + KB + i * 272 + 4 * lane) = pack2(n0, n1);
                        const float f1 = bi * eg, f2 = __expf(glast - gi);
                        *(LAS bf16_t*)(lds + KBT + (2 * lane) * 144 + 2 * i) = f2bf(n0 * f1); *(LAS bf16_t*)(lds + KBT + (2 * lane + 1) * 144 + 2 * i) = f2bf(n1 * f1);
                        *(LAS bf16_t*)(lds + KDT + (2 * lane) * 144 + permb(i)) = f2bf(n0 * f2); *(LAS bf16_t*)(lds + KDT + (2 * lane + 1) * 144 + permb(i)) = f2bf(n1 * f2); }
                }
            }
        }
        __syncthreads();
        {
            const int mat = wid >> 2, itile = wid & 3;
            LAS const unsigned char* abase = lds + (mat == 0 ? KB : QB) + (16 * itile + fr) * 272 + 16 * q4;
            bf16x8 af[4];
#pragma unroll
            for (int s4 = 0; s4 < 4; ++s4) af[s4] = *(LAS const bf16x8*)(abase + 64 * s4);
#pragma unroll
            for (int nt = 0; nt < 4; ++nt) {
                f32x4 acc = (f32x4){0.f, 0.f, 0.f, 0.f};
                if (nt <= itile) {
#pragma unroll
                    for (int s4 = 0; s4 < 4; ++s4) { const bf16x8 bfr = *(LAS const bf16x8*)(lds + KB + (16 * nt + fr) * 272 + 16 * q4 + 64 * s4);
                        acc = __builtin_amdgcn_mfma_f32_16x16x32_bf16(af[s4], bfr, acc, 0, 0, 0); }
                }
                const int j = 16 * nt + fr; const float gj = sg[j];
#pragma unroll
                for (int r = 0; r < 4; ++r) { const int i = 16 * itile + 4 * q4 + r; const float dec = __expf(sg[i] - gj);
                    if (mat == 0) sL[i * 68 + j] = i > j ? sb[i] * acc[r] * dec : 0.f;
                    else *(LAS bf16_t*)(lds + ATB + i * 144 + permb(j)) = f2bf(i >= j ? acc[r] * dec : 0.f); }
            }
        }
        __syncthreads();
        if (wid == 0) {
            float tc[64];
            TSolve<63>::run(tc, sL, lds + TB, lane);
        } else {
            for (int pc = tid - 64; pc < 1152 + 576; pc += NTHREADS - 64) {
                if (pc < 1152) { const u32x4 v4 = *(LAS const u32x4*)(lds + KDT + pc * 16); u32x2 a; a.x = v4.x; a.y = v4.y; u32x2 c; c.x = v4.z; c.y = v4.w; st_wt64(img + IMG_KDT + pc * 16, a); st_wt64(img + IMG_KDT + pc * 16 + 8, c); }
                else { const u32x4 v4 = *(LAS const u32x4*)(lds + ATB + (pc - 1152) * 16); u32x2 a; a.x = v4.x; a.y = v4.y; u32x2 c; c.x = v4.z; c.y = v4.w; st_wt64(img + IMG_AT + (pc - 1152) * 16, a); st_wt64(img + IMG_AT + (pc - 1152) * 16 + 8, c); }
            }
        }
        __syncthreads();
        {
            const int itile = wid & 3;
            bf16x8 tf[2];
#pragma unroll
            for (int s2 = 0; s2 < 2; ++s2) tf[s2] = *(LAS const bf16x8*)(lds + TB + (16 * itile + fr) * 144 + 16 * q4 + 64 * s2);
#pragma unroll
            for (int nt = 0; nt < 8; ++nt) {
                f32x4 acc = (f32x4){0.f, 0.f, 0.f, 0.f};
                if (wid < 4) {
#pragma unroll
                    for (int s2 = 0; s2 < 2; ++s2) { const bf16x8 bfr = *(LAS const bf16x8*)(lds + VBT + (16 * nt + fr) * 144 + 16 * q4 + 64 * s2);
                        acc = __builtin_amdgcn_mfma_f32_16x16x32_bf16(tf[s2], bfr, acc, 0, 0, 0); }
                    u32x2 w; w.x = pack2(acc[0], acc[1]); w.y = pack2(acc[2], acc[3]);
                    st_wt64(img + IMG_U + ((nt * 4 + itile) * 64 + lane) * 8, w);
                } else {
#pragma unroll
                    for (int s2 = 0; s2 < 2; ++s2) { const bf16x8 afr = *(LAS const bf16x8*)(lds + KBT + (16 * nt + fr) * 144 + 16 * q4 + 64 * s2);
                        acc = __builtin_amdgcn_mfma_f32_16x16x32_bf16(afr, tf[s2], acc, 0, 0, 0); }
                    u32x2 w; w.x = pack2(acc[0], acc[1]); w.y = pack2(acc[2], acc[3]);
                    st_wt64(img + IMG_W + (16 * itile + fr) * 272 + permb(16 * nt + 4 * q4), w);
                }
            }
        }
        if (tid == 0) st_wt32(gcdec + unit, __float_as_uint(__expf(glast)));
        if (PUBLISH) gdn_publish(p->gflag + unit, tid);
    }
}

constexpr int NCW = 2, NLT = NTHREADS - 64 * NCW;
constexpr int STG = 62464 + NCW * 2048;
#define LDF(ptr) (*(LAS const bf16x8*)(ptr))
#define MF16(a, b, c) __builtin_amdgcn_mfma_f32_16x16x32_bf16((a), (b), (c), 0, 0, 0)
__device__ __forceinline__ void scan_store_ot(bf16_t* op, const f32x4 (&ao)[4]) {
#pragma unroll
    for (int it = 0; it < 4; ++it) { u32x2 w; w.x = pack2(ao[it][0], ao[it][1]); w.y = pack2(ao[it][2], ao[it][3]); *(u32x2*)(op + (size_t)(16 * it) * DM) = w; }
}
__device__ __forceinline__ void scan_store_o(bf16_t* op, const f32x4 (&ao)[4], int q4) {
#pragma unroll
    for (int it = 0; it < 4; ++it)
#pragma unroll
        for (int r = 0; r < 4; ++r) op[(size_t)(16 * it + 4 * q4 + r) * DM] = f2bf(ao[it][r]);
}
__device__ __forceinline__ bf16x8 asfrag(const u32x4 v) { bf16x8 r; __builtin_memcpy(&r, &v, 16); return r; }
#define LDR(ptr) (*(LAS const u32x4*)(ptr))
template <bool WAITF>
__device__ __forceinline__ void scan_gdn(KPTR p, LAS unsigned char* lds, int b, int h, int qt, int wv) {
    const unsigned* gflag = p->gflag + (size_t)(b * 4 + h) * NCH;
    const int tid = opaque_tid(wv), wid = tid >> 6, lane = tid & 63, fr = lane & 15, q4 = lane >> 4;
    const unsigned char* gimg = p->gimg; const float* gcdec = p->gcdec + (size_t)(b * 4 + h) * NCH; bf16_t* out = p->hn;
    const bool loader = wid >= NCW;
    const int cw = wid, lt = tid - 64 * NCW;
    f32x4 S[8];
#pragma unroll
    for (int dt = 0; dt < 8; ++dt) S[dt] = (f32x4){0.f, 0.f, 0.f, 0.f};
    constexpr int NLG = NLT / 2;
    constexpr int NPC = 3904 + NCW * 128, NPR = (NPC + NLG - 1) / NLG;
    static_assert(NPR >= 16, "compute waves use R[0..7] and R[8..15] as their two operand batches");
    u32x4 R[NPR];
    float cdv = 0.f;
    constexpr int OUTB = 2 * STG, CDB = OUTB + 8192;
    const int grp = lt >= NLG ? 1 : 0, lg_ = lt - grp * NLG;
    const unsigned char* base = gimg + (size_t)(b * 4 + h) * NCH * IMG_CH;
#define GDN_PREFETCH(nn) do { int _lg = lg_; OPAQUE_V(_lg); const unsigned char* _src = base + (size_t)(nn) * IMG_CH; _Pragma("unroll") for (int _i = 0; _i < NPR; ++_i) { int _pc = _lg + NLG * _i; _pc = _pc < NPC ? _pc : NPC - 1; \
        const int _so = _pc < 3904 ? _pc * 16 : IMG_U + qt * (NCW * 2048) + (_pc - 3904) * 16; R[_i] = *(const u32x4*)(_src + _so); } cdv = ld_coherent(gcdec + (nn)); } while (0)
    int avail = 0;
    if (loader && grp < NCH) { if (WAITF) { gdn_wait8(gflag, 0, NCH, lane); avail = 8; } GDN_PREFETCH(grp); }
    float cd_next = 0.f;
    __syncthreads();
    auto load_step = [&](int nn) {
        if (nn < NCH && (nn & 1) == grp) {
            LAS unsigned char* buf = lds + (nn & 1) * STG;
#pragma unroll
            for (int i = 0; i < NPR; ++i) { int pc = lg_ + NLG * i; pc = pc < NPC ? pc : NPC - 1; *(LAS u32x4*)(buf + pc * 16) = R[i]; }
            if (lg_ == 0) *(LAS float*)(lds + CDB + (nn & 1) * 8) = cdv;
            if (nn + 2 < NCH) { if (WAITF && nn + 2 >= avail) { gdn_wait8(gflag, avail, NCH, lane); avail += 8; } GDN_PREFETCH(nn + 2); }
        }
    };
    auto flush = [&](int n) {
        for (int pc = lg_; pc < NCW * 256; pc += NLG) { const int cwi = pc >> 8, it = (pc >> 6) & 3, ln = pc & 63;
            const u32x2 w = *(LAS const u32x2*)(lds + OUTB + (n & 1) * 4096 + pc * 8);
            *(u32x2*)(out + ((size_t)b * SEQ + (size_t)n * 64 + 16 * it + (ln & 15)) * DM + 512 + h * 128 + 16 * (NCW * qt + cwi) + 4 * (ln >> 4)) = w; }
    };
    auto compute = [&](int n) {

            LAS const unsigned char* buf = lds + (n & 1) * STG;
            const float cd = *(LAS const float*)(lds + CDB + (n & 1) * 8);
            LAS const unsigned char* pw = buf + IMG_W + fr * 272 + 16 * q4;
            LAS const unsigned char* pq = buf + IMG_QD + fr * 272 + 16 * q4;
            LAS const unsigned char* pk = buf + IMG_KDT + fr * 144 + 16 * q4;
            LAS const unsigned char* pa = buf + IMG_AT + fr * 144 + 16 * q4;
            bf16x8 Sb[4];
#pragma unroll
            for (int s4 = 0; s4 < 4; ++s4) Sb[s4] = pack8(S[2 * s4], S[2 * s4 + 1]);
            f32x4 ao[4], av[4];
            u32x2 uu[4];
#pragma unroll
            for (int it = 0; it < 4; ++it) uu[it] = *(LAS const u32x2*)(buf + IMG_U + ((cw * 4 + it) * 64 + lane) * 8);
            u32x4* RA = R; u32x4* RB = R + 8;
#define GDN_LD_WQ(RR, it_) do { _Pragma("unroll") for (int s4 = 0; s4 < 4; ++s4) { RR[s4] = LDR(pw + (16 * (it_)) * 272 + 64 * s4); RR[4 + s4] = LDR(pq + (16 * (it_)) * 272 + 64 * s4); } } while (0)
#define GDN_LD_K(RR, dh_) do { _Pragma("unroll") for (int d2 = 0; d2 < 4; ++d2) _Pragma("unroll") for (int s2 = 0; s2 < 2; ++s2) RR[d2 * 2 + s2] = LDR(pk + (16 * (4 * (dh_) + d2)) * 144 + 64 * s2); } while (0)
#define GDN_MM_WQ(RR, it_) do { av[it_] = (f32x4){0.f, 0.f, 0.f, 0.f}; ao[it_] = (f32x4){0.f, 0.f, 0.f, 0.f}; \
        _Pragma("unroll") for (int s4 = 0; s4 < 4; ++s4) { av[it_] = MF16(asfrag(RR[s4]), Sb[s4], av[it_]); ao[it_] = MF16(Sb[s4], asfrag(RR[4 + s4]), ao[it_]); } } while (0)
#define GDN_MM_K(RR, dh_) do { _Pragma("unroll") for (int d2 = 0; d2 < 4; ++d2) { S[4 * (dh_) + d2] = S[4 * (dh_) + d2] * cd; \
        _Pragma("unroll") for (int s2 = 0; s2 < 2; ++s2) S[4 * (dh_) + d2] = MF16(asfrag(RR[d2 * 2 + s2]), Vb[s2], S[4 * (dh_) + d2]); } } while (0)
            GDN_LD_WQ(RA, 0); SCHED_FENCE();
            GDN_LD_WQ(RB, 1); SCHED_FENCE(); GDN_MM_WQ(RA, 0); SCHED_FENCE();
            GDN_LD_WQ(RA, 2); SCHED_FENCE(); GDN_MM_WQ(RB, 1); SCHED_FENCE();
            GDN_LD_WQ(RB, 3); SCHED_FENCE(); GDN_MM_WQ(RA, 2); SCHED_FENCE();
            GDN_LD_K(RA, 0); SCHED_FENCE(); GDN_MM_WQ(RB, 3); SCHED_FENCE();
#pragma unroll
            for (int it = 0; it < 4; ++it) {
                av[it][0] = __uint_as_float(uu[it].x << 16) - av[it][0]; av[it][1] = __uint_as_float(uu[it].x & 0xffff0000u) - av[it][1];
                av[it][2] = __uint_as_float(uu[it].y << 16) - av[it][2]; av[it][3] = __uint_as_float(uu[it].y & 0xffff0000u) - av[it][3]; }
            bf16x8 Vb[2];
#pragma unroll
            for (int s2 = 0; s2 < 2; ++s2) Vb[s2] = pack8(av[2 * s2], av[2 * s2 + 1]);
            GDN_LD_K(RB, 1); SCHED_FENCE(); GDN_MM_K(RA, 0); SCHED_FENCE();
#pragma unroll
            for (int it = 0; it < 4; ++it)
#pragma unroll
                for (int s2 = 0; s2 < 2; ++s2) R[it * 2 + s2] = LDR(pa + (16 * it) * 144 + 64 * s2);
            SCHED_FENCE(); GDN_MM_K(RB, 1); SCHED_FENCE();
#pragma unroll
            for (int it = 0; it < 4; ++it)
#pragma unroll
                for (int s2 = 0; s2 < 2; ++s2) ao[it] = MF16(Vb[s2], asfrag(R[it * 2 + s2]), ao[it]);
#undef GDN_LD_WQ
#undef GDN_LD_K
#undef GDN_MM_WQ
#undef GDN_MM_K
#pragma unroll
            for (int it = 0; it < 4; ++it) { u32x2 w; w.x = pack2(ao[it][0], ao[it][1]); w.y = pack2(ao[it][2], ao[it][3]); *(LAS u32x2*)(lds + OUTB + (n & 1) * 4096 + ((cw * 4 + it) * 64 + lane) * 8) = w; }
            };
    for (int n = -1; n < NCH; ++n) {
        if (loader) { load_step(n + 1); if (n >= 1 && (n & 1) == grp) flush(n - 1); } else if (n >= 0) compute(n);
        __syncthreads();
    }
    if (loader && grp == 0) flush(NCH - 1);
#undef GDN_PREFETCH
}
#ifndef CG_FORCE
#define CG_FORCE 0
#endif
constexpr int CG = CG_FORCE ? CG_FORCE : (NCH >= 256 ? 8 : 4), NG = NCH / CG;
template <int MODE>
__device__ __forceinline__ void scan_ret(KPTR p, LAS unsigned char* lds, int b, int h, int qt, int g, int wv) {
    const int n0 = g * CG;
    constexpr int R_Q = 0, R_K = 17408, R_KDT = 34816, R_VT = 53248;
    constexpr int RAT_OFF = 2 * STG;
    const int tid = opaque_tid(wv), wid = tid >> 6, lane = tid & 63, fr = lane & 15, q4 = lane >> 4;
    const bf16_t* proj = p->proj; bf16_t* out = p->hn; float* Lb = p->retL;
    const bool loader = wid >= NCW;
    const int cw = wid, lt = tid - 64 * NCW;
    const float lg = log1pf(-exp2f(-5.0f - (float)h));
    f32x4 S[8];
#pragma unroll
    for (int dt = 0; dt < 8; ++dt) S[dt] = (f32x4){0.f, 0.f, 0.f, 0.f};
    const float rcd = __expf(lg * 64.f), g1 = __expf(lg);
    if (MODE == 1 && !loader) {
        const float gdec = __expf(lg * (float)(64 * CG)); float wgt = 1.f;
        for (int gp = g - 1; gp >= 0; --gp) {
            const f32x4* lp = (const f32x4*)Lb + ((((size_t)(b * 4 + h) * NG + gp) * (8 / NCW) + qt) * NCW + cw) * 8 * 64 + lane;
#pragma unroll
            for (int dt = 0; dt < 8; ++dt) S[dt] = S[dt] + lp[dt * 64] * wgt;
            wgt *= gdec;
        }
    }
    float gi[4];
#pragma unroll
    for (int t4 = 0; t4 < 4; ++t4) gi[t4] = __expf(lg * (float)(16 * t4 + fr));
    constexpr int NLG = NLT / 2, NQG = (1024 + NLG - 1) / NLG, KB_N = 256 - NLG;
    static_assert(NLG >= 128 && NLG <= 256 && KB_N + 32 * NCW <= NLG, "task slots");
    u32x4 R[NQG + 8 < 16 ? 16 : NQG + 8];
    const int grp = lt >= NLG ? 1 : 0, lg_ = lt - grp * NLG;
#define RET_PREFETCH(nn) do { int _l = lg_; OPAQUE_V(_l); const bf16_t* _pq = proj + ((size_t)b * SEQ + (size_t)(n0 + (nn)) * 64) * DINP + h * 128; \
        _Pragma("unroll") for (int _i = 0; _i < NQG; ++_i) { int _pc = _l + NLG * _i; _pc = _pc < 1024 ? _pc : 1023; const int _row = _pc >> 4, _c = _pc & 15; R[_i] = *(const u32x4*)(_pq + (size_t)_row * DINP + _c * 8); } \
        _Pragma("unroll") for (int _r = 0; _r < 4; ++_r) R[NQG + _r] = *(const u32x4*)(_pq + (size_t)(4 * (_l >> 4) + _r) * DINP + 512 + (_l & 15) * 8); \
        { const bool _isk = _l < KB_N; int _v = _l - KB_N; _v = _v < 0 ? 0 : (_v < 32 * NCW ? _v : 32 * NCW - 1); const int _t = NLG + (_isk ? _l : 0); \
          const int _r0 = _isk ? 4 * (_t >> 4) : 4 * (_v >> 2), _co = _isk ? 512 + (_t & 15) * 8 : 1024 + 16 * NCW * qt + (_v & 3) * 8; \
          _Pragma("unroll") for (int _r = 0; _r < 4; ++_r) R[NQG + 4 + _r] = *(const u32x4*)(_pq + (size_t)(_r0 + _r) * DINP + _co); } } while (0)
#define RET_WRITE_K(RB_, t_) do { const int ig = (t_) >> 4, ck = (t_) & 15; float sc[4]; \
        _Pragma("unroll") for (int r = 0; r < 4; ++r) { sc[r] = 0.08838834764831845f * __expf(lg * (float)(63 - 4 * ig - r)); \
            u32x2 a; a.x = R[(RB_) + r].x; a.y = R[(RB_) + r].y; u32x2 c2; c2.x = R[(RB_) + r].z; c2.y = R[(RB_) + r].w; \
            *(LAS u32x2*)(buf + R_K + (4 * ig + r) * 272 + permb(8 * ck)) = a; *(LAS u32x2*)(buf + R_K + (4 * ig + r) * 272 + permb(8 * ck + 4)) = c2; } \
        _Pragma("unroll") for (int e = 0; e < 8; ++e) { const int wsel = e >> 1; float x[4]; \
            _Pragma("unroll") for (int r = 0; r < 4; ++r) x[r] = ((e & 1) ? __uint_as_float(R[(RB_) + r][wsel] & 0xffff0000u) : __uint_as_float(R[(RB_) + r][wsel] << 16)) * sc[r]; \
            u32x2 o; o.x = pack2(x[0], x[1]); o.y = pack2(x[2], x[3]); *(LAS u32x2*)(buf + R_KDT + (8 * ck + e) * 144 + permb(4 * ig)) = o; } } while (0)
    if (loader && grp < CG) RET_PREFETCH(grp);
    __syncthreads();
    auto load_step = [&](int nn) {
        if (nn < CG && (nn & 1) == grp) {
            LAS unsigned char* buf = lds + (nn & 1) * STG; int l2 = lg_; OPAQUE_V(l2);
#pragma unroll
            for (int i = 0; i < NQG; ++i) { int pc = l2 + NLG * i; pc = pc < 1024 ? pc : 1023; const int row = pc >> 4, c = pc & 15;
                u32x2 a; a.x = R[i].x; a.y = R[i].y; u32x2 c2; c2.x = R[i].z; c2.y = R[i].w;
                *(LAS u32x2*)(buf + R_Q + row * 272 + permb(8 * c)) = a; *(LAS u32x2*)(buf + R_Q + row * 272 + permb(8 * c + 4)) = c2; }
            RET_WRITE_K(NQG, l2);
            if (l2 < KB_N) { RET_WRITE_K(NQG + 4, NLG + l2); }
            else if (l2 < KB_N + 32 * NCW) { const int v = l2 - KB_N, igv = v >> 2, cv = v & 3;
#pragma unroll
                for (int e = 0; e < 8; ++e) { const int wsel = e >> 1, sh = 16 * (e & 1);
                    u32x2 o; o.x = ((R[NQG + 4][wsel] >> sh) & 0xffffu) | (((R[NQG + 5][wsel] >> sh) & 0xffffu) << 16); o.y = ((R[NQG + 6][wsel] >> sh) & 0xffffu) | (((R[NQG + 7][wsel] >> sh) & 0xffffu) << 16);
                    *(LAS u32x2*)(buf + R_VT + (8 * cv + e) * 144 + permb(4 * igv)) = o; } }
            if (nn + 2 < CG) RET_PREFETCH(nn + 2);
        }
    };
    auto scores = [&](int n) {
        LAS const unsigned char* buf = lds + (n & 1) * STG;
        const int lw = wid - NCW;
#pragma unroll
        for (int rep = 0; rep < 2; ++rep) {
            const int tl = lw + (NTHREADS / 64 - NCW) * rep;
            if (tl < 12) {
                int it, jt;
                if (tl < 1) { it = 0; jt = 0; } else if (tl < 3) { it = 1; jt = tl - 1; } else if (tl < 6) { it = 2; jt = tl - 3; } else if (tl < 10) { it = 3; jt = tl - 6; } else if (tl == 10) { it = 0; jt = 1; } else { it = 2; jt = 3; }
                f32x4 acc = (f32x4){0.f, 0.f, 0.f, 0.f};
                if (tl < 10) {
                    bf16x8 kf[4], qf[4];
#pragma unroll
                    for (int s4 = 0; s4 < 4; ++s4) { kf[s4] = LDF(buf + R_K + (16 * jt + fr) * 272 + 64 * s4 + 16 * q4); qf[s4] = LDF(buf + R_Q + (16 * it + fr) * 272 + 64 * s4 + 16 * q4); }
#pragma unroll
                    for (int s4 = 0; s4 < 4; ++s4) acc = MF16(kf[s4], qf[s4], acc);
                    const float gi_ = __expf(lg * (float)(16 * it + fr));
#pragma unroll
                    for (int r = 0; r < 4; ++r) { const int j = 16 * jt + 4 * q4 + r, i = 16 * it + fr;
                        acc[r] = i >= j ? acc[r] * gi_ * 0.08838834764831845f * __expf(-lg * (float)j) : 0.f; }
                }
                u32x2 w; w.x = pack2(acc[0], acc[1]); w.y = pack2(acc[2], acc[3]);
                *(LAS u32x2*)(lds + RAT_OFF + (16 * it + fr) * 144 + permb(16 * jt + 4 * q4)) = w;
            }
        }
    };
    f32x4 ot[4];
    bf16x8 Vf[2];
    auto computeA = [&](int n) {
        LAS const unsigned char* buf = lds + (n & 1) * STG;
        LAS const unsigned char* pq = buf + R_Q + fr * 272 + 16 * q4;
        LAS const unsigned char* pk = buf + R_KDT + fr * 144 + 16 * q4;
        bf16x8 Sb[4];
#pragma unroll
        for (int s4 = 0; s4 < 4; ++s4) Sb[s4] = pack8(S[2 * s4], S[2 * s4 + 1]);
#pragma unroll
        for (int s2 = 0; s2 < 2; ++s2) Vf[s2] = LDF(buf + R_VT + (16 * cw + fr) * 144 + 64 * s2 + 16 * q4);
        u32x4* RA = R; u32x4* RB = R + 8;
#define RET_LD_Q(RR, hh_) do { _Pragma("unroll") for (int i2 = 0; i2 < 2; ++i2) _Pragma("unroll") for (int s4 = 0; s4 < 4; ++s4) RR[i2 * 4 + s4] = LDR(pq + (16 * (2 * (hh_) + i2)) * 272 + 64 * s4); } while (0)
#define RET_LD_K(RR, dh_) do { _Pragma("unroll") for (int d2 = 0; d2 < 4; ++d2) _Pragma("unroll") for (int s2 = 0; s2 < 2; ++s2) RR[d2 * 2 + s2] = LDR(pk + (16 * (4 * (dh_) + d2)) * 144 + 64 * s2); } while (0)
#define RET_MM_Q(RR, hh_) do { _Pragma("unroll") for (int i2 = 0; i2 < 2; ++i2) { const int it = 2 * (hh_) + i2; ot[it] = (f32x4){0.f, 0.f, 0.f, 0.f}; \
        _Pragma("unroll") for (int s4 = 0; s4 < 4; ++s4) ot[it] = MF16(Sb[s4], asfrag(RR[i2 * 4 + s4]), ot[it]); \
        const float rd = gi[it] * g1; _Pragma("unroll") for (int r = 0; r < 4; ++r) ot[it][r] *= rd; } } while (0)
#define RET_MM_K(RR, dh_) do { _Pragma("unroll") for (int d2 = 0; d2 < 4; ++d2) { S[4 * (dh_) + d2] = S[4 * (dh_) + d2] * rcd; \
        _Pragma("unroll") for (int s2 = 0; s2 < 2; ++s2) S[4 * (dh_) + d2] = MF16(asfrag(RR[d2 * 2 + s2]), Vf[s2], S[4 * (dh_) + d2]); } } while (0)
        RET_LD_K(RA, 0); SCHED_FENCE();
        RET_LD_K(RB, 1); SCHED_FENCE(); RET_MM_K(RA, 0); SCHED_FENCE();
        if (MODE == 1) {
            RET_LD_Q(RA, 0); SCHED_FENCE(); RET_MM_K(RB, 1); SCHED_FENCE();
            RET_LD_Q(RB, 1); SCHED_FENCE(); RET_MM_Q(RA, 0); SCHED_FENCE();
            RET_MM_Q(RB, 1);
        } else { RET_MM_K(RB, 1); }
#undef RET_LD_Q
#undef RET_LD_K
#undef RET_MM_Q
#undef RET_MM_K
    };
    auto computeB = [&](int n) {
        LAS const unsigned char* pa = lds + RAT_OFF + fr * 144 + 16 * q4;
        R[0] = LDR(pa); R[1] = LDR(pa + 16 * 144); R[2] = LDR(pa + 32 * 144); R[3] = LDR(pa + 32 * 144 + 64); R[4] = LDR(pa + 48 * 144); R[5] = LDR(pa + 48 * 144 + 64);
        SCHED_FENCE();
        ot[0] = MF16(Vf[0], asfrag(R[0]), ot[0]); ot[1] = MF16(Vf[0], asfrag(R[1]), ot[1]);
        ot[2] = MF16(Vf[0], asfrag(R[2]), ot[2]); ot[2] = MF16(Vf[1], asfrag(R[3]), ot[2]);
        ot[3] = MF16(Vf[0], asfrag(R[4]), ot[3]); ot[3] = MF16(Vf[1], asfrag(R[5]), ot[3]);
        scan_store_ot(out + ((size_t)b * SEQ + (size_t)(n0 + n) * 64 + fr) * DM + h * 128 + 16 * (NCW * qt + cw) + 4 * q4, ot);
    };
    for (int n = -1; n < CG; ++n) {
        if (loader) { if (MODE == 1 && n >= 0) scores(n); load_step(n + 1); } else if (n >= 0) computeA(n);
        __syncthreads();
        if (MODE == 1) {
            if (!loader && n >= 0) computeB(n);
            __syncthreads();
        }
    }
    if (MODE == 0 && !loader) {
        f32x4* lp = (f32x4*)Lb + ((((size_t)(b * 4 + h) * NG + g) * (8 / NCW) + qt) * NCW + cw) * 8 * 64 + lane;
#pragma unroll
        for (int dt = 0; dt < 8; ++dt) lp[dt * 64] = S[dt];
    }
#undef RET_PREFETCH
#undef RET_WRITE_K
}
template <int MODE>
__device__ __forceinline__ void scan_ret_full(KPTR p, LAS unsigned char* lds, int b, int h, int g, int wv) {
    constexpr int F_Q = 0, F_K = 17408, F_KDT = 34816, F_VT = 53248, F_RAT = 71680;
    const int n0 = g * CG;
    const int tid = opaque_tid(wv), wid = tid >> 6, lane = tid & 63, fr = lane & 15, q4 = lane >> 4, cw = wid;
    const bf16_t* proj = p->proj; bf16_t* out = p->hn; float* Lb = p->retL;
    const float lg = log1pf(-exp2f(-5.0f - (float)h));
    const float rcd = __expf(lg * 64.f), g1 = __expf(lg);
    f32x4 S[8];
#pragma unroll
    for (int dt = 0; dt < 8; ++dt) S[dt] = (f32x4){0.f, 0.f, 0.f, 0.f};
    if (MODE == 1) {
        const float gdec = __expf(lg * (float)(64 * CG)); float wgt = 1.f;
        for (int gp = g - 1; gp >= 0; --gp) {
            const f32x4* lp = (const f32x4*)Lb + (((size_t)(b * 4 + h) * NG + gp) * 8 + cw) * 8 * 64 + lane;
#pragma unroll
            for (int dt = 0; dt < 8; ++dt) S[dt] = S[dt] + lp[dt * 64] * wgt;
            wgt *= gdec;
        }
    }
    float gi[4];
#pragma unroll
    for (int t4 = 0; t4 < 4; ++t4) gi[t4] = __expf(lg * (float)(16 * t4 + fr));
    u32x4 rq[2], rkv[4];
#define RF_PREFETCH(nn) do { int _l = tid; OPAQUE_V(_l); const bf16_t* _pq = proj + ((size_t)b * SEQ + (size_t)(n0 + (nn)) * 64) * DINP + h * 128; \
        _Pragma("unroll") for (int _i = 0; _i < 2; ++_i) { const int _pc = _l + NTHREADS * _i; rq[_i] = *(const u32x4*)(_pq + (size_t)(_pc >> 4) * DINP + (_pc & 15) * 8); } \
        { const bool _isk = _l < 256; const int _t = _isk ? _l : _l - 256; const int _r0 = 4 * (_t >> 4), _co = (_isk ? 512 : 1024) + (_t & 15) * 8; \
          _Pragma("unroll") for (int _r = 0; _r < 4; ++_r) rkv[_r] = *(const u32x4*)(_pq + (size_t)(_r0 + _r) * DINP + _co); } } while (0)
    auto write_stage = [&]() {
        int l2 = tid; OPAQUE_V(l2);
#pragma unroll
        for (int i = 0; i < 2; ++i) { const int pc = l2 + NTHREADS * i, row = pc >> 4, c = pc & 15;
            u32x2 a; a.x = rq[i].x; a.y = rq[i].y; u32x2 c2; c2.x = rq[i].z; c2.y = rq[i].w;
            *(LAS u32x2*)(lds + F_Q + row * 272 + permb(8 * c)) = a; *(LAS u32x2*)(lds + F_Q + row * 272 + permb(8 * c + 4)) = c2; }
        if (l2 < 256) { const int ig = l2 >> 4, ck = l2 & 15; float sc[4];
#pragma unroll
            for (int r = 0; r < 4; ++r) { sc[r] = 0.08838834764831845f * __expf(lg * (float)(63 - 4 * ig - r));
                u32x2 a; a.x = rkv[r].x; a.y = rkv[r].y; u32x2 c2; c2.x = rkv[r].z; c2.y = rkv[r].w;
                *(LAS u32x2*)(lds + F_K + (4 * ig + r) * 272 + permb(8 * ck)) = a; *(LAS u32x2*)(lds + F_K + (4 * ig + r) * 272 + permb(8 * ck + 4)) = c2; }
#pragma unroll
            for (int e = 0; e < 8; ++e) { const int wsel = e >> 1; float x[4];
#pragma unroll
                for (int r = 0; r < 4; ++r) x[r] = ((e & 1) ? __uint_as_float(rkv[r][wsel] & 0xffff0000u) : __uint_as_float(rkv[r][wsel] << 16)) * sc[r];
                u32x2 o; o.x = pack2(x[0], x[1]); o.y = pack2(x[2], x[3]); *(LAS u32x2*)(lds + F_KDT + (8 * ck + e) * 144 + permb(4 * ig)) = o; }
        } else { const int v = l2 - 256, igv = v >> 4, cv = v & 15;
#pragma unroll
            for (int e = 0; e < 8; ++e) { const int wsel = e >> 1, sh = 16 * (e & 1);
                u32x2 o; o.x = ((rkv[0][wsel] >> sh) & 0xffffu) | (((rkv[1][wsel] >> sh) & 0xffffu) << 16); o.y = ((rkv[2][wsel] >> sh) & 0xffffu) | (((rkv[3][wsel] >> sh) & 0xffffu) << 16);
                *(LAS u32x2*)(lds + F_VT + (8 * cv + e) * 144 + permb(4 * igv)) = o; } }
    };
    auto scores = [&]() {
#pragma unroll
        for (int rep = 0; rep < 2; ++rep) {
            const int tl = wid + 8 * rep;
            if (tl < 12) {
                int it, jt;
                if (tl < 1) { it = 0; jt = 0; } else if (tl < 3) { it = 1; jt = tl - 1; } else if (tl < 6) { it = 2; jt = tl - 3; } else if (tl < 10) { it = 3; jt = tl - 6; } else if (tl == 10) { it = 0; jt = 1; } else { it = 2; jt = 3; }
                f32x4 acc = (f32x4){0.f, 0.f, 0.f, 0.f};
                if (tl < 10) {
                    bf16x8 kf[4], qf[4];
#pragma unroll
                    for (int s4 = 0; s4 < 4; ++s4) { kf[s4] = LDF(lds + F_K + (16 * jt + fr) * 272 + 64 * s4 + 16 * q4); qf[s4] = LDF(lds + F_Q + (16 * it + fr) * 272 + 64 * s4 + 16 * q4); }
#pragma unroll
                    for (int s4 = 0; s4 < 4; ++s4) acc = MF16(kf[s4], qf[s4], acc);
                    const float gi_ = __expf(lg * (float)(16 * it + fr));
#pragma unroll
                    for (int r = 0; r < 4; ++r) { const int j = 16 * jt + 4 * q4 + r, i = 16 * it + fr;
                        acc[r] = i >= j ? acc[r] * gi_ * 0.08838834764831845f * __expf(-lg * (float)j) : 0.f; }
                }
                u32x2 w; w.x = pack2(acc[0], acc[1]); w.y = pack2(acc[2], acc[3]);
                *(LAS u32x2*)(lds + F_RAT + (16 * it + fr) * 144 + permb(16 * jt + 4 * q4)) = w;
            }
        }
    };
    RF_PREFETCH(0);
    __syncthreads();
    write_stage();
    if (CG > 1) RF_PREFETCH(1);
    __syncthreads();
    for (int n = 0; n < CG; ++n) {
        if (MODE == 1) { scores(); __syncthreads(); }
        {
            LAS const unsigned char* pq = lds + F_Q + fr * 272 + 16 * q4;
            LAS const unsigned char* pk = lds + F_KDT + fr * 144 + 16 * q4;
            bf16x8 Sb[4];
#pragma unroll
            for (int s4 = 0; s4 < 4; ++s4) Sb[s4] = pack8(S[2 * s4], S[2 * s4 + 1]);
            bf16x8 Vf[2];
#pragma unroll
            for (int s2 = 0; s2 < 2; ++s2) Vf[s2] = LDF(lds + F_VT + (16 * cw + fr) * 144 + 64 * s2 + 16 * q4);
            u32x4 RA[8], RB[8];
            f32x4 ot[4];
#define RF_LD_Q(RR, hh_) do { _Pragma("unroll") for (int i2 = 0; i2 < 2; ++i2) _Pragma("unroll") for (int s4 = 0; s4 < 4; ++s4) RR[i2 * 4 + s4] = LDR(pq + (16 * (2 * (hh_) + i2)) * 272 + 64 * s4); } while (0)
#define RF_LD_K(RR, dh_) do { _Pragma("unroll") for (int d2 = 0; d2 < 4; ++d2) _Pragma("unroll") for (int s2 = 0; s2 < 2; ++s2) RR[d2 * 2 + s2] = LDR(pk + (16 * (4 * (dh_) + d2)) * 144 + 64 * s2); } while (0)
#define RF_MM_Q(RR, hh_) do { _Pragma("unroll") for (int i2 = 0; i2 < 2; ++i2) { const int it = 2 * (hh_) + i2; ot[it] = (f32x4){0.f, 0.f, 0.f, 0.f}; \
        _Pragma("unroll") for (int s4 = 0; s4 < 4; ++s4) ot[it] = MF16(Sb[s4], asfrag(RR[i2 * 4 + s4]), ot[it]); \
        const float rd = gi[it] * g1; _Pragma("unroll") for (int r = 0; r < 4; ++r) ot[it][r] *= rd; } } while (0)
#define RF_MM_K(RR, dh_) do { _Pragma("unroll") for (int d2 = 0; d2 < 4; ++d2) { S[4 * (dh_) + d2] = S[4 * (dh_) + d2] * rcd; \
        _Pragma("unroll") for (int s2 = 0; s2 < 2; ++s2) S[4 * (dh_) + d2] = MF16(asfrag(RR[d2 * 2 + s2]), Vf[s2], S[4 * (dh_) + d2]); } } while (0)
            RF_LD_K(RA, 0); SCHED_FENCE();
            RF_LD_K(RB, 1); SCHED_FENCE(); RF_MM_K(RA, 0); SCHED_FENCE();
            if (MODE == 1) {
                RF_LD_Q(RA, 0); SCHED_FENCE(); RF_MM_K(RB, 1); SCHED_FENCE();
                RF_LD_Q(RB, 1); SCHED_FENCE(); RF_MM_Q(RA, 0); SCHED_FENCE();
                RF_MM_Q(RB, 1);
                LAS const unsigned char* pa = lds + F_RAT + fr * 144 + 16 * q4;
                RA[0] = LDR(pa); RA[1] = LDR(pa + 16 * 144); RA[2] = LDR(pa + 32 * 144); RA[3] = LDR(pa + 32 * 144 + 64); RA[4] = LDR(pa + 48 * 144); RA[5] = LDR(pa + 48 * 144 + 64);
                SCHED_FENCE();
                ot[0] = MF16(Vf[0], asfrag(RA[0]), ot[0]); ot[1] = MF16(Vf[0], asfrag(RA[1]), ot[1]);
                ot[2] = MF16(Vf[0], asfrag(RA[2]), ot[2]); ot[2] = MF16(Vf[1], asfrag(RA[3]), ot[2]);
                ot[3] = MF16(Vf[0], asfrag(RA[4]), ot[3]); ot[3] = MF16(Vf[1], asfrag(RA[5]), ot[3]);
                scan_store_ot(out + ((size_t)b * SEQ + (size_t)(n0 + n) * 64 + fr) * DM + h * 128 + 16 * cw + 4 * q4, ot);
            } else { RF_MM_K(RB, 1); }
#undef RF_LD_Q
#undef RF_LD_K
#undef RF_MM_Q
#undef RF_MM_K
        }
        __syncthreads();
        if (n + 1 < CG) { write_stage(); if (n + 2 < CG) RF_PREFETCH(n + 2); }
        __syncthreads();
    }
    if (MODE == 0) {
        f32x4* lp = (f32x4*)Lb + (((size_t)(b * 4 + h) * NG + g) * 8 + cw) * 8 * 64 + lane;
#pragma unroll
        for (int dt = 0; dt < 8; ++dt) lp[dt * 64] = S[dt];
    }
#undef RF_PREFETCH
}

__device__ __forceinline__ void phase_ret_local(KPTR p, LAS unsigned char* lds, int bid, int nb, int wv) {
    constexpr int NIT0 = BATCH * 4 * NG;
    for (int it = bid; it < NIT0; it += nb) {
        const int g = it % NG, bh = it / NG;
        __syncthreads();
        scan_ret_full<0>(p, lds, bh >> 2, bh & 3, g, wv);
    }
}
template <bool OVERLAP>
__device__ __forceinline__ void phase_scan(KPTR p, LAS unsigned char* lds, int bid, int nb, int wv) {
    constexpr int QN = 8 / NCW;
    constexpr int G = BATCH * 4;
    constexpr int NUG = ((G + 7) / 8) * 8 * QN;
    for (int unit = bid; unit < NUG; unit += nb) {
        const int xcd = unit & 7, t = unit >> 3, qt = t % QN, bh = (t / QN) * 8 + xcd;
        if (bh >= G) continue;
        __syncthreads();
        for (int rp = 0; rp < RPT_SG; ++rp) scan_gdn<OVERLAP>(p, lds, bh >> 2, bh & 3, qt, wv);
    }
    if (OVERLAP && bid >= NUG) { __syncthreads(); phase_gdn_pre<true>(p, lds, bid - NUG, nb - NUG, wv); }
    constexpr int NIT1 = G * NG;
    const int first = nb > NUG ? NUG : 0, step = nb > NUG ? nb - NUG : nb;
    if (bid >= first) {
        for (int it = bid - first; it < NIT1; it += step) {
            const int g = it % NG, bh = it / NG;
            __syncthreads();
            for (int rp = 0; rp < RPT_SR; ++rp) scan_ret_full<1>(p, lds, bh >> 2, bh & 3, g, wv);
        }
    }
}

__device__ __forceinline__ void phase_gatednorm(KPTR p, int bid, int nb, int wv) {
    const int tid = opaque_tid(wv), wid = tid >> 6, lane = tid & 63;
    const int hh = lane >> 3, c0 = lane * 16;
    const float* nwp = (hh < 4 ? p->ret_norm + hh * 128 : p->gdn_norm + (hh - 4) * 128) + (lane & 7) * 16;
    float nw[16];
#pragma unroll
    for (int i = 0; i < 4; ++i) { const f32x4 t4 = *(const f32x4*)(nwp + 4 * i); nw[4 * i] = t4[0]; nw[4 * i + 1] = t4[1]; nw[4 * i + 2] = t4[2]; nw[4 * i + 3] = t4[3]; }
    const int gcol = (hh < 4 ? 1536 + hh * 128 : 3584 + (hh - 4) * 128) + (lane & 7) * 16;
    for (int t = bid * 8 + wid; t < NTOK; t += nb * 8) {
        bf16_t* o = p->hn + (size_t)t * DM + c0;
        const u32x4 o0 = *(const u32x4*)o, o1 = *(const u32x4*)(o + 8);
        const bf16_t* gp = p->proj + (size_t)t * DINP + gcol;
        const u32x4 g0 = *(const u32x4*)gp, g1 = *(const u32x4*)(gp + 8);
        float a[16], g[16];
#pragma unroll
        for (int i = 0; i < 4; ++i) { a[2 * i] = __uint_as_float(o0[i] << 16); a[2 * i + 1] = __uint_as_float(o0[i] & 0xffff0000u); a[8 + 2 * i] = __uint_as_float(o1[i] << 16); a[8 + 2 * i + 1] = __uint_as_float(o1[i] & 0xffff0000u);
            g[2 * i] = __uint_as_float(g0[i] << 16); g[2 * i + 1] = __uint_as_float(g0[i] & 0xffff0000u); g[8 + 2 * i] = __uint_as_float(g1[i] << 16); g[8 + 2 * i + 1] = __uint_as_float(g1[i] & 0xffff0000u); }
        float ss = 0.f;
#pragma unroll
        for (int i = 0; i < 16; ++i) ss += a[i] * a[i];
        ss += __shfl_xor(ss, 1); ss += __shfl_xor(ss, 2); ss += __shfl_xor(ss, 4);
        const float rs = rsqrtf(ss * (1.0f / 128.f) + NORM_EPS);
        u32x4 w0, w1;
#pragma unroll
        for (int i = 0; i < 4; ++i) { w0[i] = pack2(a[2 * i] * rs * nw[2 * i] * siluf(g[2 * i]), a[2 * i + 1] * rs * nw[2 * i + 1] * siluf(g[2 * i + 1]));
            w1[i] = pack2(a[8 + 2 * i] * rs * nw[8 + 2 * i] * siluf(g[8 + 2 * i]), a[8 + 2 * i + 1] * rs * nw[8 + 2 * i + 1] * siluf(g[8 + 2 * i + 1])); }
        *(u32x4*)o = w0; *(u32x4*)(o + 8) = w1;
    }
}

__device__ __forceinline__ void phase_kmean(KPTR p, LAS unsigned char* lds, int bid, int nb, int wv) {
    const int tid = opaque_tid(wv);
    LAS float* red = (LAS float*)lds;
    const int rg = tid >> 4, c = tid & 15;
    for (int unit = bid; unit < NIT; unit += nb) {
        const int blk = unit % NBLK, h = (unit / NBLK) & 7, b = unit / (NBLK * 8);
        const bf16_t* kp = p->qkv + ((size_t)b * SEQ + (size_t)blk * 256 + rg) * 3072 + 1024 + h * 128 + c * 8;
        float a[8];
#pragma unroll
        for (int j = 0; j < 8; ++j) a[j] = 0.f;
#pragma unroll
        for (int i = 0; i < 8; ++i) { const u32x4 w = *(const u32x4*)(kp + (size_t)(32 * i) * 3072);
            a[0] += __uint_as_float(w.x << 16); a[1] += __uint_as_float(w.x & 0xffff0000u); a[2] += __uint_as_float(w.y << 16); a[3] += __uint_as_float(w.y & 0xffff0000u);
            a[4] += __uint_as_float(w.z << 16); a[5] += __uint_as_float(w.z & 0xffff0000u); a[6] += __uint_as_float(w.w << 16); a[7] += __uint_as_float(w.w & 0xffff0000u); }
        __syncthreads();
#pragma unroll
        for (int j = 0; j < 8; ++j) red[rg * 128 + c * 8 + j] = a[j];
        __syncthreads();
        if (tid < 128) { float s2 = 0.f;
#pragma unroll
            for (int g = 0; g < 32; ++g) s2 += red[g * 128 + tid];
            s2 *= (1.0f / 256.f);
            const bf16_t hi = f2bf(s2);
            p->kmh[(size_t)unit * 128 + tid] = hi; p->kml[(size_t)unit * 128 + tid] = f2bf(s2 - bf2f(hi)); }
    }
}
__device__ __forceinline__ void phase_moba_select(KPTR p, LAS unsigned char* lds, int bid, int nb, int wv) {
    const int tid = opaque_tid(wv), wid = tid >> 6, lane = tid & 63, fr = lane & 15, fq = lane >> 4;
    LAS float* sg = (LAS float*)lds + wid * (16 * 65);
    LAS unsigned* cnt = (LAS unsigned*)(lds + 8 * 16 * 65 * 4);
    LAS unsigned* gbase = cnt + 64;
    const int TPS = SEQ / 128, NU = BATCH * 8 * TPS;
    const bf16_t* qkv = p->qkv; const bf16_t* kmh = p->kmh; const bf16_t* kml = p->kml; unsigned* mcount = p->mcount; unsigned short* mlist = p->mlist; float* part_lse = p->part_lse;
    for (int unit = bid; unit < NU; unit += nb) {
        const int tile = unit % TPS, h = (unit / TPS) & 7, b = unit / (TPS * 8), bh = b * 8 + h;
        const int t0 = tile * 128 + wid * 16, own = (tile * 128) >> 8;
        if (tid < 64) cnt[tid] = 0u;
        if (own > 0) {
            f32x4 acc[GNT];
#pragma unroll
            for (int nt = 0; nt < GNT; ++nt) acc[nt] = (f32x4){0.f, 0.f, 0.f, 0.f};
            const bf16_t* qrow = qkv + ((size_t)b * SEQ + t0 + fr) * 3072 + h * 128 + 8 * fq;
#pragma unroll
            for (int s4 = 0; s4 < 4; ++s4) {
                const bf16x8 a = *(const bf16x8*)(qrow + 32 * s4);
#pragma unroll
                for (int nt = 0; nt < GNT; ++nt) {
                    int blk = 16 * nt + fr; blk = blk < NBLK ? blk : NBLK - 1;
                    const size_t ko = ((size_t)bh * NBLK + blk) * 128 + 32 * s4 + 8 * fq;
                    const bf16x8 b1 = *(const bf16x8*)(kmh + ko), b2 = *(const bf16x8*)(kml + ko);
                    acc[nt] = __builtin_amdgcn_mfma_f32_16x16x32_bf16(a, b1, acc[nt], 0, 0, 0);
                    acc[nt] = __builtin_amdgcn_mfma_f32_16x16x32_bf16(a, b2, acc[nt], 0, 0, 0);
                }
            }
#pragma unroll
            for (int nt = 0; nt < GNT; ++nt)
#pragma unroll
                for (int r = 0; r < 4; ++r) sg[(4 * fq + r) * 65 + 16 * nt + fr] = acc[nt][r];
        }
        __syncthreads();
        int i0 = -1, i1 = -1, i2 = -1; unsigned r0 = 0, r1 = 0, r2 = 0;
        if (lane < 16) {
            float v0 = -3e38f, v1 = -3e38f, v2 = -3e38f;
            for (int j = 0; j < own; ++j) {
                const float g = sg[lane * 65 + j];
                if (g > v0) { v2 = v1; i2 = i1; v1 = v0; i1 = i0; v0 = g; i0 = j; }
                else if (g > v1) { v2 = v1; i2 = i1; v1 = g; i1 = j; }
                else if (g > v2) { v2 = g; i2 = j; }
            }
            if (i0 >= 0) r0 = LDS_ATOMIC_ADD(cnt + i0, 1u);
            if (i1 >= 0) r1 = LDS_ATOMIC_ADD(cnt + i1, 1u);
            if (i2 >= 0) r2 = LDS_ATOMIC_ADD(cnt + i2, 1u);
        }
        __syncthreads();
        if (tid < 64 && tid < own) { const unsigned c = cnt[tid]; if (c > 0u) gbase[tid] = atomicAdd(mcount + bh * NBLK + tid, c); }
        __syncthreads();
        if (lane < 16) {
            const int t = t0 + lane;
            const size_t pb = ((size_t)((size_t)b * SEQ + t) * 8 + h) * 3;
            unsigned short* lst = mlist + (size_t)bh * LTOT;
            if (i0 >= 0) lst[list_off(i0) + gbase[i0] + r0] = (unsigned short)(((unsigned)t << 2) | 0u); else part_lse[pb + 0] = -1e30f;
            if (i1 >= 0) lst[list_off(i1) + gbase[i1] + r1] = (unsigned short)(((unsigned)t << 2) | 1u); else part_lse[pb + 1] = -1e30f;
            if (i2 >= 0) lst[list_off(i2) + gbase[i2] + r2] = (unsigned short)(((unsigned)t << 2) | 2u); else part_lse[pb + 2] = -1e30f;
        }
    }
}

__device__ __forceinline__ void moba_stage_kv(const bf16_t* qkv, LAS unsigned char* Ks, LAS unsigned char* VTs, int b, int h, int j, int tid) {
    OPAQUE_V(tid);
    const bf16_t* kbase = qkv + ((size_t)b * SEQ + (size_t)j * 256) * 3072 + 1024 + h * 128;
    const bf16_t* vbase = kbase + 1024;
#pragma unroll
    for (int i = 0; i < 8; ++i) { const int id = tid + NTHREADS * i, key = id >> 4, c = id & 15;
        *(LAS u32x4*)(Ks + key * KS_STRIDE + c * 16) = *(const u32x4*)(kbase + (size_t)key * 3072 + c * 8); }
#pragma unroll
    for (int i = 0; i < 2; ++i) { const int id = tid + NTHREADS * i, c = (id & 3) | (((id >> 4) & 3) << 2), g = ((id >> 2) & 3) | ((id >> 6) << 2);
        u32x4 r0 = *(const u32x4*)(vbase + (size_t)(4 * g) * 3072 + c * 8), r1 = *(const u32x4*)(vbase + (size_t)(4 * g + 1) * 3072 + c * 8);
        u32x4 r2 = *(const u32x4*)(vbase + (size_t)(4 * g + 2) * 3072 + c * 8), r3 = *(const u32x4*)(vbase + (size_t)(4 * g + 3) * 3072 + c * 8);
#pragma unroll
        for (int e = 0; e < 8; ++e) { const int wsel = e >> 1, sh = 16 * (e & 1);
            const unsigned x0 = (r0[wsel] >> sh) & 0xffffu, x1 = (r1[wsel] >> sh) & 0xffffu, x2 = (r2[wsel] >> sh) & 0xffffu, x3 = (r3[wsel] >> sh) & 0xffffu;
            u32x2 o; o.x = x0 | (x1 << 16); o.y = x2 | (x3 << 16);
            *(LAS u32x2*)(VTs + (8 * c + e) * VT_STRIDE + 8 * g) = o; }
    }
}
struct AttnState { f32x16 o[4]; float m, l; };
#ifndef CPU_EMU
__device__ __forceinline__ u32x4 swap16(const u32x4 w, int) {
    const u32x2 r0 = __builtin_amdgcn_permlane32_swap(w.x, w.z, false, false), r1 = __builtin_amdgcn_permlane32_swap(w.y, w.w, false, false);
    u32x4 o; o.x = r0.x; o.z = r0.y; o.y = r1.x; o.w = r1.y; return o; }
#else
static inline u32x4 swap16(const u32x4 w, int lane) {
    unsigned a0 = w.x, b0 = w.z, a1 = w.y, b1 = w.w;
    const unsigned a0o = __shfl(a0, lane ^ 32), b0o = __shfl(b0, lane ^ 32), a1o = __shfl(a1, lane ^ 32), b1o = __shfl(b1, lane ^ 32);
    if (lane < 32) { b0 = a0o; b1 = a1o; } else { a0 = b0o; a1 = b1o; }
    u32x4 o; o.x = a0; o.y = a1; o.z = b0; o.w = b1; return o; }
#endif
template <bool CAUSAL>
__device__ __forceinline__ void attn_block(LAS const unsigned char* Ks, LAS const unsigned char* VTs, const bf16x8 (&qf)[8], float bias0, float slope, int qloc, int wtile, int lane, AttnState& st) {
    const int l31 = lane & 31, h2 = lane >> 5;
    constexpr float L2E = 1.4426950408889634f;
    const float scale2 = 0.08838834764831845f * L2E, slope2 = slope * L2E;
    const float bb = __builtin_fmaf(slope2, (float)(4 * h2), bias0 * L2E);
#pragma unroll 1
    for (int hf = 0; hf < 2; ++hf) {
        if (CAUSAL && 4 * hf > wtile) break;
        f32x16 sv[4];
#pragma unroll
        for (int kt = 0; kt < 4; ++kt) {
            const int kt4 = 4 * hf + kt;
            f32x16 acc;
#pragma unroll
            for (int r = 0; r < 16; ++r) acc[r] = 0.f;
            if (!CAUSAL || kt4 <= wtile) {
#pragma unroll
                for (int s8 = 0; s8 < 8; ++s8) { const bf16x8 a = *(LAS const bf16x8*)(Ks + (32 * kt4 + l31) * KS_STRIDE + (16 * s8 + 8 * h2) * 2);
                    acc = __builtin_amdgcn_mfma_f32_32x32x16_bf16(a, qf[s8], acc, 0, 0, 0);
                    if (s8 == 3) SCHED_FENCE(); }
                const float kb = __builtin_fmaf(slope2, (float)(32 * kt4), bb);
#pragma unroll
                for (int r = 0; r < 16; ++r) { const int cr = (r & 3) + 8 * (r >> 2);
                    float v = __builtin_fmaf(acc[r], scale2, __builtin_fmaf(slope2, (float)cr, kb));
                    if (CAUSAL && kt4 == wtile && 32 * kt4 + cr + 4 * h2 > qloc) v = -1e30f;
                    acc[r] = v; }
            } else {
#pragma unroll
                for (int r = 0; r < 16; ++r) acc[r] = -1e30f;
            }
            sv[kt] = acc;
            SCHED_FENCE();
        }
        float mx = -1e30f;
#pragma unroll
        for (int kt = 0; kt < 4; ++kt)
#pragma unroll
            for (int r = 0; r < 16; ++r) mx = fmaxf(mx, sv[kt][r]);
        mx = fmaxf(mx, __shfl_xor(mx, 32));
        const float mnew = fmaxf(st.m, mx);
        const float alpha = __builtin_amdgcn_exp2f(st.m - mnew);
        st.m = mnew;
        float ls = 0.f;
#pragma unroll
        for (int kt = 0; kt < 4; ++kt)
#pragma unroll
            for (int r = 0; r < 16; ++r) { const float pv = __builtin_amdgcn_exp2f(sv[kt][r] - mnew); sv[kt][r] = pv; ls += pv; }
        st.l = st.l * alpha + ls;
#pragma unroll
        for (int dt = 0; dt < 4; ++dt)
#pragma unroll
            for (int r = 0; r < 16; ++r) st.o[dt][r] *= alpha;
#pragma unroll
        for (int kt = 0; kt < 4; ++kt) {
            const int kt4 = 4 * hf + kt;
            if (CAUSAL && kt4 > wtile) continue;
#pragma unroll
            for (int s2 = 0; s2 < 2; ++s2) {
                u32x4 pw; pw.x = pack2(sv[kt][8 * s2 + 0], sv[kt][8 * s2 + 1]); pw.y = pack2(sv[kt][8 * s2 + 2], sv[kt][8 * s2 + 3]); pw.z = pack2(sv[kt][8 * s2 + 4], sv[kt][8 * s2 + 5]); pw.w = pack2(sv[kt][8 * s2 + 6], sv[kt][8 * s2 + 7]);
                bf16x8 pf; __builtin_memcpy(&pf, &pw, 16);
#pragma unroll
                for (int dt = 0; dt < 4; ++dt) {
                    LAS const unsigned char* vp = VTs + (32 * dt + l31) * VT_STRIDE + (32 * kt4 + 16 * s2 + 4 * h2) * 2;
                    const u32x2 lo = *(LAS const u32x2*)vp, hi = *(LAS const u32x2*)(vp + 16);
                    u32x4 aw; aw.x = lo.x; aw.y = lo.y; aw.z = hi.x; aw.w = hi.y;
                    bf16x8 a; __builtin_memcpy(&a, &aw, 16);
                    st.o[dt] = __builtin_amdgcn_mfma_f32_32x32x16_bf16(a, pf, st.o[dt], 0, 0, 0);
                }
                SCHED_FENCE();
            }
        }
    }
}
__device__ __forceinline__ void load_qfrag(const bf16_t* qrow, int h2, bf16x8 (&qf)[8]) {
#pragma unroll
    for (int s8 = 0; s8 < 8; ++s8) qf[s8] = *(const bf16x8*)(qrow + 16 * s8 + 8 * h2);
}

__device__ __forceinline__ void phase_moba_gather(KPTR p, LAS unsigned char* lds, int bid, int nb, int wv) {
#ifndef CPU_EMU
    const int tid = opaque_tid(wv), wid = wv, lane = tid & 63, l31 = lane & 31, h2 = lane >> 5;
#else
    const int tid = opaque_tid(wv), wid = tid >> 6, lane = tid & 63, l31 = lane & 31, h2 = lane >> 5;
#endif
    LAS unsigned char* Ks = lds; LAS unsigned char* VTs = lds + KS_BYTES;
    LAS unsigned* pref = (LAS unsigned*)(lds + KS_BYTES + VT_BYTES);
    LAS unsigned* wsum = pref + NIT + 1;
    const bf16_t* qkv = p->qkv; const unsigned* mcount = p->mcount; const unsigned short* mlist = p->mlist;
    constexpr int IPT = (NIT + NTHREADS - 1) / NTHREADS;
    unsigned loc[IPT]; unsigned tsum = 0;
#pragma unroll
    for (int i = 0; i < IPT; ++i) { const int it = tid * IPT + i; const unsigned c = it < NIT ? mcount[it] : 0u; loc[i] = c ? 1u + 2u * ((c + 255u) >> 8) : 0u; tsum += loc[i]; }
    unsigned inc = tsum;
    for (int o = 1; o < 64; o <<= 1) { const unsigned t2 = __shfl_up(inc, o); if (lane >= o) inc += t2; }
    if (lane == 63) wsum[wid] = inc;
    __syncthreads();
    unsigned wbase = 0;
#pragma unroll
    for (int w = 0; w < 8; ++w) if (w < wid) wbase += wsum[w];
    unsigned run = wbase + inc - tsum;
#pragma unroll
    for (int i = 0; i < IPT; ++i) { const int it = tid * IPT + i; if (it < NIT) pref[it] = run; run += loc[i]; }
    if (tid == NTHREADS - 1) pref[NIT] = run;
    __syncthreads();
    const unsigned C = pref[NIT];
    const unsigned lo = (unsigned)(((unsigned long long)C * (unsigned)bid) / (unsigned)nb), hi = (unsigned)(((unsigned long long)C * (unsigned)(bid + 1)) / (unsigned)nb);
    if (lo >= hi) return;
    int first = 0; { int a = 0, c = NIT; while (c - a > 1) { const int mid = (a + c) >> 1; if (pref[mid] <= lo) a = mid; else c = mid; } first = a; }
    for (int it = first; it < NIT; ++it) {
        const unsigned ps = pref[it], pe = pref[it + 1];
        if (ps >= hi) break;
        if (pe <= lo || pe == ps) continue;
        const unsigned nr = (pe - ps - 1u) >> 1;
        unsigned r_lo = 0; if (lo > ps + 1u) r_lo = (lo - ps - 1u + 1u) >> 1;
        unsigned r_hi = nr; if (hi < ps + 1u + 2u * nr) r_hi = hi > ps + 1u ? (hi - ps - 1u + 1u) >> 1 : 0u;
        if (r_lo >= r_hi) continue;
        const int j = it % NBLK, h = (it / NBLK) & 7, b = it / (NBLK * 8), bh = b * 8 + h;
        const unsigned cnt = mcount[it];
        const unsigned ra = r_lo * 256u, rb = (r_hi * 256u) < cnt ? (r_hi * 256u) : cnt;
        __syncthreads();
        moba_stage_kv(qkv, Ks, VTs, b, h, j, tid);
        __syncthreads();
        const float slope = exp2f(-(float)(h + 1));
        const unsigned short* lst = mlist + (size_t)bh * LTOT + list_off(j);
        unsigned ent_next = 0;
        int l31i = l31; OPAQUE_V(l31i);
        { const unsigned row = ra + 32u * wid + l31i; if (ra + 32u * wid < rb) ent_next = lst[row < rb ? row : (rb - 1)]; }
        for (unsigned r0 = ra + 32u * wid; r0 < rb; r0 += 256u) {
            const unsigned row = r0 + l31i; const bool active = row < rb;
            const unsigned ent = ent_next;
            if (r0 + 256u < rb) { const unsigned rn = row + 256u; ent_next = lst[rn < rb ? rn : (rb - 1)]; }
            const int t = (int)(ent >> 2), k = (int)(ent & 3u);
            int h2q = h2; OPAQUE_V(h2q);
            bf16x8 qf[8]; load_qfrag(qkv + ((size_t)b * SEQ + t) * 3072 + h * 128, h2q, qf);
            AttnState st;
#pragma unroll
            for (int dt = 0; dt < 4; ++dt)
#pragma unroll
                for (int r = 0; r < 16; ++r) st.o[dt][r] = 0.f;
            st.m = -1e30f; st.l = 0.f;
            attn_block<false>(Ks, VTs, qf, slope * (float)(256 * j - t), slope, 0, 0, lane, st);
            const float lt = st.l + __shfl_xor(st.l, 32);
            const float inv = 1.0f / lt;
            {
                const size_t pb = ((size_t)((size_t)b * SEQ + t) * 8 + h) * 3 + k;
                bf16_t* po = p->part_o + pb * 128;
#pragma unroll
                for (int dt = 0; dt < 4; ++dt)
#pragma unroll
                    for (int gp = 0; gp < 4; gp += 2) { u32x4 w;
                        w.x = pack2(st.o[dt][4 * gp] * inv, st.o[dt][4 * gp + 1] * inv); w.y = pack2(st.o[dt][4 * gp + 2] * inv, st.o[dt][4 * gp + 3] * inv);
                        w.z = pack2(st.o[dt][4 * gp + 4] * inv, st.o[dt][4 * gp + 5] * inv); w.w = pack2(st.o[dt][4 * gp + 6] * inv, st.o[dt][4 * gp + 7] * inv);
                        w = swap16(w, lane);
                        if (active) *(u32x4*)(po + 32 * dt + 8 * (gp + h2)) = w; }
                if (active && h2 == 0) p->part_lse[pb] = st.m * 0.6931471805599453f + __logf(lt);
            }
        }
    }
}
__device__ __forceinline__ void phase_moba_own(KPTR p, LAS unsigned char* lds, int bid, int nb, int wv) {
    const int tid = opaque_tid(wv), wid = tid >> 6, lane = tid & 63, l31 = lane & 31, h2 = lane >> 5;
    LAS unsigned char* Ks = lds; LAS unsigned char* VTs = lds + KS_BYTES;
    const bf16_t* qkv = p->qkv; const bf16_t* part_o = p->part_o; const float* part_lse = p->part_lse; bf16_t* out = p->hn;
    for (int it = bid; it < NIT; it += nb) {
        const int j = it % NBLK, h = (it / NBLK) & 7, b = it / (NBLK * 8);
        const float slope = exp2f(-(float)(h + 1));
        const int qloc = 32 * wid + l31, t = j * 256 + qloc;
        bf16x8 qf[8]; load_qfrag(qkv + ((size_t)b * SEQ + t) * 3072 + h * 128, h2, qf);
        __syncthreads();
        moba_stage_kv(qkv, Ks, VTs, b, h, j, tid);
        __syncthreads();
        AttnState st;
#pragma unroll
        for (int dt = 0; dt < 4; ++dt)
#pragma unroll
            for (int r = 0; r < 16; ++r) st.o[dt][r] = 0.f;
        st.m = -1e30f; st.l = 0.f;
        attn_block<true>(Ks, VTs, qf, slope * (float)(-qloc), slope, qloc, wid, lane, st);
        const float lt = st.l + __shfl_xor(st.l, 32);
        const float lse_own = st.m * 0.6931471805599453f + __logf(lt);
        const size_t pb = ((size_t)((size_t)b * SEQ + t) * 8 + h) * 3;
        const float l0 = part_lse[pb], l1 = part_lse[pb + 1], l2 = part_lse[pb + 2];
        const float M = fmaxf(fmaxf(lse_own, l0), fmaxf(l1, l2));
        const float w_own = __expf(lse_own - M), w0 = __expf(l0 - M), w1 = __expf(l1 - M), w2 = __expf(l2 - M);
        const float Wi = 1.0f / (w_own + w0 + w1 + w2);
        const float c_own = w_own * Wi / lt, c0 = w0 * Wi, c1 = w1 * Wi, c2 = w2 * Wi;
        bf16_t* orow = out + ((size_t)b * SEQ + t) * DM + h * 128;
        const bool v0 = l0 > -1e29f, v1 = l1 > -1e29f, v2 = l2 > -1e29f;
#pragma unroll
        for (int dt = 0; dt < 4; ++dt) {
            u32x2 pw[3][4]; u32x4 pq[3][2];
#pragma unroll
            for (int k = 0; k < 3; ++k)
#pragma unroll
                for (int gp = 0; gp < 2; ++gp) pq[k][gp] = *(const u32x4*)(part_o + (pb + k) * 128 + 32 * dt + 8 * (2 * gp + h2));
#pragma unroll
            for (int k = 0; k < 3; ++k)
#pragma unroll
                for (int gp = 0; gp < 2; ++gp) { const u32x4 q = swap16(pq[k][gp], lane); pw[k][2 * gp].x = q.x; pw[k][2 * gp].y = q.y; pw[k][2 * gp + 1].x = q.z; pw[k][2 * gp + 1].y = q.w; }
            u32x2 wo4[4];
#pragma unroll
            for (int g = 0; g < 4; ++g) {
                const int d0 = 32 * dt + 8 * g + 4 * h2;
                float v[4];
#pragma unroll
                for (int e = 0; e < 4; ++e) v[e] = st.o[dt][4 * g + e] * c_own;
#pragma unroll
                for (int k = 0; k < 3; ++k) {
                    const bool vk = k == 0 ? v0 : (k == 1 ? v1 : v2); const float ck = k == 0 ? c0 : (k == 1 ? c1 : c2);
                    const u32x2 w = pw[k][g];
                    const float f0 = __uint_as_float(w.x << 16), f1 = __uint_as_float(w.x & 0xffff0000u), f2 = __uint_as_float(w.y << 16), f3 = __uint_as_float(w.y & 0xffff0000u);
                    v[0] += vk ? ck * f0 : 0.f; v[1] += vk ? ck * f1 : 0.f; v[2] += vk ? ck * f2 : 0.f; v[3] += vk ? ck * f3 : 0.f;
                }
                wo4[g].x = pack2(v[0], v[1]); wo4[g].y = pack2(v[2], v[3]);
            }
#pragma unroll
            for (int gp = 0; gp < 4; gp += 2) { u32x4 w; w.x = wo4[gp].x; w.y = wo4[gp].y; w.z = wo4[gp + 1].x; w.w = wo4[gp + 1].y;
                w = swap16(w, lane);
                *(u32x4*)(orow + 32 * dt + 8 * (gp + h2)) = w; }
        }
    }
}

__device__ __forceinline__ void phase_router(KPTR p, LAS unsigned char* lds, int bid, int nb, int wv) {
    const int tid = opaque_tid(wv), wid = tid >> 6, lane = tid & 63;
    LAS unsigned* hist = (LAS unsigned*)lds;
    if (tid < 8) hist[tid] = 0u;
    __syncthreads();
    f32x4 gv[4];
#pragma unroll
    for (int i = 0; i < 4; ++i) gv[i] = *(const f32x4*)(p->ffn_norm + DM + i * 256 + lane * 4);
    const int rpw = (NTOK + nb - 1) / nb, rbeg = bid * rpw, rend = (rbeg + rpw) < NTOK ? (rbeg + rpw) : NTOK;
    f32x4 w8[16][2];
#pragma unroll
    for (int i = 0; i < 4; ++i)
#pragma unroll
        for (int e = 0; e < 4; ++e) { const float* wr_ = p->w_router + (size_t)(i * 256 + lane * 4 + e) * 8; w8[i * 4 + e][0] = *(const f32x4*)wr_; w8[i * 4 + e][1] = *(const f32x4*)(wr_ + 4); }
    for (int row = rbeg + wid; row < rend; row += 8) {
        f32x4 v[4]; load_row_b(p->hb3, row, lane, v);
        const float rs = row_rstd(v);
#pragma unroll
        for (int i = 0; i < 4; ++i) v[i] = v[i] * rs * gv[i];
        store_row_fp8((unsigned char*)p->hn, p->hns, row, lane, v);
        { float ss = 0.f;
#pragma unroll
          for (int i = 0; i < 4; ++i) ss += v[i][0] * v[i][0] + v[i][1] * v[i][1] + v[i][2] * v[i][2] + v[i][3] * v[i][3];
          ss = wave_sum(ss); if (lane == 0) p->hnn2[row] = ss; }
        f32x4 d0 = (f32x4){0.f, 0.f, 0.f, 0.f}, d1 = (f32x4){0.f, 0.f, 0.f, 0.f};
#pragma unroll
        for (int i = 0; i < 4; ++i)
#pragma unroll
            for (int e = 0; e < 4; ++e) { const float xv = v[i][e]; d0 = d0 + w8[i * 4 + e][0] * xv; d1 = d1 + w8[i * 4 + e][1] * xv; }
        float d[8] = {d0[0], d0[1], d0[2], d0[3], d1[0], d1[1], d1[2], d1[3]};
#pragma unroll
        for (int j = 0; j < 8; ++j) d[j] = wave_sum(d[j]);
        int i0 = 0; float m0 = d[0];
#pragma unroll
        for (int j = 1; j < 8; ++j) if (d[j] > m0) { m0 = d[j]; i0 = j; }
        int i1 = -1; float m1 = -3e38f;
#pragma unroll
        for (int j = 0; j < 8; ++j) if (j != i0 && d[j] > m1) { m1 = d[j]; i1 = j; }
        if (lane == 0) {
            const float e1 = __expf(m1 - m0); const float g0 = 1.0f / (1.0f + e1);
            p->midx[row * 2] = i0; p->midx[row * 2 + 1] = i1; p->mgate[row * 2] = g0; p->mgate[row * 2 + 1] = e1 * g0;
            LDS_ATOMIC_ADD(hist + i0, 1u); LDS_ATOMIC_ADD(hist + i1, 1u);
        }
    }
    __syncthreads();
    if (tid < 8) p->wghist[bid * 8 + tid] = hist[tid];
}
__device__ __forceinline__ void phase_slots(KPTR p, LAS unsigned char* lds, int bid, int nb, int wv) {
    const int tid = opaque_tid(wv);
    LAS unsigned* ltot = (LAS unsigned*)lds; LAS unsigned* lpre = ltot + 8; LAS unsigned* lcur = ltot + 16;
    if (tid < 24) ltot[tid] = 0u;
    __syncthreads();
    { const int e = tid & 7; unsigned tot = 0, pre = 0;
      for (int bb = tid >> 3; bb < nb; bb += NTHREADS / 8) { const unsigned v = p->wghist[bb * 8 + e]; tot += v; if (bb < bid) pre += v; }
      LDS_ATOMIC_ADD(ltot + e, tot); LDS_ATOMIC_ADD(lpre + e, pre); }
    __syncthreads();
    unsigned base[NE], cnt[NE]; unsigned acc = 0; float gu[NE];
#pragma unroll
    for (int e = 0; e < NE; ++e) { cnt[e] = ltot[e]; base[e] = acc; acc += (cnt[e] + 255u) & ~255u; gu[e] = __uint_as_float(p->ctrl[C_GMAX + e]) * __uint_as_float(p->ctrl[C_UMAX + e]); }
    const int rpw = (NTOK + nb - 1) / nb, rbeg = bid * rpw, rend = (rbeg + rpw) < NTOK ? (rbeg + rpw) : NTOK;
    for (int a = rbeg * 2 + tid; a < rend * 2; a += NTHREADS) {
        const int e = p->midx[a];
        unsigned b0 = 0;
#pragma unroll
        for (int j = 0; j < NE; ++j) if (j == e) b0 = base[j];
        const unsigned s = b0 + lpre[e] + LDS_ATOMIC_ADD(lcur + e, 1u);
        p->slot_of[a] = (int)s; p->arow[s] = a >> 1; p->sslot[s] = p->hns[a >> 1];
        float gm = 0.f;
#pragma unroll
        for (int j = 0; j < NE; ++j) if (j == e) gm = gu[j];
        p->shs[s] = p->hnn2[a >> 1] * gm * (1.0f / 256.f);
    }
    if (bid == 0) {
        if (tid == 0) { p->ctrl[C_NTILES] = acc >> 8; p->ctrl[C_TB + NE] = acc >> 8; }
        if (tid < NE) { unsigned bb = 0;
#pragma unroll
            for (int e = 0; e < NE; ++e) if (e == tid) bb = base[e];
            p->ctrl[C_TB + tid] = bb >> 8; }
#pragma unroll
        for (int e = 0; e < NE; ++e) {
            const unsigned lo = base[e] + cnt[e], hi = base[e] + ((cnt[e] + 255u) & ~255u);
            for (unsigned s2 = lo + tid; s2 < hi; s2 += NTHREADS) { p->arow[s2] = 0; p->sslot[s2] = 0.f; p->shs[s2] = 1.0f; }
            for (unsigned t = (base[e] >> 8) + tid; t < (hi >> 8); t += NTHREADS) p->tile_e[t] = e;
        }
    }
}
__device__ __forceinline__ void phase_final(KPTR p, const bf16_t* hsrc, int lo, int hi, int bid, int nb, int wv) {
    const int tid = opaque_tid(wv), wid = tid >> 6, lane = tid & 63;
    f32x4 gv[4];
#pragma unroll
    for (int i = 0; i < 4; ++i) gv[i] = *(const f32x4*)(p->final_norm + i * 256 + lane * 4);
    int sl0 = 0, sl1 = 0; float ga0 = 0.f, ga1 = 0.f;
    { const int row = lo + bid * 8 + wid; if (row < hi) { sl0 = p->slot_of[row * 2]; sl1 = p->slot_of[row * 2 + 1]; ga0 = p->mgate[row * 2]; ga1 = p->mgate[row * 2 + 1]; } }
    for (int row = lo + bid * 8 + wid; row < hi; row += nb * 8) {
        const int s0 = sl0, s1 = sl1; const float g0 = ga0, g1 = ga1;
        u32x2 y0[4], y1[4];
#pragma unroll
        for (int i = 0; i < 4; ++i) { y0[i] = *(const u32x2*)(p->yslot + (size_t)s0 * DM + i * 256 + lane * 4); y1[i] = *(const u32x2*)(p->yslot + (size_t)s1 * DM + i * 256 + lane * 4); }
        f32x4 v[4]; load_row_b(hsrc, row, lane, v);
        { const int rn = row + nb * 8; if (rn < hi) { sl0 = p->slot_of[rn * 2]; sl1 = p->slot_of[rn * 2 + 1]; ga0 = p->mgate[rn * 2]; ga1 = p->mgate[rn * 2 + 1]; } }
#pragma unroll
        for (int i = 0; i < 4; ++i) {
            v[i][0] += g0 * __uint_as_float(y0[i].x << 16) + g1 * __uint_as_float(y1[i].x << 16); v[i][1] += g0 * __uint_as_float(y0[i].x & 0xffff0000u) + g1 * __uint_as_float(y1[i].x & 0xffff0000u);
            v[i][2] += g0 * __uint_as_float(y0[i].y << 16) + g1 * __uint_as_float(y1[i].y << 16); v[i][3] += g0 * __uint_as_float(y0[i].y & 0xffff0000u) + g1 * __uint_as_float(y1[i].y & 0xffff0000u); }
        const float rs = row_rstd(v);
#pragma unroll
        for (int i = 0; i < 4; ++i) *(f32x4*)(p->out + (size_t)row * DM + i * 256 + lane * 4) = v[i] * rs * gv[i];
    }
}


#ifndef CPU_EMU
#define XB_TMO      128
#define XB_XCNT(j)  (256  + 64 * (j))
#define XB_XSUB(j)  (1280 + 64 * (j))
#define XB_XGEN(j)  (2304 + 64 * (j))
#define XB_TOP      3328
#define XB_TOPGEN   3392
#define XCD_BAR_WORDS 3456
#define XB_SPIN_CAP (1u << 20)
__device__ __forceinline__ unsigned xb_ld(unsigned* p) { return __hip_atomic_load(p, __ATOMIC_RELAXED, __HIP_MEMORY_SCOPE_AGENT); }
__device__ __forceinline__ unsigned xb_add(unsigned* p, unsigned v) { return __hip_atomic_fetch_add(p, v, __ATOMIC_RELAXED, __HIP_MEMORY_SCOPE_AGENT); }
__device__ __forceinline__ unsigned xb_xcc_id() { return (unsigned)__builtin_amdgcn_s_getreg((3 << 11) | 20) & 0xFu; }
#define XB_SPIN(cond, bar) do { unsigned _sp = 0; while (cond) { __builtin_amdgcn_s_sleep(1); \
    if ((++_sp & 255u) == 0u) { if (xb_ld(&(bar)[XB_TMO])) break; if (_sp > XB_SPIN_CAP) { atomicAdd(&(bar)[XB_TMO], 1u); break; } } } } while (0)
__device__ __forceinline__ void xcd_barrier_post(unsigned* bar, int tid) { if (tid == 0) (void)xb_add(&bar[XB_XCNT(xb_xcc_id())], 1u); }
__device__ __forceinline__ void xcd_barrier_complete(unsigned* bar, unsigned x, unsigned& nloc, unsigned& nx) {
    const unsigned G = gridDim.x * gridDim.y * gridDim.z;
    unsigned sum, cnt, mine, sp = 0u;
    for (;;) {
        sum = 0u; cnt = 0u; mine = 0u;
#pragma unroll
        for (unsigned j = 0; j < 16; ++j) { const unsigned c = xb_ld(&bar[XB_XCNT(j)]); sum += c; cnt += (c > 0u) ? 1u : 0u; mine = (j == x) ? c : mine; }
        if (sum == G) break;
        __builtin_amdgcn_s_sleep(1);
        if ((++sp & 255u) == 0u) { if (xb_ld(&bar[XB_TMO])) break; if (sp > XB_SPIN_CAP) { atomicAdd(&bar[XB_TMO], 1u); break; } }
    }
    nloc = mine > 0u ? mine : 1u; nx = cnt > 0u ? cnt : 1u;
}
__device__ __forceinline__ void xcd_barrier(unsigned* bar, volatile LAS unsigned* st, int tid) {
    asm volatile("s_waitcnt vmcnt(0)" ::: "memory");
    __syncthreads();
    if (tid == 0) {
        __builtin_amdgcn_s_waitcnt(0);
        const unsigned x = xb_xcc_id();
        unsigned nloc = st[0], nx = st[1];
        if (nloc == 0u) { xcd_barrier_complete(bar, x, nloc, nx); st[0] = nloc; st[1] = nx; }
        const unsigned old = xb_add(&bar[XB_XSUB(x)], 1u);
        const unsigned gen = old / nloc;
        if (old + 1u == (gen + 1u) * nloc) {
            __builtin_amdgcn_fence(__ATOMIC_RELEASE, "agent");
            asm volatile("s_waitcnt vmcnt(0)" ::: "memory");
            const unsigned og = xb_add(&bar[XB_TOP], 1u);
            const unsigned tg = og / nx;
            if (og + 1u == (tg + 1u) * nx) xb_add(&bar[XB_TOPGEN], 1u);
            else XB_SPIN(xb_ld(&bar[XB_TOPGEN]) == tg, bar);
            __builtin_amdgcn_fence(__ATOMIC_ACQUIRE, "agent");
            xb_add(&bar[XB_XGEN(x)], 1u);
            asm volatile("s_waitcnt vmcnt(0)" ::: "memory");
        } else {
            XB_SPIN(xb_ld(&bar[XB_XGEN(x)]) == gen, bar);
            __builtin_amdgcn_fence(__ATOMIC_ACQUIRE, "agent");
            asm volatile("s_waitcnt vmcnt(0)" ::: "memory");
        }
    }
    __syncthreads();
}
#define GRID_BARRIER() do { unsigned* _bar = p->bar; xcd_barrier(_bar, (volatile LAS unsigned*)(lds + kDynLds - 16), opaque_tid(wv)); } while (0)
#else
#define XCD_BAR_WORDS 3456
#define GRID_BARRIER() emu::grid_sync()
#endif

#ifndef CPU_EMU
extern __shared__ __attribute__((aligned(16))) unsigned char smem_raw[];
#define GET_LDS() ((LAS unsigned char*)smem_raw)
#else
#define GET_LDS() (emu::blk->smem)
#endif

__global__ void __launch_bounds__(NTHREADS) fwd_megakernel(Params p_arg) {
    cg::grid_group grid = cg::this_grid();
    KPTR p = KARG_PTR(p_arg);
    LAS unsigned char* lds = GET_LDS();
#ifndef CPU_EMU
    const int wv = __builtin_amdgcn_readfirstlane((int)(threadIdx.x >> 6));
#else
    const int wv = 0;
#endif
    const int bid = blockIdx.x, nb = gridDim.x, tid = opaque_tid(wv);
#ifndef CPU_EMU
    if (tid == 0) { volatile LAS unsigned* st = (volatile LAS unsigned*)(lds + kDynLds - 16); st[0] = 0u; st[1] = 0u; }
    __syncthreads();
    xcd_barrier_post(p->bar, tid);
#endif
    LAUNDER(p);
    if (bid == 0 && tid < 256) p->ctrl[tid] = 0u;
    for (int i = bid * NTHREADS + tid; i < NIT; i += nb * NTHREADS) p->mcount[i] = 0u;
    for (int i = bid * NTHREADS + tid; i < NCHH; i += nb * NTHREADS) p->gflag[i] = 0u;
    convert_wt(lds, p->w_in, DM, DIN, 0, DINP, p->wt_in, 128, 0, bid, nb, wv);
    convert_wt(lds, p->w_out0, DM, DM, 0, DM, p->wt_out0, 128, 0, bid, nb, wv);
    convert_wt(lds, p->w_gate0, DM, FF, 0, FF, p->wt_gu0, 256, 0, bid, nb, wv);
    convert_wt(lds, p->w_up0, DM, FF, 0, FF, p->wt_gu0, 256, 128, bid, nb, wv);
    convert_wt(lds, p->w_down0, FF, DM, 0, DM, p->wt_d0, 128, 0, bid, nb, wv);
    convert_wt(lds, p->w_qkv, DM, 3072, 0, 3072, p->wt_qkv, 128, 0, bid, nb, wv);
    convert_wt(lds, p->w_out1, DM, DM, 0, DM, p->wt_out1, 128, 0, bid, nb, wv);
    phase_norm<true>(p, p->x, p->mix_norm, bid, nb, wv);
    if (p->pad0 != 0) grid.sync(); else GRID_BARRIER();
    LAUNDER(p);
    for (int rp = 0; rp < RPT_GEMM; ++rp) { StaticOrder so; so.init(NTOK / 256, DINP / 256, nb, bid); Gemm g{p->hn, p->wt_in, nullptr}; EpiBf16 e{p->proj, DINP, 0}; gemm_phase<DM>(lds, g, so, e, wv); }
    GRID_BARRIER();
    LAUNDER(p);
    constexpr int NUG_ = ((BATCH * 4 + 7) / 8) * 8 * (8 / NCW);
    const bool overlap = nb >= NUG_ + 32;
    if (!overlap) phase_gdn_pre<false>(p, lds, bid, nb, wv);
    phase_ret_local(p, lds, bid, nb, wv);
    GRID_BARRIER();
    LAUNDER(p);
    if (overlap) phase_scan<true>(p, lds, bid, nb, wv); else phase_scan<false>(p, lds, bid, nb, wv);
    GRID_BARRIER();
    LAUNDER(p);
    phase_gatednorm(p, bid, nb, wv);
    GRID_BARRIER();
    LAUNDER(p);
    { StaticOrder so; so.init(NTOK / 256, DM / 256, nb, bid); Gemm g{p->hn, p->wt_out0, nullptr}; EpiResBf16<true> e{p->x, nullptr, p->hb}; gemm_phase<DM>(lds, g, so, e, wv); }
    GRID_BARRIER();
    LAUNDER(p);
#if FP8_FFN0
    phase_norm<false, true, true>(p, p->hb, p->ffn_norm, bid, nb, wv);
    quant_rows<DM, false>(p, lds, p->wt_gu0, p->w8_gu0, p->ws_gu0, 2 * FF, bid, nb, wv);
#else
    phase_norm<false, false, true>(p, p->hb, p->ffn_norm, bid, nb, wv);
#endif
    GRID_BARRIER();
    LAUNDER(p);
#if FP8_FFN0
    for (int rp = 0; rp < RPT_GEMM; ++rp) { StaticOrder so; so.init(NTOK / 256, 2 * FF / 256, nb, bid); Gemm g{p->hn, (const bf16_t*)p->w8_gu0, nullptr}; EpiSwigluS e{p->act0, FF, 0, p->hns, p->ws_gu0}; gemm_phase<DM, EpiSwigluS, StaticOrder, true>(lds, g, so, e, wv); }
#else
    for (int rp = 0; rp < RPT_GEMM; ++rp) { StaticOrder so; so.init(NTOK / 256, 2 * FF / 256, nb, bid); Gemm g{p->hn, p->wt_gu0, nullptr}; EpiSwiglu e{p->act0, FF, 0}; gemm_phase<DM>(lds, g, so, e, wv); }
#endif
    GRID_BARRIER();
    LAUNDER(p);
    { StaticOrder so; so.init(NTOK / 256, DM / 256, nb, bid); Gemm g{p->act0, p->wt_d0, nullptr}; EpiResBf16<false> e{nullptr, p->hb, p->hb}; gemm_phase<FF>(lds, g, so, e, wv); }
    GRID_BARRIER();
    LAUNDER(p);
    phase_norm<false, false, true>(p, p->hb, p->mix_norm + DM, bid, nb, wv);
    GRID_BARRIER();
    LAUNDER(p);
    for (int rp = 0; rp < RPT_GEMM; ++rp) { StaticOrder so; so.init(NTOK / 256, 3072 / 256, nb, bid); Gemm g{p->hn, p->wt_qkv, nullptr}; EpiBf16 e{p->qkv, 3072, 0}; gemm_phase<DM>(lds, g, so, e, wv); }
    GRID_BARRIER();
    LAUNDER(p);
    phase_kmean(p, lds, bid, nb, wv);
    GRID_BARRIER();
    LAUNDER(p);
    phase_moba_select(p, lds, bid, nb, wv);
    GRID_BARRIER();
    LAUNDER(p);
    for (int rp = 0; rp < RPT_MG; ++rp) phase_moba_gather(p, lds, bid, nb, wv);
    GRID_BARRIER();
    LAUNDER(p);
    for (int rp = 0; rp < RPT_MO; ++rp) phase_moba_own(p, lds, bid, nb, wv);
    GRID_BARRIER();
    LAUNDER(p);
    convert_gu_fp8(p, lds, bid, nb, wv);
    for (int rp = 0; rp < RPT_CONV; ++rp) for (int e = 0; e < NE; ++e) {
        convert_wt(lds, p->w_mdown + (size_t)e * FFE * DM, FFE, DM, 0, DM, p->wt_md_tmp + (size_t)e * DM * FFE, 128, 0, bid, nb, wv);
    }
    { StaticOrder so; so.init(NTOK / 256, DM / 256, nb, bid); Gemm g{p->hn, p->wt_out1, nullptr}; EpiResBf16<false> e{nullptr, p->hb, p->hb3}; gemm_phase<DM>(lds, g, so, e, wv); }
    GRID_BARRIER();
    LAUNDER(p);
    phase_router(p, lds, bid, nb, wv);
    quant_rows<FFE, false>(p, lds, p->wt_md_tmp, p->w8_md, p->ws_md, NE * DM, bid, nb, wv);
    GRID_BARRIER();
    LAUNDER(p);
    phase_slots(p, lds, bid, nb, wv);
    GRID_BARRIER();
    LAUNDER(p);
    {
        const int ntiles = (int)p->ctrl[C_NTILES];
        const int npass = (ntiles + p->tiles_per_pass - 1) / p->tiles_per_pass;
        const int tpp = npass > 0 ? (ntiles + npass - 1) / npass : 1;
        const size_t mbuf = (size_t)p->tiles_per_pass * 256 * FFE; int q = 0;
        for (int t0 = 0; t0 < ntiles; t0 += tpp, ++q) {
            const int nM = (ntiles - t0) < tpp ? (ntiles - t0) : tpp;
            unsigned char* mb = (unsigned char*)p->mact + (size_t)(q & 1) * mbuf;
            for (int rp = 0; rp < RPT_GEMM; ++rp) { MoeOrder mo; mo.init(t0, nM, 2 * FFE / 256, p->tile_e, nb, bid); Gemm g{p->hn, (const bf16_t*)p->w8_mgu, p->arow}; EpiSwigluS8 e{mb, FFE, t0 * 256, p->sslot, p->ws_mgu, p->shs}; gemm_phase<DM, EpiSwigluS8, MoeOrder, true>(lds, g, mo, e, wv); }
            GRID_BARRIER();
            for (int rp = 0; rp < RPT_GEMM; ++rp) { MoeOrder mo; mo.init(t0, nM, DM / 256, p->tile_e, nb, bid); Gemm g{(const bf16_t*)((const unsigned char*)mb - (size_t)t0 * 256 * FFE), (const bf16_t*)p->w8_md, nullptr}; EpiBf16S e{p->yslot, DM, p->shs, p->ws_md}; gemm_phase<FFE, EpiBf16S, MoeOrder, true>(lds, g, mo, e, wv); }
        }
        GRID_BARRIER();
    }
    LAUNDER(p);
    phase_final(p, p->hb3, 0, NTOK, bid, nb, wv);
}

static inline size_t al256(size_t x) { return (x + 255) & ~(size_t)255; }

extern "C" void kernel_launch(void* const* d_in, const int* in_sizes, int n_in, void* d_out, int out_size, void* d_ws, size_t ws_size, hipStream_t stream) {
    Params p; memset(&p, 0, sizeof(p));
    p.x = (const float*)d_in[0]; p.mix_norm = (const float*)d_in[1]; p.ffn_norm = (const float*)d_in[2]; p.w_in = (const float*)d_in[3]; p.conv_w = (const float*)d_in[4];
    p.a_log = (const float*)d_in[5]; p.dt_bias = (const float*)d_in[6]; p.ret_norm = (const float*)d_in[7]; p.gdn_norm = (const float*)d_in[8]; p.w_out0 = (const float*)d_in[9];
    p.w_qkv = (const float*)d_in[10]; p.w_out1 = (const float*)d_in[11]; p.w_gate0 = (const float*)d_in[12]; p.w_up0 = (const float*)d_in[13]; p.w_down0 = (const float*)d_in[14];
    p.w_router = (const float*)d_in[15]; p.w_mgate = (const float*)d_in[16]; p.w_mup = (const float*)d_in[17]; p.w_mdown = (const float*)d_in[18]; p.final_norm = (const float*)d_in[19];
    p.out = (float*)d_out; p.hb = (bf16_t*)((unsigned char*)d_out + (size_t)NTOK * DM * 2);
    unsigned char* w = (unsigned char*)d_ws; size_t off = 0;
    auto take = [&](size_t bytes) { unsigned char* r = w + off; off += al256(bytes); return r; };
    p.ctrl = (unsigned*)take(4096); p.bar = (unsigned*)take((size_t)XCD_BAR_WORDS * 4);
    p.wt_in = (bf16_t*)take((size_t)DINP * DM * 2); p.wt_out0 = (bf16_t*)take((size_t)DM * DM * 2); p.wt_gu0 = (bf16_t*)take((size_t)2 * FF * DM * 2); p.wt_d0 = (bf16_t*)take((size_t)DM * FF * 2);
    p.wt_qkv = (bf16_t*)take((size_t)3072 * DM * 2); p.wt_out1 = (bf16_t*)take((size_t)DM * DM * 2);
    p.hn = (bf16_t*)take((size_t)NTOK * DM * 2);
    p.gflag = (unsigned*)take((size_t)NCHH * 4);
    p.retL = (float*)take((size_t)BATCH * 4 * NG * 128 * 128 * 4);
    p.gbeta = (float*)take((size_t)NTOK * 4 * 4); p.gg = (float*)take((size_t)NTOK * 4 * 4);
    p.arow = (int*)take((size_t)MAXTILES * 256 * 4); p.tile_e = (int*)take((size_t)MAXTILES * 4); p.slot_of = (int*)take((size_t)NTOK * 2 * 4); p.mgate = (float*)take((size_t)NTOK * 2 * 4); p.midx = (int*)take((size_t)NTOK * 2 * 4); p.wghist = (unsigned*)take((size_t)4096 * 8 * 4);
    p.w8_gu0 = take(FP8_FFN0 ? (size_t)2 * FF * DM : (size_t)256); p.ws_gu0 = (float*)take((size_t)2 * FF * 4); p.ws_mgu = (float*)take((size_t)NE * 2 * FFE * 4); p.hns = (float*)take((size_t)NTOK * 4); p.sslot = (float*)take((size_t)MAXTILES * 256 * 4);
    p.ws_md = (float*)take((size_t)NE * DM * 4); p.hnn2 = (float*)take((size_t)NTOK * 4); p.shs = (float*)take((size_t)MAXTILES * 256 * 4);
    p.kmh = (bf16_t*)take((size_t)NIT * 128 * 2); p.kml = (bf16_t*)take((size_t)NIT * 128 * 2); p.mcount = (unsigned*)take((size_t)NIT * 4);
    p.arena = w + off;
    const size_t arena_bytes = ws_size - off;
    { size_t a = 0; auto at = [&](size_t bytes) { unsigned char* r = p.arena + a; a += al256(bytes); return r; };
      p.proj = (bf16_t*)at((size_t)NTOK * DINP * 2);
      p.gimg = (unsigned char*)at((size_t)NCHH * IMG_CH); p.gcdec = (float*)at((size_t)NCHH * 4);
      if (a > arena_bytes) fprintf(stderr, "workspace too small (layer0): need %zu have %zu\n", a, arena_bytes); }
    p.act0 = (bf16_t*)p.arena;
    { size_t a = 0; auto at = [&](size_t bytes) { unsigned char* r = p.arena + a; a += al256(bytes); return r; };
      p.qkv = (bf16_t*)at((size_t)NTOK * 3072 * 2); p.part_o = (bf16_t*)at((size_t)NTOK * 8 * 3 * 128 * 2); p.part_lse = (float*)at((size_t)NTOK * 8 * 3 * 4); p.mlist = (unsigned short*)at((size_t)BATCH * 8 * LTOT * 2);
      if (a > arena_bytes) fprintf(stderr, "workspace too small (layer1): need %zu have %zu\n", a, arena_bytes); }
    { size_t a = 0; auto at = [&](size_t bytes) { unsigned char* r = p.arena + a; a += al256(bytes); return r; };
      p.w8_mgu = at((size_t)NE * 2 * FFE * DM); p.w8_md = at((size_t)NE * DM * FFE); p.yslot = (bf16_t*)at((size_t)MAXTILES * 256 * DM * 2);
      p.hb3 = (bf16_t*)at((size_t)NTOK * DM * 2);
      p.mact = (bf16_t*)(p.arena + a);
      p.wt_mgu = nullptr; p.wt_md_tmp = p.mact; p.wt_md = nullptr;
      const size_t rest = arena_bytes > a ? arena_bytes - a : 0;
      if (rest < (size_t)NE * FFE * DM * 2) fprintf(stderr, "workspace too small (moe weights)\n");
      long tiles = (long)(rest / ((size_t)2 * 256 * FFE));
      if (tiles > 64) tiles = 64;
      if (tiles < 1) { fprintf(stderr, "workspace too small (moe)\n"); tiles = 1; }
#ifdef CPU_EMU
      if (getenv("EMU_TPP")) tiles = atoi(getenv("EMU_TPP"));
#endif
      p.tiles_per_pass = (int)tiles; }
#ifdef CPU_EMU
    emu::reg("hn", p.hn, (size_t)NTOK * DM * 2, "bf16"); emu::reg("proj", p.proj, (size_t)NTOK * DINP * 2, "bf16");
    emu::reg("gbeta", p.gbeta, (size_t)NTOK * 16, "f32"); emu::reg("gg", p.gg, (size_t)NTOK * 16, "f32"); emu::reg("midx", p.midx, (size_t)NTOK * 8, "i32");
    const int grid_blocks = getenv("EMU_GRID") ? atoi(getenv("EMU_GRID")) : 8;
    emu::launch(grid_blocks, NTHREADS, kDynLds, [=]() { fwd_megakernel(p); }, true);
#else
    static int grid_blocks = 0;
    if (!grid_blocks) {
        int dev = 0, cus = 0, per_cu = 0;
        (void)hipGetDevice(&dev);
        (void)hipDeviceGetAttribute(&cus, hipDeviceAttributeMultiprocessorCount, dev);
        (void)hipFuncSetAttribute((const void*)fwd_megakernel, hipFuncAttributeMaxDynamicSharedMemorySize, (int)kDynLds);
        (void)hipOccupancyMaxActiveBlocksPerMultiprocessor(&per_cu, fwd_megakernel, NTHREADS, kDynLds);
        if (per_cu < 1) per_cu = 1;
        grid_blocks = cus;
    }
    (void)hipMemsetAsync(p.bar, 0, (size_t)XCD_BAR_WORDS * 4, stream);
    void* args[] = {&p};
    hipError_t e = hipLaunchCooperativeKernel((const void*)fwd_megakernel, dim3(grid_blocks), dim3(NTHREADS), args, kDynLds, stream);
    if (e != hipSuccess) fprintf(stderr, "cooperative launch failed: %s (grid %d)\n", hipGetErrorString(e), grid_blocks);
#endif
}
```

```cpp
#ifndef CPU_EMU
#include <hip/hip_runtime.h>
#include <hip/hip_cooperative_groups.h>
#include <cstdio>
#include <cstring>
#define LAS __attribute__((address_space(3)))
#define WAVE_SYNC() __builtin_amdgcn_wave_barrier()
#define SCHED_FENCE() __builtin_amdgcn_sched_barrier(0)
#define OPAQUE_V(x) asm volatile("" : "+v"(x))
static __device__ __forceinline__ unsigned shfl_up_u(unsigned v, int o, int lane) { const int src = lane >= o ? lane - o : lane; return (unsigned)__builtin_amdgcn_ds_bpermute(src << 2, (int)v); }
static __device__ __forceinline__ float shfl_up_f(float v, int o, int lane) { return __uint_as_float(shfl_up_u(__float_as_uint(v), o, lane)); }
#define LDS_ATOMIC_ADD(ptr, v) __hip_atomic_fetch_add((ptr), (v), __ATOMIC_RELAXED, __HIP_MEMORY_SCOPE_WORKGROUP)
#define LDS_ATOMIC_MAX(ptr, v) __hip_atomic_fetch_max((ptr), (v), __ATOMIC_RELAXED, __HIP_MEMORY_SCOPE_WORKGROUP)
#define GLOBAL_ATOMIC_MAX(ptr, v) __hip_atomic_fetch_max((ptr), (v), __ATOMIC_RELAXED, __HIP_MEMORY_SCOPE_AGENT)
static __device__ __forceinline__ int opaque_tid(int wv) { int l; asm volatile("v_mbcnt_lo_u32_b32 %0, -1, 0\n\tv_mbcnt_hi_u32_b32 %0, -1, %0" : "=v"(l)); return (wv << 6) | l; }
#else
static inline int opaque_tid(int) { return threadIdx.x; }
#define LAS
#define WAVE_SYNC() ((void)__ballot(1))
#define SCHED_FENCE() ((void)0)
#define OPAQUE_V(x) ((void)0)
static inline unsigned shfl_up_u(unsigned v, int o, int lane) { return __shfl(v, lane >= o ? lane - o : lane); }
static inline float shfl_up_f(float v, int o, int lane) { return __shfl(v, lane >= o ? lane - o : lane); }
static inline unsigned emu_fetch_add(unsigned* p, unsigned v) { unsigned o = *p; *p = o + v; return o; }
#define LDS_ATOMIC_ADD(ptr, v) emu_fetch_add((ptr), (v))
static inline unsigned emu_fetch_max(unsigned* p, unsigned v) { unsigned o = *p; if (v > o) *p = v; return o; }
#define LDS_ATOMIC_MAX(ptr, v) emu_fetch_max((ptr), (v))
#define GLOBAL_ATOMIC_MAX(ptr, v) atomicMax((ptr), (v))
#endif
namespace cg = cooperative_groups;

#ifndef RPT_SYNC
#define RPT_SYNC 0
#endif
#ifndef RPT_SG
#define RPT_SG 1
#endif
#ifndef RPT_SR
#define RPT_SR 1
#endif
#ifndef RPT_MG
#define RPT_MG 1
#endif
#ifndef RPT_MO
#define RPT_MO 1
#endif
#ifndef RPT_GEMM
#define RPT_GEMM 1
#endif
#ifndef RPT_GDN
#define RPT_GDN 1
#endif
#ifndef RPT_SCAN
#define RPT_SCAN 1
#endif
#ifndef RPT_MOBA
#define RPT_MOBA 1
#endif
#ifndef RPT_CONV
#define RPT_CONV 1
#endif
#ifndef FP8_FFN0
#define FP8_FFN0 0
#endif
#ifndef CFG_SEQ
#define CFG_SEQ 16384
#define CFG_BATCH 2
#define CFG_FF 2816
#define CFG_FFE 3584
#endif

typedef unsigned short bf16_t;
typedef short bf16x8 __attribute__((ext_vector_type(8)));
typedef float f32x4 __attribute__((ext_vector_type(4)));
typedef float f32x16 __attribute__((ext_vector_type(16)));
typedef unsigned u32x4 __attribute__((ext_vector_type(4)));
typedef unsigned u32x2 __attribute__((ext_vector_type(2)));

constexpr int DM = 1024, SEQ = CFG_SEQ, BATCH = CFG_BATCH, NTOK = SEQ * BATCH, HD = 128;
constexpr int DIN = 4104, DINP = 4096, FF = CFG_FF, FFE = CFG_FFE, NE = 8;
constexpr int NCH = SEQ / 64, NBLK = SEQ / 256, NCHH = BATCH * 4 * NCH;
constexpr int NTHREADS = 512;
constexpr int BM = 256, BK = 64, HALF = 128, HTB = HALF * BK * 2, STAGE_BYTES = 8 * HTB, NXCD = 8, WGM = 4;
constexpr size_t kDynLds = 144 * 1024;
constexpr int MAXTILES = NTOK * 2 / 256 + NE;
constexpr int NIT = BATCH * 8 * NBLK;
constexpr int LTOT = NBLK * SEQ - 128 * NBLK * (NBLK + 1);
static_assert(SEQ <= 16384, "16-bit selection-list entries");
constexpr int GNT = (NBLK + 15) / 16;
constexpr int KS_STRIDE = 272, VT_STRIDE = 520;
constexpr int KS_BYTES = 256 * KS_STRIDE, VT_BYTES = 128 * VT_STRIDE;
__host__ __device__ __forceinline__ int list_off(int j) { return j * SEQ - 128 * j * (j + 1); }
constexpr float NORM_EPS = 1e-6f;

__device__ __forceinline__ bf16_t f2bf(float f) { unsigned u = __float_as_uint(f); u += 0x7FFFu + ((u >> 16) & 1u); return (bf16_t)(u >> 16); }
__device__ __forceinline__ float bf2f(bf16_t h) { return __uint_as_float(((unsigned)h) << 16); }
#ifndef CPU_EMU
typedef __bf16 hwbf16x2 __attribute__((ext_vector_type(2)));
typedef float f32x2v __attribute__((ext_vector_type(2)));
__device__ __forceinline__ unsigned pack2(float lo, float hi) { f32x2v v; v.x = lo; v.y = hi; hwbf16x2 b = __builtin_convertvector(v, hwbf16x2); unsigned r; __builtin_memcpy(&r, &b, 4); return r; }
#else
__device__ __forceinline__ unsigned pack2(float lo, float hi) { return (unsigned)f2bf(lo) | ((unsigned)f2bf(hi) << 16); }
#endif
#ifndef CPU_EMU
__device__ __forceinline__ float siluf(float x) { return x * __builtin_amdgcn_rcpf(1.0f + __builtin_amdgcn_exp2f(-1.4426950408889634f * x)); }
#else
__device__ __forceinline__ float siluf(float x) { return x / (1.0f + __expf(-x)); }
#endif
#ifndef CPU_EMU
__device__ __forceinline__ unsigned pack4_fp8(float a, float b, float c, float d) { int r = 0; r = __builtin_amdgcn_cvt_pk_fp8_f32(a, b, r, false); r = __builtin_amdgcn_cvt_pk_fp8_f32(c, d, r, true); return (unsigned)r; }
#else
static inline float fp8_to_f(unsigned char v) { const int s = v >> 7, e = (v >> 3) & 15, m = v & 7; const float a = e == 0 ? ldexpf((float)m, -9) : ldexpf((float)(8 + m), e - 10); return s ? -a : a; }
static inline unsigned char f_to_fp8(float x) {
    const unsigned s = x < 0.f ? 0x80u : 0u; float a = fabsf(x); if (!(a == a)) return 0x7f; if (a > 448.f) a = 448.f; if (a == 0.f) return (unsigned char)s;
    int e; (void)frexpf(a, &e); e -= 1; if (e < -6) e = -6;
    const float step = ldexpf(1.f, e - 3); float q = nearbyintf(a / step) * step; if (q > 448.f) q = 448.f;
    int e2; (void)frexpf(q, &e2); e2 -= 1; unsigned bits;
    if (q < ldexpf(1.f, -6)) bits = (unsigned)nearbyintf(q * 512.f); else bits = ((unsigned)(e2 + 7) << 3) | ((unsigned)nearbyintf(q / ldexpf(1.f, e2 - 3)) - 8u);
    return (unsigned char)(s | bits);
}
static inline unsigned pack4_fp8(float a, float b, float c, float d) { return (unsigned)f_to_fp8(a) | ((unsigned)f_to_fp8(b) << 8) | ((unsigned)f_to_fp8(c) << 16) | ((unsigned)f_to_fp8(d) << 24); }
#endif
constexpr float FP8_TOP = 384.f;
#ifndef CPU_EMU
__device__ __forceinline__ float wave_sum(float s) { int l; asm volatile("v_mbcnt_lo_u32_b32 %0, -1, 0\n\tv_mbcnt_hi_u32_b32 %0, -1, %0" : "=v"(l));
#pragma unroll
    for (int o = 32; o >= 1; o >>= 1) s += __uint_as_float((unsigned)__builtin_amdgcn_ds_bpermute((l ^ o) << 2, (int)__float_as_uint(s))); return s; }
__device__ __forceinline__ float wave_max(float s) { int l; asm volatile("v_mbcnt_lo_u32_b32 %0, -1, 0\n\tv_mbcnt_hi_u32_b32 %0, -1, %0" : "=v"(l));
#pragma unroll
    for (int o = 32; o >= 1; o >>= 1) s = fmaxf(s, __uint_as_float((unsigned)__builtin_amdgcn_ds_bpermute((l ^ o) << 2, (int)__float_as_uint(s)))); return s; }
#else
__device__ __forceinline__ float wave_sum(float s) { for (int o = 32; o >= 1; o >>= 1) s += __shfl_xor(s, o); return s; }
__device__ __forceinline__ float wave_max(float s) { for (int o = 32; o >= 1; o >>= 1) s = fmaxf(s, __shfl_xor(s, o)); return s; }
#endif

struct Params;
#ifndef CPU_EMU
typedef const __attribute__((address_space(4))) Params* KPTR;
#define KARG_PTR(arg) ((KPTR)__builtin_amdgcn_kernarg_segment_ptr())
#define LAUNDER(q) asm volatile("" : "+s"(q))
#else
typedef const Params* KPTR;
#define KARG_PTR(arg) (&(arg))
#define LAUNDER(q) ((void)0)
#endif
struct Params {
    const float* x; const float* mix_norm; const float* ffn_norm; const float* w_in; const float* conv_w; const float* a_log; const float* dt_bias;
    const float* ret_norm; const float* gdn_norm; const float* w_out0; const float* w_qkv; const float* w_out1; const float* w_gate0; const float* w_up0;
    const float* w_down0; const float* w_router; const float* w_mgate; const float* w_mup; const float* w_mdown; const float* final_norm;
    float* out;
    bf16_t* hb;
    bf16_t* hb3;
    unsigned* ctrl;
    unsigned* bar;
    bf16_t* wt_in; bf16_t* wt_out0; bf16_t* wt_gu0; bf16_t* wt_d0; bf16_t* wt_qkv; bf16_t* wt_out1;
    bf16_t* hn;
    float* gbeta; float* gg;
    float* retL;
    unsigned* gflag;
    unsigned char* arena;
    bf16_t* proj; unsigned char* gimg; float* gcdec;
    bf16_t* act0;
    bf16_t* qkv; bf16_t* kmh; bf16_t* kml; unsigned* mcount; unsigned short* mlist; bf16_t* part_o; float* part_lse;
    bf16_t* wt_mgu; bf16_t* wt_md; bf16_t* yslot; bf16_t* mact; int* arow; int* tile_e; int* slot_of; float* mgate; int* midx; unsigned* wghist;
    unsigned char* w8_gu0; float* ws_gu0; unsigned char* w8_mgu; float* ws_mgu; float* hns; float* sslot; unsigned char* w8_md; float* ws_md; float* hnn2; float* sn2; float* shs; bf16_t* wt_md_tmp;
    int tiles_per_pass; int pad0;
};

#define C_CNT(e) (64 + (e))
#define C_CUR(e) (128 + (e))
#define C_NTILES 192
#define C_GMAX 216
#define C_UMAX 224
#define C_TB 200

__host__ __device__ __forceinline__ int lds_byte(int r, int c) { const int st = (r >> 4) * 2 + (c >> 5), rr = r & 15, cc = c & 31, ob = rr * 64 + cc * 2; return st * 1024 + (ob ^ (((ob >> 9) & 1) << 5)); }
__host__ __device__ __forceinline__ void stage_rc(int b, int& R, int& C) { const int st = b / 1024, sb = b % 1024, swz = sb ^ (((sb >> 9) & 1) << 5); R = (st >> 1) * 16 + swz / 64; C = (st & 1) * 32 + (swz % 64) / 2; }
__host__ __device__ __forceinline__ int perm32(int rho) { const int n = rho >> 4, i = rho & 15; return 8 * (i >> 2) + 4 * n + (i & 3); }

struct Unit { int pm, pn, pnb; };
struct Gemm { const bf16_t* A; const bf16_t* Bt; const int* arow; };

struct StaticOrder {
    int nM, nN, nwg, G, c;
    __device__ void init(int nM_, int nN_, int G_, int c_) { nM = nM_; nN = nN_; nwg = nM * nN; G = G_; c = c_; }
    __device__ bool next(int i, Unit& u) const {
        const long L = (long)i * G + c; if (L >= nwg) return false;
        int wgid = (int)L; { const int q = nwg / NXCD, r = nwg % NXCD, xcd = wgid % NXCD, off = wgid / NXCD; wgid = (xcd < r ? xcd * (q + 1) : r * (q + 1) + (xcd - r) * q) + off; }
        const int nig = WGM * nN, gid = wgid / nig, fm = gid * WGM, gsz = (nM - fm) < WGM ? (nM - fm) : WGM;
        u.pm = fm + ((wgid % nig) % gsz); u.pn = (wgid % nig) / gsz; u.pnb = u.pn; return true;
    }
};
struct MoeOrder {
    StaticOrder so; int t0; const int* tile_e;
    __device__ void init(int t0_, int nM_, int nN_, const int* te, int G_, int c_) { so.init(nM_, nN_, G_, c_); t0 = t0_; tile_e = te; }
    __device__ bool next(int i, Unit& u) const { if (!so.next(i, u)) return false; u.pm += t0; u.pnb = tile_e[u.pm] * so.nN + u.pn; return true; }
};

struct EpiBf16 {
    static constexpr bool PERM = true;
    bf16_t* O; int ldc; int rowbase;
    __device__ __forceinline__ void operator()(const f32x4 (&acc)[2][2][4][2], const Unit& u, int wr, int wc, int fr, int fq) const {
        const int row0 = u.pm * BM + wr * 64 + fr - rowbase, col0 = u.pn * BM + wc * 32 + 8 * fq;
#pragma unroll
        for (int ai = 0; ai < 2; ++ai)
#pragma unroll
            for (int m = 0; m < 4; ++m) { bf16_t* rowp = O + (size_t)(row0 + ai * HALF + m * 16) * ldc + col0;
#pragma unroll
                for (int bj = 0; bj < 2; ++bj) { const f32x4 v0 = acc[ai][bj][m][0], v1 = acc[ai][bj][m][1];
                    u32x4 w; w.x = pack2(v0[0], v0[1]); w.y = pack2(v0[2], v0[3]); w.z = pack2(v1[0], v1[1]); w.w = pack2(v1[2], v1[3]);
                    *(u32x4*)(rowp + bj * HALF) = w; } }
    }
};
struct EpiSwiglu {
    static constexpr bool PERM = true;
    bf16_t* O; int ldc; int rowbase;
    __device__ __forceinline__ void operator()(const f32x4 (&acc)[2][2][4][2], const Unit& u, int wr, int wc, int fr, int fq) const {
        const int row0 = u.pm * BM + wr * 64 + fr - rowbase, col0 = u.pn * HALF + wc * 32 + 8 * fq;
#pragma unroll
        for (int ai = 0; ai < 2; ++ai)
#pragma unroll
            for (int m = 0; m < 4; ++m) { bf16_t* rowp = O + (size_t)(row0 + ai * HALF + m * 16) * ldc + col0;
                float r[8];
#pragma unroll
                for (int n = 0; n < 2; ++n)
#pragma unroll
                    for (int j = 0; j < 4; ++j) r[n * 4 + j] = siluf(acc[ai][0][m][n][j]) * acc[ai][1][m][n][j];
                u32x4 w; w.x = pack2(r[0], r[1]); w.y = pack2(r[2], r[3]); w.z = pack2(r[4], r[5]); w.w = pack2(r[6], r[7]);
                *(u32x4*)rowp = w; }
    }
};
struct EpiSwigluS {
    static constexpr bool PERM = true;
    bf16_t* O; int ldc; int rowbase; const float* sa; const float* sb;
    __device__ __forceinline__ void operator()(const f32x4 (&acc)[2][2][4][2], const Unit& u, int wr, int wc, int fr, int fq) const {
        const int rowg = u.pm * BM + wr * 64 + fr, row0 = rowg - rowbase, col0 = u.pn * HALF + wc * 32 + 8 * fq;
        const float* sbp = sb + (size_t)u.pnb * BM + wc * 32 + 8 * fq;
        f32x4 sg[2], su[2];
#pragma unroll
        for (int n = 0; n < 2; ++n) { sg[n] = *(const f32x4*)(sbp + 4 * n); su[n] = *(const f32x4*)(sbp + HALF + 4 * n); }
        float ra[2][4];
#pragma unroll
        for (int ai = 0; ai < 2; ++ai)
#pragma unroll
            for (int m = 0; m < 4; ++m) ra[ai][m] = sa[rowg + ai * HALF + m * 16];
#pragma unroll
        for (int ai = 0; ai < 2; ++ai)
#pragma unroll
            for (int m = 0; m < 4; ++m) { bf16_t* rowp = O + (size_t)(row0 + ai * HALF + m * 16) * ldc + col0;
                float r[8];
#pragma unroll
                for (int n = 0; n < 2; ++n)
#pragma unroll
                    for (int j = 0; j < 4; ++j) r[n * 4 + j] = siluf(acc[ai][0][m][n][j] * (ra[ai][m] * sg[n][j])) * (acc[ai][1][m][n][j] * (ra[ai][m] * su[n][j]));
                u32x4 w; w.x = pack2(r[0], r[1]); w.y = pack2(r[2], r[3]); w.z = pack2(r[4], r[5]); w.w = pack2(r[6], r[7]);
                *(u32x4*)rowp = w; }
    }
};
struct EpiSwigluS8 {
    static constexpr bool PERM = true;
    unsigned char* O8; int ldc; int rowbase; const float* sa; const float* sb; const float* so;
    __device__ __forceinline__ void operator()(const f32x4 (&acc)[2][2][4][2], const Unit& u, int wr, int wc, int fr, int fq) const {
        const int rowg = u.pm * BM + wr * 64 + fr, row0 = rowg - rowbase, col0 = u.pn * HALF + wc * 32 + 8 * fq;
        const float* sbp = sb + (size_t)u.pnb * BM + wc * 32 + 8 * fq;
        f32x4 sg[2], su[2];
#pragma unroll
        for (int n = 0; n < 2; ++n) { sg[n] = *(const f32x4*)(sbp + 4 * n); su[n] = *(const f32x4*)(sbp + HALF + 4 * n); }
        float ra[2][4], ro[2][4];
#pragma unroll
        for (int ai = 0; ai < 2; ++ai)
#pragma unroll
            for (int m = 0; m < 4; ++m) { ra[ai][m] = sa[rowg + ai * HALF + m * 16]; const float so_ = so[rowg + ai * HALF + m * 16]; ro[ai][m] = so_ > 0.f ? 1.0f / so_ : 0.f; }
#pragma unroll
        for (int ai = 0; ai < 2; ++ai)
#pragma unroll
            for (int m = 0; m < 4; ++m) { unsigned char* rowp = O8 + (size_t)(row0 + ai * HALF + m * 16) * ldc + col0;
                float r[8];
#pragma unroll
                for (int n = 0; n < 2; ++n)
#pragma unroll
                    for (int j = 0; j < 4; ++j) r[n * 4 + j] = siluf(acc[ai][0][m][n][j] * (ra[ai][m] * sg[n][j])) * (acc[ai][1][m][n][j] * (ra[ai][m] * su[n][j])) * ro[ai][m];
                u32x2 w; w.x = pack4_fp8(r[0], r[1], r[2], r[3]); w.y = pack4_fp8(r[4], r[5], r[6], r[7]);
                *(u32x2*)rowp = w; }
    }
};
struct EpiBf16S {
    static constexpr bool PERM = true;
    bf16_t* O; int ldc; const float* sa; const float* sb;
    __device__ __forceinline__ void operator()(const f32x4 (&acc)[2][2][4][2], const Unit& u, int wr, int wc, int fr, int fq) const {
        const int row0 = u.pm * BM + wr * 64 + fr, col0 = u.pn * BM + wc * 32 + 8 * fq;
        const float* sbp = sb + (size_t)u.pnb * BM + wc * 32 + 8 * fq;
        f32x4 sv[2][2];
#pragma unroll
        for (int bj = 0; bj < 2; ++bj)
#pragma unroll
            for (int n = 0; n < 2; ++n) sv[bj][n] = *(const f32x4*)(sbp + bj * HALF + 4 * n);
#pragma unroll
        for (int ai = 0; ai < 2; ++ai)
#pragma unroll
            for (int m = 0; m < 4; ++m) { bf16_t* rowp = O + (size_t)(row0 + ai * HALF + m * 16) * ldc + col0; const float ra = sa[row0 + ai * HALF + m * 16];
#pragma unroll
                for (int bj = 0; bj < 2; ++bj) { const f32x4 v0 = acc[ai][bj][m][0] * sv[bj][0] * ra, v1 = acc[ai][bj][m][1] * sv[bj][1] * ra;
                    u32x4 w; w.x = pack2(v0[0], v0[1]); w.y = pack2(v0[2], v0[3]); w.z = pack2(v1[0], v1[1]); w.w = pack2(v1[2], v1[3]);
                    *(u32x4*)(rowp + bj * HALF) = w; } }
    }
};
template <bool F32BASE>
struct EpiResBf16 {
    static constexpr bool PERM = true;
    static constexpr bool LSCALE = false;
    const float* basef; const bf16_t* baseb; bf16_t* out;
    __device__ __forceinline__ void operator()(const f32x4 (&acc)[2][2][4][2], const Unit& u, int wr, int wc, int fr, int fq) const {
        const int row0 = u.pm * BM + wr * 64 + fr, col0 = u.pn * BM + wc * 32 + 8 * fq;
#pragma unroll
        for (int ai = 0; ai < 2; ++ai)
#pragma unroll
            for (int m = 0; m < 4; ++m) { const size_t off = (size_t)(row0 + ai * HALF + m * 16) * DM + col0;
#pragma unroll
                for (int bj = 0; bj < 2; ++bj) { f32x4 b0, b1;
                    if (F32BASE) { b0 = *(const f32x4*)(basef + off + bj * HALF); b1 = *(const f32x4*)(basef + off + bj * HALF + 4); }
                    else { const u32x4 w = *(const u32x4*)(baseb + off + bj * HALF);
                        b0[0] = __uint_as_float(w.x << 16); b0[1] = __uint_as_float(w.x & 0xffff0000u); b0[2] = __uint_as_float(w.y << 16); b0[3] = __uint_as_float(w.y & 0xffff0000u);
                        b1[0] = __uint_as_float(w.z << 16); b1[1] = __uint_as_float(w.z & 0xffff0000u); b1[2] = __uint_as_float(w.w << 16); b1[3] = __uint_as_float(w.w & 0xffff0000u); }
                    const f32x4 v0 = acc[ai][bj][m][0] + b0, v1 = acc[ai][bj][m][1] + b1;
                    u32x4 o; o.x = pack2(v0[0], v0[1]); o.y = pack2(v0[2], v0[3]); o.z = pack2(v1[0], v1[1]); o.w = pack2(v1[2], v1[3]);
                    *(u32x4*)(out + off + bj * HALF) = o; } }
    }
};
struct EpiResF32 {
    static constexpr bool PERM = false;
    const float* base; float* out; int ldc;
    __device__ __forceinline__ void operator()(const f32x4 (&acc)[2][2][4][2], const Unit& u, int wr, int wc, int fr, int fq) const {
        const int row0 = u.pm * BM + wr * 64 + fr, col0 = u.pn * BM + wc * 32 + 4 * fq;
#pragma unroll
        for (int ai = 0; ai < 2; ++ai)
#pragma unroll
            for (int m = 0; m < 4; ++m) { const size_t off = (size_t)(row0 + ai * HALF + m * 16) * ldc + col0;
#pragma unroll
                for (int bj = 0; bj < 2; ++bj)
#pragma unroll
                    for (int n = 0; n < 2; ++n) { const f32x4 b = *(const f32x4*)(base + off + bj * HALF + n * 16); *(f32x4*)(out + off + bj * HALF + n * 16) = b + acc[ai][bj][m][n]; } }
    }
};

#ifndef CPU_EMU
typedef int i32x8 __attribute__((ext_vector_type(8)));
__device__ __forceinline__ i32x8 cat8(const bf16x8 lo, const bf16x8 hi) { u32x4 a, b; __builtin_memcpy(&a, &lo, 16); __builtin_memcpy(&b, &hi, 16); i32x8 r; r[0] = (int)a.x; r[1] = (int)a.y; r[2] = (int)a.z; r[3] = (int)a.w; r[4] = (int)b.x; r[5] = (int)b.y; r[6] = (int)b.z; r[7] = (int)b.w; return r; }
template <int K, class Epi, class Sched, bool FP8 = false>
__device__ __forceinline__ void gemm_phase(LAS unsigned char* lds, const Gemm g, const Sched& S, const Epi& E, int wv) {
    const int tid = opaque_tid(wv), wid = __builtin_amdgcn_readfirstlane(tid >> 6), lane = tid & 63, wr = wid >> 2, wc = wid & 3, fr = lane & 15, fq = lane >> 4;
    constexpr int RB = FP8 ? K : 2 * K;
    constexpr int nt = RB / 128;
    static_assert(nt % 2 == 0 && nt >= 4, "k tiles");
    unsigned voffB[2];
#pragma unroll
    for (int i = 0; i < 2; ++i) { int R, C; stage_rc(tid * 16 + i * 8192, R, C); const int Rb = Epi::PERM ? ((R & ~31) + perm32(R & 31)) : R; voffB[i] = (unsigned)(Rb * RB + C * 2); }
    constexpr size_t kstep = (size_t)(BK * 2);
    constexpr size_t hstep = (size_t)HALF * RB;
    constexpr size_t tstep = 2 * hstep;
    const unsigned ldsw = (unsigned)wid * 1024u;
    const int aoffl = lds_byte(wr * 64 + fr, fq * 8), boffl = lds_byte(wc * 32 + fr, fq * 8);
    unsigned aoff[2][2];
#define G_LOADA(u) do { _Pragma("unroll") for (int _h = 0; _h < 2; ++_h) _Pragma("unroll") for (int _i = 0; _i < 2; ++_i) { int _R, _C; stage_rc(tid * 16 + _i * 8192, _R, _C); const int _r = (u).pm * BM + _h * HALF + _R; \
        const int _s = g.arow ? g.arow[_r] : _r; aoff[_h][_i] = (unsigned)(_s * RB + _C * 2); } } while (0)
#define G_SA(b, h) (((b) * 2 + (h)) * HTB)
#define G_SB(b, h) ((4 + (b) * 2 + (h)) * HTB)
#define G_STAGEB(bufoff, gbase) do { _Pragma("unroll") for (int _i = 0; _i < 2; ++_i) \
        __builtin_amdgcn_global_load_lds((const unsigned*)((const char*)(gbase) + voffB[_i]), (LAS unsigned*)(lds + (bufoff) + ldsw + _i * 8192), 16, 0, 0); } while (0)
#define G_STAGEA(bufoff, kt, h) do { _Pragma("unroll") for (int _i = 0; _i < 2; ++_i) \
        __builtin_amdgcn_global_load_lds((const unsigned*)((const char*)g.A + (size_t)(kt) * kstep + aoff[h][_i]), (LAS unsigned*)(lds + (bufoff) + ldsw + _i * 8192), 16, 0, 0); } while (0)
#define G_LDA(dst, b, h) do { _Pragma("unroll") for (int m = 0; m < 4; ++m) _Pragma("unroll") for (int k = 0; k < 2; ++k) dst[m][k] = *(const LAS bf16x8*)(lds + G_SA(b, h) + aoffl + m * 2048 + k * 1024); } while (0)
#define G_LDB(dst, b, h) do { _Pragma("unroll") for (int n = 0; n < 2; ++n) _Pragma("unroll") for (int k = 0; k < 2; ++k) dst[n][k] = *(const LAS bf16x8*)(lds + G_SB(b, h) + boffl + n * 2048 + k * 1024); } while (0)
#define G_MMA(ai, bj, At, Bt) do { if constexpr (FP8) __builtin_amdgcn_sched_barrier(0); __builtin_amdgcn_s_setprio(1); _Pragma("unroll") for (int m = 0; m < 4; ++m) _Pragma("unroll") for (int n = 0; n < 2; ++n) { \
        if constexpr (FP8) acc[ai][bj][m][n] = __builtin_amdgcn_mfma_scale_f32_16x16x128_f8f6f4(cat8(Bt[n][0], Bt[n][1]), cat8(At[m][0], At[m][1]), acc[ai][bj][m][n], 0, 0, 0, 0x7F7F7F7F, 0, 0x7F7F7F7F); \
        else { _Pragma("unroll") for (int k = 0; k < 2; ++k) acc[ai][bj][m][n] = __builtin_amdgcn_mfma_f32_16x16x32_bf16(Bt[n][k], At[m][k], acc[ai][bj][m][n], 0, 0, 0); } } \
        __builtin_amdgcn_s_setprio(0); if constexpr (FP8) __builtin_amdgcn_sched_barrier(0); } while (0)
#define G_WAIT_V(n) asm volatile("s_waitcnt vmcnt(" #n ")" ::: "memory")
#define G_WAIT_L(n) asm volatile("s_waitcnt lgkmcnt(" #n ")" ::: "memory")
#define G_BAR __builtin_amdgcn_s_barrier()
#define G_SCHED __builtin_amdgcn_sched_barrier(0)
    Unit cur, nxt; int ui = 0;
    if (!S.next(0, cur)) return;
    f32x4 acc[2][2][4][2];
#pragma unroll
    for (int a = 0; a < 2; ++a)
#pragma unroll
        for (int b = 0; b < 2; ++b)
#pragma unroll
            for (int m = 0; m < 4; ++m)
#pragma unroll
                for (int n = 0; n < 2; ++n) acc[a][b][m][n] = (f32x4){0.f, 0.f, 0.f, 0.f};
    bf16x8 At[4][2], B0[2][2], B1[2][2];
    const char* cB = (const char*)g.Bt + (size_t)cur.pnb * tstep;
    G_LOADA(cur);
    G_STAGEB(G_SB(0, 0), cB); G_STAGEA(G_SA(0, 0), 0, 0); G_STAGEB(G_SB(0, 1), cB + hstep); G_STAGEA(G_SA(0, 1), 0, 1);
    if (wr == 1) G_BAR;
    G_WAIT_V(4); G_BAR;
    G_STAGEB(G_SB(1, 0), cB + kstep); G_STAGEA(G_SA(1, 0), 1, 0); G_STAGEB(G_SB(1, 1), cB + hstep + kstep);
    G_WAIT_V(6); G_BAR;
    for (;;) {
        const bool has_next = S.next(ui + 1, nxt);
        const char* nB = has_next ? (const char*)g.Bt + (size_t)nxt.pnb * tstep : cB;
        for (int t = 0; t < nt; t += 2) {
            const bool last = (t == nt - 2);
            const int k2 = last ? 0 : t + 2, k3 = k2 + 1;
            const char* b2 = last ? nB : cB + (size_t)(t + 2) * kstep; const char* b3 = b2 + kstep;
            G_LDB(B0, 0, 0); G_SCHED; G_LDA(At, 0, 0); G_STAGEA(G_SA(1, 1), t + 1, 1);
            if (g.arow && has_next && t == nt - 4 && tid < BM)
                __builtin_amdgcn_global_load_lds((const unsigned*)(g.arow + nxt.pm * BM + tid), (LAS unsigned*)(lds + STAGE_BYTES + wid * 256), 4, 0, 0);
            G_WAIT_L(8); G_BAR; G_WAIT_L(0); G_MMA(0, 0, At, B0); G_BAR; G_SCHED;
            if (last && has_next) {
                if (g.arow) {
#pragma unroll
                    for (int _h = 0; _h < 2; ++_h)
#pragma unroll
                        for (int _i = 0; _i < 2; ++_i) { int _R, _C; stage_rc(tid * 16 + _i * 8192, _R, _C); const int _s = *(LAS const int*)(lds + STAGE_BYTES + (_h * HALF + _R) * 4); aoff[_h][_i] = (unsigned)(_s * RB + _C * 2); }
                } else G_LOADA(nxt);
            }
            G_LDB(B1, 0, 1); G_STAGEB(G_SB(0, 0), b2);
            G_BAR; G_WAIT_L(0); G_MMA(0, 1, At, B1); G_BAR;
            G_LDA(At, 0, 1); G_STAGEA(G_SA(0, 0), k2, 0);
            G_BAR; G_WAIT_L(0); G_MMA(1, 0, At, B0); G_BAR; G_SCHED;
            G_STAGEB(G_SB(0, 1), b2 + hstep);
            G_WAIT_V(6); G_BAR; G_MMA(1, 1, At, B1); G_BAR;
            G_LDB(B0, 1, 0); G_SCHED; G_LDA(At, 1, 0); G_STAGEA(G_SA(0, 1), k2, 1);
            G_WAIT_L(8); G_BAR; G_WAIT_L(0); G_MMA(0, 0, At, B0); G_BAR; G_SCHED;
            G_LDB(B1, 1, 1); G_STAGEB(G_SB(1, 0), b3);
            G_BAR; G_WAIT_L(0); G_MMA(0, 1, At, B1); G_BAR;
            G_LDA(At, 1, 1); G_STAGEA(G_SA(1, 0), k3, 0);
            G_BAR; G_WAIT_L(0); G_MMA(1, 0, At, B0); G_BAR; G_SCHED;
            G_STAGEB(G_SB(1, 1), b3 + hstep);
            G_WAIT_V(6); G_BAR; G_MMA(1, 1, At, B1); G_BAR;
        }
        E(acc, cur, wr, wc, fr, fq);
        if (!has_next) break;
#pragma unroll
        for (int a = 0; a < 2; ++a)
#pragma unroll
            for (int b = 0; b < 2; ++b)
#pragma unroll
                for (int m = 0; m < 4; ++m)
#pragma unroll
                    for (int n = 0; n < 2; ++n) acc[a][b][m][n] = (f32x4){0.f, 0.f, 0.f, 0.f};
        cur = nxt; cB = nB; ++ui;
    }
    G_WAIT_V(0);
    if (wr == 0) G_BAR;
    G_BAR;
}
#else
template <int K, class Epi, class Sched, bool FP8 = false>
__device__ __forceinline__ void gemm_phase(unsigned char* lds, const Gemm g, const Sched& S, const Epi& E, int wv) {
    const int tid = opaque_tid(wv), wid = tid >> 6, lane = tid & 63, wr = wid >> 2, wc = wid & 3, fr = lane & 15, fq = lane >> 4;
    Unit u;
    for (int ui = 0; S.next(ui, u); ++ui) {
        f32x4 acc[2][2][4][2];
        for (int ai = 0; ai < 2; ++ai) for (int bj = 0; bj < 2; ++bj) for (int m = 0; m < 4; ++m) for (int n = 0; n < 2; ++n) for (int j = 0; j < 4; ++j) {
            const int r = u.pm * 256 + 128 * ai + 64 * wr + 16 * m + fr;
            const int cl = Epi::PERM ? (128 * bj + 32 * wc + 8 * fq + 4 * n + j) : (128 * bj + 32 * wc + 16 * n + 4 * fq + j);
            const int ar = g.arow ? g.arow[r] : r;
            float s = 0.f;
            if (FP8) { const unsigned char* a = (const unsigned char*)g.A + (size_t)ar * K; const unsigned char* b = (const unsigned char*)g.Bt + ((size_t)u.pnb * 256 + cl) * K; for (int k = 0; k < K; ++k) s += fp8_to_f(a[k]) * fp8_to_f(b[k]); }
            else { const bf16_t* a = g.A + (size_t)ar * K; const bf16_t* b = g.Bt + ((size_t)u.pnb * 256 + cl) * K; for (int k = 0; k < K; ++k) s += bf2f(a[k]) * bf2f(b[k]); }
            acc[ai][bj][m][n][j] = s;
        }
        E(acc, u, wr, wc, fr, fq);
    }
}
#endif

__device__ __forceinline__ void convert_wt(LAS unsigned char* lds, const float* W, int K, int ldw, int col0, int ncols, bf16_t* Wt, int rowmul, int rowadd, int bid, int nb, int wv) {
    LAS float* t = (LAS float*)lds;
    const int tid = opaque_tid(wv);
    const int tk = K / 64, tn = ncols / 64, ntile = tk * tn;
    const int lr = tid >> 4, c4 = (tid & 15) * 4;
    f32x4 v[2];
    if (bid < ntile) { const int k0 = (bid % tk) * 64, n0 = (bid / tk) * 64;
#pragma unroll
        for (int i = 0; i < 2; ++i) v[i] = *(const f32x4*)(W + (size_t)(k0 + lr + 32 * i) * ldw + col0 + n0 + c4); }
    for (int tile = bid; tile < ntile; tile += nb) {
        const int k0 = (tile % tk) * 64, n0 = (tile / tk) * 64;
        __syncthreads();
#pragma unroll
        for (int i = 0; i < 2; ++i) { const int r = lr + 32 * i; t[r * 65 + c4] = v[i][0]; t[r * 65 + c4 + 1] = v[i][1]; t[r * 65 + c4 + 2] = v[i][2]; t[r * 65 + c4 + 3] = v[i][3]; }
        const int nt2 = tile + nb;
        if (nt2 < ntile) { const int k1 = (nt2 % tk) * 64, n1 = (nt2 / tk) * 64;
#pragma unroll
            for (int i = 0; i < 2; ++i) v[i] = *(const f32x4*)(W + (size_t)(k1 + lr + 32 * i) * ldw + col0 + n1 + c4); }
        __syncthreads();
        { const int c = tid >> 3, k8 = (tid & 7) * 8; const int cc = n0 + c; const int dr = (cc >> 7) * rowmul + (cc & 127) + rowadd;
          u32x4 w; w.x = pack2(t[(k8 + 0) * 65 + c], t[(k8 + 1) * 65 + c]); w.y = pack2(t[(k8 + 2) * 65 + c], t[(k8 + 3) * 65 + c]);
          w.z = pack2(t[(k8 + 4) * 65 + c], t[(k8 + 5) * 65 + c]); w.w = pack2(t[(k8 + 6) * 65 + c], t[(k8 + 7) * 65 + c]);
          *(u32x4*)(Wt + (size_t)dr * K + k0 + k8) = w; }
    }
    __syncthreads();
}

__device__ __forceinline__ void load_row(const float* src, int row, int lane, f32x4 (&v)[4]) {
#pragma unroll
    for (int i = 0; i < 4; ++i) v[i] = *(const f32x4*)(src + (size_t)row * DM + i * 256 + lane * 4);
}
__device__ __forceinline__ void load_row_b(const bf16_t* src, int row, int lane, f32x4 (&v)[4]) {
#pragma unroll
    for (int i = 0; i < 4; ++i) { const u32x2 w = *(const u32x2*)(src + (size_t)row * DM + i * 256 + lane * 4);
        v[i][0] = __uint_as_float(w.x << 16); v[i][1] = __uint_as_float(w.x & 0xffff0000u); v[i][2] = __uint_as_float(w.y << 16); v[i][3] = __uint_as_float(w.y & 0xffff0000u); }
}
__device__ __forceinline__ float row_rstd(const f32x4 (&v)[4]) {
    float s = 0.f;
#pragma unroll
    for (int i = 0; i < 4; ++i) s += v[i][0] * v[i][0] + v[i][1] * v[i][1] + v[i][2] * v[i][2] + v[i][3] * v[i][3];
    s = wave_sum(s);
    return rsqrtf(s * (1.0f / DM) + NORM_EPS);
}
__device__ __forceinline__ void store_row_bf16(bf16_t* dst, int row, int lane, const f32x4 (&v)[4]) {
#pragma unroll
    for (int i = 0; i < 4; ++i) { u32x2 w; w.x = pack2(v[i][0], v[i][1]); w.y = pack2(v[i][2], v[i][3]); *(u32x2*)(dst + (size_t)row * DM + i * 256 + lane * 4) = w; }
}

__device__ __forceinline__ void store_row_fp8(unsigned char* dst, float* scale, int row, int lane, const f32x4 (&v)[4]) {
    float am = 0.f;
#pragma unroll
    for (int i = 0; i < 4; ++i) am = fmaxf(fmaxf(am, fmaxf(fabsf(v[i][0]), fabsf(v[i][1]))), fmaxf(fabsf(v[i][2]), fabsf(v[i][3])));
    am = wave_max(am);
    const float sc = am > 0.f ? am * (1.0f / FP8_TOP) : 1.0f, inv = 1.0f / sc;
#pragma unroll
    for (int i = 0; i < 4; ++i) *(unsigned*)(dst + (size_t)row * DM + i * 256 + lane * 4) = pack4_fp8(v[i][0] * inv, v[i][1] * inv, v[i][2] * inv, v[i][3] * inv);
    if (lane == 0) scale[row] = sc;
}
template <int K, bool NORMS>
__device__ __forceinline__ void quant_rows(KPTR p, LAS unsigned char* lds, const bf16_t* src, unsigned char* dst, float* scl, int nrows, int bid, int nb, int wv) {
    constexpr int NC = K / 512;
    const int tid = opaque_tid(wv), wid = tid >> 6, lane = tid & 63;
    LAS unsigned* nmx = (LAS unsigned*)lds;
    if (NORMS) { if (tid < 2 * NE) nmx[tid] = 0u; __syncthreads(); }
    int row = bid * 8 + wid;
    u32x4 nx[NC];
#pragma unroll
    for (int c = 0; c < NC; ++c) nx[c] = (u32x4){0u, 0u, 0u, 0u};
    if (row < nrows) {
#pragma unroll
        for (int c = 0; c < NC; ++c) nx[c] = *(const u32x4*)(src + (size_t)row * K + (c * 64 + lane) * 8); }
    for (; row < nrows; row += nb * 8) {
        u32x4 cu[NC];
#pragma unroll
        for (int c = 0; c < NC; ++c) cu[c] = nx[c];
        const int rn = row + nb * 8;
        if (rn < nrows) {
#pragma unroll
            for (int c = 0; c < NC; ++c) nx[c] = *(const u32x4*)(src + (size_t)rn * K + (c * 64 + lane) * 8); }
        float am = 0.f, ss = 0.f;
#pragma unroll
        for (int c = 0; c < NC; ++c)
#pragma unroll
            for (int q = 0; q < 4; ++q) { const float lo = __uint_as_float(cu[c][q] << 16), hi = __uint_as_float(cu[c][q] & 0xffff0000u); am = fmaxf(am, fmaxf(fabsf(lo), fabsf(hi))); if (NORMS) ss += lo * lo + hi * hi; }
        am = wave_max(am);
        const float sc = am > 0.f ? am * (1.0f / FP8_TOP) : 1.0f, inv = 1.0f / sc;
#pragma unroll
        for (int c = 0; c < NC; ++c) { u32x2 w;
            w.x = pack4_fp8(__uint_as_float(cu[c][0] << 16) * inv, __uint_as_float(cu[c][0] & 0xffff0000u) * inv, __uint_as_float(cu[c][1] << 16) * inv, __uint_as_float(cu[c][1] & 0xffff0000u) * inv);
            w.y = pack4_fp8(__uint_as_float(cu[c][2] << 16) * inv, __uint_as_float(cu[c][2] & 0xffff0000u) * inv, __uint_as_float(cu[c][3] << 16) * inv, __uint_as_float(cu[c][3] & 0xffff0000u) * inv);
            *(u32x2*)(dst + (size_t)row * K + (c * 64 + lane) * 8) = w; }
        if (lane == 0) scl[row] = sc;
        if (NORMS) { ss = wave_sum(ss); if (lane == 0) LDS_ATOMIC_MAX(nmx + ((row >> 7) & 1) * NE + row / (2 * FFE), __float_as_uint(sqrtf(ss))); }
    }
    if (NORMS) { __syncthreads(); if (tid < 2 * NE) (void)GLOBAL_ATOMIC_MAX(p->ctrl + (tid < NE ? C_GMAX + tid : C_UMAX + tid - NE), nmx[tid]); __syncthreads(); }
}
__device__ __forceinline__ const float* gu_src(KPTR p, int item, int t, int kr, int c4) {
    constexpr int NPAN = FFE / 32;
    const int e = item / (2 * NPAN), r = item % (2 * NPAN), up = r / NPAN, pn = r % NPAN;
    return (up ? p->w_mup : p->w_mgate) + (size_t)e * DM * FFE + (size_t)(t * 64 + kr) * FFE + pn * 32 + c4;
}
__device__ __forceinline__ void convert_gu_fp8(KPTR p, LAS unsigned char* lds, int bid, int nb, int wv) {
    constexpr int PSF = 1028, NPAN = FFE / 32, NITEM = NE * 2 * NPAN, TPI = DM / 64;
    const int tid = opaque_tid(wv), wid = tid >> 6, lane = tid & 63;
    LAS float* pan = (LAS float*)lds;
    LAS float* red = pan + 32 * PSF;
    LAS float* scl = red + 8 * 32 * 2;
    const int c4 = (tid & 7) * 4, kr = tid >> 3;
    const int nmine = bid < NITEM ? (NITEM - bid + nb - 1) / nb : 0, total = nmine * TPI;
    if (nmine == 0) return;
    constexpr int PD = 8;
    static_assert(TPI % PD == 0, "ring");
    f32x4 pf[PD];
#pragma unroll
    for (int i = 0; i < PD; ++i) { const int gi = i < total ? i : total - 1; pf[i] = *(const f32x4*)gu_src(p, bid + (gi / TPI) * nb, gi % TPI, kr, c4); }
    int g = 0;
    for (int it = 0; it < nmine; ++it) {
        const int item = bid + it * nb, e = item / (2 * NPAN), r = item % (2 * NPAN), up = r / NPAN, pn = r % NPAN;
        float am[4] = {0.f, 0.f, 0.f, 0.f}, ss[4] = {0.f, 0.f, 0.f, 0.f};
        for (int t0 = 0; t0 < TPI; t0 += PD) {
#pragma unroll
            for (int u = 0; u < PD; ++u, ++g) { const int t = t0 + u;
                const f32x4 v = pf[u];
                { int gn = g + PD; gn = gn < total ? gn : total - 1; int kr2 = kr; OPAQUE_V(kr2); pf[u] = *(const f32x4*)gu_src(p, bid + (gn / TPI) * nb, gn % TPI, kr2, c4); }
#pragma unroll
                for (int j = 0; j < 4; ++j) { am[j] = fmaxf(am[j], fabsf(v[j])); ss[j] += v[j] * v[j]; pan[(c4 + j) * PSF + t * 64 + kr] = v[j]; }
            }
        }
#pragma unroll
        for (int j = 0; j < 4; ++j) {
#pragma unroll
            for (int o = 8; o <= 32; o <<= 1) { am[j] = fmaxf(am[j], __shfl_xor(am[j], o)); ss[j] += __shfl_xor(ss[j], o); }
        }
        if ((lane >> 3) == 0) {
#pragma unroll
            for (int j = 0; j < 4; ++j) { red[(wid * 32 + c4 + j) * 2] = am[j]; red[(wid * 32 + c4 + j) * 2 + 1] = ss[j]; } }
        __syncthreads();
        if (tid < 64) { float a = 0.f, q = 0.f;
            if (tid < 32) {
#pragma unroll
                for (int w = 0; w < 8; ++w) { a = fmaxf(a, red[(w * 32 + tid) * 2]); q += red[(w * 32 + tid) * 2 + 1]; }
                const float sc = a > 0.f ? a * (1.0f / FP8_TOP) : 1.0f; scl[tid] = sc; scl[32 + tid] = 1.0f / sc;
                const int cc = pn * 32 + tid; p->ws_mgu[(size_t)e * 2 * FFE + (cc >> 7) * 256 + (cc & 127) + up * 128] = sc; }
            const float nm = wave_max(tid < 32 ? sqrtf(q) : 0.f);
            if (tid == 0) (void)GLOBAL_ATOMIC_MAX(p->ctrl + (up ? C_UMAX : C_GMAX) + e, __float_as_uint(nm)); }
        __syncthreads();
#pragma unroll
        for (int i2 = 0; i2 < 8; ++i2) { const int n = i2 * 4 + (tid >> 7), k8 = (tid & 127) * 8, cc = pn * 32 + n;
            const f32x4 a = *(LAS const f32x4*)(pan + n * PSF + k8), b = *(LAS const f32x4*)(pan + n * PSF + k8 + 4); const float inv = scl[32 + n];
            u32x2 w; w.x = pack4_fp8(a[0] * inv, a[1] * inv, a[2] * inv, a[3] * inv); w.y = pack4_fp8(b[0] * inv, b[1] * inv, b[2] * inv, b[3] * inv);
            *(u32x2*)(p->w8_mgu + ((size_t)e * 2 * FFE + (cc >> 7) * 256 + (cc & 127) + up * 128) * DM + k8) = w; }
        __syncthreads();
    }
}
template <bool WITH_GDN, bool OUT8 = false, bool SRCB = false>
__device__ __forceinline__ void phase_norm(KPTR p, const void* src, const float* gain, int bid, int nb, int wv) {
    const int tid = opaque_tid(wv), wid = tid >> 6, lane = tid & 63;
    f32x4 gv[4];
#pragma unroll
    for (int i = 0; i < 4; ++i) gv[i] = *(const f32x4*)(gain + i * 256 + lane * 4);
    f32x4 w8[WITH_GDN ? 16 : 1][2];
    if (WITH_GDN) {
#pragma unroll
        for (int i = 0; i < 4; ++i)
#pragma unroll
            for (int e = 0; e < 4; ++e) { const float* wr_ = p->w_in + (size_t)(i * 256 + lane * 4 + e) * DIN + DINP; w8[i * 4 + e][0] = *(const f32x4*)wr_; w8[i * 4 + e][1] = *(const f32x4*)(wr_ + 4); }
    }
    for (int row = bid * 8 + wid; row < NTOK; row += nb * 8) {
        f32x4 v[4]; if (SRCB) load_row_b((const bf16_t*)src, row, lane, v); else load_row((const float*)src, row, lane, v);
        const float rs = row_rstd(v);
#pragma unroll
        for (int i = 0; i < 4; ++i) v[i] = v[i] * rs * gv[i];
        if (OUT8) store_row_fp8((unsigned char*)p->hn, p->hns, row, lane, v); else store_row_bf16(p->hn, row, lane, v);
        if (WITH_GDN) {
            f32x4 d0 = (f32x4){0.f, 0.f, 0.f, 0.f}, d1 = (f32x4){0.f, 0.f, 0.f, 0.f};
#pragma unroll
            for (int i = 0; i < 4; ++i)
#pragma unroll
                for (int e = 0; e < 4; ++e) { const float xv = v[i][e]; d0 = d0 + w8[i * 4 + e][0] * xv; d1 = d1 + w8[i * 4 + e][1] * xv; }
            float d[8] = {d0[0], d0[1], d0[2], d0[3], d1[0], d1[1], d1[2], d1[3]};
#pragma unroll
            for (int j = 0; j < 8; ++j) d[j] = wave_sum(d[j]);
            if (lane < 4) {
                const float braw = lane == 0 ? d[0] : lane == 1 ? d[1] : lane == 2 ? d[2] : d[3];
                const float araw = lane == 0 ? d[4] : lane == 1 ? d[5] : lane == 2 ? d[6] : d[7];
                p->gbeta[(size_t)row * 4 + lane] = 1.0f / (1.0f + __expf(-braw));
                const float z = araw + p->dt_bias[lane];
                const float sp = z > 20.f ? z : log1pf(__expf(z));
                p->gg[(size_t)row * 4 + lane] = -__expf(p->a_log[lane]) * sp;
            }
        }
    }
}

constexpr int IMG_W = 0, IMG_QD = 17408, IMG_KDT = 34816, IMG_AT = 53248, IMG_U = 62464, IMG_CH = 78848;
__host__ __device__ constexpr int permb(int k) { return (k >> 5) * 64 + ((((k & 15) >> 2) * 8) + (((k >> 4) & 1) * 4) + (k & 3)) * 2; }
__device__ __forceinline__ bf16x8 frag2(LAS const unsigned char* ptr) {
    const u32x2 lo = *(LAS const u32x2*)ptr, hi = *(LAS const u32x2*)(ptr + 32);
    u32x4 w; w.x = lo.x; w.y = lo.y; w.z = hi.x; w.w = hi.y; bf16x8 r; __builtin_memcpy(&r, &w, 16); return r;
}
__device__ __forceinline__ bf16x8 pack8(const f32x4 a, const f32x4 b) {
    u32x4 w; w.x = pack2(a[0], a[1]); w.y = pack2(a[2], a[3]); w.z = pack2(b[0], b[1]); w.w = pack2(b[2], b[3]); bf16x8 r; __builtin_memcpy(&r, &w, 16); return r;
}


#ifndef CPU_EMU
__device__ __forceinline__ void st_wt32(void* p, unsigned v) { __hip_atomic_store((unsigned*)p, v, __ATOMIC_RELAXED, __HIP_MEMORY_SCOPE_AGENT); }
__device__ __forceinline__ void st_wt64(void* p, u32x2 v) { unsigned long long x = ((unsigned long long)v.y << 32) | v.x; __hip_atomic_store((unsigned long long*)p, x, __ATOMIC_RELAXED, __HIP_MEMORY_SCOPE_AGENT); }
#else
static inline void st_wt32(void* p, unsigned v) { *(unsigned*)p = v; }
static inline void st_wt64(void* p, u32x2 v) { *(u32x2*)p = v; }
#endif

#ifndef CPU_EMU
__device__ __forceinline__ void gdn_publish(unsigned* flag, int tid) {
    asm volatile("s_waitcnt vmcnt(0)" ::: "memory");
    __syncthreads();
    if (tid == 0) __hip_atomic_store(flag, 1u, __ATOMIC_RELAXED, __HIP_MEMORY_SCOPE_AGENT);
}
__device__ __forceinline__ void gdn_wait8(const unsigned* flags, int c, int nmax, int lane) {
    const int k = c + (lane & 7); const bool need = k < nmax;
    unsigned spins = 0;
    for (;;) {
        const unsigned v = need ? __hip_atomic_load(flags + k, __ATOMIC_RELAXED, __HIP_MEMORY_SCOPE_AGENT) : 1u;
        if (__all(v != 0u)) break;
        __builtin_amdgcn_s_sleep(4); if (++spins > (1u << 22)) break;
    }
    __builtin_amdgcn_fence(__ATOMIC_ACQUIRE, "agent");
}
__device__ __forceinline__ float ld_coherent(const float* p) { return __uint_as_float(__hip_atomic_load((const unsigned*)p, __ATOMIC_RELAXED, __HIP_MEMORY_SCOPE_AGENT)); }
#else
static inline void gdn_publish(unsigned* flag, int tid) { __syncthreads(); if (tid == 0) __atomic_store_n(flag, 1u, __ATOMIC_SEQ_CST); }
static inline void gdn_wait8(const unsigned* flags, int c, int nmax, int lane) { for (int k = c; k < c + 8 && k < nmax; ++k) while (__atomic_load_n(flags + k, __ATOMIC_SEQ_CST) == 0) emu::yield(); }
static inline float ld_coherent(const float* p) { return *p; }
#endif

template <int I> struct TSolve {
    static __device__ __forceinline__ void run(float (&tc)[64], LAS const float* sL, LAS unsigned char* tb, int lane) {
        TSolve<I - 1>::run(tc, sL, tb, lane);
        float p0 = 0.f, p1 = 0.f, p2 = 0.f, p3 = 0.f;
#pragma unroll
        for (int j = 0; j < I; ++j) { const float pr = sL[I * 68 + j] * tc[j]; if ((j & 3) == 0) p0 += pr; else if ((j & 3) == 1) p1 += pr; else if ((j & 3) == 2) p2 += pr; else p3 += pr; }
        const float t2 = ((I == lane) ? 1.f : 0.f) - ((p0 + p1) + (p2 + p3));
        tc[I] = t2; *(LAS bf16_t*)(tb + I * 144 + 2 * lane) = f2bf(t2);
    }
};
template <> struct TSolve<-1> { static __device__ __forceinline__ void run(float (&)[64], LAS const float*, LAS unsigned char*, int) {} };

template <bool PUBLISH>
__device__ __forceinline__ void phase_gdn_pre(KPTR p, LAS unsigned char* lds, int first, int stride, int wv) {
    constexpr int QB = 0, KB = 17408, VBT = 34816, KBT = 53248, KDT = 71680, LF = 90112, TB = 107520, ATB = 116736, SG = 125952, SBE = 126208;
    const int tid0 = opaque_tid(wv);
    LAS float* sL = (LAS float*)(lds + LF); LAS float* sg = (LAS float*)(lds + SG); LAS float* sb = (LAS float*)(lds + SBE);
    const bf16_t* proj = p->proj; const float* conv_w = p->conv_w; const float* gg = p->gg; const float* gbeta = p->gbeta; unsigned char* gimg = p->gimg; float* gcdec = p->gcdec;
    for (int uu = first; uu < NCHH; uu += stride) {
        int tid = tid0; OPAQUE_V(tid);
        const int wid = tid >> 6, lane = tid & 63, fr = lane & 15, q4 = lane >> 4;
        const int n = uu / (BATCH * 4), bh_ = uu % (BATCH * 4), h = bh_ & 3, b = bh_ >> 2;
        const int unit = bh_ * NCH + n;
        const size_t tok0 = (size_t)b * SEQ + (size_t)n * 64;
        unsigned char* img = gimg + (size_t)unit * IMG_CH;
        __syncthreads();
        if (wid == 0) { float gsum = gg[(tok0 + lane) * 4 + h]; for (int o = 1; o < 64; o <<= 1) { const float t2 = __shfl_up(gsum, o); if (lane >= o) gsum += t2; } sg[lane] = gsum; sb[lane] = gbeta[(tok0 + lane) * 4 + h]; }
        __syncthreads();
        const float glast = sg[63];
        unsigned xall[3][11];
#pragma unroll
        for (int w3 = 0; w3 < 3; ++w3) { const int cc = w3 * 512 + h * 128 + 2 * lane;
#pragma unroll
            for (int r = 0; r < 11; ++r) { const int tt = n * 64 + wid * 8 - 3 + r; xall[w3][r] = tt >= 0 ? *(const unsigned*)(proj + ((size_t)b * SEQ + tt) * DINP + 2048 + cc) : 0u; } }
#pragma unroll
        for (int which = 0; which < 3; ++which) {
            const int rb = wid, c0 = which * 512 + h * 128 + 2 * lane;
            float cw0[4], cw1[4];
#pragma unroll
            for (int kk = 0; kk < 4; ++kk) { cw0[kk] = conv_w[kk * 1536 + c0]; cw1[kk] = conv_w[kk * 1536 + c0 + 1]; }
            unsigned xv[11];
#pragma unroll
            for (int r = 0; r < 11; ++r) xv[r] = xall[which][r];
            float a0[8], a1[8], ss[8];
#pragma unroll
            for (int i8 = 0; i8 < 8; ++i8) { float y0 = 0.f, y1 = 0.f;
#pragma unroll
                for (int kk = 0; kk < 4; ++kk) { y0 += cw0[kk] * __uint_as_float(xv[i8 + kk] << 16); y1 += cw1[kk] * __uint_as_float(xv[i8 + kk] & 0xffff0000u); }
                a0[i8] = siluf(y0); a1[i8] = siluf(y1); ss[i8] = a0[i8] * a0[i8] + a1[i8] * a1[i8]; }
            if (which != 2) {
#pragma unroll
                for (int i8 = 0; i8 < 8; ++i8) ss[i8] = wave_sum(ss[i8]);
            }
#pragma unroll
            for (int i8 = 0; i8 < 8; ++i8) {
                const int i = rb * 8 + i8;
                const float gi = sg[i], bi = sb[i], eg = __expf(gi);
                if (which == 2) {
                    *(LAS bf16_t*)(lds + VBT + (2 * lane) * 144 + 2 * i) = f2bf(a0[i8] * bi); *(LAS bf16_t*)(lds + VBT + (2 * lane + 1) * 144 + 2 * i) = f2bf(a1[i8] * bi);
                } else {
                    const float sc = rsqrtf(ss[i8] + NORM_EPS) * (which == 0 ? 0.08838834764831845f : 1.0f);
                    const float n0 = a0[i8] * sc, n1 = a1[i8] * sc;
                    if (which == 0) { *(LAS unsigned*)(lds + QB + i * 272 + 4 * lane) = pack2(n0, n1); st_wt32(img + IMG_QD + i * 272 + permb(2 * lane), pack2(n0 * eg, n1 * eg)); }
                    else { *(LAS unsigned*)(lds + KB + i * 272 + 4 * lane) = pack2(n0, n1);
                        const float f1 = bi * eg, f2 = __expf(glast - gi);
                        *(LAS bf16_t*)(lds + KBT + (2 * lane) * 144 + 2 * i) = f2bf(n0 * f1); *(LAS bf16_t*)(lds + KBT + (2 * lane + 1) * 144 + 2 * i) = f2bf(n1 * f1);
                        *(LAS bf16_t*)(lds + KDT + (2 * lane) * 144 + permb(i)) = f2bf(n0 * f2); *(LAS bf16_t*)(lds + KDT + (2 * lane + 1) * 144 + permb(i)) = f2bf(n1 * f2); }
                }
            }
        }
        __syncthreads();
        {
            const int mat = wid >> 2, itile = wid & 3;
            LAS const unsigned char* abase = lds + (mat == 0 ? KB : QB) + (16 * itile + fr) * 272 + 16 * q4;
            bf16x8 af[4];
#pragma unroll
            for (int s4 = 0; s4 < 4; ++s4) af[s4] = *(LAS const bf16x8*)(abase + 64 * s4);
#pragma unroll
            for (int nt = 0; nt < 4; ++nt) {
                f32x4 acc = (f32x4){0.f, 0.f, 0.f, 0.f};
                if (nt <= itile) {
#pragma unroll
                    for (int s4 = 0; s4 < 4; ++s4) { const bf16x8 bfr = *(LAS const bf16x8*)(lds + KB + (16 * nt + fr) * 272 + 16 * q4 + 64 * s4);
                        acc = __builtin_amdgcn_mfma_f32_16x16x32_bf16(af[s4], bfr, acc, 0, 0, 0); }
                }
                const int j = 16 * nt + fr; const float gj = sg[j];
#pragma unroll
                for (int r = 0; r < 4; ++r) { const int i = 16 * itile + 4 * q4 + r; const float dec = __expf(sg[i] - gj);
                    if (mat == 0) sL[i * 68 + j] = i > j ? sb[i] * acc[r] * dec : 0.f;
                    else *(LAS bf16_t*)(lds + ATB + i * 144 + permb(j)) = f2bf(i >= j ? acc[r] * dec : 0.f); }
            }
        }
        __syncthreads();
        if (wid == 0) {
            float tc[64];
            TSolve<63>::run(tc, sL, lds + TB, lane);
        } else {
            for (int pc = tid - 64; pc < 1152 + 576; pc += NTHREADS - 64) {
                if (pc < 1152) { const u32x4 v4 = *(LAS const u32x4*)(lds + KDT + pc * 16); u32x2 a; a.x = v4.x; a.y = v4.y; u32x2 c; c.x = v4.z; c.y = v4.w; st_wt64(img + IMG_KDT + pc * 16, a); st_wt64(img + IMG_KDT + pc * 16 + 8, c); }
                else { const u32x4 v4 = *(LAS const u32x4*)(lds + ATB + (pc - 1152) * 16); u32x2 a; a.x = v4.x; a.y = v4.y; u32x2 c; c.x = v4.z; c.y = v4.w; st_wt64(img + IMG_AT + (pc - 1152) * 16, a); st_wt64(img + IMG_AT + (pc - 1152) * 16 + 8, c); }
            }
        }
        __syncthreads();
        {
            const int itile = wid & 3;
            bf16x8 tf[2];
#pragma unroll
            for (int s2 = 0; s2 < 2; ++s2) tf[s2] = *(LAS const bf16x8*)(lds + TB + (16 * itile + fr) * 144 + 16 * q4 + 64 * s2);
#pragma unroll
            for (int nt = 0; nt < 8; ++nt) {
                f32x4 acc = (f32x4){0.f, 0.f, 0.f, 0.f};
                if (wid < 4) {
#pragma unroll
                    for (int s2 = 0; s2 < 2; ++s2) { const bf16x8 bfr = *(LAS const bf16x8*)(lds + VBT + (16 * nt + fr) * 144 + 16 * q4 + 64 * s2);
                        acc = __builtin_amdgcn_mfma_f32_16x16x32_bf16(tf[s2], bfr, acc, 0, 0, 0); }
                    u32x2 w; w.x = pack2(acc[0], acc[1]); w.y = pack2(acc[2], acc[3]);
                    st_wt64(img + IMG_U + ((nt * 4 + itile) * 64 + lane) * 8, w);
                } else {
#pragma unroll
                    for (int s2 = 0; s2 < 2; ++s2) { const bf16x8 afr = *(LAS const bf16x8*)(lds + KBT + (16 * nt + fr) * 144 + 16 * q4 + 64 * s2);
                        acc = __builtin_amdgcn_mfma_f32_16x16x32_bf16(afr, tf[s2], acc, 0, 0, 0); }
                    u32x2 w; w.x = pack2(acc[0], acc[1]); w.y = pack2(acc[2], acc[3]);
                    st_wt64(img + IMG_W + (16 * itile + fr) * 272 + permb(16 * nt + 4 * q4), w);
                }
            }
        }
        if (tid == 0) st_wt32(gcdec + unit, __float_as_uint(__expf(glast)));
        if (PUBLISH) gdn_publish(p->gflag + unit, tid);
    }
}

constexpr int NCW = 2, NLT = NTHREADS - 64 * NCW;
constexpr int STG = 62464 + NCW * 2048;
#define LDF(ptr) (*(LAS const bf16x8*)(ptr))
#define MF16(a, b, c) __builtin_amdgcn_mfma_f32_16x16x32_bf16((a), (b), (c), 0, 0, 0)
__device__ __forceinline__ void scan_store_ot(bf16_t* op, const f32x4 (&ao)[4]) {
#pragma unroll
    for (int it = 0; it < 4; ++it) { u32x2 w; w.x = pack2(ao[it][0], ao[it][1]); w.y = pack2(ao[it][2], ao[it][3]); *(u32x2*)(op + (size_t)(16 * it) * DM) = w; }
}
__device__ __forceinline__ void scan_store_o(bf16_t* op, const f32x4 (&ao)[4], int q4) {
#pragma unroll
    for (int it = 0; it < 4; ++it)
#pragma unroll
        for (int r = 0; r < 4; ++r) op[(size_t)(16 * it + 4 * q4 + r) * DM] = f2bf(ao[it][r]);
}
__device__ __forceinline__ bf16x8 asfrag(const u32x4 v) { bf16x8 r; __builtin_memcpy(&r, &v, 16); return r; }
#define LDR(ptr) (*(LAS const u32x4*)(ptr))
template <bool WAITF>
__device__ __forceinline__ void scan_gdn(KPTR p, LAS unsigned char* lds, int b, int h, int qt, int wv) {
    const unsigned* gflag = p->gflag + (size_t)(b * 4 + h) * NCH;
    const int tid = opaque_tid(wv), wid = tid >> 6, lane = tid & 63, fr = lane & 15, q4 = lane >> 4;
    const unsigned char* gimg = p->gimg; const float* gcdec = p->gcdec + (size_t)(b * 4 + h) * NCH; bf16_t* out = p->hn;
    const bool loader = wid >= NCW;
    const int cw = wid, lt = tid - 64 * NCW;
    f32x4 S[8];
#pragma unroll
    for (int dt = 0; dt < 8; ++dt) S[dt] = (f32x4){0.f, 0.f, 0.f, 0.f};
    constexpr int NLG = NLT / 2;
    constexpr int NPC = 3904 + NCW * 128, NPR = (NPC + NLG - 1) / NLG;
    static_assert(NPR >= 16, "compute waves use R[0..7] and R[8..15] as their two operand batches");
    u32x4 R[NPR];
    float cdv = 0.f;
    constexpr int OUTB = 2 * STG, CDB = OUTB + 8192;
    const int grp = lt >= NLG ? 1 : 0, lg_ = lt - grp * NLG;
    const unsigned char* base = gimg + (size_t)(b * 4 + h) * NCH * IMG_CH;
#define GDN_PREFETCH(nn) do { int _lg = lg_; OPAQUE_V(_lg); const unsigned char* _src = base + (size_t)(nn) * IMG_CH; _Pragma("unroll") for (int _i = 0; _i < NPR; ++_i) { int _pc = _lg + NLG * _i; _pc = _pc < NPC ? _pc : NPC - 1; \
        const int _so = _pc < 3904 ? _pc * 16 : IMG_U + qt * (NCW * 2048) + (_pc - 3904) * 16; R[_i] = *(const u32x4*)(_src + _so); } cdv = ld_coherent(gcdec + (nn)); } while (0)
    int avail = 0;
    if (loader && grp < NCH) { if (WAITF) { gdn_wait8(gflag, 0, NCH, lane); avail = 8; } GDN_PREFETCH(grp); }
    float cd_next = 0.f;
    __syncthreads();
    auto load_step = [&](int nn) {
        if (nn < NCH && (nn & 1) == grp) {
            LAS unsigned char* buf = lds + (nn & 1) * STG;
#pragma unroll
            for (int i = 0; i < NPR; ++i) { int pc = lg_ + NLG * i; pc = pc < NPC ? pc : NPC - 1; *(LAS u32x4*)(buf + pc * 16) = R[i]; }
            if (lg_ == 0) *(LAS float*)(lds + CDB + (nn & 1) * 8) = cdv;
            if (nn + 2 < NCH) { if (WAITF && nn + 2 >= avail) { gdn_wait8(gflag, avail, NCH, lane); avail += 8; } GDN_PREFETCH(nn + 2); }
        }
    };
    auto flush = [&](int n) {
        for (int pc = lg_; pc < NCW * 256; pc += NLG) { const int cwi = pc >> 8, it = (pc >> 6) & 3, ln = pc & 63;
            const u32x2 w = *(LAS const u32x2*)(lds + OUTB + (n & 1) * 4096 + pc * 8);
            *(u32x2*)(out + ((size_t)b * SEQ + (size_t)n * 64 + 16 * it + (ln & 15)) * DM + 512 + h * 128 + 16 * (NCW * qt + cwi) + 4 * (ln >> 4)) = w; }
    };
    auto compute = [&](int n) {

            LAS const unsigned char* buf = lds + (n & 1) * STG;
            const float cd = *(LAS const float*)(lds + CDB + (n & 1) * 8);
            LAS const unsigned char* pw = buf + IMG_W + fr * 272 + 16 * q4;
            LAS const unsigned char* pq = buf + IMG_QD + fr * 272 + 16 * q4;
            LAS const unsigned char* pk = buf + IMG_KDT + fr * 144 + 16 * q4;
            LAS const unsigned char* pa = buf + IMG_AT + fr * 144 + 16 * q4;
            bf16x8 Sb[4];
#pragma unroll
            for (int s4 = 0; s4 < 4; ++s4) Sb[s4] = pack8(S[2 * s4], S[2 * s4 + 1]);
            f32x4 ao[4], av[4];
            u32x2 uu[4];
#pragma unroll
            for (int it = 0; it < 4; ++it) uu[it] = *(LAS const u32x2*)(buf + IMG_U + ((cw * 4 + it) * 64 + lane) * 8);
            u32x4* RA = R; u32x4* RB = R + 8;
#define GDN_LD_WQ(RR, it_) do { _Pragma("unroll") for (int s4 = 0; s4 < 4; ++s4) { RR[s4] = LDR(pw + (16 * (it_)) * 272 + 64 * s4); RR[4 + s4] = LDR(pq + (16 * (it_)) * 272 + 64 * s4); } } while (0)
#define GDN_LD_K(RR, dh_) do { _Pragma("unroll") for (int d2 = 0; d2 < 4; ++d2) _Pragma("unroll") for (int s2 = 0; s2 < 2; ++s2) RR[d2 * 2 + s2] = LDR(pk + (16 * (4 * (dh_) + d2)) * 144 + 64 * s2); } while (0)
#define GDN_MM_WQ(RR, it_) do { av[it_] = (f32x4){0.f, 0.f, 0.f, 0.f}; ao[it_] = (f32x4){0.f, 0.f, 0.f, 0.f}; \
        _Pragma("unroll") for (int s4 = 0; s4 < 4; ++s4) { av[it_] = MF16(asfrag(RR[s4]), Sb[s4], av[it_]); ao[it_] = MF16(Sb[s4], asfrag(RR[4 + s4]), ao[it_]); } } while (0)
#define GDN_MM_K(RR, dh_) do { _Pragma("unroll") for (int d2 = 0; d2 < 4; ++d2) { S[4 * (dh_) + d2] = S[4 * (dh_) + d2] * cd; \
        _Pragma("unroll") for (int s2 = 0; s2 < 2; ++s2) S[4 * (dh_) + d2] = MF16(asfrag(RR[d2 * 2 + s2]), Vb[s2], S[4 * (dh_) + d2]); } } while (0)
            GDN_LD_WQ(RA, 0); SCHED_FENCE();
            GDN_LD_WQ(RB, 1); SCHED_FENCE(); GDN_MM_WQ(RA, 0); SCHED_FENCE();
            GDN_LD_WQ(RA, 2); SCHED_FENCE(); GDN_MM_WQ(RB, 1); SCHED_FENCE();
            GDN_LD_WQ(RB, 3); SCHED_FENCE(); GDN_MM_WQ(RA, 2); SCHED_FENCE();
            GDN_LD_K(RA, 0); SCHED_FENCE(); GDN_MM_WQ(RB, 3); SCHED_FENCE();
#pragma unroll
            for (int it = 0; it < 4; ++it) {
                av[it][0] = __uint_as_float(uu[it].x << 16) - av[it][0]; av[it][1] = __uint_as_float(uu[it].x & 0xffff0000u) - av[it][1];
                av[it][2] = __uint_as_float(uu[it].y << 16) - av[it][2]; av[it][3] = __uint_as_float(uu[it].y & 0xffff0000u) - av[it][3]; }
            bf16x8 Vb[2];
#pragma unroll
            for (int s2 = 0; s2 < 2; ++s2) Vb[s2] = pack8(av[2 * s2], av[2 * s2 + 1]);
            GDN_LD_K(RB, 1); SCHED_FENCE(); GDN_MM_K(RA, 0); SCHED_FENCE();
#pragma unroll
            for (int it = 0; it < 4; ++it)
#pragma unroll
                for (int s2 = 0; s2 < 2; ++s2) R[it * 2 + s2] = LDR(pa + (16 * it) * 144 + 64 * s2);
            SCHED_FENCE(); GDN_MM_K(RB, 1); SCHED_FENCE();
#pragma unroll
            for (int it = 0; it < 4; ++it)
#pragma unroll
                for (int s2 = 0; s2 < 2; ++s2) ao[it] = MF16(Vb[s2], asfrag(R[it * 2 + s2]), ao[it]);
#undef GDN_LD_WQ
#undef GDN_LD_K
#undef GDN_MM_WQ
#undef GDN_MM_K
#pragma unroll
            for (int it = 0; it < 4; ++it) { u32x2 w; w.x = pack2(ao[it][0], ao[it][1]); w.y = pack2(ao[it][2], ao[it][3]); *(LAS u32x2*)(lds + OUTB + (n & 1) * 4096 + ((cw * 4 + it) * 64 + lane) * 8) = w; }
            };
    for (int n = -1; n < NCH; ++n) {
        if (loader) { load_step(n + 1); if (n >= 1 && (n & 1) == grp) flush(n - 1); } else if (n >= 0) compute(n);
        __syncthreads();
    }
    if (loader && grp == 0) flush(NCH - 1);
#undef GDN_PREFETCH
}
#ifndef CG_FORCE
#define CG_FORCE 0
#endif
constexpr int CG = CG_FORCE ? CG_FORCE : (NCH >= 256 ? 8 : 4), NG = NCH / CG;
template <int MODE>
__device__ __forceinline__ void scan_ret(KPTR p, LAS unsigned char* lds, int b, int h, int qt, int g, int wv) {
    const int n0 = g * CG;
    constexpr int R_Q = 0, R_K = 17408, R_KDT = 34816, R_VT = 53248;
    constexpr int RAT_OFF = 2 * STG;
    const int tid = opaque_tid(wv), wid = tid >> 6, lane = tid & 63, fr = lane & 15, q4 = lane >> 4;
    const bf16_t* proj = p->proj; bf16_t* out = p->hn; float* Lb = p->retL;
    const bool loader = wid >= NCW;
    const int cw = wid, lt = tid - 64 * NCW;
    const float lg = log1pf(-exp2f(-5.0f - (float)h));
    f32x4 S[8];
#pragma unroll
    for (int dt = 0; dt < 8; ++dt) S[dt] = (f32x4){0.f, 0.f, 0.f, 0.f};
    const float rcd = __expf(lg * 64.f), g1 = __expf(lg);
    if (MODE == 1 && !loader) {
        const float gdec = __expf(lg * (float)(64 * CG)); float wgt = 1.f;
        for (int gp = g - 1; gp >= 0; --gp) {
            const f32x4* lp = (const f32x4*)Lb + ((((size_t)(b * 4 + h) * NG + gp) * (8 / NCW) + qt) * NCW + cw) * 8 * 64 + lane;
#pragma unroll
            for (int dt = 0; dt < 8; ++dt) S[dt] = S[dt] + lp[dt * 64] * wgt;
            wgt *= gdec;
        }
    }
    float gi[4];
#pragma unroll
    for (int t4 = 0; t4 < 4; ++t4) gi[t4] = __expf(lg * (float)(16 * t4 + fr));
    constexpr int NLG = NLT / 2, NQG = (1024 + NLG - 1) / NLG, KB_N = 256 - NLG;
    static_assert(NLG >= 128 && NLG <= 256 && KB_N + 32 * NCW <= NLG, "task slots");
    u32x4 R[NQG + 8 < 16 ? 16 : NQG + 8];
    const int grp = lt >= NLG ? 1 : 0, lg_ = lt - grp * NLG;
#define RET_PREFETCH(nn) do { int _l = lg_; OPAQUE_V(_l); const bf16_t* _pq = proj + ((size_t)b * SEQ + (size_t)(n0 + (nn)) * 64) * DINP + h * 128; \
        _Pragma("unroll") for (int _i = 0; _i < NQG; ++_i) { int _pc = _l + NLG * _i; _pc = _pc < 1024 ? _pc : 1023; const int _row = _pc >> 4, _c = _pc & 15; R[_i] = *(const u32x4*)(_pq + (size_t)_row * DINP + _c * 8); } \
        _Pragma("unroll") for (int _r = 0; _r < 4; ++_r) R[NQG + _r] = *(const u32x4*)(_pq + (size_t)(4 * (_l >> 4) + _r) * DINP + 512 + (_l & 15) * 8); \
        { const bool _isk = _l < KB_N; int _v = _l - KB_N; _v = _v < 0 ? 0 : (_v < 32 * NCW ? _v : 32 * NCW - 1); const int _t = NLG + (_isk ? _l : 0); \
          const int _r0 = _isk ? 4 * (_t >> 4) : 4 * (_v >> 2), _co = _isk ? 512 + (_t & 15) * 8 : 1024 + 16 * NCW * qt + (_v & 3) * 8; \
          _Pragma("unroll") for (int _r = 0; _r < 4; ++_r) R[NQG + 4 + _r] = *(const u32x4*)(_pq + (size_t)(_r0 + _r) * DINP + _co); } } while (0)
#define RET_WRITE_K(RB_, t_) do { const int ig = (t_) >> 4, ck = (t_) & 15; float sc[4]; \
        _Pragma("unroll") for (int r = 0; r < 4; ++r) { sc[r] = 0.08838834764831845f * __expf(lg * (float)(63 - 4 * ig - r)); \
            u32x2 a; a.x = R[(RB_) + r].x; a.y = R[(RB_) + r].y; u32x2 c2; c2.x = R[(RB_) + r].z; c2.y = R[(RB_) + r].w; \
            *(LAS u32x2*)(buf + R_K + (4 * ig + r) * 272 + permb(8 * ck)) = a; *(LAS u32x2*)(buf + R_K + (4 * ig + r) * 272 + permb(8 * ck + 4)) = c2; } \
        _Pragma("unroll") for (int e = 0; e < 8; ++e) { const int wsel = e >> 1; float x[4]; \
            _Pragma("unroll") for (int r = 0; r < 4; ++r) x[r] = ((e & 1) ? __uint_as_float(R[(RB_) + r][wsel] & 0xffff0000u) : __uint_as_float(R[(RB_) + r][wsel] << 16)) * sc[r]; \
            u32x2 o; o.x = pack2(x[0], x[1]); o.y = pack2(x[2], x[3]); *(LAS u32x2*)(buf + R_KDT + (8 * ck + e) * 144 + permb(4 * ig)) = o; } } while (0)
    if (loader && grp < CG) RET_PREFETCH(grp);
    __syncthreads();
    auto load_step = [&](int nn) {
        if (nn < CG && (nn & 1) == grp) {
            LAS unsigned char* buf = lds + (nn & 1) * STG; int l2 = lg_; OPAQUE_V(l2);
#pragma unroll
            for (int i = 0; i < NQG; ++i) { int pc = l2 + NLG * i; pc = pc < 1024 ? pc : 1023; const int row = pc >> 4, c = pc & 15;
                u32x2 a; a.x = R[i].x; a.y = R[i].y; u32x2 c2; c2.x = R[i].z; c2.y = R[i].w;
                *(LAS u32x2*)(buf + R_Q + row * 272 + permb(8 * c)) = a; *(LAS u32x2*)(buf + R_Q + row * 272 + permb(8 * c + 4)) = c2; }
            RET_WRITE_K(NQG, l2);
            if (l2 < KB_N) { RET_WRITE_K(NQG + 4, NLG + l2); }
            else if (l2 < KB_N + 32 * NCW) { const int v = l2 - KB_N, igv = v >> 2, cv = v & 3;
#pragma unroll
                for (int e = 0; e < 8; ++e) { const int wsel = e >> 1, sh = 16 * (e & 1);
                    u32x2 o; o.x = ((R[NQG + 4][wsel] >> sh) & 0xffffu) | (((R[NQG + 5][wsel] >> sh) & 0xffffu) << 16); o.y = ((R[NQG + 6][wsel] >> sh) & 0xffffu) | (((R[NQG + 7][wsel] >> sh) & 0xffffu) << 16);
                    *(LAS u32x2*)(buf + R_VT + (8 * cv + e) * 144 + permb(4 * igv)) = o; } }
            if (nn + 2 < CG) RET_PREFETCH(nn + 2);
        }
    };
    auto scores = [&](int n) {
        LAS const unsigned char* buf = lds + (n & 1) * STG;
        const int lw = wid - NCW;
#pragma unroll
        for (int rep = 0; rep < 2; ++rep) {
            const int tl = lw + (NTHREADS / 64 - NCW) * rep;
            if (tl < 12) {
                int it, jt;
                if (tl < 1) { it = 0; jt = 0; } else if (tl < 3) { it = 1; jt = tl - 1; } else if (tl < 6) { it = 2; jt = tl - 3; } else if (tl < 10) { it = 3; jt = tl - 6; } else if (tl == 10) { it = 0; jt = 1; } else { it = 2; jt = 3; }
                f32x4 acc = (f32x4){0.f, 0.f, 0.f, 0.f};
                if (tl < 10) {
                    bf16x8 kf[4], qf[4];
#pragma unroll
                    for (int s4 = 0; s4 < 4; ++s4) { kf[s4] = LDF(buf + R_K + (16 * jt + fr) * 272 + 64 * s4 + 16 * q4); qf[s4] = LDF(buf + R_Q + (16 * it + fr) * 272 + 64 * s4 + 16 * q4); }
#pragma unroll
                    for (int s4 = 0; s4 < 4; ++s4) acc = MF16(kf[s4], qf[s4], acc);
                    const float gi_ = __expf(lg * (float)(16 * it + fr));
#pragma unroll
                    for (int r = 0; r < 4; ++r) { const int j = 16 * jt + 4 * q4 + r, i = 16 * it + fr;
                        acc[r] = i >= j ? acc[r] * gi_ * 0.08838834764831845f * __expf(-lg * (float)j) : 0.f; }
                }
                u32x2 w; w.x = pack2(acc[0], acc[1]); w.y = pack2(acc[2], acc[3]);
                *(LAS u32x2*)(lds + RAT_OFF + (16 * it + fr) * 144 + permb(16 * jt + 4 * q4)) = w;
            }
        }
    };
    f32x4 ot[4];
    bf16x8 Vf[2];
    auto computeA = [&](int n) {
        LAS const unsigned char* buf = lds + (n & 1) * STG;
        LAS const unsigned char* pq = buf + R_Q + fr * 272 + 16 * q4;
        LAS const unsigned char* pk = buf + R_KDT + fr * 144 + 16 * q4;
        bf16x8 Sb[4];
#pragma unroll
        for (int s4 = 0; s4 < 4; ++s4) Sb[s4] = pack8(S[2 * s4], S[2 * s4 + 1]);
#pragma unroll
        for (int s2 = 0; s2 < 2; ++s2) Vf[s2] = LDF(buf + R_VT + (16 * cw + fr) * 144 + 64 * s2 + 16 * q4);
        u32x4* RA = R; u32x4* RB = R + 8;
#define RET_LD_Q(RR, hh_) do { _Pragma("unroll") for (int i2 = 0; i2 < 2; ++i2) _Pragma("unroll") for (int s4 = 0; s4 < 4; ++s4) RR[i2 * 4 + s4] = LDR(pq + (16 * (2 * (hh_) + i2)) * 272 + 64 * s4); } while (0)
#define RET_LD_K(RR, dh_) do { _Pragma("unroll") for (int d2 = 0; d2 < 4; ++d2) _Pragma("unroll") for (int s2 = 0; s2 < 2; ++s2) RR[d2 * 2 + s2] = LDR(pk + (16 * (4 * (dh_) + d2)) * 144 + 64 * s2); } while (0)
#define RET_MM_Q(RR, hh_) do { _Pragma("unroll") for (int i2 = 0; i2 < 2; ++i2) { const int it = 2 * (hh_) + i2; ot[it] = (f32x4){0.f, 0.f, 0.f, 0.f}; \
        _Pragma("unroll") for (int s4 = 0; s4 < 4; ++s4) ot[it] = MF16(Sb[s4], asfrag(RR[i2 * 4 + s4]), ot[it]); \
        const float rd = gi[it] * g1; _Pragma("unroll") for (int r = 0; r < 4; ++r) ot[it][r] *= rd; } } while (0)
#define RET_MM_K(RR, dh_) do { _Pragma("unroll") for (int d2 = 0; d2 < 4; ++d2) { S[4 * (dh_) + d2] = S[4 * (dh_) + d2] * rcd; \
        _Pragma("unroll") for (int s2 = 0; s2 < 2; ++s2) S[4 * (dh_) + d2] = MF16(asfrag(RR[d2 * 2 + s2]), Vf[s2], S[4 * (dh_) + d2]); } } while (0)
        RET_LD_K(RA, 0); SCHED_FENCE();
        RET_LD_K(RB, 1); SCHED_FENCE(); RET_MM_K(RA, 0); SCHED_FENCE();
        if (MODE == 1) {
            RET_LD_Q(RA, 0); SCHED_FENCE(); RET_MM_K(RB, 1); SCHED_FENCE();
            RET_LD_Q(RB, 1); SCHED_FENCE(); RET_MM_Q(RA, 0); SCHED_FENCE();
            RET_MM_Q(RB, 1);
        } else { RET_MM_K(RB, 1); }
#undef RET_LD_Q
#undef RET_LD_K
#undef RET_MM_Q
#undef RET_MM_K
    };
    auto computeB = [&](int n) {
        LAS const unsigned char* pa = lds + RAT_OFF + fr * 144 + 16 * q4;
        R[0] = LDR(pa); R[1] = LDR(pa + 16 * 144); R[2] = LDR(pa + 32 * 144); R[3] = LDR(pa + 32 * 144 + 64); R[4] = LDR(pa + 48 * 144); R[5] = LDR(pa + 48 * 144 + 64);
        SCHED_FENCE();
        ot[0] = MF16(Vf[0], asfrag(R[0]), ot[0]); ot[1] = MF16(Vf[0], asfrag(R[1]), ot[1]);
        ot[2] = MF16(Vf[0], asfrag(R[2]), ot[2]); ot[2] = MF16(Vf[1], asfrag(R[3]), ot[2]);
        ot[3] = MF16(Vf[0], asfrag(R[4]), ot[3]); ot[3] = MF16(Vf[1], asfrag(R[5]), ot[3]);
        scan_store_ot(out + ((size_t)b * SEQ + (size_t)(n0 + n) * 64 + fr) * DM + h * 128 + 16 * (NCW * qt + cw) + 4 * q4, ot);
    };
    for (int n = -1; n < CG; ++n) {
        if (loader) { if (MODE == 1 && n >= 0) scores(n); load_step(n + 1); } else if (n >= 0) computeA(n);
        __syncthreads();
        if (MODE == 1) {
            if (!loader && n >= 0) computeB(n);
            __syncthreads();
        }
    }
    if (MODE == 0 && !loader) {
        f32x4* lp = (f32x4*)Lb + ((((size_t)(b * 4 + h) * NG + g) * (8 / NCW) + qt) * NCW + cw) * 8 * 64 + lane;
#pragma unroll
        for (int dt = 0; dt < 8; ++dt) lp[dt * 64] = S[dt];
    }
#undef RET_PREFETCH
#undef RET_WRITE_K
}
template <int MODE>
__device__ __forceinline__ void scan_ret_full(KPTR p, LAS unsigned char* lds, int b, int h, int g, int wv) {
    constexpr int F_Q = 0, F_K = 17408, F_KDT = 34816, F_VT = 53248, F_RAT = 71680;
    const int n0 = g * CG;
    const int tid = opaque_tid(wv), wid = tid >> 6, lane = tid & 63, fr = lane & 15, q4 = lane >> 4, cw = wid;
    const bf16_t* proj = p->proj; bf16_t* out = p->hn; float* Lb = p->retL;
    const float lg = log1pf(-exp2f(-5.0f - (float)h));
    const float rcd = __expf(lg * 64.f), g1 = __expf(lg);
    f32x4 S[8];
#pragma unroll
    for (int dt = 0; dt < 8; ++dt) S[dt] = (f32x4){0.f, 0.f, 0.f, 0.f};
    if (MODE == 1) {
        const float gdec = __expf(lg * (float)(64 * CG)); float wgt = 1.f;
        for (int gp = g - 1; gp >= 0; --gp) {
            const f32x4* lp = (const f32x4*)Lb + (((size_t)(b * 4 + h) * NG + gp) * 8 + cw) * 8 * 64 + lane;
#pragma unroll
            for (int dt = 0; dt < 8; ++dt) S[dt] = S[dt] + lp[dt * 64] * wgt;
            wgt *= gdec;
        }
    }
    float gi[4];
#pragma unroll
    for (int t4 = 0; t4 < 4; ++t4) gi[t4] = __expf(lg * (float)(16 * t4 + fr));
    u32x4 rq[2], rkv[4];
#define RF_PREFETCH(nn) do { int _l = tid; OPAQUE_V(_l); const bf16_t* _pq = proj + ((size_t)b * SEQ + (size_t)(n0 + (nn)) * 64) * DINP + h * 128; \
        _Pragma("unroll") for (int _i = 0; _i < 2; ++_i) { const int _pc = _l + NTHREADS * _i; rq[_i] = *(const u32x4*)(_pq + (size_t)(_pc >> 4) * DINP + (_pc & 15) * 8); } \
        { const bool _isk = _l < 256; const int _t = _isk ? _l : _l - 256; const int _r0 = 4 * (_t >> 4), _co = (_isk ? 512 : 1024) + (_t & 15) * 8; \
          _Pragma("unroll") for (int _r = 0; _r < 4; ++_r) rkv[_r] = *(const u32x4*)(_pq + (size_t)(_r0 + _r) * DINP + _co); } } while (0)
    auto write_stage = [&]() {
        int l2 = tid; OPAQUE_V(l2);
#pragma unroll
        for (int i = 0; i < 2; ++i) { const int pc = l2 + NTHREADS * i, row = pc >> 4, c = pc & 15;
            u32x2 a; a.x = rq[i].x; a.y = rq[i].y; u32x2 c2; c2.x = rq[i].z; c2.y = rq[i].w;
            *(LAS u32x2*)(lds + F_Q + row * 272 + permb(8 * c)) = a; *(LAS u32x2*)(lds + F_Q + row * 272 + permb(8 * c + 4)) = c2; }
        if (l2 < 256) { const int ig = l2 >> 4, ck = l2 & 15; float sc[4];
#pragma unroll
            for (int r = 0; r < 4; ++r) { sc[r] = 0.08838834764831845f * __expf(lg * (float)(63 - 4 * ig - r));
                u32x2 a; a.x = rkv[r].x; a.y = rkv[r].y; u32x2 c2; c2.x = rkv[r].z; c2.y = rkv[r].w;
                *(LAS u32x2*)(lds + F_K + (4 * ig + r) * 272 + permb(8 * ck)) = a; *(LAS u32x2*)(lds + F_K + (4 * ig + r) * 272 + permb(8 * ck + 4)) = c2; }
#pragma unroll
            for (int e = 0; e < 8; ++e) { const int wsel = e >> 1; float x[4];
#pragma unroll
                for (int r = 0; r < 4; ++r) x[r] = ((e & 1) ? __uint_as_float(rkv[r][wsel] & 0xffff0000u) : __uint_as_float(rkv[r][wsel] << 16)) * sc[r];
                u32x2 o; o.x = pack2(x[0], x[1]); o.y = pack2(x[2], x[3]); *(LAS u32x2*)(lds + F_KDT + (8 * ck + e) * 144 + permb(4 * ig)) = o; }
        } else { const int v = l2 - 256, igv = v >> 4, cv = v & 15;
#pragma unroll
            for (int e = 0; e < 8; ++e) { const int wsel = e >> 1, sh = 16 * (e & 1);
                u32x2 o; o.x = ((rkv[0][wsel] >> sh) & 0xffffu) | (((rkv[1][wsel] >> sh) & 0xffffu) << 16); o.y = ((rkv[2][wsel] >> sh) & 0xffffu) | (((rkv[3][wsel] >> sh) & 0xffffu) << 16);
                *(LAS u32x2*)(lds + F_VT + (8 * cv + e) * 144 + permb(4 * igv)) = o; } }
    };
    auto scores = [&]() {
#pragma unroll
        for (int rep = 0; rep < 2; ++rep) {
            const int tl = wid + 8 * rep;
            if (tl < 12) {
                int it, jt;
                if (tl < 1) { it = 0; jt = 0; } else if (tl < 3) { it = 1; jt = tl - 1; } else if (tl < 6) { it = 2; jt = tl - 3; } else if (tl < 10) { it = 3; jt = tl - 6; } else if (tl == 10) { it = 0; jt = 1; } else { it = 2; jt = 3; }
                f32x4 acc = (f32x4){0.f, 0.f, 0.f, 0.f};
                if (tl < 10) {
                    bf16x8 kf[4], qf[4];
#pragma unroll
                    for (int s4 = 0; s4 < 4; ++s4) { kf[s4] = LDF(lds + F_K + (16 * jt + fr) * 272 + 64 * s4 + 16 * q4); qf[s4] = LDF(lds + F_Q + (16 * it + fr) * 272 + 64 * s4 + 16 * q4); }
#pragma unroll
                    for (int s4 = 0; s4 < 4; ++s4) acc = MF16(kf[s4], qf[s4], acc);
                    const float gi_ = __expf(lg * (float)(16 * it + fr));
#pragma unroll
                    for (int r = 0; r < 4; ++r) { const int j = 16 * jt + 4 * q4 + r, i = 16 * it + fr;
                        acc[r] = i >= j ? acc[r] * gi_ * 0.08838834764831845f * __expf(-lg * (float)j) : 0.f; }
                }
                u32x2 w; w.x = pack2(acc[0], acc[1]); w.y = pack2(acc[2], acc[3]);
                *(LAS u32x2*)(lds + F_RAT + (16 * it + fr) * 144 + permb(16 * jt + 4 * q4)) = w;
            }
        }
    };
    RF_PREFETCH(0);
    __syncthreads();
    write_stage();
    if (CG > 1) RF_PREFETCH(1);
    __syncthreads();
    for (int n = 0; n < CG; ++n) {
        if (MODE == 1) { scores(); __syncthreads(); }
        {
            LAS const unsigned char* pq = lds + F_Q + fr * 272 + 16 * q4;
            LAS const unsigned char* pk = lds + F_KDT + fr * 144 + 16 * q4;
            bf16x8 Sb[4];
#pragma unroll
            for (int s4 = 0; s4 < 4; ++s4) Sb[s4] = pack8(S[2 * s4], S[2 * s4 + 1]);
            bf16x8 Vf[2];
#pragma unroll
            for (int s2 = 0; s2 < 2; ++s2) Vf[s2] = LDF(lds + F_VT + (16 * cw + fr) * 144 + 64 * s2 + 16 * q4);
            u32x4 RA[8], RB[8];
            f32x4 ot[4];
#define RF_LD_Q(RR, hh_) do { _Pragma("unroll") for (int i2 = 0; i2 < 2; ++i2) _Pragma("unroll") for (int s4 = 0; s4 < 4; ++s4) RR[i2 * 4 + s4] = LDR(pq + (16 * (2 * (hh_) + i2)) * 272 + 64 * s4); } while (0)
#define RF_LD_K(RR, dh_) do { _Pragma("unroll") for (int d2 = 0; d2 < 4; ++d2) _Pragma("unroll") for (int s2 = 0; s2 < 2; ++s2) RR[d2 * 2 + s2] = LDR(pk + (16 * (4 * (dh_) + d2)) * 144 + 64 * s2); } while (0)
#define RF_MM_Q(RR, hh_) do { _Pragma("unroll") for (int i2 = 0; i2 < 2; ++i2) { const int it = 2 * (hh_) + i2; ot[it] = (f32x4){0.f, 0.f, 0.f, 0.f}; \
        _Pragma("unroll") for (int s4 = 0; s4 < 4; ++s4) ot[it] = MF16(Sb[s4], asfrag(RR[i2 * 4 + s4]), ot[it]); \
        const float rd = gi[it] * g1; _Pragma("unroll") for (int r = 0; r < 4; ++r) ot[it][r] *= rd; } } while (0)
#define RF_MM_K(RR, dh_) do { _Pragma("unroll") for (int d2 = 0; d2 < 4; ++d2) { S[4 * (dh_) + d2] = S[4 * (dh_) + d2] * rcd; \
        _Pragma("unroll") for (int s2 = 0; s2 < 2; ++s2) S[4 * (dh_) + d2] = MF16(asfrag(RR[d2 * 2 + s2]), Vf[s2], S[4 * (dh_) + d2]); } } while (0)
            RF_LD_K(RA, 0); SCHED_FENCE();
            RF_LD_K(RB, 1); SCHED_FENCE(); RF_MM_K(RA, 0); SCHED_FENCE();
            if (MODE == 1) {
                RF_LD_Q(RA, 0); SCHED_FENCE(); RF_MM_K(RB, 1); SCHED_FENCE();
                RF_LD_Q(RB, 1); SCHED_FENCE(); RF_MM_Q(RA, 0); SCHED_FENCE();
                RF_MM_Q(RB, 1);
                LAS const unsigned char* pa = lds + F_RAT + fr * 144 + 16 * q4;
                RA[0] = LDR(pa); RA[1] = LDR(pa + 16 * 144); RA[2] = LDR(pa + 32 * 144); RA[3] = LDR(pa + 32 * 144 + 64); RA[4] = LDR(pa + 48 * 144); RA[5] = LDR(pa + 48 * 144 + 64);
                SCHED_FENCE();
                ot[0] = MF16(Vf[0], asfrag(RA[0]), ot[0]); ot[1] = MF16(Vf[0], asfrag(RA[1]), ot[1]);
                ot[2] = MF16(Vf[0], asfrag(RA[2]), ot[2]); ot[2] = MF16(Vf[1], asfrag(RA[3]), ot[2]);
                ot[3] = MF16(Vf[0], asfrag(RA[4]), ot[3]); ot[3] = MF16(Vf[1], asfrag(RA[5]), ot[3]);
                scan_store_ot(out + ((size_t)b * SEQ + (size_t)(n0 + n) * 64 + fr) * DM + h * 128 + 16 * cw + 4 * q4, ot);
            } else { RF_MM_K(RB, 1); }
#undef RF_LD_Q
#undef RF_LD_K
#undef RF_MM_Q
#undef RF_MM_K
        }
        __syncthreads();
        if (n + 1 < CG) { write_stage(); if (n + 2 < CG) RF_PREFETCH(n + 2); }
        __syncthreads();
    }
    if (MODE == 0) {
        f32x4* lp = (f32x4*)Lb + (((size_t)(b * 4 + h) * NG + g) * 8 + cw) * 8 * 64 + lane;
#pragma unroll
        for (int dt = 0; dt < 8; ++dt) lp[dt * 64] = S[dt];
    }
#undef RF_PREFETCH
}

__device__ __forceinline__ void phase_ret_local(KPTR p, LAS unsigned char* lds, int bid, int nb, int wv) {
    constexpr int NIT0 = BATCH * 4 * NG;
    for (int it = bid; it < NIT0; it += nb) {
        const int g = it % NG, bh = it / NG;
        __syncthreads();
        scan_ret_full<0>(p, lds, bh >> 2, bh & 3, g, wv);
    }
}
template <bool OVERLAP>
__device__ __forceinline__ void phase_scan(KPTR p, LAS unsigned char* lds, int bid, int nb, int wv) {
    constexpr int QN = 8 / NCW;
    constexpr int G = BATCH * 4;
    constexpr int NUG = ((G + 7) / 8) * 8 * QN;
    for (int unit = bid; unit < NUG; unit += nb) {
        const int xcd = unit & 7, t = unit >> 3, qt = t % QN, bh = (t / QN) * 8 + xcd;
        if (bh >= G) continue;
        __syncthreads();
        for (int rp = 0; rp < RPT_SG; ++rp) scan_gdn<OVERLAP>(p, lds, bh >> 2, bh & 3, qt, wv);
    }
    if (OVERLAP && bid >= NUG) { __syncthreads(); phase_gdn_pre<true>(p, lds, bid - NUG, nb - NUG, wv); }
    constexpr int NIT1 = G * NG;
    const int first = nb > NUG ? NUG : 0, step = nb > NUG ? nb - NUG : nb;
    if (bid >= first) {
        for (int it = bid - first; it < NIT1; it += step) {
            const int g = it % NG, bh = it / NG;
            __syncthreads();
            for (int rp = 0; rp < RPT_SR; ++rp) scan_ret_full<1>(p, lds, bh >> 2, bh & 3, g, wv);
        }
    }
}

__device__ __forceinline__ void phase_gatednorm(KPTR p, int bid, int nb, int wv) {
    const int tid = opaque_tid(wv), wid = tid >> 6, lane = tid & 63;
    const int hh = lane >> 3, c0 = lane * 16;
    const float* nwp = (hh < 4 ? p->ret_norm + hh * 128 : p->gdn_norm + (hh - 4) * 128) + (lane & 7) * 16;
    float nw[16];
#pragma unroll
    for (int i = 0; i < 4; ++i) { const f32x4 t4 = *(const f32x4*)(nwp + 4 * i); nw[4 * i] = t4[0]; nw[4 * i + 1] = t4[1]; nw[4 * i + 2] = t4[2]; nw[4 * i + 3] = t4[3]; }
    const int gcol = (hh < 4 ? 1536 + hh * 128 : 3584 + (hh - 4) * 128) + (lane & 7) * 16;
    for (int t = bid * 8 + wid; t < NTOK; t += nb * 8) {
        bf16_t* o = p->hn + (size_t)t * DM + c0;
        const u32x4 o0 = *(const u32x4*)o, o1 = *(const u32x4*)(o + 8);
        const bf16_t* gp = p->proj + (size_t)t * DINP + gcol;
        const u32x4 g0 = *(const u32x4*)gp, g1 = *(const u32x4*)(gp + 8);
        float a[16], g[16];
#pragma unroll
        for (int i = 0; i < 4; ++i) { a[2 * i] = __uint_as_float(o0[i] << 16); a[2 * i + 1] = __uint_as_float(o0[i] & 0xffff0000u); a[8 + 2 * i] = __uint_as_float(o1[i] << 16); a[8 + 2 * i + 1] = __uint_as_float(o1[i] & 0xffff0000u);
            g[2 * i] = __uint_as_float(g0[i] << 16); g[2 * i + 1] = __uint_as_float(g0[i] & 0xffff0000u); g[8 + 2 * i] = __uint_as_float(g1[i] << 16); g[8 + 2 * i + 1] = __uint_as_float(g1[i] & 0xffff0000u); }
        float ss = 0.f;
#pragma unroll
        for (int i = 0; i < 16; ++i) ss += a[i] * a[i];
        ss += __shfl_xor(ss, 1); ss += __shfl_xor(ss, 2); ss += __shfl_xor(ss, 4);
        const float rs = rsqrtf(ss * (1.0f / 128.f) + NORM_EPS);
        u32x4 w0, w1;
#pragma unroll
        for (int i = 0; i < 4; ++i) { w0[i] = pack2(a[2 * i] * rs * nw[2 * i] * siluf(g[2 * i]), a[2 * i + 1] * rs * nw[2 * i + 1] * siluf(g[2 * i + 1]));
            w1[i] = pack2(a[8 + 2 * i] * rs * nw[8 + 2 * i] * siluf(g[8 + 2 * i]), a[8 + 2 * i + 1] * rs * nw[8 + 2 * i + 1] * siluf(g[8 + 2 * i + 1])); }
        *(u32x4*)o = w0; *(u32x4*)(o + 8) = w1;
    }
}

__device__ __forceinline__ void phase_kmean(KPTR p, LAS unsigned char* lds, int bid, int nb, int wv) {
    const int tid = opaque_tid(wv);
    LAS float* red = (LAS float*)lds;
    const int rg = tid >> 4, c = tid & 15;
    for (int unit = bid; unit < NIT; unit += nb) {
        const int blk = unit % NBLK, h = (unit / NBLK) & 7, b = unit / (NBLK * 8);
        const bf16_t* kp = p->qkv + ((size_t)b * SEQ + (size_t)blk * 256 + rg) * 3072 + 1024 + h * 128 + c * 8;
        float a[8];
#pragma unroll
        for (int j = 0; j < 8; ++j) a[j] = 0.f;
#pragma unroll
        for (int i = 0; i < 8; ++i) { const u32x4 w = *(const u32x4*)(kp + (size_t)(32 * i) * 3072);
            a[0] += __uint_as_float(w.x << 16); a[1] += __uint_as_float(w.x & 0xffff0000u); a[2] += __uint_as_float(w.y << 16); a[3] += __uint_as_float(w.y & 0xffff0000u);
            a[4] += __uint_as_float(w.z << 16); a[5] += __uint_as_float(w.z & 0xffff0000u); a[6] += __uint_as_float(w.w << 16); a[7] += __uint_as_float(w.w & 0xffff0000u); }
        __syncthreads();
#pragma unroll
        for (int j = 0; j < 8; ++j) red[rg * 128 + c * 8 + j] = a[j];
        __syncthreads();
        if (tid < 128) { float s2 = 0.f;
#pragma unroll
            for (int g = 0; g < 32; ++g) s2 += red[g * 128 + tid];
            s2 *= (1.0f / 256.f);
            const bf16_t hi = f2bf(s2);
            p->kmh[(size_t)unit * 128 + tid] = hi; p->kml[(size_t)unit * 128 + tid] = f2bf(s2 - bf2f(hi)); }
    }
}
__device__ __forceinline__ void phase_moba_select(KPTR p, LAS unsigned char* lds, int bid, int nb, int wv) {
    const int tid = opaque_tid(wv), wid = tid >> 6, lane = tid & 63, fr = lane & 15, fq = lane >> 4;
    LAS float* sg = (LAS float*)lds + wid * (16 * 65);
    LAS unsigned* cnt = (LAS unsigned*)(lds + 8 * 16 * 65 * 4);
    LAS unsigned* gbase = cnt + 64;
    const int TPS = SEQ / 128, NU = BATCH * 8 * TPS;
    const bf16_t* qkv = p->qkv; const bf16_t* kmh = p->kmh; const bf16_t* kml = p->kml; unsigned* mcount = p->mcount; unsigned short* mlist = p->mlist; float* part_lse = p->part_lse;
    for (int unit = bid; unit < NU; unit += nb) {
        const int tile = unit % TPS, h = (unit / TPS) & 7, b = unit / (TPS * 8), bh = b * 8 + h;
        const int t0 = tile * 128 + wid * 16, own = (tile * 128) >> 8;
        if (tid < 64) cnt[tid] = 0u;
        if (own > 0) {
            f32x4 acc[GNT];
#pragma unroll
            for (int nt = 0; nt < GNT; ++nt) acc[nt] = (f32x4){0.f, 0.f, 0.f, 0.f};
            const bf16_t* qrow = qkv + ((size_t)b * SEQ + t0 + fr) * 3072 + h * 128 + 8 * fq;
#pragma unroll
            for (int s4 = 0; s4 < 4; ++s4) {
                const bf16x8 a = *(const bf16x8*)(qrow + 32 * s4);
#pragma unroll
                for (int nt = 0; nt < GNT; ++nt) {
                    int blk = 16 * nt + fr; blk = blk < NBLK ? blk : NBLK - 1;
                    const size_t ko = ((size_t)bh * NBLK + blk) * 128 + 32 * s4 + 8 * fq;
                    const bf16x8 b1 = *(const bf16x8*)(kmh + ko), b2 = *(const bf16x8*)(kml + ko);
                    acc[nt] = __builtin_amdgcn_mfma_f32_16x16x32_bf16(a, b1, acc[nt], 0, 0, 0);
                    acc[nt] = __builtin_amdgcn_mfma_f32_16x16x32_bf16(a, b2, acc[nt], 0, 0, 0);
                }
            }
#pragma unroll
            for (int nt = 0; nt < GNT; ++nt)
#pragma unroll
                for (int r = 0; r < 4; ++r) sg[(4 * fq + r) * 65 + 16 * nt + fr] = acc[nt][r];
        }
        __syncthreads();
        int i0 = -1, i1 = -1, i2 = -1; unsigned r0 = 0, r1 = 0, r2 = 0;
        if (lane < 16) {
            float v0 = -3e38f, v1 = -3e38f, v2 = -3e38f;
            for (int j = 0; j < own; ++j) {
                const float g = sg[lane * 65 + j];
                if (g > v0) { v2 = v1; i2 = i1; v1 = v0; i1 = i0; v0 = g; i0 = j; }
                else if (g > v1) { v2 = v1; i2 = i1; v1 = g; i1 = j; }
                else if (g > v2) { v2 = g; i2 = j; }
            }
            if (i0 >= 0) r0 = LDS_ATOMIC_ADD(cnt + i0, 1u);
            if (i1 >= 0) r1 = LDS_ATOMIC_ADD(cnt + i1, 1u);
            if (i2 >= 0) r2 = LDS_ATOMIC_ADD(cnt + i2, 1u);
        }
        __syncthreads();
        if (tid < 64 && tid < own) { const unsigned c = cnt[tid]; if (c > 0u) gbase[tid] = atomicAdd(mcount + bh * NBLK + tid, c); }
        __syncthreads();
        if (lane < 16) {
            const int t = t0 + lane;
            const size_t pb = ((size_t)((size_t)b * SEQ + t) * 8 + h) * 3;
            unsigned short* lst = mlist + (size_t)bh * LTOT;
            if (i0 >= 0) lst[list_off(i0) + gbase[i0] + r0] = (unsigned short)(((unsigned)t << 2) | 0u); else part_lse[pb + 0] = -1e30f;
            if (i1 >= 0) lst[list_off(i1) + gbase[i1] + r1] = (unsigned short)(((unsigned)t << 2) | 1u); else part_lse[pb + 1] = -1e30f;
            if (i2 >= 0) lst[list_off(i2) + gbase[i2] + r2] = (unsigned short)(((unsigned)t << 2) | 2u); else part_lse[pb + 2] = -1e30f;
        }
    }
}

__device__ __forceinline__ void moba_stage_kv(const bf16_t* qkv, LAS unsigned char* Ks, LAS unsigned char* VTs, int b, int h, int j, int tid) {
    OPAQUE_V(tid);
    const bf16_t* kbase = qkv + ((size_t)b * SEQ + (size_t)j * 256) * 3072 + 1024 + h * 128;
    const bf16_t* vbase = kbase + 1024;
#pragma unroll
    for (int i = 0; i < 8; ++i) { const int id = tid + NTHREADS * i, key = id >> 4, c = id & 15;
        *(LAS u32x4*)(Ks + key * KS_STRIDE + c * 16) = *(const u32x4*)(kbase + (size_t)key * 3072 + c * 8); }
#pragma unroll
    for (int i = 0; i < 2; ++i) { const int id = tid + NTHREADS * i, c = (id & 3) | (((id >> 4) & 3) << 2), g = ((id >> 2) & 3) | ((id >> 6) << 2);
        u32x4 r0 = *(const u32x4*)(vbase + (size_t)(4 * g) * 3072 + c * 8), r1 = *(const u32x4*)(vbase + (size_t)(4 * g + 1) * 3072 + c * 8);
        u32x4 r2 = *(const u32x4*)(vbase + (size_t)(4 * g + 2) * 3072 + c * 8), r3 = *(const u32x4*)(vbase + (size_t)(4 * g + 3) * 3072 + c * 8);
#pragma unroll
        for (int e = 0; e < 8; ++e) { const int wsel = e >> 1, sh = 16 * (e & 1);
            const unsigned x0 = (r0[wsel] >> sh) & 0xffffu, x1 = (r1[wsel] >> sh) & 0xffffu, x2 = (r2[wsel] >> sh) & 0xffffu, x3 = (r3[wsel] >> sh) & 0xffffu;
            u32x2 o; o.x = x0 | (x1 << 16); o.y = x2 | (x3 << 16);
            *(LAS u32x2*)(VTs + (8 * c + e) * VT_STRIDE + 8 * g) = o; }
    }
}
struct AttnState { f32x16 o[4]; float m, l; };
#ifndef CPU_EMU
__device__ __forceinline__ u32x4 swap16(const u32x4 w, int) {
    const u32x2 r0 = __builtin_amdgcn_permlane32_swap(w.x, w.z, false, false), r1 = __builtin_amdgcn_permlane32_swap(w.y, w.w, false, false);
    u32x4 o; o.x = r0.x; o.z = r0.y; o.y = r1.x; o.w = r1.y; return o; }
#else
static inline u32x4 swap16(const u32x4 w, int lane) {
    unsigned a0 = w.x, b0 = w.z, a1 = w.y, b1 = w.w;
    const unsigned a0o = __shfl(a0, lane ^ 32), b0o = __shfl(b0, lane ^ 32), a1o = __shfl(a1, lane ^ 32), b1o = __shfl(b1, lane ^ 32);
    if (lane < 32) { b0 = a0o; b1 = a1o; } else { a0 = b0o; a1 = b1o; }
    u32x4 o; o.x = a0; o.y = a1; o.z = b0; o.w = b1; return o; }
#endif
template <bool CAUSAL>
__device__ __forceinline__ void attn_block(LAS const unsigned char* Ks, LAS const unsigned char* VTs, const bf16x8 (&qf)[8], float bias0, float slope, int qloc, int wtile, int lane, AttnState& st) {
    const int l31 = lane & 31, h2 = lane >> 5;
    constexpr float L2E = 1.4426950408889634f;
    const float scale2 = 0.08838834764831845f * L2E, slope2 = slope * L2E;
    const float bb = __builtin_fmaf(slope2, (float)(4 * h2), bias0 * L2E);
#pragma unroll 1
    for (int hf = 0; hf < 2; ++hf) {
        if (CAUSAL && 4 * hf > wtile) break;
        f32x16 sv[4];
#pragma unroll
        for (int kt = 0; kt < 4; ++kt) {
            const int kt4 = 4 * hf + kt;
            f32x16 acc;
            if (!CAUSAL || kt4 <= wtile) {
                const f32x16 zero16 = (f32x16){0.f, 0.f, 0.f, 0.f, 0.f, 0.f, 0.f, 0.f, 0.f, 0.f, 0.f, 0.f, 0.f, 0.f, 0.f, 0.f};
#pragma unroll
                for (int s8 = 0; s8 < 8; ++s8) { const bf16x8 a = *(LAS const bf16x8*)(Ks + (32 * kt4 + l31) * KS_STRIDE + (16 * s8 + 8 * h2) * 2);
                    acc = __builtin_amdgcn_mfma_f32_32x32x16_bf16(a, qf[s8], s8 == 0 ? zero16 : acc, 0, 0, 0);
                    if (s8 == 3) SCHED_FENCE(); }
                const float kb = __builtin_fmaf(slope2, (float)(32 * kt4), bb);
#pragma unroll
                for (int r = 0; r < 16; ++r) { const int cr = (r & 3) + 8 * (r >> 2);
                    float v = __builtin_fmaf(acc[r], scale2, __builtin_fmaf(slope2, (float)cr, kb));
                    if (CAUSAL && kt4 == wtile && 32 * kt4 + cr + 4 * h2 > qloc) v = -1e30f;
                    acc[r] = v; }
            } else {
#pragma unroll
                for (int r = 0; r < 16; ++r) acc[r] = -1e30f;
            }
            sv[kt] = acc;
            SCHED_FENCE();
        }
        float mx = -1e30f;
#pragma unroll
        for (int kt = 0; kt < 4; ++kt)
#pragma unroll
            for (int r = 0; r < 16; ++r) mx = fmaxf(mx, sv[kt][r]);
        mx = fmaxf(mx, __shfl_xor(mx, 32));
        float mnew = mx;
        if (hf != 0) {
            mnew = st.m;
            if (__any(mx - st.m > 8.0f)) {
                mnew = fmaxf(st.m, mx);
                const float alpha = __builtin_amdgcn_exp2f(st.m - mnew);
                st.l *= alpha;
#pragma unroll
                for (int dt = 0; dt < 4; ++dt)
#pragma unroll
                    for (int r = 0; r < 16; ++r) st.o[dt][r] *= alpha;
            }
        }
        st.m = mnew;
        float ls = 0.f;
#pragma unroll
        for (int kt = 0; kt < 4; ++kt)
#pragma unroll
            for (int r = 0; r < 16; ++r) { const float pv = __builtin_amdgcn_exp2f(sv[kt][r] - mnew); sv[kt][r] = pv; ls += pv; }
        st.l += ls;
#pragma unroll
        for (int kt = 0; kt < 4; ++kt) {
            const int kt4 = 4 * hf + kt;
            if (CAUSAL && kt4 > wtile) continue;
#pragma unroll
            for (int s2 = 0; s2 < 2; ++s2) {
                u32x4 pw; pw.x = pack2(sv[kt][8 * s2 + 0], sv[kt][8 * s2 + 1]); pw.y = pack2(sv[kt][8 * s2 + 2], sv[kt][8 * s2 + 3]); pw.z = pack2(sv[kt][8 * s2 + 4], sv[kt][8 * s2 + 5]); pw.w = pack2(sv[kt][8 * s2 + 6], sv[kt][8 * s2 + 7]);
                bf16x8 pf; __builtin_memcpy(&pf, &pw, 16);
#pragma unroll
                for (int dt = 0; dt < 4; ++dt) {
                    LAS const unsigned char* vp = VTs + (32 * dt + l31) * VT_STRIDE + (32 * kt4 + 16 * s2 + 4 * h2) * 2;
                    const u32x2 lo = *(LAS const u32x2*)vp, hi = *(LAS const u32x2*)(vp + 16);
                    u32x4 aw; aw.x = lo.x; aw.y = lo.y; aw.z = hi.x; aw.w = hi.y;
                    bf16x8 a; __builtin_memcpy(&a, &aw, 16);
                    st.o[dt] = __builtin_amdgcn_mfma_f32_32x32x16_bf16(a, pf, st.o[dt], 0, 0, 0);
                }
                SCHED_FENCE();
            }
        }
    }
}
__device__ __forceinline__ void load_qfrag(const bf16_t* qrow, int h2, bf16x8 (&qf)[8]) {
#pragma unroll
    for (int s8 = 0; s8 < 8; ++s8) qf[s8] = *(const bf16x8*)(qrow + 16 * s8 + 8 * h2);
}

__device__ __forceinline__ void phase_moba_gather(KPTR p, LAS unsigned char* lds, int bid, int nb, int wv) {
#ifndef CPU_EMU
    const int tid = opaque_tid(wv), wid = wv, lane = tid & 63, l31 = lane & 31, h2 = lane >> 5;
#else
    const int tid = opaque_tid(wv), wid = tid >> 6, lane = tid & 63, l31 = lane & 31, h2 = lane >> 5;
#endif
    LAS unsigned char* Ks = lds; LAS unsigned char* VTs = lds + KS_BYTES;
    LAS unsigned* pref = (LAS unsigned*)(lds + KS_BYTES + VT_BYTES);
    LAS unsigned* wsum = pref + NIT + 1;
    const bf16_t* qkv = p->qkv; const unsigned* mcount = p->mcount; const unsigned short* mlist = p->mlist;
    constexpr int IPT = (NIT + NTHREADS - 1) / NTHREADS;
    unsigned loc[IPT]; unsigned tsum = 0;
#pragma unroll
    for (int i = 0; i < IPT; ++i) { const int it = tid * IPT + i; const unsigned c = it < NIT ? mcount[it] : 0u; loc[i] = c ? 1u + 2u * ((c + 255u) >> 8) : 0u; tsum += loc[i]; }
    unsigned inc = tsum;
    for (int o = 1; o < 64; o <<= 1) { const unsigned t2 = __shfl_up(inc, o); if (lane >= o) inc += t2; }
    if (lane == 63) wsum[wid] = inc;
    __syncthreads();
    unsigned wbase = 0;
#pragma unroll
    for (int w = 0; w < 8; ++w) if (w < wid) wbase += wsum[w];
    unsigned run = wbase + inc - tsum;
#pragma unroll
    for (int i = 0; i < IPT; ++i) { const int it = tid * IPT + i; if (it < NIT) pref[it] = run; run += loc[i]; }
    if (tid == NTHREADS - 1) pref[NIT] = run;
    __syncthreads();
    const unsigned C = pref[NIT];
    const unsigned lo = (unsigned)(((unsigned long long)C * (unsigned)bid) / (unsigned)nb), hi = (unsigned)(((unsigned long long)C * (unsigned)(bid + 1)) / (unsigned)nb);
    if (lo >= hi) return;
    int first = 0; { int a = 0, c = NIT; while (c - a > 1) { const int mid = (a + c) >> 1; if (pref[mid] <= lo) a = mid; else c = mid; } first = a; }
    for (int it = first; it < NIT; ++it) {
        const unsigned ps = pref[it], pe = pref[it + 1];
        if (ps >= hi) break;
        if (pe <= lo || pe == ps) continue;
        const unsigned nr = (pe - ps - 1u) >> 1;
        unsigned r_lo = 0; if (lo > ps + 1u) r_lo = (lo - ps - 1u + 1u) >> 1;
        unsigned r_hi = nr; if (hi < ps + 1u + 2u * nr) r_hi = hi > ps + 1u ? (hi - ps - 1u + 1u) >> 1 : 0u;
        if (r_lo >= r_hi) continue;
        const int j = it % NBLK, h = (it / NBLK) & 7, b = it / (NBLK * 8), bh = b * 8 + h;
        const unsigned cnt = mcount[it];
        const unsigned ra = r_lo * 256u, rb = (r_hi * 256u) < cnt ? (r_hi * 256u) : cnt;
        __syncthreads();
        moba_stage_kv(qkv, Ks, VTs, b, h, j, tid);
        __syncthreads();
        const float slope = exp2f(-(float)(h + 1));
        const unsigned short* lst = mlist + (size_t)bh * LTOT + list_off(j);
        unsigned ent_next = 0;
        int l31i = l31; OPAQUE_V(l31i);
        { const unsigned row = ra + 32u * wid + l31i; if (ra + 32u * wid < rb) ent_next = lst[row < rb ? row : (rb - 1)]; }
        for (unsigned r0 = ra + 32u * wid; r0 < rb; r0 += 256u) {
            const unsigned row = r0 + l31i; const bool active = row < rb;
            const unsigned ent = ent_next;
            if (r0 + 256u < rb) { const unsigned rn = row + 256u; ent_next = lst[rn < rb ? rn : (rb - 1)]; }
            const int t = (int)(ent >> 2), k = (int)(ent & 3u);
            int h2q = h2; OPAQUE_V(h2q);
            bf16x8 qf[8]; load_qfrag(qkv + ((size_t)b * SEQ + t) * 3072 + h * 128, h2q, qf);
            AttnState st;
#pragma unroll
            for (int dt = 0; dt < 4; ++dt)
#pragma unroll
                for (int r = 0; r < 16; ++r) st.o[dt][r] = 0.f;
            st.m = -1e30f; st.l = 0.f;
            attn_block<false>(Ks, VTs, qf, slope * (float)(256 * j - t), slope, 0, 0, lane, st);
            const float lt = st.l + __shfl_xor(st.l, 32);
            const float inv = 1.0f / lt;
            {
                const size_t pb = ((size_t)((size_t)b * SEQ + t) * 8 + h) * 3 + k;
                bf16_t* po = p->part_o + pb * 128;
#pragma unroll
                for (int dt = 0; dt < 4; ++dt)
#pragma unroll
                    for (int gp = 0; gp < 4; gp += 2) { u32x4 w;
                        w.x = pack2(st.o[dt][4 * gp] * inv, st.o[dt][4 * gp + 1] * inv); w.y = pack2(st.o[dt][4 * gp + 2] * inv, st.o[dt][4 * gp + 3] * inv);
                        w.z = pack2(st.o[dt][4 * gp + 4] * inv, st.o[dt][4 * gp + 5] * inv); w.w = pack2(st.o[dt][4 * gp + 6] * inv, st.o[dt][4 * gp + 7] * inv);
                        w = swap16(w, lane);
                        if (active) *(u32x4*)(po + 32 * dt + 8 * (gp + h2)) = w; }
                if (active && h2 == 0) p->part_lse[pb] = st.m * 0.6931471805599453f + __logf(lt);
            }
        }
    }
}
__device__ __forceinline__ void phase_moba_own(KPTR p, LAS unsigned char* lds, int bid, int nb, int wv) {
    const int tid = opaque_tid(wv), wid = tid >> 6, lane = tid & 63, l31 = lane & 31, h2 = lane >> 5;
    LAS unsigned char* Ks = lds; LAS unsigned char* VTs = lds + KS_BYTES;
    const bf16_t* qkv = p->qkv; const bf16_t* part_o = p->part_o; const float* part_lse = p->part_lse; bf16_t* out = p->hn;
    for (int it = bid; it < NIT; it += nb) {
        const int j = it % NBLK, h = (it / NBLK) & 7, b = it / (NBLK * 8);
        const float slope = exp2f(-(float)(h + 1));
        const int qloc = 32 * wid + l31, t = j * 256 + qloc;
        bf16x8 qf[8]; load_qfrag(qkv + ((size_t)b * SEQ + t) * 3072 + h * 128, h2, qf);
        __syncthreads();
        moba_stage_kv(qkv, Ks, VTs, b, h, j, tid);
        __syncthreads();
        AttnState st;
#pragma unroll
        for (int dt = 0; dt < 4; ++dt)
#pragma unroll
            for (int r = 0; r < 16; ++r) st.o[dt][r] = 0.f;
        st.m = -1e30f; st.l = 0.f;
        attn_block<true>(Ks, VTs, qf, slope * (float)(-qloc), slope, qloc, wid, lane, st);
        const float lt = st.l + __shfl_xor(st.l, 32);
        const float lse_own = st.m * 0.6931471805599453f + __logf(lt);
        const size_t pb = ((size_t)((size_t)b * SEQ + t) * 8 + h) * 3;
        const float l0 = part_lse[pb], l1 = part_lse[pb + 1], l2 = part_lse[pb + 2];
        const float M = fmaxf(fmaxf(lse_own, l0), fmaxf(l1, l2));
        const float w_own = __expf(lse_own - M), w0 = __expf(l0 - M), w1 = __expf(l1 - M), w2 = __expf(l2 - M);
        const float Wi = 1.0f / (w_own + w0 + w1 + w2);
        const float c_own = w_own * Wi / lt, c0 = w0 * Wi, c1 = w1 * Wi, c2 = w2 * Wi;
        bf16_t* orow = out + ((size_t)b * SEQ + t) * DM + h * 128;
        const bool v0 = l0 > -1e29f, v1 = l1 > -1e29f, v2 = l2 > -1e29f;
#pragma unroll
        for (int dt = 0; dt < 4; ++dt) {
            u32x2 pw[3][4]; u32x4 pq[3][2];
#pragma unroll
            for (int k = 0; k < 3; ++k)
#pragma unroll
                for (int gp = 0; gp < 2; ++gp) pq[k][gp] = *(const u32x4*)(part_o + (pb + k) * 128 + 32 * dt + 8 * (2 * gp + h2));
#pragma unroll
            for (int k = 0; k < 3; ++k)
#pragma unroll
                for (int gp = 0; gp < 2; ++gp) { const u32x4 q = swap16(pq[k][gp], lane); pw[k][2 * gp].x = q.x; pw[k][2 * gp].y = q.y; pw[k][2 * gp + 1].x = q.z; pw[k][2 * gp + 1].y = q.w; }
            u32x2 wo4[4];
#pragma unroll
            for (int g = 0; g < 4; ++g) {
                const int d0 = 32 * dt + 8 * g + 4 * h2;
                float v[4];
#pragma unroll
                for (int e = 0; e < 4; ++e) v[e] = st.o[dt][4 * g + e] * c_own;
#pragma unroll
                for (int k = 0; k < 3; ++k) {
                    const bool vk = k == 0 ? v0 : (k == 1 ? v1 : v2); const float ck = k == 0 ? c0 : (k == 1 ? c1 : c2);
                    const u32x2 w = pw[k][g];
                    const float f0 = __uint_as_float(w.x << 16), f1 = __uint_as_float(w.x & 0xffff0000u), f2 = __uint_as_float(w.y << 16), f3 = __uint_as_float(w.y & 0xffff0000u);
                    v[0] += vk ? ck * f0 : 0.f; v[1] += vk ? ck * f1 : 0.f; v[2] += vk ? ck * f2 : 0.f; v[3] += vk ? ck * f3 : 0.f;
                }
                wo4[g].x = pack2(v[0], v[1]); wo4[g].y = pack2(v[2], v[3]);
            }
#pragma unroll
            for (int gp = 0; gp < 4; gp += 2) { u32x4 w; w.x = wo4[gp].x; w.y = wo4[gp].y; w.z = wo4[gp + 1].x; w.w = wo4[gp + 1].y;
                w = swap16(w, lane);
                *(u32x4*)(orow + 32 * dt + 8 * (gp + h2)) = w; }
        }
    }
}

__device__ __forceinline__ void phase_router(KPTR p, LAS unsigned char* lds, int bid, int nb, int wv) {
    const int tid = opaque_tid(wv), wid = tid >> 6, lane = tid & 63;
    LAS unsigned* hist = (LAS unsigned*)lds;
    if (tid < 8) hist[tid] = 0u;
    __syncthreads();
    f32x4 gv[4];
#pragma unroll
    for (int i = 0; i < 4; ++i) gv[i] = *(const f32x4*)(p->ffn_norm + DM + i * 256 + lane * 4);
    const int rpw = (NTOK + nb - 1) / nb, rbeg = bid * rpw, rend = (rbeg + rpw) < NTOK ? (rbeg + rpw) : NTOK;
    f32x4 w8[16][2];
#pragma unroll
    for (int i = 0; i < 4; ++i)
#pragma unroll
        for (int e = 0; e < 4; ++e) { const float* wr_ = p->w_router + (size_t)(i * 256 + lane * 4 + e) * 8; w8[i * 4 + e][0] = *(const f32x4*)wr_; w8[i * 4 + e][1] = *(const f32x4*)(wr_ + 4); }
    for (int row = rbeg + wid; row < rend; row += 8) {
        f32x4 v[4]; load_row_b(p->hb3, row, lane, v);
        const float rs = row_rstd(v);
#pragma unroll
        for (int i = 0; i < 4; ++i) v[i] = v[i] * rs * gv[i];
        store_row_fp8((unsigned char*)p->hn, p->hns, row, lane, v);
        { float ss = 0.f;
#pragma unroll
          for (int i = 0; i < 4; ++i) ss += v[i][0] * v[i][0] + v[i][1] * v[i][1] + v[i][2] * v[i][2] + v[i][3] * v[i][3];
          ss = wave_sum(ss); if (lane == 0) p->hnn2[row] = ss; }
        f32x4 d0 = (f32x4){0.f, 0.f, 0.f, 0.f}, d1 = (f32x4){0.f, 0.f, 0.f, 0.f};
#pragma unroll
        for (int i = 0; i < 4; ++i)
#pragma unroll
            for (int e = 0; e < 4; ++e) { const float xv = v[i][e]; d0 = d0 + w8[i * 4 + e][0] * xv; d1 = d1 + w8[i * 4 + e][1] * xv; }
        float d[8] = {d0[0], d0[1], d0[2], d0[3], d1[0], d1[1], d1[2], d1[3]};
#pragma unroll
        for (int j = 0; j < 8; ++j) d[j] = wave_sum(d[j]);
        int i0 = 0; float m0 = d[0];
#pragma unroll
        for (int j = 1; j < 8; ++j) if (d[j] > m0) { m0 = d[j]; i0 = j; }
        int i1 = -1; float m1 = -3e38f;
#pragma unroll
        for (int j = 0; j < 8; ++j) if (j != i0 && d[j] > m1) { m1 = d[j]; i1 = j; }
        if (lane == 0) {
            const float e1 = __expf(m1 - m0); const float g0 = 1.0f / (1.0f + e1);
            p->midx[row * 2] = i0; p->midx[row * 2 + 1] = i1; p->mgate[row * 2] = g0; p->mgate[row * 2 + 1] = e1 * g0;
            LDS_ATOMIC_ADD(hist + i0, 1u); LDS_ATOMIC_ADD(hist + i1, 1u);
        }
    }
    __syncthreads();
    if (tid < 8) p->wghist[bid * 8 + tid] = hist[tid];
}
__device__ __forceinline__ void phase_slots(KPTR p, LAS unsigned char* lds, int bid, int nb, int wv) {
    const int tid = opaque_tid(wv);
    LAS unsigned* ltot = (LAS unsigned*)lds; LAS unsigned* lpre = ltot + 8; LAS unsigned* lcur = ltot + 16;
    if (tid < 24) ltot[tid] = 0u;
    __syncthreads();
    { const int e = tid & 7; unsigned tot = 0, pre = 0;
      for (int bb = tid >> 3; bb < nb; bb += NTHREADS / 8) { const unsigned v = p->wghist[bb * 8 + e]; tot += v; if (bb < bid) pre += v; }
      LDS_ATOMIC_ADD(ltot + e, tot); LDS_ATOMIC_ADD(lpre + e, pre); }
    __syncthreads();
    unsigned base[NE], cnt[NE]; unsigned acc = 0; float gu[NE];
#pragma unroll
    for (int e = 0; e < NE; ++e) { cnt[e] = ltot[e]; base[e] = acc; acc += (cnt[e] + 255u) & ~255u; gu[e] = __uint_as_float(p->ctrl[C_GMAX + e]) * __uint_as_float(p->ctrl[C_UMAX + e]); }
    const int rpw = (NTOK + nb - 1) / nb, rbeg = bid * rpw, rend = (rbeg + rpw) < NTOK ? (rbeg + rpw) : NTOK;
    for (int a = rbeg * 2 + tid; a < rend * 2; a += NTHREADS) {
        const int e = p->midx[a];
        unsigned b0 = 0;
#pragma unroll
        for (int j = 0; j < NE; ++j) if (j == e) b0 = base[j];
        const unsigned s = b0 + lpre[e] + LDS_ATOMIC_ADD(lcur + e, 1u);
        p->slot_of[a] = (int)s; p->arow[s] = a >> 1; p->sslot[s] = p->hns[a >> 1];
        float gm = 0.f;
#pragma unroll
        for (int j = 0; j < NE; ++j) if (j == e) gm = gu[j];
        p->shs[s] = p->hnn2[a >> 1] * gm * (1.0f / 256.f);
    }
    if (bid == 0) {
        if (tid == 0) { p->ctrl[C_NTILES] = acc >> 8; p->ctrl[C_TB + NE] = acc >> 8; }
        if (tid < NE) { unsigned bb = 0;
#pragma unroll
            for (int e = 0; e < NE; ++e) if (e == tid) bb = base[e];
            p->ctrl[C_TB + tid] = bb >> 8; }
#pragma unroll
        for (int e = 0; e < NE; ++e) {
            const unsigned lo = base[e] + cnt[e], hi = base[e] + ((cnt[e] + 255u) & ~255u);
            for (unsigned s2 = lo + tid; s2 < hi; s2 += NTHREADS) { p->arow[s2] = 0; p->sslot[s2] = 0.f; p->shs[s2] = 1.0f; }
            for (unsigned t = (base[e] >> 8) + tid; t < (hi >> 8); t += NTHREADS) p->tile_e[t] = e;
        }
    }
}
__device__ __forceinline__ void phase_final(KPTR p, const bf16_t* hsrc, int lo, int hi, int bid, int nb, int wv) {
    const int tid = opaque_tid(wv), wid = tid >> 6, lane = tid & 63;
    f32x4 gv[4];
#pragma unroll
    for (int i = 0; i < 4; ++i) gv[i] = *(const f32x4*)(p->final_norm + i * 256 + lane * 4);
    int sl0 = 0, sl1 = 0; float ga0 = 0.f, ga1 = 0.f;
    { const int row = lo + bid * 8 + wid; if (row < hi) { sl0 = p->slot_of[row * 2]; sl1 = p->slot_of[row * 2 + 1]; ga0 = p->mgate[row * 2]; ga1 = p->mgate[row * 2 + 1]; } }
    for (int row = lo + bid * 8 + wid; row < hi; row += nb * 8) {
        const int s0 = sl0, s1 = sl1; const float g0 = ga0, g1 = ga1;
        u32x2 y0[4], y1[4];
#pragma unroll
        for (int i = 0; i < 4; ++i) { y0[i] = *(const u32x2*)(p->yslot + (size_t)s0 * DM + i * 256 + lane * 4); y1[i] = *(const u32x2*)(p->yslot + (size_t)s1 * DM + i * 256 + lane * 4); }
        f32x4 v[4]; load_row_b(hsrc, row, lane, v);
        { const int rn = row + nb * 8; if (rn < hi) { sl0 = p->slot_of[rn * 2]; sl1 = p->slot_of[rn * 2 + 1]; ga0 = p->mgate[rn * 2]; ga1 = p->mgate[rn * 2 + 1]; } }
#pragma unroll
        for (int i = 0; i < 4; ++i) {
            v[i][0] += g0 * __uint_as_float(y0[i].x << 16) + g1 * __uint_as_float(y1[i].x << 16); v[i][1] += g0 * __uint_as_float(y0[i].x & 0xffff0000u) + g1 * __uint_as_float(y1[i].x & 0xffff0000u);
            v[i][2] += g0 * __uint_as_float(y0[i].y << 16) + g1 * __uint_as_float(y1[i].y << 16); v[i][3] += g0 * __uint_as_float(y0[i].y & 0xffff0000u) + g1 * __uint_as_float(y1[i].y & 0xffff0000u); }
        const float rs = row_rstd(v);
#pragma unroll
        for (int i = 0; i < 4; ++i) *(f32x4*)(p->out + (size_t)row * DM + i * 256 + lane * 4) = v[i] * rs * gv[i];
    }
}


#ifndef CPU_EMU
#define XB_TMO      128
#define XB_XCNT(j)  (256  + 64 * (j))
#define XB_XSUB(j)  (1280 + 64 * (j))
#define XB_XGEN(j)  (2304 + 64 * (j))
#define XB_TOP      3328
#define XB_TOPGEN   3392
#define XCD_BAR_WORDS 3456
#define XB_SPIN_CAP (1u << 20)
__device__ __forceinline__ unsigned xb_ld(unsigned* p) { return __hip_atomic_load(p, __ATOMIC_RELAXED, __HIP_MEMORY_SCOPE_AGENT); }
__device__ __forceinline__ unsigned xb_add(unsigned* p, unsigned v) { return __hip_atomic_fetch_add(p, v, __ATOMIC_RELAXED, __HIP_MEMORY_SCOPE_AGENT); }
__device__ __forceinline__ unsigned xb_xcc_id() { return (unsigned)__builtin_amdgcn_s_getreg((3 << 11) | 20) & 0xFu; }
#define XB_SPIN(cond, bar) do { unsigned _sp = 0; while (cond) { __builtin_amdgcn_s_sleep(1); \
    if ((++_sp & 255u) == 0u) { if (xb_ld(&(bar)[XB_TMO])) break; if (_sp > XB_SPIN_CAP) { atomicAdd(&(bar)[XB_TMO], 1u); break; } } } } while (0)
__device__ __forceinline__ void xcd_barrier_post(unsigned* bar, int tid) { if (tid == 0) (void)xb_add(&bar[XB_XCNT(xb_xcc_id())], 1u); }
__device__ __forceinline__ void xcd_barrier_complete(unsigned* bar, unsigned x, unsigned& nloc, unsigned& nx) {
    const unsigned G = gridDim.x * gridDim.y * gridDim.z;
    unsigned sum, cnt, mine, sp = 0u;
    for (;;) {
        sum = 0u; cnt = 0u; mine = 0u;
#pragma unroll
        for (unsigned j = 0; j < 16; ++j) { const unsigned c = xb_ld(&bar[XB_XCNT(j)]); sum += c; cnt += (c > 0u) ? 1u : 0u; mine = (j == x) ? c : mine; }
        if (sum == G) break;
        __builtin_amdgcn_s_sleep(1);
        if ((++sp & 255u) == 0u) { if (xb_ld(&bar[XB_TMO])) break; if (sp > XB_SPIN_CAP) { atomicAdd(&bar[XB_TMO], 1u); break; } }
    }
    nloc = mine > 0u ? mine : 1u; nx = cnt > 0u ? cnt : 1u;
}
__device__ __forceinline__ void xcd_barrier(unsigned* bar, volatile LAS unsigned* st, int tid) {
    asm volatile("s_waitcnt vmcnt(0)" ::: "memory");
    __syncthreads();
    if (tid == 0) {
        __builtin_amdgcn_s_waitcnt(0);
        const unsigned x = xb_xcc_id();
        unsigned nloc = st[0], nx = st[1];
        if (nloc == 0u) { xcd_barrier_complete(bar, x, nloc, nx); st[0] = nloc; st[1] = nx; }
        const unsigned old = xb_add(&bar[XB_XSUB(x)], 1u);
        const unsigned gen = old / nloc;
        if (old + 1u == (gen + 1u) * nloc) {
            __builtin_amdgcn_fence(__ATOMIC_RELEASE, "agent");
            asm volatile("s_waitcnt vmcnt(0)" ::: "memory");
            const unsigned og = xb_add(&bar[XB_TOP], 1u);
            const unsigned tg = og / nx;
            if (og + 1u == (tg + 1u) * nx) xb_add(&bar[XB_TOPGEN], 1u);
            else XB_SPIN(xb_ld(&bar[XB_TOPGEN]) == tg, bar);
            __builtin_amdgcn_fence(__ATOMIC_ACQUIRE, "agent");
            xb_add(&bar[XB_XGEN(x)], 1u);
            asm volatile("s_waitcnt vmcnt(0)" ::: "memory");
        } else {
            XB_SPIN(xb_ld(&bar[XB_XGEN(x)]) == gen, bar);
            __builtin_amdgcn_fence(__ATOMIC_ACQUIRE, "agent");
            asm volatile("s_waitcnt vmcnt(0)" ::: "memory");
        }
    }
    __syncthreads();
}
#define GRID_BARRIER() do { unsigned* _bar = p->bar; xcd_barrier(_bar, (volatile LAS unsigned*)(lds + kDynLds - 16), opaque_tid(wv)); } while (0)
#else
#define XCD_BAR_WORDS 3456
#define GRID_BARRIER() emu::grid_sync()
#endif

#ifndef CPU_EMU
extern __shared__ __attribute__((aligned(16))) unsigned char smem_raw[];
#define GET_LDS() ((LAS unsigned char*)smem_raw)
#else
#define GET_LDS() (emu::blk->smem)
#endif

__global__ void __launch_bounds__(NTHREADS) fwd_megakernel(Params p_arg) {
    cg::grid_group grid = cg::this_grid();
    KPTR p = KARG_PTR(p_arg);
    LAS unsigned char* lds = GET_LDS();
#ifndef CPU_EMU
    const int wv = __builtin_amdgcn_readfirstlane((int)(threadIdx.x >> 6));
#else
    const int wv = 0;
#endif
    const int bid = blockIdx.x, nb = gridDim.x, tid = opaque_tid(wv);
#ifndef CPU_EMU
    if (tid == 0) { volatile LAS unsigned* st = (volatile LAS unsigned*)(lds + kDynLds - 16); st[0] = 0u; st[1] = 0u; }
    __syncthreads();
    xcd_barrier_post(p->bar, tid);
#endif
    LAUNDER(p);
    if (bid == 0 && tid < 256) p->ctrl[tid] = 0u;
    for (int i = bid * NTHREADS + tid; i < NIT; i += nb * NTHREADS) p->mcount[i] = 0u;
    for (int i = bid * NTHREADS + tid; i < NCHH; i += nb * NTHREADS) p->gflag[i] = 0u;
    convert_wt(lds, p->w_in, DM, DIN, 0, DINP, p->wt_in, 128, 0, bid, nb, wv);
    convert_wt(lds, p->w_out0, DM, DM, 0, DM, p->wt_out0, 128, 0, bid, nb, wv);
    convert_wt(lds, p->w_gate0, DM, FF, 0, FF, p->wt_gu0, 256, 0, bid, nb, wv);
    convert_wt(lds, p->w_up0, DM, FF, 0, FF, p->wt_gu0, 256, 128, bid, nb, wv);
    convert_wt(lds, p->w_down0, FF, DM, 0, DM, p->wt_d0, 128, 0, bid, nb, wv);
    convert_wt(lds, p->w_qkv, DM, 3072, 0, 3072, p->wt_qkv, 128, 0, bid, nb, wv);
    convert_wt(lds, p->w_out1, DM, DM, 0, DM, p->wt_out1, 128, 0, bid, nb, wv);
    phase_norm<true>(p, p->x, p->mix_norm, bid, nb, wv);
    if (p->pad0 != 0) grid.sync(); else GRID_BARRIER();
    LAUNDER(p);
    for (int rp = 0; rp < RPT_GEMM; ++rp) { StaticOrder so; so.init(NTOK / 256, DINP / 256, nb, bid); Gemm g{p->hn, p->wt_in, nullptr}; EpiBf16 e{p->proj, DINP, 0}; gemm_phase<DM>(lds, g, so, e, wv); }
    GRID_BARRIER();
    LAUNDER(p);
    constexpr int NUG_ = ((BATCH * 4 + 7) / 8) * 8 * (8 / NCW);
    const bool overlap = nb >= NUG_ + 32;
    if (!overlap) phase_gdn_pre<false>(p, lds, bid, nb, wv);
    phase_ret_local(p, lds, bid, nb, wv);
    GRID_BARRIER();
    LAUNDER(p);
    if (overlap) phase_scan<true>(p, lds, bid, nb, wv); else phase_scan<false>(p, lds, bid, nb, wv);
    GRID_BARRIER();
    LAUNDER(p);
    phase_gatednorm(p, bid, nb, wv);
    GRID_BARRIER();
    LAUNDER(p);
    { StaticOrder so; so.init(NTOK / 256, DM / 256, nb, bid); Gemm g{p->hn, p->wt_out0, nullptr}; EpiResBf16<true> e{p->x, nullptr, p->hb}; gemm_phase<DM>(lds, g, so, e, wv); }
    GRID_BARRIER();
    LAUNDER(p);
#if FP8_FFN0
    phase_norm<false, true, true>(p, p->hb, p->ffn_norm, bid, nb, wv);
    quant_rows<DM, false>(p, lds, p->wt_gu0, p->w8_gu0, p->ws_gu0, 2 * FF, bid, nb, wv);
#else
    phase_norm<false, false, true>(p, p->hb, p->ffn_norm, bid, nb, wv);
#endif
    GRID_BARRIER();
    LAUNDER(p);
#if FP8_FFN0
    for (int rp = 0; rp < RPT_GEMM; ++rp) { StaticOrder so; so.init(NTOK / 256, 2 * FF / 256, nb, bid); Gemm g{p->hn, (const bf16_t*)p->w8_gu0, nullptr}; EpiSwigluS e{p->act0, FF, 0, p->hns, p->ws_gu0}; gemm_phase<DM, EpiSwigluS, StaticOrder, true>(lds, g, so, e, wv); }
#else
    for (int rp = 0; rp < RPT_GEMM; ++rp) { StaticOrder so; so.init(NTOK / 256, 2 * FF / 256, nb, bid); Gemm g{p->hn, p->wt_gu0, nullptr}; EpiSwiglu e{p->act0, FF, 0}; gemm_phase<DM>(lds, g, so, e, wv); }
#endif
    GRID_BARRIER();
    LAUNDER(p);
    { StaticOrder so; so.init(NTOK / 256, DM / 256, nb, bid); Gemm g{p->act0, p->wt_d0, nullptr}; EpiResBf16<false> e{nullptr, p->hb, p->hb}; gemm_phase<FF>(lds, g, so, e, wv); }
    GRID_BARRIER();
    LAUNDER(p);
    phase_norm<false, false, true>(p, p->hb, p->mix_norm + DM, bid, nb, wv);
    GRID_BARRIER();
    LAUNDER(p);
    for (int rp = 0; rp < RPT_GEMM; ++rp) { StaticOrder so; so.init(NTOK / 256, 3072 / 256, nb, bid); Gemm g{p->hn, p->wt_qkv, nullptr}; EpiBf16 e{p->qkv, 3072, 0}; gemm_phase<DM>(lds, g, so, e, wv); }
    GRID_BARRIER();
    LAUNDER(p);
    phase_kmean(p, lds, bid, nb, wv);
    GRID_BARRIER();
    LAUNDER(p);
    phase_moba_select(p, lds, bid, nb, wv);
    GRID_BARRIER();
    LAUNDER(p);
    for (int rp = 0; rp < RPT_MG; ++rp) phase_moba_gather(p, lds, bid, nb, wv);
    GRID_BARRIER();
    LAUNDER(p);
    for (int rp = 0; rp < RPT_MO; ++rp) phase_moba_own(p, lds, bid, nb, wv);
    GRID_BARRIER();
    LAUNDER(p);
    convert_gu_fp8(p, lds, bid, nb, wv);
    for (int rp = 0; rp < RPT_CONV; ++rp) for (int e = 0; e < NE; ++e) {
        convert_wt(lds, p->w_mdown + (size_t)e * FFE * DM, FFE, DM, 0, DM, p->wt_md_tmp + (size_t)e * DM * FFE, 128, 0, bid, nb, wv);
    }
    { StaticOrder so; so.init(NTOK / 256, DM / 256, nb, bid); Gemm g{p->hn, p->wt_out1, nullptr}; EpiResBf16<false> e{nullptr, p->hb, p->hb3}; gemm_phase<DM>(lds, g, so, e, wv); }
    GRID_BARRIER();
    LAUNDER(p);
    phase_router(p, lds, bid, nb, wv);
    quant_rows<FFE, false>(p, lds, p->wt_md_tmp, p->w8_md, p->ws_md, NE * DM, bid, nb, wv);
    GRID_BARRIER();
    LAUNDER(p);
    phase_slots(p, lds, bid, nb, wv);
    GRID_BARRIER();
    LAUNDER(p);
    {
        const int ntiles = (int)p->ctrl[C_NTILES];
        const int npass = (ntiles + p->tiles_per_pass - 1) / p->tiles_per_pass;
        const int tpp = npass > 0 ? (ntiles + npass - 1) / npass : 1;
        const size_t mbuf = (size_t)p->tiles_per_pass * 256 * FFE; int q = 0;
        for (int t0 = 0; t0 < ntiles; t0 += tpp, ++q) {
            const int nM = (ntiles - t0) < tpp ? (ntiles - t0) : tpp;
            unsigned char* mb = (unsigned char*)p->mact + (size_t)(q & 1) * mbuf;
            for (int rp = 0; rp < RPT_GEMM; ++rp) { MoeOrder mo; mo.init(t0, nM, 2 * FFE / 256, p->tile_e, nb, bid); Gemm g{p->hn, (const bf16_t*)p->w8_mgu, p->arow}; EpiSwigluS8 e{mb, FFE, t0 * 256, p->sslot, p->ws_mgu, p->shs}; gemm_phase<DM, EpiSwigluS8, MoeOrder, true>(lds, g, mo, e, wv); }
            GRID_BARRIER();
            for (int rp = 0; rp < RPT_GEMM; ++rp) { MoeOrder mo; mo.init(t0, nM, DM / 256, p->tile_e, nb, bid); Gemm g{(const bf16_t*)((const unsigned char*)mb - (size_t)t0 * 256 * FFE), (const bf16_t*)p->w8_md, nullptr}; EpiBf16S e{p->yslot, DM, p->shs, p->ws_md}; gemm_phase<FFE, EpiBf16S, MoeOrder, true>(lds, g, mo, e, wv); }
        }
        GRID_BARRIER();
    }
    LAUNDER(p);
    phase_final(p, p->hb3, 0, NTOK, bid, nb, wv);
}

static inline size_t al256(size_t x) { return (x + 255) & ~(size_t)255; }

extern "C" void kernel_launch(void* const* d_in, const int* in_sizes, int n_in, void* d_out, int out_size, void* d_ws, size_t ws_size, hipStream_t stream) {
    Params p; memset(&p, 0, sizeof(p));
    p.x = (const float*)d_in[0]; p.mix_norm = (const float*)d_in[1]; p.ffn_norm = (const float*)d_in[2]; p.w_in = (const float*)d_in[3]; p.conv_w = (const float*)d_in[4];
    p.a_log = (const float*)d_in[5]; p.dt_bias = (const float*)d_in[6]; p.ret_norm = (const float*)d_in[7]; p.gdn_norm = (const float*)d_in[8]; p.w_out0 = (const float*)d_in[9];
    p.w_qkv = (const float*)d_in[10]; p.w_out1 = (const float*)d_in[11]; p.w_gate0 = (const float*)d_in[12]; p.w_up0 = (const float*)d_in[13]; p.w_down0 = (const float*)d_in[14];
    p.w_router = (const float*)d_in[15]; p.w_mgate = (const float*)d_in[16]; p.w_mup = (const float*)d_in[17]; p.w_mdown = (const float*)d_in[18]; p.final_norm = (const float*)d_in[19];
    p.out = (float*)d_out; p.hb = (bf16_t*)((unsigned char*)d_out + (size_t)NTOK * DM * 2);
    unsigned char* w = (unsigned char*)d_ws; size_t off = 0;
    auto take = [&](size_t bytes) { unsigned char* r = w + off; off += al256(bytes); return r; };
    p.ctrl = (unsigned*)take(4096); p.bar = (unsigned*)take((size_t)XCD_BAR_WORDS * 4);
    p.wt_in = (bf16_t*)take((size_t)DINP * DM * 2); p.wt_out0 = (bf16_t*)take((size_t)DM * DM * 2); p.wt_gu0 = (bf16_t*)take((size_t)2 * FF * DM * 2); p.wt_d0 = (bf16_t*)take((size_t)DM * FF * 2);
    p.wt_qkv = (bf16_t*)take((size_t)3072 * DM * 2); p.wt_out1 = (bf16_t*)take((size_t)DM * DM * 2);
    p.hn = (bf16_t*)take((size_t)NTOK * DM * 2);
    p.gflag = (unsigned*)take((size_t)NCHH * 4);
    p.retL = (float*)take((size_t)BATCH * 4 * NG * 128 * 128 * 4);
    p.gbeta = (float*)take((size_t)NTOK * 4 * 4); p.gg = (float*)take((size_t)NTOK * 4 * 4);
    p.arow = (int*)take((size_t)MAXTILES * 256 * 4); p.tile_e = (int*)take((size_t)MAXTILES * 4); p.slot_of = (int*)take((size_t)NTOK * 2 * 4); p.mgate = (float*)take((size_t)NTOK * 2 * 4); p.midx = (int*)take((size_t)NTOK * 2 * 4); p.wghist = (unsigned*)take((size_t)4096 * 8 * 4);
    p.w8_gu0 = take(FP8_FFN0 ? (size_t)2 * FF * DM : (size_t)256); p.ws_gu0 = (float*)take((size_t)2 * FF * 4); p.ws_mgu = (float*)take((size_t)NE * 2 * FFE * 4); p.hns = (float*)take((size_t)NTOK * 4); p.sslot = (float*)take((size_t)MAXTILES * 256 * 4);
    p.ws_md = (float*)take((size_t)NE * DM * 4); p.hnn2 = (float*)take((size_t)NTOK * 4); p.shs = (float*)take((size_t)MAXTILES * 256 * 4);
    p.kmh = (bf16_t*)take((size_t)NIT * 128 * 2); p.kml = (bf16_t*)take((size_t)NIT * 128 * 2); p.mcount = (unsigned*)take((size_t)NIT * 4);
    p.arena = w + off;
    const size_t arena_bytes = ws_size - off;
    { size_t a = 0; auto at = [&](size_t bytes) { unsigned char* r = p.arena + a; a += al256(bytes); return r; };
      p.proj = (bf16_t*)at((size_t)NTOK * DINP * 2);
      p.gimg = (unsigned char*)at((size_t)NCHH * IMG_CH); p.gcdec = (float*)at((size_t)NCHH * 4);
      if (a > arena_bytes) fprintf(stderr, "workspace too small (layer0): need %zu have %zu\n", a, arena_bytes); }
    p.act0 = (bf16_t*)p.arena;
    { size_t a = 0; auto at = [&](size_t bytes) { unsigned char* r = p.arena + a; a += al256(bytes); return r; };
      p.qkv = (bf16_t*)at((size_t)NTOK * 3072 * 2); p.part_o = (bf16_t*)at((size_t)NTOK * 8 * 3 * 128 * 2); p.part_lse = (float*)at((size_t)NTOK * 8 * 3 * 4); p.mlist = (unsigned short*)at((size_t)BATCH * 8 * LTOT * 2);
      if (a > arena_bytes) fprintf(stderr, "workspace too small (layer1): need %zu have %zu\n", a, arena_bytes); }
    { size_t a = 0; auto at = [&](size_t bytes) { unsigned char* r = p.arena + a; a += al256(bytes); return r; };
      p.w8_mgu = at((size_t)NE * 2 * FFE * DM); p.w8_md = at((size_t)NE * DM * FFE); p.yslot = (bf16_t*)at((size_t)MAXTILES * 256 * DM * 2);
      p.hb3 = (bf16_t*)at((size_t)NTOK * DM * 2);
      p.mact = (bf16_t*)(p.arena + a);
      p.wt_mgu = nullptr; p.wt_md_tmp = p.mact; p.wt_md = nullptr;
      const size_t rest = arena_bytes > a ? arena_bytes - a : 0;
      if (rest < (size_t)NE * FFE * DM * 2) fprintf(stderr, "workspace too small (moe weights)\n");
      long tiles = (long)(rest / ((size_t)2 * 256 * FFE));
      if (tiles > 64) tiles = 64;
      if (tiles < 1) { fprintf(stderr, "workspace too small (moe)\n"); tiles = 1; }
#ifdef CPU_EMU
      if (getenv("EMU_TPP")) tiles = atoi(getenv("EMU_TPP"));
#endif
      p.tiles_per_pass = (int)tiles; }
#ifdef CPU_EMU
    emu::reg("hn", p.hn, (size_t)NTOK * DM * 2, "bf16"); emu::reg("proj", p.proj, (size_t)NTOK * DINP * 2, "bf16");
    emu::reg("gbeta", p.gbeta, (size_t)NTOK * 16, "f32"); emu::reg("gg", p.gg, (size_t)NTOK * 16, "f32"); emu::reg("midx", p.midx, (size_t)NTOK * 8, "i32");
    const int grid_blocks = getenv("EMU_GRID") ? atoi(getenv("EMU_GRID")) : 8;
    emu::launch(grid_blocks, NTHREADS, kDynLds, [=]() { fwd_megakernel(p); }, true);
#else
    static int grid_blocks = 0;
    if (!grid_blocks) {
        int dev = 0, cus = 0, per_cu = 0;
        (void)hipGetDevice(&dev);
        (void)hipDeviceGetAttribute(&cus, hipDeviceAttributeMultiprocessorCount, dev);
        (void)hipFuncSetAttribute((const void*)fwd_megakernel, hipFuncAttributeMaxDynamicSharedMemorySize, (int)kDynLds);
        (void)hipOccupancyMaxActiveBlocksPerMultiprocessor(&per_cu, fwd_megakernel, NTHREADS, kDynLds);
        if (per_cu < 1) per_cu = 1;
        grid_blocks = cus;
    }
    (void)hipMemsetAsync(p.bar, 0, (size_t)XCD_BAR_WORDS * 4, stream);
    void* args[] = {&p};
    hipError_t e = hipLaunchCooperativeKernel((const void*)fwd_megakernel, dim3(grid_blocks), dim3(NTHREADS), args, kDynLds, stream);
    if (e != hipSuccess) fprintf(stderr, "cooperative launch failed: %s (grid %d)\n", hipGetErrorString(e), grid_blocks);
#endif
}
```

```cpp
#ifndef CPU_EMU
#include <hip/hip_runtime.h>
#include <hip/hip_cooperative_groups.h>
#include <cstdio>
#include <cstring>
#define LAS __attribute__((address_space(3)))
#define WAVE_SYNC() __builtin_amdgcn_wave_barrier()
#define SCHED_FENCE() __builtin_amdgcn_sched_barrier(0)
#define OPAQUE_V(x) asm volatile("" : "+v"(x))
static __device__ __forceinline__ unsigned shfl_up_u(unsigned v, int o, int lane) { const int src = lane >= o ? lane - o : lane; return (unsigned)__builtin_amdgcn_ds_bpermute(src << 2, (int)v); }
static __device__ __forceinline__ float shfl_up_f(float v, int o, int lane) { return __uint_as_float(shfl_up_u(__float_as_uint(v), o, lane)); }
#define LDS_ATOMIC_ADD(ptr, v) __hip_atomic_fetch_add((ptr), (v), __ATOMIC_RELAXED, __HIP_MEMORY_SCOPE_WORKGROUP)
#define LDS_ATOMIC_MAX(ptr, v) __hip_atomic_fetch_max((ptr), (v), __ATOMIC_RELAXED, __HIP_MEMORY_SCOPE_WORKGROUP)
#define GLOBAL_ATOMIC_MAX(ptr, v) __hip_atomic_fetch_max((ptr), (v), __ATOMIC_RELAXED, __HIP_MEMORY_SCOPE_AGENT)
static __device__ __forceinline__ int opaque_tid(int wv) { int l; asm volatile("v_mbcnt_lo_u32_b32 %0, -1, 0\n\tv_mbcnt_hi_u32_b32 %0, -1, %0" : "=v"(l)); return (wv << 6) | l; }
#else
static inline int opaque_tid(int) { return threadIdx.x; }
#define LAS
#define WAVE_SYNC() ((void)__ballot(1))
#define SCHED_FENCE() ((void)0)
#define OPAQUE_V(x) ((void)0)
static inline unsigned shfl_up_u(unsigned v, int o, int lane) { return __shfl(v, lane >= o ? lane - o : lane); }
static inline float shfl_up_f(float v, int o, int lane) { return __shfl(v, lane >= o ? lane - o : lane); }
static inline unsigned emu_fetch_add(unsigned* p, unsigned v) { unsigned o = *p; *p = o + v; return o; }
#define LDS_ATOMIC_ADD(ptr, v) emu_fetch_add((ptr), (v))
static inline unsigned emu_fetch_max(unsigned* p, unsigned v) { unsigned o = *p; if (v > o) *p = v; return o; }
#define LDS_ATOMIC_MAX(ptr, v) emu_fetch_max((ptr), (v))
#define GLOBAL_ATOMIC_MAX(ptr, v) atomicMax((ptr), (v))
#endif
namespace cg = cooperative_groups;

#ifndef RPT_SYNC
#define RPT_SYNC 0
#endif
#ifndef RPT_SG
#define RPT_SG 1
#endif
#ifndef RPT_SR
#define RPT_SR 1
#endif
#ifndef RPT_MG
#define RPT_MG 1
#endif
#ifndef RPT_MO
#define RPT_MO 1
#endif
#ifndef RPT_GEMM
#define RPT_GEMM 1
#endif
#ifndef RPT_GDN
#define RPT_GDN 1
#endif
#ifndef RPT_SCAN
#define RPT_SCAN 1
#endif
#ifndef RPT_MOBA
#define RPT_MOBA 1
#endif
#ifndef RPT_CONV
#define RPT_CONV 1
#endif
#ifndef FP8_FFN0
#define FP8_FFN0 0
#endif
#ifndef CFG_SEQ
#define CFG_SEQ 16384
#define CFG_BATCH 2
#define CFG_FF 2816
#define CFG_FFE 3584
#endif

typedef unsigned short bf16_t;
typedef short bf16x8 __attribute__((ext_vector_type(8)));
typedef float f32x4 __attribute__((ext_vector_type(4)));
typedef float f32x16 __attribute__((ext_vector_type(16)));
typedef unsigned u32x4 __attribute__((ext_vector_type(4)));
typedef unsigned u32x2 __attribute__((ext_vector_type(2)));

constexpr int DM = 1024, SEQ = CFG_SEQ, BATCH = CFG_BATCH, NTOK = SEQ * BATCH, HD = 128;
constexpr int DIN = 4104, DINP = 4096, FF = CFG_FF, FFE = CFG_FFE, NE = 8;
constexpr int NCH = SEQ / 64, NBLK = SEQ / 256, NCHH = BATCH * 4 * NCH;
constexpr int NTHREADS = 512;
constexpr int BM = 256, BK = 64, HALF = 128, HTB = HALF * BK * 2, STAGE_BYTES = 8 * HTB, NXCD = 8, WGM = 4;
constexpr size_t kDynLds = 144 * 1024;
constexpr int MAXTILES = NTOK * 2 / 256 + NE;
constexpr int NIT = BATCH * 8 * NBLK;
constexpr int LTOT = NBLK * SEQ - 128 * NBLK * (NBLK + 1);
static_assert(SEQ <= 16384, "16-bit selection-list entries");
constexpr int GNT = (NBLK + 15) / 16;
constexpr int KS_STRIDE = 272, VT_STRIDE = 520;
constexpr int KS_BYTES = 256 * KS_STRIDE, VT_BYTES = 128 * VT_STRIDE;
__host__ __device__ __forceinline__ int list_off(int j) { return j * SEQ - 128 * j * (j + 1); }
constexpr float NORM_EPS = 1e-6f;

__device__ __forceinline__ bf16_t f2bf(float f) { unsigned u = __float_as_uint(f); u += 0x7FFFu + ((u >> 16) & 1u); return (bf16_t)(u >> 16); }
__device__ __forceinline__ float bf2f(bf16_t h) { return __uint_as_float(((unsigned)h) << 16); }
#ifndef CPU_EMU
typedef __bf16 hwbf16x2 __attribute__((ext_vector_type(2)));
typedef float f32x2v __attribute__((ext_vector_type(2)));
__device__ __forceinline__ unsigned pack2(float lo, float hi) { f32x2v v; v.x = lo; v.y = hi; hwbf16x2 b = __builtin_convertvector(v, hwbf16x2); unsigned r; __builtin_memcpy(&r, &b, 4); return r; }
#else
__device__ __forceinline__ unsigned pack2(float lo, float hi) { return (unsigned)f2bf(lo) | ((unsigned)f2bf(hi) << 16); }
#endif
#ifndef CPU_EMU
__device__ __forceinline__ float siluf(float x) { return x * __builtin_amdgcn_rcpf(1.0f + __builtin_amdgcn_exp2f(-1.4426950408889634f * x)); }
#else
__device__ __forceinline__ float siluf(float x) { return x / (1.0f + __expf(-x)); }
#endif
#ifndef CPU_EMU
__device__ __forceinline__ unsigned pack4_fp8(float a, float b, float c, float d) { int r = 0; r = __builtin_amdgcn_cvt_pk_fp8_f32(a, b, r, false); r = __builtin_amdgcn_cvt_pk_fp8_f32(c, d, r, true); return (unsigned)r; }
#else
static inline float fp8_to_f(unsigned char v) { const int s = v >> 7, e = (v >> 3) & 15, m = v & 7; const float a = e == 0 ? ldexpf((float)m, -9) : ldexpf((float)(8 + m), e - 10); return s ? -a : a; }
static inline unsigned char f_to_fp8(float x) {
    const unsigned s = x < 0.f ? 0x80u : 0u; float a = fabsf(x); if (!(a == a)) return 0x7f; if (a > 448.f) a = 448.f; if (a == 0.f) return (unsigned char)s;
    int e; (void)frexpf(a, &e); e -= 1; if (e < -6) e = -6;
    const float step = ldexpf(1.f, e - 3); float q = nearbyintf(a / step) * step; if (q > 448.f) q = 448.f;
    int e2; (void)frexpf(q, &e2); e2 -= 1; unsigned bits;
    if (q < ldexpf(1.f, -6)) bits = (unsigned)nearbyintf(q * 512.f); else bits = ((unsigned)(e2 + 7) << 3) | ((unsigned)nearbyintf(q / ldexpf(1.f, e2 - 3)) - 8u);
    return (unsigned char)(s | bits);
}
static inline unsigned pack4_fp8(float a, float b, float c, float d) { return (unsigned)f_to_fp8(a) | ((unsigned)f_to_fp8(b) << 8) | ((unsigned)f_to_fp8(c) << 16) | ((unsigned)f_to_fp8(d) << 24); }
#endif
constexpr float FP8_TOP = 384.f;
#ifndef CPU_EMU
__device__ __forceinline__ float wave_sum(float s) { int l; asm volatile("v_mbcnt_lo_u32_b32 %0, -1, 0\n\tv_mbcnt_hi_u32_b32 %0, -1, %0" : "=v"(l));
#pragma unroll
    for (int o = 32; o >= 1; o >>= 1) s += __uint_as_float((unsigned)__builtin_amdgcn_ds_bpermute((l ^ o) << 2, (int)__float_as_uint(s))); return s; }
__device__ __forceinline__ float wave_max(float s) { int l; asm volatile("v_mbcnt_lo_u32_b32 %0, -1, 0\n\tv_mbcnt_hi_u32_b32 %0, -1, %0" : "=v"(l));
#pragma unroll
    for (int o = 32; o >= 1; o >>= 1) s = fmaxf(s, __uint_as_float((unsigned)__builtin_amdgcn_ds_bpermute((l ^ o) << 2, (int)__float_as_uint(s)))); return s; }
#else
__device__ __forceinline__ float wave_sum(float s) { for (int o = 32; o >= 1; o >>= 1) s += __shfl_xor(s, o); return s; }
__device__ __forceinline__ float wave_max(float s) { for (int o = 32; o >= 1; o >>= 1) s = fmaxf(s, __shfl_xor(s, o)); return s; }
#endif

struct Params;
#ifndef CPU_EMU
typedef const __attribute__((address_space(4))) Params* KPTR;
#define KARG_PTR(arg) ((KPTR)__builtin_amdgcn_kernarg_segment_ptr())
#define LAUNDER(q) asm volatile("" : "+s"(q))
#else
typedef const Params* KPTR;
#define KARG_PTR(arg) (&(arg))
#define LAUNDER(q) ((void)0)
#endif
struct Params {
    const float* x; const float* mix_norm; const float* ffn_norm; const float* w_in; const float* conv_w; const float* a_log; const float* dt_bias;
    const float* ret_norm; const float* gdn_norm; const float* w_out0; const float* w_qkv; const float* w_out1; const float* w_gate0; const float* w_up0;
    const float* w_down0; const float* w_router; const float* w_mgate; const float* w_mup; const float* w_mdown; const float* final_norm;
    float* out;
    bf16_t* hb;
    bf16_t* hb3;
    unsigned* ctrl;
    unsigned* bar;
    bf16_t* wt_in; bf16_t* wt_out0; bf16_t* wt_gu0; bf16_t* wt_d0; bf16_t* wt_qkv; bf16_t* wt_out1;
    bf16_t* hn;
    float* gbeta; float* gg;
    float* retL;
    unsigned* gflag;
    unsigned char* arena;
    bf16_t* proj; unsigned char* gimg; float* gcdec;
    bf16_t* act0;
    bf16_t* qkv; bf16_t* kmh; bf16_t* kml; unsigned* mcount; unsigned short* mlist; bf16_t* part_o; float* part_lse;
    bf16_t* wt_mgu; bf16_t* wt_md; bf16_t* yslot; bf16_t* mact; int* arow; int* tile_e; int* slot_of; float* mgate; int* midx; unsigned* wghist;
    unsigned char* w8_gu0; float* ws_gu0; unsigned char* w8_mgu; float* ws_mgu; float* hns; float* sslot; unsigned char* w8_md; float* ws_md; float* hnn2; float* sn2; float* shs; bf16_t* wt_md_tmp;
    int tiles_per_pass; int pad0;
};

#define C_CNT(e) (64 + (e))
#define C_CUR(e) (128 + (e))
#define C_NTILES 192
#define C_GMAX 216
#define C_UMAX 224
#define C_TB 200

__host__ __device__ __forceinline__ int lds_byte(int r, int c) { const int st = (r >> 4) * 2 + (c >> 5), rr = r & 15, cc = c & 31, ob = rr * 64 + cc * 2; return st * 1024 + (ob ^ (((ob >> 9) & 1) << 5)); }
__host__ __device__ __forceinline__ void stage_rc(int b, int& R, int& C) { const int st = b / 1024, sb = b % 1024, swz = sb ^ (((sb >> 9) & 1) << 5); R = (st >> 1) * 16 + swz / 64; C = (st & 1) * 32 + (swz % 64) / 2; }
__host__ __device__ __forceinline__ int perm32(int rho) { const int n = rho >> 4, i = rho & 15; return 8 * (i >> 2) + 4 * n + (i & 3); }

struct Unit { int pm, pn, pnb; };
struct Gemm { const bf16_t* A; const bf16_t* Bt; const int* arow; };

struct StaticOrder {
    int nM, nN, nwg, G, c;
    __device__ void init(int nM_, int nN_, int G_, int c_) { nM = nM_; nN = nN_; nwg = nM * nN; G = G_; c = c_; }
    __device__ bool next(int i, Unit& u) const {
        const long L = (long)i * G + c; if (L >= nwg) return false;
        int wgid = (int)L; { const int q = nwg / NXCD, r = nwg % NXCD, xcd = wgid % NXCD, off = wgid / NXCD; wgid = (xcd < r ? xcd * (q + 1) : r * (q + 1) + (xcd - r) * q) + off; }
        const int nig = WGM * nN, gid = wgid / nig, fm = gid * WGM, gsz = (nM - fm) < WGM ? (nM - fm) : WGM;
        u.pm = fm + ((wgid % nig) % gsz); u.pn = (wgid % nig) / gsz; u.pnb = u.pn; return true;
    }
};
struct MoeOrder {
    StaticOrder so; int t0; const int* tile_e;
    __device__ void init(int t0_, int nM_, int nN_, const int* te, int G_, int c_) { so.init(nM_, nN_, G_, c_); t0 = t0_; tile_e = te; }
    __device__ bool next(int i, Unit& u) const { if (!so.next(i, u)) return false; u.pm += t0; u.pnb = tile_e[u.pm] * so.nN + u.pn; return true; }
};

struct EpiBf16 {
    static constexpr bool PERM = true;
    bf16_t* O; int ldc; int rowbase;
    __device__ __forceinline__ void operator()(const f32x4 (&acc)[2][2][4][2], const Unit& u, int wr, int wc, int fr, int fq) const {
        const int row0 = u.pm * BM + wr * 64 + fr - rowbase, col0 = u.pn * BM + wc * 32 + 8 * fq;
#pragma unroll
        for (int ai = 0; ai < 2; ++ai)
#pragma unroll
            for (int m = 0; m < 4; ++m) { bf16_t* rowp = O + (size_t)(row0 + ai * HALF + m * 16) * ldc + col0;
#pragma unroll
                for (int bj = 0; bj < 2; ++bj) { const f32x4 v0 = acc[ai][bj][m][0], v1 = acc[ai][bj][m][1];
                    u32x4 w; w.x = pack2(v0[0], v0[1]); w.y = pack2(v0[2], v0[3]); w.z = pack2(v1[0], v1[1]); w.w = pack2(v1[2], v1[3]);
                    *(u32x4*)(rowp + bj * HALF) = w; } }
    }
};
struct EpiSwiglu {
    static constexpr bool PERM = true;
    bf16_t* O; int ldc; int rowbase;
    __device__ __forceinline__ void operator()(const f32x4 (&acc)[2][2][4][2], const Unit& u, int wr, int wc, int fr, int fq) const {
        const int row0 = u.pm * BM + wr * 64 + fr - rowbase, col0 = u.pn * HALF + wc * 32 + 8 * fq;
#pragma unroll
        for (int ai = 0; ai < 2; ++ai)
#pragma unroll
            for (int m = 0; m < 4; ++m) { bf16_t* rowp = O + (size_t)(row0 + ai * HALF + m * 16) * ldc + col0;
                float r[8];
#pragma unroll
                for (int n = 0; n < 2; ++n)
#pragma unroll
                    for (int j = 0; j < 4; ++j) r[n * 4 + j] = siluf(acc[ai][0][m][n][j]) * acc[ai][1][m][n][j];
                u32x4 w; w.x = pack2(r[0], r[1]); w.y = pack2(r[2], r[3]); w.z = pack2(r[4], r[5]); w.w = pack2(r[6], r[7]);
                *(u32x4*)rowp = w; }
    }
};
struct EpiSwigluS {
    static constexpr bool PERM = true;
    bf16_t* O; int ldc; int rowbase; const float* sa; const float* sb;
    __device__ __forceinline__ void operator()(const f32x4 (&acc)[2][2][4][2], const Unit& u, int wr, int wc, int fr, int fq) const {
        const int rowg = u.pm * BM + wr * 64 + fr, row0 = rowg - rowbase, col0 = u.pn * HALF + wc * 32 + 8 * fq;
        const float* sbp = sb + (size_t)u.pnb * BM + wc * 32 + 8 * fq;
        f32x4 sg[2], su[2];
#pragma unroll
        for (int n = 0; n < 2; ++n) { sg[n] = *(const f32x4*)(sbp + 4 * n); su[n] = *(const f32x4*)(sbp + HALF + 4 * n); }
        float ra[2][4];
#pragma unroll
        for (int ai = 0; ai < 2; ++ai)
#pragma unroll
            for (int m = 0; m < 4; ++m) ra[ai][m] = sa[rowg + ai * HALF + m * 16];
#pragma unroll
        for (int ai = 0; ai < 2; ++ai)
#pragma unroll
            for (int m = 0; m < 4; ++m) { bf16_t* rowp = O + (size_t)(row0 + ai * HALF + m * 16) * ldc + col0;
                float r[8];
#pragma unroll
                for (int n = 0; n < 2; ++n)
#pragma unroll
                    for (int j = 0; j < 4; ++j) r[n * 4 + j] = siluf(acc[ai][0][m][n][j] * (ra[ai][m] * sg[n][j])) * (acc[ai][1][m][n][j] * (ra[ai][m] * su[n][j]));
                u32x4 w; w.x = pack2(r[0], r[1]); w.y = pack2(r[2], r[3]); w.z = pack2(r[4], r[5]); w.w = pack2(r[6], r[7]);
                *(u32x4*)rowp = w; }
    }
};
struct EpiSwigluS8 {
    static constexpr bool PERM = true;
    unsigned char* O8; int ldc; int rowbase; const float* sa; const float* sb; const float* so;
    __device__ __forceinline__ void operator()(const f32x4 (&acc)[2][2][4][2], const Unit& u, int wr, int wc, int fr, int fq) const {
        const int rowg = u.pm * BM + wr * 64 + fr, row0 = rowg - rowbase, col0 = u.pn * HALF + wc * 32 + 8 * fq;
        const float* sbp = sb + (size_t)u.pnb * BM + wc * 32 + 8 * fq;
        f32x4 sg[2], su[2];
#pragma unroll
        for (int n = 0; n < 2; ++n) { sg[n] = *(const f32x4*)(sbp + 4 * n); su[n] = *(const f32x4*)(sbp + HALF + 4 * n); }
        float ra[2][4], ro[2][4];
#pragma unroll
        for (int ai = 0; ai < 2; ++ai)
#pragma unroll
            for (int m = 0; m < 4; ++m) { ra[ai][m] = sa[rowg + ai * HALF + m * 16]; const float so_ = so[rowg + ai * HALF + m * 16]; ro[ai][m] = so_ > 0.f ? 1.0f / so_ : 0.f; }
#pragma unroll
        for (int ai = 0; ai < 2; ++ai)
#pragma unroll
            for (int m = 0; m < 4; ++m) { unsigned char* rowp = O8 + (size_t)(row0 + ai * HALF + m * 16) * ldc + col0;
                float r[8];
#pragma unroll
                for (int n = 0; n < 2; ++n)
#pragma unroll
                    for (int j = 0; j < 4; ++j) r[n * 4 + j] = siluf(acc[ai][0][m][n][j] * (ra[ai][m] * sg[n][j])) * (acc[ai][1][m][n][j] * (ra[ai][m] * su[n][j])) * ro[ai][m];
                u32x2 w; w.x = pack4_fp8(r[0], r[1], r[2], r[3]); w.y = pack4_fp8(r[4], r[5], r[6], r[7]);
                *(u32x2*)rowp = w; }
    }
};
struct EpiBf16S {
    static constexpr bool PERM = true;
    bf16_t* O; int ldc; const float* sa; const float* sb;
    __device__ __forceinline__ void operator()(const f32x4 (&acc)[2][2][4][2], const Unit& u, int wr, int wc, int fr, int fq) const {
        const int row0 = u.pm * BM + wr * 64 + fr, col0 = u.pn * BM + wc * 32 + 8 * fq;
        const float* sbp = sb + (size_t)u.pnb * BM + wc * 32 + 8 * fq;
        f32x4 sv[2][2];
#pragma unroll
        for (int bj = 0; bj < 2; ++bj)
#pragma unroll
            for (int n = 0; n < 2; ++n) sv[bj][n] = *(const f32x4*)(sbp + bj * HALF + 4 * n);
#pragma unroll
        for (int ai = 0; ai < 2; ++ai)
#pragma unroll
            for (int m = 0; m < 4; ++m) { bf16_t* rowp = O + (size_t)(row0 + ai * HALF + m * 16) * ldc + col0; const float ra = sa[row0 + ai * HALF + m * 16];
#pragma unroll
                for (int bj = 0; bj < 2; ++bj) { const f32x4 v0 = acc[ai][bj][m][0] * sv[bj][0] * ra, v1 = acc[ai][bj][m][1] * sv[bj][1] * ra;
                    u32x4 w; w.x = pack2(v0[0], v0[1]); w.y = pack2(v0[2], v0[3]); w.z = pack2(v1[0], v1[1]); w.w = pack2(v1[2], v1[3]);
                    *(u32x4*)(rowp + bj * HALF) = w; } }
    }
};
template <bool F32BASE>
struct EpiResBf16 {
    static constexpr bool PERM = true;
    static constexpr bool LSCALE = false;
    const float* basef; const bf16_t* baseb; bf16_t* out;
    __device__ __forceinline__ void operator()(const f32x4 (&acc)[2][2][4][2], const Unit& u, int wr, int wc, int fr, int fq) const {
        const int row0 = u.pm * BM + wr * 64 + fr, col0 = u.pn * BM + wc * 32 + 8 * fq;
#pragma unroll
        for (int ai = 0; ai < 2; ++ai)
#pragma unroll
            for (int m = 0; m < 4; ++m) { const size_t off = (size_t)(row0 + ai * HALF + m * 16) * DM + col0;
#pragma unroll
                for (int bj = 0; bj < 2; ++bj) { f32x4 b0, b1;
                    if (F32BASE) { b0 = *(const f32x4*)(basef + off + bj * HALF); b1 = *(const f32x4*)(basef + off + bj * HALF + 4); }
                    else { const u32x4 w = *(const u32x4*)(baseb + off + bj * HALF);
                        b0[0] = __uint_as_float(w.x << 16); b0[1] = __uint_as_float(w.x & 0xffff0000u); b0[2] = __uint_as_float(w.y << 16); b0[3] = __uint_as_float(w.y & 0xffff0000u);
                        b1[0] = __uint_as_float(w.z << 16); b1[1] = __uint_as_float(w.z & 0xffff0000u); b1[2] = __uint_as_float(w.w << 16); b1[3] = __uint_as_float(w.w & 0xffff0000u); }
                    const f32x4 v0 = acc[ai][bj][m][0] + b0, v1 = acc[ai][bj][m][1] + b1;
                    u32x4 o; o.x = pack2(v0[0], v0[1]); o.y = pack2(v0[2], v0[3]); o.z = pack2(v1[0], v1[1]); o.w = pack2(v1[2], v1[3]);
                    *(u32x4*)(out + off + bj * HALF) = o; } }
    }
};
struct EpiResF32 {
    static constexpr bool PERM = false;
    const float* base; float* out; int ldc;
    __device__ __forceinline__ void operator()(const f32x4 (&acc)[2][2][4][2], const Unit& u, int wr, int wc, int fr, int fq) const {
        const int row0 = u.pm * BM + wr * 64 + fr, col0 = u.pn * BM + wc * 32 + 4 * fq;
#pragma unroll
        for (int ai = 0; ai < 2; ++ai)
#pragma unroll
            for (int m = 0; m < 4; ++m) { const size_t off = (size_t)(row0 + ai * HALF + m * 16) * ldc + col0;
#pragma unroll
                for (int bj = 0; bj < 2; ++bj)
#pragma unroll
                    for (int n = 0; n < 2; ++n) { const f32x4 b = *(const f32x4*)(base + off + bj * HALF + n * 16); *(f32x4*)(out + off + bj * HALF + n * 16) = b + acc[ai][bj][m][n]; } }
    }
};

#ifndef CPU_EMU
typedef int i32x8 __attribute__((ext_vector_type(8)));
__device__ __forceinline__ i32x8 cat8(const bf16x8 lo, const bf16x8 hi) { u32x4 a, b; __builtin_memcpy(&a, &lo, 16); __builtin_memcpy(&b, &hi, 16); i32x8 r; r[0] = (int)a.x; r[1] = (int)a.y; r[2] = (int)a.z; r[3] = (int)a.w; r[4] = (int)b.x; r[5] = (int)b.y; r[6] = (int)b.z; r[7] = (int)b.w; return r; }
template <int K, class Epi, class Sched, bool FP8 = false>
__device__ __forceinline__ void gemm_phase(LAS unsigned char* lds, const Gemm g, const Sched& S, const Epi& E, int wv) {
    const int tid = opaque_tid(wv), wid = __builtin_amdgcn_readfirstlane(tid >> 6), lane = tid & 63, wr = wid >> 2, wc = wid & 3, fr = lane & 15, fq = lane >> 4;
    constexpr int RB = FP8 ? K : 2 * K;
    constexpr int nt = RB / 128;
    static_assert(nt % 2 == 0 && nt >= 4, "k tiles");
    unsigned voffB[2];
#pragma unroll
    for (int i = 0; i < 2; ++i) { int R, C; stage_rc(tid * 16 + i * 8192, R, C); const int Rb = Epi::PERM ? ((R & ~31) + perm32(R & 31)) : R; voffB[i] = (unsigned)(Rb * RB + C * 2); }
    constexpr size_t kstep = (size_t)(BK * 2);
    constexpr size_t hstep = (size_t)HALF * RB;
    constexpr size_t tstep = 2 * hstep;
    const unsigned ldsw = (unsigned)wid * 1024u;
    const int aoffl = lds_byte(wr * 64 + fr, fq * 8), boffl = lds_byte(wc * 32 + fr, fq * 8);
    unsigned aoff[2][2];
#define G_LOADA(u) do { _Pragma("unroll") for (int _h = 0; _h < 2; ++_h) _Pragma("unroll") for (int _i = 0; _i < 2; ++_i) { int _R, _C; stage_rc(tid * 16 + _i * 8192, _R, _C); const int _r = (u).pm * BM + _h * HALF + _R; \
        const int _s = g.arow ? g.arow[_r] : _r; aoff[_h][_i] = (unsigned)(_s * RB + _C * 2); } } while (0)
#define G_SA(b, h) (((b) * 2 + (h)) * HTB)
#define G_SB(b, h) ((4 + (b) * 2 + (h)) * HTB)
#define G_STAGEB(bufoff, gbase) do { _Pragma("unroll") for (int _i = 0; _i < 2; ++_i) \
        __builtin_amdgcn_global_load_lds((const unsigned*)((const char*)(gbase) + voffB[_i]), (LAS unsigned*)(lds + (bufoff) + ldsw + _i * 8192), 16, 0, 0); } while (0)
#define G_STAGEA(bufoff, kt, h) do { _Pragma("unroll") for (int _i = 0; _i < 2; ++_i) \
        __builtin_amdgcn_global_load_lds((const unsigned*)((const char*)g.A + (size_t)(kt) * kstep + aoff[h][_i]), (LAS unsigned*)(lds + (bufoff) + ldsw + _i * 8192), 16, 0, 0); } while (0)
#define G_LDA(dst, b, h) do { _Pragma("unroll") for (int m = 0; m < 4; ++m) _Pragma("unroll") for (int k = 0; k < 2; ++k) dst[m][k] = *(const LAS bf16x8*)(lds + G_SA(b, h) + aoffl + m * 2048 + k * 1024); } while (0)
#define G_LDB(dst, b, h) do { _Pragma("unroll") for (int n = 0; n < 2; ++n) _Pragma("unroll") for (int k = 0; k < 2; ++k) dst[n][k] = *(const LAS bf16x8*)(lds + G_SB(b, h) + boffl + n * 2048 + k * 1024); } while (0)
#define G_MMA(ai, bj, At, Bt) do { if constexpr (FP8) __builtin_amdgcn_sched_barrier(0); __builtin_amdgcn_s_setprio(1); _Pragma("unroll") for (int m = 0; m < 4; ++m) _Pragma("unroll") for (int n = 0; n < 2; ++n) { \
        if constexpr (FP8) acc[ai][bj][m][n] = __builtin_amdgcn_mfma_scale_f32_16x16x128_f8f6f4(cat8(Bt[n][0], Bt[n][1]), cat8(At[m][0], At[m][1]), acc[ai][bj][m][n], 0, 0, 0, 0x7F7F7F7F, 0, 0x7F7F7F7F); \
        else { _Pragma("unroll") for (int k = 0; k < 2; ++k) acc[ai][bj][m][n] = __builtin_amdgcn_mfma_f32_16x16x32_bf16(Bt[n][k], At[m][k], acc[ai][bj][m][n], 0, 0, 0); } } \
        __builtin_amdgcn_s_setprio(0); if constexpr (FP8) __builtin_amdgcn_sched_barrier(0); } while (0)
#define G_WAIT_V(n) asm volatile("s_waitcnt vmcnt(" #n ")" ::: "memory")
#define G_WAIT_L(n) asm volatile("s_waitcnt lgkmcnt(" #n ")" ::: "memory")
#define G_BAR __builtin_amdgcn_s_barrier()
#define G_SCHED __builtin_amdgcn_sched_barrier(0)
    Unit cur, nxt; int ui = 0;
    if (!S.next(0, cur)) return;
    f32x4 acc[2][2][4][2];
#pragma unroll
    for (int a = 0; a < 2; ++a)
#pragma unroll
        for (int b = 0; b < 2; ++b)
#pragma unroll
            for (int m = 0; m < 4; ++m)
#pragma unroll
                for (int n = 0; n < 2; ++n) acc[a][b][m][n] = (f32x4){0.f, 0.f, 0.f, 0.f};
    bf16x8 At[4][2], B0[2][2], B1[2][2];
    const char* cB = (const char*)g.Bt + (size_t)cur.pnb * tstep;
    G_LOADA(cur);
    G_STAGEB(G_SB(0, 0), cB); G_STAGEA(G_SA(0, 0), 0, 0); G_STAGEB(G_SB(0, 1), cB + hstep); G_STAGEA(G_SA(0, 1), 0, 1);
    if (wr == 1) G_BAR;
    G_WAIT_V(4); G_BAR;
    G_STAGEB(G_SB(1, 0), cB + kstep); G_STAGEA(G_SA(1, 0), 1, 0); G_STAGEB(G_SB(1, 1), cB + hstep + kstep);
    G_WAIT_V(6); G_BAR;
    for (;;) {
        const bool has_next = S.next(ui + 1, nxt);
        const char* nB = has_next ? (const char*)g.Bt + (size_t)nxt.pnb * tstep : cB;
        for (int t = 0; t < nt; t += 2) {
            const bool last = (t == nt - 2);
            const int k2 = last ? 0 : t + 2, k3 = k2 + 1;
            const char* b2 = last ? nB : cB + (size_t)(t + 2) * kstep; const char* b3 = b2 + kstep;
            G_LDB(B0, 0, 0); G_SCHED; G_LDA(At, 0, 0); G_STAGEA(G_SA(1, 1), t + 1, 1);
            if (g.arow && has_next && t == nt - 4 && tid < BM)
                __builtin_amdgcn_global_load_lds((const unsigned*)(g.arow + nxt.pm * BM + tid), (LAS unsigned*)(lds + STAGE_BYTES + wid * 256), 4, 0, 0);
            G_WAIT_L(8); G_BAR; G_WAIT_L(0); G_MMA(0, 0, At, B0); G_BAR; G_SCHED;
            if (last && has_next) {
                if (g.arow) {
#pragma unroll
                    for (int _h = 0; _h < 2; ++_h)
#pragma unroll
                        for (int _i = 0; _i < 2; ++_i) { int _R, _C; stage_rc(tid * 16 + _i * 8192, _R, _C); const int _s = *(LAS const int*)(lds + STAGE_BYTES + (_h * HALF + _R) * 4); aoff[_h][_i] = (unsigned)(_s * RB + _C * 2); }
                } else G_LOADA(nxt);
            }
            G_LDB(B1, 0, 1); G_STAGEB(G_SB(0, 0), b2);
            G_BAR; G_WAIT_L(0); G_MMA(0, 1, At, B1); G_BAR;
            G_LDA(At, 0, 1); G_STAGEA(G_SA(0, 0), k2, 0);
            G_BAR; G_WAIT_L(0); G_MMA(1, 0, At, B0); G_BAR; G_SCHED;
            G_STAGEB(G_SB(0, 1), b2 + hstep);
            G_WAIT_V(6); G_BAR; G_MMA(1, 1, At, B1); G_BAR;
            G_LDB(B0, 1, 0); G_SCHED; G_LDA(At, 1, 0); G_STAGEA(G_SA(0, 1), k2, 1);
            G_WAIT_L(8); G_BAR; G_WAIT_L(0); G_MMA(0, 0, At, B0); G_BAR; G_SCHED;
            G_LDB(B1, 1, 1); G_STAGEB(G_SB(1, 0), b3);
            G_BAR; G_WAIT_L(0); G_MMA(0, 1, At, B1); G_BAR;
            G_LDA(At, 1, 1); G_STAGEA(G_SA(1, 0), k3, 0);
            G_BAR; G_WAIT_L(0); G_MMA(1, 0, At, B0); G_BAR; G_SCHED;
            G_STAGEB(G_SB(1, 1), b3 + hstep);
            G_WAIT_V(6); G_BAR; G_MMA(1, 1, At, B1); G_BAR;
        }
        E(acc, cur, wr, wc, fr, fq);
        if (!has_next) break;
#pragma unroll
        for (int a = 0; a < 2; ++a)
#pragma unroll
            for (int b = 0; b < 2; ++b)
#pragma unroll
                for (int m = 0; m < 4; ++m)
#pragma unroll
                    for (int n = 0; n < 2; ++n) acc[a][b][m][n] = (f32x4){0.f, 0.f, 0.f, 0.f};
        cur = nxt; cB = nB; ++ui;
    }
    G_WAIT_V(0);
    if (wr == 0) G_BAR;
    G_BAR;
}
#else
template <int K, class Epi, class Sched, bool FP8 = false>
__device__ __forceinline__ void gemm_phase(unsigned char* lds, const Gemm g, const Sched& S, const Epi& E, int wv) {
    const int tid = opaque_tid(wv), wid = tid >> 6, lane = tid & 63, wr = wid >> 2, wc = wid & 3, fr = lane & 15, fq = lane >> 4;
    Unit u;
    for (int ui = 0; S.next(ui, u); ++ui) {
        f32x4 acc[2][2][4][2];
        for (int ai = 0; ai < 2; ++ai) for (int bj = 0; bj < 2; ++bj) for (int m = 0; m < 4; ++m) for (int n = 0; n < 2; ++n) for (int j = 0; j < 4; ++j) {
            const int r = u.pm * 256 + 128 * ai + 64 * wr + 16 * m + fr;
            const int cl = Epi::PERM ? (128 * bj + 32 * wc + 8 * fq + 4 * n + j) : (128 * bj + 32 * wc + 16 * n + 4 * fq + j);
            const int ar = g.arow ? g.arow[r] : r;
            float s = 0.f;
            if (FP8) { const unsigned char* a = (const unsigned char*)g.A + (size_t)ar * K; const unsigned char* b = (const unsigned char*)g.Bt + ((size_t)u.pnb * 256 + cl) * K; for (int k = 0; k < K; ++k) s += fp8_to_f(a[k]) * fp8_to_f(b[k]); }
            else { const bf16_t* a = g.A + (size_t)ar * K; const bf16_t* b = g.Bt + ((size_t)u.pnb * 256 + cl) * K; for (int k = 0; k < K; ++k) s += bf2f(a[k]) * bf2f(b[k]); }
            acc[ai][bj][m][n][j] = s;
        }
        E(acc, u, wr, wc, fr, fq);
    }
}
#endif

__device__ __forceinline__ void convert_wt(LAS unsigned char* lds, const float* W, int K, int ldw, int col0, int ncols, bf16_t* Wt, int rowmul, int rowadd, int bid, int nb, int wv) {
    LAS float* t = (LAS float*)lds;
    const int tid = opaque_tid(wv);
    const int tk = K / 64, tn = ncols / 64, ntile = tk * tn;
    const int lr = tid >> 4, c4 = (tid & 15) * 4;
    f32x4 v[2];
    if (bid < ntile) { const int k0 = (bid % tk) * 64, n0 = (bid / tk) * 64;
#pragma unroll
        for (int i = 0; i < 2; ++i) v[i] = *(const f32x4*)(W + (size_t)(k0 + lr + 32 * i) * ldw + col0 + n0 + c4); }
    for (int tile = bid; tile < ntile; tile += nb) {
        const int k0 = (tile % tk) * 64, n0 = (tile / tk) * 64;
        __syncthreads();
#pragma unroll
        for (int i = 0; i < 2; ++i) { const int r = lr + 32 * i; t[r * 65 + c4] = v[i][0]; t[r * 65 + c4 + 1] = v[i][1]; t[r * 65 + c4 + 2] = v[i][2]; t[r * 65 + c4 + 3] = v[i][3]; }
        const int nt2 = tile + nb;
        if (nt2 < ntile) { const int k1 = (nt2 % tk) * 64, n1 = (nt2 / tk) * 64;
#pragma unroll
            for (int i = 0; i < 2; ++i) v[i] = *(const f32x4*)(W + (size_t)(k1 + lr + 32 * i) * ldw + col0 + n1 + c4); }
        __syncthreads();
        { const int c = tid >> 3, k8 = (tid & 7) * 8; const int cc = n0 + c; const int dr = (cc >> 7) * rowmul + (cc & 127) + rowadd;
          u32x4 w; w.x = pack2(t[(k8 + 0) * 65 + c], t[(k8 + 1) * 65 + c]); w.y = pack2(t[(k8 + 2) * 65 + c], t[(k8 + 3) * 65 + c]);
          w.z = pack2(t[(k8 + 4) * 65 + c], t[(k8 + 5) * 65 + c]); w.w = pack2(t[(k8 + 6) * 65 + c], t[(k8 + 7) * 65 + c]);
          *(u32x4*)(Wt + (size_t)dr * K + k0 + k8) = w; }
    }
    __syncthreads();
}

__device__ __forceinline__ void load_row(const float* src, int row, int lane, f32x4 (&v)[4]) {
#pragma unroll
    for (int i = 0; i < 4; ++i) v[i] = *(const f32x4*)(src + (size_t)row * DM + i * 256 + lane * 4);
}
__device__ __forceinline__ void load_row_b(const bf16_t* src, int row, int lane, f32x4 (&v)[4]) {
#pragma unroll
    for (int i = 0; i < 4; ++i) { const u32x2 w = *(const u32x2*)(src + (size_t)row * DM + i * 256 + lane * 4);
        v[i][0] = __uint_as_float(w.x << 16); v[i][1] = __uint_as_float(w.x & 0xffff0000u); v[i][2] = __uint_as_float(w.y << 16); v[i][3] = __uint_as_float(w.y & 0xffff0000u); }
}
__device__ __forceinline__ float row_rstd(const f32x4 (&v)[4]) {
    float s = 0.f;
#pragma unroll
    for (int i = 0; i < 4; ++i) s += v[i][0] * v[i][0] + v[i][1] * v[i][1] + v[i][2] * v[i][2] + v[i][3] * v[i][3];
    s = wave_sum(s);
    return rsqrtf(s * (1.0f / DM) + NORM_EPS);
}
__device__ __forceinline__ void store_row_bf16(bf16_t* dst, int row, int lane, const f32x4 (&v)[4]) {
#pragma unroll
    for (int i = 0; i < 4; ++i) { u32x2 w; w.x = pack2(v[i][0], v[i][1]); w.y = pack2(v[i][2], v[i][3]); *(u32x2*)(dst + (size_t)row * DM + i * 256 + lane * 4) = w; }
}

__device__ __forceinline__ void store_row_fp8(unsigned char* dst, float* scale, int row, int lane, const f32x4 (&v)[4]) {
    float am = 0.f;
#pragma unroll
    for (int i = 0; i < 4; ++i) am = fmaxf(fmaxf(am, fmaxf(fabsf(v[i][0]), fabsf(v[i][1]))), fmaxf(fabsf(v[i][2]), fabsf(v[i][3])));
    am = wave_max(am);
    const float sc = am > 0.f ? am * (1.0f / FP8_TOP) : 1.0f, inv = 1.0f / sc;
#pragma unroll
    for (int i = 0; i < 4; ++i) *(unsigned*)(dst + (size_t)row * DM + i * 256 + lane * 4) = pack4_fp8(v[i][0] * inv, v[i][1] * inv, v[i][2] * inv, v[i][3] * inv);
    if (lane == 0) scale[row] = sc;
}
template <int K, bool NORMS>
__device__ __forceinline__ void quant_rows(KPTR p, LAS unsigned char* lds, const bf16_t* src, unsigned char* dst, float* scl, int nrows, int bid, int nb, int wv) {
    constexpr int NC = K / 512;
    const int tid = opaque_tid(wv), wid = tid >> 6, lane = tid & 63;
    LAS unsigned* nmx = (LAS unsigned*)lds;
    if (NORMS) { if (tid < 2 * NE) nmx[tid] = 0u; __syncthreads(); }
    int row = bid * 8 + wid;
    u32x4 nx[NC];
#pragma unroll
    for (int c = 0; c < NC; ++c) nx[c] = (u32x4){0u, 0u, 0u, 0u};
    if (row < nrows) {
#pragma unroll
        for (int c = 0; c < NC; ++c) nx[c] = *(const u32x4*)(src + (size_t)row * K + (c * 64 + lane) * 8); }
    for (; row < nrows; row += nb * 8) {
        u32x4 cu[NC];
#pragma unroll
        for (int c = 0; c < NC; ++c) cu[c] = nx[c];
        const int rn = row + nb * 8;
        if (rn < nrows) {
#pragma unroll
            for (int c = 0; c < NC; ++c) nx[c] = *(const u32x4*)(src + (size_t)rn * K + (c * 64 + lane) * 8); }
        float am = 0.f, ss = 0.f;
#pragma unroll
        for (int c = 0; c < NC; ++c)
#pragma unroll
            for (int q = 0; q < 4; ++q) { const float lo = __uint_as_float(cu[c][q] << 16), hi = __uint_as_float(cu[c][q] & 0xffff0000u); am = fmaxf(am, fmaxf(fabsf(lo), fabsf(hi))); if (NORMS) ss += lo * lo + hi * hi; }
        am = wave_max(am);
        const float sc = am > 0.f ? am * (1.0f / FP8_TOP) : 1.0f, inv = 1.0f / sc;
#pragma unroll
        for (int c = 0; c < NC; ++c) { u32x2 w;
            w.x = pack4_fp8(__uint_as_float(cu[c][0] << 16) * inv, __uint_as_float(cu[c][0] & 0xffff0000u) * inv, __uint_as_float(cu[c][1] << 16) * inv, __uint_as_float(cu[c][1] & 0xffff0000u) * inv);
            w.y = pack4_fp8(__uint_as_float(cu[c][2] << 16) * inv, __uint_as_float(cu[c][2] & 0xffff0000u) * inv, __uint_as_float(cu[c][3] << 16) * inv, __uint_as_float(cu[c][3] & 0xffff0000u) * inv);
            *(u32x2*)(dst + (size_t)row * K + (c * 64 + lane) * 8) = w; }
        if (lane == 0) scl[row] = sc;
        if (NORMS) { ss = wave_sum(ss); if (lane == 0) LDS_ATOMIC_MAX(nmx + ((row >> 7) & 1) * NE + row / (2 * FFE), __float_as_uint(sqrtf(ss))); }
    }
    if (NORMS) { __syncthreads(); if (tid < 2 * NE) (void)GLOBAL_ATOMIC_MAX(p->ctrl + (tid < NE ? C_GMAX + tid : C_UMAX + tid - NE), nmx[tid]); __syncthreads(); }
}
__device__ __forceinline__ const float* gu_src(KPTR p, int item, int t, int kr, int c4) {
    constexpr int NPAN = FFE / 32;
    const int e = item / (2 * NPAN), r = item % (2 * NPAN), up = r / NPAN, pn = r % NPAN;
    return (up ? p->w_mup : p->w_mgate) + (size_t)e * DM * FFE + (size_t)(t * 64 + kr) * FFE + pn * 32 + c4;
}
__device__ __forceinline__ void convert_gu_fp8(KPTR p, LAS unsigned char* lds, int bid, int nb, int wv) {
    constexpr int PSF = 1028, NPAN = FFE / 32, NITEM = NE * 2 * NPAN, TPI = DM / 64;
    const int tid = opaque_tid(wv), wid = tid >> 6, lane = tid & 63;
    LAS float* pan = (LAS float*)lds;
    LAS float* red = pan + 32 * PSF;
    LAS float* scl = red + 8 * 32 * 2;
    const int c4 = (tid & 7) * 4, kr = tid >> 3;
    const int nmine = bid < NITEM ? (NITEM - bid + nb - 1) / nb : 0, total = nmine * TPI;
    if (nmine == 0) return;
    constexpr int PD = 8;
    static_assert(TPI % PD == 0, "ring");
    f32x4 pf[PD];
#pragma unroll
    for (int i = 0; i < PD; ++i) { const int gi = i < total ? i : total - 1; pf[i] = *(const f32x4*)gu_src(p, bid + (gi / TPI) * nb, gi % TPI, kr, c4); }
    int g = 0;
    for (int it = 0; it < nmine; ++it) {
        const int item = bid + it * nb, e = item / (2 * NPAN), r = item % (2 * NPAN), up = r / NPAN, pn = r % NPAN;
        float am[4] = {0.f, 0.f, 0.f, 0.f}, ss[4] = {0.f, 0.f, 0.f, 0.f};
        for (int t0 = 0; t0 < TPI; t0 += PD) {
#pragma unroll
            for (int u = 0; u < PD; ++u, ++g) { const int t = t0 + u;
                const f32x4 v = pf[u];
                { int gn = g + PD; gn = gn < total ? gn : total - 1; int kr2 = kr; OPAQUE_V(kr2); pf[u] = *(const f32x4*)gu_src(p, bid + (gn / TPI) * nb, gn % TPI, kr2, c4); }
#pragma unroll
                for (int j = 0; j < 4; ++j) { am[j] = fmaxf(am[j], fabsf(v[j])); ss[j] += v[j] * v[j]; pan[(c4 + j) * PSF + t * 64 + kr] = v[j]; }
            }
        }
#pragma unroll
        for (int j = 0; j < 4; ++j) {
#pragma unroll
            for (int o = 8; o <= 32; o <<= 1) { am[j] = fmaxf(am[j], __shfl_xor(am[j], o)); ss[j] += __shfl_xor(ss[j], o); }
        }
        if ((lane >> 3) == 0) {
#pragma unroll
            for (int j = 0; j < 4; ++j) { red[(wid * 32 + c4 + j) * 2] = am[j]; red[(wid * 32 + c4 + j) * 2 + 1] = ss[j]; } }
        __syncthreads();
        if (tid < 64) { float a = 0.f, q = 0.f;
            if (tid < 32) {
#pragma unroll
                for (int w = 0; w < 8; ++w) { a = fmaxf(a, red[(w * 32 + tid) * 2]); q += red[(w * 32 + tid) * 2 + 1]; }
                const float sc = a > 0.f ? a * (1.0f / FP8_TOP) : 1.0f; scl[tid] = sc; scl[32 + tid] = 1.0f / sc;
                const int cc = pn * 32 + tid; p->ws_mgu[(size_t)e * 2 * FFE + (cc >> 7) * 256 + (cc & 127) + up * 128] = sc; }
            const float nm = wave_max(tid < 32 ? sqrtf(q) : 0.f);
            if (tid == 0) (void)GLOBAL_ATOMIC_MAX(p->ctrl + (up ? C_UMAX : C_GMAX) + e, __float_as_uint(nm)); }
        __syncthreads();
#pragma unroll
        for (int i2 = 0; i2 < 8; ++i2) { const int n = i2 * 4 + (tid >> 7), k8 = (tid & 127) * 8, cc = pn * 32 + n;
            const f32x4 a = *(LAS const f32x4*)(pan + n * PSF + k8), b = *(LAS const f32x4*)(pan + n * PSF + k8 + 4); const float inv = scl[32 + n];
            u32x2 w; w.x = pack4_fp8(a[0] * inv, a[1] * inv, a[2] * inv, a[3] * inv); w.y = pack4_fp8(b[0] * inv, b[1] * inv, b[2] * inv, b[3] * inv);
            *(u32x2*)(p->w8_mgu + ((size_t)e * 2 * FFE + (cc >> 7) * 256 + (cc & 127) + up * 128) * DM + k8) = w; }
        __syncthreads();
    }
}
template <bool WITH_GDN, bool OUT8 = false, bool SRCB = false>
__device__ __forceinline__ void phase_norm(KPTR p, const void* src, const float* gain, int bid, int nb, int wv) {
    const int tid = opaque_tid(wv), wid = tid >> 6, lane = tid & 63;
    f32x4 gv[4];
#pragma unroll
    for (int i = 0; i < 4; ++i) gv[i] = *(const f32x4*)(gain + i * 256 + lane * 4);
    f32x4 w8[WITH_GDN ? 16 : 1][2];
    if (WITH_GDN) {
#pragma unroll
        for (int i = 0; i < 4; ++i)
#pragma unroll
            for (int e = 0; e < 4; ++e) { const float* wr_ = p->w_in + (size_t)(i * 256 + lane * 4 + e) * DIN + DINP; w8[i * 4 + e][0] = *(const f32x4*)wr_; w8[i * 4 + e][1] = *(const f32x4*)(wr_ + 4); }
    }
    for (int row = bid * 8 + wid; row < NTOK; row += nb * 8) {
        f32x4 v[4]; if (SRCB) load_row_b((const bf16_t*)src, row, lane, v); else load_row((const float*)src, row, lane, v);
        const float rs = row_rstd(v);
#pragma unroll
        for (int i = 0; i < 4; ++i) v[i] = v[i] * rs * gv[i];
        if (OUT8) store_row_fp8((unsigned char*)p->hn, p->hns, row, lane, v); else store_row_bf16(p->hn, row, lane, v);
        if (WITH_GDN) {
            f32x4 d0 = (f32x4){0.f, 0.f, 0.f, 0.f}, d1 = (f32x4){0.f, 0.f, 0.f, 0.f};
#pragma unroll
            for (int i = 0; i < 4; ++i)
#pragma unroll
                for (int e = 0; e < 4; ++e) { const float xv = v[i][e]; d0 = d0 + w8[i * 4 + e][0] * xv; d1 = d1 + w8[i * 4 + e][1] * xv; }
            float d[8] = {d0[0], d0[1], d0[2], d0[3], d1[0], d1[1], d1[2], d1[3]};
#pragma unroll
            for (int j = 0; j < 8; ++j) d[j] = wave_sum(d[j]);
            if (lane < 4) {
                const float braw = lane == 0 ? d[0] : lane == 1 ? d[1] : lane == 2 ? d[2] : d[3];
                const float araw = lane == 0 ? d[4] : lane == 1 ? d[5] : lane == 2 ? d[6] : d[7];
                p->gbeta[(size_t)row * 4 + lane] = 1.0f / (1.0f + __expf(-braw));
                const float z = araw + p->dt_bias[lane];
                const float sp = z > 20.f ? z : log1pf(__expf(z));
                p->gg[(size_t)row * 4 + lane] = -__expf(p->a_log[lane]) * sp;
            }
        }
    }
}

constexpr int IMG_W = 0, IMG_QD = 17408, IMG_KDT = 34816, IMG_AT = 53248, IMG_U = 62464, IMG_CH = 78848;
__host__ __device__ constexpr int permb(int k) { return (k >> 5) * 64 + ((((k & 15) >> 2) * 8) + (((k >> 4) & 1) * 4) + (k & 3)) * 2; }
__device__ __forceinline__ bf16x8 frag2(LAS const unsigned char* ptr) {
    const u32x2 lo = *(LAS const u32x2*)ptr, hi = *(LAS const u32x2*)(ptr + 32);
    u32x4 w; w.x = lo.x; w.y = lo.y; w.z = hi.x; w.w = hi.y; bf16x8 r; __builtin_memcpy(&r, &w, 16); return r;
}
__device__ __forceinline__ bf16x8 pack8(const f32x4 a, const f32x4 b) {
    u32x4 w; w.x = pack2(a[0], a[1]); w.y = pack2(a[2], a[3]); w.z = pack2(b[0], b[1]); w.w = pack2(b[2], b[3]); bf16x8 r; __builtin_memcpy(&r, &w, 16); return r;
}


#ifndef CPU_EMU
__device__ __forceinline__ void st_wt32(void* p, unsigned v) { __hip_atomic_store((unsigned*)p, v, __ATOMIC_RELAXED, __HIP_MEMORY_SCOPE_AGENT); }
__device__ __forceinline__ void st_wt64(void* p, u32x2 v) { unsigned long long x = ((unsigned long long)v.y << 32) | v.x; __hip_atomic_store((unsigned long long*)p, x, __ATOMIC_RELAXED, __HIP_MEMORY_SCOPE_AGENT); }
#else
static inline void st_wt32(void* p, unsigned v) { *(unsigned*)p = v; }
static inline void st_wt64(void* p, u32x2 v) { *(u32x2*)p = v; }
#endif

#ifndef CPU_EMU
__device__ __forceinline__ void gdn_publish(unsigned* flag, int tid) {
    asm volatile("s_waitcnt vmcnt(0)" ::: "memory");
    __syncthreads();
    if (tid == 0) __hip_atomic_store(flag, 1u, __ATOMIC_RELAXED, __HIP_MEMORY_SCOPE_AGENT);
}
__device__ __forceinline__ void gdn_wait8(const unsigned* flags, int c, int nmax, int lane) {
    const int k = c + (lane & 7); const bool need = k < nmax;
    unsigned spins = 0;
    for (;;) {
        const unsigned v = need ? __hip_atomic_load(flags + k, __ATOMIC_RELAXED, __HIP_MEMORY_SCOPE_AGENT) : 1u;
        if (__all(v != 0u)) break;
        __builtin_amdgcn_s_sleep(4); if (++spins > (1u << 22)) break;
    }
    __builtin_amdgcn_fence(__ATOMIC_ACQUIRE, "agent");
}
__device__ __forceinline__ float ld_coherent(const float* p) { return __uint_as_float(__hip_atomic_load((const unsigned*)p, __ATOMIC_RELAXED, __HIP_MEMORY_SCOPE_AGENT)); }
#else
static inline void gdn_publish(unsigned* flag, int tid) { __syncthreads(); if (tid == 0) __atomic_store_n(flag, 1u, __ATOMIC_SEQ_CST); }
static inline void gdn_wait8(const unsigned* flags, int c, int nmax, int lane) { for (int k = c; k < c + 8 && k < nmax; ++k) while (__atomic_load_n(flags + k, __ATOMIC_SEQ_CST) == 0) emu::yield(); }
static inline float ld_coherent(const float* p) { return *p; }
#endif

template <int I> struct TSolve {
    static __device__ __forceinline__ void run(float (&tc)[64], LAS const float* sL, LAS unsigned char* tb, int lane) {
        TSolve<I - 1>::run(tc, sL, tb, lane);
        float p0 = 0.f, p1 = 0.f, p2 = 0.f, p3 = 0.f;
#pragma unroll
        for (int j = 0; j < I; ++j) { const float pr = sL[I * 68 + j] * tc[j]; if ((j & 3) == 0) p0 += pr; else if ((j & 3) == 1) p1 += pr; else if ((j & 3) == 2) p2 += pr; else p3 += pr; }
        const float t2 = ((I == lane) ? 1.f : 0.f) - ((p0 + p1) + (p2 + p3));
        tc[I] = t2; *(LAS bf16_t*)(tb + I * 144 + 2 * lane) = f2bf(t2);
    }
};
template <> struct TSolve<-1> { static __device__ __forceinline__ void run(float (&)[64], LAS const float*, LAS unsigned char*, int) {} };

template <bool PUBLISH>
__device__ __forceinline__ void phase_gdn_pre(KPTR p, LAS unsigned char* lds, int first, int stride, int wv) {
    constexpr int QB = 0, KB = 17408, VBT = 34816, KBT = 53248, KDT = 71680, LF = 90112, TB = 107520, ATB = 116736, SG = 125952, SBE = 126208;
    const int tid0 = opaque_tid(wv);
    LAS float* sL = (LAS float*)(lds + LF); LAS float* sg = (LAS float*)(lds + SG); LAS float* sb = (LAS float*)(lds + SBE);
    const bf16_t* proj = p->proj; const float* conv_w = p->conv_w; const float* gg = p->gg; const float* gbeta = p->gbeta; unsigned char* gimg = p->gimg; float* gcdec = p->gcdec;
    for (int uu = first; uu < NCHH; uu += stride) {
        int tid = tid0; OPAQUE_V(tid);
        const int wid = tid >> 6, lane = tid & 63, fr = lane & 15, q4 = lane >> 4;
        const int n = uu / (BATCH * 4), bh_ = uu % (BATCH * 4), h = bh_ & 3, b = bh_ >> 2;
        const int unit = bh_ * NCH + n;
        const size_t tok0 = (size_t)b * SEQ + (size_t)n * 64;
        unsigned char* img = gimg + (size_t)unit * IMG_CH;
        __syncthreads();
        if (wid == 0) { float gsum = gg[(tok0 + lane) * 4 + h]; for (int o = 1; o < 64; o <<= 1) { const float t2 = __shfl_up(gsum, o); if (lane >= o) gsum += t2; } sg[lane] = gsum; sb[lane] = gbeta[(tok0 + lane) * 4 + h]; }
        __syncthreads();
        const float glast = sg[63];
        unsigned xall[3][11];
#pragma unroll
        for (int w3 = 0; w3 < 3; ++w3) { const int cc = w3 * 512 + h * 128 + 2 * lane;
#pragma unroll
            for (int r = 0; r < 11; ++r) { const int tt = n * 64 + wid * 8 - 3 + r; xall[w3][r] = tt >= 0 ? *(const unsigned*)(proj + ((size_t)b * SEQ + tt) * DINP + 2048 + cc) : 0u; } }
#pragma unroll
        for (int which = 0; which < 3; ++which) {
            const int rb = wid, c0 = which * 512 + h * 128 + 2 * lane;
            float cw0[4], cw1[4];
#pragma unroll
            for (int kk = 0; kk < 4; ++kk) { cw0[kk] = conv_w[kk * 1536 + c0]; cw1[kk] = conv_w[kk * 1536 + c0 + 1]; }
            unsigned xv[11];
#pragma unroll
            for (int r = 0; r < 11; ++r) xv[r] = xall[which][r];
            float a0[8], a1[8], ss[8];
#pragma unroll
            for (int i8 = 0; i8 < 8; ++i8) { float y0 = 0.f, y1 = 0.f;
#pragma unroll
                for (int kk = 0; kk < 4; ++kk) { y0 += cw0[kk] * __uint_as_float(xv[i8 + kk] << 16); y1 += cw1[kk] * __uint_as_float(xv[i8 + kk] & 0xffff0000u); }
                a0[i8] = siluf(y0); a1[i8] = siluf(y1); ss[i8] = a0[i8] * a0[i8] + a1[i8] * a1[i8]; }
            if (which != 2) {
#pragma unroll
                for (int i8 = 0; i8 < 8; ++i8) ss[i8] = wave_sum(ss[i8]);
            }
#pragma unroll
            for (int i8 = 0; i8 < 8; ++i8) {
                const int i = rb * 8 + i8;
                const float gi = sg[i], bi = sb[i], eg = __expf(gi);
                if (which == 2) {
                    *(LAS bf16_t*)(lds + VBT + (2 * lane) * 144 + 2 * i) = f2bf(a0[i8] * bi); *(LAS bf16_t*)(lds + VBT + (2 * lane + 1) * 144 + 2 * i) = f2bf(a1[i8] * bi);
                } else {
                    const float sc = rsqrtf(ss[i8] + NORM_EPS) * (which == 0 ? 0.08838834764831845f : 1.0f);
                    const float n0 = a0[i8] * sc, n1 = a1[i8] * sc;
                    if (which == 0) { *(LAS unsigned*)(lds + QB + i * 272 + 4 * lane) = pack2(n0, n1); st_wt32(img + IMG_QD + i * 272 + permb(2 * lane), pack2(n0 * eg, n1 * eg)); }
                    else { *(LAS unsigned*)(lds + KB + i * 272 + 4 * lane) = pack2(n0, n1);
                        const float f1 = bi * eg, f2 = __expf(glast - gi);
                        *(LAS bf16_t*)(lds + KBT + (2 * lane) * 144 + 2 * i) = f2bf(n0 * f1); *(LAS bf16_t*)(lds + KBT + (2 * lane + 1) * 144 + 2 * i) = f2bf(n1 * f1);
                        *(LAS bf16_t*)(lds + KDT + (2 * lane) * 144 + permb(i)) = f2bf(n0 * f2); *(LAS bf16_t*)(lds + KDT + (2 * lane + 1) * 144 + permb(i)) = f2bf(n1 * f2); }
                }
            }
        }
        __syncthreads();
        {
            const int mat = wid >> 2, itile = wid & 3;
            LAS const unsigned char* abase = lds + (mat == 0 ? KB : QB) + (16 * itile + fr) * 272 + 16 * q4;
            bf16x8 af[4];
#pragma unroll
            for (int s4 = 0; s4 < 4; ++s4) af[s4] = *(LAS const bf16x8*)(abase + 64 * s4);
#pragma unroll
            for (int nt = 0; nt < 4; ++nt) {
                f32x4 acc = (f32x4){0.f, 0.f, 0.f, 0.f};
                if (nt <= itile) {
#pragma unroll
                    for (int s4 = 0; s4 < 4; ++s4) { const bf16x8 bfr = *(LAS const bf16x8*)(lds + KB + (16 * nt + fr) * 272 + 16 * q4 + 64 * s4);
                        acc = __builtin_amdgcn_mfma_f32_16x16x32_bf16(af[s4], bfr, acc, 0, 0, 0); }
                }
                const int j = 16 * nt + fr; const float gj = sg[j];
#pragma unroll
                for (int r = 0; r < 4; ++r) { const int i = 16 * itile + 4 * q4 + r; const float dec = __expf(sg[i] - gj);
                    if (mat == 0) sL[i * 68 + j] = i > j ? sb[i] * acc[r] * dec : 0.f;
                    else *(LAS bf16_t*)(lds + ATB + i * 144 + permb(j)) = f2bf(i >= j ? acc[r] * dec : 0.f); }
            }
        }
        __syncthreads();
        if (wid == 0) {
            float tc[64];
            TSolve<63>::run(tc, sL, lds + TB, lane);
        } else {
            for (int pc = tid - 64; pc < 1152 + 576; pc += NTHREADS - 64) {
                if (pc < 1152) { const u32x4 v4 = *(LAS const u32x4*)(lds + KDT + pc * 16); u32x2 a; a.x = v4.x; a.y = v4.y; u32x2 c; c.x = v4.z; c.y = v4.w; st_wt64(img + IMG_KDT + pc * 16, a); st_wt64(img + IMG_KDT + pc * 16 + 8, c); }
                else { const u32x4 v4 = *(LAS const u32x4*)(lds + ATB + (pc - 1152) * 16); u32x2 a; a.x = v4.x; a.y = v4.y; u32x2 c; c.x = v4.z; c.y = v4.w; st_wt64(img + IMG_AT + (pc - 1152) * 16, a); st_wt64(img + IMG_AT + (pc - 1152) * 16 + 8, c); }
            }
        }
        __syncthreads();
        {
            const int itile = wid & 3;
            bf16x8 tf[2];
#pragma unroll
            for (int s2 = 0; s2 < 2; ++s2) tf[s2] = *(LAS const bf16x8*)(lds + TB + (16 * itile + fr) * 144 + 16 * q4 + 64 * s2);
#pragma unroll
            for (int nt = 0; nt < 8; ++nt) {
                f32x4 acc = (f32x4){0.f, 0.f, 0.f, 0.f};
                if (wid < 4) {
#pragma unroll
                    for (int s2 = 0; s2 < 2; ++s2) { const bf16x8 bfr = *(LAS const bf16x8*)(lds + VBT + (16 * nt + fr) * 144 + 16 * q4 + 64 * s2);
                        acc = __builtin_amdgcn_mfma_f32_16x16x32_bf16(tf[s2], bfr, acc, 0, 0, 0); }
                    u32x2 w; w.x = pack2(acc[0], acc[1]); w.y = pack2(acc[2], acc[3]);
                    st_wt64(img + IMG_U + ((nt * 4 + itile) * 64 + lane) * 8, w);
                } else {
#pragma unroll
                    for (int s2 = 0; s2 < 2; ++s2) { const bf16x8 afr = *(LAS const bf16x8*)(lds + KBT + (16 * nt + fr) * 144 + 16 * q4 + 64 * s2);
                        acc = __builtin_amdgcn_mfma_f32_16x16x32_bf16(afr, tf[s2], acc, 0, 0, 0); }
                    u32x2 w; w.x = pack2(acc[0], acc[1]); w.y = pack2(acc[2], acc[3]);
                    st_wt64(img + IMG_W + (16 * itile + fr) * 272 + permb(16 * nt + 4 * q4), w);
                }
            }
        }
        if (tid == 0) st_wt32(gcdec + unit, __float_as_uint(__expf(glast)));
        if (PUBLISH) gdn_publish(p->gflag + unit, tid);
    }
}

constexpr int NCW = 2, NLT = NTHREADS - 64 * NCW;
constexpr int STG = 62464 + NCW * 2048;
#define LDF(ptr) (*(LAS const bf16x8*)(ptr))
#define MF16(a, b, c) __builtin_amdgcn_mfma_f32_16x16x32_bf16((a), (b), (c), 0, 0, 0)
__device__ __forceinline__ void scan_store_ot(bf16_t* op, const f32x4 (&ao)[4]) {
#pragma unroll
    for (int it = 0; it < 4; ++it) { u32x2 w; w.x = pack2(ao[it][0], ao[it][1]); w.y = pack2(ao[it][2], ao[it][3]); *(u32x2*)(op + (size_t)(16 * it) * DM) = w; }
}
__device__ __forceinline__ void scan_store_o(bf16_t* op, const f32x4 (&ao)[4], int q4) {
#pragma unroll
    for (int it = 0; it < 4; ++it)
#pragma unroll
        for (int r = 0; r < 4; ++r) op[(size_t)(16 * it + 4 * q4 + r) * DM] = f2bf(ao[it][r]);
}
__device__ __forceinline__ bf16x8 asfrag(const u32x4 v) { bf16x8 r; __builtin_memcpy(&r, &v, 16); return r; }
#define LDR(ptr) (*(LAS const u32x4*)(ptr))
template <bool WAITF>
__device__ __forceinline__ void scan_gdn(KPTR p, LAS unsigned char* lds, int b, int h, int qt, int wv) {
    const unsigned* gflag = p->gflag + (size_t)(b * 4 + h) * NCH;
    const int tid = opaque_tid(wv), wid = tid >> 6, lane = tid & 63, fr = lane & 15, q4 = lane >> 4;
    const unsigned char* gimg = p->gimg; const float* gcdec = p->gcdec + (size_t)(b * 4 + h) * NCH; bf16_t* out = p->hn;
    const bool loader = wid >= NCW;
    const int cw = wid, lt = tid - 64 * NCW;
    f32x4 S[8];
#pragma unroll
    for (int dt = 0; dt < 8; ++dt) S[dt] = (f32x4){0.f, 0.f, 0.f, 0.f};
    constexpr int NLG = NLT / 2;
    constexpr int NPC = 3904 + NCW * 128, NPR = (NPC + NLG - 1) / NLG;
    static_assert(NPR >= 16, "compute waves use R[0..7] and R[8..15] as their two operand batches");
    u32x4 R[NPR];
    float cdv = 0.f;
    constexpr int OUTB = 2 * STG, CDB = OUTB + 8192;
    const int grp = lt >= NLG ? 1 : 0, lg_ = lt - grp * NLG;
    const unsigned char* base = gimg + (size_t)(b * 4 + h) * NCH * IMG_CH;
#define GDN_PREFETCH(nn) do { int _lg = lg_; OPAQUE_V(_lg); const unsigned char* _src = base + (size_t)(nn) * IMG_CH; _Pragma("unroll") for (int _i = 0; _i < NPR; ++_i) { int _pc = _lg + NLG * _i; _pc = _pc < NPC ? _pc : NPC - 1; \
        const int _so = _pc < 3904 ? _pc * 16 : IMG_U + qt * (NCW * 2048) + (_pc - 3904) * 16; R[_i] = *(const u32x4*)(_src + _so); } cdv = ld_coherent(gcdec + (nn)); } while (0)
    int avail = 0;
    if (loader && grp < NCH) { if (WAITF) { gdn_wait8(gflag, 0, NCH, lane); avail = 8; } GDN_PREFETCH(grp); }
    float cd_next = 0.f;
    __syncthreads();
    auto load_step = [&](int nn) {
        if (nn < NCH && (nn & 1) == grp) {
            LAS unsigned char* buf = lds + (nn & 1) * STG;
#pragma unroll
            for (int i = 0; i < NPR; ++i) { int pc = lg_ + NLG * i; pc = pc < NPC ? pc : NPC - 1; *(LAS u32x4*)(buf + pc * 16) = R[i]; }
            if (lg_ == 0) *(LAS float*)(lds + CDB + (nn & 1) * 8) = cdv;
            if (nn + 2 < NCH) { if (WAITF && nn + 2 >= avail) { gdn_wait8(gflag, avail, NCH, lane); avail += 8; } GDN_PREFETCH(nn + 2); }
        }
    };
    auto flush = [&](int n) {
        for (int pc = lg_; pc < NCW * 256; pc += NLG) { const int cwi = pc >> 8, it = (pc >> 6) & 3, ln = pc & 63;
            const u32x2 w = *(LAS const u32x2*)(lds + OUTB + (n & 1) * 4096 + pc * 8);
            *(u32x2*)(out + ((size_t)b * SEQ + (size_t)n * 64 + 16 * it + (ln & 15)) * DM + 512 + h * 128 + 16 * (NCW * qt + cwi) + 4 * (ln >> 4)) = w; }
    };
    auto compute = [&](int n) {

            LAS const unsigned char* buf = lds + (n & 1) * STG;
            const float cd = *(LAS const float*)(lds + CDB + (n & 1) * 8);
            LAS const unsigned char* pw = buf + IMG_W + fr * 272 + 16 * q4;
            LAS const unsigned char* pq = buf + IMG_QD + fr * 272 + 16 * q4;
            LAS const unsigned char* pk = buf + IMG_KDT + fr * 144 + 16 * q4;
            LAS const unsigned char* pa = buf + IMG_AT + fr * 144 + 16 * q4;
            bf16x8 Sb[4];
#pragma unroll
            for (int s4 = 0; s4 < 4; ++s4) Sb[s4] = pack8(S[2 * s4], S[2 * s4 + 1]);
            f32x4 ao[4], av[4];
            u32x2 uu[4];
#pragma unroll
            for (int it = 0; it < 4; ++it) uu[it] = *(LAS const u32x2*)(buf + IMG_U + ((cw * 4 + it) * 64 + lane) * 8);
            u32x4* RA = R; u32x4* RB = R + 8;
#define GDN_LD_WQ(RR, it_) do { _Pragma("unroll") for (int s4 = 0; s4 < 4; ++s4) { RR[s4] = LDR(pw + (16 * (it_)) * 272 + 64 * s4); RR[4 + s4] = LDR(pq + (16 * (it_)) * 272 + 64 * s4); } } while (0)
#define GDN_LD_K(RR, dh_) do { _Pragma("unroll") for (int d2 = 0; d2 < 4; ++d2) _Pragma("unroll") for (int s2 = 0; s2 < 2; ++s2) RR[d2 * 2 + s2] = LDR(pk + (16 * (4 * (dh_) + d2)) * 144 + 64 * s2); } while (0)
#define GDN_MM_WQ(RR, it_) do { av[it_] = (f32x4){0.f, 0.f, 0.f, 0.f}; ao[it_] = (f32x4){0.f, 0.f, 0.f, 0.f}; \
        _Pragma("unroll") for (int s4 = 0; s4 < 4; ++s4) { av[it_] = MF16(asfrag(RR[s4]), Sb[s4], av[it_]); ao[it_] = MF16(Sb[s4], asfrag(RR[4 + s4]), ao[it_]); } } while (0)
#define GDN_MM_K(RR, dh_) do { _Pragma("unroll") for (int d2 = 0; d2 < 4; ++d2) { S[4 * (dh_) + d2] = S[4 * (dh_) + d2] * cd; \
        _Pragma("unroll") for (int s2 = 0; s2 < 2; ++s2) S[4 * (dh_) + d2] = MF16(asfrag(RR[d2 * 2 + s2]), Vb[s2], S[4 * (dh_) + d2]); } } while (0)
            GDN_LD_WQ(RA, 0); SCHED_FENCE();
            GDN_LD_WQ(RB, 1); SCHED_FENCE(); GDN_MM_WQ(RA, 0); SCHED_FENCE();
            GDN_LD_WQ(RA, 2); SCHED_FENCE(); GDN_MM_WQ(RB, 1); SCHED_FENCE();
            GDN_LD_WQ(RB, 3); SCHED_FENCE(); GDN_MM_WQ(RA, 2); SCHED_FENCE();
            GDN_LD_K(RA, 0); SCHED_FENCE(); GDN_MM_WQ(RB, 3); SCHED_FENCE();
#pragma unroll
            for (int it = 0; it < 4; ++it) {
                av[it][0] = __uint_as_float(uu[it].x << 16) - av[it][0]; av[it][1] = __uint_as_float(uu[it].x & 0xffff0000u) - av[it][1];
                av[it][2] = __uint_as_float(uu[it].y << 16) - av[it][2]; av[it][3] = __uint_as_float(uu[it].y & 0xffff0000u) - av[it][3]; }
            bf16x8 Vb[2];
#pragma unroll
            for (int s2 = 0; s2 < 2; ++s2) Vb[s2] = pack8(av[2 * s2], av[2 * s2 + 1]);
            GDN_LD_K(RB, 1); SCHED_FENCE(); GDN_MM_K(RA, 0); SCHED_FENCE();
#pragma unroll
            for (int it = 0; it < 4; ++it)
#pragma unroll
                for (int s2 = 0; s2 < 2; ++s2) R[it * 2 + s2] = LDR(pa + (16 * it) * 144 + 64 * s2);
            SCHED_FENCE(); GDN_MM_K(RB, 1); SCHED_FENCE();
#pragma unroll
            for (int it = 0; it < 4; ++it)
#pragma unroll
                for (int s2 = 0; s2 < 2; ++s2) ao[it] = MF16(Vb[s2], asfrag(R[it * 2 + s2]), ao[it]);
#undef GDN_LD_WQ
#undef GDN_LD_K
#undef GDN_MM_WQ
#undef GDN_MM_K
#pragma unroll
            for (int it = 0; it < 4; ++it) { u32x2 w; w.x = pack2(ao[it][0], ao[it][1]); w.y = pack2(ao[it][2], ao[it][3]); *(LAS u32x2*)(lds + OUTB + (n & 1) * 4096 + ((cw * 4 + it) * 64 + lane) * 8) = w; }
            };
    for (int n = -1; n < NCH; ++n) {
        if (loader) { load_step(n + 1); if (n >= 1 && (n & 1) == grp) flush(n - 1); } else if (n >= 0) compute(n);
        __syncthreads();
    }
    if (loader && grp == 0) flush(NCH - 1);
#undef GDN_PREFETCH
}
#ifndef CG_FORCE
#define CG_FORCE 0
#endif
constexpr int CG = CG_FORCE ? CG_FORCE : (NCH >= 256 ? 8 : 4), NG = NCH / CG;
template <int MODE>
__device__ __forceinline__ void scan_ret(KPTR p, LAS unsigned char* lds, int b, int h, int qt, int g, int wv) {
    const int n0 = g * CG;
    constexpr int R_Q = 0, R_K = 17408, R_KDT = 34816, R_VT = 53248;
    constexpr int RAT_OFF = 2 * STG;
    const int tid = opaque_tid(wv), wid = tid >> 6, lane = tid & 63, fr = lane & 15, q4 = lane >> 4;
    const bf16_t* proj = p->proj; bf16_t* out = p->hn; float* Lb = p->retL;
    const bool loader = wid >= NCW;
    const int cw = wid, lt = tid - 64 * NCW;
    const float lg = log1pf(-exp2f(-5.0f - (float)h));
    f32x4 S[8];
#pragma unroll
    for (int dt = 0; dt < 8; ++dt) S[dt] = (f32x4){0.f, 0.f, 0.f, 0.f};
    const float rcd = __expf(lg * 64.f), g1 = __expf(lg);
    if (MODE == 1 && !loader) {
        const float gdec = __expf(lg * (float)(64 * CG)); float wgt = 1.f;
        for (int gp = g - 1; gp >= 0; --gp) {
            const f32x4* lp = (const f32x4*)Lb + ((((size_t)(b * 4 + h) * NG + gp) * (8 / NCW) + qt) * NCW + cw) * 8 * 64 + lane;
#pragma unroll
            for (int dt = 0; dt < 8; ++dt) S[dt] = S[dt] + lp[dt * 64] * wgt;
            wgt *= gdec;
        }
    }
    float gi[4];
#pragma unroll
    for (int t4 = 0; t4 < 4; ++t4) gi[t4] = __expf(lg * (float)(16 * t4 + fr));
    constexpr int NLG = NLT / 2, NQG = (1024 + NLG - 1) / NLG, KB_N = 256 - NLG;
    static_assert(NLG >= 128 && NLG <= 256 && KB_N + 32 * NCW <= NLG, "task slots");
    u32x4 R[NQG + 8 < 16 ? 16 : NQG + 8];
    const int grp = lt >= NLG ? 1 : 0, lg_ = lt - grp * NLG;
#define RET_PREFETCH(nn) do { int _l = lg_; OPAQUE_V(_l); const bf16_t* _pq = proj + ((size_t)b * SEQ + (size_t)(n0 + (nn)) * 64) * DINP + h * 128; \
        _Pragma("unroll") for (int _i = 0; _i < NQG; ++_i) { int _pc = _l + NLG * _i; _pc = _pc < 1024 ? _pc : 1023; const int _row = _pc >> 4, _c = _pc & 15; R[_i] = *(const u32x4*)(_pq + (size_t)_row * DINP + _c * 8); } \
        _Pragma("unroll") for (int _r = 0; _r < 4; ++_r) R[NQG + _r] = *(const u32x4*)(_pq + (size_t)(4 * (_l >> 4) + _r) * DINP + 512 + (_l & 15) * 8); \
        { const bool _isk = _l < KB_N; int _v = _l - KB_N; _v = _v < 0 ? 0 : (_v < 32 * NCW ? _v : 32 * NCW - 1); const int _t = NLG + (_isk ? _l : 0); \
          const int _r0 = _isk ? 4 * (_t >> 4) : 4 * (_v >> 2), _co = _isk ? 512 + (_t & 15) * 8 : 1024 + 16 * NCW * qt + (_v & 3) * 8; \
          _Pragma("unroll") for (int _r = 0; _r < 4; ++_r) R[NQG + 4 + _r] = *(const u32x4*)(_pq + (size_t)(_r0 + _r) * DINP + _co); } } while (0)
#define RET_WRITE_K(RB_, t_) do { const int ig = (t_) >> 4, ck = (t_) & 15; float sc[4]; \
        _Pragma("unroll") for (int r = 0; r < 4; ++r) { sc[r] = 0.08838834764831845f * __expf(lg * (float)(63 - 4 * ig - r)); \
            u32x2 a; a.x = R[(RB_) + r].x; a.y = R[(RB_) + r].y; u32x2 c2; c2.x = R[(RB_) + r].z; c2.y = R[(RB_) + r].w; \
            *(LAS u32x2*)(buf + R_K + (4 * ig + r) * 272 + permb(8 * ck)) = a; *(LAS u32x2*)(buf + R_K + (4 * ig + r) * 272 + permb(8 * ck + 4)) = c2; } \
        _Pragma("unroll") for (int e = 0; e < 8; ++e) { const int wsel = e >> 1; float x[4]; \
            _Pragma("unroll") for (int r = 0; r < 4; ++r) x[r] = ((e & 1) ? __uint_as_float(R[(RB_) + r][wsel] & 0xffff0000u) : __uint_as_float(R[(RB_) + r][wsel] << 16)) * sc[r]; \
            u32x2 o; o.x = pack2(x[0], x[1]); o.y = pack2(x[2], x[3]); *(LAS u32x2*)(buf + R_KDT + (8 * ck + e) * 144 + permb(4 * ig)) = o; } } while (0)
    if (loader && grp < CG) RET_PREFETCH(grp);
    __syncthreads();
    auto load_step = [&](int nn) {
        if (nn < CG && (nn & 1) == grp) {
            LAS unsigned char* buf = lds + (nn & 1) * STG; int l2 = lg_; OPAQUE_V(l2);
#pragma unroll
            for (int i = 0; i < NQG; ++i) { int pc = l2 + NLG * i; pc = pc < 1024 ? pc : 1023; const int row = pc >> 4, c = pc & 15;
                u32x2 a; a.x = R[i].x; a.y = R[i].y; u32x2 c2; c2.x = R[i].z; c2.y = R[i].w;
                *(LAS u32x2*)(buf + R_Q + row * 272 + permb(8 * c)) = a; *(LAS u32x2*)(buf + R_Q + row * 272 + permb(8 * c + 4)) = c2; }
            RET_WRITE_K(NQG, l2);
            if (l2 < KB_N) { RET_WRITE_K(NQG + 4, NLG + l2); }
            else if (l2 < KB_N + 32 * NCW) { const int v = l2 - KB_N, igv = v >> 2, cv = v & 3;
#pragma unroll
                for (int e = 0; e < 8; ++e) { const int wsel = e >> 1, sh = 16 * (e & 1);
                    u32x2 o; o.x = ((R[NQG + 4][wsel] >> sh) & 0xffffu) | (((R[NQG + 5][wsel] >> sh) & 0xffffu) << 16); o.y = ((R[NQG + 6][wsel] >> sh) & 0xffffu) | (((R[NQG + 7][wsel] >> sh) & 0xffffu) << 16);
                    *(LAS u32x2*)(buf + R_VT + (8 * cv + e) * 144 + permb(4 * igv)) = o; } }
            if (nn + 2 < CG) RET_PREFETCH(nn + 2);
        }
    };
    auto scores = [&](int n) {
        LAS const unsigned char* buf = lds + (n & 1) * STG;
        const int lw = wid - NCW;
#pragma unroll
        for (int rep = 0; rep < 2; ++rep) {
            const int tl = lw + (NTHREADS / 64 - NCW) * rep;
            if (tl < 12) {
                int it, jt;
                if (tl < 1) { it = 0; jt = 0; } else if (tl < 3) { it = 1; jt = tl - 1; } else if (tl < 6) { it = 2; jt = tl - 3; } else if (tl < 10) { it = 3; jt = tl - 6; } else if (tl == 10) { it = 0; jt = 1; } else { it = 2; jt = 3; }
                f32x4 acc = (f32x4){0.f, 0.f, 0.f, 0.f};
                if (tl < 10) {
                    bf16x8 kf[4], qf[4];
#pragma unroll
                    for (int s4 = 0; s4 < 4; ++s4) { kf[s4] = LDF(buf + R_K + (16 * jt + fr) * 272 + 64 * s4 + 16 * q4); qf[s4] = LDF(buf + R_Q + (16 * it + fr) * 272 + 64 * s4 + 16 * q4); }
#pragma unroll
                    for (int s4 = 0; s4 < 4; ++s4) acc = MF16(kf[s4], qf[s4], acc);
                    const float gi_ = __expf(lg * (float)(16 * it + fr));
#pragma unroll
                    for (int r = 0; r < 4; ++r) { const int j = 16 * jt + 4 * q4 + r, i = 16 * it + fr;
                        acc[r] = i >= j ? acc[r] * gi_ * 0.08838834764831845f * __expf(-lg * (float)j) : 0.f; }
                }
                u32x2 w; w.x = pack2(acc[0], acc[1]); w.y = pack2(acc[2], acc[3]);
                *(LAS u32x2*)(lds + RAT_OFF + (16 * it + fr) * 144 + permb(16 * jt + 4 * q4)) = w;
            }
        }
    };
    f32x4 ot[4];
    bf16x8 Vf[2];
    auto computeA = [&](int n) {
        LAS const unsigned char* buf = lds + (n & 1) * STG;
        LAS const unsigned char* pq = buf + R_Q + fr * 272 + 16 * q4;
        LAS const unsigned char* pk = buf + R_KDT + fr * 144 + 16 * q4;
        bf16x8 Sb[4];
#pragma unroll
        for (int s4 = 0; s4 < 4; ++s4) Sb[s4] = pack8(S[2 * s4], S[2 * s4 + 1]);
#pragma unroll
        for (int s2 = 0; s2 < 2; ++s2) Vf[s2] = LDF(buf + R_VT + (16 * cw + fr) * 144 + 64 * s2 + 16 * q4);
        u32x4* RA = R; u32x4* RB = R + 8;
#define RET_LD_Q(RR, hh_) do { _Pragma("unroll") for (int i2 = 0; i2 < 2; ++i2) _Pragma("unroll") for (int s4 = 0; s4 < 4; ++s4) RR[i2 * 4 + s4] = LDR(pq + (16 * (2 * (hh_) + i2)) * 272 + 64 * s4); } while (0)
#define RET_LD_K(RR, dh_) do { _Pragma("unroll") for (int d2 = 0; d2 < 4; ++d2) _Pragma("unroll") for (int s2 = 0; s2 < 2; ++s2) RR[d2 * 2 + s2] = LDR(pk + (16 * (4 * (dh_) + d2)) * 144 + 64 * s2); } while (0)
#define RET_MM_Q(RR, hh_) do { _Pragma("unroll") for (int i2 = 0; i2 < 2; ++i2) { const int it = 2 * (hh_) + i2; ot[it] = (f32x4){0.f, 0.f, 0.f, 0.f}; \
        _Pragma("unroll") for (int s4 = 0; s4 < 4; ++s4) ot[it] = MF16(Sb[s4], asfrag(RR[i2 * 4 + s4]), ot[it]); \
        const float rd = gi[it] * g1; _Pragma("unroll") for (int r = 0; r < 4; ++r) ot[it][r] *= rd; } } while (0)
#define RET_MM_K(RR, dh_) do { _Pragma("unroll") for (int d2 = 0; d2 < 4; ++d2) { S[4 * (dh_) + d2] = S[4 * (dh_) + d2] * rcd; \
        _Pragma("unroll") for (int s2 = 0; s2 < 2; ++s2) S[4 * (dh_) + d2] = MF16(asfrag(RR[d2 * 2 + s2]), Vf[s2], S[4 * (dh_) + d2]); } } while (0)
        RET_LD_K(RA, 0); SCHED_FENCE();
        RET_LD_K(RB, 1); SCHED_FENCE(); RET_MM_K(RA, 0); SCHED_FENCE();
        if (MODE == 1) {
            RET_LD_Q(RA, 0); SCHED_FENCE(); RET_MM_K(RB, 1); SCHED_FENCE();
            RET_LD_Q(RB, 1); SCHED_FENCE(); RET_MM_Q(RA, 0); SCHED_FENCE();
            RET_MM_Q(RB, 1);
        } else { RET_MM_K(RB, 1); }
#undef RET_LD_Q
#undef RET_LD_K
#undef RET_MM_Q
#undef RET_MM_K
    };
    auto computeB = [&](int n) {
        LAS const unsigned char* pa = lds + RAT_OFF + fr * 144 + 16 * q4;
        R[0] = LDR(pa); R[1] = LDR(pa + 16 * 144); R[2] = LDR(pa + 32 * 144); R[3] = LDR(pa + 32 * 144 + 64); R[4] = LDR(pa + 48 * 144); R[5] = LDR(pa + 48 * 144 + 64);
        SCHED_FENCE();
        ot[0] = MF16(Vf[0], asfrag(R[0]), ot[0]); ot[1] = MF16(Vf[0], asfrag(R[1]), ot[1]);
        ot[2] = MF16(Vf[0], asfrag(R[2]), ot[2]); ot[2] = MF16(Vf[1], asfrag(R[3]), ot[2]);
        ot[3] = MF16(Vf[0], asfrag(R[4]), ot[3]); ot[3] = MF16(Vf[1], asfrag(R[5]), ot[3]);
        scan_store_ot(out + ((size_t)b * SEQ + (size_t)(n0 + n) * 64 + fr) * DM + h * 128 + 16 * (NCW * qt + cw) + 4 * q4, ot);
    };
    for (int n = -1; n < CG; ++n) {
        if (loader) { if (MODE == 1 && n >= 0) scores(n); load_step(n + 1); } else if (n >= 0) computeA(n);
        __syncthreads();
        if (MODE == 1) {
            if (!loader && n >= 0) computeB(n);
            __syncthreads();
        }
    }
    if (MODE == 0 && !loader) {
        f32x4* lp = (f32x4*)Lb + ((((size_t)(b * 4 + h) * NG + g) * (8 / NCW) + qt) * NCW + cw) * 8 * 64 + lane;
#pragma unroll
        for (int dt = 0; dt < 8; ++dt) lp[dt * 64] = S[dt];
    }
#undef RET_PREFETCH
#undef RET_WRITE_K
}
template <int MODE>
__device__ __forceinline__ void scan_ret_full(KPTR p, LAS unsigned char* lds, int b, int h, int g, int wv) {
    constexpr int F_Q = 0, F_K = 17408, F_KDT = 34816, F_VT = 53248, F_RAT = 71680;
    const int n0 = g * CG;
    const int tid = opaque_tid(wv), wid = tid >> 6, lane = tid & 63, fr = lane & 15, q4 = lane >> 4, cw = wid;
    const bf16_t* proj = p->proj; bf16_t* out = p->hn; float* Lb = p->retL;
    const float lg = log1pf(-exp2f(-5.0f - (float)h));
    const float rcd = __expf(lg * 64.f), g1 = __expf(lg);
    f32x4 S[8];
#pragma unroll
    for (int dt = 0; dt < 8; ++dt) S[dt] = (f32x4){0.f, 0.f, 0.f, 0.f};
    if (MODE == 1) {
        const float gdec = __expf(lg * (float)(64 * CG)); float wgt = 1.f;
        for (int gp = g - 1; gp >= 0; --gp) {
            const f32x4* lp = (const f32x4*)Lb + (((size_t)(b * 4 + h) * NG + gp) * 8 + cw) * 8 * 64 + lane;
#pragma unroll
            for (int dt = 0; dt < 8; ++dt) S[dt] = S[dt] + lp[dt * 64] * wgt;
            wgt *= gdec;
        }
    }
    float gi[4];
#pragma unroll
    for (int t4 = 0; t4 < 4; ++t4) gi[t4] = __expf(lg * (float)(16 * t4 + fr));
    u32x4 rq[2], rkv[4];
#define RF_PREFETCH(nn) do { int _l = tid; OPAQUE_V(_l); const bf16_t* _pq = proj + ((size_t)b * SEQ + (size_t)(n0 + (nn)) * 64) * DINP + h * 128; \
        _Pragma("unroll") for (int _i = 0; _i < 2; ++_i) { const int _pc = _l + NTHREADS * _i; rq[_i] = *(const u32x4*)(_pq + (size_t)(_pc >> 4) * DINP + (_pc & 15) * 8); } \
        { const bool _isk = _l < 256; const int _t = _isk ? _l : _l - 256; const int _r0 = 4 * (_t >> 4), _co = (_isk ? 512 : 1024) + (_t & 15) * 8; \
          _Pragma("unroll") for (int _r = 0; _r < 4; ++_r) rkv[_r] = *(const u32x4*)(_pq + (size_t)(_r0 + _r) * DINP + _co); } } while (0)
    auto write_stage = [&]() {
        int l2 = tid; OPAQUE_V(l2);
#pragma unroll
        for (int i = 0; i < 2; ++i) { const int pc = l2 + NTHREADS * i, row = pc >> 4, c = pc & 15;
            u32x2 a; a.x = rq[i].x; a.y = rq[i].y; u32x2 c2; c2.x = rq[i].z; c2.y = rq[i].w;
            *(LAS u32x2*)(lds + F_Q + row * 272 + permb(8 * c)) = a; *(LAS u32x2*)(lds + F_Q + row * 272 + permb(8 * c + 4)) = c2; }
        if (l2 < 256) { const int ig = l2 >> 4, ck = l2 & 15; float sc[4];
#pragma unroll
            for (int r = 0; r < 4; ++r) { sc[r] = 0.08838834764831845f * __expf(lg * (float)(63 - 4 * ig - r));
                u32x2 a; a.x = rkv[r].x; a.y = rkv[r].y; u32x2 c2; c2.x = rkv[r].z; c2.y = rkv[r].w;
                *(LAS u32x2*)(lds + F_K + (4 * ig + r) * 272 + permb(8 * ck)) = a; *(LAS u32x2*)(lds + F_K + (4 * ig + r) * 272 + permb(8 * ck + 4)) = c2; }
#pragma unroll
            for (int e = 0; e < 8; ++e) { const int wsel = e >> 1; float x[4];
#pragma unroll
                for (int r = 0; r < 4; ++r) x[r] = ((e & 1) ? __uint_as_float(rkv[r][wsel] & 0xffff0000u) : __uint_as_float(rkv[r][wsel] << 16)) * sc[r];
                u32x2 o; o.x = pack2(x[0], x[1]); o.y = pack2(x[2], x[3]); *(LAS u32x2*)(lds + F_KDT + (8 * ck + e) * 144 + permb(4 * ig)) = o; }
        } else { const int v = l2 - 256, igv = v >> 4, cv = v & 15;
#pragma unroll
            for (int e = 0; e < 8; ++e) { const int wsel = e >> 1, sh = 16 * (e & 1);
                u32x2 o; o.x = ((rkv[0][wsel] >> sh) & 0xffffu) | (((rkv[1][wsel] >> sh) & 0xffffu) << 16); o.y = ((rkv[2][wsel] >> sh) & 0xffffu) | (((rkv[3][wsel] >> sh) & 0xffffu) << 16);
                *(LAS u32x2*)(lds + F_VT + (8 * cv + e) * 144 + permb(4 * igv)) = o; } }
    };
    auto scores = [&]() {
#pragma unroll
        for (int rep = 0; rep < 2; ++rep) {
            const int tl = wid + 8 * rep;
            if (tl < 12) {
                int it, jt;
                if (tl < 1) { it = 0; jt = 0; } else if (tl < 3) { it = 1; jt = tl - 1; } else if (tl < 6) { it = 2; jt = tl - 3; } else if (tl < 10) { it = 3; jt = tl - 6; } else if (tl == 10) { it = 0; jt = 1; } else { it = 2; jt = 3; }
                f32x4 acc = (f32x4){0.f, 0.f, 0.f, 0.f};
                if (tl < 10) {
                    bf16x8 kf[4], qf[4];
#pragma unroll
                    for (int s4 = 0; s4 < 4; ++s4) { kf[s4] = LDF(lds + F_K + (16 * jt + fr) * 272 + 64 * s4 + 16 * q4); qf[s4] = LDF(lds + F_Q + (16 * it + fr) * 272 + 64 * s4 + 16 * q4); }
#pragma unroll
                    for (int s4 = 0; s4 < 4; ++s4) acc = MF16(kf[s4], qf[s4], acc);
                    const float gi_ = __expf(lg * (float)(16 * it + fr));
#pragma unroll
                    for (int r = 0; r < 4; ++r) { const int j = 16 * jt + 4 * q4 + r, i = 16 * it + fr;
                        acc[r] = i >= j ? acc[r] * gi_ * 0.08838834764831845f * __expf(-lg * (float)j) : 0.f; }
                }
                u32x2 w; w.x = pack2(acc[0], acc[1]); w.y = pack2(acc[2], acc[3]);
                *(LAS u32x2*)(lds + F_RAT + (16 * it + fr) * 144 + permb(16 * jt + 4 * q4)) = w;
            }
        }
    };
    RF_PREFETCH(0);
    __syncthreads();
    write_stage();
    if (CG > 1) RF_PREFETCH(1);
    __syncthreads();
    for (int n = 0; n < CG; ++n) {
        if (MODE == 1) { scores(); __syncthreads(); }
        {
            LAS const unsigned char* pq = lds + F_Q + fr * 272 + 16 * q4;
            LAS const unsigned char* pk = lds + F_KDT + fr * 144 + 16 * q4;
            bf16x8 Sb[4];
#pragma unroll
            for (int s4 = 0; s4 < 4; ++s4) Sb[s4] = pack8(S[2 * s4], S[2 * s4 + 1]);
            bf16x8 Vf[2];
#pragma unroll
            for (int s2 = 0; s2 < 2; ++s2) Vf[s2] = LDF(lds + F_VT + (16 * cw + fr) * 144 + 64 * s2 + 16 * q4);
            u32x4 RA[8], RB[8];
            f32x4 ot[4];
#define RF_LD_Q(RR, hh_) do { _Pragma("unroll") for (int i2 = 0; i2 < 2; ++i2) _Pragma("unroll") for (int s4 = 0; s4 < 4; ++s4) RR[i2 * 4 + s4] = LDR(pq + (16 * (2 * (hh_) + i2)) * 272 + 64 * s4); } while (0)
#define RF_LD_K(RR, dh_) do { _Pragma("unroll") for (int d2 = 0; d2 < 4; ++d2) _Pragma("unroll") for (int s2 = 0; s2 < 2; ++s2) RR[d2 * 2 + s2] = LDR(pk + (16 * (4 * (dh_) + d2)) * 144 + 64 * s2); } while (0)
#define RF_MM_Q(RR, hh_) do { _Pragma("unroll") for (int i2 = 0; i2 < 2; ++i2) { const int it = 2 * (hh_) + i2; ot[it] = (f32x4){0.f, 0.f, 0.f, 0.f}; \
        _Pragma("unroll") for (int s4 = 0; s4 < 4; ++s4) ot[it] = MF16(Sb[s4], asfrag(RR[i2 * 4 + s4]), ot[it]); \
        const float rd = gi[it] * g1; _Pragma("unroll") for (int r = 0; r < 4; ++r) ot[it][r] *= rd; } } while (0)
#define RF_MM_K(RR, dh_) do { _Pragma("unroll") for (int d2 = 0; d2 < 4; ++d2) { S[4 * (dh_) + d2] = S[4 * (dh_) + d2] * rcd; \
        _Pragma("unroll") for (int s2 = 0; s2 < 2; ++s2) S[4 * (dh_) + d2] = MF16(asfrag(RR[d2 * 2 + s2]), Vf[s2], S[4 * (dh_) + d2]); } } while (0)
            RF_LD_K(RA, 0); SCHED_FENCE();
            RF_LD_K(RB, 1); SCHED_FENCE(); RF_MM_K(RA, 0); SCHED_FENCE();
            if (MODE == 1) {
                RF_LD_Q(RA, 0); SCHED_FENCE(); RF_MM_K(RB, 1); SCHED_FENCE();
                RF_LD_Q(RB, 1); SCHED_FENCE(); RF_MM_Q(RA, 0); SCHED_FENCE();
                RF_MM_Q(RB, 1);
                LAS const unsigned char* pa = lds + F_RAT + fr * 144 + 16 * q4;
                RA[0] = LDR(pa); RA[1] = LDR(pa + 16 * 144); RA[2] = LDR(pa + 32 * 144); RA[3] = LDR(pa + 32 * 144 + 64); RA[4] = LDR(pa + 48 * 144); RA[5] = LDR(pa + 48 * 144 + 64);
                SCHED_FENCE();
                ot[0] = MF16(Vf[0], asfrag(RA[0]), ot[0]); ot[1] = MF16(Vf[0], asfrag(RA[1]), ot[1]);
                ot[2] = MF16(Vf[0], asfrag(RA[2]), ot[2]); ot[2] = MF16(Vf[1], asfrag(RA[3]), ot[2]);
                ot[3] = MF16(Vf[0], asfrag(RA[4]), ot[3]); ot[3] = MF16(Vf[1], asfrag(RA[5]), ot[3]);
                scan_store_ot(out + ((size_t)b * SEQ + (size_t)(n0 + n) * 64 + fr) * DM + h * 128 + 16 * cw + 4 * q4, ot);
            } else { RF_MM_K(RB, 1); }
#undef RF_LD_Q
#undef RF_LD_K
#undef RF_MM_Q
#undef RF_MM_K
        }
        __syncthreads();
        if (n + 1 < CG) { write_stage(); if (n + 2 < CG) RF_PREFETCH(n + 2); }
        __syncthreads();
    }
    if (MODE == 0) {
        f32x4* lp = (f32x4*)Lb + (((size_t)(b * 4 + h) * NG + g) * 8 + cw) * 8 * 64 + lane;
#pragma unroll
        for (int dt = 0; dt < 8; ++dt) lp[dt * 64] = S[dt];
    }
#undef RF_PREFETCH
}

__device__ __forceinline__ void phase_ret_local(KPTR p, LAS unsigned char* lds, int bid, int nb, int wv) {
    constexpr int NIT0 = BATCH * 4 * NG;
    for (int it = bid; it < NIT0; it += nb) {
        const int g = it % NG, bh = it / NG;
        __syncthreads();
        scan_ret_full<0>(p, lds, bh >> 2, bh & 3, g, wv);
    }
}
template <bool OVERLAP>
__device__ __forceinline__ void phase_scan(KPTR p, LAS unsigned char* lds, int bid, int nb, int wv) {
    constexpr int QN = 8 / NCW;
    constexpr int G = BATCH * 4;
    constexpr int NUG = ((G + 7) / 8) * 8 * QN;
    for (int unit = bid; unit < NUG; unit += nb) {
        const int xcd = unit & 7, t = unit >> 3, qt = t % QN, bh = (t / QN) * 8 + xcd;
        if (bh >= G) continue;
        __syncthreads();
        for (int rp = 0; rp < RPT_SG; ++rp) scan_gdn<OVERLAP>(p, lds, bh >> 2, bh & 3, qt, wv);
    }
    if (OVERLAP && bid >= NUG) { __syncthreads(); phase_gdn_pre<true>(p, lds, bid - NUG, nb - NUG, wv); }
    constexpr int NIT1 = G * NG;
    const int first = nb > NUG ? NUG : 0, step = nb > NUG ? nb - NUG : nb;
    if (bid >= first) {
        for (int it = bid - first; it < NIT1; it += step) {
            const int g = it % NG, bh = it / NG;
            __syncthreads();
            for (int rp = 0; rp < RPT_SR; ++rp) scan_ret_full<1>(p, lds, bh >> 2, bh & 3, g, wv);
        }
    }
}

__device__ __forceinline__ void phase_gatednorm(KPTR p, int bid, int nb, int wv) {
    const int tid = opaque_tid(wv), wid = tid >> 6, lane = tid & 63;
    const int hh = lane >> 3, c0 = lane * 16;
    const float* nwp = (hh < 4 ? p->ret_norm + hh * 128 : p->gdn_norm + (hh - 4) * 128) + (lane & 7) * 16;
    float nw[16];
#pragma unroll
    for (int i = 0; i < 4; ++i) { const f32x4 t4 = *(const f32x4*)(nwp + 4 * i); nw[4 * i] = t4[0]; nw[4 * i + 1] = t4[1]; nw[4 * i + 2] = t4[2]; nw[4 * i + 3] = t4[3]; }
    const int gcol = (hh < 4 ? 1536 + hh * 128 : 3584 + (hh - 4) * 128) + (lane & 7) * 16;
    for (int t = bid * 8 + wid; t < NTOK; t += nb * 8) {
        bf16_t* o = p->hn + (size_t)t * DM + c0;
        const u32x4 o0 = *(const u32x4*)o, o1 = *(const u32x4*)(o + 8);
        const bf16_t* gp = p->proj + (size_t)t * DINP + gcol;
        const u32x4 g0 = *(const u32x4*)gp, g1 = *(const u32x4*)(gp + 8);
        float a[16], g[16];
#pragma unroll
        for (int i = 0; i < 4; ++i) { a[2 * i] = __uint_as_float(o0[i] << 16); a[2 * i + 1] = __uint_as_float(o0[i] & 0xffff0000u); a[8 + 2 * i] = __uint_as_float(o1[i] << 16); a[8 + 2 * i + 1] = __uint_as_float(o1[i] & 0xffff0000u);
            g[2 * i] = __uint_as_float(g0[i] << 16); g[2 * i + 1] = __uint_as_float(g0[i] & 0xffff0000u); g[8 + 2 * i] = __uint_as_float(g1[i] << 16); g[8 + 2 * i + 1] = __uint_as_float(g1[i] & 0xffff0000u); }
        float ss = 0.f;
#pragma unroll
        for (int i = 0; i < 16; ++i) ss += a[i] * a[i];
        ss += __shfl_xor(ss, 1); ss += __shfl_xor(ss, 2); ss += __shfl_xor(ss, 4);
        const float rs = rsqrtf(ss * (1.0f / 128.f) + NORM_EPS);
        u32x4 w0, w1;
#pragma unroll
        for (int i = 0; i < 4; ++i) { w0[i] = pack2(a[2 * i] * rs * nw[2 * i] * siluf(g[2 * i]), a[2 * i + 1] * rs * nw[2 * i + 1] * siluf(g[2 * i + 1]));
            w1[i] = pack2(a[8 + 2 * i] * rs * nw[8 + 2 * i] * siluf(g[8 + 2 * i]), a[8 + 2 * i + 1] * rs * nw[8 + 2 * i + 1] * siluf(g[8 + 2 * i + 1])); }
        *(u32x4*)o = w0; *(u32x4*)(o + 8) = w1;
    }
}

__device__ __forceinline__ void phase_kmean(KPTR p, LAS unsigned char* lds, int bid, int nb, int wv) {
    const int tid = opaque_tid(wv);
    LAS float* red = (LAS float*)lds;
    const int rg = tid >> 4, c = tid & 15;
    for (int unit = bid; unit < NIT; unit += nb) {
        const int blk = unit % NBLK, h = (unit / NBLK) & 7, b = unit / (NBLK * 8);
        const bf16_t* kp = p->qkv + ((size_t)b * SEQ + (size_t)blk * 256 + rg) * 3072 + 1024 + h * 128 + c * 8;
        float a[8];
#pragma unroll
        for (int j = 0; j < 8; ++j) a[j] = 0.f;
#pragma unroll
        for (int i = 0; i < 8; ++i) { const u32x4 w = *(const u32x4*)(kp + (size_t)(32 * i) * 3072);
            a[0] += __uint_as_float(w.x << 16); a[1] += __uint_as_float(w.x & 0xffff0000u); a[2] += __uint_as_float(w.y << 16); a[3] += __uint_as_float(w.y & 0xffff0000u);
            a[4] += __uint_as_float(w.z << 16); a[5] += __uint_as_float(w.z & 0xffff0000u); a[6] += __uint_as_float(w.w << 16); a[7] += __uint_as_float(w.w & 0xffff0000u); }
        __syncthreads();
#pragma unroll
        for (int j = 0; j < 8; ++j) red[rg * 128 + c * 8 + j] = a[j];
        __syncthreads();
        if (tid < 128) { float s2 = 0.f;
#pragma unroll
            for (int g = 0; g < 32; ++g) s2 += red[g * 128 + tid];
            s2 *= (1.0f / 256.f);
            const bf16_t hi = f2bf(s2);
            p->kmh[(size_t)unit * 128 + tid] = hi; p->kml[(size_t)unit * 128 + tid] = f2bf(s2 - bf2f(hi)); }
    }
}
__device__ __forceinline__ void phase_moba_select(KPTR p, LAS unsigned char* lds, int bid, int nb, int wv) {
    const int tid = opaque_tid(wv), wid = tid >> 6, lane = tid & 63, fr = lane & 15, fq = lane >> 4;
    LAS float* sg = (LAS float*)lds + wid * (16 * 65);
    LAS unsigned* cnt = (LAS unsigned*)(lds + 8 * 16 * 65 * 4);
    LAS unsigned* gbase = cnt + 64;
    const int TPS = SEQ / 128, NU = BATCH * 8 * TPS;
    const bf16_t* qkv = p->qkv; const bf16_t* kmh = p->kmh; const bf16_t* kml = p->kml; unsigned* mcount = p->mcount; unsigned short* mlist = p->mlist; float* part_lse = p->part_lse;
    for (int unit = bid; unit < NU; unit += nb) {
        const int tile = unit % TPS, h = (unit / TPS) & 7, b = unit / (TPS * 8), bh = b * 8 + h;
        const int t0 = tile * 128 + wid * 16, own = (tile * 128) >> 8;
        if (tid < 64) cnt[tid] = 0u;
        if (own > 0) {
            f32x4 acc[GNT];
#pragma unroll
            for (int nt = 0; nt < GNT; ++nt) acc[nt] = (f32x4){0.f, 0.f, 0.f, 0.f};
            const bf16_t* qrow = qkv + ((size_t)b * SEQ + t0 + fr) * 3072 + h * 128 + 8 * fq;
#pragma unroll
            for (int s4 = 0; s4 < 4; ++s4) {
                const bf16x8 a = *(const bf16x8*)(qrow + 32 * s4);
#pragma unroll
                for (int nt = 0; nt < GNT; ++nt) {
                    int blk = 16 * nt + fr; blk = blk < NBLK ? blk : NBLK - 1;
                    const size_t ko = ((size_t)bh * NBLK + blk) * 128 + 32 * s4 + 8 * fq;
                    const bf16x8 b1 = *(const bf16x8*)(kmh + ko), b2 = *(const bf16x8*)(kml + ko);
                    acc[nt] = __builtin_amdgcn_mfma_f32_16x16x32_bf16(a, b1, acc[nt], 0, 0, 0);
                    acc[nt] = __builtin_amdgcn_mfma_f32_16x16x32_bf16(a, b2, acc[nt], 0, 0, 0);
                }
            }
#pragma unroll
            for (int nt = 0; nt < GNT; ++nt)
#pragma unroll
                for (int r = 0; r < 4; ++r) sg[(4 * fq + r) * 65 + 16 * nt + fr] = acc[nt][r];
        }
        __syncthreads();
        int i0 = -1, i1 = -1, i2 = -1; unsigned r0 = 0, r1 = 0, r2 = 0;
        if (lane < 16) {
            float v0 = -3e38f, v1 = -3e38f, v2 = -3e38f;
            for (int j = 0; j < own; ++j) {
                const float g = sg[lane * 65 + j];
                if (g > v0) { v2 = v1; i2 = i1; v1 = v0; i1 = i0; v0 = g; i0 = j; }
                else if (g > v1) { v2 = v1; i2 = i1; v1 = g; i1 = j; }
                else if (g > v2) { v2 = g; i2 = j; }
            }
            if (i0 >= 0) r0 = LDS_ATOMIC_ADD(cnt + i0, 1u);
            if (i1 >= 0) r1 = LDS_ATOMIC_ADD(cnt + i1, 1u);
            if (i2 >= 0) r2 = LDS_ATOMIC_ADD(cnt + i2, 1u);
        }
        __syncthreads();
        if (tid < 64 && tid < own) { const unsigned c = cnt[tid]; if (c > 0u) gbase[tid] = atomicAdd(mcount + bh * NBLK + tid, c); }
        __syncthreads();
        if (lane < 16) {
            const int t = t0 + lane;
            const size_t pb = ((size_t)((size_t)b * SEQ + t) * 8 + h) * 3;
            unsigned short* lst = mlist + (size_t)bh * LTOT;
            if (i0 >= 0) lst[list_off(i0) + gbase[i0] + r0] = (unsigned short)(((unsigned)t << 2) | 0u); else part_lse[pb + 0] = -1e30f;
            if (i1 >= 0) lst[list_off(i1) + gbase[i1] + r1] = (unsigned short)(((unsigned)t << 2) | 1u); else part_lse[pb + 1] = -1e30f;
            if (i2 >= 0) lst[list_off(i2) + gbase[i2] + r2] = (unsigned short)(((unsigned)t << 2) | 2u); else part_lse[pb + 2] = -1e30f;
        }
    }
}

__device__ __forceinline__ void moba_stage_kv(const bf16_t* qkv, LAS unsigned char* Ks, LAS unsigned char* VTs, int b, int h, int j, int tid) {
    OPAQUE_V(tid);
    const bf16_t* kbase = qkv + ((size_t)b * SEQ + (size_t)j * 256) * 3072 + 1024 + h * 128;
    const bf16_t* vbase = kbase + 1024;
#pragma unroll
    for (int i = 0; i < 8; ++i) { const int id = tid + NTHREADS * i, key = id >> 4, c = id & 15;
        *(LAS u32x4*)(Ks + key * KS_STRIDE + c * 16) = *(const u32x4*)(kbase + (size_t)key * 3072 + c * 8); }
#pragma unroll
    for (int i = 0; i < 2; ++i) { const int id = tid + NTHREADS * i, c = (id & 3) | (((id >> 4) & 3) << 2), g = ((id >> 2) & 3) | ((id >> 6) << 2);
        u32x4 r0 = *(const u32x4*)(vbase + (size_t)(4 * g) * 3072 + c * 8), r1 = *(const u32x4*)(vbase + (size_t)(4 * g + 1) * 3072 + c * 8);
        u32x4 r2 = *(const u32x4*)(vbase + (size_t)(4 * g + 2) * 3072 + c * 8), r3 = *(const u32x4*)(vbase + (size_t)(4 * g + 3) * 3072 + c * 8);
#pragma unroll
        for (int e = 0; e < 8; ++e) { const int wsel = e >> 1, sh = 16 * (e & 1);
            const unsigned x0 = (r0[wsel] >> sh) & 0xffffu, x1 = (r1[wsel] >> sh) & 0xffffu, x2 = (r2[wsel] >> sh) & 0xffffu, x3 = (r3[wsel] >> sh) & 0xffffu;
            u32x2 o; o.x = x0 | (x1 << 16); o.y = x2 | (x3 << 16);
            *(LAS u32x2*)(VTs + (8 * c + e) * VT_STRIDE + 8 * g) = o; }
    }
}
struct AttnState { f32x16 o[4]; float m, l; };
#ifndef CPU_EMU
__device__ __forceinline__ u32x4 swap16(const u32x4 w, int) {
    const u32x2 r0 = __builtin_amdgcn_permlane32_swap(w.x, w.z, false, false), r1 = __builtin_amdgcn_permlane32_swap(w.y, w.w, false, false);
    u32x4 o; o.x = r0.x; o.z = r0.y; o.y = r1.x; o.w = r1.y; return o; }
#else
static inline u32x4 swap16(const u32x4 w, int lane) {
    unsigned a0 = w.x, b0 = w.z, a1 = w.y, b1 = w.w;
    const unsigned a0o = __shfl(a0, lane ^ 32), b0o = __shfl(b0, lane ^ 32), a1o = __shfl(a1, lane ^ 32), b1o = __shfl(b1, lane ^ 32);
    if (lane < 32) { b0 = a0o; b1 = a1o; } else { a0 = b0o; a1 = b1o; }
    u32x4 o; o.x = a0; o.y = a1; o.z = b0; o.w = b1; return o; }
#endif
template <bool CAUSAL>
__device__ __forceinline__ void attn_block(LAS const unsigned char* Ks, LAS const unsigned char* VTs, const bf16x8 (&qf)[8], float bias0, float slope, int qloc, int wtile, int lane, AttnState& st) {
    const int l31 = lane & 31, h2 = lane >> 5;
    constexpr float L2E = 1.4426950408889634f;
    const float scale2 = 0.08838834764831845f * L2E, slope2 = slope * L2E;
    const float bb = __builtin_fmaf(slope2, (float)(4 * h2), bias0 * L2E);
#pragma unroll 1
    for (int hf = 0; hf < 2; ++hf) {
        if (CAUSAL && 4 * hf > wtile) break;
        LAS const unsigned char* kbase = Ks + (128 * hf + l31) * KS_STRIDE + 16 * h2;
        LAS const unsigned char* vbase = VTs + l31 * VT_STRIDE + (128 * hf + 4 * h2) * 2;
        f32x16 sv[4];
#pragma unroll
        for (int kt = 0; kt < 4; ++kt) {
            const int kt4 = 4 * hf + kt;
            f32x16 acc;
#pragma unroll
            for (int r = 0; r < 16; ++r) acc[r] = 0.f;
            if (!CAUSAL || kt4 <= wtile) {
#pragma unroll
                for (int s8 = 0; s8 < 8; ++s8) { const bf16x8 a = *(LAS const bf16x8*)(kbase + (32 * kt) * KS_STRIDE + 32 * s8);
                    acc = __builtin_amdgcn_mfma_f32_32x32x16_bf16(a, qf[s8], acc, 0, 0, 0);
                    if (s8 == 3) SCHED_FENCE(); }
                const float kb = __builtin_fmaf(slope2, (float)(32 * kt4), bb);
#pragma unroll
                for (int r = 0; r < 16; ++r) { const int cr = (r & 3) + 8 * (r >> 2);
                    float v = __builtin_fmaf(acc[r], scale2, __builtin_fmaf(slope2, (float)cr, kb));
                    if (CAUSAL && kt4 == wtile && 32 * kt4 + cr + 4 * h2 > qloc) v = -1e30f;
                    acc[r] = v; }
            } else {
#pragma unroll
                for (int r = 0; r < 16; ++r) acc[r] = -1e30f;
            }
            sv[kt] = acc;
            SCHED_FENCE();
        }
        float mx = -1e30f;
#pragma unroll
        for (int kt = 0; kt < 4; ++kt)
#pragma unroll
            for (int r = 0; r < 16; ++r) mx = fmaxf(mx, sv[kt][r]);
        mx = fmaxf(mx, __shfl_xor(mx, 32));
        const float mnew = fmaxf(st.m, mx);
        const float alpha = __builtin_amdgcn_exp2f(st.m - mnew);
        st.m = mnew;
        float ls = 0.f;
#pragma unroll
        for (int kt = 0; kt < 4; ++kt)
#pragma unroll
            for (int r = 0; r < 16; ++r) { const float pv = __builtin_amdgcn_exp2f(sv[kt][r] - mnew); sv[kt][r] = pv; ls += pv; }
        st.l = st.l * alpha + ls;
#pragma unroll
        for (int dt = 0; dt < 4; ++dt)
#pragma unroll
            for (int r = 0; r < 16; ++r) st.o[dt][r] *= alpha;
#pragma unroll
        for (int kt = 0; kt < 4; ++kt) {
            const int kt4 = 4 * hf + kt;
            if (CAUSAL && kt4 > wtile) continue;
#pragma unroll
            for (int s2 = 0; s2 < 2; ++s2) {
                u32x4 pw; pw.x = pack2(sv[kt][8 * s2 + 0], sv[kt][8 * s2 + 1]); pw.y = pack2(sv[kt][8 * s2 + 2], sv[kt][8 * s2 + 3]); pw.z = pack2(sv[kt][8 * s2 + 4], sv[kt][8 * s2 + 5]); pw.w = pack2(sv[kt][8 * s2 + 6], sv[kt][8 * s2 + 7]);
                bf16x8 pf; __builtin_memcpy(&pf, &pw, 16);
#pragma unroll
                for (int dt = 0; dt < 4; ++dt) {
                    LAS const unsigned char* vp = vbase + (32 * dt) * VT_STRIDE + (32 * kt + 16 * s2) * 2;
                    const u32x2 lo = *(LAS const u32x2*)vp, hi = *(LAS const u32x2*)(vp + 16);
                    u32x4 aw; aw.x = lo.x; aw.y = lo.y; aw.z = hi.x; aw.w = hi.y;
                    bf16x8 a; __builtin_memcpy(&a, &aw, 16);
                    st.o[dt] = __builtin_amdgcn_mfma_f32_32x32x16_bf16(a, pf, st.o[dt], 0, 0, 0);
                }
                SCHED_FENCE();
            }
        }
    }
}
__device__ __forceinline__ void load_qfrag(const bf16_t* qrow, int h2, bf16x8 (&qf)[8]) {
#pragma unroll
    for (int s8 = 0; s8 < 8; ++s8) qf[s8] = *(const bf16x8*)(qrow + 16 * s8 + 8 * h2);
}

__device__ __forceinline__ void phase_moba_gather(KPTR p, LAS unsigned char* lds, int bid, int nb, int wv) {
#ifndef CPU_EMU
    const int tid = opaque_tid(wv), wid = wv, lane = tid & 63, l31 = lane & 31, h2 = lane >> 5;
#else
    const int tid = opaque_tid(wv), wid = tid >> 6, lane = tid & 63, l31 = lane & 31, h2 = lane >> 5;
#endif
    LAS unsigned char* Ks = lds; LAS unsigned char* VTs = lds + KS_BYTES;
    LAS unsigned* pref = (LAS unsigned*)(lds + KS_BYTES + VT_BYTES);
    LAS unsigned* wsum = pref + NIT + 1;
    const bf16_t* qkv = p->qkv; const unsigned* mcount = p->mcount; const unsigned short* mlist = p->mlist;
    constexpr int IPT = (NIT + NTHREADS - 1) / NTHREADS;
    unsigned loc[IPT]; unsigned tsum = 0;
#pragma unroll
    for (int i = 0; i < IPT; ++i) { const int it = tid * IPT + i; const unsigned c = it < NIT ? mcount[it] : 0u; loc[i] = c ? 1u + 2u * ((c + 255u) >> 8) : 0u; tsum += loc[i]; }
    unsigned inc = tsum;
    for (int o = 1; o < 64; o <<= 1) { const unsigned t2 = __shfl_up(inc, o); if (lane >= o) inc += t2; }
    if (lane == 63) wsum[wid] = inc;
    __syncthreads();
    unsigned wbase = 0;
#pragma unroll
    for (int w = 0; w < 8; ++w) if (w < wid) wbase += wsum[w];
    unsigned run = wbase + inc - tsum;
#pragma unroll
    for (int i = 0; i < IPT; ++i) { const int it = tid * IPT + i; if (it < NIT) pref[it] = run; run += loc[i]; }
    if (tid == NTHREADS - 1) pref[NIT] = run;
    __syncthreads();
    const unsigned C = pref[NIT];
    const unsigned lo = (unsigned)(((unsigned long long)C * (unsigned)bid) / (unsigned)nb), hi = (unsigned)(((unsigned long long)C * (unsigned)(bid + 1)) / (unsigned)nb);
    if (lo >= hi) return;
    int first = 0; { int a = 0, c = NIT; while (c - a > 1) { const int mid = (a + c) >> 1; if (pref[mid] <= lo) a = mid; else c = mid; } first = a; }
    for (int it = first; it < NIT; ++it) {
        const unsigned ps = pref[it], pe = pref[it + 1];
        if (ps >= hi) break;
        if (pe <= lo || pe == ps) continue;
        const unsigned nr = (pe - ps - 1u) >> 1;
        unsigned r_lo = 0; if (lo > ps + 1u) r_lo = (lo - ps - 1u + 1u) >> 1;
        unsigned r_hi = nr; if (hi < ps + 1u + 2u * nr) r_hi = hi > ps + 1u ? (hi - ps - 1u + 1u) >> 1 : 0u;
        if (r_lo >= r_hi) continue;
        const int j = it % NBLK, h = (it / NBLK) & 7, b = it / (NBLK * 8), bh = b * 8 + h;
        const unsigned cnt = mcount[it];
        const unsigned ra = r_lo * 256u, rb = (r_hi * 256u) < cnt ? (r_hi * 256u) : cnt;
        __syncthreads();
        moba_stage_kv(qkv, Ks, VTs, b, h, j, tid);
        __syncthreads();
        const float slope = exp2f(-(float)(h + 1));
        const unsigned short* lst = mlist + (size_t)bh * LTOT + list_off(j);
        unsigned ent_next = 0;
        int l31i = l31; OPAQUE_V(l31i);
        { const unsigned row = ra + 32u * wid + l31i; if (ra + 32u * wid < rb) ent_next = lst[row < rb ? row : (rb - 1)]; }
        for (unsigned r0 = ra + 32u * wid; r0 < rb; r0 += 256u) {
            const unsigned row = r0 + l31i; const bool active = row < rb;
            const unsigned ent = ent_next;
            if (r0 + 256u < rb) { const unsigned rn = row + 256u; ent_next = lst[rn < rb ? rn : (rb - 1)]; }
            const int t = (int)(ent >> 2), k = (int)(ent & 3u);
            int h2q = h2; OPAQUE_V(h2q);
            bf16x8 qf[8]; load_qfrag(qkv + ((size_t)b * SEQ + t) * 3072 + h * 128, h2q, qf);
            AttnState st;
#pragma unroll
            for (int dt = 0; dt < 4; ++dt)
#pragma unroll
                for (int r = 0; r < 16; ++r) st.o[dt][r] = 0.f;
            st.m = -1e30f; st.l = 0.f;
            attn_block<false>(Ks, VTs, qf, slope * (float)(256 * j - t), slope, 0, 0, lane, st);
            const float lt = st.l + __shfl_xor(st.l, 32);
            const float inv = 1.0f / lt;
            {
                const size_t pb = ((size_t)((size_t)b * SEQ + t) * 8 + h) * 3 + k;
                bf16_t* po = p->part_o + pb * 128;
#pragma unroll
                for (int dt = 0; dt < 4; ++dt)
#pragma unroll
                    for (int gp = 0; gp < 4; gp += 2) { u32x4 w;
                        w.x = pack2(st.o[dt][4 * gp] * inv, st.o[dt][4 * gp + 1] * inv); w.y = pack2(st.o[dt][4 * gp + 2] * inv, st.o[dt][4 * gp + 3] * inv);
                        w.z = pack2(st.o[dt][4 * gp + 4] * inv, st.o[dt][4 * gp + 5] * inv); w.w = pack2(st.o[dt][4 * gp + 6] * inv, st.o[dt][4 * gp + 7] * inv);
                        w = swap16(w, lane);
                        if (active) *(u32x4*)(po + 32 * dt + 8 * (gp + h2)) = w; }
                if (active && h2 == 0) p->part_lse[pb] = st.m * 0.6931471805599453f + __logf(lt);
            }
        }
    }
}
__device__ __forceinline__ void phase_moba_own(KPTR p, LAS unsigned char* lds, int bid, int nb, int wv) {
    const int tid = opaque_tid(wv), wid = tid >> 6, lane = tid & 63, l31 = lane & 31, h2 = lane >> 5;
    LAS unsigned char* Ks = lds; LAS unsigned char* VTs = lds + KS_BYTES;
    const bf16_t* qkv = p->qkv; const bf16_t* part_o = p->part_o; const float* part_lse = p->part_lse; bf16_t* out = p->hn;
    for (int it = bid; it < NIT; it += nb) {
        const int j = it % NBLK, h = (it / NBLK) & 7, b = it / (NBLK * 8);
        const float slope = exp2f(-(float)(h + 1));
        const int qloc = 32 * wid + l31, t = j * 256 + qloc;
        bf16x8 qf[8]; load_qfrag(qkv + ((size_t)b * SEQ + t) * 3072 + h * 128, h2, qf);
        __syncthreads();
        moba_stage_kv(qkv, Ks, VTs, b, h, j, tid);
        __syncthreads();
        AttnState st;
#pragma unroll
        for (int dt = 0; dt < 4; ++dt)
#pragma unroll
            for (int r = 0; r < 16; ++r) st.o[dt][r] = 0.f;
        st.m = -1e30f; st.l = 0.f;
        attn_block<true>(Ks, VTs, qf, slope * (float)(-qloc), slope, qloc, wid, lane, st);
        const float lt = st.l + __shfl_xor(st.l, 32);
        const float lse_own = st.m * 0.6931471805599453f + __logf(lt);
        const size_t pb = ((size_t)((size_t)b * SEQ + t) * 8 + h) * 3;
        const float l0 = part_lse[pb], l1 = part_lse[pb + 1], l2 = part_lse[pb + 2];
        const float M = fmaxf(fmaxf(lse_own, l0), fmaxf(l1, l2));
        const float w_own = __expf(lse_own - M), w0 = __expf(l0 - M), w1 = __expf(l1 - M), w2 = __expf(l2 - M);
        const float Wi = 1.0f / (w_own + w0 + w1 + w2);
        const float c_own = w_own * Wi / lt, c0 = w0 * Wi, c1 = w1 * Wi, c2 = w2 * Wi;
        bf16_t* orow = out + ((size_t)b * SEQ + t) * DM + h * 128;
        const bool v0 = l0 > -1e29f, v1 = l1 > -1e29f, v2 = l2 > -1e29f;
#pragma unroll
        for (int dt = 0; dt < 4; ++dt) {
            u32x2 pw[3][4]; u32x4 pq[3][2];
#pragma unroll
            for (int k = 0; k < 3; ++k)
#pragma unroll
                for (int gp = 0; gp < 2; ++gp) pq[k][gp] = *(const u32x4*)(part_o + (pb + k) * 128 + 32 * dt + 8 * (2 * gp + h2));
#pragma unroll
            for (int k = 0; k < 3; ++k)
#pragma unroll
                for (int gp = 0; gp < 2; ++gp) { const u32x4 q = swap16(pq[k][gp], lane); pw[k][2 * gp].x = q.x; pw[k][2 * gp].y = q.y; pw[k][2 * gp + 1].x = q.z; pw[k][2 * gp + 1].y = q.w; }
            u32x2 wo4[4];
#pragma unroll
            for (int g = 0; g < 4; ++g) {
                const int d0 = 32 * dt + 8 * g + 4 * h2;
                float v[4];
#pragma unroll
                for (int e = 0; e < 4; ++e) v[e] = st.o[dt][4 * g + e] * c_own;
#pragma unroll
                for (int k = 0; k < 3; ++k) {
                    const bool vk = k == 0 ? v0 : (k == 1 ? v1 : v2); const float ck = k == 0 ? c0 : (k == 1 ? c1 : c2);
                    const u32x2 w = pw[k][g];
                    const float f0 = __uint_as_float(w.x << 16), f1 = __uint_as_float(w.x & 0xffff0000u), f2 = __uint_as_float(w.y << 16), f3 = __uint_as_float(w.y & 0xffff0000u);
                    v[0] += vk ? ck * f0 : 0.f; v[1] += vk ? ck * f1 : 0.f; v[2] += vk ? ck * f2 : 0.f; v[3] += vk ? ck * f3 : 0.f;
                }
                wo4[g].x = pack2(v[0], v[1]); wo4[g].y = pack2(v[2], v[3]);
            }
#pragma unroll
            for (int gp = 0; gp < 4; gp += 2) { u32x4 w; w.x = wo4[gp].x; w.y = wo4[gp].y; w.z = wo4[gp + 1].x; w.w = wo4[gp + 1].y;
                w = swap16(w, lane);
                *(u32x4*)(orow + 32 * dt + 8 * (gp + h2)) = w; }
        }
    }
}

__device__ __forceinline__ void phase_router(KPTR p, LAS unsigned char* lds, int bid, int nb, int wv) {
    const int tid = opaque_tid(wv), wid = tid >> 6, lane = tid & 63;
    LAS unsigned* hist = (LAS unsigned*)lds;
    if (tid < 8) hist[tid] = 0u;
    __syncthreads();
    f32x4 gv[4];
#pragma unroll
    for (int i = 0; i < 4; ++i) gv[i] = *(const f32x4*)(p->ffn_norm + DM + i * 256 + lane * 4);
    const int rpw = (NTOK + nb - 1) / nb, rbeg = bid * rpw, rend = (rbeg + rpw) < NTOK ? (rbeg + rpw) : NTOK;
    f32x4 w8[16][2];
#pragma unroll
    for (int i = 0; i < 4; ++i)
#pragma unroll
        for (int e = 0; e < 4; ++e) { const float* wr_ = p->w_router + (size_t)(i * 256 + lane * 4 + e) * 8; w8[i * 4 + e][0] = *(const f32x4*)wr_; w8[i * 4 + e][1] = *(const f32x4*)(wr_ + 4); }
    for (int row = rbeg + wid; row < rend; row += 8) {
        f32x4 v[4]; load_row_b(p->hb3, row, lane, v);
        const float rs = row_rstd(v);
#pragma unroll
        for (int i = 0; i < 4; ++i) v[i] = v[i] * rs * gv[i];
        store_row_fp8((unsigned char*)p->hn, p->hns, row, lane, v);
        { float ss = 0.f;
#pragma unroll
          for (int i = 0; i < 4; ++i) ss += v[i][0] * v[i][0] + v[i][1] * v[i][1] + v[i][2] * v[i][2] + v[i][3] * v[i][3];
          ss = wave_sum(ss); if (lane == 0) p->hnn2[row] = ss; }
        f32x4 d0 = (f32x4){0.f, 0.f, 0.f, 0.f}, d1 = (f32x4){0.f, 0.f, 0.f, 0.f};
#pragma unroll
        for (int i = 0; i < 4; ++i)
#pragma unroll
            for (int e = 0; e < 4; ++e) { const float xv = v[i][e]; d0 = d0 + w8[i * 4 + e][0] * xv; d1 = d1 + w8[i * 4 + e][1] * xv; }
        float d[8] = {d0[0], d0[1], d0[2], d0[3], d1[0], d1[1], d1[2], d1[3]};
#pragma unroll
        for (int j = 0; j < 8; ++j) d[j] = wave_sum(d[j]);
        int i0 = 0; float m0 = d[0];
#pragma unroll
        for (int j = 1; j < 8; ++j) if (d[j] > m0) { m0 = d[j]; i0 = j; }
        int i1 = -1; float m1 = -3e38f;
#pragma unroll
        for (int j = 0; j < 8; ++j) if (j != i0 && d[j] > m1) { m1 = d[j]; i1 = j; }
        if (lane == 0) {
            const float e1 = __expf(m1 - m0); const float g0 = 1.0f / (1.0f + e1);
            p->midx[row * 2] = i0; p->midx[row * 2 + 1] = i1; p->mgate[row * 2] = g0; p->mgate[row * 2 + 1] = e1 * g0;
            LDS_ATOMIC_ADD(hist + i0, 1u); LDS_ATOMIC_ADD(hist + i1, 1u);
        }
    }
    __syncthreads();
    if (tid < 8) p->wghist[bid * 8 + tid] = hist[tid];
}
__device__ __forceinline__ void phase_slots(KPTR p, LAS unsigned char* lds, int bid, int nb, int wv) {
    const int tid = opaque_tid(wv);
    LAS unsigned* ltot = (LAS unsigned*)lds; LAS unsigned* lpre = ltot + 8; LAS unsigned* lcur = ltot + 16;
    if (tid < 24) ltot[tid] = 0u;
    __syncthreads();
    { const int e = tid & 7; unsigned tot = 0, pre = 0;
      for (int bb = tid >> 3; bb < nb; bb += NTHREADS / 8) { const unsigned v = p->wghist[bb * 8 + e]; tot += v; if (bb < bid) pre += v; }
      LDS_ATOMIC_ADD(ltot + e, tot); LDS_ATOMIC_ADD(lpre + e, pre); }
    __syncthreads();
    unsigned base[NE], cnt[NE]; unsigned acc = 0; float gu[NE];
#pragma unroll
    for (int e = 0; e < NE; ++e) { cnt[e] = ltot[e]; base[e] = acc; acc += (cnt[e] + 255u) & ~255u; gu[e] = __uint_as_float(p->ctrl[C_GMAX + e]) * __uint_as_float(p->ctrl[C_UMAX + e]); }
    const int rpw = (NTOK + nb - 1) / nb, rbeg = bid * rpw, rend = (rbeg + rpw) < NTOK ? (rbeg + rpw) : NTOK;
    for (int a = rbeg * 2 + tid; a < rend * 2; a += NTHREADS) {
        const int e = p->midx[a];
        unsigned b0 = 0;
#pragma unroll
        for (int j = 0; j < NE; ++j) if (j == e) b0 = base[j];
        const unsigned s = b0 + lpre[e] + LDS_ATOMIC_ADD(lcur + e, 1u);
        p->slot_of[a] = (int)s; p->arow[s] = a >> 1; p->sslot[s] = p->hns[a >> 1];
        float gm = 0.f;
#pragma unroll
        for (int j = 0; j < NE; ++j) if (j == e) gm = gu[j];
        p->shs[s] = p->hnn2[a >> 1] * gm * (1.0f / 256.f);
    }
    if (bid == 0) {
        if (tid == 0) { p->ctrl[C_NTILES] = acc >> 8; p->ctrl[C_TB + NE] = acc >> 8; }
        if (tid < NE) { unsigned bb = 0;
#pragma unroll
            for (int e = 0; e < NE; ++e) if (e == tid) bb = base[e];
            p->ctrl[C_TB + tid] = bb >> 8; }
#pragma unroll
        for (int e = 0; e < NE; ++e) {
            const unsigned lo = base[e] + cnt[e], hi = base[e] + ((cnt[e] + 255u) & ~255u);
            for (unsigned s2 = lo + tid; s2 < hi; s2 += NTHREADS) { p->arow[s2] = 0; p->sslot[s2] = 0.f; p->shs[s2] = 1.0f; }
            for (unsigned t = (base[e] >> 8) + tid; t < (hi >> 8); t += NTHREADS) p->tile_e[t] = e;
        }
    }
}
__device__ __forceinline__ void phase_final(KPTR p, const bf16_t* hsrc, int lo, int hi, int bid, int nb, int wv) {
    const int tid = opaque_tid(wv), wid = tid >> 6, lane = tid & 63;
    f32x4 gv[4];
#pragma unroll
    for (int i = 0; i < 4; ++i) gv[i] = *(const f32x4*)(p->final_norm + i * 256 + lane * 4);
    int sl0 = 0, sl1 = 0; float ga0 = 0.f, ga1 = 0.f;
    { const int row = lo + bid * 8 + wid; if (row < hi) { sl0 = p->slot_of[row * 2]; sl1 = p->slot_of[row * 2 + 1]; ga0 = p->mgate[row * 2]; ga1 = p->mgate[row * 2 + 1]; } }
    for (int row = lo + bid * 8 + wid; row < hi; row += nb * 8) {
        const int s0 = sl0, s1 = sl1; const float g0 = ga0, g1 = ga1;
        u32x2 y0[4], y1[4];
#pragma unroll
        for (int i = 0; i < 4; ++i) { y0[i] = *(const u32x2*)(p->yslot + (size_t)s0 * DM + i * 256 + lane * 4); y1[i] = *(const u32x2*)(p->yslot + (size_t)s1 * DM + i * 256 + lane * 4); }
        f32x4 v[4]; load_row_b(hsrc, row, lane, v);
        { const int rn = row + nb * 8; if (rn < hi) { sl0 = p->slot_of[rn * 2]; sl1 = p->slot_of[rn * 2 + 1]; ga0 = p->mgate[rn * 2]; ga1 = p->mgate[rn * 2 + 1]; } }
#pragma unroll
        for (int i = 0; i < 4; ++i) {
            v[i][0] += g0 * __uint_as_float(y0[i].x << 16) + g1 * __uint_as_float(y1[i].x << 16); v[i][1] += g0 * __uint_as_float(y0[i].x & 0xffff0000u) + g1 * __uint_as_float(y1[i].x & 0xffff0000u);
            v[i][2] += g0 * __uint_as_float(y0[i].y << 16) + g1 * __uint_as_float(y1[i].y << 16); v[i][3] += g0 * __uint_as_float(y0[i].y & 0xffff0000u) + g1 * __uint_as_float(y1[i].y & 0xffff0000u); }
        const float rs = row_rstd(v);
#pragma unroll
        for (int i = 0; i < 4; ++i) *(f32x4*)(p->out + (size_t)row * DM + i * 256 + lane * 4) = v[i] * rs * gv[i];
    }
}


#ifndef CPU_EMU
#define XB_TMO      128
#define XB_XCNT(j)  (256  + 64 * (j))
#define XB_XSUB(j)  (1280 + 64 * (j))
#define XB_XGEN(j)  (2304 + 64 * (j))
#define XB_TOP      3328
#define XB_TOPGEN   3392
#define XCD_BAR_WORDS 3456
#define XB_SPIN_CAP (1u << 20)
__device__ __forceinline__ unsigned xb_ld(unsigned* p) { return __hip_atomic_load(p, __ATOMIC_RELAXED, __HIP_MEMORY_SCOPE_AGENT); }
__device__ __forceinline__ unsigned xb_add(unsigned* p, unsigned v) { return __hip_atomic_fetch_add(p, v, __ATOMIC_RELAXED, __HIP_MEMORY_SCOPE_AGENT); }
__device__ __forceinline__ unsigned xb_xcc_id() { return (unsigned)__builtin_amdgcn_s_getreg((3 << 11) | 20) & 0xFu; }
#define XB_SPIN(cond, bar) do { unsigned _sp = 0; while (cond) { __builtin_amdgcn_s_sleep(1); \
    if ((++_sp & 255u) == 0u) { if (xb_ld(&(bar)[XB_TMO])) break; if (_sp > XB_SPIN_CAP) { atomicAdd(&(bar)[XB_TMO], 1u); break; } } } } while (0)
__device__ __forceinline__ void xcd_barrier_post(unsigned* bar, int tid) { if (tid == 0) (void)xb_add(&bar[XB_XCNT(xb_xcc_id())], 1u); }
__device__ __forceinline__ void xcd_barrier_complete(unsigned* bar, unsigned x, unsigned& nloc, unsigned& nx) {
    const unsigned G = gridDim.x * gridDim.y * gridDim.z;
    unsigned sum, cnt, mine, sp = 0u;
    for (;;) {
        sum = 0u; cnt = 0u; mine = 0u;
#pragma unroll
        for (unsigned j = 0; j < 16; ++j) { const unsigned c = xb_ld(&bar[XB_XCNT(j)]); sum += c; cnt += (c > 0u) ? 1u : 0u; mine = (j == x) ? c : mine; }
        if (sum == G) break;
        __builtin_amdgcn_s_sleep(1);
        if ((++sp & 255u) == 0u) { if (xb_ld(&bar[XB_TMO])) break; if (sp > XB_SPIN_CAP) { atomicAdd(&bar[XB_TMO], 1u); break; } }
    }
    nloc = mine > 0u ? mine : 1u; nx = cnt > 0u ? cnt : 1u;
}
__device__ __forceinline__ void xcd_barrier(unsigned* bar, volatile LAS unsigned* st, int tid) {
    asm volatile("s_waitcnt vmcnt(0)" ::: "memory");
    __syncthreads();
    if (tid == 0) {
        __builtin_amdgcn_s_waitcnt(0);
        const unsigned x = xb_xcc_id();
        unsigned nloc = st[0], nx = st[1];
        if (nloc == 0u) { xcd_barrier_complete(bar, x, nloc, nx); st[0] = nloc; st[1] = nx; }
        const unsigned old = xb_add(&bar[XB_XSUB(x)], 1u);
        const unsigned gen = old / nloc;
        if (old + 1u == (gen + 1u) * nloc) {
            __builtin_amdgcn_fence(__ATOMIC_RELEASE, "agent");
            asm volatile("s_waitcnt vmcnt(0)" ::: "memory");
            const unsigned og = xb_add(&bar[XB_TOP], 1u);
            const unsigned tg = og / nx;
            if (og + 1u == (tg + 1u) * nx) xb_add(&bar[XB_TOPGEN], 1u);
            else XB_SPIN(xb_ld(&bar[XB_TOPGEN]) == tg, bar);
            __builtin_amdgcn_fence(__ATOMIC_ACQUIRE, "agent");
            xb_add(&bar[XB_XGEN(x)], 1u);
            asm volatile("s_waitcnt vmcnt(0)" ::: "memory");
        } else {
            XB_SPIN(xb_ld(&bar[XB_XGEN(x)]) == gen, bar);
            __builtin_amdgcn_fence(__ATOMIC_ACQUIRE, "agent");
            asm volatile("s_waitcnt vmcnt(0)" ::: "memory");
        }
    }
    __syncthreads();
}
#define GRID_BARRIER() do { unsigned* _bar = p->bar; xcd_barrier(_bar, (volatile LAS unsigned*)(lds + kDynLds - 16), opaque_tid(wv)); } while (0)
#else
#define XCD_BAR_WORDS 3456
#define GRID_BARRIER() emu::grid_sync()
#endif

#ifndef CPU_EMU
extern __shared__ __attribute__((aligned(16))) unsigned char smem_raw[];
#define GET_LDS() ((LAS unsigned char*)smem_raw)
#else
#define GET_LDS() (emu::blk->smem)
#endif

__global__ void __launch_bounds__(NTHREADS) fwd_megakernel(Params p_arg) {
    cg::grid_group grid = cg::this_grid();
    KPTR p = KARG_PTR(p_arg);
    LAS unsigned char* lds = GET_LDS();
#ifndef CPU_EMU
    const int wv = __builtin_amdgcn_readfirstlane((int)(threadIdx.x >> 6));
#else
    const int wv = 0;
#endif
    const int bid = blockIdx.x, nb = gridDim.x, tid = opaque_tid(wv);
#ifndef CPU_EMU
    if (tid == 0) { volatile LAS unsigned* st = (volatile LAS unsigned*)(lds + kDynLds - 16); st[0] = 0u; st[1] = 0u; }
    __syncthreads();
    xcd_barrier_post(p->bar, tid);
#endif
    LAUNDER(p);
    if (bid == 0 && tid < 256) p->ctrl[tid] = 0u;
    for (int i = bid * NTHREADS + tid; i < NIT; i += nb * NTHREADS) p->mcount[i] = 0u;
    for (int i = bid * NTHREADS + tid; i < NCHH; i += nb * NTHREADS) p->gflag[i] = 0u;
    convert_wt(lds, p->w_in, DM, DIN, 0, DINP, p->wt_in, 128, 0, bid, nb, wv);
    convert_wt(lds, p->w_out0, DM, DM, 0, DM, p->wt_out0, 128, 0, bid, nb, wv);
    convert_wt(lds, p->w_gate0, DM, FF, 0, FF, p->wt_gu0, 256, 0, bid, nb, wv);
    convert_wt(lds, p->w_up0, DM, FF, 0, FF, p->wt_gu0, 256, 128, bid, nb, wv);
    convert_wt(lds, p->w_down0, FF, DM, 0, DM, p->wt_d0, 128, 0, bid, nb, wv);
    convert_wt(lds, p->w_qkv, DM, 3072, 0, 3072, p->wt_qkv, 128, 0, bid, nb, wv);
    convert_wt(lds, p->w_out1, DM, DM, 0, DM, p->wt_out1, 128, 0, bid, nb, wv);
    phase_norm<true>(p, p->x, p->mix_norm, bid, nb, wv);
    if (p->pad0 != 0) grid.sync(); else GRID_BARRIER();
    LAUNDER(p);
    for (int rp = 0; rp < RPT_GEMM; ++rp) { StaticOrder so; so.init(NTOK / 256, DINP / 256, nb, bid); Gemm g{p->hn, p->wt_in, nullptr}; EpiBf16 e{p->proj, DINP, 0}; gemm_phase<DM>(lds, g, so, e, wv); }
    GRID_BARRIER();
    LAUNDER(p);
    constexpr int NUG_ = ((BATCH * 4 + 7) / 8) * 8 * (8 / NCW);
    const bool overlap = nb >= NUG_ + 32;
    if (!overlap) phase_gdn_pre<false>(p, lds, bid, nb, wv);
    phase_ret_local(p, lds, bid, nb, wv);
    GRID_BARRIER();
    LAUNDER(p);
    if (overlap) phase_scan<true>(p, lds, bid, nb, wv); else phase_scan<false>(p, lds, bid, nb, wv);
    GRID_BARRIER();
    LAUNDER(p);
    phase_gatednorm(p, bid, nb, wv);
    GRID_BARRIER();
    LAUNDER(p);
    { StaticOrder so; so.init(NTOK / 256, DM / 256, nb, bid); Gemm g{p->hn, p->wt_out0, nullptr}; EpiResBf16<true> e{p->x, nullptr, p->hb}; gemm_phase<DM>(lds, g, so, e, wv); }
    GRID_BARRIER();
    LAUNDER(p);
#if FP8_FFN0
    phase_norm<false, true, true>(p, p->hb, p->ffn_norm, bid, nb, wv);
    quant_rows<DM, false>(p, lds, p->wt_gu0, p->w8_gu0, p->ws_gu0, 2 * FF, bid, nb, wv);
#else
    phase_norm<false, false, true>(p, p->hb, p->ffn_norm, bid, nb, wv);
#endif
    GRID_BARRIER();
    LAUNDER(p);
#if FP8_FFN0
    for (int rp = 0; rp < RPT_GEMM; ++rp) { StaticOrder so; so.init(NTOK / 256, 2 * FF / 256, nb, bid); Gemm g{p->hn, (const bf16_t*)p->w8_gu0, nullptr}; EpiSwigluS e{p->act0, FF, 0, p->hns, p->ws_gu0}; gemm_phase<DM, EpiSwigluS, StaticOrder, true>(lds, g, so, e, wv); }
#else
    for (int rp = 0; rp < RPT_GEMM; ++rp) { StaticOrder so; so.init(NTOK / 256, 2 * FF / 256, nb, bid); Gemm g{p->hn, p->wt_gu0, nullptr}; EpiSwiglu e{p->act0, FF, 0}; gemm_phase<DM>(lds, g, so, e, wv); }
#endif
    GRID_BARRIER();
    LAUNDER(p);
    { StaticOrder so; so.init(NTOK / 256, DM / 256, nb, bid); Gemm g{p->act0, p->wt_d0, nullptr}; EpiResBf16<false> e{nullptr, p->hb, p->hb}; gemm_phase<FF>(lds, g, so, e, wv); }
    GRID_BARRIER();
    LAUNDER(p);
    phase_norm<false, false, true>(p, p->hb, p->mix_norm + DM, bid, nb, wv);
    GRID_BARRIER();
    LAUNDER(p);
    for (int rp = 0; rp < RPT_GEMM; ++rp) { StaticOrder so; so.init(NTOK / 256, 3072 / 256, nb, bid); Gemm g{p->hn, p->wt_qkv, nullptr}; EpiBf16 e{p->qkv, 3072, 0}; gemm_phase<DM>(lds, g, so, e, wv); }
    GRID_BARRIER();
    LAUNDER(p);
    phase_kmean(p, lds, bid, nb, wv);
    GRID_BARRIER();
    LAUNDER(p);
    phase_moba_select(p, lds, bid, nb, wv);
    GRID_BARRIER();
    LAUNDER(p);
    for (int rp = 0; rp < RPT_MG; ++rp) phase_moba_gather(p, lds, bid, nb, wv);
    GRID_BARRIER();
    LAUNDER(p);
    for (int rp = 0; rp < RPT_MO; ++rp) phase_moba_own(p, lds, bid, nb, wv);
    GRID_BARRIER();
    LAUNDER(p);
    convert_gu_fp8(p, lds, bid, nb, wv);
    for (int rp = 0; rp < RPT_CONV; ++rp) for (int e = 0; e < NE; ++e) {
        convert_wt(lds, p->w_mdown + (size_t)e * FFE * DM, FFE, DM, 0, DM, p->wt_md_tmp + (size_t)e * DM * FFE, 128, 0, bid, nb, wv);
    }
    { StaticOrder so; so.init(NTOK / 256, DM / 256, nb, bid); Gemm g{p->hn, p->wt_out1, nullptr}; EpiResBf16<false> e{nullptr, p->hb, p->hb3}; gemm_phase<DM>(lds, g, so, e, wv); }
    GRID_BARRIER();
    LAUNDER(p);
    phase_router(p, lds, bid, nb, wv);
    quant_rows<FFE, false>(p, lds, p->wt_md_tmp, p->w8_md, p->ws_md, NE * DM, bid, nb, wv);
    GRID_BARRIER();
    LAUNDER(p);
    phase_slots(p, lds, bid, nb, wv);
    GRID_BARRIER();
    LAUNDER(p);
    {
        const int ntiles = (int)p->ctrl[C_NTILES];
        const int npass = (ntiles + p->tiles_per_pass - 1) / p->tiles_per_pass;
        const int tpp = npass > 0 ? (ntiles + npass - 1) / npass : 1;
        const size_t mbuf = (size_t)p->tiles_per_pass * 256 * FFE; int q = 0;
        for (int t0 = 0; t0 < ntiles; t0 += tpp, ++q) {
            const int nM = (ntiles - t0) < tpp ? (ntiles - t0) : tpp;
            unsigned char* mb = (unsigned char*)p->mact + (size_t)(q & 1) * mbuf;
            for (int rp = 0; rp < RPT_GEMM; ++rp) { MoeOrder mo; mo.init(t0, nM, 2 * FFE / 256, p->tile_e, nb, bid); Gemm g{p->hn, (const bf16_t*)p->w8_mgu, p->arow}; EpiSwigluS8 e{mb, FFE, t0 * 256, p->sslot, p->ws_mgu, p->shs}; gemm_phase<DM, EpiSwigluS8, MoeOrder, true>(lds, g, mo, e, wv); }
            GRID_BARRIER();
            for (int rp = 0; rp < RPT_GEMM; ++rp) { MoeOrder mo; mo.init(t0, nM, DM / 256, p->tile_e, nb, bid); Gemm g{(const bf16_t*)((const unsigned char*)mb - (size_t)t0 * 256 * FFE), (const bf16_t*)p->w8_md, nullptr}; EpiBf16S e{p->yslot, DM, p->shs, p->ws_md}; gemm_phase<FFE, EpiBf16S, MoeOrder, true>(lds, g, mo, e, wv); }
        }
        GRID_BARRIER();
    }
    LAUNDER(p);
    phase_final(p, p->hb3, 0, NTOK, bid, nb, wv);
}

static inline size_t al256(size_t x) { return (x + 255) & ~(size_t)255; }

extern "C" void kernel_launch(void* const* d_in, const int* in_sizes, int n_in, void* d_out, int out_size, void* d_ws, size_t ws_size, hipStream_t stream) {
    Params p; memset(&p, 0, sizeof(p));
    p.x = (const float*)d_in[0]; p.mix_norm = (const float*)d_in[1]; p.ffn_norm = (const float*)d_in[2]; p.w_in = (const float*)d_in[3]; p.conv_w = (const float*)d_in[4];
    p.a_log = (const float*)d_in[5]; p.dt_bias = (const float*)d_in[6]; p.ret_norm = (const float*)d_in[7]; p.gdn_norm = (const float*)d_in[8]; p.w_out0 = (const float*)d_in[9];
    p.w_qkv = (const float*)d_in[10]; p.w_out1 = (const float*)d_in[11]; p.w_gate0 = (const float*)d_in[12]; p.w_up0 = (const float*)d_in[13]; p.w_down0 = (const float*)d_in[14];
    p.w_router = (const float*)d_in[15]; p.w_mgate = (const float*)d_in[16]; p.w_mup = (const float*)d_in[17]; p.w_mdown = (const float*)d_in[18]; p.final_norm = (const float*)d_in[19];
    p.out = (float*)d_out; p.hb = (bf16_t*)((unsigned char*)d_out + (size_t)NTOK * DM * 2);
    unsigned char* w = (unsigned char*)d_ws; size_t off = 0;
    auto take = [&](size_t bytes) { unsigned char* r = w + off; off += al256(bytes); return r; };
    p.ctrl = (unsigned*)take(4096); p.bar = (unsigned*)take((size_t)XCD_BAR_WORDS * 4);
    p.wt_in = (bf16_t*)take((size_t)DINP * DM * 2); p.wt_out0 = (bf16_t*)take((size_t)DM * DM * 2); p.wt_gu0 = (bf16_t*)take((size_t)2 * FF * DM * 2); p.wt_d0 = (bf16_t*)take((size_t)DM * FF * 2);
    p.wt_qkv = (bf16_t*)take((size_t)3072 * DM * 2); p.wt_out1 = (bf16_t*)take((size_t)DM * DM * 2);
    p.hn = (bf16_t*)take((size_t)NTOK * DM * 2);
    p.gflag = (unsigned*)take((size_t)NCHH * 4);
    p.retL = (float*)take((size_t)BATCH * 4 * NG * 128 * 128 * 4);
    p.gbeta = (float*)take((size_t)NTOK * 4 * 4); p.gg = (float*)take((size_t)NTOK * 4 * 4);
    p.arow = (int*)take((size_t)MAXTILES * 256 * 4); p.tile_e = (int*)take((size_t)MAXTILES * 4); p.slot_of = (int*)take((size_t)NTOK * 2 * 4); p.mgate = (float*)take((size_t)NTOK * 2 * 4); p.midx = (int*)take((size_t)NTOK * 2 * 4); p.wghist = (unsigned*)take((size_t)4096 * 8 * 4);
    p.w8_gu0 = take(FP8_FFN0 ? (size_t)2 * FF * DM : (size_t)256); p.ws_gu0 = (float*)take((size_t)2 * FF * 4); p.ws_mgu = (float*)take((size_t)NE * 2 * FFE * 4); p.hns = (float*)take((size_t)NTOK * 4); p.sslot = (float*)take((size_t)MAXTILES * 256 * 4);
    p.ws_md = (float*)take((size_t)NE * DM * 4); p.hnn2 = (float*)take((size_t)NTOK * 4); p.shs = (float*)take((size_t)MAXTILES * 256 * 4);
    p.kmh = (bf16_t*)take((size_t)NIT * 128 * 2); p.kml = (bf16_t*)take((size_t)NIT * 128 * 2); p.mcount = (unsigned*)take((size_t)NIT * 4);
    p.arena = w + off;
    const size_t arena_bytes = ws_size - off;
    { size_t a = 0; auto at = [&](size_t bytes) { unsigned char* r = p.arena + a; a += al256(bytes); return r; };
      p.proj = (bf16_t*)at((size_t)NTOK * DINP * 2);
      p.gimg = (unsigned char*)at((size_t)NCHH * IMG_CH); p.gcdec = (float*)at((size_t)NCHH * 4);
      if (a > arena_bytes) fprintf(stderr, "workspace too small (layer0): need %zu have %zu\n", a, arena_bytes); }
    p.act0 = (bf16_t*)p.arena;
    { size_t a = 0; auto at = [&](size_t bytes) { unsigned char* r = p.arena + a; a += al256(bytes); return r; };
      p.qkv = (bf16_t*)at((size_t)NTOK * 3072 * 2); p.part_o = (bf16_t*)at((size_t)NTOK * 8 * 3 * 128 * 2); p.part_lse = (float*)at((size_t)NTOK * 8 * 3 * 4); p.mlist = (unsigned short*)at((size_t)BATCH * 8 * LTOT * 2);
      if (a > arena_bytes) fprintf(stderr, "workspace too small (layer1): need %zu have %zu\n", a, arena_bytes); }
    { size_t a = 0; auto at = [&](size_t bytes) { unsigned char* r = p.arena + a; a += al256(bytes); return r; };
      p.w8_mgu = at((size_t)NE * 2 * FFE * DM); p.w8_md = at((size_t)NE * DM * FFE); p.yslot = (bf16_t*)at((size_t)MAXTILES * 256 * DM * 2);
      p.hb3 = (bf16_t*)at((size_t)NTOK * DM * 2);
      p.mact = (bf16_t*)(p.arena + a);
      p.wt_mgu = nullptr; p.wt_md_tmp = p.mact; p.wt_md = nullptr;
      const size_t rest = arena_bytes > a ? arena_bytes - a : 0;
      if (rest < (size_t)NE * FFE * DM * 2) fprintf(stderr, "workspace too small (moe weights)\n");
      long tiles = (long)(rest / ((size_t)2 * 256 * FFE));
      if (tiles > 64) tiles = 64;
      if (tiles < 1) { fprintf(stderr, "workspace too small (moe)\n"); tiles = 1; }
#ifdef CPU_EMU
      if (getenv("EMU_TPP")) tiles = atoi(getenv("EMU_TPP"));
#endif
      p.tiles_per_pass = (int)tiles; }
#ifdef CPU_EMU
    emu::reg("hn", p.hn, (size_t)NTOK * DM * 2, "bf16"); emu::reg("proj", p.proj, (size_t)NTOK * DINP * 2, "bf16");
    emu::reg("gbeta", p.gbeta, (size_t)NTOK * 16, "f32"); emu::reg("gg", p.gg, (size_t)NTOK * 16, "f32"); emu::reg("midx", p.midx, (size_t)NTOK * 8, "i32");
    const int grid_blocks = getenv("EMU_GRID") ? atoi(getenv("EMU_GRID")) : 8;
    emu::launch(grid_blocks, NTHREADS, kDynLds, [=]() { fwd_megakernel(p); }, true);
#else
    static int grid_blocks = 0;
    if (!grid_blocks) {
        int dev = 0, cus = 0, per_cu = 0;
        (void)hipGetDevice(&dev);
        (void)hipDeviceGetAttribute(&cus, hipDeviceAttributeMultiprocessorCount, dev);
        (void)hipFuncSetAttribute((const void*)fwd_megakernel, hipFuncAttributeMaxDynamicSharedMemorySize, (int)kDynLds);
        (void)hipOccupancyMaxActiveBlocksPerMultiprocessor(&per_cu, fwd_megakernel, NTHREADS, kDynLds);
        if (per_cu < 1) per_cu = 1;
        grid_blocks = cus;
    }
    (void)hipMemsetAsync(p.bar, 0, (size_t)XCD_BAR_WORDS * 4, stream);
    void* args[] = {&p};
    hipError_t e = hipLaunchCooperativeKernel((const void*)fwd_megakernel, dim3(grid_blocks), dim3(NTHREADS), args, kDynLds, stream);
    if (e != hipSuccess) fprintf(stderr, "cooperative launch failed: %s (grid %d)\n", hipGetErrorString(e), grid_blocks);
#endif
}
```

```cpp
#ifndef CPU_EMU
#include <hip/hip_runtime.h>
#include <hip/hip_cooperative_groups.h>
#include <cstdio>
#include <cstring>
#define LAS __attribute__((address_space(3)))
#define WAVE_SYNC() __builtin_amdgcn_wave_barrier()
#define SCHED_FENCE() __builtin_amdgcn_sched_barrier(0)
#define OPAQUE_V(x) asm volatile("" : "+v"(x))
static __device__ __forceinline__ unsigned shfl_up_u(unsigned v, int o, int lane) { const int src = lane >= o ? lane - o : lane; return (unsigned)__builtin_amdgcn_ds_bpermute(src << 2, (int)v); }
static __device__ __forceinline__ float shfl_up_f(float v, int o, int lane) { return __uint_as_float(shfl_up_u(__float_as_uint(v), o, lane)); }
#define LDS_ATOMIC_ADD(ptr, v) __hip_atomic_fetch_add((ptr), (v), __ATOMIC_RELAXED, __HIP_MEMORY_SCOPE_WORKGROUP)
#define LDS_ATOMIC_MAX(ptr, v) __hip_atomic_fetch_max((ptr), (v), __ATOMIC_RELAXED, __HIP_MEMORY_SCOPE_WORKGROUP)
#define GLOBAL_ATOMIC_MAX(ptr, v) __hip_atomic_fetch_max((ptr), (v), __ATOMIC_RELAXED, __HIP_MEMORY_SCOPE_AGENT)
static __device__ __forceinline__ int opaque_tid(int wv) { int l; asm volatile("v_mbcnt_lo_u32_b32 %0, -1, 0\n\tv_mbcnt_hi_u32_b32 %0, -1, %0" : "=v"(l)); return (wv << 6) | l; }
#else
static inline int opaque_tid(int) { return threadIdx.x; }
#define LAS
#define WAVE_SYNC() ((void)__ballot(1))
#define SCHED_FENCE() ((void)0)
#define OPAQUE_V(x) ((void)0)
static inline unsigned shfl_up_u(unsigned v, int o, int lane) { return __shfl(v, lane >= o ? lane - o : lane); }
static inline float shfl_up_f(float v, int o, int lane) { return __shfl(v, lane >= o ? lane - o : lane); }
static inline unsigned emu_fetch_add(unsigned* p, unsigned v) { unsigned o = *p; *p = o + v; return o; }
#define LDS_ATOMIC_ADD(ptr, v) emu_fetch_add((ptr), (v))
static inline unsigned emu_fetch_max(unsigned* p, unsigned v) { unsigned o = *p; if (v > o) *p = v; return o; }
#define LDS_ATOMIC_MAX(ptr, v) emu_fetch_max((ptr), (v))
#define GLOBAL_ATOMIC_MAX(ptr, v) atomicMax((ptr), (v))
#endif
namespace cg = cooperative_groups;

#ifndef RPT_SYNC
#define RPT_SYNC 0
#endif
#ifndef RPT_SG
#define RPT_SG 1
#endif
#ifndef RPT_SR
#define RPT_SR 1
#endif
#ifndef RPT_MG
#define RPT_MG 1
#endif
#ifndef RPT_MO
#define RPT_MO 1
#endif
#ifndef RPT_GEMM
#define RPT_GEMM 1
#endif
#ifndef RPT_GDN
#define RPT_GDN 1
#endif
#ifndef RPT_SCAN
#define RPT_SCAN 1
#endif
#ifndef RPT_MOBA
#define RPT_MOBA 1
#endif
#ifndef RPT_CONV
#define RPT_CONV 1
#endif
#ifndef FP8_FFN0
#define FP8_FFN0 0
#endif
#ifndef CFG_SEQ
#define CFG_SEQ 16384
#define CFG_BATCH 2
#define CFG_FF 2816
#define CFG_FFE 3584
#endif

typedef unsigned short bf16_t;
typedef short bf16x8 __attribute__((ext_vector_type(8)));
typedef float f32x4 __attribute__((ext_vector_type(4)));
typedef float f32x16 __attribute__((ext_vector_type(16)));
typedef unsigned u32x4 __attribute__((ext_vector_type(4)));
typedef unsigned u32x2 __attribute__((ext_vector_type(2)));

constexpr int DM = 1024, SEQ = CFG_SEQ, BATCH = CFG_BATCH, NTOK = SEQ * BATCH, HD = 128;
constexpr int DIN = 4104, DINP = 4096, FF = CFG_FF, FFE = CFG_FFE, NE = 8;
constexpr int NCH = SEQ / 64, NBLK = SEQ / 256, NCHH = BATCH * 4 * NCH;
constexpr int NTHREADS = 512;
constexpr int BM = 256, BK = 64, HALF = 128, HTB = HALF * BK * 2, STAGE_BYTES = 8 * HTB, NXCD = 8, WGM = 4;
constexpr size_t kDynLds = 144 * 1024;
constexpr int MAXTILES = NTOK * 2 / 256 + NE;
constexpr int NIT = BATCH * 8 * NBLK;
constexpr int LTOT = NBLK * SEQ - 128 * NBLK * (NBLK + 1);
static_assert(SEQ <= 16384, "16-bit selection-list entries");
constexpr int GNT = (NBLK + 15) / 16;
constexpr int KS_STRIDE = 272, VT_STRIDE = 520;
constexpr int KS_BYTES = 256 * KS_STRIDE, VT_BYTES = 128 * VT_STRIDE;
__host__ __device__ __forceinline__ int list_off(int j) { return j * SEQ - 128 * j * (j + 1); }
constexpr float NORM_EPS = 1e-6f;

__device__ __forceinline__ bf16_t f2bf(float f) { unsigned u = __float_as_uint(f); u += 0x7FFFu + ((u >> 16) & 1u); return (bf16_t)(u >> 16); }
__device__ __forceinline__ float bf2f(bf16_t h) { return __uint_as_float(((unsigned)h) << 16); }
#ifndef CPU_EMU
typedef __bf16 hwbf16x2 __attribute__((ext_vector_type(2)));
typedef float f32x2v __attribute__((ext_vector_type(2)));
__device__ __forceinline__ unsigned pack2(float lo, float hi) { f32x2v v; v.x = lo; v.y = hi; hwbf16x2 b = __builtin_convertvector(v, hwbf16x2); unsigned r; __builtin_memcpy(&r, &b, 4); return r; }
#else
__device__ __forceinline__ unsigned pack2(float lo, float hi) { return (unsigned)f2bf(lo) | ((unsigned)f2bf(hi) << 16); }
#endif
#ifndef CPU_EMU
__device__ __forceinline__ float siluf(float x) { return x * __builtin_amdgcn_rcpf(1.0f + __builtin_amdgcn_exp2f(-1.4426950408889634f * x)); }
#else
__device__ __forceinline__ float siluf(float x) { return x / (1.0f + __expf(-x)); }
#endif
#ifndef CPU_EMU
__device__ __forceinline__ unsigned pack4_fp8(float a, float b, float c, float d) { int r = 0; r = __builtin_amdgcn_cvt_pk_fp8_f32(a, b, r, false); r = __builtin_amdgcn_cvt_pk_fp8_f32(c, d, r, true); return (unsigned)r; }
#else
static inline float fp8_to_f(unsigned char v) { const int s = v >> 7, e = (v >> 3) & 15, m = v & 7; const float a = e == 0 ? ldexpf((float)m, -9) : ldexpf((float)(8 + m), e - 10); return s ? -a : a; }
static inline unsigned char f_to_fp8(float x) {
    const unsigned s = x < 0.f ? 0x80u : 0u; float a = fabsf(x); if (!(a == a)) return 0x7f; if (a > 448.f) a = 448.f; if (a == 0.f) return (unsigned char)s;
    int e; (void)frexpf(a, &e); e -= 1; if (e < -6) e = -6;
    const float step = ldexpf(1.f, e - 3); float q = nearbyintf(a / step) * step; if (q > 448.f) q = 448.f;
    int e2; (void)frexpf(q, &e2); e2 -= 1; unsigned bits;
    if (q < ldexpf(1.f, -6)) bits = (unsigned)nearbyintf(q * 512.f); else bits = ((unsigned)(e2 + 7) << 3) | ((unsigned)nearbyintf(q / ldexpf(1.f, e2 - 3)) - 8u);
    return (unsigned char)(s | bits);
}
static inline unsigned pack4_fp8(float a, float b, float c, float d) { return (unsigned)f_to_fp8(a) | ((unsigned)f_to_fp8(b) << 8) | ((unsigned)f_to_fp8(c) << 16) | ((unsigned)f_to_fp8(d) << 24); }
#endif
constexpr float FP8_TOP = 384.f;
__device__ __forceinline__ f32x4 silu_mul4(const f32x4 g, const f32x4 u) {
    const f32x4 t = g * -1.4426950408889634f;
    f32x4 e;
#ifndef CPU_EMU
    e[0] = __builtin_amdgcn_exp2f(t[0]); e[1] = __builtin_amdgcn_exp2f(t[1]); e[2] = __builtin_amdgcn_exp2f(t[2]); e[3] = __builtin_amdgcn_exp2f(t[3]);
#else
    e[0] = exp2f(t[0]); e[1] = exp2f(t[1]); e[2] = exp2f(t[2]); e[3] = exp2f(t[3]);
#endif
    const f32x4 d = e + 1.0f;
    f32x4 r; r[0] = __builtin_amdgcn_rcpf(d[0]); r[1] = __builtin_amdgcn_rcpf(d[1]); r[2] = __builtin_amdgcn_rcpf(d[2]); r[3] = __builtin_amdgcn_rcpf(d[3]);
    return (g * r) * u;
}
#ifndef CPU_EMU
__device__ __forceinline__ float wave_sum(float s) { int l; asm volatile("v_mbcnt_lo_u32_b32 %0, -1, 0\n\tv_mbcnt_hi_u32_b32 %0, -1, %0" : "=v"(l));
#pragma unroll
    for (int o = 32; o >= 1; o >>= 1) s += __uint_as_float((unsigned)__builtin_amdgcn_ds_bpermute((l ^ o) << 2, (int)__float_as_uint(s))); return s; }
__device__ __forceinline__ float wave_max(float s) { int l; asm volatile("v_mbcnt_lo_u32_b32 %0, -1, 0\n\tv_mbcnt_hi_u32_b32 %0, -1, %0" : "=v"(l));
#pragma unroll
    for (int o = 32; o >= 1; o >>= 1) s = fmaxf(s, __uint_as_float((unsigned)__builtin_amdgcn_ds_bpermute((l ^ o) << 2, (int)__float_as_uint(s)))); return s; }
#else
__device__ __forceinline__ float wave_sum(float s) { for (int o = 32; o >= 1; o >>= 1) s += __shfl_xor(s, o); return s; }
__device__ __forceinline__ float wave_max(float s) { for (int o = 32; o >= 1; o >>= 1) s = fmaxf(s, __shfl_xor(s, o)); return s; }
#endif

struct Params;
#ifndef CPU_EMU
typedef const __attribute__((address_space(4))) Params* KPTR;
#define KARG_PTR(arg) ((KPTR)__builtin_amdgcn_kernarg_segment_ptr())
#define LAUNDER(q) asm volatile("" : "+s"(q))
#else
typedef const Params* KPTR;
#define KARG_PTR(arg) (&(arg))
#define LAUNDER(q) ((void)0)
#endif
struct Params {
    const float* x; const float* mix_norm; const float* ffn_norm; const float* w_in; const float* conv_w; const float* a_log; const float* dt_bias;
    const float* ret_norm; const float* gdn_norm; const float* w_out0; const float* w_qkv; const float* w_out1; const float* w_gate0; const float* w_up0;
    const float* w_down0; const float* w_router; const float* w_mgate; const float* w_mup; const float* w_mdown; const float* final_norm;
    float* out;
    bf16_t* hb;
    bf16_t* hb3;
    unsigned* ctrl;
    unsigned* bar;
    bf16_t* wt_in; bf16_t* wt_out0; bf16_t* wt_gu0; bf16_t* wt_d0; bf16_t* wt_qkv; bf16_t* wt_out1;
    bf16_t* hn;
    float* gbeta; float* gg;
    float* retL;
    unsigned* gflag;
    unsigned char* arena;
    bf16_t* proj; unsigned char* gimg; float* gcdec;
    bf16_t* act0;
    bf16_t* qkv; bf16_t* kmh; bf16_t* kml; unsigned* mcount; unsigned short* mlist; bf16_t* part_o; float* part_lse;
    bf16_t* wt_mgu; bf16_t* wt_md; bf16_t* yslot; bf16_t* mact; int* arow; int* tile_e; int* slot_of; float* mgate; int* midx; unsigned* wghist;
    unsigned char* w8_gu0; float* ws_gu0; unsigned char* w8_mgu; float* ws_mgu; float* hns; float* sslot; unsigned char* w8_md; float* ws_md; float* hnn2; float* sn2; float* shs; bf16_t* wt_md_tmp;
    int tiles_per_pass; int pad0;
};

#define C_CNT(e) (64 + (e))
#define C_CUR(e) (128 + (e))
#define C_NTILES 192
#define C_GMAX 216
#define C_UMAX 224
#define C_TB 200

__host__ __device__ __forceinline__ int lds_byte(int r, int c) { const int st = (r >> 4) * 2 + (c >> 5), rr = r & 15, cc = c & 31, ob = rr * 64 + cc * 2; return st * 1024 + (ob ^ (((ob >> 9) & 1) << 5)); }
__host__ __device__ __forceinline__ void stage_rc(int b, int& R, int& C) { const int st = b / 1024, sb = b % 1024, swz = sb ^ (((sb >> 9) & 1) << 5); R = (st >> 1) * 16 + swz / 64; C = (st & 1) * 32 + (swz % 64) / 2; }
__host__ __device__ __forceinline__ int perm32(int rho) { const int n = rho >> 4, i = rho & 15; return 8 * (i >> 2) + 4 * n + (i & 3); }

#ifndef CPU_EMU
extern __shared__ __attribute__((aligned(16))) unsigned char smem_raw[];
#define GET_LDS() ((LAS unsigned char*)smem_raw)
#define GLDS4(src, dst) __builtin_amdgcn_global_load_lds((const unsigned*)(src), (LAS unsigned*)(dst), 4, 0, 0)
#else
#define GET_LDS() (emu::blk->smem)
#endif
constexpr int LS_OFF = 128 * 1024 + 1024;
#define LS_PTR() ((LAS const float*)(GET_LDS() + LS_OFF))
struct Unit { int pm, pn, pnb; };
struct Gemm { const bf16_t* A; const bf16_t* Bt; const int* arow; };

struct StaticOrder {
    int nM, nN, nwg, G, c;
    __device__ void init(int nM_, int nN_, int G_, int c_) { nM = nM_; nN = nN_; nwg = nM * nN; G = G_; c = c_; }
    __device__ bool next(int i, Unit& u) const {
        const long L = (long)i * G + c; if (L >= nwg) return false;
        int wgid = (int)L; { const int q = nwg / NXCD, r = nwg % NXCD, xcd = wgid % NXCD, off = wgid / NXCD; wgid = (xcd < r ? xcd * (q + 1) : r * (q + 1) + (xcd - r) * q) + off; }
        const int nig = WGM * nN, gid = wgid / nig, fm = gid * WGM, gsz = (nM - fm) < WGM ? (nM - fm) : WGM;
        u.pm = fm + ((wgid % nig) % gsz); u.pn = (wgid % nig) / gsz; u.pnb = u.pn; return true;
    }
};
struct MoeOrder {
    StaticOrder so; int t0; const int* tile_e;
    __device__ void init(int t0_, int nM_, int nN_, const int* te, int G_, int c_) { so.init(nM_, nN_, G_, c_); t0 = t0_; tile_e = te; }
    __device__ bool next(int i, Unit& u) const { if (!so.next(i, u)) return false; u.pm += t0; u.pnb = tile_e[u.pm] * so.nN + u.pn; return true; }
};

struct EpiBf16 {
    static constexpr bool PERM = true;
    static constexpr bool LSCALE = false;
    bf16_t* O; int ldc; int rowbase;
    __device__ __forceinline__ void operator()(const f32x4 (&acc)[2][2][4][2], const Unit& u, int wr, int wc, int fr, int fq) const {
        const int row0 = u.pm * BM + wr * 64 + fr - rowbase, col0 = u.pn * BM + wc * 32 + 8 * fq;
#pragma unroll
        for (int ai = 0; ai < 2; ++ai)
#pragma unroll
            for (int m = 0; m < 4; ++m) { bf16_t* rowp = O + (size_t)(row0 + ai * HALF + m * 16) * ldc + col0;
#pragma unroll
                for (int bj = 0; bj < 2; ++bj) { const f32x4 v0 = acc[ai][bj][m][0], v1 = acc[ai][bj][m][1];
                    u32x4 w; w.x = pack2(v0[0], v0[1]); w.y = pack2(v0[2], v0[3]); w.z = pack2(v1[0], v1[1]); w.w = pack2(v1[2], v1[3]);
                    *(u32x4*)(rowp + bj * HALF) = w; } }
    }
};
struct EpiSwiglu {
    static constexpr bool PERM = true;
    static constexpr bool LSCALE = false;
    bf16_t* O; int ldc; int rowbase;
    __device__ __forceinline__ void operator()(const f32x4 (&acc)[2][2][4][2], const Unit& u, int wr, int wc, int fr, int fq) const {
        const int row0 = u.pm * BM + wr * 64 + fr - rowbase, col0 = u.pn * HALF + wc * 32 + 8 * fq;
#pragma unroll
        for (int ai = 0; ai < 2; ++ai)
#pragma unroll
            for (int m = 0; m < 4; ++m) { bf16_t* rowp = O + (size_t)(row0 + ai * HALF + m * 16) * ldc + col0;
                float r[8];
#pragma unroll
                for (int n = 0; n < 2; ++n) { const f32x4 h4 = silu_mul4(acc[ai][0][m][n], acc[ai][1][m][n]); r[n * 4] = h4[0]; r[n * 4 + 1] = h4[1]; r[n * 4 + 2] = h4[2]; r[n * 4 + 3] = h4[3]; }
                u32x4 w; w.x = pack2(r[0], r[1]); w.y = pack2(r[2], r[3]); w.z = pack2(r[4], r[5]); w.w = pack2(r[6], r[7]);
                *(u32x4*)rowp = w; }
    }
};
struct EpiSwigluS {
    static constexpr bool PERM = true;
    static constexpr bool LSCALE = false;
    bf16_t* O; int ldc; int rowbase; const float* sa; const float* sb;
    __device__ __forceinline__ void operator()(const f32x4 (&acc)[2][2][4][2], const Unit& u, int wr, int wc, int fr, int fq) const {
        const int rowg = u.pm * BM + wr * 64 + fr, row0 = rowg - rowbase, col0 = u.pn * HALF + wc * 32 + 8 * fq;
        const float* sbp = sb + (size_t)u.pnb * BM + wc * 32 + 8 * fq;
        f32x4 sg[2], su[2];
#pragma unroll
        for (int n = 0; n < 2; ++n) { sg[n] = *(const f32x4*)(sbp + 4 * n); su[n] = *(const f32x4*)(sbp + HALF + 4 * n); }
        float ra[2][4];
#pragma unroll
        for (int ai = 0; ai < 2; ++ai)
#pragma unroll
            for (int m = 0; m < 4; ++m) ra[ai][m] = sa[rowg + ai * HALF + m * 16];
#pragma unroll
        for (int ai = 0; ai < 2; ++ai)
#pragma unroll
            for (int m = 0; m < 4; ++m) { bf16_t* rowp = O + (size_t)(row0 + ai * HALF + m * 16) * ldc + col0;
                float r[8];
#pragma unroll
                for (int n = 0; n < 2; ++n)
#pragma unroll
                    for (int j = 0; j < 4; ++j) r[n * 4 + j] = siluf(acc[ai][0][m][n][j] * (ra[ai][m] * sg[n][j])) * (acc[ai][1][m][n][j] * (ra[ai][m] * su[n][j]));
                u32x4 w; w.x = pack2(r[0], r[1]); w.y = pack2(r[2], r[3]); w.z = pack2(r[4], r[5]); w.w = pack2(r[6], r[7]);
                *(u32x4*)rowp = w; }
    }
};
struct EpiSwigluS8 {
    static constexpr bool PERM = true;
    static constexpr bool LSCALE = true;
    unsigned char* O8; int ldc; int rowbase; const float* sa; const float* sb; const float* so;
    __device__ __forceinline__ void prefetch(const Unit& u, int tid, int wid) const {
#ifndef CPU_EMU
        LAS unsigned char* d = (LAS unsigned char*)LS_PTR() + wid * 256;
        GLDS4(sa + (size_t)u.pm * BM + tid, d); GLDS4(so + (size_t)u.pm * BM + tid, d + 1024); GLDS4(sb + (size_t)u.pnb * BM + tid, d + 2048);
#else
        float* d = (float*)LS_PTR(); d[tid] = sa[(size_t)u.pm * BM + tid]; d[256 + tid] = so[(size_t)u.pm * BM + tid]; d[512 + tid] = sb[(size_t)u.pnb * BM + tid];
#endif
    }
    __device__ __forceinline__ void operator()(const f32x4 (&acc)[2][2][4][2], const Unit& u, int wr, int wc, int fr, int fq) const {
        const int rowg = u.pm * BM + wr * 64 + fr, row0 = rowg - rowbase, col0 = u.pn * HALF + wc * 32 + 8 * fq;
        LAS const float* ls = LS_PTR(); LAS const float* sbp = ls + 512 + wc * 32 + 8 * fq;
        f32x4 sg[2], su[2];
#pragma unroll
        for (int n = 0; n < 2; ++n) { sg[n] = *(LAS const f32x4*)(sbp + 4 * n); su[n] = *(LAS const f32x4*)(sbp + HALF + 4 * n); }
        float ra[2][4], ro[2][4];
#pragma unroll
        for (int ai = 0; ai < 2; ++ai)
#pragma unroll
            for (int m = 0; m < 4; ++m) { const int rl = wr * 64 + fr + ai * HALF + m * 16; ra[ai][m] = ls[rl]; const float so_ = ls[256 + rl]; ro[ai][m] = so_ > 0.f ? __builtin_amdgcn_rcpf(so_) : 0.f; }
#pragma unroll
        for (int ai = 0; ai < 2; ++ai)
#pragma unroll
            for (int m = 0; m < 4; ++m) { unsigned char* rowp = O8 + (size_t)(row0 + ai * HALF + m * 16) * ldc + col0;
                float r[8];
#pragma unroll
                for (int n = 0; n < 2; ++n) { const f32x4 h4 = silu_mul4(acc[ai][0][m][n] * (sg[n] * ra[ai][m]), acc[ai][1][m][n] * (su[n] * (ra[ai][m] * ro[ai][m])));
                    r[n * 4] = h4[0]; r[n * 4 + 1] = h4[1]; r[n * 4 + 2] = h4[2]; r[n * 4 + 3] = h4[3]; }
                u32x2 w; w.x = pack4_fp8(r[0], r[1], r[2], r[3]); w.y = pack4_fp8(r[4], r[5], r[6], r[7]);
                *(u32x2*)rowp = w; }
    }
};
struct EpiBf16S {
    static constexpr bool PERM = true;
    static constexpr bool LSCALE = true;
    bf16_t* O; int ldc; const float* sa; const float* sb;
    __device__ __forceinline__ void prefetch(const Unit& u, int tid, int wid) const {
#ifndef CPU_EMU
        LAS unsigned char* d = (LAS unsigned char*)LS_PTR() + wid * 256;
        GLDS4(sa + (size_t)u.pm * BM + tid, d); GLDS4(sb + (size_t)u.pnb * BM + tid, d + 2048);
#else
        float* d = (float*)LS_PTR(); d[tid] = sa[(size_t)u.pm * BM + tid]; d[512 + tid] = sb[(size_t)u.pnb * BM + tid];
#endif
    }
    __device__ __forceinline__ void operator()(const f32x4 (&acc)[2][2][4][2], const Unit& u, int wr, int wc, int fr, int fq) const {
        const int row0 = u.pm * BM + wr * 64 + fr, col0 = u.pn * BM + wc * 32 + 8 * fq;
        LAS const float* ls = LS_PTR(); LAS const float* sbp = ls + 512 + wc * 32 + 8 * fq;
        f32x4 sv[2][2];
#pragma unroll
        for (int bj = 0; bj < 2; ++bj)
#pragma unroll
            for (int n = 0; n < 2; ++n) sv[bj][n] = *(LAS const f32x4*)(sbp + bj * HALF + 4 * n);
#pragma unroll
        for (int ai = 0; ai < 2; ++ai)
#pragma unroll
            for (int m = 0; m < 4; ++m) { bf16_t* rowp = O + (size_t)(row0 + ai * HALF + m * 16) * ldc + col0; const float ra = ls[wr * 64 + fr + ai * HALF + m * 16];
#pragma unroll
                for (int bj = 0; bj < 2; ++bj) { const f32x4 v0 = acc[ai][bj][m][0] * sv[bj][0] * ra, v1 = acc[ai][bj][m][1] * sv[bj][1] * ra;
                    u32x4 w; w.x = pack2(v0[0], v0[1]); w.y = pack2(v0[2], v0[3]); w.z = pack2(v1[0], v1[1]); w.w = pack2(v1[2], v1[3]);
                    *(u32x4*)(rowp + bj * HALF) = w; } }
    }
};
template <bool F32BASE>
struct EpiResBf16 {
    static constexpr bool PERM = true;
    static constexpr bool LSCALE = false;
    const float* basef; const bf16_t* baseb; bf16_t* out;
    __device__ __forceinline__ void operator()(const f32x4 (&acc)[2][2][4][2], const Unit& u, int wr, int wc, int fr, int fq) const {
        const int row0 = u.pm * BM + wr * 64 + fr, col0 = u.pn * BM + wc * 32 + 8 * fq;
#pragma unroll
        for (int ai = 0; ai < 2; ++ai)
#pragma unroll
            for (int m = 0; m < 4; ++m) { const size_t off = (size_t)(row0 + ai * HALF + m * 16) * DM + col0;
#pragma unroll
                for (int bj = 0; bj < 2; ++bj) { f32x4 b0, b1;
                    if (F32BASE) { b0 = *(const f32x4*)(basef + off + bj * HALF); b1 = *(const f32x4*)(basef + off + bj * HALF + 4); }
                    else { const u32x4 w = *(const u32x4*)(baseb + off + bj * HALF);
                        b0[0] = __uint_as_float(w.x << 16); b0[1] = __uint_as_float(w.x & 0xffff0000u); b0[2] = __uint_as_float(w.y << 16); b0[3] = __uint_as_float(w.y & 0xffff0000u);
                        b1[0] = __uint_as_float(w.z << 16); b1[1] = __uint_as_float(w.z & 0xffff0000u); b1[2] = __uint_as_float(w.w << 16); b1[3] = __uint_as_float(w.w & 0xffff0000u); }
                    const f32x4 v0 = acc[ai][bj][m][0] + b0, v1 = acc[ai][bj][m][1] + b1;
                    u32x4 o; o.x = pack2(v0[0], v0[1]); o.y = pack2(v0[2], v0[3]); o.z = pack2(v1[0], v1[1]); o.w = pack2(v1[2], v1[3]);
                    *(u32x4*)(out + off + bj * HALF) = o; } }
    }
};
struct EpiResF32 {
    static constexpr bool PERM = false;
    static constexpr bool LSCALE = false;
    const float* base; float* out; int ldc;
    __device__ __forceinline__ void operator()(const f32x4 (&acc)[2][2][4][2], const Unit& u, int wr, int wc, int fr, int fq) const {
        const int row0 = u.pm * BM + wr * 64 + fr, col0 = u.pn * BM + wc * 32 + 4 * fq;
#pragma unroll
        for (int ai = 0; ai < 2; ++ai)
#pragma unroll
            for (int m = 0; m < 4; ++m) { const size_t off = (size_t)(row0 + ai * HALF + m * 16) * ldc + col0;
#pragma unroll
                for (int bj = 0; bj < 2; ++bj)
#pragma unroll
                    for (int n = 0; n < 2; ++n) { const f32x4 b = *(const f32x4*)(base + off + bj * HALF + n * 16); *(f32x4*)(out + off + bj * HALF + n * 16) = b + acc[ai][bj][m][n]; } }
    }
};

#ifndef CPU_EMU
typedef int i32x8 __attribute__((ext_vector_type(8)));
__device__ __forceinline__ i32x8 cat8(const bf16x8 lo, const bf16x8 hi) { u32x4 a, b; __builtin_memcpy(&a, &lo, 16); __builtin_memcpy(&b, &hi, 16); i32x8 r; r[0] = (int)a.x; r[1] = (int)a.y; r[2] = (int)a.z; r[3] = (int)a.w; r[4] = (int)b.x; r[5] = (int)b.y; r[6] = (int)b.z; r[7] = (int)b.w; return r; }
template <int K, class Epi, class Sched, bool FP8 = false, bool GATHER = false>
__device__ __forceinline__ void gemm_phase(LAS unsigned char* lds, const Gemm g, const Sched& S, const Epi& E, int wv) {
    const int tid = opaque_tid(wv), wid = __builtin_amdgcn_readfirstlane(tid >> 6), lane = tid & 63, wr = wid >> 2, wc = wid & 3, fr = lane & 15, fq = lane >> 4;
    constexpr int RB = FP8 ? K : 2 * K;
    constexpr int nt = RB / 128;
    static_assert(nt % 2 == 0 && nt >= 4, "k tiles");
    unsigned voffB[2];
#pragma unroll
    for (int i = 0; i < 2; ++i) { int R, C; stage_rc(tid * 16 + i * 8192, R, C); const int Rb = Epi::PERM ? ((R & ~31) + perm32(R & 31)) : R; voffB[i] = (unsigned)(Rb * RB + C * 2); }
    constexpr size_t kstep = (size_t)(BK * 2);
    constexpr size_t hstep = (size_t)HALF * RB;
    constexpr size_t tstep = 2 * hstep;
    const unsigned ldsw = (unsigned)wid * 1024u;
    const int aoffl = lds_byte(wr * 64 + fr, fq * 8), boffl = lds_byte(wc * 32 + fr, fq * 8);
    unsigned aoff[2][2];
#define G_LOADA(u) do { _Pragma("unroll") for (int _h = 0; _h < 2; ++_h) _Pragma("unroll") for (int _i = 0; _i < 2; ++_i) { int _R, _C; stage_rc(tid * 16 + _i * 8192, _R, _C); const int _r = (u).pm * BM + _h * HALF + _R; \
        const int _s = GATHER ? g.arow[_r] : _r; aoff[_h][_i] = (unsigned)(_s * RB + _C * 2); } } while (0)
#define G_SA(b, h) (((b) * 2 + (h)) * HTB)
#define G_SB(b, h) ((4 + (b) * 2 + (h)) * HTB)
#define G_STAGEB(bufoff, gbase) do { _Pragma("unroll") for (int _i = 0; _i < 2; ++_i) \
        __builtin_amdgcn_global_load_lds((const unsigned*)((const char*)(gbase) + voffB[_i]), (LAS unsigned*)(lds + (bufoff) + ldsw + _i * 8192), 16, 0, 0); } while (0)
#define G_STAGEA(bufoff, kt, h) do { _Pragma("unroll") for (int _i = 0; _i < 2; ++_i) \
        __builtin_amdgcn_global_load_lds((const unsigned*)((const char*)g.A + (size_t)(kt) * kstep + aoff[h][_i]), (LAS unsigned*)(lds + (bufoff) + ldsw + _i * 8192), 16, 0, 0); } while (0)
#define G_LDA(dst, b, h) do { _Pragma("unroll") for (int m = 0; m < 4; ++m) _Pragma("unroll") for (int k = 0; k < 2; ++k) dst[m][k] = *(const LAS bf16x8*)(lds + G_SA(b, h) + aoffl + m * 2048 + k * 1024); } while (0)
#define G_LDB(dst, b, h) do { _Pragma("unroll") for (int n = 0; n < 2; ++n) _Pragma("unroll") for (int k = 0; k < 2; ++k) dst[n][k] = *(const LAS bf16x8*)(lds + G_SB(b, h) + boffl + n * 2048 + k * 1024); } while (0)
#define G_MMA(ai, bj, At, Bt) do { if constexpr (FP8) __builtin_amdgcn_sched_barrier(0); __builtin_amdgcn_s_setprio(1); _Pragma("unroll") for (int m = 0; m < 4; ++m) _Pragma("unroll") for (int n = 0; n < 2; ++n) { \
        if constexpr (FP8) acc[ai][bj][m][n] = __builtin_amdgcn_mfma_scale_f32_16x16x128_f8f6f4(cat8(Bt[n][0], Bt[n][1]), cat8(At[m][0], At[m][1]), acc[ai][bj][m][n], 0, 0, 0, 0x7F7F7F7F, 0, 0x7F7F7F7F); \
        else { _Pragma("unroll") for (int k = 0; k < 2; ++k) acc[ai][bj][m][n] = __builtin_amdgcn_mfma_f32_16x16x32_bf16(Bt[n][k], At[m][k], acc[ai][bj][m][n], 0, 0, 0); } } \
        __builtin_amdgcn_s_setprio(0); if constexpr (FP8) __builtin_amdgcn_sched_barrier(0); } while (0)
#define G_WAIT_V(n) asm volatile("s_waitcnt vmcnt(" #n ")" ::: "memory")
#define G_WAIT_L(n) asm volatile("s_waitcnt lgkmcnt(" #n ")" ::: "memory")
#define G_BAR __builtin_amdgcn_s_barrier()
#define G_SCHED __builtin_amdgcn_sched_barrier(0)
    Unit cur, nxt; int ui = 0;
    if (!S.next(0, cur)) return;
    f32x4 acc[2][2][4][2];
#pragma unroll
    for (int a = 0; a < 2; ++a)
#pragma unroll
        for (int b = 0; b < 2; ++b)
#pragma unroll
            for (int m = 0; m < 4; ++m)
#pragma unroll
                for (int n = 0; n < 2; ++n) acc[a][b][m][n] = (f32x4){0.f, 0.f, 0.f, 0.f};
    bf16x8 At[4][2], B0[2][2], B1[2][2];
    const char* cB = (const char*)g.Bt + (size_t)cur.pnb * tstep;
    G_LOADA(cur);
    G_STAGEB(G_SB(0, 0), cB); G_STAGEA(G_SA(0, 0), 0, 0); G_STAGEB(G_SB(0, 1), cB + hstep); G_STAGEA(G_SA(0, 1), 0, 1);
    if (wr == 1) G_BAR;
    G_WAIT_V(4); G_BAR;
    G_STAGEB(G_SB(1, 0), cB + kstep); G_STAGEA(G_SA(1, 0), 1, 0); G_STAGEB(G_SB(1, 1), cB + hstep + kstep);
    G_WAIT_V(6); G_BAR;
    for (;;) {
        const bool has_next = S.next(ui + 1, nxt);
        const char* nB = has_next ? (const char*)g.Bt + (size_t)nxt.pnb * tstep : cB;
        for (int t = 0; t < nt; t += 2) {
            const bool last = (t == nt - 2);
            const int k2 = last ? 0 : t + 2, k3 = k2 + 1;
            const char* b2 = last ? nB : cB + (size_t)(t + 2) * kstep; const char* b3 = b2 + kstep;
            G_LDB(B0, 0, 0); G_SCHED; G_LDA(At, 0, 0); G_STAGEA(G_SA(1, 1), t + 1, 1);
            if constexpr (Epi::LSCALE) { if (t == nt - 4 && wid < BM / 64) { int t2 = tid; OPAQUE_V(t2); E.prefetch(cur, t2, wid); } }
            if (GATHER && has_next && t == nt - 4 && wid < BM / 64)
                __builtin_amdgcn_global_load_lds((const unsigned*)(g.arow + nxt.pm * BM + tid), (LAS unsigned*)(lds + STAGE_BYTES + wid * 256), 4, 0, 0);
            G_WAIT_L(8); G_BAR; G_WAIT_L(0); G_MMA(0, 0, At, B0); G_BAR; G_SCHED;
            if (last && has_next) {
                if constexpr (GATHER) {
#pragma unroll
                    for (int _h = 0; _h < 2; ++_h)
#pragma unroll
                        for (int _i = 0; _i < 2; ++_i) { int _R, _C; stage_rc(tid * 16 + _i * 8192, _R, _C); const int _s = *(LAS const int*)(lds + STAGE_BYTES + (_h * HALF + _R) * 4); aoff[_h][_i] = (unsigned)(_s * RB + _C * 2); }
                } else G_LOADA(nxt);
            }
            G_LDB(B1, 0, 1); G_STAGEB(G_SB(0, 0), b2);
            G_BAR; G_WAIT_L(0); G_MMA(0, 1, At, B1); G_BAR;
            G_LDA(At, 0, 1); G_STAGEA(G_SA(0, 0), k2, 0);
            G_BAR; G_WAIT_L(0); G_MMA(1, 0, At, B0); G_BAR; G_SCHED;
            G_STAGEB(G_SB(0, 1), b2 + hstep);
            G_WAIT_V(6); G_BAR; G_MMA(1, 1, At, B1); G_BAR;
            G_LDB(B0, 1, 0); G_SCHED; G_LDA(At, 1, 0); G_STAGEA(G_SA(0, 1), k2, 1);
            G_WAIT_L(8); G_BAR; G_WAIT_L(0); G_MMA(0, 0, At, B0); G_BAR; G_SCHED;
            G_LDB(B1, 1, 1); G_STAGEB(G_SB(1, 0), b3);
            G_BAR; G_WAIT_L(0); G_MMA(0, 1, At, B1); G_BAR;
            G_LDA(At, 1, 1); G_STAGEA(G_SA(1, 0), k3, 0);
            G_BAR; G_WAIT_L(0); G_MMA(1, 0, At, B0); G_BAR; G_SCHED;
            G_STAGEB(G_SB(1, 1), b3 + hstep);
            G_WAIT_V(6); G_BAR; G_MMA(1, 1, At, B1); G_BAR;
        }
        E(acc, cur, wr, wc, fr, fq);
        if (!has_next) break;
#pragma unroll
        for (int a = 0; a < 2; ++a)
#pragma unroll
            for (int b = 0; b < 2; ++b)
#pragma unroll
                for (int m = 0; m < 4; ++m)
#pragma unroll
                    for (int n = 0; n < 2; ++n) acc[a][b][m][n] = (f32x4){0.f, 0.f, 0.f, 0.f};
        cur = nxt; cB = nB; ++ui;
    }
    G_WAIT_V(0);
    if (wr == 0) G_BAR;
    G_BAR;
}
#else
template <int K, class Epi, class Sched, bool FP8 = false, bool GATHER = false>
__device__ __forceinline__ void gemm_phase(unsigned char* lds, const Gemm g, const Sched& S, const Epi& E, int wv) {
    const int tid = opaque_tid(wv), wid = tid >> 6, lane = tid & 63, wr = wid >> 2, wc = wid & 3, fr = lane & 15, fq = lane >> 4;
    Unit u;
    for (int ui = 0; S.next(ui, u); ++ui) {
        f32x4 acc[2][2][4][2];
        for (int ai = 0; ai < 2; ++ai) for (int bj = 0; bj < 2; ++bj) for (int m = 0; m < 4; ++m) for (int n = 0; n < 2; ++n) for (int j = 0; j < 4; ++j) {
            const int r = u.pm * 256 + 128 * ai + 64 * wr + 16 * m + fr;
            const int cl = Epi::PERM ? (128 * bj + 32 * wc + 8 * fq + 4 * n + j) : (128 * bj + 32 * wc + 16 * n + 4 * fq + j);
            const int ar = GATHER ? g.arow[r] : r;
            float s = 0.f;
            if (FP8) { const unsigned char* a = (const unsigned char*)g.A + (size_t)ar * K; const unsigned char* b = (const unsigned char*)g.Bt + ((size_t)u.pnb * 256 + cl) * K; for (int k = 0; k < K; ++k) s += fp8_to_f(a[k]) * fp8_to_f(b[k]); }
            else { const bf16_t* a = g.A + (size_t)ar * K; const bf16_t* b = g.Bt + ((size_t)u.pnb * 256 + cl) * K; for (int k = 0; k < K; ++k) s += bf2f(a[k]) * bf2f(b[k]); }
            acc[ai][bj][m][n][j] = s;
        }
        if constexpr (Epi::LSCALE) { __syncthreads(); if (tid < BM) E.prefetch(u, tid, wid); __syncthreads(); }
        E(acc, u, wr, wc, fr, fq);
    }
}
#endif

__device__ __forceinline__ void convert_wt(LAS unsigned char* lds, const float* W, int K, int ldw, int col0, int ncols, bf16_t* Wt, int rowmul, int rowadd, int bid, int nb, int wv) {
    LAS float* t = (LAS float*)lds;
    const int tid = opaque_tid(wv);
    const int tk = K / 64, tn = ncols / 64, ntile = tk * tn;
    const int lr = tid >> 4, c4 = (tid & 15) * 4;
    f32x4 v[2];
    if (bid < ntile) { const int k0 = (bid % tk) * 64, n0 = (bid / tk) * 64;
#pragma unroll
        for (int i = 0; i < 2; ++i) v[i] = *(const f32x4*)(W + (size_t)(k0 + lr + 32 * i) * ldw + col0 + n0 + c4); }
    for (int tile = bid; tile < ntile; tile += nb) {
        const int k0 = (tile % tk) * 64, n0 = (tile / tk) * 64;
        __syncthreads();
#pragma unroll
        for (int i = 0; i < 2; ++i) { const int r = lr + 32 * i; t[r * 65 + c4] = v[i][0]; t[r * 65 + c4 + 1] = v[i][1]; t[r * 65 + c4 + 2] = v[i][2]; t[r * 65 + c4 + 3] = v[i][3]; }
        const int nt2 = tile + nb;
        if (nt2 < ntile) { const int k1 = (nt2 % tk) * 64, n1 = (nt2 / tk) * 64;
#pragma unroll
            for (int i = 0; i < 2; ++i) v[i] = *(const f32x4*)(W + (size_t)(k1 + lr + 32 * i) * ldw + col0 + n1 + c4); }
        __syncthreads();
        { const int c = tid >> 3, k8 = (tid & 7) * 8; const int cc = n0 + c; const int dr = (cc >> 7) * rowmul + (cc & 127) + rowadd;
          u32x4 w; w.x = pack2(t[(k8 + 0) * 65 + c], t[(k8 + 1) * 65 + c]); w.y = pack2(t[(k8 + 2) * 65 + c], t[(k8 + 3) * 65 + c]);
          w.z = pack2(t[(k8 + 4) * 65 + c], t[(k8 + 5) * 65 + c]); w.w = pack2(t[(k8 + 6) * 65 + c], t[(k8 + 7) * 65 + c]);
          *(u32x4*)(Wt + (size_t)dr * K + k0 + k8) = w; }
    }
    __syncthreads();
}

__device__ __forceinline__ void load_row(const float* src, int row, int lane, f32x4 (&v)[4]) {
#pragma unroll
    for (int i = 0; i < 4; ++i) v[i] = *(const f32x4*)(src + (size_t)row * DM + i * 256 + lane * 4);
}
__device__ __forceinline__ void load_row_b(const bf16_t* src, int row, int lane, f32x4 (&v)[4]) {
#pragma unroll
    for (int i = 0; i < 4; ++i) { const u32x2 w = *(const u32x2*)(src + (size_t)row * DM + i * 256 + lane * 4);
        v[i][0] = __uint_as_float(w.x << 16); v[i][1] = __uint_as_float(w.x & 0xffff0000u); v[i][2] = __uint_as_float(w.y << 16); v[i][3] = __uint_as_float(w.y & 0xffff0000u); }
}
__device__ __forceinline__ float row_rstd(const f32x4 (&v)[4]) {
    float s = 0.f;
#pragma unroll
    for (int i = 0; i < 4; ++i) s += v[i][0] * v[i][0] + v[i][1] * v[i][1] + v[i][2] * v[i][2] + v[i][3] * v[i][3];
    s = wave_sum(s);
    return rsqrtf(s * (1.0f / DM) + NORM_EPS);
}
__device__ __forceinline__ void store_row_bf16(bf16_t* dst, int row, int lane, const f32x4 (&v)[4]) {
#pragma unroll
    for (int i = 0; i < 4; ++i) { u32x2 w; w.x = pack2(v[i][0], v[i][1]); w.y = pack2(v[i][2], v[i][3]); *(u32x2*)(dst + (size_t)row * DM + i * 256 + lane * 4) = w; }
}

__device__ __forceinline__ void store_row_fp8(unsigned char* dst, float* scale, int row, int lane, const f32x4 (&v)[4]) {
    float am = 0.f;
#pragma unroll
    for (int i = 0; i < 4; ++i) am = fmaxf(fmaxf(am, fmaxf(fabsf(v[i][0]), fabsf(v[i][1]))), fmaxf(fabsf(v[i][2]), fabsf(v[i][3])));
    am = wave_max(am);
    const float sc = am > 0.f ? am * (1.0f / FP8_TOP) : 1.0f, inv = 1.0f / sc;
#pragma unroll
    for (int i = 0; i < 4; ++i) *(unsigned*)(dst + (size_t)row * DM + i * 256 + lane * 4) = pack4_fp8(v[i][0] * inv, v[i][1] * inv, v[i][2] * inv, v[i][3] * inv);
    if (lane == 0) scale[row] = sc;
}
template <int K, bool NORMS>
__device__ __forceinline__ void quant_rows(KPTR p, LAS unsigned char* lds, const bf16_t* src, unsigned char* dst, float* scl, int nrows, int bid, int nb, int wv) {
    constexpr int NC = K / 512;
    const int tid = opaque_tid(wv), wid = tid >> 6, lane = tid & 63;
    LAS unsigned* nmx = (LAS unsigned*)lds;
    if (NORMS) { if (tid < 2 * NE) nmx[tid] = 0u; __syncthreads(); }
    int row = bid * 8 + wid;
    u32x4 nx[NC];
#pragma unroll
    for (int c = 0; c < NC; ++c) nx[c] = (u32x4){0u, 0u, 0u, 0u};
    if (row < nrows) {
#pragma unroll
        for (int c = 0; c < NC; ++c) nx[c] = *(const u32x4*)(src + (size_t)row * K + (c * 64 + lane) * 8); }
    for (; row < nrows; row += nb * 8) {
        u32x4 cu[NC];
#pragma unroll
        for (int c = 0; c < NC; ++c) cu[c] = nx[c];
        const int rn = row + nb * 8;
        if (rn < nrows) {
#pragma unroll
            for (int c = 0; c < NC; ++c) nx[c] = *(const u32x4*)(src + (size_t)rn * K + (c * 64 + lane) * 8); }
        float am = 0.f, ss = 0.f;
#pragma unroll
        for (int c = 0; c < NC; ++c)
#pragma unroll
            for (int q = 0; q < 4; ++q) { const float lo = __uint_as_float(cu[c][q] << 16), hi = __uint_as_float(cu[c][q] & 0xffff0000u); am = fmaxf(am, fmaxf(fabsf(lo), fabsf(hi))); if (NORMS) ss += lo * lo + hi * hi; }
        am = wave_max(am);
        const float sc = am > 0.f ? am * (1.0f / FP8_TOP) : 1.0f, inv = 1.0f / sc;
#pragma unroll
        for (int c = 0; c < NC; ++c) { u32x2 w;
            w.x = pack4_fp8(__uint_as_float(cu[c][0] << 16) * inv, __uint_as_float(cu[c][0] & 0xffff0000u) * inv, __uint_as_float(cu[c][1] << 16) * inv, __uint_as_float(cu[c][1] & 0xffff0000u) * inv);
            w.y = pack4_fp8(__uint_as_float(cu[c][2] << 16) * inv, __uint_as_float(cu[c][2] & 0xffff0000u) * inv, __uint_as_float(cu[c][3] << 16) * inv, __uint_as_float(cu[c][3] & 0xffff0000u) * inv);
            *(u32x2*)(dst + (size_t)row * K + (c * 64 + lane) * 8) = w; }
        if (lane == 0) scl[row] = sc;
        if (NORMS) { ss = wave_sum(ss); if (lane == 0) LDS_ATOMIC_MAX(nmx + ((row >> 7) & 1) * NE + row / (2 * FFE), __float_as_uint(sqrtf(ss))); }
    }
    if (NORMS) { __syncthreads(); if (tid < 2 * NE) (void)GLOBAL_ATOMIC_MAX(p->ctrl + (tid < NE ? C_GMAX + tid : C_UMAX + tid - NE), nmx[tid]); __syncthreads(); }
}
__device__ __forceinline__ const float* gu_src(KPTR p, int item, int t, int kr, int c4) {
    constexpr int NPAN = FFE / 32;
    const int e = item / (2 * NPAN), r = item % (2 * NPAN), up = r / NPAN, pn = r % NPAN;
    return (up ? p->w_mup : p->w_mgate) + (size_t)e * DM * FFE + (size_t)(t * 64 + kr) * FFE + pn * 32 + c4;
}
__device__ __forceinline__ void convert_gu_fp8(KPTR p, LAS unsigned char* lds, int bid, int nb, int wv) {
    constexpr int PSF = 1028, NPAN = FFE / 32, NITEM = NE * 2 * NPAN, TPI = DM / 64;
    const int tid = opaque_tid(wv), wid = tid >> 6, lane = tid & 63;
    LAS float* pan = (LAS float*)lds;
    LAS float* red = pan + 32 * PSF;
    LAS float* scl = red + 8 * 32 * 2;
    const int c4 = (tid & 7) * 4, kr = tid >> 3;
    const int nmine = bid < NITEM ? (NITEM - bid + nb - 1) / nb : 0, total = nmine * TPI;
    if (nmine == 0) return;
    constexpr int PD = 8;
    static_assert(TPI % PD == 0, "ring");
    f32x4 pf[PD];
#pragma unroll
    for (int i = 0; i < PD; ++i) { const int gi = i < total ? i : total - 1; pf[i] = *(const f32x4*)gu_src(p, bid + (gi / TPI) * nb, gi % TPI, kr, c4); }
    int g = 0;
    for (int it = 0; it < nmine; ++it) {
        const int item = bid + it * nb, e = item / (2 * NPAN), r = item % (2 * NPAN), up = r / NPAN, pn = r % NPAN;
        float am[4] = {0.f, 0.f, 0.f, 0.f}, ss[4] = {0.f, 0.f, 0.f, 0.f};
        for (int t0 = 0; t0 < TPI; t0 += PD) {
#pragma unroll
            for (int u = 0; u < PD; ++u, ++g) { const int t = t0 + u;
                const f32x4 v = pf[u];
                { int gn = g + PD; gn = gn < total ? gn : total - 1; int kr2 = kr; OPAQUE_V(kr2); pf[u] = *(const f32x4*)gu_src(p, bid + (gn / TPI) * nb, gn % TPI, kr2, c4); }
#pragma unroll
                for (int j = 0; j < 4; ++j) { am[j] = fmaxf(am[j], fabsf(v[j])); ss[j] += v[j] * v[j]; pan[(c4 + j) * PSF + t * 64 + kr] = v[j]; }
            }
        }
#pragma unroll
        for (int j = 0; j < 4; ++j) {
#pragma unroll
            for (int o = 8; o <= 32; o <<= 1) { am[j] = fmaxf(am[j], __shfl_xor(am[j], o)); ss[j] += __shfl_xor(ss[j], o); }
        }
        if ((lane >> 3) == 0) {
#pragma unroll
            for (int j = 0; j < 4; ++j) { red[(wid * 32 + c4 + j) * 2] = am[j]; red[(wid * 32 + c4 + j) * 2 + 1] = ss[j]; } }
        __syncthreads();
        if (tid < 64) { float a = 0.f, q = 0.f;
            if (tid < 32) {
#pragma unroll
                for (int w = 0; w < 8; ++w) { a = fmaxf(a, red[(w * 32 + tid) * 2]); q += red[(w * 32 + tid) * 2 + 1]; }
                const float sc = a > 0.f ? a * (1.0f / FP8_TOP) : 1.0f; scl[tid] = sc; scl[32 + tid] = 1.0f / sc;
                const int cc = pn * 32 + tid; p->ws_mgu[(size_t)e * 2 * FFE + (cc >> 7) * 256 + (cc & 127) + up * 128] = sc; }
            const float nm = wave_max(tid < 32 ? sqrtf(q) : 0.f);
            if (tid == 0) (void)GLOBAL_ATOMIC_MAX(p->ctrl + (up ? C_UMAX : C_GMAX) + e, __float_as_uint(nm)); }
        __syncthreads();
#pragma unroll
        for (int i2 = 0; i2 < 8; ++i2) { const int n = i2 * 4 + (tid >> 7), k8 = (tid & 127) * 8, cc = pn * 32 + n;
            const f32x4 a = *(LAS const f32x4*)(pan + n * PSF + k8), b = *(LAS const f32x4*)(pan + n * PSF + k8 + 4); const float inv = scl[32 + n];
            u32x2 w; w.x = pack4_fp8(a[0] * inv, a[1] * inv, a[2] * inv, a[3] * inv); w.y = pack4_fp8(b[0] * inv, b[1] * inv, b[2] * inv, b[3] * inv);
            *(u32x2*)(p->w8_mgu + ((size_t)e * 2 * FFE + (cc >> 7) * 256 + (cc & 127) + up * 128) * DM + k8) = w; }
        __syncthreads();
    }
}
template <bool WITH_GDN, bool OUT8 = false, bool SRCB = false>
__device__ __forceinline__ void phase_norm(KPTR p, const void* src, const float* gain, int bid, int nb, int wv) {
    const int tid = opaque_tid(wv), wid = tid >> 6, lane = tid & 63;
    f32x4 gv[4];
#pragma unroll
    for (int i = 0; i < 4; ++i) gv[i] = *(const f32x4*)(gain + i * 256 + lane * 4);
    f32x4 w8[WITH_GDN ? 16 : 1][2];
    if (WITH_GDN) {
#pragma unroll
        for (int i = 0; i < 4; ++i)
#pragma unroll
            for (int e = 0; e < 4; ++e) { const float* wr_ = p->w_in + (size_t)(i * 256 + lane * 4 + e) * DIN + DINP; w8[i * 4 + e][0] = *(const f32x4*)wr_; w8[i * 4 + e][1] = *(const f32x4*)(wr_ + 4); }
    }
    for (int row = bid * 8 + wid; row < NTOK; row += nb * 8) {
        f32x4 v[4]; if (SRCB) load_row_b((const bf16_t*)src, row, lane, v); else load_row((const float*)src, row, lane, v);
        const float rs = row_rstd(v);
#pragma unroll
        for (int i = 0; i < 4; ++i) v[i] = v[i] * rs * gv[i];
        if (OUT8) store_row_fp8((unsigned char*)p->hn, p->hns, row, lane, v); else store_row_bf16(p->hn, row, lane, v);
        if (WITH_GDN) {
            f32x4 d0 = (f32x4){0.f, 0.f, 0.f, 0.f}, d1 = (f32x4){0.f, 0.f, 0.f, 0.f};
#pragma unroll
            for (int i = 0; i < 4; ++i)
#pragma unroll
                for (int e = 0; e < 4; ++e) { const float xv = v[i][e]; d0 = d0 + w8[i * 4 + e][0] * xv; d1 = d1 + w8[i * 4 + e][1] * xv; }
            float d[8] = {d0[0], d0[1], d0[2], d0[3], d1[0], d1[1], d1[2], d1[3]};
#pragma unroll
            for (int j = 0; j < 8; ++j) d[j] = wave_sum(d[j]);
            if (lane < 4) {
                const float braw = lane == 0 ? d[0] : lane == 1 ? d[1] : lane == 2 ? d[2] : d[3];
                const float araw = lane == 0 ? d[4] : lane == 1 ? d[5] : lane == 2 ? d[6] : d[7];
                p->gbeta[(size_t)row * 4 + lane] = 1.0f / (1.0f + __expf(-braw));
                const float z = araw + p->dt_bias[lane];
                const float sp = z > 20.f ? z : log1pf(__expf(z));
                p->gg[(size_t)row * 4 + lane] = -__expf(p->a_log[lane]) * sp;
            }
        }
    }
}

constexpr int IMG_W = 0, IMG_QD = 17408, IMG_KDT = 34816, IMG_AT = 53248, IMG_U = 62464, IMG_CH = 78848;
__host__ __device__ constexpr int permb(int k) { return (k >> 5) * 64 + ((((k & 15) >> 2) * 8) + (((k >> 4) & 1) * 4) + (k & 3)) * 2; }
__device__ __forceinline__ bf16x8 frag2(LAS const unsigned char* ptr) {
    const u32x2 lo = *(LAS const u32x2*)ptr, hi = *(LAS const u32x2*)(ptr + 32);
    u32x4 w; w.x = lo.x; w.y = lo.y; w.z = hi.x; w.w = hi.y; bf16x8 r; __builtin_memcpy(&r, &w, 16); return r;
}
__device__ __forceinline__ bf16x8 pack8(const f32x4 a, const f32x4 b) {
    u32x4 w; w.x = pack2(a[0], a[1]); w.y = pack2(a[2], a[3]); w.z = pack2(b[0], b[1]); w.w = pack2(b[2], b[3]); bf16x8 r; __builtin_memcpy(&r, &w, 16); return r;
}


#ifndef CPU_EMU
__device__ __forceinline__ void st_wt32(void* p, unsigned v) { __hip_atomic_store((unsigned*)p, v, __ATOMIC_RELAXED, __HIP_MEMORY_SCOPE_AGENT); }
__device__ __forceinline__ void st_wt64(void* p, u32x2 v) { unsigned long long x = ((unsigned long long)v.y << 32) | v.x; __hip_atomic_store((unsigned long long*)p, x, __ATOMIC_RELAXED, __HIP_MEMORY_SCOPE_AGENT); }
#else
static inline void st_wt32(void* p, unsigned v) { *(unsigned*)p = v; }
static inline void st_wt64(void* p, u32x2 v) { *(u32x2*)p = v; }
#endif

#ifndef CPU_EMU
__device__ __forceinline__ void gdn_publish(unsigned* flag, int tid) {
    asm volatile("s_waitcnt vmcnt(0)" ::: "memory");
    __syncthreads();
    if (tid == 0) __hip_atomic_store(flag, 1u, __ATOMIC_RELAXED, __HIP_MEMORY_SCOPE_AGENT);
}
__device__ __forceinline__ void gdn_wait8(const unsigned* flags, int c, int nmax, int lane) {
    const int k = c + (lane & 7); const bool need = k < nmax;
    unsigned spins = 0;
    for (;;) {
        const unsigned v = need ? __hip_atomic_load(flags + k, __ATOMIC_RELAXED, __HIP_MEMORY_SCOPE_AGENT) : 1u;
        if (__all(v != 0u)) break;
        __builtin_amdgcn_s_sleep(4); if (++spins > (1u << 22)) break;
    }
    __builtin_amdgcn_fence(__ATOMIC_ACQUIRE, "agent");
}
__device__ __forceinline__ float ld_coherent(const float* p) { return __uint_as_float(__hip_atomic_load((const unsigned*)p, __ATOMIC_RELAXED, __HIP_MEMORY_SCOPE_AGENT)); }
#else
static inline void gdn_publish(unsigned* flag, int tid) { __syncthreads(); if (tid == 0) __atomic_store_n(flag, 1u, __ATOMIC_SEQ_CST); }
static inline void gdn_wait8(const unsigned* flags, int c, int nmax, int lane) { for (int k = c; k < c + 8 && k < nmax; ++k) while (__atomic_load_n(flags + k, __ATOMIC_SEQ_CST) == 0) emu::yield(); }
static inline float ld_coherent(const float* p) { return *p; }
#endif

template <int I> struct TSolve {
    static __device__ __forceinline__ void run(float (&tc)[64], LAS const float* sL, LAS unsigned char* tb, int lane) {
        TSolve<I - 1>::run(tc, sL, tb, lane);
        float p0 = 0.f, p1 = 0.f, p2 = 0.f, p3 = 0.f;
#pragma unroll
        for (int j = 0; j < I; ++j) { const float pr = sL[I * 68 + j] * tc[j]; if ((j & 3) == 0) p0 += pr; else if ((j & 3) == 1) p1 += pr; else if ((j & 3) == 2) p2 += pr; else p3 += pr; }
        const float t2 = ((I == lane) ? 1.f : 0.f) - ((p0 + p1) + (p2 + p3));
        tc[I] = t2; *(LAS bf16_t*)(tb + I * 144 + 2 * lane) = f2bf(t2);
    }
};
template <> struct TSolve<-1> { static __device__ __forceinline__ void run(float (&)[64], LAS const float*, LAS unsigned char*, int) {} };

template <bool PUBLISH>
__device__ __forceinline__ void phase_gdn_pre(KPTR p, LAS unsigned char* lds, int first, int stride, int wv) {
    constexpr int QB = 0, KB = 17408, VBT = 34816, KBT = 53248, KDT = 71680, LF = 90112, TB = 107520, ATB = 116736, SG = 125952, SBE = 126208;
    const int tid0 = opaque_tid(wv);
    LAS float* sL = (LAS float*)(lds + LF); LAS float* sg = (LAS float*)(lds + SG); LAS float* sb = (LAS float*)(lds + SBE);
    const bf16_t* proj = p->proj; const float* conv_w = p->conv_w; const float* gg = p->gg; const float* gbeta = p->gbeta; unsigned char* gimg = p->gimg; float* gcdec = p->gcdec;
    for (int uu = first; uu < NCHH; uu += stride) {
        int tid = tid0; OPAQUE_V(tid);
        const int wid = tid >> 6, lane = tid & 63, fr = lane & 15, q4 = lane >> 4;
        const int n = uu / (BATCH * 4), bh_ = uu % (BATCH * 4), h = bh_ & 3, b = bh_ >> 2;
        const int unit = bh_ * NCH + n;
        const size_t tok0 = (size_t)b * SEQ + (size_t)n * 64;
        unsigned char* img = gimg + (size_t)unit * IMG_CH;
        __syncthreads();
        if (wid == 0) { float gsum = gg[(tok0 + lane) * 4 + h]; for (int o = 1; o < 64; o <<= 1) { const float t2 = __shfl_up(gsum, o); if (lane >= o) gsum += t2; } sg[lane] = gsum; sb[lane] = gbeta[(tok0 + lane) * 4 + h]; }
        __syncthreads();
        const float glast = sg[63];
        unsigned xall[3][11];
#pragma unroll
        for (int w3 = 0; w3 < 3; ++w3) { const int cc = w3 * 512 + h * 128 + 2 * lane;
#pragma unroll
            for (int r = 0; r < 11; ++r) { const int tt = n * 64 + wid * 8 - 3 + r; xall[w3][r] = tt >= 0 ? *(const unsigned*)(proj + ((size_t)b * SEQ + tt) * DINP + 2048 + cc) : 0u; } }
#pragma unroll
        for (int which = 0; which < 3; ++which) {
            const int rb = wid, c0 = which * 512 + h * 128 + 2 * lane;
            float cw0[4], cw1[4];
#pragma unroll
            for (int kk = 0; kk < 4; ++kk) { cw0[kk] = conv_w[kk * 1536 + c0]; cw1[kk] = conv_w[kk * 1536 + c0 + 1]; }
            unsigned xv[11];
#pragma unroll
            for (int r = 0; r < 11; ++r) xv[r] = xall[which][r];
            float a0[8], a1[8], ss[8];
#pragma unroll
            for (int i8 = 0; i8 < 8; ++i8) { float y0 = 0.f, y1 = 0.f;
#pragma unroll
                for (int kk = 0; kk < 4; ++kk) { y0 += cw0[kk] * __uint_as_float(xv[i8 + kk] << 16); y1 += cw1[kk] * __uint_as_float(xv[i8 + kk] & 0xffff0000u); }
                a0[i8] = siluf(y0); a1[i8] = siluf(y1); ss[i8] = a0[i8] * a0[i8] + a1[i8] * a1[i8]; }
            if (which != 2) {
#pragma unroll
                for (int i8 = 0; i8 < 8; ++i8) ss[i8] = wave_sum(ss[i8]);
            }
#pragma unroll
            for (int i8 = 0; i8 < 8; ++i8) {
                const int i = rb * 8 + i8;
                const float gi = sg[i], bi = sb[i], eg = __expf(gi);
                if (which == 2) {
                    *(LAS bf16_t*)(lds + VBT + (2 * lane) * 144 + 2 * i) = f2bf(a0[i8] * bi); *(LAS bf16_t*)(lds + VBT + (2 * lane + 1) * 144 + 2 * i) = f2bf(a1[i8] * bi);
                } else {
                    const float sc = rsqrtf(ss[i8] + NORM_EPS) * (which == 0 ? 0.08838834764831845f : 1.0f);
                    const float n0 = a0[i8] * sc, n1 = a1[i8] * sc;
                    if (which == 0) { *(LAS unsigned*)(lds + QB + i * 272 + 4 * lane) = pack2(n0, n1); st_wt32(img + IMG_QD + i * 272 + permb(2 * lane), pack2(n0 * eg, n1 * eg)); }
                    else { *(LAS unsigned*)(lds + KB + i * 272 + 4 * lane) = pack2(n0, n1);
                        const float f1 = bi * eg, f2 = __expf(glast - gi);
                        *(LAS bf16_t*)(lds + KBT + (2 * lane) * 144 + 2 * i) = f2bf(n0 * f1); *(LAS bf16_t*)(lds + KBT + (2 * lane + 1) * 144 + 2 * i) = f2bf(n1 * f1);
                        *(LAS bf16_t*)(lds + KDT + (2 * lane) * 144 + permb(i)) = f2bf(n0 * f2); *(LAS bf16_t*)(lds + KDT + (2 * lane + 1) * 144 + permb(i)) = f2bf(n1 * f2); }
                }
            }
        }
        __syncthreads();
        {
            const int mat = wid >> 2, itile = wid & 3;
            LAS const unsigned char* abase = lds + (mat == 0 ? KB : QB) + (16 * itile + fr) * 272 + 16 * q4;
            bf16x8 af[4];
#pragma unroll
            for (int s4 = 0; s4 < 4; ++s4) af[s4] = *(LAS const bf16x8*)(abase + 64 * s4);
#pragma unroll
            for (int nt = 0; nt < 4; ++nt) {
                f32x4 acc = (f32x4){0.f, 0.f, 0.f, 0.f};
                if (nt <= itile) {
#pragma unroll
                    for (int s4 = 0; s4 < 4; ++s4) { const bf16x8 bfr = *(LAS const bf16x8*)(lds + KB + (16 * nt + fr) * 272 + 16 * q4 + 64 * s4);
                        acc = __builtin_amdgcn_mfma_f32_16x16x32_bf16(af[s4], bfr, acc, 0, 0, 0); }
                }
                const int j = 16 * nt + fr; const float gj = sg[j];
#pragma unroll
                for (int r = 0; r < 4; ++r) { const int i = 16 * itile + 4 * q4 + r; const float dec = __expf(sg[i] - gj);
                    if (mat == 0) sL[i * 68 + j] = i > j ? sb[i] * acc[r] * dec : 0.f;
                    else *(LAS bf16_t*)(lds + ATB + i * 144 + permb(j)) = f2bf(i >= j ? acc[r] * dec : 0.f); }
            }
        }
        __syncthreads();
        if (wid == 0) {
            float tc[64];
            TSolve<63>::run(tc, sL, lds + TB, lane);
        } else {
            for (int pc = tid - 64; pc < 1152 + 576; pc += NTHREADS - 64) {
                if (pc < 1152) { const u32x4 v4 = *(LAS const u32x4*)(lds + KDT + pc * 16); u32x2 a; a.x = v4.x; a.y = v4.y; u32x2 c; c.x = v4.z; c.y = v4.w; st_wt64(img + IMG_KDT + pc * 16, a); st_wt64(img + IMG_KDT + pc * 16 + 8, c); }
                else { const u32x4 v4 = *(LAS const u32x4*)(lds + ATB + (pc - 1152) * 16); u32x2 a; a.x = v4.x; a.y = v4.y; u32x2 c; c.x = v4.z; c.y = v4.w; st_wt64(img + IMG_AT + (pc - 1152) * 16, a); st_wt64(img + IMG_AT + (pc - 1152) * 16 + 8, c); }
            }
        }
        __syncthreads();
        {
            const int itile = wid & 3;
            bf16x8 tf[2];
#pragma unroll
            for (int s2 = 0; s2 < 2; ++s2) tf[s2] = *(LAS const bf16x8*)(lds + TB + (16 * itile + fr) * 144 + 16 * q4 + 64 * s2);
#pragma unroll
            for (int nt = 0; nt < 8; ++nt) {
                f32x4 acc = (f32x4){0.f, 0.f, 0.f, 0.f};
                if (wid < 4) {
#pragma unroll
                    for (int s2 = 0; s2 < 2; ++s2) { const bf16x8 bfr = *(LAS const bf16x8*)(lds + VBT + (16 * nt + fr) * 144 + 16 * q4 + 64 * s2);
                        acc = __builtin_amdgcn_mfma_f32_16x16x32_bf16(tf[s2], bfr, acc, 0, 0, 0); }
                    u32x2 w; w.x = pack2(acc[0], acc[1]); w.y = pack2(acc[2], acc[3]);
                    st_wt64(img + IMG_U + ((nt * 4 + itile) * 64 + lane) * 8, w);
                } else {
#pragma unroll
                    for (int s2 = 0; s2 < 2; ++s2) { const bf16x8 afr = *(LAS const bf16x8*)(lds + KBT + (16 * nt + fr) * 144 + 16 * q4 + 64 * s2);
                        acc = __builtin_amdgcn_mfma_f32_16x16x32_bf16(afr, tf[s2], acc, 0, 0, 0); }
                    u32x2 w; w.x = pack2(acc[0], acc[1]); w.y = pack2(acc[2], acc[3]);
                    st_wt64(img + IMG_W + (16 * itile + fr) * 272 + permb(16 * nt + 4 * q4), w);
                }
            }
        }
        if (tid == 0) st_wt32(gcdec + unit, __float_as_uint(__expf(glast)));
        if (PUBLISH) gdn_publish(p->gflag + unit, tid);
    }
}

constexpr int NCW = 2, NLT = NTHREADS - 64 * NCW;
constexpr int STG = 62464 + NCW * 2048;
#define LDF(ptr) (*(LAS const bf16x8*)(ptr))
#define MF16(a, b, c) __builtin_amdgcn_mfma_f32_16x16x32_bf16((a), (b), (c), 0, 0, 0)
__device__ __forceinline__ void scan_store_ot(bf16_t* op, const f32x4 (&ao)[4]) {
#pragma unroll
    for (int it = 0; it < 4; ++it) { u32x2 w; w.x = pack2(ao[it][0], ao[it][1]); w.y = pack2(ao[it][2], ao[it][3]); *(u32x2*)(op + (size_t)(16 * it) * DM) = w; }
}
__device__ __forceinline__ void scan_store_o(bf16_t* op, const f32x4 (&ao)[4], int q4) {
#pragma unroll
    for (int it = 0; it < 4; ++it)
#pragma unroll
        for (int r = 0; r < 4; ++r) op[(size_t)(16 * it + 4 * q4 + r) * DM] = f2bf(ao[it][r]);
}
__device__ __forceinline__ bf16x8 asfrag(const u32x4 v) { bf16x8 r; __builtin_memcpy(&r, &v, 16); return r; }
#define LDR(ptr) (*(LAS const u32x4*)(ptr))
template <bool WAITF>
__device__ __forceinline__ void scan_gdn(KPTR p, LAS unsigned char* lds, int b, int h, int qt, int wv) {
    const unsigned* gflag = p->gflag + (size_t)(b * 4 + h) * NCH;
    const int tid = opaque_tid(wv), wid = tid >> 6, lane = tid & 63, fr = lane & 15, q4 = lane >> 4;
    const unsigned char* gimg = p->gimg; const float* gcdec = p->gcdec + (size_t)(b * 4 + h) * NCH; bf16_t* out = p->hn;
    const bool loader = wid >= NCW;
    const int cw = wid, lt = tid - 64 * NCW;
    f32x4 S[8];
#pragma unroll
    for (int dt = 0; dt < 8; ++dt) S[dt] = (f32x4){0.f, 0.f, 0.f, 0.f};
    constexpr int NLG = NLT / 2;
    constexpr int NPC = 3904 + NCW * 128, NPR = (NPC + NLG - 1) / NLG;
    static_assert(NPR >= 16, "compute waves use R[0..7] and R[8..15] as their two operand batches");
    u32x4 R[NPR];
    float cdv = 0.f;
    constexpr int OUTB = 2 * STG, CDB = OUTB + 8192;
    const int grp = lt >= NLG ? 1 : 0, lg_ = lt - grp * NLG;
    const unsigned char* base = gimg + (size_t)(b * 4 + h) * NCH * IMG_CH;
#define GDN_PREFETCH(nn) do { int _lg = lg_; OPAQUE_V(_lg); const unsigned char* _src = base + (size_t)(nn) * IMG_CH; _Pragma("unroll") for (int _i = 0; _i < NPR; ++_i) { int _pc = _lg + NLG * _i; _pc = _pc < NPC ? _pc : NPC - 1; \
        const int _so = _pc < 3904 ? _pc * 16 : IMG_U + qt * (NCW * 2048) + (_pc - 3904) * 16; R[_i] = *(const u32x4*)(_src + _so); } cdv = ld_coherent(gcdec + (nn)); } while (0)
    int avail = 0;
    if (loader && grp < NCH) { if (WAITF) { gdn_wait8(gflag, 0, NCH, lane); avail = 8; } GDN_PREFETCH(grp); }
    float cd_next = 0.f;
    __syncthreads();
    auto load_step = [&](int nn) {
        if (nn < NCH && (nn & 1) == grp) {
            LAS unsigned char* buf = lds + (nn & 1) * STG;
#pragma unroll
            for (int i = 0; i < NPR; ++i) { int pc = lg_ + NLG * i; pc = pc < NPC ? pc : NPC - 1; *(LAS u32x4*)(buf + pc * 16) = R[i]; }
            if (lg_ == 0) *(LAS float*)(lds + CDB + (nn & 1) * 8) = cdv;
            if (nn + 2 < NCH) { if (WAITF && nn + 2 >= avail) { gdn_wait8(gflag, avail, NCH, lane); avail += 8; } GDN_PREFETCH(nn + 2); }
        }
    };
    auto flush = [&](int n) {
        for (int pc = lg_; pc < NCW * 256; pc += NLG) { const int cwi = pc >> 8, it = (pc >> 6) & 3, ln = pc & 63;
            const u32x2 w = *(LAS const u32x2*)(lds + OUTB + (n & 1) * 4096 + pc * 8);
            *(u32x2*)(out + ((size_t)b * SEQ + (size_t)n * 64 + 16 * it + (ln & 15)) * DM + 512 + h * 128 + 16 * (NCW * qt + cwi) + 4 * (ln >> 4)) = w; }
    };
    auto compute = [&](int n) {

            LAS const unsigned char* buf = lds + (n & 1) * STG;
            const float cd = *(LAS const float*)(lds + CDB + (n & 1) * 8);
            LAS const unsigned char* pw = buf + IMG_W + fr * 272 + 16 * q4;
            LAS const unsigned char* pq = buf + IMG_QD + fr * 272 + 16 * q4;
            LAS const unsigned char* pk = buf + IMG_KDT + fr * 144 + 16 * q4;
            LAS const unsigned char* pa = buf + IMG_AT + fr * 144 + 16 * q4;
            bf16x8 Sb[4];
#pragma unroll
            for (int s4 = 0; s4 < 4; ++s4) Sb[s4] = pack8(S[2 * s4], S[2 * s4 + 1]);
            f32x4 ao[4], av[4];
            u32x2 uu[4];
#pragma unroll
            for (int it = 0; it < 4; ++it) uu[it] = *(LAS const u32x2*)(buf + IMG_U + ((cw * 4 + it) * 64 + lane) * 8);
            u32x4* RA = R; u32x4* RB = R + 8;
#define GDN_LD_WQ(RR, it_) do { _Pragma("unroll") for (int s4 = 0; s4 < 4; ++s4) { RR[s4] = LDR(pw + (16 * (it_)) * 272 + 64 * s4); RR[4 + s4] = LDR(pq + (16 * (it_)) * 272 + 64 * s4); } } while (0)
#define GDN_LD_K(RR, dh_) do { _Pragma("unroll") for (int d2 = 0; d2 < 4; ++d2) _Pragma("unroll") for (int s2 = 0; s2 < 2; ++s2) RR[d2 * 2 + s2] = LDR(pk + (16 * (4 * (dh_) + d2)) * 144 + 64 * s2); } while (0)
#define GDN_MM_WQ(RR, it_) do { av[it_] = (f32x4){0.f, 0.f, 0.f, 0.f}; ao[it_] = (f32x4){0.f, 0.f, 0.f, 0.f}; \
        _Pragma("unroll") for (int s4 = 0; s4 < 4; ++s4) { av[it_] = MF16(asfrag(RR[s4]), Sb[s4], av[it_]); ao[it_] = MF16(Sb[s4], asfrag(RR[4 + s4]), ao[it_]); } } while (0)
#define GDN_MM_K(RR, dh_) do { _Pragma("unroll") for (int d2 = 0; d2 < 4; ++d2) { S[4 * (dh_) + d2] = S[4 * (dh_) + d2] * cd; \
        _Pragma("unroll") for (int s2 = 0; s2 < 2; ++s2) S[4 * (dh_) + d2] = MF16(asfrag(RR[d2 * 2 + s2]), Vb[s2], S[4 * (dh_) + d2]); } } while (0)
            GDN_LD_WQ(RA, 0); SCHED_FENCE();
            GDN_LD_WQ(RB, 1); SCHED_FENCE(); GDN_MM_WQ(RA, 0); SCHED_FENCE();
            GDN_LD_WQ(RA, 2); SCHED_FENCE(); GDN_MM_WQ(RB, 1); SCHED_FENCE();
            GDN_LD_WQ(RB, 3); SCHED_FENCE(); GDN_MM_WQ(RA, 2); SCHED_FENCE();
            GDN_LD_K(RA, 0); SCHED_FENCE(); GDN_MM_WQ(RB, 3); SCHED_FENCE();
#pragma unroll
            for (int it = 0; it < 4; ++it) {
                av[it][0] = __uint_as_float(uu[it].x << 16) - av[it][0]; av[it][1] = __uint_as_float(uu[it].x & 0xffff0000u) - av[it][1];
                av[it][2] = __uint_as_float(uu[it].y << 16) - av[it][2]; av[it][3] = __uint_as_float(uu[it].y & 0xffff0000u) - av[it][3]; }
            bf16x8 Vb[2];
#pragma unroll
            for (int s2 = 0; s2 < 2; ++s2) Vb[s2] = pack8(av[2 * s2], av[2 * s2 + 1]);
            GDN_LD_K(RB, 1); SCHED_FENCE(); GDN_MM_K(RA, 0); SCHED_FENCE();
#pragma unroll
            for (int it = 0; it < 4; ++it)
#pragma unroll
                for (int s2 = 0; s2 < 2; ++s2) R[it * 2 + s2] = LDR(pa + (16 * it) * 144 + 64 * s2);
            SCHED_FENCE(); GDN_MM_K(RB, 1); SCHED_FENCE();
#pragma unroll
            for (int it = 0; it < 4; ++it)
#pragma unroll
                for (int s2 = 0; s2 < 2; ++s2) ao[it] = MF16(Vb[s2], asfrag(R[it * 2 + s2]), ao[it]);
#undef GDN_LD_WQ
#undef GDN_LD_K
#undef GDN_MM_WQ
#undef GDN_MM_K
#pragma unroll
            for (int it = 0; it < 4; ++it) { u32x2 w; w.x = pack2(ao[it][0], ao[it][1]); w.y = pack2(ao[it][2], ao[it][3]); *(LAS u32x2*)(lds + OUTB + (n & 1) * 4096 + ((cw * 4 + it) * 64 + lane) * 8) = w; }
            };
    for (int n = -1; n < NCH; ++n) {
        if (loader) { load_step(n + 1); if (n >= 1 && (n & 1) == grp) flush(n - 1); } else if (n >= 0) compute(n);
        __syncthreads();
    }
    if (loader && grp == 0) flush(NCH - 1);
#undef GDN_PREFETCH
}
#ifndef CG_FORCE
#define CG_FORCE 0
#endif
constexpr int CG = CG_FORCE ? CG_FORCE : (NCH >= 256 ? 8 : 4), NG = NCH / CG;
template <int MODE>
__device__ __forceinline__ void scan_ret(KPTR p, LAS unsigned char* lds, int b, int h, int qt, int g, int wv) {
    const int n0 = g * CG;
    constexpr int R_Q = 0, R_K = 17408, R_KDT = 34816, R_VT = 53248;
    constexpr int RAT_OFF = 2 * STG;
    const int tid = opaque_tid(wv), wid = tid >> 6, lane = tid & 63, fr = lane & 15, q4 = lane >> 4;
    const bf16_t* proj = p->proj; bf16_t* out = p->hn; float* Lb = p->retL;
    const bool loader = wid >= NCW;
    const int cw = wid, lt = tid - 64 * NCW;
    const float lg = log1pf(-exp2f(-5.0f - (float)h));
    f32x4 S[8];
#pragma unroll
    for (int dt = 0; dt < 8; ++dt) S[dt] = (f32x4){0.f, 0.f, 0.f, 0.f};
    const float rcd = __expf(lg * 64.f), g1 = __expf(lg);
    if (MODE == 1 && !loader) {
        const float gdec = __expf(lg * (float)(64 * CG)); float wgt = 1.f;
        for (int gp = g - 1; gp >= 0; --gp) {
            const f32x4* lp = (const f32x4*)Lb + ((((size_t)(b * 4 + h) * NG + gp) * (8 / NCW) + qt) * NCW + cw) * 8 * 64 + lane;
#pragma unroll
            for (int dt = 0; dt < 8; ++dt) S[dt] = S[dt] + lp[dt * 64] * wgt;
            wgt *= gdec;
        }
    }
    float gi[4];
#pragma unroll
    for (int t4 = 0; t4 < 4; ++t4) gi[t4] = __expf(lg * (float)(16 * t4 + fr));
    constexpr int NLG = NLT / 2, NQG = (1024 + NLG - 1) / NLG, KB_N = 256 - NLG;
    static_assert(NLG >= 128 && NLG <= 256 && KB_N + 32 * NCW <= NLG, "task slots");
    u32x4 R[NQG + 8 < 16 ? 16 : NQG + 8];
    const int grp = lt >= NLG ? 1 : 0, lg_ = lt - grp * NLG;
#define RET_PREFETCH(nn) do { int _l = lg_; OPAQUE_V(_l); const bf16_t* _pq = proj + ((size_t)b * SEQ + (size_t)(n0 + (nn)) * 64) * DINP + h * 128; \
        _Pragma("unroll") for (int _i = 0; _i < NQG; ++_i) { int _pc = _l + NLG * _i; _pc = _pc < 1024 ? _pc : 1023; const int _row = _pc >> 4, _c = _pc & 15; R[_i] = *(const u32x4*)(_pq + (size_t)_row * DINP + _c * 8); } \
        _Pragma("unroll") for (int _r = 0; _r < 4; ++_r) R[NQG + _r] = *(const u32x4*)(_pq + (size_t)(4 * (_l >> 4) + _r) * DINP + 512 + (_l & 15) * 8); \
        { const bool _isk = _l < KB_N; int _v = _l - KB_N; _v = _v < 0 ? 0 : (_v < 32 * NCW ? _v : 32 * NCW - 1); const int _t = NLG + (_isk ? _l : 0); \
          const int _r0 = _isk ? 4 * (_t >> 4) : 4 * (_v >> 2), _co = _isk ? 512 + (_t & 15) * 8 : 1024 + 16 * NCW * qt + (_v & 3) * 8; \
          _Pragma("unroll") for (int _r = 0; _r < 4; ++_r) R[NQG + 4 + _r] = *(const u32x4*)(_pq + (size_t)(_r0 + _r) * DINP + _co); } } while (0)
#define RET_WRITE_K(RB_, t_) do { const int ig = (t_) >> 4, ck = (t_) & 15; float sc[4]; \
        _Pragma("unroll") for (int r = 0; r < 4; ++r) { sc[r] = 0.08838834764831845f * __expf(lg * (float)(63 - 4 * ig - r)); \
            u32x2 a; a.x = R[(RB_) + r].x; a.y = R[(RB_) + r].y; u32x2 c2; c2.x = R[(RB_) + r].z; c2.y = R[(RB_) + r].w; \
            *(LAS u32x2*)(buf + R_K + (4 * ig + r) * 272 + permb(8 * ck)) = a; *(LAS u32x2*)(buf + R_K + (4 * ig + r) * 272 + permb(8 * ck + 4)) = c2; } \
        _Pragma("unroll") for (int e = 0; e < 8; ++e) { const int wsel = e >> 1; float x[4]; \
            _Pragma("unroll") for (int r = 0; r < 4; ++r) x[r] = ((e & 1) ? __uint_as_float(R[(RB_) + r][wsel] & 0xffff0000u) : __uint_as_float(R[(RB_) + r][wsel] << 16)) * sc[r]; \
            u32x2 o; o.x = pack2(x[0], x[1]); o.y = pack2(x[2], x[3]); *(LAS u32x2*)(buf + R_KDT + (8 * ck + e) * 144 + permb(4 * ig)) = o; } } while (0)
    if (loader && grp < CG) RET_PREFETCH(grp);
    __syncthreads();
    auto load_step = [&](int nn) {
        if (nn < CG && (nn & 1) == grp) {
            LAS unsigned char* buf = lds + (nn & 1) * STG; int l2 = lg_; OPAQUE_V(l2);
#pragma unroll
            for (int i = 0; i < NQG; ++i) { int pc = l2 + NLG * i; pc = pc < 1024 ? pc : 1023; const int row = pc >> 4, c = pc & 15;
                u32x2 a; a.x = R[i].x; a.y = R[i].y; u32x2 c2; c2.x = R[i].z; c2.y = R[i].w;
                *(LAS u32x2*)(buf + R_Q + row * 272 + permb(8 * c)) = a; *(LAS u32x2*)(buf + R_Q + row * 272 + permb(8 * c + 4)) = c2; }
            RET_WRITE_K(NQG, l2);
            if (l2 < KB_N) { RET_WRITE_K(NQG + 4, NLG + l2); }
            else if (l2 < KB_N + 32 * NCW) { const int v = l2 - KB_N, igv = v >> 2, cv = v & 3;
#pragma unroll
                for (int e = 0; e < 8; ++e) { const int wsel = e >> 1, sh = 16 * (e & 1);
                    u32x2 o; o.x = ((R[NQG + 4][wsel] >> sh) & 0xffffu) | (((R[NQG + 5][wsel] >> sh) & 0xffffu) << 16); o.y = ((R[NQG + 6][wsel] >> sh) & 0xffffu) | (((R[NQG + 7][wsel] >> sh) & 0xffffu) << 16);
                    *(LAS u32x2*)(buf + R_VT + (8 * cv + e) * 144 + permb(4 * igv)) = o; } }
            if (nn + 2 < CG) RET_PREFETCH(nn + 2);
        }
    };
    auto scores = [&](int n) {
        LAS const unsigned char* buf = lds + (n & 1) * STG;
        const int lw = wid - NCW;
#pragma unroll
        for (int rep = 0; rep < 2; ++rep) {
            const int tl = lw + (NTHREADS / 64 - NCW) * rep;
            if (tl < 12) {
                int it, jt;
                if (tl < 1) { it = 0; jt = 0; } else if (tl < 3) { it = 1; jt = tl - 1; } else if (tl < 6) { it = 2; jt = tl - 3; } else if (tl < 10) { it = 3; jt = tl - 6; } else if (tl == 10) { it = 0; jt = 1; } else { it = 2; jt = 3; }
                f32x4 acc = (f32x4){0.f, 0.f, 0.f, 0.f};
                if (tl < 10) {
                    bf16x8 kf[4], qf[4];
#pragma unroll
                    for (int s4 = 0; s4 < 4; ++s4) { kf[s4] = LDF(buf + R_K + (16 * jt + fr) * 272 + 64 * s4 + 16 * q4); qf[s4] = LDF(buf + R_Q + (16 * it + fr) * 272 + 64 * s4 + 16 * q4); }
#pragma unroll
                    for (int s4 = 0; s4 < 4; ++s4) acc = MF16(kf[s4], qf[s4], acc);
                    const float gi_ = __expf(lg * (float)(16 * it + fr));
#pragma unroll
                    for (int r = 0; r < 4; ++r) { const int j = 16 * jt + 4 * q4 + r, i = 16 * it + fr;
                        acc[r] = i >= j ? acc[r] * gi_ * 0.08838834764831845f * __expf(-lg * (float)j) : 0.f; }
                }
                u32x2 w; w.x = pack2(acc[0], acc[1]); w.y = pack2(acc[2], acc[3]);
                *(LAS u32x2*)(lds + RAT_OFF + (16 * it + fr) * 144 + permb(16 * jt + 4 * q4)) = w;
            }
        }
    };
    f32x4 ot[4];
    bf16x8 Vf[2];
    auto computeA = [&](int n) {
        LAS const unsigned char* buf = lds + (n & 1) * STG;
        LAS const unsigned char* pq = buf + R_Q + fr * 272 + 16 * q4;
        LAS const unsigned char* pk = buf + R_KDT + fr * 144 + 16 * q4;
        bf16x8 Sb[4];
#pragma unroll
        for (int s4 = 0; s4 < 4; ++s4) Sb[s4] = pack8(S[2 * s4], S[2 * s4 + 1]);
#pragma unroll
        for (int s2 = 0; s2 < 2; ++s2) Vf[s2] = LDF(buf + R_VT + (16 * cw + fr) * 144 + 64 * s2 + 16 * q4);
        u32x4* RA = R; u32x4* RB = R + 8;
#define RET_LD_Q(RR, hh_) do { _Pragma("unroll") for (int i2 = 0; i2 < 2; ++i2) _Pragma("unroll") for (int s4 = 0; s4 < 4; ++s4) RR[i2 * 4 + s4] = LDR(pq + (16 * (2 * (hh_) + i2)) * 272 + 64 * s4); } while (0)
#define RET_LD_K(RR, dh_) do { _Pragma("unroll") for (int d2 = 0; d2 < 4; ++d2) _Pragma("unroll") for (int s2 = 0; s2 < 2; ++s2) RR[d2 * 2 + s2] = LDR(pk + (16 * (4 * (dh_) + d2)) * 144 + 64 * s2); } while (0)
#define RET_MM_Q(RR, hh_) do { _Pragma("unroll") for (int i2 = 0; i2 < 2; ++i2) { const int it = 2 * (hh_) + i2; ot[it] = (f32x4){0.f, 0.f, 0.f, 0.f}; \
        _Pragma("unroll") for (int s4 = 0; s4 < 4; ++s4) ot[it] = MF16(Sb[s4], asfrag(RR[i2 * 4 + s4]), ot[it]); \
        const float rd = gi[it] * g1; _Pragma("unroll") for (int r = 0; r < 4; ++r) ot[it][r] *= rd; } } while (0)
#define RET_MM_K(RR, dh_) do { _Pragma("unroll") for (int d2 = 0; d2 < 4; ++d2) { S[4 * (dh_) + d2] = S[4 * (dh_) + d2] * rcd; \
        _Pragma("unroll") for (int s2 = 0; s2 < 2; ++s2) S[4 * (dh_) + d2] = MF16(asfrag(RR[d2 * 2 + s2]), Vf[s2], S[4 * (dh_) + d2]); } } while (0)
        RET_LD_K(RA, 0); SCHED_FENCE();
        RET_LD_K(RB, 1); SCHED_FENCE(); RET_MM_K(RA, 0); SCHED_FENCE();
        if (MODE == 1) {
            RET_LD_Q(RA, 0); SCHED_FENCE(); RET_MM_K(RB, 1); SCHED_FENCE();
            RET_LD_Q(RB, 1); SCHED_FENCE(); RET_MM_Q(RA, 0); SCHED_FENCE();
            RET_MM_Q(RB, 1);
        } else { RET_MM_K(RB, 1); }
#undef RET_LD_Q
#undef RET_LD_K
#undef RET_MM_Q
#undef RET_MM_K
    };
    auto computeB = [&](int n) {
        LAS const unsigned char* pa = lds + RAT_OFF + fr * 144 + 16 * q4;
        R[0] = LDR(pa); R[1] = LDR(pa + 16 * 144); R[2] = LDR(pa + 32 * 144); R[3] = LDR(pa + 32 * 144 + 64); R[4] = LDR(pa + 48 * 144); R[5] = LDR(pa + 48 * 144 + 64);
        SCHED_FENCE();
        ot[0] = MF16(Vf[0], asfrag(R[0]), ot[0]); ot[1] = MF16(Vf[0], asfrag(R[1]), ot[1]);
        ot[2] = MF16(Vf[0], asfrag(R[2]), ot[2]); ot[2] = MF16(Vf[1], asfrag(R[3]), ot[2]);
        ot[3] = MF16(Vf[0], asfrag(R[4]), ot[3]); ot[3] = MF16(Vf[1], asfrag(R[5]), ot[3]);
        scan_store_ot(out + ((size_t)b * SEQ + (size_t)(n0 + n) * 64 + fr) * DM + h * 128 + 16 * (NCW * qt + cw) + 4 * q4, ot);
    };
    for (int n = -1; n < CG; ++n) {
        if (loader) { if (MODE == 1 && n >= 0) scores(n); load_step(n + 1); } else if (n >= 0) computeA(n);
        __syncthreads();
        if (MODE == 1) {
            if (!loader && n >= 0) computeB(n);
            __syncthreads();
        }
    }
    if (MODE == 0 && !loader) {
        f32x4* lp = (f32x4*)Lb + ((((size_t)(b * 4 + h) * NG + g) * (8 / NCW) + qt) * NCW + cw) * 8 * 64 + lane;
#pragma unroll
        for (int dt = 0; dt < 8; ++dt) lp[dt * 64] = S[dt];
    }
#undef RET_PREFETCH
#undef RET_WRITE_K
}
template <int MODE>
__device__ __forceinline__ void scan_ret_full(KPTR p, LAS unsigned char* lds, int b, int h, int g, int wv) {
    constexpr int F_Q = 0, F_K = 17408, F_KDT = 34816, F_VT = 53248, F_RAT = 71680;
    const int n0 = g * CG;
    const int tid = opaque_tid(wv), wid = tid >> 6, lane = tid & 63, fr = lane & 15, q4 = lane >> 4, cw = wid;
    const bf16_t* proj = p->proj; bf16_t* out = p->hn; float* Lb = p->retL;
    const float lg = log1pf(-exp2f(-5.0f - (float)h));
    const float rcd = __expf(lg * 64.f), g1 = __expf(lg);
    f32x4 S[8];
#pragma unroll
    for (int dt = 0; dt < 8; ++dt) S[dt] = (f32x4){0.f, 0.f, 0.f, 0.f};
    if (MODE == 1) {
        const float gdec = __expf(lg * (float)(64 * CG)); float wgt = 1.f;
        for (int gp = g - 1; gp >= 0; --gp) {
            const f32x4* lp = (const f32x4*)Lb + (((size_t)(b * 4 + h) * NG + gp) * 8 + cw) * 8 * 64 + lane;
#pragma unroll
            for (int dt = 0; dt < 8; ++dt) S[dt] = S[dt] + lp[dt * 64] * wgt;
            wgt *= gdec;
        }
    }
    float gi[4];
#pragma unroll
    for (int t4 = 0; t4 < 4; ++t4) gi[t4] = __expf(lg * (float)(16 * t4 + fr));
    u32x4 rq[2], rkv[4];
#define RF_PREFETCH(nn) do { int _l = tid; OPAQUE_V(_l); const bf16_t* _pq = proj + ((size_t)b * SEQ + (size_t)(n0 + (nn)) * 64) * DINP + h * 128; \
        _Pragma("unroll") for (int _i = 0; _i < 2; ++_i) { const int _pc = _l + NTHREADS * _i; rq[_i] = *(const u32x4*)(_pq + (size_t)(_pc >> 4) * DINP + (_pc & 15) * 8); } \
        { const bool _isk = _l < 256; const int _t = _isk ? _l : _l - 256; const int _r0 = 4 * (_t >> 4), _co = (_isk ? 512 : 1024) + (_t & 15) * 8; \
          _Pragma("unroll") for (int _r = 0; _r < 4; ++_r) rkv[_r] = *(const u32x4*)(_pq + (size_t)(_r0 + _r) * DINP + _co); } } while (0)
    auto write_stage = [&]() {
        int l2 = tid; OPAQUE_V(l2);
#pragma unroll
        for (int i = 0; i < 2; ++i) { const int pc = l2 + NTHREADS * i, row = pc >> 4, c = pc & 15;
            u32x2 a; a.x = rq[i].x; a.y = rq[i].y; u32x2 c2; c2.x = rq[i].z; c2.y = rq[i].w;
            *(LAS u32x2*)(lds + F_Q + row * 272 + permb(8 * c)) = a; *(LAS u32x2*)(lds + F_Q + row * 272 + permb(8 * c + 4)) = c2; }
        if (l2 < 256) { const int ig = l2 >> 4, ck = l2 & 15; float sc[4];
#pragma unroll
            for (int r = 0; r < 4; ++r) { sc[r] = 0.08838834764831845f * __expf(lg * (float)(63 - 4 * ig - r));
                u32x2 a; a.x = rkv[r].x; a.y = rkv[r].y; u32x2 c2; c2.x = rkv[r].z; c2.y = rkv[r].w;
                *(LAS u32x2*)(lds + F_K + (4 * ig + r) * 272 + permb(8 * ck)) = a; *(LAS u32x2*)(lds + F_K + (4 * ig + r) * 272 + permb(8 * ck + 4)) = c2; }
#pragma unroll
            for (int e = 0; e < 8; ++e) { const int wsel = e >> 1; float x[4];
#pragma unroll
                for (int r = 0; r < 4; ++r) x[r] = ((e & 1) ? __uint_as_float(rkv[r][wsel] & 0xffff0000u) : __uint_as_float(rkv[r][wsel] << 16)) * sc[r];
                u32x2 o; o.x = pack2(x[0], x[1]); o.y = pack2(x[2], x[3]); *(LAS u32x2*)(lds + F_KDT + (8 * ck + e) * 144 + permb(4 * ig)) = o; }
        } else { const int v = l2 - 256, igv = v >> 4, cv = v & 15;
#pragma unroll
            for (int e = 0; e < 8; ++e) { const int wsel = e >> 1, sh = 16 * (e & 1);
                u32x2 o; o.x = ((rkv[0][wsel] >> sh) & 0xffffu) | (((rkv[1][wsel] >> sh) & 0xffffu) << 16); o.y = ((rkv[2][wsel] >> sh) & 0xffffu) | (((rkv[3][wsel] >> sh) & 0xffffu) << 16);
                *(LAS u32x2*)(lds + F_VT + (8 * cv + e) * 144 + permb(4 * igv)) = o; } }
    };
    auto scores = [&]() {
#pragma unroll
        for (int rep = 0; rep < 2; ++rep) {
            const int tl = wid + 8 * rep;
            if (tl < 12) {
                int it, jt;
                if (tl < 1) { it = 0; jt = 0; } else if (tl < 3) { it = 1; jt = tl - 1; } else if (tl < 6) { it = 2; jt = tl - 3; } else if (tl < 10) { it = 3; jt = tl - 6; } else if (tl == 10) { it = 0; jt = 1; } else { it = 2; jt = 3; }
                f32x4 acc = (f32x4){0.f, 0.f, 0.f, 0.f};
                if (tl < 10) {
                    bf16x8 kf[4], qf[4];
#pragma unroll
                    for (int s4 = 0; s4 < 4; ++s4) { kf[s4] = LDF(lds + F_K + (16 * jt + fr) * 272 + 64 * s4 + 16 * q4); qf[s4] = LDF(lds + F_Q + (16 * it + fr) * 272 + 64 * s4 + 16 * q4); }
#pragma unroll
                    for (int s4 = 0; s4 < 4; ++s4) acc = MF16(kf[s4], qf[s4], acc);
                    const float gi_ = __expf(lg * (float)(16 * it + fr));
#pragma unroll
                    for (int r = 0; r < 4; ++r) { const int j = 16 * jt + 4 * q4 + r, i = 16 * it + fr;
                        acc[r] = i >= j ? acc[r] * gi_ * 0.08838834764831845f * __expf(-lg * (float)j) : 0.f; }
                }
                u32x2 w; w.x = pack2(acc[0], acc[1]); w.y = pack2(acc[2], acc[3]);
                *(LAS u32x2*)(lds + F_RAT + (16 * it + fr) * 144 + permb(16 * jt + 4 * q4)) = w;
            }
        }
    };
    RF_PREFETCH(0);
    __syncthreads();
    write_stage();
    if (CG > 1) RF_PREFETCH(1);
    __syncthreads();
    for (int n = 0; n < CG; ++n) {
        if (MODE == 1) { scores(); __syncthreads(); }
        {
            LAS const unsigned char* pq = lds + F_Q + fr * 272 + 16 * q4;
            LAS const unsigned char* pk = lds + F_KDT + fr * 144 + 16 * q4;
            bf16x8 Sb[4];
#pragma unroll
            for (int s4 = 0; s4 < 4; ++s4) Sb[s4] = pack8(S[2 * s4], S[2 * s4 + 1]);
            bf16x8 Vf[2];
#pragma unroll
            for (int s2 = 0; s2 < 2; ++s2) Vf[s2] = LDF(lds + F_VT + (16 * cw + fr) * 144 + 64 * s2 + 16 * q4);
            u32x4 RA[8], RB[8];
            f32x4 ot[4];
#define RF_LD_Q(RR, hh_) do { _Pragma("unroll") for (int i2 = 0; i2 < 2; ++i2) _Pragma("unroll") for (int s4 = 0; s4 < 4; ++s4) RR[i2 * 4 + s4] = LDR(pq + (16 * (2 * (hh_) + i2)) * 272 + 64 * s4); } while (0)
#define RF_LD_K(RR, dh_) do { _Pragma("unroll") for (int d2 = 0; d2 < 4; ++d2) _Pragma("unroll") for (int s2 = 0; s2 < 2; ++s2) RR[d2 * 2 + s2] = LDR(pk + (16 * (4 * (dh_) + d2)) * 144 + 64 * s2); } while (0)
#define RF_MM_Q(RR, hh_) do { _Pragma("unroll") for (int i2 = 0; i2 < 2; ++i2) { const int it = 2 * (hh_) + i2; ot[it] = (f32x4){0.f, 0.f, 0.f, 0.f}; \
        _Pragma("unroll") for (int s4 = 0; s4 < 4; ++s4) ot[it] = MF16(Sb[s4], asfrag(RR[i2 * 4 + s4]), ot[it]); \
        const float rd = gi[it] * g1; _Pragma("unroll") for (int r = 0; r < 4; ++r) ot[it][r] *= rd; } } while (0)
#define RF_MM_K(RR, dh_) do { _Pragma("unroll") for (int d2 = 0; d2 < 4; ++d2) { S[4 * (dh_) + d2] = S[4 * (dh_) + d2] * rcd; \
        _Pragma("unroll") for (int s2 = 0; s2 < 2; ++s2) S[4 * (dh_) + d2] = MF16(asfrag(RR[d2 * 2 + s2]), Vf[s2], S[4 * (dh_) + d2]); } } while (0)
            RF_LD_K(RA, 0); SCHED_FENCE();
            RF_LD_K(RB, 1); SCHED_FENCE(); RF_MM_K(RA, 0); SCHED_FENCE();
            if (MODE == 1) {
                RF_LD_Q(RA, 0); SCHED_FENCE(); RF_MM_K(RB, 1); SCHED_FENCE();
                RF_LD_Q(RB, 1); SCHED_FENCE(); RF_MM_Q(RA, 0); SCHED_FENCE();
                RF_MM_Q(RB, 1);
                LAS const unsigned char* pa = lds + F_RAT + fr * 144 + 16 * q4;
                RA[0] = LDR(pa); RA[1] = LDR(pa + 16 * 144); RA[2] = LDR(pa + 32 * 144); RA[3] = LDR(pa + 32 * 144 + 64); RA[4] = LDR(pa + 48 * 144); RA[5] = LDR(pa + 48 * 144 + 64);
                SCHED_FENCE();
                ot[0] = MF16(Vf[0], asfrag(RA[0]), ot[0]); ot[1] = MF16(Vf[0], asfrag(RA[1]), ot[1]);
                ot[2] = MF16(Vf[0], asfrag(RA[2]), ot[2]); ot[2] = MF16(Vf[1], asfrag(RA[3]), ot[2]);
                ot[3] = MF16(Vf[0], asfrag(RA[4]), ot[3]); ot[3] = MF16(Vf[1], asfrag(RA[5]), ot[3]);
                scan_store_ot(out + ((size_t)b * SEQ + (size_t)(n0 + n) * 64 + fr) * DM + h * 128 + 16 * cw + 4 * q4, ot);
            } else { RF_MM_K(RB, 1); }
#undef RF_LD_Q
#undef RF_LD_K
#undef RF_MM_Q
#undef RF_MM_K
        }
        __syncthreads();
        if (n + 1 < CG) { write_stage(); if (n + 2 < CG) RF_PREFETCH(n + 2); }
        __syncthreads();
    }
    if (MODE == 0) {
        f32x4* lp = (f32x4*)Lb + (((size_t)(b * 4 + h) * NG + g) * 8 + cw) * 8 * 64 + lane;
#pragma unroll
        for (int dt = 0; dt < 8; ++dt) lp[dt * 64] = S[dt];
    }
#undef RF_PREFETCH
}

__device__ __forceinline__ void phase_ret_local(KPTR p, LAS unsigned char* lds, int bid, int nb, int wv) {
    constexpr int NIT0 = BATCH * 4 * NG;
    for (int it = bid; it < NIT0; it += nb) {
        const int g = it % NG, bh = it / NG;
        __syncthreads();
        scan_ret_full<0>(p, lds, bh >> 2, bh & 3, g, wv);
    }
}
template <bool OVERLAP>
__device__ __forceinline__ void phase_scan(KPTR p, LAS unsigned char* lds, int bid, int nb, int wv) {
    constexpr int QN = 8 / NCW;
    constexpr int G = BATCH * 4;
    constexpr int NUG = ((G + 7) / 8) * 8 * QN;
    for (int unit = bid; unit < NUG; unit += nb) {
        const int xcd = unit & 7, t = unit >> 3, qt = t % QN, bh = (t / QN) * 8 + xcd;
        if (bh >= G) continue;
        __syncthreads();
        for (int rp = 0; rp < RPT_SG; ++rp) scan_gdn<OVERLAP>(p, lds, bh >> 2, bh & 3, qt, wv);
    }
    if (OVERLAP && bid >= NUG) { __syncthreads(); phase_gdn_pre<true>(p, lds, bid - NUG, nb - NUG, wv); }
    constexpr int NIT1 = G * NG;
    const int first = nb > NUG ? NUG : 0, step = nb > NUG ? nb - NUG : nb;
    if (bid >= first) {
        for (int it = bid - first; it < NIT1; it += step) {
            const int g = it % NG, bh = it / NG;
            __syncthreads();
            for (int rp = 0; rp < RPT_SR; ++rp) scan_ret_full<1>(p, lds, bh >> 2, bh & 3, g, wv);
        }
    }
}

__device__ __forceinline__ void phase_gatednorm(KPTR p, int bid, int nb, int wv) {
    const int tid = opaque_tid(wv), wid = tid >> 6, lane = tid & 63;
    const int hh = lane >> 3, c0 = lane * 16;
    const float* nwp = (hh < 4 ? p->ret_norm + hh * 128 : p->gdn_norm + (hh - 4) * 128) + (lane & 7) * 16;
    float nw[16];
#pragma unroll
    for (int i = 0; i < 4; ++i) { const f32x4 t4 = *(const f32x4*)(nwp + 4 * i); nw[4 * i] = t4[0]; nw[4 * i + 1] = t4[1]; nw[4 * i + 2] = t4[2]; nw[4 * i + 3] = t4[3]; }
    const int gcol = (hh < 4 ? 1536 + hh * 128 : 3584 + (hh - 4) * 128) + (lane & 7) * 16;
    for (int t = bid * 8 + wid; t < NTOK; t += nb * 8) {
        bf16_t* o = p->hn + (size_t)t * DM + c0;
        const u32x4 o0 = *(const u32x4*)o, o1 = *(const u32x4*)(o + 8);
        const bf16_t* gp = p->proj + (size_t)t * DINP + gcol;
        const u32x4 g0 = *(const u32x4*)gp, g1 = *(const u32x4*)(gp + 8);
        float a[16], g[16];
#pragma unroll
        for (int i = 0; i < 4; ++i) { a[2 * i] = __uint_as_float(o0[i] << 16); a[2 * i + 1] = __uint_as_float(o0[i] & 0xffff0000u); a[8 + 2 * i] = __uint_as_float(o1[i] << 16); a[8 + 2 * i + 1] = __uint_as_float(o1[i] & 0xffff0000u);
            g[2 * i] = __uint_as_float(g0[i] << 16); g[2 * i + 1] = __uint_as_float(g0[i] & 0xffff0000u); g[8 + 2 * i] = __uint_as_float(g1[i] << 16); g[8 + 2 * i + 1] = __uint_as_float(g1[i] & 0xffff0000u); }
        float ss = 0.f;
#pragma unroll
        for (int i = 0; i < 16; ++i) ss += a[i] * a[i];
        ss += __shfl_xor(ss, 1); ss += __shfl_xor(ss, 2); ss += __shfl_xor(ss, 4);
        const float rs = rsqrtf(ss * (1.0f / 128.f) + NORM_EPS);
        u32x4 w0, w1;
#pragma unroll
        for (int i = 0; i < 4; ++i) { w0[i] = pack2(a[2 * i] * rs * nw[2 * i] * siluf(g[2 * i]), a[2 * i + 1] * rs * nw[2 * i + 1] * siluf(g[2 * i + 1]));
            w1[i] = pack2(a[8 + 2 * i] * rs * nw[8 + 2 * i] * siluf(g[8 + 2 * i]), a[8 + 2 * i + 1] * rs * nw[8 + 2 * i + 1] * siluf(g[8 + 2 * i + 1])); }
        *(u32x4*)o = w0; *(u32x4*)(o + 8) = w1;
    }
}

__device__ __forceinline__ void phase_kmean(KPTR p, LAS unsigned char* lds, int bid, int nb, int wv) {
    const int tid = opaque_tid(wv);
    LAS float* red = (LAS float*)lds;
    const int rg = tid >> 4, c = tid & 15;
    for (int unit = bid; unit < NIT; unit += nb) {
        const int blk = unit % NBLK, h = (unit / NBLK) & 7, b = unit / (NBLK * 8);
        const bf16_t* kp = p->qkv + ((size_t)b * SEQ + (size_t)blk * 256 + rg) * 3072 + 1024 + h * 128 + c * 8;
        float a[8];
#pragma unroll
        for (int j = 0; j < 8; ++j) a[j] = 0.f;
#pragma unroll
        for (int i = 0; i < 8; ++i) { const u32x4 w = *(const u32x4*)(kp + (size_t)(32 * i) * 3072);
            a[0] += __uint_as_float(w.x << 16); a[1] += __uint_as_float(w.x & 0xffff0000u); a[2] += __uint_as_float(w.y << 16); a[3] += __uint_as_float(w.y & 0xffff0000u);
            a[4] += __uint_as_float(w.z << 16); a[5] += __uint_as_float(w.z & 0xffff0000u); a[6] += __uint_as_float(w.w << 16); a[7] += __uint_as_float(w.w & 0xffff0000u); }
        __syncthreads();
#pragma unroll
        for (int j = 0; j < 8; ++j) red[rg * 128 + c * 8 + j] = a[j];
        __syncthreads();
        if (tid < 128) { float s2 = 0.f;
#pragma unroll
            for (int g = 0; g < 32; ++g) s2 += red[g * 128 + tid];
            s2 *= (1.0f / 256.f);
            const bf16_t hi = f2bf(s2);
            p->kmh[(size_t)unit * 128 + tid] = hi; p->kml[(size_t)unit * 128 + tid] = f2bf(s2 - bf2f(hi)); }
    }
}
__device__ __forceinline__ void phase_moba_select(KPTR p, LAS unsigned char* lds, int bid, int nb, int wv) {
    const int tid = opaque_tid(wv), wid = tid >> 6, lane = tid & 63, fr = lane & 15, fq = lane >> 4;
    LAS float* sg = (LAS float*)lds + wid * (16 * 65);
    LAS unsigned* cnt = (LAS unsigned*)(lds + 8 * 16 * 65 * 4);
    LAS unsigned* gbase = cnt + 64;
    const int TPS = SEQ / 128, NU = BATCH * 8 * TPS;
    const bf16_t* qkv = p->qkv; const bf16_t* kmh = p->kmh; const bf16_t* kml = p->kml; unsigned* mcount = p->mcount; unsigned short* mlist = p->mlist; float* part_lse = p->part_lse;
    for (int unit = bid; unit < NU; unit += nb) {
        const int tile = unit % TPS, h = (unit / TPS) & 7, b = unit / (TPS * 8), bh = b * 8 + h;
        const int t0 = tile * 128 + wid * 16, own = (tile * 128) >> 8;
        if (tid < 64) cnt[tid] = 0u;
        if (own > 0) {
            f32x4 acc[GNT];
#pragma unroll
            for (int nt = 0; nt < GNT; ++nt) acc[nt] = (f32x4){0.f, 0.f, 0.f, 0.f};
            const bf16_t* qrow = qkv + ((size_t)b * SEQ + t0 + fr) * 3072 + h * 128 + 8 * fq;
#pragma unroll
            for (int s4 = 0; s4 < 4; ++s4) {
                const bf16x8 a = *(const bf16x8*)(qrow + 32 * s4);
#pragma unroll
                for (int nt = 0; nt < GNT; ++nt) {
                    int blk = 16 * nt + fr; blk = blk < NBLK ? blk : NBLK - 1;
                    const size_t ko = ((size_t)bh * NBLK + blk) * 128 + 32 * s4 + 8 * fq;
                    const bf16x8 b1 = *(const bf16x8*)(kmh + ko), b2 = *(const bf16x8*)(kml + ko);
                    acc[nt] = __builtin_amdgcn_mfma_f32_16x16x32_bf16(a, b1, acc[nt], 0, 0, 0);
                    acc[nt] = __builtin_amdgcn_mfma_f32_16x16x32_bf16(a, b2, acc[nt], 0, 0, 0);
                }
            }
#pragma unroll
            for (int nt = 0; nt < GNT; ++nt)
#pragma unroll
                for (int r = 0; r < 4; ++r) sg[(4 * fq + r) * 65 + 16 * nt + fr] = acc[nt][r];
        }
        __syncthreads();
        int i0 = -1, i1 = -1, i2 = -1; unsigned r0 = 0, r1 = 0, r2 = 0;
        if (lane < 16) {
            float v0 = -3e38f, v1 = -3e38f, v2 = -3e38f;
            for (int j = 0; j < own; ++j) {
                const float g = sg[lane * 65 + j];
                if (g > v0) { v2 = v1; i2 = i1; v1 = v0; i1 = i0; v0 = g; i0 = j; }
                else if (g > v1) { v2 = v1; i2 = i1; v1 = g; i1 = j; }
                else if (g > v2) { v2 = g; i2 = j; }
            }
            if (i0 >= 0) r0 = LDS_ATOMIC_ADD(cnt + i0, 1u);
            if (i1 >= 0) r1 = LDS_ATOMIC_ADD(cnt + i1, 1u);
            if (i2 >= 0) r2 = LDS_ATOMIC_ADD(cnt + i2, 1u);
        }
        __syncthreads();
        if (tid < 64 && tid < own) { const unsigned c = cnt[tid]; if (c > 0u) gbase[tid] = atomicAdd(mcount + bh * NBLK + tid, c); }
        __syncthreads();
        if (lane < 16) {
            const int t = t0 + lane;
            const size_t pb = ((size_t)((size_t)b * SEQ + t) * 8 + h) * 3;
            unsigned short* lst = mlist + (size_t)bh * LTOT;
            if (i0 >= 0) lst[list_off(i0) + gbase[i0] + r0] = (unsigned short)(((unsigned)t << 2) | 0u); else part_lse[pb + 0] = -1e30f;
            if (i1 >= 0) lst[list_off(i1) + gbase[i1] + r1] = (unsigned short)(((unsigned)t << 2) | 1u); else part_lse[pb + 1] = -1e30f;
            if (i2 >= 0) lst[list_off(i2) + gbase[i2] + r2] = (unsigned short)(((unsigned)t << 2) | 2u); else part_lse[pb + 2] = -1e30f;
        }
    }
}

__device__ __forceinline__ void moba_stage_kv(const bf16_t* qkv, LAS unsigned char* Ks, LAS unsigned char* VTs, int b, int h, int j, int tid) {
    OPAQUE_V(tid);
    const bf16_t* kbase = qkv + ((size_t)b * SEQ + (size_t)j * 256) * 3072 + 1024 + h * 128;
    const bf16_t* vbase = kbase + 1024;
#pragma unroll
    for (int i = 0; i < 8; ++i) { const int id = tid + NTHREADS * i, key = id >> 4, c = id & 15;
        *(LAS u32x4*)(Ks + key * KS_STRIDE + c * 16) = *(const u32x4*)(kbase + (size_t)key * 3072 + c * 8); }
#pragma unroll
    for (int i = 0; i < 2; ++i) { const int id = tid + NTHREADS * i, c = (id & 3) | (((id >> 4) & 3) << 2), g = ((id >> 2) & 3) | ((id >> 6) << 2);
        u32x4 r0 = *(const u32x4*)(vbase + (size_t)(4 * g) * 3072 + c * 8), r1 = *(const u32x4*)(vbase + (size_t)(4 * g + 1) * 3072 + c * 8);
        u32x4 r2 = *(const u32x4*)(vbase + (size_t)(4 * g + 2) * 3072 + c * 8), r3 = *(const u32x4*)(vbase + (size_t)(4 * g + 3) * 3072 + c * 8);
#pragma unroll
        for (int e = 0; e < 8; ++e) { const int wsel = e >> 1, sh = 16 * (e & 1);
            const unsigned x0 = (r0[wsel] >> sh) & 0xffffu, x1 = (r1[wsel] >> sh) & 0xffffu, x2 = (r2[wsel] >> sh) & 0xffffu, x3 = (r3[wsel] >> sh) & 0xffffu;
            u32x2 o; o.x = x0 | (x1 << 16); o.y = x2 | (x3 << 16);
            *(LAS u32x2*)(VTs + (8 * c + e) * VT_STRIDE + 8 * g) = o; }
    }
}
struct AttnState { f32x16 o[4]; float m, l; };
typedef float f32p2 __attribute__((ext_vector_type(2)));
#ifndef CPU_EMU
__device__ __forceinline__ u32x4 swap16(const u32x4 w, int) {
    const u32x2 r0 = __builtin_amdgcn_permlane32_swap(w.x, w.z, false, false), r1 = __builtin_amdgcn_permlane32_swap(w.y, w.w, false, false);
    u32x4 o; o.x = r0.x; o.z = r0.y; o.y = r1.x; o.w = r1.y; return o; }
#else
static inline u32x4 swap16(const u32x4 w, int lane) {
    unsigned a0 = w.x, b0 = w.z, a1 = w.y, b1 = w.w;
    const unsigned a0o = __shfl(a0, lane ^ 32), b0o = __shfl(b0, lane ^ 32), a1o = __shfl(a1, lane ^ 32), b1o = __shfl(b1, lane ^ 32);
    if (lane < 32) { b0 = a0o; b1 = a1o; } else { a0 = b0o; a1 = b1o; }
    u32x4 o; o.x = a0; o.y = a1; o.z = b0; o.w = b1; return o; }
#endif
template <bool CAUSAL>
__device__ __forceinline__ void attn_block(LAS const unsigned char* Ks, LAS const unsigned char* VTs, const bf16x8 (&qf)[8], float bias0, float slope, int qloc, int wtile, int lane, AttnState& st) {
    const int l31 = lane & 31, h2 = lane >> 5;
    constexpr float L2E = 1.4426950408889634f;
    const float scale2 = 0.08838834764831845f * L2E, slope2 = slope * L2E;
    const float bb = __builtin_fmaf(slope2, (float)(4 * h2), bias0 * L2E);
#pragma unroll 1
    for (int hf = 0; hf < 2; ++hf) {
        if (CAUSAL && 4 * hf > wtile) break;
        LAS const unsigned char* kbase = Ks + (128 * hf + l31) * KS_STRIDE + 16 * h2;
        LAS const unsigned char* vbase = VTs + l31 * VT_STRIDE + (128 * hf + 4 * h2) * 2;
        f32x16 sv[4];
#pragma unroll
        for (int kt = 0; kt < 4; ++kt) {
            const int kt4 = 4 * hf + kt;
            f32x16 acc;
#pragma unroll
            for (int r = 0; r < 16; ++r) acc[r] = 0.f;
            if (!CAUSAL || kt4 <= wtile) {
#pragma unroll
                for (int s8 = 0; s8 < 8; ++s8) { const bf16x8 a = *(LAS const bf16x8*)(kbase + (32 * kt) * KS_STRIDE + 32 * s8);
                    acc = __builtin_amdgcn_mfma_f32_32x32x16_bf16(a, qf[s8], acc, 0, 0, 0);
                    if (s8 == 3) SCHED_FENCE(); }
                const float kb = __builtin_fmaf(slope2, (float)(32 * kt4), bb);
                const f32p2 sc2 = {scale2, scale2}, sl2 = {slope2, slope2}, kb2 = {kb, kb};
#pragma unroll
                for (int r = 0; r < 16; r += 2) { const int cr0 = (r & 3) + 8 * (r >> 2), cr1 = ((r + 1) & 3) + 8 * ((r + 1) >> 2);
                    const f32p2 c2 = {(float)cr0, (float)cr1}, a2 = {acc[r], acc[r + 1]};
                    f32p2 v2 = __builtin_elementwise_fma(a2, sc2, __builtin_elementwise_fma(sl2, c2, kb2));
                    if (CAUSAL && kt4 == wtile) { if (32 * kt4 + cr0 + 4 * h2 > qloc) v2.x = -1e30f; if (32 * kt4 + cr1 + 4 * h2 > qloc) v2.y = -1e30f; }
                    acc[r] = v2.x; acc[r + 1] = v2.y; }
            } else {
#pragma unroll
                for (int r = 0; r < 16; ++r) acc[r] = -1e30f;
            }
            sv[kt] = acc;
            SCHED_FENCE();
        }
        float mx = -1e30f;
#pragma unroll
        for (int kt = 0; kt < 4; ++kt)
#pragma unroll
            for (int r = 0; r < 16; ++r) mx = fmaxf(mx, sv[kt][r]);
        mx = fmaxf(mx, __shfl_xor(mx, 32));
        const float mnew = fmaxf(st.m, mx);
        const float alpha = __builtin_amdgcn_exp2f(st.m - mnew);
        st.m = mnew;
        f32p2 ls2 = {0.f, 0.f}; const f32p2 mn2 = {mnew, mnew};
#pragma unroll
        for (int kt = 0; kt < 4; ++kt)
#pragma unroll
            for (int r = 0; r < 16; r += 2) { const f32p2 d2 = (f32p2){sv[kt][r], sv[kt][r + 1]} - mn2;
                const f32p2 p2 = {__builtin_amdgcn_exp2f(d2.x), __builtin_amdgcn_exp2f(d2.y)};
                sv[kt][r] = p2.x; sv[kt][r + 1] = p2.y; ls2 += p2; }
        st.l = st.l * alpha + (ls2.x + ls2.y);
#pragma unroll
        for (int dt = 0; dt < 4; ++dt)
#pragma unroll
            for (int r = 0; r < 16; ++r) st.o[dt][r] *= alpha;
#pragma unroll
        for (int kt = 0; kt < 4; ++kt) {
            const int kt4 = 4 * hf + kt;
            if (CAUSAL && kt4 > wtile) continue;
#pragma unroll
            for (int s2 = 0; s2 < 2; ++s2) {
                u32x4 pw; pw.x = pack2(sv[kt][8 * s2 + 0], sv[kt][8 * s2 + 1]); pw.y = pack2(sv[kt][8 * s2 + 2], sv[kt][8 * s2 + 3]); pw.z = pack2(sv[kt][8 * s2 + 4], sv[kt][8 * s2 + 5]); pw.w = pack2(sv[kt][8 * s2 + 6], sv[kt][8 * s2 + 7]);
                bf16x8 pf; __builtin_memcpy(&pf, &pw, 16);
#pragma unroll
                for (int dt = 0; dt < 4; ++dt) {
                    LAS const unsigned char* vp = vbase + (32 * dt) * VT_STRIDE + (32 * kt + 16 * s2) * 2;
                    const u32x2 lo = *(LAS const u32x2*)vp, hi = *(LAS const u32x2*)(vp + 16);
                    u32x4 aw; aw.x = lo.x; aw.y = lo.y; aw.z = hi.x; aw.w = hi.y;
                    bf16x8 a; __builtin_memcpy(&a, &aw, 16);
                    st.o[dt] = __builtin_amdgcn_mfma_f32_32x32x16_bf16(a, pf, st.o[dt], 0, 0, 0);
                }
                SCHED_FENCE();
            }
        }
    }
}
__device__ __forceinline__ void load_qfrag(const bf16_t* qrow, int h2, bf16x8 (&qf)[8]) {
#pragma unroll
    for (int s8 = 0; s8 < 8; ++s8) qf[s8] = *(const bf16x8*)(qrow + 16 * s8 + 8 * h2);
}

__device__ __forceinline__ void phase_moba_gather(KPTR p, LAS unsigned char* lds, int bid, int nb, int wv) {
#ifndef CPU_EMU
    const int tid = opaque_tid(wv), wid = wv, lane = tid & 63, l31 = lane & 31, h2 = lane >> 5;
#else
    const int tid = opaque_tid(wv), wid = tid >> 6, lane = tid & 63, l31 = lane & 31, h2 = lane >> 5;
#endif
    LAS unsigned char* Ks = lds; LAS unsigned char* VTs = lds + KS_BYTES;
    LAS unsigned* pref = (LAS unsigned*)(lds + KS_BYTES + VT_BYTES);
    LAS unsigned* wsum = pref + NIT + 1;
    const bf16_t* qkv = p->qkv; const unsigned* mcount = p->mcount; const unsigned short* mlist = p->mlist;
    constexpr int IPT = (NIT + NTHREADS - 1) / NTHREADS;
    unsigned loc[IPT]; unsigned tsum = 0;
#pragma unroll
    for (int i = 0; i < IPT; ++i) { const int it = tid * IPT + i; const unsigned c = it < NIT ? mcount[it] : 0u; loc[i] = c ? 1u + 2u * ((c + 255u) >> 8) : 0u; tsum += loc[i]; }
    unsigned inc = tsum;
    for (int o = 1; o < 64; o <<= 1) { const unsigned t2 = __shfl_up(inc, o); if (lane >= o) inc += t2; }
    if (lane == 63) wsum[wid] = inc;
    __syncthreads();
    unsigned wbase = 0;
#pragma unroll
    for (int w = 0; w < 8; ++w) if (w < wid) wbase += wsum[w];
    unsigned run = wbase + inc - tsum;
#pragma unroll
    for (int i = 0; i < IPT; ++i) { const int it = tid * IPT + i; if (it < NIT) pref[it] = run; run += loc[i]; }
    if (tid == NTHREADS - 1) pref[NIT] = run;
    __syncthreads();
    const unsigned C = pref[NIT];
    const unsigned lo = (unsigned)(((unsigned long long)C * (unsigned)bid) / (unsigned)nb), hi = (unsigned)(((unsigned long long)C * (unsigned)(bid + 1)) / (unsigned)nb);
    if (lo >= hi) return;
    int first = 0; { int a = 0, c = NIT; while (c - a > 1) { const int mid = (a + c) >> 1; if (pref[mid] <= lo) a = mid; else c = mid; } first = a; }
    for (int it = first; it < NIT; ++it) {
        const unsigned ps = pref[it], pe = pref[it + 1];
        if (ps >= hi) break;
        if (pe <= lo || pe == ps) continue;
        const unsigned nr = (pe - ps - 1u) >> 1;
        unsigned r_lo = 0; if (lo > ps + 1u) r_lo = (lo - ps - 1u + 1u) >> 1;
        unsigned r_hi = nr; if (hi < ps + 1u + 2u * nr) r_hi = hi > ps + 1u ? (hi - ps - 1u + 1u) >> 1 : 0u;
        if (r_lo >= r_hi) continue;
        const int j = it % NBLK, h = (it / NBLK) & 7, b = it / (NBLK * 8), bh = b * 8 + h;
        const unsigned cnt = mcount[it];
        const unsigned ra = r_lo * 256u, rb = (r_hi * 256u) < cnt ? (r_hi * 256u) : cnt;
        __syncthreads();
        moba_stage_kv(qkv, Ks, VTs, b, h, j, tid);
        __syncthreads();
        const float slope = exp2f(-(float)(h + 1));
        const unsigned short* lst = mlist + (size_t)bh * LTOT + list_off(j);
        unsigned ent_next = 0;
        int l31i = l31; OPAQUE_V(l31i);
        { const unsigned row = ra + 32u * wid + l31i; if (ra + 32u * wid < rb) ent_next = lst[row < rb ? row : (rb - 1)]; }
        for (unsigned r0 = ra + 32u * wid; r0 < rb; r0 += 256u) {
            const unsigned row = r0 + l31i; const bool active = row < rb;
            const unsigned ent = ent_next;
            if (r0 + 256u < rb) { const unsigned rn = row + 256u; ent_next = lst[rn < rb ? rn : (rb - 1)]; }
            const int t = (int)(ent >> 2), k = (int)(ent & 3u);
            int h2q = h2; OPAQUE_V(h2q);
            bf16x8 qf[8]; load_qfrag(qkv + ((size_t)b * SEQ + t) * 3072 + h * 128, h2q, qf);
            AttnState st;
#pragma unroll
            for (int dt = 0; dt < 4; ++dt)
#pragma unroll
                for (int r = 0; r < 16; ++r) st.o[dt][r] = 0.f;
            st.m = -1e30f; st.l = 0.f;
            attn_block<false>(Ks, VTs, qf, slope * (float)(256 * j - t), slope, 0, 0, lane, st);
            const float lt = st.l + __shfl_xor(st.l, 32);
            const float inv = 1.0f / lt;
            {
                const size_t pb = ((size_t)((size_t)b * SEQ + t) * 8 + h) * 3 + k;
                bf16_t* po = p->part_o + pb * 128;
#pragma unroll
                for (int dt = 0; dt < 4; ++dt)
#pragma unroll
                    for (int gp = 0; gp < 4; gp += 2) { u32x4 w;
                        w.x = pack2(st.o[dt][4 * gp] * inv, st.o[dt][4 * gp + 1] * inv); w.y = pack2(st.o[dt][4 * gp + 2] * inv, st.o[dt][4 * gp + 3] * inv);
                        w.z = pack2(st.o[dt][4 * gp + 4] * inv, st.o[dt][4 * gp + 5] * inv); w.w = pack2(st.o[dt][4 * gp + 6] * inv, st.o[dt][4 * gp + 7] * inv);
                        w = swap16(w, lane);
                        if (active) *(u32x4*)(po + 32 * dt + 8 * (gp + h2)) = w; }
                if (active && h2 == 0) p->part_lse[pb] = st.m * 0.6931471805599453f + __logf(lt);
            }
        }
    }
}
__device__ __forceinline__ void phase_moba_own(KPTR p, LAS unsigned char* lds, int bid, int nb, int wv) {
    const int tid = opaque_tid(wv), wid = tid >> 6, lane = tid & 63, l31 = lane & 31, h2 = lane >> 5;
    LAS unsigned char* Ks = lds; LAS unsigned char* VTs = lds + KS_BYTES;
    const bf16_t* qkv = p->qkv; const bf16_t* part_o = p->part_o; const float* part_lse = p->part_lse; bf16_t* out = p->hn;
    for (int it = bid; it < NIT; it += nb) {
        const int j = it % NBLK, h = (it / NBLK) & 7, b = it / (NBLK * 8);
        const float slope = exp2f(-(float)(h + 1));
        const int qloc = 32 * wid + l31, t = j * 256 + qloc;
        bf16x8 qf[8]; load_qfrag(qkv + ((size_t)b * SEQ + t) * 3072 + h * 128, h2, qf);
        __syncthreads();
        moba_stage_kv(qkv, Ks, VTs, b, h, j, tid);
        __syncthreads();
        AttnState st;
#pragma unroll
        for (int dt = 0; dt < 4; ++dt)
#pragma unroll
            for (int r = 0; r < 16; ++r) st.o[dt][r] = 0.f;
        st.m = -1e30f; st.l = 0.f;
        attn_block<true>(Ks, VTs, qf, slope * (float)(-qloc), slope, qloc, wid, lane, st);
        const float lt = st.l + __shfl_xor(st.l, 32);
        const float lse_own = st.m * 0.6931471805599453f + __logf(lt);
        const size_t pb = ((size_t)((size_t)b * SEQ + t) * 8 + h) * 3;
        const float l0 = part_lse[pb], l1 = part_lse[pb + 1], l2 = part_lse[pb + 2];
        const float M = fmaxf(fmaxf(lse_own, l0), fmaxf(l1, l2));
        const float w_own = __expf(lse_own - M), w0 = __expf(l0 - M), w1 = __expf(l1 - M), w2 = __expf(l2 - M);
        const float Wi = 1.0f / (w_own + w0 + w1 + w2);
        const float c_own = w_own * Wi / lt, c0 = w0 * Wi, c1 = w1 * Wi, c2 = w2 * Wi;
        bf16_t* orow = out + ((size_t)b * SEQ + t) * DM + h * 128;
        const bool v0 = l0 > -1e29f, v1 = l1 > -1e29f, v2 = l2 > -1e29f;
#pragma unroll
        for (int dt = 0; dt < 4; ++dt) {
            u32x2 pw[3][4]; u32x4 pq[3][2];
#pragma unroll
            for (int k = 0; k < 3; ++k)
#pragma unroll
                for (int gp = 0; gp < 2; ++gp) pq[k][gp] = *(const u32x4*)(part_o + (pb + k) * 128 + 32 * dt + 8 * (2 * gp + h2));
#pragma unroll
            for (int k = 0; k < 3; ++k)
#pragma unroll
                for (int gp = 0; gp < 2; ++gp) { const u32x4 q = swap16(pq[k][gp], lane); pw[k][2 * gp].x = q.x; pw[k][2 * gp].y = q.y; pw[k][2 * gp + 1].x = q.z; pw[k][2 * gp + 1].y = q.w; }
            u32x2 wo4[4];
#pragma unroll
            for (int g = 0; g < 4; ++g) {
                const int d0 = 32 * dt + 8 * g + 4 * h2;
                float v[4];
#pragma unroll
                for (int e = 0; e < 4; ++e) v[e] = st.o[dt][4 * g + e] * c_own;
#pragma unroll
                for (int k = 0; k < 3; ++k) {
                    const bool vk = k == 0 ? v0 : (k == 1 ? v1 : v2); const float ck = k == 0 ? c0 : (k == 1 ? c1 : c2);
                    const u32x2 w = pw[k][g];
                    const float f0 = __uint_as_float(w.x << 16), f1 = __uint_as_float(w.x & 0xffff0000u), f2 = __uint_as_float(w.y << 16), f3 = __uint_as_float(w.y & 0xffff0000u);
                    v[0] += vk ? ck * f0 : 0.f; v[1] += vk ? ck * f1 : 0.f; v[2] += vk ? ck * f2 : 0.f; v[3] += vk ? ck * f3 : 0.f;
                }
                wo4[g].x = pack2(v[0], v[1]); wo4[g].y = pack2(v[2], v[3]);
            }
#pragma unroll
            for (int gp = 0; gp < 4; gp += 2) { u32x4 w; w.x = wo4[gp].x; w.y = wo4[gp].y; w.z = wo4[gp + 1].x; w.w = wo4[gp + 1].y;
                w = swap16(w, lane);
                *(u32x4*)(orow + 32 * dt + 8 * (gp + h2)) = w; }
        }
    }
}

__device__ __forceinline__ void phase_router(KPTR p, LAS unsigned char* lds, int bid, int nb, int wv) {
    const int tid = opaque_tid(wv), wid = tid >> 6, lane = tid & 63;
    LAS unsigned* hist = (LAS unsigned*)lds;
    if (tid < 8) hist[tid] = 0u;
    __syncthreads();
    f32x4 gv[4];
#pragma unroll
    for (int i = 0; i < 4; ++i) gv[i] = *(const f32x4*)(p->ffn_norm + DM + i * 256 + lane * 4);
    const int rpw = (NTOK + nb - 1) / nb, rbeg = bid * rpw, rend = (rbeg + rpw) < NTOK ? (rbeg + rpw) : NTOK;
    f32x4 w8[16][2];
#pragma unroll
    for (int i = 0; i < 4; ++i)
#pragma unroll
        for (int e = 0; e < 4; ++e) { const float* wr_ = p->w_router + (size_t)(i * 256 + lane * 4 + e) * 8; w8[i * 4 + e][0] = *(const f32x4*)wr_; w8[i * 4 + e][1] = *(const f32x4*)(wr_ + 4); }
    for (int row = rbeg + wid; row < rend; row += 8) {
        f32x4 v[4]; load_row_b(p->hb3, row, lane, v);
        const float rs = row_rstd(v);
#pragma unroll
        for (int i = 0; i < 4; ++i) v[i] = v[i] * rs * gv[i];
        store_row_fp8((unsigned char*)p->hn, p->hns, row, lane, v);
        { float ss = 0.f;
#pragma unroll
          for (int i = 0; i < 4; ++i) ss += v[i][0] * v[i][0] + v[i][1] * v[i][1] + v[i][2] * v[i][2] + v[i][3] * v[i][3];
          ss = wave_sum(ss); if (lane == 0) p->hnn2[row] = ss; }
        f32x4 d0 = (f32x4){0.f, 0.f, 0.f, 0.f}, d1 = (f32x4){0.f, 0.f, 0.f, 0.f};
#pragma unroll
        for (int i = 0; i < 4; ++i)
#pragma unroll
            for (int e = 0; e < 4; ++e) { const float xv = v[i][e]; d0 = d0 + w8[i * 4 + e][0] * xv; d1 = d1 + w8[i * 4 + e][1] * xv; }
        float d[8] = {d0[0], d0[1], d0[2], d0[3], d1[0], d1[1], d1[2], d1[3]};
#pragma unroll
        for (int j = 0; j < 8; ++j) d[j] = wave_sum(d[j]);
        int i0 = 0; float m0 = d[0];
#pragma unroll
        for (int j = 1; j < 8; ++j) if (d[j] > m0) { m0 = d[j]; i0 = j; }
        int i1 = -1; float m1 = -3e38f;
#pragma unroll
        for (int j = 0; j < 8; ++j) if (j != i0 && d[j] > m1) { m1 = d[j]; i1 = j; }
        if (lane == 0) {
            const float e1 = __expf(m1 - m0); const float g0 = 1.0f / (1.0f + e1);
            p->midx[row * 2] = i0; p->midx[row * 2 + 1] = i1; p->mgate[row * 2] = g0; p->mgate[row * 2 + 1] = e1 * g0;
            LDS_ATOMIC_ADD(hist + i0, 1u); LDS_ATOMIC_ADD(hist + i1, 1u);
        }
    }
    __syncthreads();
    if (tid < 8) p->wghist[bid * 8 + tid] = hist[tid];
}
__device__ __forceinline__ void phase_slots(KPTR p, LAS unsigned char* lds, int bid, int nb, int wv) {
    const int tid = opaque_tid(wv);
    LAS unsigned* ltot = (LAS unsigned*)lds; LAS unsigned* lpre = ltot + 8; LAS unsigned* lcur = ltot + 16;
    if (tid < 24) ltot[tid] = 0u;
    __syncthreads();
    { const int e = tid & 7; unsigned tot = 0, pre = 0;
      for (int bb = tid >> 3; bb < nb; bb += NTHREADS / 8) { const unsigned v = p->wghist[bb * 8 + e]; tot += v; if (bb < bid) pre += v; }
      LDS_ATOMIC_ADD(ltot + e, tot); LDS_ATOMIC_ADD(lpre + e, pre); }
    __syncthreads();
    unsigned base[NE], cnt[NE]; unsigned acc = 0; float gu[NE];
#pragma unroll
    for (int e = 0; e < NE; ++e) { cnt[e] = ltot[e]; base[e] = acc; acc += (cnt[e] + 255u) & ~255u; gu[e] = __uint_as_float(p->ctrl[C_GMAX + e]) * __uint_as_float(p->ctrl[C_UMAX + e]); }
    const int rpw = (NTOK + nb - 1) / nb, rbeg = bid * rpw, rend = (rbeg + rpw) < NTOK ? (rbeg + rpw) : NTOK;
    for (int a = rbeg * 2 + tid; a < rend * 2; a += NTHREADS) {
        const int e = p->midx[a];
        unsigned b0 = 0;
#pragma unroll
        for (int j = 0; j < NE; ++j) if (j == e) b0 = base[j];
        const unsigned s = b0 + lpre[e] + LDS_ATOMIC_ADD(lcur + e, 1u);
        p->slot_of[a] = (int)s; p->arow[s] = a >> 1; p->sslot[s] = p->hns[a >> 1];
        float gm = 0.f;
#pragma unroll
        for (int j = 0; j < NE; ++j) if (j == e) gm = gu[j];
        p->shs[s] = p->hnn2[a >> 1] * gm * (1.0f / 256.f);
    }
    if (bid == 0) {
        if (tid == 0) { p->ctrl[C_NTILES] = acc >> 8; p->ctrl[C_TB + NE] = acc >> 8; }
        if (tid < NE) { unsigned bb = 0;
#pragma unroll
            for (int e = 0; e < NE; ++e) if (e == tid) bb = base[e];
            p->ctrl[C_TB + tid] = bb >> 8; }
#pragma unroll
        for (int e = 0; e < NE; ++e) {
            const unsigned lo = base[e] + cnt[e], hi = base[e] + ((cnt[e] + 255u) & ~255u);
            for (unsigned s2 = lo + tid; s2 < hi; s2 += NTHREADS) { p->arow[s2] = 0; p->sslot[s2] = 0.f; p->shs[s2] = 1.0f; }
            for (unsigned t = (base[e] >> 8) + tid; t < (hi >> 8); t += NTHREADS) p->tile_e[t] = e;
        }
    }
}
__device__ __forceinline__ void phase_final(KPTR p, const bf16_t* hsrc, int lo, int hi, int bid, int nb, int wv) {
    const int tid = opaque_tid(wv), wid = tid >> 6, lane = tid & 63;
    f32x4 gv[4];
#pragma unroll
    for (int i = 0; i < 4; ++i) gv[i] = *(const f32x4*)(p->final_norm + i * 256 + lane * 4);
    int sl0 = 0, sl1 = 0; float ga0 = 0.f, ga1 = 0.f;
    { const int row = lo + bid * 8 + wid; if (row < hi) { sl0 = p->slot_of[row * 2]; sl1 = p->slot_of[row * 2 + 1]; ga0 = p->mgate[row * 2]; ga1 = p->mgate[row * 2 + 1]; } }
    for (int row = lo + bid * 8 + wid; row < hi; row += nb * 8) {
        const int s0 = sl0, s1 = sl1; const float g0 = ga0, g1 = ga1;
        u32x2 y0[4], y1[4];
#pragma unroll
        for (int i = 0; i < 4; ++i) { y0[i] = *(const u32x2*)(p->yslot + (size_t)s0 * DM + i * 256 + lane * 4); y1[i] = *(const u32x2*)(p->yslot + (size_t)s1 * DM + i * 256 + lane * 4); }
        f32x4 v[4]; load_row_b(hsrc, row, lane, v);
        { const int rn = row + nb * 8; if (rn < hi) { sl0 = p->slot_of[rn * 2]; sl1 = p->slot_of[rn * 2 + 1]; ga0 = p->mgate[rn * 2]; ga1 = p->mgate[rn * 2 + 1]; } }
#pragma unroll
        for (int i = 0; i < 4; ++i) {
            v[i][0] += g0 * __uint_as_float(y0[i].x << 16) + g1 * __uint_as_float(y1[i].x << 16); v[i][1] += g0 * __uint_as_float(y0[i].x & 0xffff0000u) + g1 * __uint_as_float(y1[i].x & 0xffff0000u);
            v[i][2] += g0 * __uint_as_float(y0[i].y << 16) + g1 * __uint_as_float(y1[i].y << 16); v[i][3] += g0 * __uint_as_float(y0[i].y & 0xffff0000u) + g1 * __uint_as_float(y1[i].y & 0xffff0000u); }
        const float rs = row_rstd(v);
#pragma unroll
        for (int i = 0; i < 4; ++i) *(f32x4*)(p->out + (size_t)row * DM + i * 256 + lane * 4) = v[i] * rs * gv[i];
    }
}


#ifndef CPU_EMU
#define XB_TMO      128
#define XB_XCNT(j)  (256  + 64 * (j))
#define XB_XSUB(j)  (1280 + 64 * (j))
#define XB_XGEN(j)  (2304 + 64 * (j))
#define XB_TOP      3328
#define XB_TOPGEN   3392
#define XCD_BAR_WORDS 3456
#define XB_SPIN_CAP (1u << 20)
__device__ __forceinline__ unsigned xb_ld(unsigned* p) { return __hip_atomic_load(p, __ATOMIC_RELAXED, __HIP_MEMORY_SCOPE_AGENT); }
__device__ __forceinline__ unsigned xb_add(unsigned* p, unsigned v) { return __hip_atomic_fetch_add(p, v, __ATOMIC_RELAXED, __HIP_MEMORY_SCOPE_AGENT); }
__device__ __forceinline__ unsigned xb_xcc_id() { return (unsigned)__builtin_amdgcn_s_getreg((3 << 11) | 20) & 0xFu; }
#define XB_SPIN(cond, bar) do { unsigned _sp = 0; while (cond) { __builtin_amdgcn_s_sleep(1); \
    if ((++_sp & 255u) == 0u) { if (xb_ld(&(bar)[XB_TMO])) break; if (_sp > XB_SPIN_CAP) { atomicAdd(&(bar)[XB_TMO], 1u); break; } } } } while (0)
__device__ __forceinline__ void xcd_barrier_post(unsigned* bar, int tid) { if (tid == 0) (void)xb_add(&bar[XB_XCNT(xb_xcc_id())], 1u); }
__device__ __forceinline__ void xcd_barrier_complete(unsigned* bar, unsigned x, unsigned& nloc, unsigned& nx) {
    const unsigned G = gridDim.x * gridDim.y * gridDim.z;
    unsigned sum, cnt, mine, sp = 0u;
    for (;;) {
        sum = 0u; cnt = 0u; mine = 0u;
#pragma unroll
        for (unsigned j = 0; j < 16; ++j) { const unsigned c = xb_ld(&bar[XB_XCNT(j)]); sum += c; cnt += (c > 0u) ? 1u : 0u; mine = (j == x) ? c : mine; }
        if (sum == G) break;
        __builtin_amdgcn_s_sleep(1);
        if ((++sp & 255u) == 0u) { if (xb_ld(&bar[XB_TMO])) break; if (sp > XB_SPIN_CAP) { atomicAdd(&bar[XB_TMO], 1u); break; } }
    }
    nloc = mine > 0u ? mine : 1u; nx = cnt > 0u ? cnt : 1u;
}
__device__ __forceinline__ void xcd_barrier(unsigned* bar, volatile LAS unsigned* st, int tid) {
    asm volatile("s_waitcnt vmcnt(0)" ::: "memory");
    __syncthreads();
    if (tid == 0) {
        __builtin_amdgcn_s_waitcnt(0);
        const unsigned x = xb_xcc_id();
        unsigned nloc = st[0], nx = st[1];
        if (nloc == 0u) { xcd_barrier_complete(bar, x, nloc, nx); st[0] = nloc; st[1] = nx; }
        const unsigned old = xb_add(&bar[XB_XSUB(x)], 1u);
        const unsigned gen = old / nloc;
        if (old + 1u == (gen + 1u) * nloc) {
            __builtin_amdgcn_fence(__ATOMIC_RELEASE, "agent");
            asm volatile("s_waitcnt vmcnt(0)" ::: "memory");
            const unsigned og = xb_add(&bar[XB_TOP], 1u);
            const unsigned tg = og / nx;
            if (og + 1u == (tg + 1u) * nx) xb_add(&bar[XB_TOPGEN], 1u);
            else XB_SPIN(xb_ld(&bar[XB_TOPGEN]) == tg, bar);
            __builtin_amdgcn_fence(__ATOMIC_ACQUIRE, "agent");
            xb_add(&bar[XB_XGEN(x)], 1u);
            asm volatile("s_waitcnt vmcnt(0)" ::: "memory");
        } else {
            XB_SPIN(xb_ld(&bar[XB_XGEN(x)]) == gen, bar);
            __builtin_amdgcn_fence(__ATOMIC_ACQUIRE, "agent");
            asm volatile("s_waitcnt vmcnt(0)" ::: "memory");
        }
    }
    __syncthreads();
}
#define GRID_BARRIER() do { unsigned* _bar = p->bar; xcd_barrier(_bar, (volatile LAS unsigned*)(lds + kDynLds - 16), opaque_tid(wv)); } while (0)
#else
#define XCD_BAR_WORDS 3456
#define GRID_BARRIER() emu::grid_sync()
#endif


__global__ void __launch_bounds__(NTHREADS) fwd_megakernel(Params p_arg) {
    cg::grid_group grid = cg::this_grid();
    KPTR p = KARG_PTR(p_arg);
    LAS unsigned char* lds = GET_LDS();
#ifndef CPU_EMU
    const int wv = __builtin_amdgcn_readfirstlane((int)(threadIdx.x >> 6));
#else
    const int wv = 0;
#endif
    const int bid = blockIdx.x, nb = gridDim.x, tid = opaque_tid(wv);
#ifndef CPU_EMU
    if (tid == 0) { volatile LAS unsigned* st = (volatile LAS unsigned*)(lds + kDynLds - 16); st[0] = 0u; st[1] = 0u; }
    __syncthreads();
    xcd_barrier_post(p->bar, tid);
#endif
    LAUNDER(p);
    if (bid == 0 && tid < 256) p->ctrl[tid] = 0u;
    for (int i = bid * NTHREADS + tid; i < NIT; i += nb * NTHREADS) p->mcount[i] = 0u;
    for (int i = bid * NTHREADS + tid; i < NCHH; i += nb * NTHREADS) p->gflag[i] = 0u;
    convert_wt(lds, p->w_in, DM, DIN, 0, DINP, p->wt_in, 128, 0, bid, nb, wv);
    convert_wt(lds, p->w_out0, DM, DM, 0, DM, p->wt_out0, 128, 0, bid, nb, wv);
    convert_wt(lds, p->w_gate0, DM, FF, 0, FF, p->wt_gu0, 256, 0, bid, nb, wv);
    convert_wt(lds, p->w_up0, DM, FF, 0, FF, p->wt_gu0, 256, 128, bid, nb, wv);
    convert_wt(lds, p->w_down0, FF, DM, 0, DM, p->wt_d0, 128, 0, bid, nb, wv);
    convert_wt(lds, p->w_qkv, DM, 3072, 0, 3072, p->wt_qkv, 128, 0, bid, nb, wv);
    convert_wt(lds, p->w_out1, DM, DM, 0, DM, p->wt_out1, 128, 0, bid, nb, wv);
    phase_norm<true>(p, p->x, p->mix_norm, bid, nb, wv);
    if (p->pad0 != 0) grid.sync(); else GRID_BARRIER();
    LAUNDER(p);
    for (int rp = 0; rp < RPT_GEMM; ++rp) { StaticOrder so; so.init(NTOK / 256, DINP / 256, nb, bid); Gemm g{p->hn, p->wt_in, nullptr}; EpiBf16 e{p->proj, DINP, 0}; gemm_phase<DM>(lds, g, so, e, wv); }
    GRID_BARRIER();
    LAUNDER(p);
    constexpr int NUG_ = ((BATCH * 4 + 7) / 8) * 8 * (8 / NCW);
    const bool overlap = nb >= NUG_ + 32;
    if (!overlap) phase_gdn_pre<false>(p, lds, bid, nb, wv);
    phase_ret_local(p, lds, bid, nb, wv);
    GRID_BARRIER();
    LAUNDER(p);
    if (overlap) phase_scan<true>(p, lds, bid, nb, wv); else phase_scan<false>(p, lds, bid, nb, wv);
    GRID_BARRIER();
    LAUNDER(p);
    phase_gatednorm(p, bid, nb, wv);
    GRID_BARRIER();
    LAUNDER(p);
    { StaticOrder so; so.init(NTOK / 256, DM / 256, nb, bid); Gemm g{p->hn, p->wt_out0, nullptr}; EpiResBf16<true> e{p->x, nullptr, p->hb}; gemm_phase<DM>(lds, g, so, e, wv); }
    GRID_BARRIER();
    LAUNDER(p);
#if FP8_FFN0
    phase_norm<false, true, true>(p, p->hb, p->ffn_norm, bid, nb, wv);
    quant_rows<DM, false>(p, lds, p->wt_gu0, p->w8_gu0, p->ws_gu0, 2 * FF, bid, nb, wv);
#else
    phase_norm<false, false, true>(p, p->hb, p->ffn_norm, bid, nb, wv);
#endif
    GRID_BARRIER();
    LAUNDER(p);
#if FP8_FFN0
    for (int rp = 0; rp < RPT_GEMM; ++rp) { StaticOrder so; so.init(NTOK / 256, 2 * FF / 256, nb, bid); Gemm g{p->hn, (const bf16_t*)p->w8_gu0, nullptr}; EpiSwigluS e{p->act0, FF, 0, p->hns, p->ws_gu0}; gemm_phase<DM, EpiSwigluS, StaticOrder, true>(lds, g, so, e, wv); }
#else
    for (int rp = 0; rp < RPT_GEMM; ++rp) { StaticOrder so; so.init(NTOK / 256, 2 * FF / 256, nb, bid); Gemm g{p->hn, p->wt_gu0, nullptr}; EpiSwiglu e{p->act0, FF, 0}; gemm_phase<DM>(lds, g, so, e, wv); }
#endif
    GRID_BARRIER();
    LAUNDER(p);
    { StaticOrder so; so.init(NTOK / 256, DM / 256, nb, bid); Gemm g{p->act0, p->wt_d0, nullptr}; EpiResBf16<false> e{nullptr, p->hb, p->hb}; gemm_phase<FF>(lds, g, so, e, wv); }
    GRID_BARRIER();
    LAUNDER(p);
    phase_norm<false, false, true>(p, p->hb, p->mix_norm + DM, bid, nb, wv);
    GRID_BARRIER();
    LAUNDER(p);
    for (int rp = 0; rp < RPT_GEMM; ++rp) { StaticOrder so; so.init(NTOK / 256, 3072 / 256, nb, bid); Gemm g{p->hn, p->wt_qkv, nullptr}; EpiBf16 e{p->qkv, 3072, 0}; gemm_phase<DM>(lds, g, so, e, wv); }
    GRID_BARRIER();
    LAUNDER(p);
    phase_kmean(p, lds, bid, nb, wv);
    GRID_BARRIER();
    LAUNDER(p);
    phase_moba_select(p, lds, bid, nb, wv);
    GRID_BARRIER();
    LAUNDER(p);
    for (int rp = 0; rp < RPT_MG; ++rp) phase_moba_gather(p, lds, bid, nb, wv);
    GRID_BARRIER();
    LAUNDER(p);
    for (int rp = 0; rp < RPT_MO; ++rp) phase_moba_own(p, lds, bid, nb, wv);
    GRID_BARRIER();
    LAUNDER(p);
    convert_gu_fp8(p, lds, bid, nb, wv);
    for (int rp = 0; rp < RPT_CONV; ++rp) for (int e = 0; e < NE; ++e) {
        convert_wt(lds, p->w_mdown + (size_t)e * FFE * DM, FFE, DM, 0, DM, p->wt_md_tmp + (size_t)e * DM * FFE, 128, 0, bid, nb, wv);
    }
    { StaticOrder so; so.init(NTOK / 256, DM / 256, nb, bid); Gemm g{p->hn, p->wt_out1, nullptr}; EpiResBf16<false> e{nullptr, p->hb, p->hb3}; gemm_phase<DM>(lds, g, so, e, wv); }
    GRID_BARRIER();
    LAUNDER(p);
    phase_router(p, lds, bid, nb, wv);
    quant_rows<FFE, false>(p, lds, p->wt_md_tmp, p->w8_md, p->ws_md, NE * DM, bid, nb, wv);
    GRID_BARRIER();
    LAUNDER(p);
    phase_slots(p, lds, bid, nb, wv);
    GRID_BARRIER();
    LAUNDER(p);
    {
        const int ntiles = (int)p->ctrl[C_NTILES];
        const int npass = (ntiles + p->tiles_per_pass - 1) / p->tiles_per_pass;
        const int tpp = npass > 0 ? (ntiles + npass - 1) / npass : 1;
        const size_t mbuf = (size_t)p->tiles_per_pass * 256 * FFE; int q = 0;
        for (int t0 = 0; t0 < ntiles; t0 += tpp, ++q) {
            const int nM = (ntiles - t0) < tpp ? (ntiles - t0) : tpp;
            unsigned char* mb = (unsigned char*)p->mact + (size_t)(q & 1) * mbuf;
            for (int rp = 0; rp < RPT_GEMM; ++rp) { MoeOrder mo; mo.init(t0, nM, 2 * FFE / 256, p->tile_e, nb, bid); Gemm g{p->hn, (const bf16_t*)p->w8_mgu, p->arow}; EpiSwigluS8 e{mb, FFE, t0 * 256, p->sslot, p->ws_mgu, p->shs}; gemm_phase<DM, EpiSwigluS8, MoeOrder, true, true>(lds, g, mo, e, wv); }
            GRID_BARRIER();
            for (int rp = 0; rp < RPT_GEMM; ++rp) { MoeOrder mo; mo.init(t0, nM, DM / 256, p->tile_e, nb, bid); Gemm g{(const bf16_t*)((const unsigned char*)mb - (size_t)t0 * 256 * FFE), (const bf16_t*)p->w8_md, nullptr}; EpiBf16S e{p->yslot, DM, p->shs, p->ws_md}; gemm_phase<FFE, EpiBf16S, MoeOrder, true>(lds, g, mo, e, wv); }
        }
        GRID_BARRIER();
    }
    LAUNDER(p);
    phase_final(p, p->hb3, 0, NTOK, bid, nb, wv);
}

static inline size_t al256(size_t x) { return (x + 255) & ~(size_t)255; }

extern "C" void kernel_launch(void* const* d_in, const int* in_sizes, int n_in, void* d_out, int out_size, void* d_ws, size_t ws_size, hipStream_t stream) {
    Params p; memset(&p, 0, sizeof(p));
    p.x = (const float*)d_in[0]; p.mix_norm = (const float*)d_in[1]; p.ffn_norm = (const float*)d_in[2]; p.w_in = (const float*)d_in[3]; p.conv_w = (const float*)d_in[4];
    p.a_log = (const float*)d_in[5]; p.dt_bias = (const float*)d_in[6]; p.ret_norm = (const float*)d_in[7]; p.gdn_norm = (const float*)d_in[8]; p.w_out0 = (const float*)d_in[9];
    p.w_qkv = (const float*)d_in[10]; p.w_out1 = (const float*)d_in[11]; p.w_gate0 = (const float*)d_in[12]; p.w_up0 = (const float*)d_in[13]; p.w_down0 = (const float*)d_in[14];
    p.w_router = (const float*)d_in[15]; p.w_mgate = (const float*)d_in[16]; p.w_mup = (const float*)d_in[17]; p.w_mdown = (const float*)d_in[18]; p.final_norm = (const float*)d_in[19];
    p.out = (float*)d_out; p.hb = (bf16_t*)((unsigned char*)d_out + (size_t)NTOK * DM * 2);
    unsigned char* w = (unsigned char*)d_ws; size_t off = 0;
    auto take = [&](size_t bytes) { unsigned char* r = w + off; off += al256(bytes); return r; };
    p.ctrl = (unsigned*)take(4096); p.bar = (unsigned*)take((size_t)XCD_BAR_WORDS * 4);
    p.wt_in = (bf16_t*)take((size_t)DINP * DM * 2); p.wt_out0 = (bf16_t*)take((size_t)DM * DM * 2); p.wt_gu0 = (bf16_t*)take((size_t)2 * FF * DM * 2); p.wt_d0 = (bf16_t*)take((size_t)DM * FF * 2);
    p.wt_qkv = (bf16_t*)take((size_t)3072 * DM * 2); p.wt_out1 = (bf16_t*)take((size_t)DM * DM * 2);
    p.hn = (bf16_t*)take((size_t)NTOK * DM * 2);
    p.gflag = (unsigned*)take((size_t)NCHH * 4);
    p.retL = (float*)take((size_t)BATCH * 4 * NG * 128 * 128 * 4);
    p.gbeta = (float*)take((size_t)NTOK * 4 * 4); p.gg = (float*)take((size_t)NTOK * 4 * 4);
    p.arow = (int*)take((size_t)MAXTILES * 256 * 4); p.tile_e = (int*)take((size_t)MAXTILES * 4); p.slot_of = (int*)take((size_t)NTOK * 2 * 4); p.mgate = (float*)take((size_t)NTOK * 2 * 4); p.midx = (int*)take((size_t)NTOK * 2 * 4); p.wghist = (unsigned*)take((size_t)4096 * 8 * 4);
    p.w8_gu0 = take(FP8_FFN0 ? (size_t)2 * FF * DM : (size_t)256); p.ws_gu0 = (float*)take((size_t)2 * FF * 4); p.ws_mgu = (float*)take((size_t)NE * 2 * FFE * 4); p.hns = (float*)take((size_t)NTOK * 4); p.sslot = (float*)take((size_t)MAXTILES * 256 * 4);
    p.ws_md = (float*)take((size_t)NE * DM * 4); p.hnn2 = (float*)take((size_t)NTOK * 4); p.shs = (float*)take((size_t)MAXTILES * 256 * 4);
    p.kmh = (bf16_t*)take((size_t)NIT * 128 * 2); p.kml = (bf16_t*)take((size_t)NIT * 128 * 2); p.mcount = (unsigned*)take((size_t)NIT * 4);
    p.arena = w + off;
    const size_t arena_bytes = ws_size - off;
    { size_t a = 0; auto at = [&](size_t bytes) { unsigned char* r = p.arena + a; a += al256(bytes); return r; };
      p.proj = (bf16_t*)at((size_t)NTOK * DINP * 2);
      p.gimg = (unsigned char*)at((size_t)NCHH * IMG_CH); p.gcdec = (float*)at((size_t)NCHH * 4);
      if (a > arena_bytes) fprintf(stderr, "workspace too small (layer0): need %zu have %zu\n", a, arena_bytes); }
    p.act0 = (bf16_t*)p.arena;
    { size_t a = 0; auto at = [&](size_t bytes) { unsigned char* r = p.arena + a; a += al256(bytes); return r; };
      p.qkv = (bf16_t*)at((size_t)NTOK * 3072 * 2); p.part_o = (bf16_t*)at((size_t)NTOK * 8 * 3 * 128 * 2); p.part_lse = (float*)at((size_t)NTOK * 8 * 3 * 4); p.mlist = (unsigned short*)at((size_t)BATCH * 8 * LTOT * 2);
      if (a > arena_bytes) fprintf(stderr, "workspace too small (layer1): need %zu have %zu\n", a, arena_bytes); }
    { size_t a = 0; auto at = [&](size_t bytes) { unsigned char* r = p.arena + a; a += al256(bytes); return r; };
      p.w8_mgu = at((size_t)NE * 2 * FFE * DM); p.w8_md = at((size_t)NE * DM * FFE); p.yslot = (bf16_t*)at((size_t)MAXTILES * 256 * DM * 2);
      p.hb3 = (bf16_t*)at((size_t)NTOK * DM * 2);
      p.mact = (bf16_t*)(p.arena + a);
      p.wt_mgu = nullptr; p.wt_md_tmp = p.mact; p.wt_md = nullptr;
      const size_t rest = arena_bytes > a ? arena_bytes - a : 0;
      if (rest < (size_t)NE * FFE * DM * 2) fprintf(stderr, "workspace too small (moe weights)\n");
      long tiles = (long)(rest / ((size_t)2 * 256 * FFE));
      if (tiles > 64) tiles = 64;
      if (tiles < 1) { fprintf(stderr, "workspace too small (moe)\n"); tiles = 1; }
#ifdef CPU_EMU
      if (getenv("EMU_TPP")) tiles = atoi(getenv("EMU_TPP"));
#endif
      p.tiles_per_pass = (int)tiles; }
#ifdef CPU_EMU
    emu::reg("hn", p.hn, (size_t)NTOK * DM * 2, "bf16"); emu::reg("proj", p.proj, (size_t)NTOK * DINP * 2, "bf16");
    emu::reg("gbeta", p.gbeta, (size_t)NTOK * 16, "f32"); emu::reg("gg", p.gg, (size_t)NTOK * 16, "f32"); emu::reg("midx", p.midx, (size_t)NTOK * 8, "i32");
    const int grid_blocks = getenv("EMU_GRID") ? atoi(getenv("EMU_GRID")) : 8;
    emu::launch(grid_blocks, NTHREADS, kDynLds, [=]() { fwd_megakernel(p); }, true);
#else
    static int grid_blocks = 0;
    if (!grid_blocks) {
        int dev = 0, cus = 0, per_cu = 0;
        (void)hipGetDevice(&dev);
        (void)hipDeviceGetAttribute(&cus, hipDeviceAttributeMultiprocessorCount, dev);
        (void)hipFuncSetAttribute((const void*)fwd_megakernel, hipFuncAttributeMaxDynamicSharedMemorySize, (int)kDynLds);
        (void)hipOccupancyMaxActiveBlocksPerMultiprocessor(&per_cu, fwd_megakernel, NTHREADS, kDynLds);
        if (per_cu < 1) per_cu = 1;
        grid_blocks = cus;
    }
    (void)hipMemsetAsync(p.bar, 0, (size_t)XCD_BAR_WORDS * 4, stream);
    void* args[] = {&p};
    hipError_t e = hipLaunchCooperativeKernel((const void*)fwd_megakernel, dim3(grid_blocks), dim3(NTHREADS), args, kDynLds, stream);
    if (e != hipSuccess) fprintf(stderr, "cooperative launch failed: %s (grid %d)\n", hipGetErrorString(e), grid_blocks);
#endif
}
```
